# Optimizing an MI355X kernel written in HIP

```python
import functools
import jax, jax.numpy as jnp
from jax import lax
import numpy as np

D_MODEL = 1024
BATCH = 16
SEQ = 2048
DEPTH = 1
DEC_BATCH = 32
DEC_SEQ = 4
PAST_LEN = 16384
PAGE_SIZE = 128

D_MIX = D_MODEL
D_CONV = D_MIX // 2
CONV_W = 3
N_HEADS = 8
HEAD_DIM = (D_MIX - D_CONV) // N_HEADS
N_KV = 2
N_REP = N_HEADS // N_KV
ROT_DIM = HEAD_DIM // 4
ROPE_THETA = 500000.0
N_IDX_HEADS = 8
D_IDX = 64
IDX_ROT = D_IDX // 4
K_TOP = 256
Q_BLOCK = 128
D_FF = 128 * ((8 * D_MODEL // 3 + 127) // 128)
EPS = 1e-6
IN_WIDTHS = (D_CONV, D_CONV, D_CONV, N_HEADS * HEAD_DIM, N_KV * HEAD_DIM, N_KV * HEAD_DIM,
             N_IDX_HEADS * D_IDX, D_IDX, N_IDX_HEADS)
N_IN = sum(IN_WIDTHS)

kernel_name = "hymba_conv_dsa_macaron_step"


def rmsnorm(x, g):
    xf = x.astype(jnp.float32)
    y = xf * lax.rsqrt(jnp.mean(xf * xf, axis=-1, keepdims=True) + EPS)
    return (y * g.astype(jnp.float32)).astype(x.dtype)


def swiglu(x, w_gate, w_up, w_down):
    return (jax.nn.silu(x @ w_gate) * (x @ w_up)) @ w_down


def partial_rope(x, pos, rot_dim):
    half = rot_dim // 2
    inv = jnp.power(jnp.float32(ROPE_THETA), -jnp.arange(half, dtype=jnp.float32) * (2.0 / rot_dim))
    ang = pos.astype(jnp.float32)[:, None] * inv[None, :]
    cos = jnp.cos(ang)[:, None, :]
    sin = jnp.sin(ang)[:, None, :]
    x1 = x[..., :half].astype(jnp.float32)
    x2 = x[..., half:rot_dim].astype(jnp.float32)
    rot = jnp.concatenate([x1 * cos - x2 * sin, x2 * cos + x1 * sin], axis=-1).astype(x.dtype)
    return jnp.concatenate([rot, x[..., rot_dim:]], axis=-1)


def short_conv(u_ext, w, b):
    T = u_ext.shape[1] - (CONV_W - 1)
    out = b
    for j in range(CONV_W):
        out = out + w[j] * u_ext[:, j:j + T]
    return out


def take_rows(a, idx):
    return jax.vmap(lambda ab, ib: ab[ib])(a, idx)


def indexer_scores(qi, wi, ki):
    s = jax.nn.relu(jnp.einsum('bqhd,bsd->bqhs', qi, ki).astype(jnp.float32))
    return jnp.einsum('bqhs,bqh->bqs', s, wi.astype(jnp.float32)) * (D_IDX ** -0.5 * N_IDX_HEADS ** -0.5)


def sparse_attention(q, scores, q_pos, gather_kv, k_sel):
    n_keys = scores.shape[-1]
    key_pos = jnp.arange(n_keys, dtype=jnp.int32)
    scores = jnp.where(key_pos[None, None, :] <= q_pos[None, :, None], scores, -jnp.inf)
    _, idx = lax.top_k(scores, k_sel)
    valid = idx <= q_pos[None, :, None]
    kg, vg = gather_kv(idx)
    B, Q = q.shape[:2]
    qg = q.reshape(B, Q, N_KV, N_REP, HEAD_DIM)
    logits = jnp.einsum('bqgrd,bqkgd->bqgrk', qg, kg).astype(jnp.float32) * (HEAD_DIM ** -0.5)
    logits = jnp.where(valid[:, :, None, None, :], logits, -jnp.inf)
    p = jax.nn.softmax(logits, axis=-1)
    out = jnp.einsum('bqgrk,bqkgd->bqgrd', p.astype(vg.dtype), vg)
    return out.reshape(B, Q, N_HEADS, HEAD_DIM)


def attend_prompt(q, k, v, qi, ki, wi, k_sel):
    B, T = q.shape[:2]
    n_blk = T // Q_BLOCK
    gather_kv = lambda idx: (take_rows(k, idx), take_rows(v, idx))

    def block(j):
        t0 = j * Q_BLOCK
        sl = lambda a: lax.dynamic_slice_in_dim(a, t0, Q_BLOCK, axis=1)
        q_pos = t0 + jnp.arange(Q_BLOCK, dtype=jnp.int32)
        sc = indexer_scores(sl(qi), sl(wi), ki)
        return sparse_attention(sl(q), sc, q_pos, gather_kv, k_sel)

    out = lax.map(block, jnp.arange(n_blk, dtype=jnp.int32))
    return jnp.moveaxis(out, 0, 1).reshape(B, T, N_HEADS, HEAD_DIM)


def attend_paged(q, k, v, qi, ki, wi, pool_k, pool_v, pool_idx_k, page_table, k_sel):
    Bd, T = q.shape[:2]
    past_len = page_table.shape[1] * PAGE_SIZE
    past_ki = pool_idx_k[page_table].reshape(Bd, past_len, D_IDX).astype(ki.dtype)
    ki_all = jnp.concatenate([past_ki, ki], axis=1)
    q_pos = past_len + jnp.arange(T, dtype=jnp.int32)
    sc = indexer_scores(qi, wi, ki_all)

    def gather_kv(idx):
        is_past = (idx < past_len)[..., None, None]
        ic = jnp.minimum(idx, past_len - 1)
        page = jax.vmap(lambda pt, i: pt[i])(page_table, ic // PAGE_SIZE)
        off = ic % PAGE_SIZE
        inew = jnp.clip(idx - past_len, 0, T - 1)
        kg = jnp.where(is_past, pool_k[page, off].astype(k.dtype), take_rows(k, inew))
        vg = jnp.where(is_past, pool_v[page, off].astype(v.dtype), take_rows(v, inew))
        return kg, vg

    return sparse_attention(q, sc, q_pos, gather_kv, k_sel)


def decoder_layer(x, pos, conv_prev, attend, ffn1_norm, ffn1_w_gate, ffn1_w_up, ffn1_w_down,
                  mix_norm, w_in, conv_w, conv_b, q_norm, k_norm, w_out,
                  ffn2_norm, ffn2_w_gate, ffn2_w_up, ffn2_w_down):
    B, T, _ = x.shape
    x = x + 0.5 * swiglu(rmsnorm(x, ffn1_norm), ffn1_w_gate, ffn1_w_up, ffn1_w_down)
    h = rmsnorm(x, mix_norm)
    split_at = [int(s) for s in np.cumsum(IN_WIDTHS)[:-1]]
    gb, gc, hc, q, k, v, qi, ki, wi = jnp.split(h @ w_in, split_at, axis=-1)
    u = gc * hc
    u_ext = jnp.concatenate([conv_prev.astype(u.dtype), u], axis=1)
    y_conv = gb * short_conv(u_ext, conv_w, conv_b)
    conv_state = u_ext[:, -(CONV_W - 1):]
    q = partial_rope(rmsnorm(q.reshape(B, T, N_HEADS, HEAD_DIM), q_norm), pos, ROT_DIM)
    k = partial_rope(rmsnorm(k.reshape(B, T, N_KV, HEAD_DIM), k_norm), pos, ROT_DIM)
    v = v.reshape(B, T, N_KV, HEAD_DIM)
    qi = partial_rope(qi.reshape(B, T, N_IDX_HEADS, D_IDX), pos, IDX_ROT)
    ki = partial_rope(ki[:, :, None, :], pos, IDX_ROT)[:, :, 0]
    attn = attend(q, k, v, qi, ki, wi)
    x = x + jnp.concatenate([y_conv, attn.reshape(B, T, N_HEADS * HEAD_DIM)], axis=-1) @ w_out
    x = x + 0.5 * swiglu(rmsnorm(x, ffn2_norm), ffn2_w_gate, ffn2_w_up, ffn2_w_down)
    return x, k, v, ki, conv_state


def setup_inputs(seed: int = 0) -> dict:
    key = jax.random.key(seed)
    ks = jax.random.split(key, 24)
    n_pages = PAST_LEN // PAGE_SIZE
    n_pool = (DEC_BATCH * n_pages * 5) // 4
    nrm = lambda k, shape, s=1.0: jax.random.normal(k, shape, jnp.float32) * s
    gain = lambda k, shape: 1.0 + 0.01 * jax.random.normal(k, shape, jnp.float32)
    page_table = jax.random.permutation(ks[6], n_pool)[:DEC_BATCH * n_pages].reshape(DEC_BATCH, n_pages).astype(jnp.int32)
    return {
        "x_prompt": nrm(ks[0], (BATCH, SEQ, D_MODEL)),
        "x_sample": nrm(ks[1], (DEC_BATCH, DEC_SEQ, D_MODEL)),
        "cache_k": nrm(ks[2], (DEPTH, n_pool, PAGE_SIZE, N_KV, HEAD_DIM)),
        "cache_v": nrm(ks[3], (DEPTH, n_pool, PAGE_SIZE, N_KV, HEAD_DIM)),
        "cache_idx_k": nrm(ks[4], (DEPTH, n_pool, PAGE_SIZE, D_IDX)),
        "cache_conv": nrm(ks[5], (DEPTH, DEC_BATCH, CONV_W - 1, D_CONV)),
        "page_table": page_table,
        "ffn1_norm": gain(ks[7], (DEPTH, D_MODEL)),
        "ffn1_w_gate": nrm(ks[8], (DEPTH, D_MODEL, D_FF), D_MODEL ** -0.5),
        "ffn1_w_up": nrm(ks[9], (DEPTH, D_MODEL, D_FF), D_MODEL ** -0.5),
        "ffn1_w_down": nrm(ks[10], (DEPTH, D_FF, D_MODEL), D_FF ** -0.5),
        "mix_norm": gain(ks[11], (DEPTH, D_MODEL)),
        "w_in": nrm(ks[12], (DEPTH, D_MODEL, N_IN), D_MODEL ** -0.5),
        "conv_w": nrm(ks[13], (DEPTH, CONV_W, D_CONV), CONV_W ** -0.5),
        "conv_b": nrm(ks[14], (DEPTH, D_CONV), 0.01),
        "q_norm": gain(ks[15], (DEPTH, HEAD_DIM)),
        "k_norm": gain(ks[16], (DEPTH, HEAD_DIM)),
        "w_out": nrm(ks[17], (DEPTH, D_MIX, D_MODEL), D_MIX ** -0.5),
        "ffn2_norm": gain(ks[18], (DEPTH, D_MODEL)),
        "ffn2_w_gate": nrm(ks[19], (DEPTH, D_MODEL, D_FF), D_MODEL ** -0.5),
        "ffn2_w_up": nrm(ks[20], (DEPTH, D_MODEL, D_FF), D_MODEL ** -0.5),
        "ffn2_w_down": nrm(ks[21], (DEPTH, D_FF, D_MODEL), D_FF ** -0.5),
    }


def reference(x_prompt, x_sample, cache_k, cache_v, cache_idx_k, cache_conv, page_table,
              ffn1_norm, ffn1_w_gate, ffn1_w_up, ffn1_w_down, mix_norm, w_in, conv_w, conv_b,
              q_norm, k_norm, w_out, ffn2_norm, ffn2_w_gate, ffn2_w_up, ffn2_w_down):
    past_len = page_table.shape[1] * PAGE_SIZE
    pos_p = jnp.arange(SEQ, dtype=jnp.int32)
    pos_s = past_len + jnp.arange(DEC_SEQ, dtype=jnp.int32)
    k_sel_p = min(K_TOP, SEQ // 4)
    k_sel_s = min(K_TOP, (past_len + DEC_SEQ) // 4)
    yp, ys = x_prompt, x_sample
    kp_l, vp_l, ip_l, cp_l, ks_l, vs_l, is_l, cs_l = [], [], [], [], [], [], [], []
    for l in range(DEPTH):
        w = (ffn1_norm[l], ffn1_w_gate[l], ffn1_w_up[l], ffn1_w_down[l], mix_norm[l], w_in[l],
             conv_w[l], conv_b[l], q_norm[l], k_norm[l], w_out[l],
             ffn2_norm[l], ffn2_w_gate[l], ffn2_w_up[l], ffn2_w_down[l])
        conv_zero = jnp.zeros((yp.shape[0], CONV_W - 1, D_CONV), yp.dtype)
        att_p = functools.partial(attend_prompt, k_sel=k_sel_p)
        att_s = functools.partial(attend_paged, pool_k=cache_k[l], pool_v=cache_v[l],
                                  pool_idx_k=cache_idx_k[l], page_table=page_table, k_sel=k_sel_s)
        yp, kp, vp, ip, cp = decoder_layer(yp, pos_p, conv_zero, att_p, *w)
        ys, kss, vss, iss, css = decoder_layer(ys, pos_s, cache_conv[l], att_s, *w)
        kp_l.append(kp); vp_l.append(vp); ip_l.append(ip); cp_l.append(cp)
        ks_l.append(kss); vs_l.append(vss); is_l.append(iss); cs_l.append(css)
    k_prompt = jnp.stack(kp_l); v_prompt = jnp.stack(vp_l)
    idxk_prompt = jnp.stack(ip_l); conv_prompt = jnp.stack(cp_l)
    k_sample = jnp.stack(ks_l); v_sample = jnp.stack(vs_l)
    idxk_sample = jnp.stack(is_l); conv_sample = jnp.stack(cs_l)
    return (yp, ys, k_prompt, v_prompt, idxk_prompt, conv_prompt, k_sample, v_sample, idxk_sample, conv_sample)
```

```cpp
#include <hip/hip_runtime.h>
#include <cstdio>
#include <cstdint>
#include <type_traits>
namespace pg8 {
#define PG8_LAS __attribute__((address_space(3)))
typedef unsigned short bf16_t;
typedef short bf16x8 __attribute__((ext_vector_type(8)));
typedef float f32x4 __attribute__((ext_vector_type(4)));
typedef unsigned u32x4 __attribute__((ext_vector_type(4)));
constexpr int BM = 256, BK = 64, HALF = 128, HTB = HALF * BK * 2  , STAGE_BYTES = 8 * HTB, NXCD = 8, WGM = 8;

__host__ __device__ __forceinline__ int lds_byte(int r, int c) { const int st = (r >> 4) * 2 + (c >> 5), rr = r & 15, cc = c & 31, ob = rr * 64 + cc * 2; return st * 1024 + (ob ^ (((ob >> 9) & 1) << 5)); }
__host__ __device__ __forceinline__ void stage_rc(int b, int& R, int& C) { const int st = b / 1024, sb = b % 1024, swz = sb ^ (((sb >> 9) & 1) << 5); R = (st >> 1) * 16 + swz / 64; C = (st & 1) * 32 + (swz % 64) / 2; }
__host__ __device__ __forceinline__ int perm32(int rho) { const int n = rho >> 4, i = rho & 15; return 8 * (i >> 2) + 4 * n + (i & 3); }

struct Unit { int pm, pn; };
struct Gemm { const bf16_t* A; const bf16_t* Bt; int M, N, K; };

struct StaticOrder {
    int nM, nN, nwg, G, c;
    __host__ __device__ void init(int M, int N, int G_, int c_) { nM = M / BM; nN = N / BM; nwg = nM * nN; G = G_; c = c_; }
    __host__ __device__ bool next(int i, Unit& u) const {
        const long L = (long)i * G + c; if (L >= nwg) return false;
        int wgid = (int)L; { const int q = nwg / NXCD, r = nwg % NXCD, xcd = wgid % NXCD, off = wgid / NXCD; wgid = (xcd < r ? xcd * (q + 1) : r * (q + 1) + (xcd - r) * q) + off; }
        const int nig = WGM * nN, gid = wgid / nig, fm = gid * WGM, gsz = (nM - fm) < WGM ? (nM - fm) : WGM;
        u.pm = fm + ((wgid % nig) % gsz); u.pn = (wgid % nig) / gsz; return true;
    }
    __device__ __forceinline__ void a_ready(const Unit&) const {}
    __device__ __forceinline__ void done(const Unit&) const {}
};
__device__ __forceinline__ unsigned cvt_pk_bf16(float lo, float hi) { unsigned r; asm volatile("v_cvt_pk_bf16_f32 %0, %1, %2" : "=v"(r) : "v"(lo), "v"(hi)); return r; }
template <class Epi, class Sched, bool ALIGN_EPI = false, bool SP2 = false, int QM = 0, int PFD = 0>
__device__ __forceinline__ void gemm_phase(PG8_LAS unsigned char* lds, const Gemm g, const Sched& S, const Epi& E) {
    const int tid = threadIdx.x, wid = __builtin_amdgcn_readfirstlane(tid >> 6), lane = tid & 63, wr = wid >> 2, wc = wid & 3, fr = lane & 15, fq = lane >> 4;
    const int K = g.K, nt = K / BK;
    unsigned voffA[2], voffB[2];
#pragma unroll
    for (int i = 0; i < 2; ++i) { int R, C; stage_rc(tid * 16 + i * 8192, R, C); const int Rb = Epi::PERM ? ((R & ~31) + perm32(R & 31)) : R;
        voffA[i] = (unsigned)(R * K + C) * 2u; voffB[i] = (unsigned)(Rb * K + C) * 2u; }
    unsigned voffP[2];
#pragma unroll
    for (int i = 0; i < 2; ++i) voffP[i] = (unsigned)((32 * wid + 16 * i + (lane >> 2)) * K) * 2u + (unsigned)(lane & 3) * 4u;
#define PG8_PF(s2, kt) do { if constexpr (PFD != 0) { const char* p_ = ((kt) < nt) ? cA + (size_t)(kt) * kstep : nA + (size_t)((kt) - nt) * kstep; \
        __builtin_amdgcn_global_load_lds((const unsigned*)(p_ + voffP[s2]), (PG8_LAS unsigned*)(lds + 143360 + wid * 256), 4, 0, 0); } } while (0)
#define PG8_WAIT_V8() do { if constexpr (PFD != 0) PG8_WAIT_V(10); else PG8_WAIT_V(8); } while (0)
    const size_t kstep = (size_t)(BK * 2);
    const size_t hstep = (size_t)HALF * K * 2;
    const size_t tstep = 2 * hstep;
    const unsigned ldsw = (unsigned)wid * 1024u;
    const int aoff = lds_byte(wr * 64 + fr, fq * 8), boff = lds_byte(wc * 32 + fr, fq * 8);
#define PG8_SA(b, h) (((b) * 2 + (h)) * HTB)
#define PG8_SB(b, h) ((4 + (b) * 2 + (h)) * HTB)
#define PG8_STAGE(bufoff, gbase, voff) do { _Pragma("unroll") for (int _i = 0; _i < 2; ++_i) \
        __builtin_amdgcn_global_load_lds((const unsigned*)((const char*)(gbase) + (voff)[_i]), (PG8_LAS unsigned*)(lds + (bufoff) + ldsw + _i * 8192), 16, 0, 0); } while (0)
#define PG8_LDF(dst_, addr_) do { if constexpr (QM == 1) { const pg8_v4i lo_ = *(const PG8_LAS pg8_v4i*)(addr_), hi_ = *(const PG8_LAS pg8_v4i*)((addr_) + 1024); \
            (dst_).v = __builtin_shufflevector(lo_, hi_, 0, 1, 2, 3, 4, 5, 6, 7); } \
        else { (dst_).k[0] = *(const PG8_LAS bf16x8*)(addr_); (dst_).k[1] = *(const PG8_LAS bf16x8*)((addr_) + 1024); } } while (0)
#define PG8_LDA(dst, b, h) do { _Pragma("unroll") for (int m = 0; m < 4; ++m) PG8_LDF(dst[m], lds + PG8_SA(b, h) + aoff + m * 2048); } while (0)
#define PG8_LDB(dst, b, h) do { _Pragma("unroll") for (int n = 0; n < 2; ++n) PG8_LDF(dst[n], lds + PG8_SB(b, h) + boff + n * 2048); } while (0)
#define PG8_MMA(ai, bj, At, Bt) do { __builtin_amdgcn_s_setprio(1); if constexpr (QM != 0) asm volatile("s_nop 4");     \
        _Pragma("unroll") for (int m = 0; m < 4; ++m) _Pragma("unroll") for (int n = 0; n < 2; ++n) { \
            if constexpr (QM == 1) asm volatile("v_mfma_scale_f32_16x16x128_f8f6f4 %0, %1, %2, %0, %3, %3 op_sel_hi:[0,0,0]" : "+v"(acc[ai][bj][m][n]) : "v"(Bt[n].v), "v"(At[m].v), "v"(scl8_));     \
            else if constexpr (QM == 2) { _Pragma("unroll") for (int k = 0; k < 2; ++k) asm volatile("v_mfma_i32_16x16x64_i8 %0, %1, %2, %0" : "+v"(acc[ai][bj][m][n]) : "v"(Bt[n].k[k]), "v"(At[m].k[k])); } \
            else { _Pragma("unroll") for (int k = 0; k < 2; ++k) acc[ai][bj][m][n] = __builtin_amdgcn_mfma_f32_16x16x32_bf16(Bt[n].k[k], At[m].k[k], acc[ai][bj][m][n], 0, 0, 0); } } \
        __builtin_amdgcn_s_setprio(0); } while (0)
#define PG8_WAIT_V(n) asm volatile("s_waitcnt vmcnt(" #n ")" ::: "memory")
#define PG8_WAIT_L(n) asm volatile("s_waitcnt lgkmcnt(" #n ")" ::: "memory")
#define PG8_BAR __builtin_amdgcn_s_barrier()
#define PG8_SCHED __builtin_amdgcn_sched_barrier(0)
    Unit cur, nxt; int ui = 0;
    if (!S.next(0, cur)) return;
    f32x4 acc[2][2][4][2];
    E.init(acc, cur, wr, wc, fr, fq);
    typedef int pg8_v8i __attribute__((ext_vector_type(8))); typedef int pg8_v4i __attribute__((ext_vector_type(4)));
    struct FragB { bf16x8 k[2]; }; struct Frag8 { pg8_v8i v; };
    typedef typename std::conditional<QM == 1, Frag8, FragB>::type Frag;
    Frag At[4], B0[2], B1[2];
    unsigned scl8_ = 0x7F7F7F7Fu; asm volatile("" : "+v"(scl8_));
    const char* cA = (const char*)g.A + (size_t)cur.pm * tstep; const char* cB = (const char*)g.Bt + (size_t)cur.pn * tstep;
    S.a_ready(cur);
    if constexpr (SP2) {
        PG8_STAGE(PG8_SB(0, 0), cB, voffB); PG8_STAGE(PG8_SB(0, 1), cB + hstep, voffB); PG8_STAGE(PG8_SA(0, 0), cA, voffA); PG8_STAGE(PG8_SA(0, 1), cA + hstep, voffA);
        if (wr == 1) PG8_BAR;
        PG8_WAIT_V(2); PG8_BAR;
        PG8_STAGE(PG8_SB(1, 0), cB + kstep, voffB); PG8_STAGE(PG8_SA(1, 0), cA + kstep, voffA); PG8_STAGE(PG8_SB(1, 1), cB + hstep + kstep, voffB);
        PG8_WAIT_V(6); PG8_BAR;
    } else {
        PG8_STAGE(PG8_SB(0, 0), cB, voffB); PG8_STAGE(PG8_SA(0, 0), cA, voffA); PG8_STAGE(PG8_SB(0, 1), cB + hstep, voffB); PG8_STAGE(PG8_SA(0, 1), cA + hstep, voffA);
        if (wr == 1) PG8_BAR;
        PG8_WAIT_V(4); PG8_BAR;
        PG8_STAGE(PG8_SB(1, 0), cB + kstep, voffB); PG8_STAGE(PG8_SA(1, 0), cA + kstep, voffA); PG8_STAGE(PG8_SB(1, 1), cB + hstep + kstep, voffB);
        PG8_WAIT_V(6); PG8_BAR;
    }
    for (;;) {
        const bool has_next = S.next(ui + 1, nxt);
        const char* nA = has_next ? (const char*)g.A + (size_t)nxt.pm * tstep : cA; const char* nB = has_next ? (const char*)g.Bt + (size_t)nxt.pn * tstep : cB;
#pragma unroll 1
        for (int t = 0; t < nt; t += 2) {
            const bool last = (t == nt - 2);
            const char* a1 = cA + (size_t)(t + 1) * kstep;
            const char* a2 = last ? nA : cA + (size_t)(t + 2) * kstep; const char* b2 = last ? nB : cB + (size_t)(t + 2) * kstep;
            const char* a3 = a2 + kstep; const char* b3 = b2 + kstep;
            if (last && has_next) S.a_ready(nxt);
            if constexpr (SP2) {
            PG8_LDB(B0, 0, 0); PG8_LDB(B1, 0, 1); PG8_SCHED; PG8_LDA(At, 0, 0); PG8_STAGE(PG8_SA(1, 1), a1 + hstep, voffA); PG8_PF(0, t + PFD);
            PG8_WAIT_V8(); PG8_WAIT_L(0); PG8_BAR; PG8_MMA(0, 0, At, B0); PG8_MMA(0, 1, At, B1); PG8_BAR; PG8_SCHED;
            PG8_LDA(At, 0, 1); PG8_STAGE(PG8_SB(0, 0), b2, voffB); PG8_STAGE(PG8_SB(0, 1), b2 + hstep, voffB); PG8_STAGE(PG8_SA(0, 0), a2, voffA); PG8_PF(1, t + PFD);
            PG8_WAIT_V8(); PG8_WAIT_L(0); PG8_BAR; PG8_MMA(1, 0, At, B0); PG8_MMA(1, 1, At, B1); PG8_BAR; PG8_SCHED;
            PG8_LDB(B0, 1, 0); PG8_LDB(B1, 1, 1); PG8_SCHED; PG8_LDA(At, 1, 0); PG8_STAGE(PG8_SA(0, 1), a2 + hstep, voffA); PG8_PF(0, t + 1 + PFD);
            PG8_WAIT_V8(); PG8_WAIT_L(0); PG8_BAR; PG8_MMA(0, 0, At, B0); PG8_MMA(0, 1, At, B1); PG8_BAR; PG8_SCHED;
            PG8_LDA(At, 1, 1); PG8_STAGE(PG8_SB(1, 0), b3, voffB); PG8_STAGE(PG8_SB(1, 1), b3 + hstep, voffB); PG8_STAGE(PG8_SA(1, 0), a3, voffA); PG8_PF(1, t + 1 + PFD);
            PG8_WAIT_V8(); PG8_WAIT_L(0); PG8_BAR; PG8_MMA(1, 0, At, B0); PG8_MMA(1, 1, At, B1); PG8_BAR; PG8_SCHED;
            } else {
            PG8_LDB(B0, 0, 0); PG8_SCHED; PG8_LDA(At, 0, 0); PG8_STAGE(PG8_SA(1, 1), a1 + hstep, voffA);
            PG8_WAIT_L(8); PG8_BAR; PG8_WAIT_L(0); PG8_MMA(0, 0, At, B0); PG8_BAR; PG8_SCHED;
            PG8_LDB(B1, 0, 1); PG8_STAGE(PG8_SB(0, 0), b2, voffB);
            PG8_BAR; PG8_WAIT_L(0); PG8_MMA(0, 1, At, B1); PG8_BAR;
            PG8_LDA(At, 0, 1); PG8_STAGE(PG8_SA(0, 0), a2, voffA);
            PG8_BAR; PG8_WAIT_L(0); PG8_MMA(1, 0, At, B0); PG8_BAR; PG8_SCHED;
            PG8_STAGE(PG8_SB(0, 1), b2 + hstep, voffB);
            PG8_WAIT_V(6); PG8_BAR; PG8_MMA(1, 1, At, B1); PG8_BAR;
            PG8_LDB(B0, 1, 0); PG8_SCHED; PG8_LDA(At, 1, 0); PG8_STAGE(PG8_SA(0, 1), a2 + hstep, voffA);
            PG8_WAIT_L(8); PG8_BAR; PG8_WAIT_L(0); PG8_MMA(0, 0, At, B0); PG8_BAR; PG8_SCHED;
            PG8_LDB(B1, 1, 1); PG8_STAGE(PG8_SB(1, 0), b3, voffB);
            PG8_BAR; PG8_WAIT_L(0); PG8_MMA(0, 1, At, B1); PG8_BAR;
            PG8_LDA(At, 1, 1); PG8_STAGE(PG8_SA(1, 0), a3, voffA);
            PG8_BAR; PG8_WAIT_L(0); PG8_MMA(1, 0, At, B0); PG8_BAR; PG8_SCHED;
            PG8_STAGE(PG8_SB(1, 1), b3 + hstep, voffB);
            PG8_WAIT_V(6); PG8_BAR; PG8_MMA(1, 1, At, B1); PG8_BAR;
            }
        }
        if constexpr (ALIGN_EPI) { if (wr == 0) PG8_BAR; }
        if constexpr (QM != 0) asm volatile("s_nop 15\n\ts_nop 7" ::: "memory");
        if constexpr (!Epi::AFTER_DRAIN) { E(acc, cur, wr, wc, fr, fq, ui, has_next, nxt);
#if defined(PROBE_DUP) && PROBE_DUP == 61
            E(acc, cur, wr, wc, fr, fq, ui, has_next, nxt);
#endif
            S.done(cur); }
        if (!has_next) break;
        cur = nxt; cA = nA; cB = nB; ++ui;
        if constexpr (ALIGN_EPI) { if (wr == 1) PG8_BAR; }
    }
    PG8_WAIT_V(0);
    if constexpr (!ALIGN_EPI) { if (wr == 0) PG8_BAR; }
    PG8_BAR;
    if constexpr (Epi::AFTER_DRAIN) { E.fused(acc, cur, wr, wc, fr, fq, lds, wid, lane); S.done(cur); }
#undef PG8_SA
#undef PG8_PF
#undef PG8_WAIT_V8
#undef PG8_SB
#undef PG8_STAGE
#undef PG8_LDA
#undef PG8_LDF
#undef PG8_LDB
#undef PG8_MMA
#undef PG8_WAIT_V
#undef PG8_WAIT_L
#undef PG8_BAR
#undef PG8_SCHED
}
}
#include <hip/hip_bf16.h>
#include <cmath>
namespace attn_body {
using bf16=__hip_bfloat16;
using bf16x8=__attribute__((ext_vector_type(8)))short;
using s16x4=__attribute__((ext_vector_type(4)))short;
using f32x16=__attribute__((ext_vector_type(16)))float;
using u32x4=__attribute__((ext_vector_type(4)))unsigned;
constexpr int BATCH=16,NHEAD=8,SEQ=2048,D=64;
constexpr int QP=512,KP=128,OP=1024,OOFF=512;
constexpr int NW=8,QBLK=32,QB=QBLK*NW,KVBLK=64,NQB=SEQ/QB;
constexpr int ATTN_UNIT_ROWS=QB;
__device__ __forceinline__ int crow(int r,int hi){return (r&3)+8*(r>>2)+4*hi;}
#define SBAR() __builtin_amdgcn_sched_barrier(0)
#define MSKV(v,W,r) __uint_as_float(__float_as_uint(v)&(unsigned)(((int)((W)<<(31-(((r)&3)+8*((r)>>2)))))>>31))
__device__ __forceinline__ void cmask(f32x16&p0,f32x16&p1,int jb,int qrel,int hi){
  const float NEG=-INFINITY; int kb=64*jb+4*hi;
  #pragma unroll
  for(int r=0;r<16;++r){int kv=kb+(r&3)+8*(r>>2); if(kv>qrel)p0[r]=NEG; if(kv+32>qrel)p1[r]=NEG;}
}

constexpr int NSLOT=3, SLOTB=8192;
constexpr int LDS_K=0, LDS_V=NSLOT*SLOTB, LDS_WS=2*NSLOT*SLOTB, LDS_OST=LDS_WS+NW*64*4, LDS_MSK=LDS_OST+NW*4096, LDS_BYTES=LDS_MSK+NW*8192;
constexpr float C2=0.125f*1.4426950408889634f;
__device__ __forceinline__ void glds16(const void*gsrc,unsigned lds_dst){unsigned keep;
  asm volatile("s_mov_b32 %0, m0\n\ts_mov_b32 m0, %2\n\ts_nop 0\n\tglobal_load_lds_dwordx4 %1, off\n\ts_mov_b32 m0, %0":"=&s"(keep):"v"(gsrc),"s"(lds_dst):"memory");}
__device__ __forceinline__ float max3f(float a,float b,float c){float r;asm("v_max3_f32 %0, %1, %2, %3":"=v"(r):"v"(a),"v"(b),"v"(c));return r;}
__device__ __forceinline__ float max2f(float a,float b){float r;asm("v_max_f32_e32 %0, %1, %2":"=v"(r):"v"(a),"v"(b));return r;}
__device__ __forceinline__ float fadd_s(float a,float b){float r;asm("v_add_f32_e32 %0, %1, %2":"=v"(r):"v"(a),"v"(b));return r;}
__device__ __forceinline__ float fsub_s(float a,float b){float r;asm("v_sub_f32_e32 %0, %1, %2":"=v"(r):"v"(a),"v"(b));return r;}
typedef float f32x2_t __attribute__((ext_vector_type(2))); typedef __bf16 bf16x2_t __attribute__((ext_vector_type(2)));
__device__ __forceinline__ unsigned cvtpk_s(float lo,float hi){f32x2_t v={lo,hi};bf16x2_t b=__builtin_convertvector(v,bf16x2_t);return __builtin_bit_cast(unsigned,b);}
#define WAIT_BAR(N) asm volatile("s_waitcnt vmcnt(" #N ") lgkmcnt(0)\n\ts_barrier":::"memory")

__device__ __forceinline__ void qkt(f32x16&p0,f32x16&p1,const char*Kslot,const bf16x8*qr,const f32x16&negm,int r32,int hi){
  const char*kb=Kslot+hi*1024+r32*16;
  #pragma unroll
  for(int d0=0;d0<4;++d0){
    const bf16x8 b0=*reinterpret_cast<const bf16x8*>(kb+d0*2048);
    const bf16x8 b1=*reinterpret_cast<const bf16x8*>(kb+d0*2048+512);
    if(d0==0){p0=__builtin_amdgcn_mfma_f32_32x32x16_bf16(b0,qr[0],negm,0,0,0);p1=__builtin_amdgcn_mfma_f32_32x32x16_bf16(b1,qr[0],negm,0,0,0);}
    else{p0=__builtin_amdgcn_mfma_f32_32x32x16_bf16(b0,qr[d0],p0,0,0,0);p1=__builtin_amdgcn_mfma_f32_32x32x16_bf16(b1,qr[d0],p1,0,0,0);}}
}
typedef __attribute__((address_space(3))) const char* lds_cptr;
typedef short v4i16_t __attribute__((ext_vector_type(4)));
__device__ __forceinline__ void kload8(bf16x8*kf,lds_cptr kp){
  kf[0]=*(const __attribute__((address_space(3))) bf16x8*)(kp);      kf[1]=*(const __attribute__((address_space(3))) bf16x8*)(kp+512);
  kf[2]=*(const __attribute__((address_space(3))) bf16x8*)(kp+2048); kf[3]=*(const __attribute__((address_space(3))) bf16x8*)(kp+2560);
  kf[4]=*(const __attribute__((address_space(3))) bf16x8*)(kp+4096); kf[5]=*(const __attribute__((address_space(3))) bf16x8*)(kp+4608);
  kf[6]=*(const __attribute__((address_space(3))) bf16x8*)(kp+6144); kf[7]=*(const __attribute__((address_space(3))) bf16x8*)(kp+6656);
}
__device__ __forceinline__ void kload2(bf16x8*kf,lds_cptr kp,int j){ kf[2*j]=*(const __attribute__((address_space(3))) bf16x8*)(kp+j*2048); kf[2*j+1]=*(const __attribute__((address_space(3))) bf16x8*)(kp+j*2048+512); }
__device__ __forceinline__ s16x4 vtr(lds_cptr p){ return __builtin_bit_cast(s16x4,__builtin_amdgcn_ds_read_tr16_b64_v4i16((__attribute__((address_space(3))) v4i16_t*)p)); }
__device__ __forceinline__ float rowmax(const f32x16&p0,const f32x16&p1){
  float a=max3f(p0[0],p0[1],p1[0]),b=max3f(p0[2],p0[3],p1[1]);a=max3f(a,p1[2],p1[3]);
  #pragma unroll
  for(int r=4;r<16;r+=4){a=max3f(a,p0[r],p0[r+1]);b=max3f(b,p0[r+2],p0[r+3]);a=max3f(a,p1[r],p1[r+1]);b=max3f(b,p1[r+2],p1[r+3]);}
  const float m=max2f(a,b);
  auto rr=__builtin_amdgcn_permlane32_swap(__float_as_uint(m),__float_as_uint(m),false,false);
  return max2f(__uint_as_float(rr[0]),__uint_as_float(rr[1]));
}
__device__ __forceinline__ void pv(f32x16*o,int vb,bf16x8 pa0,bf16x8 pa1,bf16x8 pa2,bf16x8 pa3){
  #pragma unroll
  for(int d0=0;d0<2;++d0){s16x4 lo[4],hi[4];
    #pragma unroll
    for(int ks=0;ks<4;++ks){
      asm volatile("ds_read_b64_tr_b16 %0,%1 offset:%c2":"=&v"(lo[ks]):"v"(vb),"i"(d0*4096+ks*1024):"memory");
      asm volatile("ds_read_b64_tr_b16 %0,%1 offset:%c2":"=&v"(hi[ks]):"v"(vb),"i"(d0*4096+ks*1024+512):"memory");}
    asm volatile("s_waitcnt lgkmcnt(0)":::"memory");SBAR();
    #define PK(k) (bf16x8){lo[k][0],lo[k][1],lo[k][2],lo[k][3],hi[k][0],hi[k][1],hi[k][2],hi[k][3]}
    o[d0]=__builtin_amdgcn_mfma_f32_32x32x16_bf16(pa0,PK(0),o[d0],0,0,0);
    o[d0]=__builtin_amdgcn_mfma_f32_32x32x16_bf16(pa1,PK(1),o[d0],0,0,0);
    o[d0]=__builtin_amdgcn_mfma_f32_32x32x16_bf16(pa2,PK(2),o[d0],0,0,0);
    o[d0]=__builtin_amdgcn_mfma_f32_32x32x16_bf16(pa3,PK(3),o[d0],0,0,0);
    #undef PK
  }
}

#ifndef ATTN_STORE16
#define ATTN_STORE16(p,v) (*(u32x4*)(p)=(v))
#endif
template<int THRL> __device__ __forceinline__ void attn_unit(int b,int h,int qb,const bf16*Q,const bf16*K,const bf16*V,const unsigned long long*MK,bf16*O,char*shm){
  const int tid=threadIdx.x,lane=tid&63,r32=lane&31,hi=lane>>5; const int wid=__builtin_amdgcn_readfirstlane(tid>>6);
  const long rowbase=(long)b*SEQ; const int q0=qb*QB;
  const bf16*Qw=Q+(rowbase+q0+wid*QBLK)*QP+h*D;
  const bf16*Kh=K+rowbase*KP+(h>>2)*D,*Vh=V+rowbase*KP+(h>>2)*D;
  const unsigned lds0=(unsigned)(uintptr_t)shm;
  float*wsf=(float*)(shm+LDS_WS)+wid*64;
  const bf16*ksrc=Kh+(long)lane*KP+wid*8;
  const bf16*vsrc=Vh+(long)(16*(wid&3)+(lane>>2))*KP+(wid>>2)*32+(lane&3)*8;
  const unsigned kdst=lds0+LDS_K+wid*1024, vdst=lds0+LDS_V+wid*1024;
  #define DMA_K(t,slot) glds16(ksrc+(long)(t)*KVBLK*KP,(unsigned)__builtin_amdgcn_readfirstlane(kdst+(slot)))
  #define DMA_V(t,slot) glds16(vsrc+(long)(t)*KVBLK*KP,(unsigned)__builtin_amdgcn_readfirstlane(vdst+(slot)))
  const int vb0=(int)(lds0+LDS_V)+((lane>>4)&1)*32+(lane&3)*8+(4*hi+((lane&15)>>2))*64;
  const char*Kbase=shm+LDS_K; bf16x8 kf[8];
  const lds_cptr shm3=(lds_cptr)shm; const lds_cptr kp0=shm3+LDS_K+hi*1024+r32*16; const lds_cptr vp0=shm3+LDS_V+((lane>>4)&1)*32+(lane&3)*8+(4*hi+((lane&15)>>2))*64;
  const int NT=(q0+QB)/KVBLK;
  const __attribute__((address_space(3))) char* shm3m=(const __attribute__((address_space(3))) char*)shm;
  typedef __attribute__((address_space(3))) unsigned long long* lds_u64p;
  const lds_u64p mskw=(lds_u64p)(shm3m+LDS_MSK+wid*8192);
  unsigned long long mtmp[16];
  { const unsigned long long*mq=MK+(q0+wid*QBLK+r32);
    #pragma unroll
    for(int i=0;i<16;++i){int tt=2*i+hi; tt=tt<NT?tt:NT-1; mtmp[i]=mq[(long)tt*SEQ];} }
  DMA_K(0,0);DMA_V(0,0);DMA_K(1,SLOTB);
  bf16x8 qr[4];
  #pragma unroll
  for(int d0=0;d0<4;++d0)qr[d0]=*reinterpret_cast<const bf16x8*>(&Qw[(long)r32*QP+d0*16+hi*8]);
  float mhat=0.f,l_reg=0.f;f32x16 o[2];o[0]=f32x16{};o[1]=f32x16{};f32x16 negm=f32x16{};asm volatile("":"+v"(negm));
  const int qrel=wid*QBLK+r32;
  #define CMASK(P0,P1,t) do{int jb_=(t)-(NT-4); if(jb_>=0)cmask(P0,P1,jb_,qrel,hi);}while(0)
  bool resc=false;
  #define START(P0,P1) do{ const float rm=rowmax(P0,P1); resc=false; \
    { const float dl=rm; mhat=fadd_s(mhat,dl); \
      _Pragma("unroll") for(int r=0;r<16;++r){P0[r]=fsub_s(P0[r],dl);P1[r]=fsub_s(P1[r],dl);} \
      _Pragma("unroll") for(int r=0;r<16;++r)negm[r]=-mhat; asm volatile("":"+v"(negm)); } \
    _Pragma("unroll") for(int r=0;r<16;++r)P0[r]=__builtin_amdgcn_exp2f(P0[r]); }while(0)
  #define RESC() do{ if(resc){ asm volatile("s_waitcnt lgkmcnt(0)":::"memory"); \
      _Pragma("unroll") for(int d_=0;d_<2;++d_) _Pragma("unroll") for(int r=0;r<16;++r)o[d_][r]*=wsf[crow(r,hi)]; } }while(0)
  f32x16 pA0,pA1,pB0,pB1;
  int sl_prev=0,sl_cur=0,sl_next=SLOTB;
  #define ROT() do{sl_prev=sl_cur;sl_cur=sl_next;sl_next=(sl_next==(NSLOT-1)*SLOTB)?0:sl_next+SLOTB;}while(0)
  DMA_K(2,2*SLOTB);
  WAIT_BAR(3);
  #pragma unroll
  for(int i=0;i<16;++i)mskw[(2*i+hi)*32+r32]=mtmp[i];
  #define MLOAD(t,LO,HI) do{ const unsigned long long mw_=mskw[(t)*32+r32]; LO=((unsigned)mw_)>>(4*hi); HI=((unsigned)(mw_>>32))>>(4*hi); }while(0)
  unsigned mlo,mhi; MLOAD(0,mlo,mhi);
  qkt(pA0,pA1,Kbase,qr,negm,r32,hi);asm volatile("s_nop 15\n\ts_nop 7":"+v"(pA0),"+v"(pA1));
  START(pA0,pA1);
  _Pragma("unroll") for(int r=0;r<16;++r)pA1[r]=__builtin_amdgcn_exp2f(pA1[r]);
  _Pragma("unroll") for(int r=0;r<16;++r){pA0[r]=MSKV(pA0[r],mlo,r);pA1[r]=MSKV(pA1[r],mhi,r);}
  WAIT_BAR(0);
  DMA_K(3,0);DMA_V(1,SLOTB);
  ROT();
  kload8(kf,kp0+sl_cur);
  WAIT_BAR(2);
  s16x4 vlo[8],vhi[8]; u32x4 pw0,pw1,pw2,pw3;
  #define PKW(P,B) cvtpk_s(P[B],P[B+1])
  #define PAF(k) __builtin_bit_cast(bf16x8,pw##k)
  #define VFR(i) (bf16x8){vlo[i][0],vlo[i][1],vlo[i][2],vlo[i][3],vhi[i][0],vhi[i][1],vhi[i][2],vhi[i][3]}
  #define PIN(x) asm volatile("":"+v"(x))
  #define MX3(a,b,c) __builtin_fmaxf(__builtin_fmaxf((a),(b)),(c))
  #define GAPA(MF,A0,A1,A2,A3,W0,W1,PW) do{ MF; sacc+=A0; sacc+=A1; sacc+=A2; sacc+=A3; PIN(sacc); W0; W1; PIN(PW); SBAR(); }while(0)
  #define EX(v) __builtin_amdgcn_exp2f(v)
  #define GAPB(MF,X,B,W) do{ MF; X[B]=MSKV(EX(X[B]),W,B); X[B+1]=MSKV(EX(X[B+1]),W,B+1); X[B+2]=MSKV(EX(X[B+2]),W,B+2); X[B+3]=MSKV(EX(X[B+3]),W,B+3); PIN(X); SBAR(); }while(0)
  #define VRD(i) do{ vlo[i]=vtr(vp_+(((i)>>2)*4096+((i)&3)*1024)); vhi[i]=vtr(vp_+(((i)>>2)*4096+((i)&3)*1024+512)); }while(0)
  #define KRD(G,j) do{ if(G){ kload2(kf,kp0+sl_next,j); SBAR(); } }while(0)
  #define STEP(C0,C1,P0,P1,t,GK,GV,GL) do{ SBAR(); \
    const lds_cptr vp_=vp0+sl_prev; MLOAD(t,mlo,mhi); \
    VRD(0); SBAR(); float sacc=(P0[0]+P0[1]); \
    GAPA(C0=__builtin_amdgcn_mfma_f32_32x32x16_bf16(kf[0],qr[0],negm,0,0,0), P0[2],P0[3],P0[4],P0[5],     pw0[0]=PKW(P0,0), pw0[1]=PKW(P0,2), pw0); \
    VRD(4); SBAR(); GAPA(C1=__builtin_amdgcn_mfma_f32_32x32x16_bf16(kf[1],qr[0],negm,0,0,0), P0[6],P0[7],P0[8],P0[9],     pw0[2]=PKW(P0,4), pw0[3]=PKW(P0,6), pw0); \
    VRD(1); SBAR(); GAPA(C0=__builtin_amdgcn_mfma_f32_32x32x16_bf16(kf[2],qr[1],C0,0,0,0),   P0[10],P0[11],P0[12],P0[13], pw1[0]=PKW(P0,8), pw1[1]=PKW(P0,10), pw1); \
    VRD(5); SBAR(); GAPA(C1=__builtin_amdgcn_mfma_f32_32x32x16_bf16(kf[3],qr[1],C1,0,0,0),   P0[14],P0[15],P1[0],P1[1],   pw1[2]=PKW(P0,12),pw1[3]=PKW(P0,14), pw1); \
    VRD(2); SBAR(); GAPA(C0=__builtin_amdgcn_mfma_f32_32x32x16_bf16(kf[4],qr[2],C0,0,0,0),   P1[2],P1[3],P1[4],P1[5],     pw2[0]=PKW(P1,0), pw2[1]=PKW(P1,2), pw2); \
    VRD(6); SBAR(); GAPA(C1=__builtin_amdgcn_mfma_f32_32x32x16_bf16(kf[5],qr[2],C1,0,0,0),   P1[6],P1[7],P1[8],P1[9],     pw2[2]=PKW(P1,4), pw2[3]=PKW(P1,6), pw2); \
    VRD(3); SBAR(); GAPA(C0=__builtin_amdgcn_mfma_f32_32x32x16_bf16(kf[6],qr[3],C0,0,0,0),   P1[10],P1[11],P1[12],P1[13], pw3[0]=PKW(P1,8), pw3[1]=PKW(P1,10), pw3); \
    VRD(7); SBAR(); GAPA(C1=__builtin_amdgcn_mfma_f32_32x32x16_bf16(kf[7],qr[3],C1,0,0,0),   P1[14],P1[15],0.f,0.f,       pw3[2]=PKW(P1,12),pw3[3]=PKW(P1,14), pw3); \
    l_reg+=sacc; \
    if(GK){DMA_K((t)+3,sl_cur);} if(GV){DMA_V((t)+1,sl_next);} \
    { float a=MX3(C0[0],C0[1],C1[0]),b=MX3(C0[2],C0[3],C1[1]); a=MX3(a,C1[2],C1[3]); \
      _Pragma("unroll") for(int r=4;r<16;r+=4){a=MX3(a,C0[r],C0[r+1]);b=MX3(b,C0[r+2],C0[r+3]);a=MX3(a,C1[r],C1[r+1]);b=MX3(b,C1[r+2],C1[r+3]);} \
      float rm=__builtin_fmaxf(a,b); { auto rr=__builtin_amdgcn_permlane32_swap(__float_as_uint(rm),__float_as_uint(rm),false,false); rm=__builtin_fmaxf(__uint_as_float(rr[0]),__uint_as_float(rr[1])); } \
      resc=false; \
      if(__builtin_expect(__any(rm>(float)THRL),0)){ const float dl=__builtin_fmaxf(rm,0.f); mhat+=dl; \
        _Pragma("unroll") for(int r=0;r<16;++r){C0[r]-=dl;C1[r]-=dl;} \
        _Pragma("unroll") for(int r=0;r<16;++r)negm[r]=-mhat; asm volatile("":"+v"(negm)); \
        const float f=__builtin_amdgcn_exp2f(-dl); l_reg*=f; if(hi==0)wsf[r32]=f; resc=true; } } \
    SBAR(); \
    GAPB(o[0]=__builtin_amdgcn_mfma_f32_32x32x16_bf16(PAF(0),VFR(0),o[0],0,0,0), C0,0,mlo); \
    GAPB(o[1]=__builtin_amdgcn_mfma_f32_32x32x16_bf16(PAF(0),VFR(4),o[1],0,0,0), C0,4,mlo); \
    KRD(GL,0); GAPB(o[0]=__builtin_amdgcn_mfma_f32_32x32x16_bf16(PAF(1),VFR(1),o[0],0,0,0), C0,8,mlo); \
    KRD(GL,1); GAPB(o[1]=__builtin_amdgcn_mfma_f32_32x32x16_bf16(PAF(1),VFR(5),o[1],0,0,0), C0,12,mlo); \
    KRD(GL,2); GAPB(o[0]=__builtin_amdgcn_mfma_f32_32x32x16_bf16(PAF(2),VFR(2),o[0],0,0,0), C1,0,mhi); \
    KRD(GL,3); GAPB(o[1]=__builtin_amdgcn_mfma_f32_32x32x16_bf16(PAF(2),VFR(6),o[1],0,0,0), C1,4,mhi); \
    GAPB(o[0]=__builtin_amdgcn_mfma_f32_32x32x16_bf16(PAF(3),VFR(3),o[0],0,0,0), C1,8,mhi); \
    GAPB(o[1]=__builtin_amdgcn_mfma_f32_32x32x16_bf16(PAF(3),VFR(7),o[1],0,0,0), C1,12,mhi); \
    }while(0)
  int t=1;
  #undef CMASK
  #define CMASK(P0,P1,t) do{}while(0)
  for(;t+5<NT;t+=2){
    STEP(pB0,pB1,pA0,pA1,t,true,true,true);     WAIT_BAR(2); RESC(); ROT();
    STEP(pA0,pA1,pB0,pB1,t+1,true,true,true);   WAIT_BAR(2); RESC(); ROT();
  }
  #undef CMASK
  #define CMASK(P0,P1,t) do{int jb_=(t)-(NT-4); if(jb_>=0)cmask(P0,P1,jb_,qrel,hi);}while(0)
  #define ENDW(tt) do{ if((tt)+3<NT){WAIT_BAR(2);} else if((tt)+2<NT){WAIT_BAR(1);} else {WAIT_BAR(0);} }while(0)
  for(;t+1<NT;t+=2){
    STEP(pB0,pB1,pA0,pA1,t,(t+3<NT),(t+1<NT),(t+1<NT));       ENDW(t);   RESC(); ROT();
    STEP(pA0,pA1,pB0,pB1,t+1,(t+4<NT),(t+2<NT),(t+2<NT));     ENDW(t+1); RESC(); ROT();
  }
  STEP(pB0,pB1,pA0,pA1,NT-1,false,false,false); RESC();
  { float sacc=pB0[0]+pB0[1]; _Pragma("unroll") for(int r=2;r<16;++r)sacc+=pB0[r]; _Pragma("unroll") for(int r=0;r<16;++r)sacc+=pB1[r]; l_reg+=sacc;
    pw0=(u32x4){PKW(pB0,0),PKW(pB0,2),PKW(pB0,4),PKW(pB0,6)};pw1=(u32x4){PKW(pB0,8),PKW(pB0,10),PKW(pB0,12),PKW(pB0,14)};pw2=(u32x4){PKW(pB1,0),PKW(pB1,2),PKW(pB1,4),PKW(pB1,6)};pw3=(u32x4){PKW(pB1,8),PKW(pB1,10),PKW(pB1,12),PKW(pB1,14)};
    SBAR(); pv(o,vb0+sl_cur,PAF(0),PAF(1),PAF(2),PAF(3)); }
  #undef PKW
  #undef PAF
  #undef VFR
  #undef PIN
  #undef MX3
  #undef GAPA
  #undef GAPB
  #undef EX
  #undef VRD
  #undef KRD
  #undef STEP
  #undef ENDW
  {auto rr=__builtin_amdgcn_permlane32_swap(__float_as_uint(l_reg),__float_as_uint(l_reg),false,false);l_reg=__uint_as_float(rr[0])+__uint_as_float(rr[1]);}
  if(hi==0)wsf[32+r32]=l_reg;asm volatile("s_waitcnt lgkmcnt(0)":::"memory");
  float rli[16];
  #pragma unroll
  for(int r=0;r<16;++r)rli[r]=__builtin_amdgcn_rcpf(wsf[32+crow(r,hi)]);
  bf16*Ow=O+(rowbase+q0+wid*QBLK)*OP+OOFF+h*D;
  { bf16*stg=(bf16*)(shm+LDS_OST)+wid*2048;
    #pragma unroll
    for(int r=0;r<16;++r){const int orow=crow(r,hi);
      #pragma unroll
      for(int d0=0;d0<2;++d0)stg[orow*64+d0*32+r32]=__float2bfloat16(o[d0][r]*rli[r]);}
    asm volatile("s_waitcnt lgkmcnt(0)":::"memory");
    #pragma unroll
    for(int i=0;i<4;++i){const int row=i*8+(lane>>3),ch=lane&7; const u32x4 v=*(const u32x4*)(stg+row*64+ch*8); ATTN_STORE16(Ow+(long)row*OP+ch*8,v);} }
  asm volatile("s_waitcnt lgkmcnt(0)\n\ts_barrier":::"memory");
  #undef DMA_K
  #undef DMA_V
  #undef CMASK
  #undef START
  #undef RESC
  #undef ROT
}
constexpr int ATTN_LDS_BYTES=LDS_BYTES;
struct AttnTensors { const bf16* Q; const bf16* K; const bf16* V; const unsigned long long* MK; bf16* O; };
struct AttnUnit { int bh; int qb; };
struct StaticOrder {
  int vcu;
  __device__ __forceinline__ explicit StaticOrder(int vcu_):vcu(vcu_){}
  __device__ __forceinline__ bool next(int i,AttnUnit&u)const{ if(vcu>=256)return false; const int s=vcu&1; u.bh=vcu>>1; if(s){ if(i>=5)return false; u.qb=5-i; } else { if(i>=3)return false; u.qb=(i==0)?7:(i==1)?6:0; } return true; }
};
template<class Sched,int THRL=8> __device__ __forceinline__ void attn_phase(char*lds,const AttnTensors&T,const Sched&S){
  AttnUnit u;
  for(int i=0;S.next(i,u);++i){ const int b=u.bh/NHEAD; attn_unit<THRL>(b,u.bh%NHEAD,u.qb,T.Q,T.K,T.V,T.MK+(long)b*32*SEQ,T.O,lds); }
}
#undef SBAR
#undef WAIT_BAR
}
#ifndef PROBE_DUP
#define PROBE_DUP (-1)
#endif
constexpr int D = 1024, NB = 16, SEQ = 2048, MP = NB * SEQ, DB = 32, DS = 4, MS = DB * DS, MTOT = MP + MS, MPAD = 33024;
constexpr int DFF = 2816, NIN = 2888, NINP = 3072, DCONV = 512;
constexpr int PAST = 16384, PAGE = 128, NPAGES = 128, KTOP = 256;
constexpr float EPS = 1e-6f, LOG2E = 1.4426950408889634f;
constexpr float QSCALE = 0.125f * LOG2E;
constexpr size_t O_YP = 0, O_YS = O_YP + (size_t)MP * D, O_KP = O_YS + (size_t)MS * D, O_VP = O_KP + (size_t)MP * 128, O_IP = O_VP + (size_t)MP * 128,
                 O_CP = O_IP + (size_t)MP * 64, O_KS = O_CP + 16 * 2 * 512, O_VS = O_KS + MS * 128, O_IS = O_VS + MS * 128, O_CS = O_IS + MS * 64, O_END = O_CS + 32 * 2 * 512;
static_assert(O_END == 44261376, "output size");

constexpr size_t al(size_t x) { return (x + 0xFFFFF) & ~(size_t)0xFFFFF; }
constexpr size_t WS_CTL = 0, CTL_ZERO_BYTES = 1u << 20;
constexpr size_t WS_ROPE = al(WS_CTL + CTL_ZERO_BYTES);
constexpr size_t WS_WGU1 = al(WS_ROPE + 2052 * 8 * 2 * 4);
constexpr size_t WS_WD1 = al(WS_WGU1 + (size_t)2 * DFF * D * 2);
constexpr size_t WS_WIN = al(WS_WD1 + (size_t)D * DFF * 2);
constexpr size_t WS_WOUT = al(WS_WIN + (size_t)NINP * D * 2);
constexpr size_t WS_WGU2 = al(WS_WOUT + (size_t)D * D * 2);
constexpr size_t WS_WD2 = al(WS_WGU2 + (size_t)2 * DFF * D * 2);
constexpr size_t WS_XB = al(WS_WD2 + (size_t)D * DFF * 2);
constexpr size_t WS_SS0 = al(WS_XB + (size_t)MPAD * D * 2);
constexpr size_t WS_SS1 = al(WS_SS0 + (size_t)MPAD * 4);
constexpr size_t WS_SS2 = al(WS_SS1 + (size_t)MPAD * 64);
constexpr size_t WS_H = al(WS_SS2 + (size_t)MPAD * 64);
constexpr size_t WS_X1 = al(WS_H + (size_t)MPAD * DFF * 2);
constexpr size_t WS_X1B = al(WS_X1 + (size_t)MPAD * D * 4);
constexpr size_t WS_X2 = al(WS_X1B + (size_t)MPAD * D * 2);
constexpr size_t WS_X2B = al(WS_X2 + (size_t)MPAD * D * 4);
constexpr size_t WS_U = al(WS_X2B + (size_t)MPAD * D * 2);
constexpr size_t WS_GB = al(WS_U + (size_t)MPAD * 512 * 2);
constexpr size_t WS_Q = al(WS_GB + (size_t)MPAD * 512 * 2);
constexpr size_t WS_QI = al(WS_Q + (size_t)MPAD * 512 * 2);
constexpr size_t WS_KB = al(WS_QI + (size_t)MPAD * 512 * 2);
constexpr size_t WS_VB = al(WS_KB + (size_t)MPAD * 128 * 2);
constexpr size_t WS_KIB = al(WS_VB + (size_t)MPAD * 128 * 2);
constexpr size_t WS_WI = al(WS_KIB + (size_t)MPAD * 64 * 2);
constexpr size_t WS_CAT = al(WS_WI + (size_t)MPAD * 8 * 4);
constexpr size_t WS_MASK = al(WS_CAT + (size_t)MPAD * D * 2);
constexpr int SSTR = 16384;
constexpr size_t WS_SSC = al(WS_MASK + (size_t)NB * 32 * SEQ * 8);
constexpr size_t WS_XB8 = al(WS_SSC + (size_t)MS * SSTR * 4);
constexpr size_t WS_X2B8 = al(WS_XB8 + (size_t)MPAD * D);
constexpr size_t WS_WGU1_8 = al(WS_X2B8 + (size_t)MPAD * D);
constexpr size_t WS_WGU2_8 = al(WS_WGU1_8 + (size_t)2 * DFF * D);
constexpr size_t WS_WD2_8 = al(WS_WGU2_8 + (size_t)2 * DFF * D);
constexpr size_t WS_H8 = al(WS_WD2_8 + (size_t)D * DFF);
constexpr size_t WS_XI8 = al(WS_H8 + (size_t)MP * DFF);
constexpr size_t WS_XS = al(WS_XI8 + (size_t)MPAD * D);
constexpr size_t WS_WGU1I8 = al(WS_XS + (size_t)MPAD * 4);
constexpr size_t WS_WSN = al(WS_WGU1I8 + (size_t)2 * DFF * D);
constexpr size_t WS_X2I8 = al(WS_WSN + (size_t)2 * DFF * 4);
constexpr size_t WS_XS2 = al(WS_X2I8 + (size_t)MPAD * D);
constexpr size_t WS_WGU2I8 = al(WS_XS2 + (size_t)MPAD * 4);
constexpr size_t WS_WSN2 = al(WS_WGU2I8 + (size_t)2 * DFF * D);
constexpr size_t WS_WD1_8 = al(WS_WSN2 + (size_t)2 * DFF * 4);
constexpr size_t WS_END = al(WS_WD1_8 + (size_t)D * DFF);
constexpr float H8SCALE = 4.0f;
constexpr float W8SCALE = 32.0f;

constexpr int CW_TMO = 0, CW_CODE = 1, CW_BAR = 4096;

constexpr int RING_OFF = 0, RING_BYTES = 152576;
constexpr int LDSCTL_OFF = RING_BYTES, MISC_OFF = LDSCTL_OFF + 320;
constexpr int LDS_BYTES = 158720;
static_assert(MISC_OFF + 128 <= LDS_BYTES && attn_body::ATTN_LDS_BYTES <= RING_BYTES && pg8::STAGE_BYTES <= RING_BYTES, "LDS map");

#define GAS __attribute__((address_space(1)))
#define LAS __attribute__((address_space(3)))
typedef unsigned short bf16;
typedef unsigned v4u __attribute__((ext_vector_type(4)));
typedef unsigned v2u __attribute__((ext_vector_type(2)));
typedef float f32x4 __attribute__((ext_vector_type(4)));
typedef float f32x16 __attribute__((ext_vector_type(16)));
typedef short bf16x8 __attribute__((ext_vector_type(8)));
typedef GAS unsigned gu32;
#define RLX_AGENT __ATOMIC_RELAXED, __HIP_MEMORY_SCOPE_AGENT
#define LDS_WAIT() asm volatile("s_waitcnt lgkmcnt(0)" ::: "memory")
#define VM_WAIT() asm volatile("s_waitcnt vmcnt(0)" ::: "memory")
__device__ __forceinline__ unsigned f2bf(float f) { unsigned u = __builtin_bit_cast(unsigned, f); return (u + 0x7fffu + ((u >> 16) & 1u)) >> 16; }
__device__ __forceinline__ unsigned pk2(float lo, float hi) { return f2bf(lo) | (f2bf(hi) << 16); }
__device__ __forceinline__ float bf2f(unsigned short h) { return __builtin_bit_cast(float, (unsigned)h << 16); }
__device__ __forceinline__ float wave_sum(float v) {
#pragma unroll
    for (int o = 1; o < 64; o <<= 1) v += __shfl_xor(v, o);
    return v;
}
__device__ __forceinline__ float wave_max(float v) {
#pragma unroll
    for (int o = 1; o < 64; o <<= 1) v = fmaxf(v, __shfl_xor(v, o));
    return v;
}

#define XB_TMO      128
#define XB_XCNT(j)  (256  + 64 * (j))
#define XB_XSUB(j)  (1280 + 64 * (j))
#define XB_XGEN(j)  (2304 + 64 * (j))
#define XB_TOP      3328
#define XB_TOPGEN   3392
#define XCD_BAR_WORDS 3456
#define XB_SPIN_CAP (1u << 18)

__device__ __forceinline__ unsigned xb_ld(unsigned* p)              { return __hip_atomic_load(p, __ATOMIC_RELAXED, __HIP_MEMORY_SCOPE_AGENT); }
__device__ __forceinline__ unsigned xb_add(unsigned* p, unsigned v) { return __hip_atomic_fetch_add(p, v, __ATOMIC_RELAXED, __HIP_MEMORY_SCOPE_AGENT); }
__device__ __forceinline__ unsigned xb_xcc_id() { return (unsigned)__builtin_amdgcn_s_getreg((3 << 11) | 20) & 0xFu; }
#define XB_SPIN(cond, bar) do { unsigned _sp = 0; while (cond) { __builtin_amdgcn_s_sleep(1); \
    if ((++_sp & 255u) == 0u) { if (xb_ld(&(bar)[XB_TMO])) break; if (_sp > XB_SPIN_CAP) { atomicAdd(&(bar)[XB_TMO], 1u); break; } } } } while (0)

struct XcdBarrier {
    unsigned* bar; unsigned x;
    volatile LAS unsigned* st;
};

__device__ __forceinline__ XcdBarrier xcd_barrier_post(unsigned* bar, volatile LAS unsigned* st) {
    XcdBarrier b; b.bar = bar; b.x = xb_xcc_id(); b.st = st;
    if (threadIdx.x == 0) (void)xb_add(&bar[XB_XCNT(b.x)], 1u);
    return b;
}
__device__ __forceinline__ void xcd_barrier_complete(unsigned* bar, unsigned x, unsigned& nloc, unsigned& nx) {
    const unsigned G = gridDim.x * gridDim.y * gridDim.z;
    unsigned sum, cnt, mine, sp = 0u;
    for (;;) {
        sum = 0u; cnt = 0u; mine = 0u;
#pragma unroll
        for (unsigned j = 0; j < 16; ++j) { const unsigned c = xb_ld(&bar[XB_XCNT(j)]); sum += c; cnt += (c > 0u) ? 1u : 0u; mine = (j == x) ? c : mine; }
        if (sum == G) break;
        __builtin_amdgcn_s_sleep(1);
        if ((++sp & 255u) == 0u) { if (xb_ld(&bar[XB_TMO])) break; if (sp > XB_SPIN_CAP) { atomicAdd(&bar[XB_TMO], 1u); break; } }
    }
    nloc = mine > 0u ? mine : 1u; nx = cnt > 0u ? cnt : 1u;
}

__device__ __forceinline__ void xcd_barrier(const XcdBarrier& b) {
    asm volatile("s_waitcnt vmcnt(0)" ::: "memory");
    __syncthreads();
    if (threadIdx.x == 0) {
        unsigned* bar = b.bar;
        __builtin_amdgcn_s_waitcnt(0);
        unsigned nloc = b.st[0], nx = b.st[1];
        if (nloc == 0u) { xcd_barrier_complete(bar, b.x, nloc, nx); b.st[0] = nloc; b.st[1] = nx; }
        const unsigned old = xb_add(&bar[XB_XSUB(b.x)], 1u);
        const unsigned gen = old / nloc;
        if (old + 1u == (gen + 1u) * nloc) {
            __builtin_amdgcn_fence(__ATOMIC_RELEASE, "agent");
            asm volatile("s_waitcnt vmcnt(0)" ::: "memory");
            const unsigned og = xb_add(&bar[XB_TOP], 1u);
            const unsigned tg = og / nx;
            if (og + 1u == (tg + 1u) * nx) xb_add(&bar[XB_TOPGEN], 1u);
            else XB_SPIN(xb_ld(&bar[XB_TOPGEN]) == tg, bar);
            __builtin_amdgcn_fence(__ATOMIC_ACQUIRE, "agent");
            xb_add(&bar[XB_XGEN(b.x)], 1u);
            asm volatile("s_waitcnt vmcnt(0)" ::: "memory");
        } else {
            XB_SPIN(xb_ld(&bar[XB_TOPGEN]) == gen, bar);
            __builtin_amdgcn_fence(__ATOMIC_ACQUIRE, "agent");
            asm volatile("s_waitcnt vmcnt(0)" ::: "memory");
        }
    }
    __syncthreads();
}
__host__ __device__ __forceinline__ int r32map(int P) { return 16 * ((P >> 2) & 1) + 4 * (P >> 3) + (P & 3); }
__host__ __device__ __forceinline__ int p128(int x) { return (x & ~31) + r32map(x & 31); }
__host__ __device__ __forceinline__ int hdmap(int d) { if (d >= 16) return d; const int fq = (d >> 2) & 1, j = (d & 3) + 4 * (d >> 3); return 8 * fq + j; }
__host__ __device__ __forceinline__ int head_row(int wc, int d) { const int x = hdmap(d); return 128 * (x >> 5) + 32 * wc + r32map(x & 31); }
__device__ __forceinline__ int dstart(int bj, int fq, int half) { return (bj == 0 && fq < 2) ? 4 * fq + 8 * half : 32 * bj + 8 * fq + 4 * half; }

struct MapGate { __device__ __forceinline__ int operator()(int c) const { return 256 * (c >> 7) + p128(c & 127); } };
struct MapUp   { __device__ __forceinline__ int operator()(int c) const { return 256 * (c >> 7) + 128 + p128(c & 127); } };
struct MapLin  { __device__ __forceinline__ int operator()(int c) const { return (c & ~127) + p128(c & 127); } };
struct MapWin  { __device__ __forceinline__ int operator()(int c) const {
    if (c < 512) return 1024 + (c & ~127) + p128(c & 127);
    if (c < 1024) { const int ch = c - 512; return 256 * (ch >> 7) + p128(ch & 127); }
    if (c < 1536) { const int ch = c - 1024; return 256 * (ch >> 7) + 128 + p128(ch & 127); }
    if (c < 2048) { const int x = c - 1536, hd = x >> 6; return 256 * (6 + (hd >> 2)) + head_row(hd & 3, x & 63); }
    if (c < 2176) { const int x = c - 2048; return 256 * 8 + head_row(x >> 6, x & 63); }
    if (c < 2304) { const int x = c - 2176; return 256 * 8 + head_row(2 + (x >> 6), x & 63); }
    if (c < 2816) { const int x = c - 2304, hd = x >> 6; return 256 * (9 + (hd >> 2)) + head_row(hd & 3, x & 63); }
    if (c < 2880) return 256 * 11 + head_row(0, c - 2816);
    return 256 * 11 + 32 + r32map(c - 2880);
} };

using pg8::Unit; using pg8::bf16_t;
__device__ __forceinline__ float rstd_from(const float* ss, int row, int nslot) {
    float s = 0.f;
    if (nslot == 1) s = ss[row];
    else { const f32x4* p = (const f32x4*)(ss + (size_t)row * 16); const f32x4 a = p[0], b = p[1], c = p[2], d = p[3]; s = ((a.x + a.y) + (a.z + a.w)) + ((b.x + b.y) + (b.z + b.w)) + ((c.x + c.y) + (c.z + c.w)) + ((d.x + d.y) + (d.z + d.w)); }
    return __builtin_amdgcn_rsqf(s * (1.0f / D) + EPS);
}
__device__ __forceinline__ float clamp8(float x) { return __builtin_amdgcn_fmed3f(x, -440.0f, 440.0f); }
__device__ __forceinline__ unsigned pk4_fp8(float a, float b, float c, float d) { int w = __builtin_amdgcn_cvt_pk_fp8_f32(clamp8(a), clamp8(b), 0, false); w = __builtin_amdgcn_cvt_pk_fp8_f32(clamp8(c), clamp8(d), w, true); return (unsigned)w; }
#define EPI_CALL_ROWS() \
    __device__ __forceinline__ void operator()(f32x4 (&acc)[2][2][4][2], const Unit& u, int wr, int wc, int fr, int fq, int ui, bool has_next, const Unit& nxt) const { \
        _Pragma("unroll") for (int ai = 0; ai < 2; ++ai) _Pragma("unroll") for (int m = 0; m < 4; ++m) { \
            const f32x4 v[2][2] = {{acc[ai][0][m][0], acc[ai][0][m][1]}, {acc[ai][1][m][0], acc[ai][1][m][1]}}; \
            row(v, u.pm * 256 + ai * 128 + wr * 64 + m * 16 + fr, u.pn, wc, fr, fq, ui); \
            if (has_next) init_rg(acc, nxt, ai, m, wr, wc, fr, fq); } }                        \
    __device__ __forceinline__ void init(f32x4 (&acc)[2][2][4][2], const Unit& u, int wr, int wc, int fr, int fq) const { \
        _Pragma("unroll") for (int ai = 0; ai < 2; ++ai) _Pragma("unroll") for (int m = 0; m < 4; ++m) init_rg(acc, u, ai, m, wr, wc, fr, fq); }
#define EPI_ZERO_INIT() \
    __device__ __forceinline__ void init_rg(f32x4 (&acc)[2][2][4][2], const Unit&, int ai, int m, int, int, int, int) const { \
        _Pragma("unroll") for (int b = 0; b < 2; ++b) _Pragma("unroll") for (int n = 0; n < 2; ++n) acc[ai][b][m][n] = (f32x4){0.f, 0.f, 0.f, 0.f}; }
__device__ __forceinline__ float rstd_of(const LAS float* tab, const float* ss, int nslot, int row, int ui) { return (ui >= 0 && tab) ? tab[ui * 256 + (row & 255)] : rstd_from(ss, row, nslot); }
struct EpiGU {
    static constexpr bool PERM = false, AFTER_DRAIN = false;
    bf16_t* H; const float* ss; int nslot; const LAS float* tab; float wscale; unsigned char* H8; const float* wsn;
    __device__ __forceinline__ void row(const f32x4 (&v)[2][2], int row, int pn, int wc, int fr, int fq, int ui) const {
        typedef float f32x2 __attribute__((ext_vector_type(2)));
        const int col0 = pn * 128 + wc * 32 + 8 * fq;
        const float rs = rstd_of(tab, ss, nslot, row, ui) * (ui >= 0 ? wscale : 1.0f);
        const float c1 = -rs * LOG2E, rs2 = rs * rs;
        const bool f8 = (ui >= 0) && H8 != nullptr;
        const float rs2s = f8 ? rs2 * H8SCALE : rs2;
        f32x2 hh[4];
#pragma unroll
        for (int n = 0; n < 2; ++n)
#pragma unroll
            for (int i = 0; i < 4; i += 2) { const f32x2 ag = {v[0][n][i], v[0][n][i + 1]}, au = {v[1][n][i], v[1][n][i + 1]};
                const f32x2 a = ag * c1; f32x2 e; e.x = __builtin_amdgcn_exp2f(a.x); e.y = __builtin_amdgcn_exp2f(a.y);
                const f32x2 d = e + 1.0f; f32x2 r; r.x = __builtin_amdgcn_rcpf(d.x); r.y = __builtin_amdgcn_rcpf(d.y);
                hh[2 * n + (i >> 1)] = (ag * au) * (r * rs2s); }
        if (f8) { v2u w8; w8.x = pk4_fp8(hh[0].x, hh[0].y, hh[1].x, hh[1].y); w8.y = pk4_fp8(hh[2].x, hh[2].y, hh[3].x, hh[3].y);
            __builtin_nontemporal_store(w8, (v2u*)(H8 + (size_t)row * DFF + col0)); }
        else { v4u w; w.x = pg8::cvt_pk_bf16(hh[0].x, hh[0].y); w.y = pg8::cvt_pk_bf16(hh[1].x, hh[1].y); w.z = pg8::cvt_pk_bf16(hh[2].x, hh[2].y); w.w = pg8::cvt_pk_bf16(hh[3].x, hh[3].y);
        __builtin_nontemporal_store(w, (v4u*)(H + (size_t)row * DFF + col0)); }
    }
    __device__ __forceinline__ void operator()(f32x4 (&acc)[2][2][4][2], const Unit& u, int wr, int wc, int fr, int fq, int ui, bool has_next, const Unit& nxt) const {
        typedef int v4i_ __attribute__((ext_vector_type(4)));
        f32x4 cs[2][2];
#pragma unroll
        for (int bj = 0; bj < 2; ++bj)
#pragma unroll
            for (int n = 0; n < 2; ++n) cs[bj][n] = wsn ? *(const f32x4*)(wsn + u.pn * 256 + bj * 128 + wc * 32 + n * 16 + 4 * fq) : (f32x4){1.f, 1.f, 1.f, 1.f};
#pragma unroll
        for (int ai = 0; ai < 2; ++ai)
#pragma unroll
            for (int m = 0; m < 4; ++m) {
                f32x4 v[2][2];
#pragma unroll
                for (int bj = 0; bj < 2; ++bj)
#pragma unroll
                    for (int n = 0; n < 2; ++n) v[bj][n] = wsn ? __builtin_convertvector(__builtin_bit_cast(v4i_, acc[ai][bj][m][n]), f32x4) * cs[bj][n] : acc[ai][bj][m][n];
                row(v, u.pm * 256 + ai * 128 + wr * 64 + m * 16 + fr, u.pn, wc, fr, fq, ui);
                if (has_next) init_rg(acc, nxt, ai, m, wr, wc, fr, fq); }
    }
    __device__ __forceinline__ void init(f32x4 (&acc)[2][2][4][2], const Unit& u, int wr, int wc, int fr, int fq) const {
#pragma unroll
        for (int ai = 0; ai < 2; ++ai)
#pragma unroll
            for (int m = 0; m < 4; ++m) init_rg(acc, u, ai, m, wr, wc, fr, fq); }
    EPI_ZERO_INIT()
};
__device__ __forceinline__ void bf8_to_f32(const v4u w, f32x4& lo, f32x4& hi) {
    lo = (f32x4){__uint_as_float(w.x << 16), __uint_as_float(w.x & 0xffff0000u), __uint_as_float(w.y << 16), __uint_as_float(w.y & 0xffff0000u)};
    hi = (f32x4){__uint_as_float(w.z << 16), __uint_as_float(w.z & 0xffff0000u), __uint_as_float(w.w << 16), __uint_as_float(w.w & 0xffff0000u)};
}
template <int MODE> struct EpiRes {
    static constexpr bool PERM = false, AFTER_DRAIN = false;
    const bf16_t* resb; float* out; bf16_t* outb; float* ss; unsigned char* out8; float ascale;
    __device__ __forceinline__ void row(const f32x4 (&v)[2][2], int row, int pn, int wc, int fr, int fq, int ui) const {
        const bool pre = ui >= 0;
        const float alpha = ((MODE == 1) ? 1.0f : 0.5f) * (pre ? ascale : 1.0f);
        const bool live = row < MTOT;
        float sq = 0.f;
#pragma unroll
        for (int bj = 0; bj < 2; ++bj) {
            const int col = pn * 256 + bj * 128 + wc * 32 + 8 * fq;
            f32x4 r0 = (f32x4){0.f, 0.f, 0.f, 0.f}, r1 = r0;
            if (!pre && live) bf8_to_f32(*(const v4u*)(resb + (size_t)row * D + col), r0, r1);
            const f32x4 v0 = r0 + alpha * v[bj][0], v1 = r1 + alpha * v[bj][1];
            if (MODE == 2) { if (live) { __builtin_nontemporal_store(v0, (f32x4*)(out + (size_t)row * D + col)); __builtin_nontemporal_store(v1, (f32x4*)(out + (size_t)row * D + col + 4)); } }
            else {
                v4u w; w.x = pg8::cvt_pk_bf16(v0[0], v0[1]); w.y = pg8::cvt_pk_bf16(v0[2], v0[3]); w.z = pg8::cvt_pk_bf16(v1[0], v1[1]); w.w = pg8::cvt_pk_bf16(v1[2], v1[3]);
                *(v4u*)(outb + (size_t)row * D + col) = w;
                if (MODE == 1 && out8) { v2u w8; w8.x = pk4_fp8(v0[0], v0[1], v0[2], v0[3]); w8.y = pk4_fp8(v1[0], v1[1], v1[2], v1[3]); *(v2u*)(out8 + (size_t)row * D + col) = w8; }
                sq += (v0[0] * v0[0] + v0[1] * v0[1]) + (v0[2] * v0[2] + v0[3] * v0[3]) + (v1[0] * v1[0] + v1[1] * v1[1]) + (v1[2] * v1[2] + v1[3] * v1[3]);
            }
        }
        if (MODE != 2) { sq += __shfl_xor(sq, 16); sq += __shfl_xor(sq, 32); if (fq == 0) ss[(size_t)row * 16 + pn * 4 + wc] = sq; }
    }
    EPI_CALL_ROWS()
    __device__ __forceinline__ void init_rg(f32x4 (&acc)[2][2][4][2], const Unit& u, int ai, int m, int wr, int wc, int fr, int fq) const {
        const float ia = ((MODE == 1) ? 1.0f : 2.0f) / ascale;
        const bf16_t* rp = resb + (size_t)(u.pm * 256 + ai * 128 + wr * 64 + m * 16 + fr) * D + u.pn * 256 + wc * 32 + 8 * fq;
#pragma unroll
        for (int bj = 0; bj < 2; ++bj) { f32x4 lo, hi; bf8_to_f32(*(const v4u*)(rp + bj * 128), lo, hi); acc[ai][bj][m][0] = lo * ia; acc[ai][bj][m][1] = hi * ia; }
    }
};
struct EpiWin {
    static constexpr bool PERM = false, AFTER_DRAIN = false;
    unsigned char* ws; float* out; const float* qn; const float* kn; const LAS float* tab;
    __device__ __forceinline__ void row(const f32x4 (&acc)[2][2], int row, int pn, int wc, int fr, int fq, int ui) const {
        const float* ss = (const float*)(ws + WS_SS1); bf16_t* U = (bf16_t*)(ws + WS_U); bf16_t* GB = (bf16_t*)(ws + WS_GB); float* WI = (float*)(ws + WS_WI); const float* rope = (const float*)(ws + WS_ROPE);
        if (pn == 11 && wc >= 2) return;
        const int type = pn < 4 ? 0 : pn < 6 ? 1 : pn < 8 ? 2 : pn == 8 ? (wc < 2 ? 3 : 4) : pn < 11 ? 5 : (wc == 0 ? 6 : 7);
        const int head = (type == 2) ? 4 * (pn - 6) + wc : (type == 5) ? 4 * (pn - 9) + wc : (type == 3) ? wc : (type == 4) ? wc - 2 : 0;
        const bool live = row < MTOT;
        const float rs = rstd_of(tab, ss, 16, row, ui);
        if (type == 0) {
            const int ch0 = pn * 128 + wc * 32 + 8 * fq;
            const f32x4 u0 = (acc[0][0] * rs) * (acc[1][0] * rs), u1 = (acc[0][1] * rs) * (acc[1][1] * rs);
            v4u w; w.x = pg8::cvt_pk_bf16(u0[0], u0[1]); w.y = pg8::cvt_pk_bf16(u0[2], u0[3]); w.z = pg8::cvt_pk_bf16(u1[0], u1[1]); w.w = pg8::cvt_pk_bf16(u1[2], u1[3]);
            *(v4u*)(U + (size_t)row * 512 + ch0) = w;
            if (row < MP) { const int s = row & (SEQ - 1); if (s >= SEQ - 2) { float* o = out + O_CP + ((size_t)(row >> 11) * 2 + (s - (SEQ - 2))) * 512 + ch0; *(f32x4*)o = u0; *(f32x4*)(o + 4) = u1; } }
            else if (live) { const int sr = row - MP, s = sr & 3; if (s >= 2) { float* o = out + O_CS + ((size_t)(sr >> 2) * 2 + (s - 2)) * 512 + ch0; *(f32x4*)o = u0; *(f32x4*)(o + 4) = u1; } }
        } else if (type == 1) {
#pragma unroll
            for (int bj = 0; bj < 2; ++bj) { const int col = (pn - 4) * 256 + bj * 128 + wc * 32 + 8 * fq; const f32x4 a = acc[bj][0] * rs, b = acc[bj][1] * rs;
                v4u w; w.x = pg8::cvt_pk_bf16(a[0], a[1]); w.y = pg8::cvt_pk_bf16(a[2], a[3]); w.z = pg8::cvt_pk_bf16(b[0], b[1]); w.w = pg8::cvt_pk_bf16(b[2], b[3]);
                *(v4u*)(GB + (size_t)row * 512 + col) = w; }
        } else if (type == 7) {
            if (fq == 0) { *(f32x4*)(WI + (size_t)row * 8) = acc[0][0] * rs; *(f32x4*)(WI + (size_t)row * 8 + 4) = acc[0][1] * rs; }
        } else {
            f32x4 v[2][2];
#pragma unroll
            for (int bj = 0; bj < 2; ++bj) { v[bj][0] = acc[bj][0] * rs; v[bj][1] = acc[bj][1] * rs; }
            if (type == 2 || type == 3) {
                float sq = 0.f;
#pragma unroll
                for (int bj = 0; bj < 2; ++bj)
#pragma unroll
                    for (int h2 = 0; h2 < 2; ++h2) sq += (v[bj][h2][0] * v[bj][h2][0] + v[bj][h2][1] * v[bj][h2][1]) + (v[bj][h2][2] * v[bj][h2][2] + v[bj][h2][3] * v[bj][h2][3]);
                sq += __shfl_xor(sq, 16); sq += __shfl_xor(sq, 32);
                const float sc = __builtin_amdgcn_rsqf(sq * (1.0f / 64.0f) + EPS);
#pragma unroll
                for (int bj = 0; bj < 2; ++bj)
#pragma unroll
                    for (int h2 = 0; h2 < 2; ++h2) { const f32x4 gq = *(const f32x4*)(qn + dstart(bj, fq, h2)), gk = *(const f32x4*)(kn + dstart(bj, fq, h2)); v[bj][h2] = v[bj][h2] * sc * ((type == 2) ? gq : gk); }
            }
            if (type != 4 && fq < 2) {
                const int pidx = row < MP ? (row & (SEQ - 1)) : (live ? SEQ + ((row - MP) & 3) : 0);
                const float* rp = rope + ((size_t)pidx * 8 + 4 * fq) * 2;
                const f32x4 cs0 = *(const f32x4*)rp, cs1 = *(const f32x4*)(rp + 4);
                const f32x4 x1 = v[0][0], x2 = v[0][1];
                const f32x4 c = (f32x4){cs0[0], cs0[2], cs1[0], cs1[2]}, s = (f32x4){cs0[1], cs0[3], cs1[1], cs1[3]};
                v[0][0] = x1 * c - x2 * s; v[0][1] = x2 * c + x1 * s;
            }
            const size_t boff = (type == 2) ? WS_Q : (type == 3) ? WS_KB : (type == 4) ? WS_VB : (type == 5) ? WS_QI : WS_KIB;
            const int bp = (type == 2 || type == 5) ? 512 : (type == 6) ? 64 : 128; const float bsc = (type == 2) ? QSCALE : 1.0f;
            bf16_t* bdst = (bf16_t*)(ws + boff);
            const bool hasf = live && (type == 3 || type == 4 || type == 6);
            const size_t fbase = (type == 3) ? (row < MP ? O_KP : O_KS) : (type == 4) ? (row < MP ? O_VP : O_VS) : (row < MP ? O_IP : O_IS);
            float* fdst = out + fbase + (size_t)(row < MP ? row : row - MP) * (type == 6 ? 64 : 128);
#pragma unroll
            for (int bj = 0; bj < 2; ++bj)
#pragma unroll
                for (int h2 = 0; h2 < 2; ++h2) { const int d = head * 64 + dstart(bj, fq, h2); const f32x4 x = v[bj][h2];
                    if (hasf) { if (row < MP) __builtin_nontemporal_store(x, (f32x4*)(fdst + d)); else *(f32x4*)(fdst + d) = x; }
                    v2u w; w.x = pg8::cvt_pk_bf16(x[0] * bsc, x[1] * bsc); w.y = pg8::cvt_pk_bf16(x[2] * bsc, x[3] * bsc);
                    *(v2u*)(bdst + (size_t)row * bp + d) = w; }
        }
    }
    EPI_CALL_ROWS()
    EPI_ZERO_INIT()
};
template <class Epi> __device__ __forceinline__ void skinny_unit(PG8_LAS unsigned char* lds, const bf16_t* A, const bf16_t* Bt, int K, int pn, int wc, int rg, const Epi& E) {
    const int tid = threadIdx.x, wid = __builtin_amdgcn_readfirstlane(tid >> 6), lane = tid & 63, fr = lane & 15, fq = lane >> 4;
    const int KQ = K >> 3, ns = KQ >> 5;
    const bf16_t* ap = A + (size_t)(MP + 64 * rg + fr) * K + wid * KQ + 8 * fq;
    const bf16_t* bp = Bt + (size_t)(256 * pn + 32 * wc + fr) * K + wid * KQ + 8 * fq;
    pg8::f32x4 acc[4][2][2];
#pragma unroll
    for (int mt = 0; mt < 4; ++mt)
#pragma unroll
        for (int bj = 0; bj < 2; ++bj)
#pragma unroll
            for (int n = 0; n < 2; ++n) acc[mt][bj][n] = (pg8::f32x4){0.f, 0.f, 0.f, 0.f};
    pg8::bf16x8 a0[4], b0[2][2], a1[4], b1[2][2], a2[4], b2[2][2], a3[4], b3[2][2];
#define SK_LOAD(af, bf, s_) do { const int sc_ = (s_) < ns ? (s_) : ns - 1; _Pragma("unroll") for (int mt = 0; mt < 4; ++mt) af[mt] = *(const pg8::bf16x8*)(ap + (size_t)(16 * mt) * K + 32 * sc_); \
        _Pragma("unroll") for (int bj = 0; bj < 2; ++bj) _Pragma("unroll") for (int n = 0; n < 2; ++n) bf[bj][n] = *(const pg8::bf16x8*)(bp + (size_t)(128 * bj + 16 * n) * K + 32 * sc_); } while (0)
#define SK_MMA(af, bf) do { _Pragma("unroll") for (int mt = 0; mt < 4; ++mt) _Pragma("unroll") for (int bj = 0; bj < 2; ++bj) _Pragma("unroll") for (int n = 0; n < 2; ++n) \
        acc[mt][bj][n] = __builtin_amdgcn_mfma_f32_16x16x32_bf16(bf[bj][n], af[mt], acc[mt][bj][n], 0, 0, 0); } while (0)
    SK_LOAD(a0, b0, 0); SK_LOAD(a1, b1, 1); SK_LOAD(a2, b2, 2);
    for (int s = 0; s < ns; s += 4) {
        SK_LOAD(a3, b3, s + 3); SK_MMA(a0, b0);
        if (s + 1 < ns) { SK_LOAD(a0, b0, s + 4); SK_MMA(a1, b1); }
        if (s + 2 < ns) { SK_LOAD(a1, b1, s + 5); SK_MMA(a2, b2); }
        if (s + 3 < ns) { SK_LOAD(a2, b2, s + 6); SK_MMA(a3, b3); }
    }
#undef SK_LOAD
#undef SK_MMA
    PG8_LAS pg8::f32x4* slab = (PG8_LAS pg8::f32x4*)lds;
#pragma unroll
    for (int mt = 0; mt < 4; ++mt)
#pragma unroll
        for (int bj = 0; bj < 2; ++bj)
#pragma unroll
            for (int n = 0; n < 2; ++n) slab[((wid * 4 + mt) * 4 + bj * 2 + n) * 64 + lane] = acc[mt][bj][n];
    __syncthreads();
    if (wid < 4) { pg8::f32x4 v[2][2];
#pragma unroll
      for (int bj = 0; bj < 2; ++bj)
#pragma unroll
          for (int n = 0; n < 2; ++n) { const int o = (wid * 4 + bj * 2 + n) * 64 + lane; pg8::f32x4 t = slab[o];
#pragma unroll
              for (int q = 1; q < 8; ++q) t = t + slab[o + q * 4 * 4 * 64];
              v[bj][n] = t; }
      E.row(v, MP + 64 * rg + 16 * wid + fr, pn, wc, fr, fq, -1); }
    __syncthreads();
}
template <class Epi> __device__ __forceinline__ void skinny_phase(PG8_LAS unsigned char* lds, const bf16_t* A, const bf16_t* Bt, int N, int K, int blk, int G, const Epi& E) {
    const int nu = (N / 256) * 8;
    for (int u = blk; u < nu; u += G) skinny_unit(lds, A, Bt, K, u >> 3, (u >> 1) & 3, u & 1, E);
}
__device__ __forceinline__ void fill_rstd_table(LAS float* tab, const pg8::StaticOrder& S, const float* ss, int nslot, const float* xs = nullptr) {
    const int tid = threadIdx.x; Unit u; int nu = 0;
    while (nu < 11 && S.next(nu, u)) ++nu;
    float sv[6], xsv[6]; int ix[6];
#pragma unroll
    for (int k2 = 0; k2 < 6; ++k2) { const int idx = tid + 512 * k2; ix[k2] = idx; const bool ok = idx < nu * 256; Unit uu_; S.next(ok ? (idx >> 8) : 0, uu_); const int row = uu_.pm * 256 + (idx & 255);
        float s_ = 0.f;
        if (nslot == 1) s_ = ss[row];
        else { const f32x4* p = (const f32x4*)(ss + (size_t)row * 16); const f32x4 a = p[0], b = p[1], c = p[2], d = p[3]; s_ = ((a.x + a.y) + (a.z + a.w)) + ((b.x + b.y) + (b.z + b.w)) + ((c.x + c.y) + (c.z + c.w)) + ((d.x + d.y) + (d.z + d.w)); }
        sv[k2] = s_; xsv[k2] = xs ? xs[row] : 1.0f; }
#pragma unroll
    for (int k2 = 0; k2 < 6; ++k2) if (ix[k2] < nu * 256) tab[ix[k2]] = __builtin_amdgcn_rsqf(sv[k2] * (1.0f / D) + EPS) * xsv[k2];
    __syncthreads();
}
__device__ __forceinline__ void quant_rows_pass(int gw, int NGW, const bf16_t* X, unsigned char* Q, float* XS, int nrows) {
    const int lane = threadIdx.x & 63;
    for (int g8 = gw; g8 < nrows / 8; g8 += NGW) {
        const int m0 = 8 * g8; v4u a[8][2];
#pragma unroll
        for (int r = 0; r < 8; ++r) { a[r][0] = *(const v4u*)(X + (size_t)(m0 + r) * D + 8 * lane); a[r][1] = *(const v4u*)(X + (size_t)(m0 + r) * D + 512 + 8 * lane); }
#pragma unroll
        for (int r = 0; r < 8; ++r) {
            float x[16];
#pragma unroll
            for (int e = 0; e < 4; ++e) { x[2 * e] = __uint_as_float(a[r][0][e] << 16); x[2 * e + 1] = __uint_as_float(a[r][0][e] & 0xffff0000u); x[8 + 2 * e] = __uint_as_float(a[r][1][e] << 16); x[9 + 2 * e] = __uint_as_float(a[r][1][e] & 0xffff0000u); }
            float mx = 0.f;
#pragma unroll
            for (int e = 0; e < 16; ++e) mx = fmaxf(mx, fabsf(x[e]));
            { unsigned v = __float_as_uint(mx), o;
              o = (unsigned)__builtin_amdgcn_update_dpp(0, (int)v, 0xB1, 0xF, 0xF, true); v = o > v ? o : v;
              o = (unsigned)__builtin_amdgcn_update_dpp(0, (int)v, 0x4E, 0xF, 0xF, true); v = o > v ? o : v;
              o = (unsigned)__builtin_amdgcn_update_dpp(0, (int)v, 0x141, 0xF, 0xF, true); v = o > v ? o : v;
              o = (unsigned)__builtin_amdgcn_update_dpp(0, (int)v, 0x140, 0xF, 0xF, true); v = o > v ? o : v;
              const unsigned p0 = (unsigned)__builtin_amdgcn_readlane((int)v, 0), p1 = (unsigned)__builtin_amdgcn_readlane((int)v, 16), p2 = (unsigned)__builtin_amdgcn_readlane((int)v, 32), p3 = (unsigned)__builtin_amdgcn_readlane((int)v, 48);
              const unsigned q0 = p0 > p1 ? p0 : p1, q1 = p2 > p3 ? p2 : p3; mx = __uint_as_float(q0 > q1 ? q0 : q1); }
            const float iq = mx > 0.f ? 127.0f / mx : 0.f;
            unsigned w[4];
#pragma unroll
            for (int e = 0; e < 4; ++e) { const int q0 = (int)__builtin_rintf(x[4 * e] * iq), q1 = (int)__builtin_rintf(x[4 * e + 1] * iq), q2 = (int)__builtin_rintf(x[4 * e + 2] * iq), q3 = (int)__builtin_rintf(x[4 * e + 3] * iq);
                w[e] = (unsigned)(q0 & 0xff) | ((unsigned)(q1 & 0xff) << 8) | ((unsigned)(q2 & 0xff) << 16) | ((unsigned)(q3 & 0xff) << 24); }
            *(v2u*)(Q + (size_t)(m0 + r) * D + 8 * lane) = (v2u){w[0], w[1]};
            *(v2u*)(Q + (size_t)(m0 + r) * D + 512 + 8 * lane) = (v2u){w[2], w[3]};
            if (lane == 0) XS[m0 + r] = mx * (1.0f / 127.0f);
        }
    }
}
struct Frame {
    LAS unsigned char* lds;
    volatile LAS unsigned* MISC;
    gu32* ctl;
    int tid, lane, wave, vcu, G;
    const void* const* in;
    float* out; unsigned char* ws;
};
#define WSP(T, off) ((T*)(F.ws + (off)))

template <class Map> __device__ __forceinline__ void p0_transpose_item(const float* W, int K, int N, const float* gain, bf16* WT, LAS float* scr, int item, int lane, const Map map, unsigned char* WT8 = nullptr) {
    const int nblk = (N + 31) / 32, kb = item / nblk, nb = item % nblk, k0 = 64 * kb, n0 = 32 * nb;
    const bool nok = n0 + (lane & 31) < N;
#pragma unroll 8
    for (int i = 0; i < 32; ++i) { const int kk = 2 * i + (lane >> 5); float v = nok ? __builtin_nontemporal_load(W + (size_t)(k0 + kk) * N + n0 + (lane & 31)) : 0.f; if (gain) v *= gain[k0 + kk]; scr[kk * 33 + (lane & 31)] = v; }
    LDS_WAIT(); asm volatile("" ::: "memory");
    const int c = lane & 7;
#pragma unroll
    for (int j = 0; j < 4; ++j) { const int n = (lane >> 3) + 8 * j; const LAS float* s = scr + (8 * c) * 33 + n;
        v4u o; o.x = pk2(s[0 * 33], s[1 * 33]); o.y = pk2(s[2 * 33], s[3 * 33]); o.z = pk2(s[4 * 33], s[5 * 33]); o.w = pk2(s[6 * 33], s[7 * 33]);
        if (n0 + n < N) { *(GAS v4u*)(WT + (size_t)map(n0 + n) * K + k0 + 8 * c) = o;
            if (WT8) { v2u o8; o8.x = pk4_fp8(s[0 * 33] * W8SCALE, s[1 * 33] * W8SCALE, s[2 * 33] * W8SCALE, s[3 * 33] * W8SCALE); o8.y = pk4_fp8(s[4 * 33] * W8SCALE, s[5 * 33] * W8SCALE, s[6 * 33] * W8SCALE, s[7 * 33] * W8SCALE);
                *(GAS v2u*)(WT8 + (size_t)map(n0 + n) * K + k0 + 8 * c) = o8; } } }
    LDS_WAIT(); asm volatile("" ::: "memory");
}
__device__ __forceinline__ void sincos_d(double a, float& s, float& c) {
    const double TWO_PI = 6.283185307179586476925286766559, PI = 3.14159265358979323846264338327950288;
    double k = __builtin_rint(a / TWO_PI); double r = a - k * TWO_PI;
    double sgn = 1.0; if (r > PI * 0.5) { r = PI - r; sgn = -1.0; } else if (r < -PI * 0.5) { r = -PI - r; sgn = -1.0; }
    const double r2 = r * r;
    double ts = 1.0, tc = 1.0, ps = 1.0, pc = 1.0;
#pragma unroll
    for (int n = 1; n <= 12; ++n) { pc = -pc * r2 / (double)((2 * n - 1) * (2 * n)); ps = -ps * r2 / (double)((2 * n) * (2 * n + 1)); tc += pc; ts += ps; }
    s = (float)(r * ts); c = (float)(sgn * tc);
}
__device__ __forceinline__ void p0_prologue(Frame& F) {
    LAS float* scr = (LAS float*)(F.lds + RING_OFF + F.wave * 16384);
    const int gw = F.vcu * 8 + F.wave, NGW = F.G * 8;
    constexpr int I_G = (D / 64) * (DFF / 32), I_D = (DFF / 64) * (D / 32), I_IN = (D / 64) * ((NIN + 31) / 32), I_O = (D / 64) * (D / 32);
    constexpr int NITEMS = 2 * (2 * I_G + I_D) + I_IN + I_O;
    for (int rep63 = 0; rep63 < (PROBE_DUP == 63 ? 2 : 1); ++rep63)
    for (int it = gw; it < NITEMS; it += NGW) {
        int r = it;
        if (r < I_G) { p0_transpose_item(((const float*)F.in[8]), D, DFF, ((const float*)F.in[7]), WSP(bf16, WS_WGU1), scr, r, F.lane, MapGate()); continue; } r -= I_G;
        if (r < I_G) { p0_transpose_item(((const float*)F.in[9]), D, DFF, ((const float*)F.in[7]), WSP(bf16, WS_WGU1), scr, r, F.lane, MapUp()); continue; } r -= I_G;
        if (r < I_D) { p0_transpose_item(((const float*)F.in[10]), DFF, D, nullptr, WSP(bf16, WS_WD1), scr, r, F.lane, MapLin(), WSP(unsigned char, WS_WD1_8)); continue; } r -= I_D;
        if (r < I_G) { p0_transpose_item(((const float*)F.in[19]), D, DFF, ((const float*)F.in[18]), WSP(bf16, WS_WGU2), scr, r, F.lane, MapGate()); continue; } r -= I_G;
        if (r < I_G) { p0_transpose_item(((const float*)F.in[20]), D, DFF, ((const float*)F.in[18]), WSP(bf16, WS_WGU2), scr, r, F.lane, MapUp()); continue; } r -= I_G;
        if (r < I_D) { p0_transpose_item(((const float*)F.in[21]), DFF, D, nullptr, WSP(bf16, WS_WD2), scr, r, F.lane, MapLin(), WSP(unsigned char, WS_WD2_8)); continue; } r -= I_D;
        if (r < I_IN) { p0_transpose_item(((const float*)F.in[12]), D, NIN, ((const float*)F.in[11]), WSP(bf16, WS_WIN), scr, r, F.lane, MapWin()); continue; } r -= I_IN;
        p0_transpose_item(((const float*)F.in[17]), D, D, nullptr, WSP(bf16, WS_WOUT), scr, r, F.lane, MapLin());
    }
    bf16* XB = WSP(bf16, WS_XB); float* SS0 = WSP(float, WS_SS0);
    for (int rep64 = 0; rep64 < (PROBE_DUP == 64 ? 2 : 1); ++rep64)
    for (int g4 = gw; g4 < MTOT / 4; g4 += NGW) {
        const int m0 = 4 * g4;
        const float* xrow = m0 < MP ? ((const float*)F.in[0]) + (size_t)m0 * D : ((const float*)F.in[1]) + (size_t)(m0 - MP) * D;
        const GAS f32x4* xr = (const GAS f32x4*)xrow + F.lane;
        f32x4 v[4][4]; float s[4];
#pragma unroll
        for (int r = 0; r < 4; ++r)
#pragma unroll
            for (int j = 0; j < 4; ++j) v[r][j] = __builtin_nontemporal_load((const f32x4*)(xr + 256 * r + 64 * j));
#pragma unroll
        for (int r = 0; r < 4; ++r) { s[r] = 0.f;
#pragma unroll
            for (int j = 0; j < 4; ++j) s[r] += (v[r][j].x * v[r][j].x + v[r][j].y * v[r][j].y) + (v[r][j].z * v[r][j].z + v[r][j].w * v[r][j].w); }
#pragma unroll
        for (int o = 1; o < 64; o <<= 1) {
#pragma unroll
            for (int r = 0; r < 4; ++r) s[r] += __shfl_xor(s[r], o); }
        GAS unsigned long long* o8 = (GAS unsigned long long*)(XB + (size_t)m0 * D) + F.lane;
#pragma unroll
        for (int r = 0; r < 4; ++r)
#pragma unroll
            for (int j = 0; j < 4; ++j) o8[256 * r + 64 * j] = (unsigned long long)pk2(v[r][j].x, v[r][j].y) | ((unsigned long long)pk2(v[r][j].z, v[r][j].w) << 32);
        { float mx[4];
#pragma unroll
          for (int r = 0; r < 4; ++r) { mx[r] = 0.f;
#pragma unroll
              for (int j = 0; j < 4; ++j) mx[r] = fmaxf(mx[r], fmaxf(fmaxf(fabsf(v[r][j].x), fabsf(v[r][j].y)), fmaxf(fabsf(v[r][j].z), fabsf(v[r][j].w)))); }
#pragma unroll
          for (int o = 1; o < 64; o <<= 1) {
#pragma unroll
              for (int r = 0; r < 4; ++r) mx[r] = fmaxf(mx[r], __shfl_xor(mx[r], o)); }
          GAS unsigned* q8 = (GAS unsigned*)(WSP(unsigned char, WS_XI8) + (size_t)m0 * D) + F.lane;
#pragma unroll
          for (int r = 0; r < 4; ++r) { const float iq = mx[r] > 0.f ? 127.0f / mx[r] : 0.f;
#pragma unroll
              for (int j = 0; j < 4; ++j) { const int a_ = (int)__builtin_rintf(v[r][j].x * iq), b_ = (int)__builtin_rintf(v[r][j].y * iq), c_ = (int)__builtin_rintf(v[r][j].z * iq), d_ = (int)__builtin_rintf(v[r][j].w * iq);
                  q8[256 * r + 64 * j] = (unsigned)(a_ & 0xff) | ((unsigned)(b_ & 0xff) << 8) | ((unsigned)(c_ & 0xff) << 16) | ((unsigned)(d_ & 0xff) << 24); } }
          if (F.lane < 4) WSP(float, WS_XS)[m0 + F.lane] = (F.lane == 0 ? mx[0] : F.lane == 1 ? mx[1] : F.lane == 2 ? mx[2] : mx[3]) * (1.0f / 127.0f); }
        if (F.lane < 4) SS0[m0 + F.lane] = F.lane == 0 ? s[0] : F.lane == 1 ? s[1] : F.lane == 2 ? s[2] : s[3];
    }
    { float* rope = WSP(float, WS_ROPE);
      const double invf[8] = {1.0, 0.19392274474868576, 0.03760603093086393, 0.007292664737217109, 0.001414213562373095, 0.0002742481756762073, 5.318295896944988e-05, 1.031338537721246e-05};
      for (int rep65 = 0; rep65 < (PROBE_DUP == 65 ? 2 : 1); ++rep65)
      for (int e = (F.vcu * 512 + F.tid); e < 2052 * 8; e += F.G * 512) { const int p = e >> 3, i = e & 7; const double pos = (double)(p < SEQ ? p : PAST + (p - SEQ));
          double f = invf[0];
#pragma unroll
          for (int q = 1; q < 8; ++q) f = (i == q) ? invf[q] : f;
          float s, c; sincos_d(pos * f, s, c); rope[2 * e] = c; rope[2 * e + 1] = s; } }
}

__device__ __forceinline__ void unpack8(const v4u a, float (&o)[8]) {
#pragma unroll
    for (int e = 0; e < 4; ++e) { o[2 * e] = bf2f((unsigned short)(a[e] & 0xffffu)); o[2 * e + 1] = bf2f((unsigned short)(a[e] >> 16)); }
}
__device__ __forceinline__ unsigned wave_umax(unsigned v) {
    unsigned o;
    o = (unsigned)__builtin_amdgcn_update_dpp(0, (int)v, 0xB1, 0xF, 0xF, true); v = o > v ? o : v;
    o = (unsigned)__builtin_amdgcn_update_dpp(0, (int)v, 0x4E, 0xF, 0xF, true); v = o > v ? o : v;
    o = (unsigned)__builtin_amdgcn_update_dpp(0, (int)v, 0x141, 0xF, 0xF, true); v = o > v ? o : v;
    o = (unsigned)__builtin_amdgcn_update_dpp(0, (int)v, 0x140, 0xF, 0xF, true); v = o > v ? o : v;
    const unsigned a = (unsigned)__builtin_amdgcn_readlane((int)v, 0), b = (unsigned)__builtin_amdgcn_readlane((int)v, 16), c = (unsigned)__builtin_amdgcn_readlane((int)v, 32), d = (unsigned)__builtin_amdgcn_readlane((int)v, 48);
    const unsigned ab = a > b ? a : b, cd = c > d ? c : d; return ab > cd ? ab : cd;
}
__device__ __forceinline__ void p0b_quant_weights(Frame& F, bool second, int gw, int NGW) {
    const bf16* W = second ? WSP(bf16, WS_WGU2) : WSP(bf16, WS_WGU1); unsigned char* Q = second ? WSP(unsigned char, WS_WGU2I8) : WSP(unsigned char, WS_WGU1I8); float* WSN = second ? WSP(float, WS_WSN2) : WSP(float, WS_WSN);
    for (int r0 = gw; r0 < 2 * DFF; r0 += 4 * NGW) {
        v4u a[4], b[4];
#pragma unroll
        for (int i = 0; i < 4; ++i) { const int r = r0 + i * NGW < 2 * DFF ? r0 + i * NGW : r0;
            a[i] = *(const GAS v4u*)(W + (size_t)r * D + 8 * F.lane); b[i] = *(const GAS v4u*)(W + (size_t)r * D + 512 + 8 * F.lane); }
#pragma unroll
        for (int i = 0; i < 4; ++i) { const int r = r0 + i * NGW;
            float x[16]; { float t0[8], t1[8]; unpack8(a[i], t0); unpack8(b[i], t1);
#pragma unroll
                for (int e = 0; e < 8; ++e) { x[e] = t0[e]; x[8 + e] = t1[e]; } }
            float mx = 0.f;
#pragma unroll
            for (int e = 0; e < 16; ++e) mx = fmaxf(mx, fabsf(x[e]));
            mx = __uint_as_float(wave_umax(__float_as_uint(mx)));
            const float iq = mx > 0.f ? 127.0f / mx : 0.f;
            unsigned w[4];
#pragma unroll
            for (int e = 0; e < 4; ++e) { const int q0 = (int)__builtin_rintf(x[4 * e] * iq), q1 = (int)__builtin_rintf(x[4 * e + 1] * iq), q2 = (int)__builtin_rintf(x[4 * e + 2] * iq), q3 = (int)__builtin_rintf(x[4 * e + 3] * iq);
                w[e] = (unsigned)(q0 & 0xff) | ((unsigned)(q1 & 0xff) << 8) | ((unsigned)(q2 & 0xff) << 16) | ((unsigned)(q3 & 0xff) << 24); }
            if (r < 2 * DFF) {
                *(GAS v2u*)(Q + (size_t)r * D + 8 * F.lane) = (v2u){w[0], w[1]};
                *(GAS v2u*)(Q + (size_t)r * D + 512 + 8 * F.lane) = (v2u){w[2], w[3]};
                if (F.lane == 0) WSN[r] = mx * (1.0f / 127.0f); } }
    }
}
__device__ __forceinline__ void p4_conv(Frame& F) {
    const int gw = F.vcu * 8 + F.wave, NGW = F.G * 8, ch = F.lane * 8;
    const bf16* U = WSP(bf16, WS_U); const bf16* GBp = WSP(bf16, WS_GB); bf16* CAT = WSP(bf16, WS_CAT);
    const float* conv_w = (const float*)F.in[13]; const float* conv_b = (const float*)F.in[14]; const float* cache_conv = (const float*)F.in[5];
    float w0[8], w1[8], w2[8], cb[8];
#pragma unroll
    for (int e = 0; e < 8; ++e) { w0[e] = conv_w[ch + e]; w1[e] = conv_w[512 + ch + e]; w2[e] = conv_w[1024 + ch + e]; cb[e] = conv_b[ch + e]; }
    for (int c = gw; c < MTOT / 8; c += NGW) {
        const int r0 = 8 * c;
        v4u ur[10], gr[8];
#pragma unroll
        for (int e = 0; e < 10; ++e) { const int rr = r0 - 2 + e; ur[e] = *(const GAS v4u*)(U + (size_t)(rr < 0 ? 0 : rr) * 512 + ch); }
#pragma unroll
        for (int e = 0; e < 8; ++e) gr[e] = *(const GAS v4u*)(GBp + (size_t)(r0 + e) * 512 + ch);
        float um2[8], um1[8];
        unpack8(ur[0], um2); unpack8(ur[1], um1);
        if (r0 < MP && (r0 & (SEQ - 1)) == 0) {
#pragma unroll
            for (int e = 0; e < 8; ++e) { um2[e] = 0.f; um1[e] = 0.f; } }
#pragma unroll
        for (int e = 0; e < 8; ++e) {
            if (r0 >= MP && (e & 3) == 0) {
                const float* cc = cache_conv + (size_t)((r0 - MP + e) >> 2) * 2 * 512 + ch;
#pragma unroll
                for (int q = 0; q < 8; ++q) { um2[q] = cc[q]; um1[q] = cc[512 + q]; } }
            float u0[8], g[8], y[8]; unpack8(ur[2 + e], u0); unpack8(gr[e], g);
#pragma unroll
            for (int q = 0; q < 8; ++q) { y[q] = g[q] * (cb[q] + w0[q] * um2[q] + w1[q] * um1[q] + w2[q] * u0[q]); um2[q] = um1[q]; um1[q] = u0[q]; }
            v4u o; o.x = pk2(y[0], y[1]); o.y = pk2(y[2], y[3]); o.z = pk2(y[4], y[5]); o.w = pk2(y[6], y[7]);
            *(GAS v4u*)(CAT + (size_t)(r0 + e) * D + ch) = o;
        }
    }
}
__device__ __forceinline__ int crow16(int r, int hi) { return (r & 3) + 8 * (r >> 2) + 4 * hi; }
__device__ __forceinline__ float xhalf_sum(float v) {
    auto rr = __builtin_amdgcn_permlane32_swap(__float_as_uint(v), __float_as_uint(v), false, false);
    return __uint_as_float(rr[0]) + __uint_as_float(rr[1]);
}
__device__ __forceinline__ void p4_sample_scores(Frame& F) {
    const int gw = F.vcu * 8 + F.wave, NGW = F.G * 8, lane = F.lane, r32 = lane & 31, hi = lane >> 5;
    const bf16* QI = WSP(bf16, WS_QI); const float* WIp = WSP(float, WS_WI); float* SSC = WSP(float, WS_SSC);
    const int* page_table = (const int*)F.in[6]; const float* cache_idx_k = (const float*)F.in[4];
    for (int item = gw; item < DB * NPAGES; item += NGW) {
        const int b = item >> 7, pg = item & 127; const int page = page_table[b * NPAGES + pg];
        bf16x8 a[4]; f32x4 w4[4];
        { const bf16* qrow = QI + (size_t)(MP + 4 * b + (r32 >> 3)) * 512 + (r32 & 7) * 64 + 8 * hi;
#pragma unroll
          for (int s = 0; s < 4; ++s) a[s] = *(const GAS bf16x8*)(qrow + 16 * s);
#pragma unroll
          for (int q = 0; q < 4; ++q) w4[q] = *(const GAS f32x4*)(WIp + (size_t)(MP + 4 * b + q) * 8 + 4 * hi); }
        const float* src = cache_idx_k + ((size_t)page * PAGE + r32) * 64 + 8 * hi;
        f32x4 lo[4][4], hh[4][4];
#pragma unroll
        for (int sub = 0; sub < 4; ++sub)
#pragma unroll
            for (int s = 0; s < 4; ++s) { lo[sub][s] = __builtin_nontemporal_load((const f32x4*)(src + sub * 32 * 64 + 16 * s)); hh[sub][s] = __builtin_nontemporal_load((const f32x4*)(src + sub * 32 * 64 + 16 * s + 4)); }
#pragma unroll
        for (int sub = 0; sub < 4; ++sub) {
            f32x16 acc = {};
#pragma unroll
            for (int s = 0; s < 4; ++s) { v4u p; p.x = pk2(lo[sub][s][0], lo[sub][s][1]); p.y = pk2(lo[sub][s][2], lo[sub][s][3]); p.z = pk2(hh[sub][s][0], hh[sub][s][1]); p.w = pk2(hh[sub][s][2], hh[sub][s][3]);
                acc = __builtin_amdgcn_mfma_f32_32x32x16_bf16(a[s], __builtin_bit_cast(bf16x8, p), acc, 0, 0, 0); }
#pragma unroll
            for (int q = 0; q < 4; ++q) {
                float sum = w4[q][0] * fmaxf(acc[4 * q], 0.f) + w4[q][1] * fmaxf(acc[4 * q + 1], 0.f) + w4[q][2] * fmaxf(acc[4 * q + 2], 0.f) + w4[q][3] * fmaxf(acc[4 * q + 3], 0.f);
                sum = xhalf_sum(sum) + 0.0f;
                if ((q >> 1) == hi) SSC[(size_t)(4 * b + q) * SSTR + pg * PAGE + sub * 32 + r32] = sum;
            }
        }
    }
}
__device__ __forceinline__ unsigned fkey(float s) { const unsigned b = __builtin_bit_cast(unsigned, s); return b ^ ((unsigned)((int)b >> 31) | 0x80000000u); }
__device__ __forceinline__ float unfkey(unsigned k) { const unsigned b = (k & 0x80000000u) ? (k ^ 0x80000000u) : ~k; return __builtin_bit_cast(float, b); }
__device__ __forceinline__ int wave_count(unsigned cl) {
    int tot = 0;
#pragma unroll
    for (int bb = 0; bb < 6; ++bb) tot += __popcll(__ballot((cl >> bb) & 1u)) << bb;
    return tot;
}
__device__ __forceinline__ void p4_index_preload(Frame& F, int b, int j, bf16x8 (&a)[4][4], float& pwq) {
    const int tid = F.tid, r32 = F.lane & 31, hi = F.lane >> 5; const size_t rowb = (size_t)b * SEQ; const int t0 = 16 * j;
    const bf16* QI = WSP(bf16, WS_QI); const float* WIp = WSP(float, WS_WI);
    pwq = WIp[(rowb + t0 + ((tid & 127) >> 3)) * 8 + (tid & 7)];
#pragma unroll
    for (int rt = 0; rt < 4; ++rt) { const bf16* qrow = QI + (rowb + t0 + 4 * rt + 2 * (r32 >> 4) + ((r32 >> 2) & 1)) * 512 + (4 * ((r32 >> 3) & 1) + (r32 & 3)) * 64 + 8 * hi;
#pragma unroll
        for (int s = 0; s < 4; ++s) a[rt][s] = *(const GAS bf16x8*)(qrow + 16 * s); }
}
__device__ __forceinline__ void p4_index_unit(Frame& F, int b, int j, int useq, bf16x8 (&a)[4][4], float& pwq, int nj) {
    const int tid = F.tid, lane = F.lane, wid = F.wave, r32 = lane & 31, hi = lane >> 5;
    const int ss_id = (F.vcu * 8 + useq) * 8 + wid, ss_item = ss_id >> 2, ss_sub = ss_id & 3, ss_b = ss_item >> 7, ss_pg = ss_item & 127;
    const bool ss_on = F.vcu < 256;
    const int ss_page = ss_on ? ((const int*)F.in[6])[ss_b * NPAGES + ss_pg] : 0;
    const int t0 = 16 * j, nk = t0 + 16, ntile = (nk + 31) >> 5;
    LAS float* S = (LAS float*)(F.lds + RING_OFF);
    LAS float* WQ = (LAS float*)(F.lds + RING_OFF + 131072);
    LAS unsigned long long* MSK = (LAS unsigned long long*)(F.lds + RING_OFF + 131072 + 512);
    LAS unsigned* HW = (LAS unsigned*)(F.lds + RING_OFF + 131072 + 512 + 4096) + wid * 512;
    const bf16* QI = WSP(bf16, WS_QI); const bf16* KIB = WSP(bf16, WS_KIB); const float* WIp = WSP(float, WS_WI);
    unsigned long long* MASK = WSP(unsigned long long, WS_MASK);
    const size_t rowb = (size_t)b * SEQ;
    for (int rep43 = 0; rep43 < (PROBE_DUP == 43 ? 2 : 1); ++rep43)
    if (j >= 16) {
        if (tid < 128) WQ[tid] = pwq;
        const bf16* kbase = KIB + (rowb + r32) * 64 + 8 * hi;
#define IDX_LOADB(dst, kt_) do { const int kc_ = (kt_) < ntile ? (kt_) : ntile - 1; _Pragma("unroll") for (int s = 0; s < 4; ++s) dst[s] = *(const GAS bf16x8*)(kbase + (size_t)kc_ * 32 * 64 + 16 * s); } while (0)
#define IDX_COMPUTE(bf_, kt_) do { const int key = (kt_) * 32 + r32; \
            _Pragma("unroll") for (int rt = 0; rt < 4; ++rt) { f32x16 acc = {}; \
                _Pragma("unroll") for (int s = 0; s < 4; ++s) acc = __builtin_amdgcn_mfma_f32_32x32x16_bf16(a[rt][s], bf_[s], acc, 0, 0, 0); \
                _Pragma("unroll") for (int qp = 0; qp < 2; ++qp) { const int ql_ = 4 * rt + 2 * qp + hi;                      \
                    const f32x4 wa = *(const LAS f32x4*)(WQ + ql_ * 8), wb = *(const LAS f32x4*)(WQ + ql_ * 8 + 4); \
                    typedef float f2_ __attribute__((ext_vector_type(2))); const f2_ z2_ = {0.f, 0.f};                        \
                    f2_ s2_ = __builtin_elementwise_max((f2_){acc[8 * qp], acc[8 * qp + 1]}, z2_) * (f2_){wa[0], wa[1]}; \
                    s2_ = __builtin_elementwise_max((f2_){acc[8 * qp + 2], acc[8 * qp + 3]}, z2_) * (f2_){wa[2], wa[3]} + s2_; \
                    s2_ = __builtin_elementwise_max((f2_){acc[8 * qp + 4], acc[8 * qp + 5]}, z2_) * (f2_){wb[0], wb[1]} + s2_; \
                    s2_ = __builtin_elementwise_max((f2_){acc[8 * qp + 6], acc[8 * qp + 7]}, z2_) * (f2_){wb[2], wb[3]} + s2_; \
                    S[ql_ * 2048 + key] = (s2_.x + s2_.y) + 0.0f; } } } while (0)
        bf16x8 bfA[4], bfB[4];
        IDX_LOADB(bfA, wid);
        __syncthreads();
        for (int kt = wid; kt < ntile; kt += 16) {
            IDX_LOADB(bfB, kt + 8);
            IDX_COMPUTE(bfA, kt);
            if (kt + 8 < ntile) { IDX_LOADB(bfA, kt + 16); IDX_COMPUTE(bfB, kt + 8); }
        }
#undef IDX_LOADB
#undef IDX_COMPUTE
        __syncthreads();
    }
    if (nj >= 16) p4_index_preload(F, b, nj, a, pwq);
    bf16x8 ss_a[4]; f32x4 ss_w[4], ss_lo[4], ss_hh[4];
    { const bf16* qrow = QI + (size_t)(MP + 4 * ss_b + (r32 >> 3)) * 512 + (r32 & 7) * 64 + 8 * hi;
      const float* src = ((const float*)F.in[4]) + ((size_t)ss_page * PAGE + ss_sub * 32 + r32) * 64 + 8 * hi;
#pragma unroll
      for (int s = 0; s < 4; ++s) { ss_lo[s] = __builtin_nontemporal_load((const f32x4*)(src + 16 * s)); ss_hh[s] = __builtin_nontemporal_load((const f32x4*)(src + 16 * s + 4)); }
#pragma unroll
      for (int s = 0; s < 4; ++s) ss_a[s] = *(const GAS bf16x8*)(qrow + 16 * s);
#pragma unroll
      for (int q = 0; q < 4; ++q) ss_w[q] = *(const GAS f32x4*)(WIp + (size_t)(MP + 4 * ss_b + q) * 8 + 4 * hi); }
#pragma unroll 1
    for (int qq = 0; qq < (PROBE_DUP == 44 ? 4 : 2); ++qq) {
        const int ql = 2 * wid + (qq & 1), t = t0 + ql;
        unsigned wlo = 0u, whi = 0u;
        if (t < KTOP) {
            const int lo_ = 64 * lane; const unsigned long long w_ = (lo_ + 63 <= t) ? ~0ull : (lo_ > t ? 0ull : ((1ull << (t - lo_ + 1)) - 1ull));
            wlo = (unsigned)w_; whi = (unsigned)(w_ >> 32);
        } else {
            bool done = false;
            { unsigned kv[32]; float amf = 0.f;
              const int ngr = (t >> 8) + 1;
#pragma unroll
              for (int g4 = 0; g4 < 8; ++g4) {
#pragma unroll
                  for (int e = 0; e < 4; ++e) kv[4 * g4 + e] = 0u;
                  if (g4 < ngr) {
                      float s4[4];
#pragma unroll
                      for (int e = 0; e < 4; ++e) s4[e] = S[ql * 2048 + lane + 64 * (4 * g4 + e)];
                      if (g4 == ngr - 1) {
#pragma unroll
                          for (int e = 0; e < 4; ++e) s4[e] = (lane + 64 * (4 * g4 + e) <= t) ? s4[e] : 0.f; }
#pragma unroll
                      for (int e = 0; e < 4; ++e) { kv[4 * g4 + e] = __float_as_uint(s4[e]); amf = fmaxf(amf, fabsf(s4[e])); } } }
              const unsigned am = wave_umax(__float_as_uint(amf));
              const float scale = am ? 0.4999f / __uint_as_float(am) : 0.f;
#pragma unroll
              for (int g4 = 0; g4 < 8; ++g4) if (g4 < ngr) {
#pragma unroll
                  for (int e = 0; e < 4; ++e) { const int jj = 4 * g4 + e; kv[jj] = __float_as_uint(__builtin_fmaf(__uint_as_float(kv[jj]), scale, 1.5f)); }
                  if (g4 == ngr - 1) {
#pragma unroll
                      for (int e = 0; e < 4; ++e) { const int jj = 4 * g4 + e; kv[jj] = (lane + 64 * jj <= t) ? kv[jj] : 0u; } } }
              unsigned pfx = 0x3F800000u, Tv = 0u; int need = KTOP;
              const unsigned hwb = (unsigned)(uintptr_t)HW;
#pragma unroll 1
              for (int pass = 0; pass < 3; ++pass) {
                  const int sh = pass == 0 ? 14 : pass == 1 ? 5 : 0;
                  const unsigned lim = pass == 2 ? 32u : (512u << sh);
                  *(LAS v4u*)(HW + 8 * lane) = (v4u){0u, 0u, 0u, 0u}; *(LAS v4u*)(HW + 8 * lane + 4) = (v4u){0u, 0u, 0u, 0u};
                  asm volatile("" ::: "memory");
#pragma unroll
                  for (int g4 = 0; g4 < 8; ++g4) if (g4 < ngr) {
#pragma unroll
                      for (int e = 0; e < 4; ++e) { const unsigned d_ = kv[4 * g4 + e] ^ pfx;
                          if (d_ < lim) __hip_atomic_fetch_add((LAS unsigned*)(uintptr_t)(hwb + ((d_ >> sh) << 2)), 1u, __ATOMIC_RELAXED, __HIP_MEMORY_SCOPE_WAVEFRONT); } }
                  asm volatile("" ::: "memory");
                  const v4u w0 = *(const LAS v4u*)(HW + 8 * lane), w1 = *(const LAS v4u*)(HW + 8 * lane + 4);
                  asm volatile("" ::: "memory");
                  const unsigned ls = ((w0[0] + w0[1]) + (w0[2] + w0[3])) + ((w1[0] + w1[1]) + (w1[2] + w1[3]));
                  unsigned p = ls;
                  p += (unsigned)__builtin_amdgcn_update_dpp(0, (int)p, 0x111, 0xF, 0xF, false);
                  p += (unsigned)__builtin_amdgcn_update_dpp(0, (int)p, 0x112, 0xF, 0xF, false);
                  p += (unsigned)__builtin_amdgcn_update_dpp(0, (int)p, 0x114, 0xF, 0xF, false);
                  p += (unsigned)__builtin_amdgcn_update_dpp(0, (int)p, 0x118, 0xF, 0xF, false);
                  const unsigned r0 = (unsigned)__builtin_amdgcn_readlane((int)p, 15), r1 = (unsigned)__builtin_amdgcn_readlane((int)p, 31), r2 = (unsigned)__builtin_amdgcn_readlane((int)p, 47), r3 = (unsigned)__builtin_amdgcn_readlane((int)p, 63);
                  const int row_ = lane >> 4; p += (row_ == 0) ? 0u : (row_ == 1) ? r0 : (row_ == 2) ? r0 + r1 : r0 + r1 + r2;
                  const unsigned tot = r0 + r1 + r2 + r3;
                  const unsigned abl = tot - p;
                  const unsigned long long fm = __ballot((int)abl < need && (int)(abl + ls) >= need);
                  const int src = (int)__builtin_ctzll(fm);
                  const unsigned abs_ = (unsigned)__builtin_amdgcn_readlane((int)abl, src);
                  const unsigned ci = ((lane & 15) < 8) ? HW[8 * src + (lane & 7)] : 0u;
                  unsigned sfx = ci;
                  sfx += (unsigned)__builtin_amdgcn_update_dpp(0, (int)sfx, 0x101, 0xF, 0xF, false);
                  sfx += (unsigned)__builtin_amdgcn_update_dpp(0, (int)sfx, 0x102, 0xF, 0xF, false);
                  sfx += (unsigned)__builtin_amdgcn_update_dpp(0, (int)sfx, 0x104, 0xF, 0xF, false);
                  const unsigned abi = abs_ + sfx - ci;
                  const unsigned long long fb = __ballot(lane < 8 && (int)abi < need && (int)(abi + ci) >= need);
                  const int sl2 = (int)__builtin_ctzll(fb);
                  const unsigned dgb = (unsigned)(8 * src + sl2), above = (unsigned)__builtin_amdgcn_readlane((int)abi, sl2), binc = (unsigned)__builtin_amdgcn_readlane((int)ci, sl2);
                  pfx |= dgb << sh; need -= (int)above; Tv = pfx;
                  if ((int)binc == need) { done = true; break; }
              }
              if (done) {
#pragma unroll
                  for (int j4 = 0; j4 < 8; ++j4) if (j4 < ngr) {
                      const unsigned long long wa = __ballot(kv[4 * j4] >= Tv), wb = __ballot(kv[4 * j4 + 1] >= Tv), wc_ = __ballot(kv[4 * j4 + 2] >= Tv), wd = __ballot(kv[4 * j4 + 3] >= Tv);
                      asm("s_nop 1\n\tv_writelane_b32 %0, %2, %10\n\tv_writelane_b32 %1, %3, %10\n\tv_writelane_b32 %0, %4, %11\n\tv_writelane_b32 %1, %5, %11\n\tv_writelane_b32 %0, %6, %12\n\tv_writelane_b32 %1, %7, %12\n\tv_writelane_b32 %0, %8, %13\n\tv_writelane_b32 %1, %9, %13"
                          : "+v"(wlo), "+v"(whi) : "s"((unsigned)wa), "s"((unsigned)(wa >> 32)), "s"((unsigned)wb), "s"((unsigned)(wb >> 32)), "s"((unsigned)wc_), "s"((unsigned)(wc_ >> 32)), "s"((unsigned)wd), "s"((unsigned)(wd >> 32)),
                            "n"(4 * j4), "n"(4 * j4 + 1), "n"(4 * j4 + 2), "n"(4 * j4 + 3));
                  }
              }
            }
            if (!done) {
            unsigned uu[32];
#pragma unroll
            for (int jj = 0; jj < 32; ++jj) { const float s = S[ql * 2048 + lane + 64 * jj]; const unsigned k_ = fkey(s); uu[jj] = (lane + 64 * jj <= t) ? k_ : 0u; }
            const int ng = (t >> 8) + 1;
#define SEL_GRP(g4, CAND) if ((g4) < ng) { unsigned long long m0_, m1_, m2_, m3_; \
                    asm volatile("v_cmp_ge_u32_e64 %0, %4, %8\n\tv_cmp_ge_u32_e64 %1, %5, %8\n\tv_cmp_ge_u32_e64 %2, %6, %8\n\tv_cmp_ge_u32_e64 %3, %7, %8" \
                        : "=&s"(m0_), "=&s"(m1_), "=&s"(m2_), "=&s"(m3_) : "v"(uu[4 * (g4)]), "v"(uu[4 * (g4) + 1]), "v"(uu[4 * (g4) + 2]), "v"(uu[4 * (g4) + 3]), "v"(CAND)); \
                    cnt_ += __popcll(m0_) + __popcll(m1_) + __popcll(m2_) + __popcll(m3_); }
#define SEL_COUNT(CAND, OUT) do { int cnt_ = 0; SEL_GRP(0, CAND) SEL_GRP(1, CAND) SEL_GRP(2, CAND) SEL_GRP(3, CAND) SEL_GRP(4, CAND) SEL_GRP(5, CAND) SEL_GRP(6, CAND) SEL_GRP(7, CAND) OUT = cnt_; } while (0)
            unsigned T = 0u; int clo = t + 1;
#pragma unroll 1
            for (int bit = 31; bit >= 0; --bit) {
                const unsigned cand = T | (1u << bit); int c; SEL_COUNT(cand, c);
                if (c >= KTOP) { T = cand; clo = c; if (c == KTOP) break; }
            }
            if (clo == KTOP) {
#pragma unroll
                for (int jj = 0; jj < 32; ++jj) { const unsigned long long word = __ballot(uu[jj] >= T);
                    asm("s_nop 1\n\tv_writelane_b32 %0, %2, %4\n\tv_writelane_b32 %1, %3, %4" : "+v"(wlo), "+v"(whi) : "s"((unsigned)word), "s"((unsigned)(word >> 32)), "n"(jj));     }
            } else {
                int cgt; { const unsigned Tp = T + 1u; SEL_COUNT(Tp, cgt); }
                const int need = KTOP - cgt; int running = 0;
#pragma unroll
                for (int jj = 0; jj < 32; ++jj) {
                    const unsigned long long eq = __ballot(uu[jj] == T);
                    const int rank = (int)__builtin_amdgcn_mbcnt_hi((unsigned)(eq >> 32), __builtin_amdgcn_mbcnt_lo((unsigned)eq, 0u));
                    const unsigned long long word = __ballot(uu[jj] > T || (uu[jj] == T && running + rank < need));
                    asm("s_nop 1\n\tv_writelane_b32 %0, %2, %4\n\tv_writelane_b32 %1, %3, %4" : "+v"(wlo), "+v"(whi) : "s"((unsigned)word), "s"((unsigned)(word >> 32)), "n"(jj));
                    running += __popcll(eq);
                }
            }
            }
#undef SEL_COUNT
#undef SEL_GRP
        }
        if (lane < 32) MSK[ql * 32 + lane] = ((unsigned long long)whi << 32) | wlo;
    }
    if (ss_on) { f32x16 acc = {};
#pragma unroll
        for (int s = 0; s < 4; ++s) { v4u p; p.x = pk2(ss_lo[s][0], ss_lo[s][1]); p.y = pk2(ss_lo[s][2], ss_lo[s][3]); p.z = pk2(ss_hh[s][0], ss_hh[s][1]); p.w = pk2(ss_hh[s][2], ss_hh[s][3]);
            acc = __builtin_amdgcn_mfma_f32_32x32x16_bf16(ss_a[s], __builtin_bit_cast(bf16x8, p), acc, 0, 0, 0); }
        float* SSC = WSP(float, WS_SSC);
#pragma unroll
        for (int q = 0; q < 4; ++q) {
            float sum = ss_w[q][0] * fmaxf(acc[4 * q], 0.f) + ss_w[q][1] * fmaxf(acc[4 * q + 1], 0.f) + ss_w[q][2] * fmaxf(acc[4 * q + 2], 0.f) + ss_w[q][3] * fmaxf(acc[4 * q + 3], 0.f);
            sum = xhalf_sum(sum) + 0.0f;
            if ((q >> 1) == hi) SSC[(size_t)(4 * ss_b + q) * SSTR + ss_pg * PAGE + ss_sub * 32 + r32] = sum;
        } }
    __syncthreads();
    { const int jt = tid >> 4, ql = tid & 15; MASK[((size_t)b * 32 + jt) * SEQ + t0 + ql] = MSK[ql * 32 + jt]; }
    __syncthreads();
}
__device__ __forceinline__ void p4_index(Frame& F) {
    if (F.vcu >= 256) return;
    const int b = F.vcu >> 4, w = F.vcu & 15;
    bf16x8 pa[4][4]; float pwq;
    p4_index_preload(F, b, 127 - w, pa, pwq);
#pragma unroll 1
    for (int k = 0; k < 4; ++k) { const int j1 = w + 16 * k; p4_index_unit(F, b, 127 - j1, 2 * k, pa, pwq, j1); p4_index_unit(F, b, j1, 2 * k + 1, pa, pwq, k < 3 ? 127 - (j1 + 16) : -1); }
}

__device__ __forceinline__ int block_sum8(LAS int* red, int par, int wid, int lane, int v) {
    if (lane == 0) red[par * 8 + wid] = v;
    __syncthreads();
    int s = 0;
#pragma unroll
    for (int w = 0; w < 8; ++w) s += red[par * 8 + w];
    return s;
}
__device__ __forceinline__ void p5_sample_unit(Frame& F, int sq) {
    const int tid = F.tid, lane = F.lane, wid = F.wave;
    const int b = sq >> 2, qi_ = sq & 3, row = MP + sq;
    LAS unsigned char* L0 = F.lds + RING_OFF;
    LAS int* red = (LAS int*)(L0);
    LAS float* newsc = (LAS float*)(L0 + 64);
    LAS int* wcnt = (LAS int*)(L0 + 128);
    LAS int* eqw = (LAS int*)(L0 + 256);
    LAS int* selidx = (LAS int*)(L0 + 2048);
    LAS float* LG = (LAS float*)(L0 + 4096);
    LAS float* OP = (LAS float*)(L0 + 16384);
    const bf16* QI = WSP(bf16, WS_QI); const bf16* KIB = WSP(bf16, WS_KIB); const float* WIp = WSP(float, WS_WI); const float* SSC = WSP(float, WS_SSC);
    const bf16* Qb = WSP(bf16, WS_Q); bf16* CAT = WSP(bf16, WS_CAT);
    if (tid < 64) {
        const int h = (tid >> 2) & 7, jn = tid & 3; float dot = 0.f;
        const bf16* qp = QI + (size_t)row * 512 + h * 64; const bf16* kp = KIB + (size_t)(MP + 4 * b + jn) * 64;
        for (int d = 0; d < 64; ++d) dot += bf2f(qp[d]) * bf2f(kp[d]);
        float v = WIp[(size_t)row * 8 + h] * fmaxf(dot, 0.f);
        v += __shfl_xor(v, 4); v += __shfl_xor(v, 8); v += __shfl_xor(v, 16);
        if (tid < 4) newsc[tid] = (jn <= qi_) ? (v + 0.0f) : -INFINITY;
    }
    __syncthreads();
    unsigned uu[33];
#pragma unroll
    for (int jj = 0; jj < 32; ++jj) uu[jj] = fkey(SSC[(size_t)sq * SSTR + tid + 512 * jj]);
    uu[32] = tid < 4 ? fkey(newsc[tid]) : 0x007FFFFFu;
    unsigned T = 0u; int par = 0;
#pragma unroll 1
    for (int bit = 31; bit >= 0; --bit) {
        const unsigned cand = T | (1u << bit); int c = 0;
#pragma unroll
        for (int jj = 0; jj < 33; ++jj) c += __popcll(__ballot(uu[jj] >= cand));
        c = block_sum8(red, par, wid, lane, c); par ^= 1;
        if (c >= KTOP) { T = cand; if (c == KTOP) break; }
    }
    int cgt = 0;
#pragma unroll
    for (int jj = 0; jj < 33; ++jj) cgt += __popcll(__ballot(uu[jj] > T));
    cgt = block_sum8(red, par, wid, lane, cgt); par ^= 1;
    const int need = KTOP - cgt;
#pragma unroll
    for (int jj = 0; jj < 33; ++jj) { const int n = __popcll(__ballot(uu[jj] == T)); if (lane == 0) eqw[jj * 8 + wid] = n; }
    __syncthreads();
#define SEL_MASK(jj, eqbase, M) do { int below_ = 0, tot_ = 0; \
        _Pragma("unroll") for (int w = 0; w < 8; ++w) { const int n_ = eqw[(jj) * 8 + w]; tot_ += n_; below_ += (w < wid) ? n_ : 0; } \
        const unsigned long long eq_ = __ballot(uu[jj] == T); \
        const int rank_ = (eqbase) + below_ + (int)__builtin_amdgcn_mbcnt_hi((unsigned)(eq_ >> 32), __builtin_amdgcn_mbcnt_lo((unsigned)eq_, 0u)); \
        M = __ballot(uu[jj] > T || (uu[jj] == T && rank_ < need)); (eqbase) += tot_; } while (0)
    { int cw = 0, eqbase = 0;
#pragma unroll
      for (int jj = 0; jj < 33; ++jj) { unsigned long long m; SEL_MASK(jj, eqbase, m); cw += __popcll(m); }
      if (lane == 0) wcnt[wid] = cw; }
    __syncthreads();
    { int base = 0, eqbase = 0;
#pragma unroll
      for (int w = 0; w < 8; ++w) base += (w < wid) ? wcnt[w] : 0;
#pragma unroll
      for (int jj = 0; jj < 33; ++jj) { unsigned long long m; SEL_MASK(jj, eqbase, m);
          const int pos = base + (int)__builtin_amdgcn_mbcnt_hi((unsigned)(m >> 32), __builtin_amdgcn_mbcnt_lo((unsigned)m, 0u));
          if ((m >> lane) & 1ull) { if (pos < KTOP) selidx[pos] = (jj < 32) ? tid + 512 * jj : PAST + tid; }
          base += __popcll(m); } }
#undef SEL_MASK
    __syncthreads();
    const int kk = lane >> 3, ds = lane & 7;
    const float* kptr[4]; const float* vptr[4];
#pragma unroll
    for (int it = 0; it < 4; ++it) {
        const int kidx = selidx[32 * wid + 8 * it + kk];
        if (kidx < PAST) { const size_t pr = (size_t)((const int*)F.in[6])[b * NPAGES + (kidx >> 7)] * PAGE + (kidx & 127); kptr[it] = ((const float*)F.in[2]) + pr * 128 + 8 * ds; vptr[it] = ((const float*)F.in[3]) + pr * 128 + 8 * ds; }
        else { const size_t nr = (size_t)(4 * b + (kidx - PAST)); kptr[it] = F.out + O_KS + nr * 128 + 8 * ds; vptr[it] = F.out + O_VS + nr * 128 + 8 * ds; }
    }
#pragma unroll 1
    for (int g = 0; g < 2; ++g) {
        float qv[4][8];
#pragma unroll
        for (int r = 0; r < 4; ++r) { const v4u qq = *(const GAS v4u*)(Qb + (size_t)row * 512 + (4 * g + r) * 64 + 8 * ds);
#pragma unroll
            for (int e = 0; e < 4; ++e) { qv[r][2 * e] = bf2f((unsigned short)(qq[e] & 0xffffu)); qv[r][2 * e + 1] = bf2f((unsigned short)(qq[e] >> 16)); } }
#pragma unroll
        for (int it = 0; it < 4; ++it) {
            const f32x4 k0 = *(const f32x4*)(kptr[it] + 64 * g), k1 = *(const f32x4*)(kptr[it] + 64 * g + 4);
#pragma unroll
            for (int r = 0; r < 4; ++r) {
                float d = (qv[r][0] * k0[0] + qv[r][1] * k0[1]) + (qv[r][2] * k0[2] + qv[r][3] * k0[3]) + (qv[r][4] * k1[0] + qv[r][5] * k1[1]) + (qv[r][6] * k1[2] + qv[r][7] * k1[3]);
                d += __shfl_xor(d, 1); d += __shfl_xor(d, 2); d += __shfl_xor(d, 4);
                if (ds == 0) LG[(4 * g + r) * 256 + 32 * wid + 8 * it + kk] = d;
            }
        }
    }
    __syncthreads();
    { float l[4];
#pragma unroll
      for (int e = 0; e < 4; ++e) l[e] = LG[wid * 256 + lane + 64 * e];
      const float m = wave_max(fmaxf(fmaxf(l[0], l[1]), fmaxf(l[2], l[3])));
      float p[4], s = 0.f;
#pragma unroll
      for (int e = 0; e < 4; ++e) { p[e] = __builtin_amdgcn_exp2f(l[e] - m); s += p[e]; }
      s = wave_sum(s); const float inv = 1.0f / s;
#pragma unroll
      for (int e = 0; e < 4; ++e) LG[wid * 256 + lane + 64 * e] = p[e] * inv; }
    __syncthreads();
#pragma unroll 1
    for (int g = 0; g < 2; ++g) {
        float acc[4][8];
#pragma unroll
        for (int r = 0; r < 4; ++r)
#pragma unroll
            for (int e = 0; e < 8; ++e) acc[r][e] = 0.f;
#pragma unroll
        for (int it = 0; it < 4; ++it) {
            const f32x4 v0 = *(const f32x4*)(vptr[it] + 64 * g), v1 = *(const f32x4*)(vptr[it] + 64 * g + 4);
#pragma unroll
            for (int r = 0; r < 4; ++r) { const float p = LG[(4 * g + r) * 256 + 32 * wid + 8 * it + kk];
#pragma unroll
                for (int e = 0; e < 4; ++e) { acc[r][e] += p * v0[e]; acc[r][4 + e] += p * v1[e]; } }
        }
#pragma unroll
        for (int r = 0; r < 4; ++r)
#pragma unroll
            for (int e = 0; e < 8; ++e) { float a = acc[r][e]; a += __shfl_xor(a, 8); a += __shfl_xor(a, 16); a += __shfl_xor(a, 32); if (kk == 0) OP[(wid * 8 + 4 * g + r) * 64 + 8 * ds + e] = a; }
    }
    __syncthreads();
    { const int hd = tid >> 6, d = tid & 63; float o = 0.f;
#pragma unroll
      for (int w = 0; w < 8; ++w) o += OP[(w * 8 + hd) * 64 + d];
      CAT[(size_t)row * D + 512 + hd * 64 + d] = (bf16)f2bf(o); }
    __syncthreads();
}

constexpr int N_PHASES = 9;
struct Args { const void* in[22]; float* out; unsigned char* ws; int ph_lo, ph_hi, use_bar, pad; };
__global__ void __launch_bounds__(512, 2) hymba_fwd(Args args) {
    extern __shared__ __attribute__((aligned(16))) unsigned char lds[];
    Frame F;
    F.lds = (LAS unsigned char*)lds;
    F.MISC = (volatile LAS unsigned*)(F.lds + MISC_OFF);
    F.tid = threadIdx.x; F.lane = F.tid & 63; F.wave = __builtin_amdgcn_readfirstlane(F.tid >> 6);
    F.G = gridDim.x; { const int bx = blockIdx.x; F.vcu = (F.G % 8 == 0) ? (bx % 8) * (F.G / 8) + bx / 8 : bx; }
    F.ws = args.ws; F.out = args.out; F.ctl = (gu32*)(args.ws + WS_CTL);
    F.in = args.in;
    for (int u = F.tid; u < (LDS_BYTES - LDSCTL_OFF) / 4; u += 512) ((LAS unsigned*)(F.lds + LDSCTL_OFF))[u] = 0u;
    __syncthreads();
    XcdBarrier bar; bar.bar = (unsigned*)(F.ctl + CW_BAR); bar.x = 0; bar.st = nullptr;
    if (args.use_bar) bar = xcd_barrier_post((unsigned*)(F.ctl + CW_BAR), F.MISC + 8);
    const int lo = args.ph_lo, hi = args.ph_hi;
#define IN(k) (lo <= (k) && (k) < hi)
#define SEAM(k) do { if (IN(k) && IN((k) + 1)) { xcd_barrier(bar); if (PROBE_DUP == 60) xcd_barrier(bar); } } while (0)
    const int cblk = (int)blockIdx.x;

#ifndef PROBE_DUP
#define PROBE_DUP (-1)
#endif
#define RUNPHASE(k, ...) do { if (IN(k)) { { int t_ = F.tid; asm volatile("" : "+v"(t_)); F.tid = t_; F.lane = t_ & 63; }     \
        __VA_ARGS__; if (PROBE_DUP == (k)) { if (args.use_bar) xcd_barrier(bar); __VA_ARGS__; } } SEAM(k); } while (0)
#define RSTAB ((LAS float*)(F.lds + RING_OFF + 131072))
#define GEMM_PHASE(EPI, A_, B_, N_, K_, SS_, NSLOT_, ...) do { pg8::Gemm g{A_, B_, MP, N_, K_}; pg8::StaticOrder S; S.init(MP, N_, F.G, cblk); \
        if ((NSLOT_) > 0) fill_rstd_table(RSTAB, S, SS_, NSLOT_); \
        EPI E{__VA_ARGS__}; \
        pg8::gemm_phase<EPI, pg8::StaticOrder, true, true>(F.lds + RING_OFF, g, S, E); \
        skinny_phase(F.lds + RING_OFF, A_, B_, N_, K_, cblk, F.G, E); if (PROBE_DUP == 50) skinny_phase(F.lds + RING_OFF, A_, B_, N_, K_, cblk, F.G, E); } while (0)
#define GEMM_PHASE8(EPI, A8_, B8_, A_, B_, N_, K_, SS_, NSLOT_, ...) do { pg8::Gemm g{(const bf16*)(A8_), (const bf16*)(B8_), MP, N_, (K_) / 2}; pg8::StaticOrder S; S.init(MP, N_, F.G, cblk); \
        if ((NSLOT_) > 0) fill_rstd_table(RSTAB, S, SS_, NSLOT_); \
        EPI E{__VA_ARGS__}; \
        pg8::gemm_phase<EPI, pg8::StaticOrder, true, true, 1>(F.lds + RING_OFF, g, S, E); \
        skinny_phase(F.lds + RING_OFF, A_, B_, N_, K_, cblk, F.G, E); if (PROBE_DUP == 52) skinny_phase(F.lds + RING_OFF, A_, B_, N_, K_, cblk, F.G, E); } while (0)
#define GEMM_PHASEI(EPI, A8_, B8_, XS_, A_, B_, N_, K_, SS_, NSLOT_, ...) do { pg8::Gemm g{(const bf16*)(A8_), (const bf16*)(B8_), MP, N_, (K_) / 2}; pg8::StaticOrder S; S.init(MP, N_, F.G, cblk); \
        fill_rstd_table(RSTAB, S, SS_, NSLOT_, XS_); \
        EPI E{__VA_ARGS__}; \
        pg8::gemm_phase<EPI, pg8::StaticOrder, true, true, 2>(F.lds + RING_OFF, g, S, E); \
        skinny_phase(F.lds + RING_OFF, A_, B_, N_, K_, cblk, F.G, E); if (PROBE_DUP == 52) skinny_phase(F.lds + RING_OFF, A_, B_, N_, K_, cblk, F.G, E); } while (0)
    RUNPHASE(0, do { p0_prologue(F); xcd_barrier(bar); p0b_quant_weights(F, false, F.vcu * 8 + F.wave, F.G * 8); } while (0));
    RUNPHASE(1, GEMM_PHASEI(EpiGU, WSP(unsigned char, WS_XI8), WSP(unsigned char, WS_WGU1I8), WSP(float, WS_XS), WSP(bf16, WS_XB), WSP(bf16, WS_WGU1), 2 * DFF, D, WSP(float, WS_SS0), 1, WSP(bf16, WS_H), WSP(float, WS_SS0), 1, RSTAB, 1.0f, WSP(unsigned char, WS_H8), WSP(float, WS_WSN)));
    RUNPHASE(2, do { GEMM_PHASE8(EpiRes<0>, WSP(unsigned char, WS_H8), WSP(unsigned char, WS_WD1_8), WSP(bf16, WS_H), WSP(bf16, WS_WD1), D, DFF, nullptr, 0, WSP(bf16, WS_XB), nullptr, WSP(bf16, WS_X1B), WSP(float, WS_SS1), nullptr, 1.0f / (W8SCALE * H8SCALE));
                     if (cblk >= 32) p0b_quant_weights(F, true, (cblk - 32) * 8 + F.wave, (F.G - 32) * 8); } while (0));
#if PROBE_DUP >= 21 && PROBE_DUP <= 23
    if (IN(2)) { xcd_barrier(bar); pg8::Gemm g{(const bf16*)WSP(unsigned char, WS_H8), (const bf16*)WSP(unsigned char, WS_WD1_8), MP, D, DFF / 2}; pg8::StaticOrder S; S.init(MP, D, F.G, cblk);
        EpiRes<0> E{WSP(bf16, WS_XB), nullptr, WSP(bf16, WS_X2B), WSP(float, WS_SS2), nullptr, 1.0f / (W8SCALE * H8SCALE)};
        pg8::gemm_phase<EpiRes<0>, pg8::StaticOrder, true, true, (PROBE_DUP == 21 ? 1 : PROBE_DUP == 22 ? 2 : 0)>(F.lds + RING_OFF, g, S, E); xcd_barrier(bar); }
#endif
    RUNPHASE(3, GEMM_PHASE(EpiWin, WSP(bf16, WS_X1B), WSP(bf16, WS_WIN), NINP, D, WSP(float, WS_SS1), 16, F.ws, F.out, (const float*)F.in[15], (const float*)F.in[16], RSTAB));
    RUNPHASE(4, do { p4_conv(F); if (PROBE_DUP == 40) p4_conv(F); p4_index(F); if (PROBE_DUP == 42) p4_index(F); } while (0));
    RUNPHASE(5, do { if ((F.vcu & 1) == 0 && F.vcu < 256) { p5_sample_unit(F, F.vcu >> 1); if (PROBE_DUP == 51) p5_sample_unit(F, F.vcu >> 1); }
        const attn_body::AttnTensors AT{(const attn_body::bf16*)WSP(bf16, WS_Q), (const attn_body::bf16*)WSP(bf16, WS_KB), (const attn_body::bf16*)WSP(bf16, WS_VB), WSP(unsigned long long, WS_MASK), (attn_body::bf16*)WSP(bf16, WS_CAT)};
        const attn_body::StaticOrder S(F.vcu); attn_body::attn_phase<attn_body::StaticOrder>((char*)lds + RING_OFF, AT, S); } while (0));
    RUNPHASE(6, do { GEMM_PHASE(EpiRes<1>, WSP(bf16, WS_CAT), WSP(bf16, WS_WOUT), D, D, nullptr, 0, WSP(bf16, WS_X1B), nullptr, WSP(bf16, WS_X2B), WSP(float, WS_SS2), nullptr, 1.0f);
                     xcd_barrier(bar); quant_rows_pass(F.vcu * 8 + F.wave, F.G * 8, WSP(bf16, WS_X2B), WSP(unsigned char, WS_X2I8), WSP(float, WS_XS2), MP); } while (0));
    RUNPHASE(7, GEMM_PHASEI(EpiGU, WSP(unsigned char, WS_X2I8), WSP(unsigned char, WS_WGU2I8), WSP(float, WS_XS2), WSP(bf16, WS_X2B), WSP(bf16, WS_WGU2), 2 * DFF, D, WSP(float, WS_SS2), 16, WSP(bf16, WS_H), WSP(float, WS_SS2), 16, RSTAB, 1.0f, WSP(unsigned char, WS_H8), WSP(float, WS_WSN2)));
    RUNPHASE(8, GEMM_PHASE8(EpiRes<2>, WSP(unsigned char, WS_H8), WSP(unsigned char, WS_WD2_8), WSP(bf16, WS_H), WSP(bf16, WS_WD2), D, DFF, nullptr, 0, WSP(bf16, WS_X2B), F.out, nullptr, nullptr, nullptr, 1.0f / (W8SCALE * H8SCALE)));
#undef RUNPHASE
#undef GEMM_PHASE
#undef GEMM_PHASE8
#undef GEMM_PHASEI
#undef RSTAB
#undef IN
#undef SEAM
}

#ifndef MK_N_LAUNCHES
#define MK_N_LAUNCHES 1
#endif
extern "C" void kernel_launch(void* const* d_in, const int* in_sizes, int n_in, void* d_out, int out_size, void* d_ws, size_t ws_size, hipStream_t stream) {
    static int grid = 0;
    if (grid == 0) {
        if (n_in != 22 || out_size != (int)O_END || ws_size < WS_END) { fprintf(stderr, "kernel_launch: unexpected problem: n_in %d out %d ws %zu (need %zu)\n", n_in, out_size, ws_size, (size_t)WS_END); grid = -1; return; }
        int dev = 0, cus = 0, per_cu = 0;
        if (hipGetDevice(&dev) != hipSuccess || hipDeviceGetAttribute(&cus, hipDeviceAttributeMultiprocessorCount, dev) != hipSuccess) { grid = -1; return; }
        if (hipFuncSetAttribute((const void*)hymba_fwd, hipFuncAttributeMaxDynamicSharedMemorySize, LDS_BYTES) != hipSuccess) { fprintf(stderr, "kernel_launch: hipFuncSetAttribute failed\n"); grid = -1; return; }
        if (hipOccupancyMaxActiveBlocksPerMultiprocessor(&per_cu, (const void*)hymba_fwd, 512, LDS_BYTES) != hipSuccess || per_cu < 1) { fprintf(stderr, "kernel_launch: occupancy query says %d blocks per CU\n", per_cu); (void)hipGetLastError(); grid = -1; return; }
        grid = cus;
        if (grid % 8 != 0 || grid < 8) { fprintf(stderr, "kernel_launch: unexpected CU count %d\n", cus); grid = -1; return; }
    }
    if (grid < 0) return;
    (void)hipMemsetAsync((char*)d_ws + WS_CTL, 0, CTL_ZERO_BYTES, stream);
    Args a{};
    for (int i = 0; i < 22; ++i) a.in[i] = d_in[i];
    a.out = (float*)d_out; a.ws = (unsigned char*)d_ws;
    if (MK_N_LAUNCHES == 1) { a.ph_lo = 0; a.ph_hi = N_PHASES; a.use_bar = 1; hipLaunchKernelGGL(hymba_fwd, dim3(grid), dim3(512), LDS_BYTES, stream, a); }
    else for (int p = 0; p < N_PHASES; ++p) { a.ph_lo = p; a.ph_hi = p + 1; a.use_bar = 0; hipLaunchKernelGGL(hymba_fwd, dim3(grid), dim3(512), LDS_BYTES, stream, a); }
}
```

```cpp
#include <hip/hip_runtime.h>
#include <cstdio>
#include <cstdint>
#include <type_traits>
namespace pg8 {
#define PG8_LAS __attribute__((address_space(3)))
typedef unsigned short bf16_t;
typedef short bf16x8 __attribute__((ext_vector_type(8)));
typedef float f32x4 __attribute__((ext_vector_type(4)));
typedef unsigned u32x4 __attribute__((ext_vector_type(4)));
constexpr int BM = 256, BK = 64, HALF = 128, HTB = HALF * BK * 2  , STAGE_BYTES = 8 * HTB, NXCD = 8, WGM = 8;

__host__ __device__ __forceinline__ int lds_byte(int r, int c) { const int st = (r >> 4) * 2 + (c >> 5), rr = r & 15, cc = c & 31, ob = rr * 64 + cc * 2; return st * 1024 + (ob ^ (((ob >> 9) & 1) << 5)); }
__host__ __device__ __forceinline__ void stage_rc(int b, int& R, int& C) { const int st = b / 1024, sb = b % 1024, swz = sb ^ (((sb >> 9) & 1) << 5); R = (st >> 1) * 16 + swz / 64; C = (st & 1) * 32 + (swz % 64) / 2; }
__host__ __device__ __forceinline__ int perm32(int rho) { const int n = rho >> 4, i = rho & 15; return 8 * (i >> 2) + 4 * n + (i & 3); }

struct Unit { int pm, pn; };
struct Gemm { const bf16_t* A; const bf16_t* Bt; int M, N, K; };

struct StaticOrder {
    int nM, nN, nwg, G, c;
    __host__ __device__ void init(int M, int N, int G_, int c_) { nM = M / BM; nN = N / BM; nwg = nM * nN; G = G_; c = c_; }
    __host__ __device__ bool next(int i, Unit& u) const {
        const long L = (long)i * G + c; if (L >= nwg) return false;
        int wgid = (int)L; { const int q = nwg / NXCD, r = nwg % NXCD, xcd = wgid % NXCD, off = wgid / NXCD; wgid = (xcd < r ? xcd * (q + 1) : r * (q + 1) + (xcd - r) * q) + off; }
        const int nig = WGM * nN, gid = wgid / nig, fm = gid * WGM, gsz = (nM - fm) < WGM ? (nM - fm) : WGM;
        u.pm = fm + ((wgid % nig) % gsz); u.pn = (wgid % nig) / gsz; return true;
    }
    __device__ __forceinline__ void a_ready(const Unit&) const {}
    __device__ __forceinline__ void done(const Unit&) const {}
};
__device__ __forceinline__ unsigned cvt_pk_bf16(float lo, float hi) { unsigned r; asm volatile("v_cvt_pk_bf16_f32 %0, %1, %2" : "=v"(r) : "v"(lo), "v"(hi)); return r; }
template <class Epi, class Sched, bool ALIGN_EPI = false, bool SP2 = false, int QM = 0, int PFD = 0>
__device__ __forceinline__ void gemm_phase(PG8_LAS unsigned char* lds, const Gemm g, const Sched& S, const Epi& E) {
    const int tid = threadIdx.x, wid = __builtin_amdgcn_readfirstlane(tid >> 6), lane = tid & 63, wr = wid >> 2, wc = wid & 3, fr = lane & 15, fq = lane >> 4;
    const int K = g.K, nt = K / BK;
    unsigned voffA[2], voffB[2];
#pragma unroll
    for (int i = 0; i < 2; ++i) { int R, C; stage_rc(tid * 16 + i * 8192, R, C); const int Rb = Epi::PERM ? ((R & ~31) + perm32(R & 31)) : R;
        voffA[i] = (unsigned)(R * K + C) * 2u; voffB[i] = (unsigned)(Rb * K + C) * 2u; }
    unsigned voffP[2];
#pragma unroll
    for (int i = 0; i < 2; ++i) voffP[i] = (unsigned)((32 * wid + 16 * i + (lane >> 2)) * K) * 2u + (unsigned)(lane & 3) * 4u;
#define PG8_PF(s2, kt) do { if constexpr (PFD != 0) { const char* p_ = ((kt) < nt) ? cA + (size_t)(kt) * kstep : nA + (size_t)((kt) - nt) * kstep; \
        __builtin_amdgcn_global_load_lds((const unsigned*)(p_ + voffP[s2]), (PG8_LAS unsigned*)(lds + 143360 + wid * 256), 4, 0, 0); } } while (0)
#define PG8_WAIT_V8() do { if constexpr (PFD != 0) PG8_WAIT_V(10); else PG8_WAIT_V(8); } while (0)
    const size_t kstep = (size_t)(BK * 2);
    const size_t hstep = (size_t)HALF * K * 2;
    const size_t tstep = 2 * hstep;
    const unsigned ldsw = (unsigned)wid * 1024u;
    const int aoff = lds_byte(wr * 64 + fr, fq * 8), boff = lds_byte(wc * 32 + fr, fq * 8);
#define PG8_SA(b, h) (((b) * 2 + (h)) * HTB)
#define PG8_SB(b, h) ((4 + (b) * 2 + (h)) * HTB)
#define PG8_STAGE(bufoff, gbase, voff) do { _Pragma("unroll") for (int _i = 0; _i < 2; ++_i) \
        __builtin_amdgcn_global_load_lds((const unsigned*)((const char*)(gbase) + (voff)[_i]), (PG8_LAS unsigned*)(lds + (bufoff) + ldsw + _i * 8192), 16, 0, 0); } while (0)
#define PG8_LDF(dst_, addr_) do { if constexpr (QM == 1) { const pg8_v4i lo_ = *(const PG8_LAS pg8_v4i*)(addr_), hi_ = *(const PG8_LAS pg8_v4i*)((addr_) + 1024); \
            (dst_).v = __builtin_shufflevector(lo_, hi_, 0, 1, 2, 3, 4, 5, 6, 7); } \
        else { (dst_).k[0] = *(const PG8_LAS bf16x8*)(addr_); (dst_).k[1] = *(const PG8_LAS bf16x8*)((addr_) + 1024); } } while (0)
#define PG8_LDA(dst, b, h) do { _Pragma("unroll") for (int m = 0; m < 4; ++m) PG8_LDF(dst[m], lds + PG8_SA(b, h) + aoff + m * 2048); } while (0)
#define PG8_LDB(dst, b, h) do { _Pragma("unroll") for (int n = 0; n < 2; ++n) PG8_LDF(dst[n], lds + PG8_SB(b, h) + boff + n * 2048); } while (0)
#define PG8_MMA(ai, bj, At, Bt) do { __builtin_amdgcn_s_setprio(1); if constexpr (QM != 0) asm volatile("s_nop 4");     \
        _Pragma("unroll") for (int m = 0; m < 4; ++m) _Pragma("unroll") for (int n = 0; n < 2; ++n) { \
            if constexpr (QM == 1) asm volatile("v_mfma_scale_f32_16x16x128_f8f6f4 %0, %1, %2, %0, %3, %3 op_sel_hi:[0,0,0]" : "+v"(acc[ai][bj][m][n]) : "v"(Bt[n].v), "v"(At[m].v), "v"(scl8_));     \
            else if constexpr (QM == 2) { _Pragma("unroll") for (int k = 0; k < 2; ++k) asm volatile("v_mfma_i32_16x16x64_i8 %0, %1, %2, %0" : "+v"(acc[ai][bj][m][n]) : "v"(Bt[n].k[k]), "v"(At[m].k[k])); } \
            else { _Pragma("unroll") for (int k = 0; k < 2; ++k) acc[ai][bj][m][n] = __builtin_amdgcn_mfma_f32_16x16x32_bf16(Bt[n].k[k], At[m].k[k], acc[ai][bj][m][n], 0, 0, 0); } } \
        __builtin_amdgcn_s_setprio(0); } while (0)
#define PG8_WAIT_V(n) asm volatile("s_waitcnt vmcnt(" #n ")" ::: "memory")
#define PG8_WAIT_L(n) asm volatile("s_waitcnt lgkmcnt(" #n ")" ::: "memory")
#define PG8_BAR __builtin_amdgcn_s_barrier()
#define PG8_SCHED __builtin_amdgcn_sched_barrier(0)
    Unit cur, nxt; int ui = 0;
    if (!S.next(0, cur)) return;
    f32x4 acc[2][2][4][2];
    E.init(acc, cur, wr, wc, fr, fq);
    typedef int pg8_v8i __attribute__((ext_vector_type(8))); typedef int pg8_v4i __attribute__((ext_vector_type(4)));
    struct FragB { bf16x8 k[2]; }; struct Frag8 { pg8_v8i v; };
    typedef typename std::conditional<QM == 1, Frag8, FragB>::type Frag;
    Frag At[4], B0[2], B1[2];
    unsigned scl8_ = 0x7F7F7F7Fu; asm volatile("" : "+v"(scl8_));
    const char* cA = (const char*)g.A + (size_t)cur.pm * tstep; const char* cB = (const char*)g.Bt + (size_t)cur.pn * tstep;
    S.a_ready(cur);
    if constexpr (SP2) {
        PG8_STAGE(PG8_SB(0, 0), cB, voffB); PG8_STAGE(PG8_SB(0, 1), cB + hstep, voffB); PG8_STAGE(PG8_SA(0, 0), cA, voffA); PG8_STAGE(PG8_SA(0, 1), cA + hstep, voffA);
        if (wr == 1) PG8_BAR;
        PG8_WAIT_V(2); PG8_BAR;
        PG8_STAGE(PG8_SB(1, 0), cB + kstep, voffB); PG8_STAGE(PG8_SA(1, 0), cA + kstep, voffA); PG8_STAGE(PG8_SB(1, 1), cB + hstep + kstep, voffB);
        PG8_WAIT_V(6); PG8_BAR;
    } else {
        PG8_STAGE(PG8_SB(0, 0), cB, voffB); PG8_STAGE(PG8_SA(0, 0), cA, voffA); PG8_STAGE(PG8_SB(0, 1), cB + hstep, voffB); PG8_STAGE(PG8_SA(0, 1), cA + hstep, voffA);
        if (wr == 1) PG8_BAR;
        PG8_WAIT_V(4); PG8_BAR;
        PG8_STAGE(PG8_SB(1, 0), cB + kstep, voffB); PG8_STAGE(PG8_SA(1, 0), cA + kstep, voffA); PG8_STAGE(PG8_SB(1, 1), cB + hstep + kstep, voffB);
        PG8_WAIT_V(6); PG8_BAR;
    }
    for (;;) {
        const bool has_next = S.next(ui + 1, nxt);
        const char* nA = has_next ? (const char*)g.A + (size_t)nxt.pm * tstep : cA; const char* nB = has_next ? (const char*)g.Bt + (size_t)nxt.pn * tstep : cB;
#pragma unroll 1
        for (int t = 0; t < nt; t += 2) {
            const bool last = (t == nt - 2);
            const char* a1 = cA + (size_t)(t + 1) * kstep;
            const char* a2 = last ? nA : cA + (size_t)(t + 2) * kstep; const char* b2 = last ? nB : cB + (size_t)(t + 2) * kstep;
            const char* a3 = a2 + kstep; const char* b3 = b2 + kstep;
            if (last && has_next) S.a_ready(nxt);
            if constexpr (SP2) {
            PG8_LDB(B0, 0, 0); PG8_LDB(B1, 0, 1); PG8_SCHED; PG8_LDA(At, 0, 0); PG8_STAGE(PG8_SA(1, 1), a1 + hstep, voffA); PG8_PF(0, t + PFD);
            PG8_WAIT_V8(); PG8_WAIT_L(0); PG8_BAR; PG8_MMA(0, 0, At, B0); PG8_MMA(0, 1, At, B1); PG8_BAR; PG8_SCHED;
            PG8_LDA(At, 0, 1); PG8_STAGE(PG8_SB(0, 0), b2, voffB); PG8_STAGE(PG8_SB(0, 1), b2 + hstep, voffB); PG8_STAGE(PG8_SA(0, 0), a2, voffA); PG8_PF(1, t + PFD);
            PG8_WAIT_V8(); PG8_WAIT_L(0); PG8_BAR; PG8_MMA(1, 0, At, B0); PG8_MMA(1, 1, At, B1); PG8_BAR; PG8_SCHED;
            PG8_LDB(B0, 1, 0); PG8_LDB(B1, 1, 1); PG8_SCHED; PG8_LDA(At, 1, 0); PG8_STAGE(PG8_SA(0, 1), a2 + hstep, voffA); PG8_PF(0, t + 1 + PFD);
            PG8_WAIT_V8(); PG8_WAIT_L(0); PG8_BAR; PG8_MMA(0, 0, At, B0); PG8_MMA(0, 1, At, B1); PG8_BAR; PG8_SCHED;
            PG8_LDA(At, 1, 1); PG8_STAGE(PG8_SB(1, 0), b3, voffB); PG8_STAGE(PG8_SB(1, 1), b3 + hstep, voffB); PG8_STAGE(PG8_SA(1, 0), a3, voffA); PG8_PF(1, t + 1 + PFD);
            PG8_WAIT_V8(); PG8_WAIT_L(0); PG8_BAR; PG8_MMA(1, 0, At, B0); PG8_MMA(1, 1, At, B1); PG8_BAR; PG8_SCHED;
            } else {
            PG8_LDB(B0, 0, 0); PG8_SCHED; PG8_LDA(At, 0, 0); PG8_STAGE(PG8_SA(1, 1), a1 + hstep, voffA);
            PG8_WAIT_L(8); PG8_BAR; PG8_WAIT_L(0); PG8_MMA(0, 0, At, B0); PG8_BAR; PG8_SCHED;
            PG8_LDB(B1, 0, 1); PG8_STAGE(PG8_SB(0, 0), b2, voffB);
            PG8_BAR; PG8_WAIT_L(0); PG8_MMA(0, 1, At, B1); PG8_BAR;
            PG8_LDA(At, 0, 1); PG8_STAGE(PG8_SA(0, 0), a2, voffA);
            PG8_BAR; PG8_WAIT_L(0); PG8_MMA(1, 0, At, B0); PG8_BAR; PG8_SCHED;
            PG8_STAGE(PG8_SB(0, 1), b2 + hstep, voffB);
            PG8_WAIT_V(6); PG8_BAR; PG8_MMA(1, 1, At, B1); PG8_BAR;
            PG8_LDB(B0, 1, 0); PG8_SCHED; PG8_LDA(At, 1, 0); PG8_STAGE(PG8_SA(0, 1), a2 + hstep, voffA);
            PG8_WAIT_L(8); PG8_BAR; PG8_WAIT_L(0); PG8_MMA(0, 0, At, B0); PG8_BAR; PG8_SCHED;
            PG8_LDB(B1, 1, 1); PG8_STAGE(PG8_SB(1, 0), b3, voffB);
            PG8_BAR; PG8_WAIT_L(0); PG8_MMA(0, 1, At, B1); PG8_BAR;
            PG8_LDA(At, 1, 1); PG8_STAGE(PG8_SA(1, 0), a3, voffA);
            PG8_BAR; PG8_WAIT_L(0); PG8_MMA(1, 0, At, B0); PG8_BAR; PG8_SCHED;
            PG8_STAGE(PG8_SB(1, 1), b3 + hstep, voffB);
            PG8_WAIT_V(6); PG8_BAR; PG8_MMA(1, 1, At, B1); PG8_BAR;
            }
        }
        if constexpr (ALIGN_EPI) { if (wr == 0) PG8_BAR; }
        if constexpr (QM != 0) asm volatile("s_nop 15\n\ts_nop 7" ::: "memory");
        if constexpr (!Epi::AFTER_DRAIN) { E(acc, cur, wr, wc, fr, fq, ui, has_next, nxt);
#if defined(PROBE_DUP) && PROBE_DUP == 61
            E(acc, cur, wr, wc, fr, fq, ui, has_next, nxt);
#endif
            S.done(cur); }
        if (!has_next) break;
        cur = nxt; cA = nA; cB = nB; ++ui;
        if constexpr (ALIGN_EPI) { if (wr == 1) PG8_BAR; }
    }
    PG8_WAIT_V(0);
    if constexpr (!ALIGN_EPI) { if (wr == 0) PG8_BAR; }
    PG8_BAR;
    if constexpr (Epi::AFTER_DRAIN) { E.fused(acc, cur, wr, wc, fr, fq, lds, wid, lane); S.done(cur); }
#undef PG8_SA
#undef PG8_PF
#undef PG8_WAIT_V8
#undef PG8_SB
#undef PG8_STAGE
#undef PG8_LDA
#undef PG8_LDF
#undef PG8_LDB
#undef PG8_MMA
#undef PG8_WAIT_V
#undef PG8_WAIT_L
#undef PG8_BAR
#undef PG8_SCHED
}
}
#include <hip/hip_bf16.h>
#include <cmath>
namespace attn_body {
using bf16=__hip_bfloat16;
using bf16x8=__attribute__((ext_vector_type(8)))short;
using s16x4=__attribute__((ext_vector_type(4)))short;
using f32x16=__attribute__((ext_vector_type(16)))float;
using u32x4=__attribute__((ext_vector_type(4)))unsigned;
constexpr int BATCH=16,NHEAD=8,SEQ=2048,D=64;
constexpr int QP=512,KP=128,OP=1024,OOFF=512;
constexpr int NW=8,QBLK=32,QB=QBLK*NW,KVBLK=64,NQB=SEQ/QB;
constexpr int ATTN_UNIT_ROWS=QB;
__device__ __forceinline__ int crow(int r,int hi){return (r&3)+8*(r>>2)+4*hi;}
#define SBAR() __builtin_amdgcn_sched_barrier(0)
#define MSKV(v,W,r) __uint_as_float(__float_as_uint(v)&(unsigned)(((int)((W)<<(31-(((r)&3)+8*((r)>>2)))))>>31))
__device__ __forceinline__ void cmask(f32x16&p0,f32x16&p1,int jb,int qrel,int hi){
  const float NEG=-INFINITY; int kb=64*jb+4*hi;
  #pragma unroll
  for(int r=0;r<16;++r){int kv=kb+(r&3)+8*(r>>2); if(kv>qrel)p0[r]=NEG; if(kv+32>qrel)p1[r]=NEG;}
}

constexpr int NSLOT=3, SLOTB=8192;
constexpr int LDS_K=0, LDS_V=NSLOT*SLOTB, LDS_WS=2*NSLOT*SLOTB, LDS_OST=LDS_WS+NW*64*4, LDS_MSK=LDS_OST+NW*4096, LDS_BYTES=LDS_MSK+NW*8192;
constexpr float C2=0.125f*1.4426950408889634f;
__device__ __forceinline__ void glds16(const void*gsrc,unsigned lds_dst){unsigned keep;
  asm volatile("s_mov_b32 %0, m0\n\ts_mov_b32 m0, %2\n\ts_nop 0\n\tglobal_load_lds_dwordx4 %1, off\n\ts_mov_b32 m0, %0":"=&s"(keep):"v"(gsrc),"s"(lds_dst):"memory");}
__device__ __forceinline__ float max3f(float a,float b,float c){float r;asm("v_max3_f32 %0, %1, %2, %3":"=v"(r):"v"(a),"v"(b),"v"(c));return r;}
__device__ __forceinline__ float max2f(float a,float b){float r;asm("v_max_f32_e32 %0, %1, %2":"=v"(r):"v"(a),"v"(b));return r;}
__device__ __forceinline__ float fadd_s(float a,float b){float r;asm("v_add_f32_e32 %0, %1, %2":"=v"(r):"v"(a),"v"(b));return r;}
__device__ __forceinline__ float fsub_s(float a,float b){float r;asm("v_sub_f32_e32 %0, %1, %2":"=v"(r):"v"(a),"v"(b));return r;}
typedef float f32x2_t __attribute__((ext_vector_type(2))); typedef __bf16 bf16x2_t __attribute__((ext_vector_type(2)));
__device__ __forceinline__ unsigned cvtpk_s(float lo,float hi){f32x2_t v={lo,hi};bf16x2_t b=__builtin_convertvector(v,bf16x2_t);return __builtin_bit_cast(unsigned,b);}
#define WAIT_BAR(N) asm volatile("s_waitcnt vmcnt(" #N ") lgkmcnt(0)\n\ts_barrier":::"memory")

__device__ __forceinline__ void qkt(f32x16&p0,f32x16&p1,const char*Kslot,const bf16x8*qr,const f32x16&negm,int r32,int hi){
  const char*kb=Kslot+hi*1024+r32*16;
  #pragma unroll
  for(int d0=0;d0<4;++d0){
    const bf16x8 b0=*reinterpret_cast<const bf16x8*>(kb+d0*2048);
    const bf16x8 b1=*reinterpret_cast<const bf16x8*>(kb+d0*2048+512);
    if(d0==0){p0=__builtin_amdgcn_mfma_f32_32x32x16_bf16(b0,qr[0],negm,0,0,0);p1=__builtin_amdgcn_mfma_f32_32x32x16_bf16(b1,qr[0],negm,0,0,0);}
    else{p0=__builtin_amdgcn_mfma_f32_32x32x16_bf16(b0,qr[d0],p0,0,0,0);p1=__builtin_amdgcn_mfma_f32_32x32x16_bf16(b1,qr[d0],p1,0,0,0);}}
}
typedef __attribute__((address_space(3))) const char* lds_cptr;
typedef short v4i16_t __attribute__((ext_vector_type(4)));
__device__ __forceinline__ void kload8(bf16x8*kf,lds_cptr kp){
  kf[0]=*(const __attribute__((address_space(3))) bf16x8*)(kp);      kf[1]=*(const __attribute__((address_space(3))) bf16x8*)(kp+512);
  kf[2]=*(const __attribute__((address_space(3))) bf16x8*)(kp+2048); kf[3]=*(const __attribute__((address_space(3))) bf16x8*)(kp+2560);
  kf[4]=*(const __attribute__((address_space(3))) bf16x8*)(kp+4096); kf[5]=*(const __attribute__((address_space(3))) bf16x8*)(kp+4608);
  kf[6]=*(const __attribute__((address_space(3))) bf16x8*)(kp+6144); kf[7]=*(const __attribute__((address_space(3))) bf16x8*)(kp+6656);
}
__device__ __forceinline__ void kload2(bf16x8*kf,lds_cptr kp,int j){ kf[2*j]=*(const __attribute__((address_space(3))) bf16x8*)(kp+j*2048); kf[2*j+1]=*(const __attribute__((address_space(3))) bf16x8*)(kp+j*2048+512); }
__device__ __forceinline__ s16x4 vtr(lds_cptr p){ return __builtin_bit_cast(s16x4,__builtin_amdgcn_ds_read_tr16_b64_v4i16((__attribute__((address_space(3))) v4i16_t*)p)); }
__device__ __forceinline__ float rowmax(const f32x16&p0,const f32x16&p1){
  float a=max3f(p0[0],p0[1],p1[0]),b=max3f(p0[2],p0[3],p1[1]);a=max3f(a,p1[2],p1[3]);
  #pragma unroll
  for(int r=4;r<16;r+=4){a=max3f(a,p0[r],p0[r+1]);b=max3f(b,p0[r+2],p0[r+3]);a=max3f(a,p1[r],p1[r+1]);b=max3f(b,p1[r+2],p1[r+3]);}
  const float m=max2f(a,b);
  auto rr=__builtin_amdgcn_permlane32_swap(__float_as_uint(m),__float_as_uint(m),false,false);
  return max2f(__uint_as_float(rr[0]),__uint_as_float(rr[1]));
}
__device__ __forceinline__ void pv(f32x16*o,int vb,bf16x8 pa0,bf16x8 pa1,bf16x8 pa2,bf16x8 pa3){
  #pragma unroll
  for(int d0=0;d0<2;++d0){s16x4 lo[4],hi[4];
    #pragma unroll
    for(int ks=0;ks<4;++ks){
      asm volatile("ds_read_b64_tr_b16 %0,%1 offset:%c2":"=&v"(lo[ks]):"v"(vb),"i"(d0*4096+ks*1024):"memory");
      asm volatile("ds_read_b64_tr_b16 %0,%1 offset:%c2":"=&v"(hi[ks]):"v"(vb),"i"(d0*4096+ks*1024+512):"memory");}
    asm volatile("s_waitcnt lgkmcnt(0)":::"memory");SBAR();
    #define PK(k) (bf16x8){lo[k][0],lo[k][1],lo[k][2],lo[k][3],hi[k][0],hi[k][1],hi[k][2],hi[k][3]}
    o[d0]=__builtin_amdgcn_mfma_f32_32x32x16_bf16(pa0,PK(0),o[d0],0,0,0);
    o[d0]=__builtin_amdgcn_mfma_f32_32x32x16_bf16(pa1,PK(1),o[d0],0,0,0);
    o[d0]=__builtin_amdgcn_mfma_f32_32x32x16_bf16(pa2,PK(2),o[d0],0,0,0);
    o[d0]=__builtin_amdgcn_mfma_f32_32x32x16_bf16(pa3,PK(3),o[d0],0,0,0);
    #undef PK
  }
}

#ifndef ATTN_STORE16
#define ATTN_STORE16(p,v) (*(u32x4*)(p)=(v))
#endif
template<int THRL> __device__ __forceinline__ void attn_unit(int b,int h,int qb,const bf16*Q,const bf16*K,const bf16*V,const unsigned long long*MK,bf16*O,char*shm){
  const int tid=threadIdx.x,lane=tid&63,r32=lane&31,hi=lane>>5; const int wid=__builtin_amdgcn_readfirstlane(tid>>6);
  const long rowbase=(long)b*SEQ; const int q0=qb*QB;
  const bf16*Qw=Q+(rowbase+q0+wid*QBLK)*QP+h*D;
  const bf16*Kh=K+rowbase*KP+(h>>2)*D,*Vh=V+rowbase*KP+(h>>2)*D;
  const unsigned lds0=(unsigned)(uintptr_t)shm;
  float*wsf=(float*)(shm+LDS_WS)+wid*64;
  const bf16*ksrc=Kh+(long)lane*KP+wid*8;
  const bf16*vsrc=Vh+(long)(16*(wid&3)+(lane>>2))*KP+(wid>>2)*32+(lane&3)*8;
  const unsigned kdst=lds0+LDS_K+wid*1024, vdst=lds0+LDS_V+wid*1024;
  #define DMA_K(t,slot) glds16(ksrc+(long)(t)*KVBLK*KP,(unsigned)__builtin_amdgcn_readfirstlane(kdst+(slot)))
  #define DMA_V(t,slot) glds16(vsrc+(long)(t)*KVBLK*KP,(unsigned)__builtin_amdgcn_readfirstlane(vdst+(slot)))
  const int vb0=(int)(lds0+LDS_V)+((lane>>4)&1)*32+(lane&3)*8+(4*hi+((lane&15)>>2))*64;
  const char*Kbase=shm+LDS_K; bf16x8 kf[8];
  const lds_cptr shm3=(lds_cptr)shm; const lds_cptr kp0=shm3+LDS_K+hi*1024+r32*16; const lds_cptr vp0=shm3+LDS_V+((lane>>4)&1)*32+(lane&3)*8+(4*hi+((lane&15)>>2))*64;
  const int NT=(q0+QB)/KVBLK;
  const __attribute__((address_space(3))) char* shm3m=(const __attribute__((address_space(3))) char*)shm;
  typedef __attribute__((address_space(3))) unsigned long long* lds_u64p;
  const lds_u64p mskw=(lds_u64p)(shm3m+LDS_MSK+wid*8192);
  unsigned long long mtmp[16];
  { const unsigned long long*mq=MK+(q0+wid*QBLK+r32);
    #pragma unroll
    for(int i=0;i<16;++i){int tt=2*i+hi; tt=tt<NT?tt:NT-1; mtmp[i]=mq[(long)tt*SEQ];} }
  DMA_K(0,0);DMA_V(0,0);DMA_K(1,SLOTB);
  bf16x8 qr[4];
  #pragma unroll
  for(int d0=0;d0<4;++d0)qr[d0]=*reinterpret_cast<const bf16x8*>(&Qw[(long)r32*QP+d0*16+hi*8]);
  float mhat=0.f,l_reg=0.f;f32x16 o[2];o[0]=f32x16{};o[1]=f32x16{};f32x16 negm=f32x16{};asm volatile("":"+v"(negm));
  const int qrel=wid*QBLK+r32;
  #define CMASK(P0,P1,t) do{int jb_=(t)-(NT-4); if(jb_>=0)cmask(P0,P1,jb_,qrel,hi);}while(0)
  bool resc=false;
  #define START(P0,P1) do{ const float rm=rowmax(P0,P1); resc=false; \
    { const float dl=rm; mhat=fadd_s(mhat,dl); \
      _Pragma("unroll") for(int r=0;r<16;++r){P0[r]=fsub_s(P0[r],dl);P1[r]=fsub_s(P1[r],dl);} \
      _Pragma("unroll") for(int r=0;r<16;++r)negm[r]=-mhat; asm volatile("":"+v"(negm)); } \
    _Pragma("unroll") for(int r=0;r<16;++r)P0[r]=__builtin_amdgcn_exp2f(P0[r]); }while(0)
  #define RESC() do{ if(resc){ asm volatile("s_waitcnt lgkmcnt(0)":::"memory"); \
      _Pragma("unroll") for(int d_=0;d_<2;++d_) _Pragma("unroll") for(int r=0;r<16;++r)o[d_][r]*=wsf[crow(r,hi)]; } }while(0)
  f32x16 pA0,pA1,pB0,pB1;
  int sl_prev=0,sl_cur=0,sl_next=SLOTB;
  #define ROT() do{sl_prev=sl_cur;sl_cur=sl_next;sl_next=(sl_next==(NSLOT-1)*SLOTB)?0:sl_next+SLOTB;}while(0)
  DMA_K(2,2*SLOTB);
  WAIT_BAR(3);
  #pragma unroll
  for(int i=0;i<16;++i)mskw[(2*i+hi)*32+r32]=mtmp[i];
  #define MLOAD(t,LO,HI) do{ const unsigned long long mw_=mskw[(t)*32+r32]; LO=((unsigned)mw_)>>(4*hi); HI=((unsigned)(mw_>>32))>>(4*hi); }while(0)
  unsigned mlo,mhi; MLOAD(0,mlo,mhi);
  qkt(pA0,pA1,Kbase,qr,negm,r32,hi);asm volatile("s_nop 15\n\ts_nop 7":"+v"(pA0),"+v"(pA1));
  START(pA0,pA1);
  _Pragma("unroll") for(int r=0;r<16;++r)pA1[r]=__builtin_amdgcn_exp2f(pA1[r]);
  _Pragma("unroll") for(int r=0;r<16;++r){pA0[r]=MSKV(pA0[r],mlo,r);pA1[r]=MSKV(pA1[r],mhi,r);}
  WAIT_BAR(0);
  DMA_K(3,0);DMA_V(1,SLOTB);
  ROT();
  kload8(kf,kp0+sl_cur);
  WAIT_BAR(2);
  s16x4 vlo[8],vhi[8]; u32x4 pw0,pw1,pw2,pw3;
  #define PKW(P,B) cvtpk_s(P[B],P[B+1])
  #define PAF(k) __builtin_bit_cast(bf16x8,pw##k)
  #define VFR(i) (bf16x8){vlo[i][0],vlo[i][1],vlo[i][2],vlo[i][3],vhi[i][0],vhi[i][1],vhi[i][2],vhi[i][3]}
  #define PIN(x) asm volatile("":"+v"(x))
  #define MX3(a,b,c) __builtin_fmaxf(__builtin_fmaxf((a),(b)),(c))
  #define GAPA(MF,A0,A1,A2,A3,W0,W1,PW) do{ MF; sacc+=A0; sacc+=A1; sacc+=A2; sacc+=A3; PIN(sacc); W0; W1; PIN(PW); SBAR(); }while(0)
  #define EX(v) __builtin_amdgcn_exp2f(v)
  #define GAPB(MF,X,B,W) do{ MF; X[B]=MSKV(EX(X[B]),W,B); X[B+1]=MSKV(EX(X[B+1]),W,B+1); X[B+2]=MSKV(EX(X[B+2]),W,B+2); X[B+3]=MSKV(EX(X[B+3]),W,B+3); PIN(X); SBAR(); }while(0)
  #define VRD(i) do{ vlo[i]=vtr(vp_+(((i)>>2)*4096+((i)&3)*1024)); vhi[i]=vtr(vp_+(((i)>>2)*4096+((i)&3)*1024+512)); }while(0)
  #define KRD(G,j) do{ if(G){ kload2(kf,kp0+sl_next,j); SBAR(); } }while(0)
  #define STEP(C0,C1,P0,P1,t,GK,GV,GL) do{ SBAR(); \
    const lds_cptr vp_=vp0+sl_prev; MLOAD(t,mlo,mhi); \
    VRD(0); SBAR(); float sacc=(P0[0]+P0[1]); \
    GAPA(C0=__builtin_amdgcn_mfma_f32_32x32x16_bf16(kf[0],qr[0],negm,0,0,0), P0[2],P0[3],P0[4],P0[5],     pw0[0]=PKW(P0,0), pw0[1]=PKW(P0,2), pw0); \
    VRD(4); SBAR(); GAPA(C1=__builtin_amdgcn_mfma_f32_32x32x16_bf16(kf[1],qr[0],negm,0,0,0), P0[6],P0[7],P0[8],P0[9],     pw0[2]=PKW(P0,4), pw0[3]=PKW(P0,6), pw0); \
    VRD(1); SBAR(); GAPA(C0=__builtin_amdgcn_mfma_f32_32x32x16_bf16(kf[2],qr[1],C0,0,0,0),   P0[10],P0[11],P0[12],P0[13], pw1[0]=PKW(P0,8), pw1[1]=PKW(P0,10), pw1); \
    VRD(5); SBAR(); GAPA(C1=__builtin_amdgcn_mfma_f32_32x32x16_bf16(kf[3],qr[1],C1,0,0,0),   P0[14],P0[15],P1[0],P1[1],   pw1[2]=PKW(P0,12),pw1[3]=PKW(P0,14), pw1); \
    VRD(2); SBAR(); GAPA(C0=__builtin_amdgcn_mfma_f32_32x32x16_bf16(kf[4],qr[2],C0,0,0,0),   P1[2],P1[3],P1[4],P1[5],     pw2[0]=PKW(P1,0), pw2[1]=PKW(P1,2), pw2); \
    VRD(6); SBAR(); GAPA(C1=__builtin_amdgcn_mfma_f32_32x32x16_bf16(kf[5],qr[2],C1,0,0,0),   P1[6],P1[7],P1[8],P1[9],     pw2[2]=PKW(P1,4), pw2[3]=PKW(P1,6), pw2); \
    VRD(3); SBAR(); GAPA(C0=__builtin_amdgcn_mfma_f32_32x32x16_bf16(kf[6],qr[3],C0,0,0,0),   P1[10],P1[11],P1[12],P1[13], pw3[0]=PKW(P1,8), pw3[1]=PKW(P1,10), pw3); \
    VRD(7); SBAR(); GAPA(C1=__builtin_amdgcn_mfma_f32_32x32x16_bf16(kf[7],qr[3],C1,0,0,0),   P1[14],P1[15],0.f,0.f,       pw3[2]=PKW(P1,12),pw3[3]=PKW(P1,14), pw3); \
    l_reg+=sacc; \
    if(GK){DMA_K((t)+3,sl_cur);} if(GV){DMA_V((t)+1,sl_next);} \
    { float a=MX3(C0[0],C0[1],C1[0]),b=MX3(C0[2],C0[3],C1[1]); a=MX3(a,C1[2],C1[3]); \
      _Pragma("unroll") for(int r=4;r<16;r+=4){a=MX3(a,C0[r],C0[r+1]);b=MX3(b,C0[r+2],C0[r+3]);a=MX3(a,C1[r],C1[r+1]);b=MX3(b,C1[r+2],C1[r+3]);} \
      float rm=__builtin_fmaxf(a,b); { auto rr=__builtin_amdgcn_permlane32_swap(__float_as_uint(rm),__float_as_uint(rm),false,false); rm=__builtin_fmaxf(__uint_as_float(rr[0]),__uint_as_float(rr[1])); } \
      resc=false; \
      if(__builtin_expect(__any(rm>(float)THRL),0)){ const float dl=__builtin_fmaxf(rm,0.f); mhat+=dl; \
        _Pragma("unroll") for(int r=0;r<16;++r){C0[r]-=dl;C1[r]-=dl;} \
        _Pragma("unroll") for(int r=0;r<16;++r)negm[r]=-mhat; asm volatile("":"+v"(negm)); \
        const float f=__builtin_amdgcn_exp2f(-dl); l_reg*=f; if(hi==0)wsf[r32]=f; resc=true; } } \
    SBAR(); \
    GAPB(o[0]=__builtin_amdgcn_mfma_f32_32x32x16_bf16(PAF(0),VFR(0),o[0],0,0,0), C0,0,mlo); \
    GAPB(o[1]=__builtin_amdgcn_mfma_f32_32x32x16_bf16(PAF(0),VFR(4),o[1],0,0,0), C0,4,mlo); \
    KRD(GL,0); GAPB(o[0]=__builtin_amdgcn_mfma_f32_32x32x16_bf16(PAF(1),VFR(1),o[0],0,0,0), C0,8,mlo); \
    KRD(GL,1); GAPB(o[1]=__builtin_amdgcn_mfma_f32_32x32x16_bf16(PAF(1),VFR(5),o[1],0,0,0), C0,12,mlo); \
    KRD(GL,2); GAPB(o[0]=__builtin_amdgcn_mfma_f32_32x32x16_bf16(PAF(2),VFR(2),o[0],0,0,0), C1,0,mhi); \
    KRD(GL,3); GAPB(o[1]=__builtin_amdgcn_mfma_f32_32x32x16_bf16(PAF(2),VFR(6),o[1],0,0,0), C1,4,mhi); \
    GAPB(o[0]=__builtin_amdgcn_mfma_f32_32x32x16_bf16(PAF(3),VFR(3),o[0],0,0,0), C1,8,mhi); \
    GAPB(o[1]=__builtin_amdgcn_mfma_f32_32x32x16_bf16(PAF(3),VFR(7),o[1],0,0,0), C1,12,mhi); \
    }while(0)
  int t=1;
  #undef CMASK
  #define CMASK(P0,P1,t) do{}while(0)
  for(;t+5<NT;t+=2){
    STEP(pB0,pB1,pA0,pA1,t,true,true,true);     WAIT_BAR(2); RESC(); ROT();
    STEP(pA0,pA1,pB0,pB1,t+1,true,true,true);   WAIT_BAR(2); RESC(); ROT();
  }
  #undef CMASK
  #define CMASK(P0,P1,t) do{int jb_=(t)-(NT-4); if(jb_>=0)cmask(P0,P1,jb_,qrel,hi);}while(0)
  #define ENDW(tt) do{ if((tt)+3<NT){WAIT_BAR(2);} else if((tt)+2<NT){WAIT_BAR(1);} else {WAIT_BAR(0);} }while(0)
  for(;t+1<NT;t+=2){
    STEP(pB0,pB1,pA0,pA1,t,(t+3<NT),(t+1<NT),(t+1<NT));       ENDW(t);   RESC(); ROT();
    STEP(pA0,pA1,pB0,pB1,t+1,(t+4<NT),(t+2<NT),(t+2<NT));     ENDW(t+1); RESC(); ROT();
  }
  STEP(pB0,pB1,pA0,pA1,NT-1,false,false,false); RESC();
  { float sacc=pB0[0]+pB0[1]; _Pragma("unroll") for(int r=2;r<16;++r)sacc+=pB0[r]; _Pragma("unroll") for(int r=0;r<16;++r)sacc+=pB1[r]; l_reg+=sacc;
    pw0=(u32x4){PKW(pB0,0),PKW(pB0,2),PKW(pB0,4),PKW(pB0,6)};pw1=(u32x4){PKW(pB0,8),PKW(pB0,10),PKW(pB0,12),PKW(pB0,14)};pw2=(u32x4){PKW(pB1,0),PKW(pB1,2),PKW(pB1,4),PKW(pB1,6)};pw3=(u32x4){PKW(pB1,8),PKW(pB1,10),PKW(pB1,12),PKW(pB1,14)};
    SBAR(); pv(o,vb0+sl_cur,PAF(0),PAF(1),PAF(2),PAF(3)); }
  #undef PKW
  #undef PAF
  #undef VFR
  #undef PIN
  #undef MX3
  #undef GAPA
  #undef GAPB
  #undef EX
  #undef VRD
  #undef KRD
  #undef STEP
  #undef ENDW
  {auto rr=__builtin_amdgcn_permlane32_swap(__float_as_uint(l_reg),__float_as_uint(l_reg),false,false);l_reg=__uint_as_float(rr[0])+__uint_as_float(rr[1]);}
  if(hi==0)wsf[32+r32]=l_reg;asm volatile("s_waitcnt lgkmcnt(0)":::"memory");
  float rli[16];
  #pragma unroll
  for(int r=0;r<16;++r)rli[r]=__builtin_amdgcn_rcpf(wsf[32+crow(r,hi)]);
  bf16*Ow=O+(rowbase+q0+wid*QBLK)*OP+OOFF+h*D;
  { bf16*stg=(bf16*)(shm+LDS_OST)+wid*2048;
    #pragma unroll
    for(int r=0;r<16;++r){const int orow=crow(r,hi);
      #pragma unroll
      for(int d0=0;d0<2;++d0)stg[orow*64+d0*32+r32]=__float2bfloat16(o[d0][r]*rli[r]);}
    asm volatile("s_waitcnt lgkmcnt(0)":::"memory");
    #pragma unroll
    for(int i=0;i<4;++i){const int row=i*8+(lane>>3),ch=lane&7; const u32x4 v=*(const u32x4*)(stg+row*64+ch*8); ATTN_STORE16(Ow+(long)row*OP+ch*8,v);} }
  asm volatile("s_waitcnt lgkmcnt(0)\n\ts_barrier":::"memory");
  #undef DMA_K
  #undef DMA_V
  #undef CMASK
  #undef START
  #undef RESC
  #undef ROT
}
constexpr int ATTN_LDS_BYTES=LDS_BYTES;
struct AttnTensors { const bf16* Q; const bf16* K; const bf16* V; const unsigned long long* MK; bf16* O; };
struct AttnUnit { int bh; int qb; };
struct StaticOrder {
  int vcu;
  __device__ __forceinline__ explicit StaticOrder(int vcu_):vcu(vcu_){}
  __device__ __forceinline__ bool next(int i,AttnUnit&u)const{ if(vcu>=256)return false; const int s=vcu&1; u.bh=vcu>>1; if(s){ if(i>=5)return false; u.qb=5-i; } else { if(i>=3)return false; u.qb=(i==0)?7:(i==1)?6:0; } return true; }
};
template<class Sched,int THRL=8> __device__ __forceinline__ void attn_phase(char*lds,const AttnTensors&T,const Sched&S){
  AttnUnit u;
  for(int i=0;S.next(i,u);++i){ const int b=u.bh/NHEAD; attn_unit<THRL>(b,u.bh%NHEAD,u.qb,T.Q,T.K,T.V,T.MK+(long)b*32*SEQ,T.O,lds); }
}
#undef SBAR
#undef WAIT_BAR
}
#ifndef PROBE_DUP
#define PROBE_DUP (-1)
#endif
constexpr int D = 1024, NB = 16, SEQ = 2048, MP = NB * SEQ, DB = 32, DS = 4, MS = DB * DS, MTOT = MP + MS, MPAD = 33024;
constexpr int DFF = 2816, NIN = 2888, NINP = 3072, DCONV = 512;
constexpr int PAST = 16384, PAGE = 128, NPAGES = 128, KTOP = 256;
constexpr float EPS = 1e-6f, LOG2E = 1.4426950408889634f;
constexpr float QSCALE = 0.125f * LOG2E;
constexpr size_t O_YP = 0, O_YS = O_YP + (size_t)MP * D, O_KP = O_YS + (size_t)MS * D, O_VP = O_KP + (size_t)MP * 128, O_IP = O_VP + (size_t)MP * 128,
                 O_CP = O_IP + (size_t)MP * 64, O_KS = O_CP + 16 * 2 * 512, O_VS = O_KS + MS * 128, O_IS = O_VS + MS * 128, O_CS = O_IS + MS * 64, O_END = O_CS + 32 * 2 * 512;
static_assert(O_END == 44261376, "output size");

constexpr size_t al(size_t x) { return (x + 0xFFFFF) & ~(size_t)0xFFFFF; }
constexpr size_t WS_CTL = 0, CTL_ZERO_BYTES = 1u << 20;
constexpr size_t WS_ROPE = al(WS_CTL + CTL_ZERO_BYTES);
constexpr size_t WS_WGU1 = al(WS_ROPE + 2052 * 8 * 2 * 4);
constexpr size_t WS_WD1 = al(WS_WGU1 + (size_t)2 * DFF * D * 2);
constexpr size_t WS_WIN = al(WS_WD1 + (size_t)D * DFF * 2);
constexpr size_t WS_WOUT = al(WS_WIN + (size_t)NINP * D * 2);
constexpr size_t WS_WGU2 = al(WS_WOUT + (size_t)D * D * 2);
constexpr size_t WS_WD2 = al(WS_WGU2 + (size_t)2 * DFF * D * 2);
constexpr size_t WS_XB = al(WS_WD2 + (size_t)D * DFF * 2);
constexpr size_t WS_SS0 = al(WS_XB + (size_t)MPAD * D * 2);
constexpr size_t WS_SS1 = al(WS_SS0 + (size_t)MPAD * 4);
constexpr size_t WS_SS2 = al(WS_SS1 + (size_t)MPAD * 64);
constexpr size_t WS_H = al(WS_SS2 + (size_t)MPAD * 64);
constexpr size_t WS_X1 = al(WS_H + (size_t)MPAD * DFF * 2);
constexpr size_t WS_X1B = al(WS_X1 + (size_t)MPAD * D * 4);
constexpr size_t WS_X2 = al(WS_X1B + (size_t)MPAD * D * 2);
constexpr size_t WS_X2B = al(WS_X2 + (size_t)MPAD * D * 4);
constexpr size_t WS_U = al(WS_X2B + (size_t)MPAD * D * 2);
constexpr size_t WS_GB = al(WS_U + (size_t)MPAD * 512 * 2);
constexpr size_t WS_Q = al(WS_GB + (size_t)MPAD * 512 * 2);
constexpr size_t WS_QI = al(WS_Q + (size_t)MPAD * 512 * 2);
constexpr size_t WS_KB = al(WS_QI + (size_t)MPAD * 512 * 2);
constexpr size_t WS_VB = al(WS_KB + (size_t)MPAD * 128 * 2);
constexpr size_t WS_KIB = al(WS_VB + (size_t)MPAD * 128 * 2);
constexpr size_t WS_WI = al(WS_KIB + (size_t)MPAD * 64 * 2);
constexpr size_t WS_CAT = al(WS_WI + (size_t)MPAD * 8 * 4);
constexpr size_t WS_MASK = al(WS_CAT + (size_t)MPAD * D * 2);
constexpr int SSTR = 16384;
constexpr size_t WS_SSC = al(WS_MASK + (size_t)NB * 32 * SEQ * 8);
constexpr size_t WS_XB8 = al(WS_SSC + (size_t)MS * SSTR * 4);
constexpr size_t WS_X2B8 = al(WS_XB8 + (size_t)MPAD * D);
constexpr size_t WS_WGU1_8 = al(WS_X2B8 + (size_t)MPAD * D);
constexpr size_t WS_WGU2_8 = al(WS_WGU1_8 + (size_t)2 * DFF * D);
constexpr size_t WS_WD2_8 = al(WS_WGU2_8 + (size_t)2 * DFF * D);
constexpr size_t WS_H8 = al(WS_WD2_8 + (size_t)D * DFF);
constexpr size_t WS_XI8 = al(WS_H8 + (size_t)MP * DFF);
constexpr size_t WS_XS = al(WS_XI8 + (size_t)MPAD * D);
constexpr size_t WS_WGU1I8 = al(WS_XS + (size_t)MPAD * 4);
constexpr size_t WS_WSN = al(WS_WGU1I8 + (size_t)2 * DFF * D);
constexpr size_t WS_X2I8 = al(WS_WSN + (size_t)2 * DFF * 4);
constexpr size_t WS_XS2 = al(WS_X2I8 + (size_t)MPAD * D);
constexpr size_t WS_WGU2I8 = al(WS_XS2 + (size_t)MPAD * 4);
constexpr size_t WS_WSN2 = al(WS_WGU2I8 + (size_t)2 * DFF * D);
constexpr size_t WS_WD1_8 = al(WS_WSN2 + (size_t)2 * DFF * 4);
constexpr size_t WS_END = al(WS_WD1_8 + (size_t)D * DFF);
constexpr float H8SCALE = 4.0f;
constexpr float W8SCALE = 32.0f;

constexpr int CW_TMO = 0, CW_CODE = 1, CW_BAR = 4096;

constexpr int RING_OFF = 0, RING_BYTES = 152576;
constexpr int LDSCTL_OFF = RING_BYTES, MISC_OFF = LDSCTL_OFF + 320;
constexpr int LDS_BYTES = 158720;
static_assert(MISC_OFF + 128 <= LDS_BYTES && attn_body::ATTN_LDS_BYTES <= RING_BYTES && pg8::STAGE_BYTES <= RING_BYTES, "LDS map");

#define GAS __attribute__((address_space(1)))
#define LAS __attribute__((address_space(3)))
typedef unsigned short bf16;
typedef unsigned v4u __attribute__((ext_vector_type(4)));
typedef unsigned v2u __attribute__((ext_vector_type(2)));
typedef float f32x4 __attribute__((ext_vector_type(4)));
typedef float f32x16 __attribute__((ext_vector_type(16)));
typedef short bf16x8 __attribute__((ext_vector_type(8)));
typedef GAS unsigned gu32;
#define RLX_AGENT __ATOMIC_RELAXED, __HIP_MEMORY_SCOPE_AGENT
#define LDS_WAIT() asm volatile("s_waitcnt lgkmcnt(0)" ::: "memory")
#define VM_WAIT() asm volatile("s_waitcnt vmcnt(0)" ::: "memory")
__device__ __forceinline__ unsigned f2bf(float f) { unsigned u = __builtin_bit_cast(unsigned, f); return (u + 0x7fffu + ((u >> 16) & 1u)) >> 16; }
__device__ __forceinline__ unsigned pk2(float lo, float hi) { return f2bf(lo) | (f2bf(hi) << 16); }
__device__ __forceinline__ float bf2f(unsigned short h) { return __builtin_bit_cast(float, (unsigned)h << 16); }
__device__ __forceinline__ float wave_sum(float v) {
#pragma unroll
    for (int o = 1; o < 64; o <<= 1) v += __shfl_xor(v, o);
    return v;
}
__device__ __forceinline__ float wave_max(float v) {
#pragma unroll
    for (int o = 1; o < 64; o <<= 1) v = fmaxf(v, __shfl_xor(v, o));
    return v;
}

#define XB_TMO      128
#define XB_XCNT(j)  (256  + 64 * (j))
#define XB_XSUB(j)  (1280 + 64 * (j))
#define XB_XGEN(j)  (2304 + 64 * (j))
#define XB_TOP      3328
#define XB_TOPGEN   3392
#define XCD_BAR_WORDS 3456
#define XB_SPIN_CAP (1u << 18)

__device__ __forceinline__ unsigned xb_ld(unsigned* p)              { return __hip_atomic_load(p, __ATOMIC_RELAXED, __HIP_MEMORY_SCOPE_AGENT); }
__device__ __forceinline__ unsigned xb_add(unsigned* p, unsigned v) { return __hip_atomic_fetch_add(p, v, __ATOMIC_RELAXED, __HIP_MEMORY_SCOPE_AGENT); }
__device__ __forceinline__ unsigned xb_xcc_id() { return (unsigned)__builtin_amdgcn_s_getreg((3 << 11) | 20) & 0xFu; }
#define XB_SPIN(cond, bar) do { unsigned _sp = 0; while (cond) { __builtin_amdgcn_s_sleep(1); \
    if ((++_sp & 255u) == 0u) { if (xb_ld(&(bar)[XB_TMO])) break; if (_sp > XB_SPIN_CAP) { atomicAdd(&(bar)[XB_TMO], 1u); break; } } } } while (0)

struct XcdBarrier {
    unsigned* bar; unsigned x;
    volatile LAS unsigned* st;
};

__device__ __forceinline__ XcdBarrier xcd_barrier_post(unsigned* bar, volatile LAS unsigned* st) {
    XcdBarrier b; b.bar = bar; b.x = xb_xcc_id(); b.st = st;
    if (threadIdx.x == 0) (void)xb_add(&bar[XB_XCNT(b.x)], 1u);
    return b;
}
__device__ __forceinline__ void xcd_barrier_complete(unsigned* bar, unsigned x, unsigned& nloc, unsigned& nx) {
    const unsigned G = gridDim.x * gridDim.y * gridDim.z;
    unsigned sum, cnt, mine, sp = 0u;
    for (;;) {
        sum = 0u; cnt = 0u; mine = 0u;
#pragma unroll
        for (unsigned j = 0; j < 16; ++j) { const unsigned c = xb_ld(&bar[XB_XCNT(j)]); sum += c; cnt += (c > 0u) ? 1u : 0u; mine = (j == x) ? c : mine; }
        if (sum == G) break;
        __builtin_amdgcn_s_sleep(1);
        if ((++sp & 255u) == 0u) { if (xb_ld(&bar[XB_TMO])) break; if (sp > XB_SPIN_CAP) { atomicAdd(&bar[XB_TMO], 1u); break; } }
    }
    nloc = mine > 0u ? mine : 1u; nx = cnt > 0u ? cnt : 1u;
}

__device__ __forceinline__ void xcd_barrier(const XcdBarrier& b) {
    asm volatile("s_waitcnt vmcnt(0)" ::: "memory");
    __syncthreads();
    if (threadIdx.x == 0) {
        unsigned* bar = b.bar;
        __builtin_amdgcn_s_waitcnt(0);
        unsigned nloc = b.st[0], nx = b.st[1];
        if (nloc == 0u) { xcd_barrier_complete(bar, b.x, nloc, nx); b.st[0] = nloc; b.st[1] = nx; }
        const unsigned old = xb_add(&bar[XB_XSUB(b.x)], 1u);
        const unsigned gen = old / nloc;
        if (old + 1u == (gen + 1u) * nloc) {
            __builtin_amdgcn_fence(__ATOMIC_RELEASE, "agent");
            asm volatile("s_waitcnt vmcnt(0)" ::: "memory");
            const unsigned og = xb_add(&bar[XB_TOP], 1u);
            const unsigned tg = og / nx;
            if (og + 1u == (tg + 1u) * nx) xb_add(&bar[XB_TOPGEN], 1u);
            else XB_SPIN(xb_ld(&bar[XB_TOPGEN]) == tg, bar);
            __builtin_amdgcn_fence(__ATOMIC_ACQUIRE, "agent");
            xb_add(&bar[XB_XGEN(b.x)], 1u);
            asm volatile("s_waitcnt vmcnt(0)" ::: "memory");
        } else {
            XB_SPIN(xb_ld(&bar[XB_TOPGEN]) == gen, bar);
            __builtin_amdgcn_fence(__ATOMIC_ACQUIRE, "agent");
            asm volatile("s_waitcnt vmcnt(0)" ::: "memory");
        }
    }
    __syncthreads();
}
__host__ __device__ __forceinline__ int r32map(int P) { return 16 * ((P >> 2) & 1) + 4 * (P >> 3) + (P & 3); }
__host__ __device__ __forceinline__ int p128(int x) { return (x & ~31) + r32map(x & 31); }
__host__ __device__ __forceinline__ int hdmap(int d) { if (d >= 16) return d; const int fq = (d >> 2) & 1, j = (d & 3) + 4 * (d >> 3); return 8 * fq + j; }
__host__ __device__ __forceinline__ int head_row(int wc, int d) { const int x = hdmap(d); return 128 * (x >> 5) + 32 * wc + r32map(x & 31); }
__device__ __forceinline__ int dstart(int bj, int fq, int half) { return (bj == 0 && fq < 2) ? 4 * fq + 8 * half : 32 * bj + 8 * fq + 4 * half; }

struct MapGate { __device__ __forceinline__ int operator()(int c) const { return 256 * (c >> 7) + p128(c & 127); } };
struct MapUp   { __device__ __forceinline__ int operator()(int c) const { return 256 * (c >> 7) + 128 + p128(c & 127); } };
struct MapLin  { __device__ __forceinline__ int operator()(int c) const { return (c & ~127) + p128(c & 127); } };
struct MapWin  { __device__ __forceinline__ int operator()(int c) const {
    if (c < 512) return 1024 + (c & ~127) + p128(c & 127);
    if (c < 1024) { const int ch = c - 512; return 256 * (ch >> 7) + p128(ch & 127); }
    if (c < 1536) { const int ch = c - 1024; return 256 * (ch >> 7) + 128 + p128(ch & 127); }
    if (c < 2048) { const int x = c - 1536, hd = x >> 6; return 256 * (6 + (hd >> 2)) + head_row(hd & 3, x & 63); }
    if (c < 2176) { const int x = c - 2048; return 256 * 8 + head_row(x >> 6, x & 63); }
    if (c < 2304) { const int x = c - 2176; return 256 * 8 + head_row(2 + (x >> 6), x & 63); }
    if (c < 2816) { const int x = c - 2304, hd = x >> 6; return 256 * (9 + (hd >> 2)) + head_row(hd & 3, x & 63); }
    if (c < 2880) return 256 * 11 + head_row(0, c - 2816);
    return 256 * 11 + 32 + r32map(c - 2880);
} };

using pg8::Unit; using pg8::bf16_t;
__device__ __forceinline__ float rstd_from(const float* ss, int row, int nslot) {
    float s = 0.f;
    if (nslot == 1) s = ss[row];
    else { const f32x4* p = (const f32x4*)(ss + (size_t)row * 16); const f32x4 a = p[0], b = p[1], c = p[2], d = p[3]; s = ((a.x + a.y) + (a.z + a.w)) + ((b.x + b.y) + (b.z + b.w)) + ((c.x + c.y) + (c.z + c.w)) + ((d.x + d.y) + (d.z + d.w)); }
    return __builtin_amdgcn_rsqf(s * (1.0f / D) + EPS);
}
__device__ __forceinline__ float clamp8(float x) { return __builtin_amdgcn_fmed3f(x, -440.0f, 440.0f); }
__device__ __forceinline__ unsigned pk4_fp8(float a, float b, float c, float d) { int w = __builtin_amdgcn_cvt_pk_fp8_f32(clamp8(a), clamp8(b), 0, false); w = __builtin_amdgcn_cvt_pk_fp8_f32(clamp8(c), clamp8(d), w, true); return (unsigned)w; }
#define EPI_CALL_ROWS() \
    __device__ __forceinline__ void operator()(f32x4 (&acc)[2][2][4][2], const Unit& u, int wr, int wc, int fr, int fq, int ui, bool has_next, const Unit& nxt) const { \
        _Pragma("unroll") for (int ai = 0; ai < 2; ++ai) _Pragma("unroll") for (int m = 0; m < 4; ++m) { \
            const f32x4 v[2][2] = {{acc[ai][0][m][0], acc[ai][0][m][1]}, {acc[ai][1][m][0], acc[ai][1][m][1]}}; \
            row(v, u.pm * 256 + ai * 128 + wr * 64 + m * 16 + fr, u.pn, wc, fr, fq, ui); \
            if (has_next) init_rg(acc, nxt, ai, m, wr, wc, fr, fq); } }                        \
    __device__ __forceinline__ void init(f32x4 (&acc)[2][2][4][2], const Unit& u, int wr, int wc, int fr, int fq) const { \
        _Pragma("unroll") for (int ai = 0; ai < 2; ++ai) _Pragma("unroll") for (int m = 0; m < 4; ++m) init_rg(acc, u, ai, m, wr, wc, fr, fq); }
#define EPI_ZERO_INIT() \
    __device__ __forceinline__ void init_rg(f32x4 (&acc)[2][2][4][2], const Unit&, int ai, int m, int, int, int, int) const { \
        _Pragma("unroll") for (int b = 0; b < 2; ++b) _Pragma("unroll") for (int n = 0; n < 2; ++n) acc[ai][b][m][n] = (f32x4){0.f, 0.f, 0.f, 0.f}; }
__device__ __forceinline__ float rstd_of(const LAS float* tab, const float* ss, int nslot, int row, int ui) { return (ui >= 0 && tab) ? tab[ui * 256 + (row & 255)] : rstd_from(ss, row, nslot); }
struct EpiGU {
    static constexpr bool PERM = false, AFTER_DRAIN = false;
    bf16_t* H; const float* ss; int nslot; const LAS float* tab; float wscale; unsigned char* H8; const float* wsn;
    __device__ __forceinline__ void row(const f32x4 (&v)[2][2], int row, int pn, int wc, int fr, int fq, int ui) const {
        typedef float f32x2 __attribute__((ext_vector_type(2)));
        const int col0 = pn * 128 + wc * 32 + 8 * fq;
        const float rs = rstd_of(tab, ss, nslot, row, ui) * (ui >= 0 ? wscale : 1.0f);
        const float c1 = -rs * LOG2E, rs2 = rs * rs;
        const bool f8 = (ui >= 0) && H8 != nullptr;
        const float rs2s = f8 ? rs2 * H8SCALE : rs2;
        f32x2 hh[4];
#pragma unroll
        for (int n = 0; n < 2; ++n)
#pragma unroll
            for (int i = 0; i < 4; i += 2) { const f32x2 ag = {v[0][n][i], v[0][n][i + 1]}, au = {v[1][n][i], v[1][n][i + 1]};
                const f32x2 a = ag * c1; f32x2 e; e.x = __builtin_amdgcn_exp2f(a.x); e.y = __builtin_amdgcn_exp2f(a.y);
                const f32x2 d = e + 1.0f; f32x2 r; r.x = __builtin_amdgcn_rcpf(d.x); r.y = __builtin_amdgcn_rcpf(d.y);
                hh[2 * n + (i >> 1)] = (ag * au) * (r * rs2s); }
        if (f8) { v2u w8; w8.x = pk4_fp8(hh[0].x, hh[0].y, hh[1].x, hh[1].y); w8.y = pk4_fp8(hh[2].x, hh[2].y, hh[3].x, hh[3].y);
            __builtin_nontemporal_store(w8, (v2u*)(H8 + (size_t)row * DFF + col0)); }
        else { v4u w; w.x = pg8::cvt_pk_bf16(hh[0].x, hh[0].y); w.y = pg8::cvt_pk_bf16(hh[1].x, hh[1].y); w.z = pg8::cvt_pk_bf16(hh[2].x, hh[2].y); w.w = pg8::cvt_pk_bf16(hh[3].x, hh[3].y);
        __builtin_nontemporal_store(w, (v4u*)(H + (size_t)row * DFF + col0)); }
    }
    __device__ __forceinline__ void operator()(f32x4 (&acc)[2][2][4][2], const Unit& u, int wr, int wc, int fr, int fq, int ui, bool has_next, const Unit& nxt) const {
        typedef int v4i_ __attribute__((ext_vector_type(4)));
        f32x4 cs[2][2];
#pragma unroll
        for (int bj = 0; bj < 2; ++bj)
#pragma unroll
            for (int n = 0; n < 2; ++n) cs[bj][n] = wsn ? *(const f32x4*)(wsn + u.pn * 256 + bj * 128 + wc * 32 + n * 16 + 4 * fq) : (f32x4){1.f, 1.f, 1.f, 1.f};
#pragma unroll
        for (int ai = 0; ai < 2; ++ai)
#pragma unroll
            for (int m = 0; m < 4; ++m) {
                f32x4 v[2][2];
#pragma unroll
                for (int bj = 0; bj < 2; ++bj)
#pragma unroll
                    for (int n = 0; n < 2; ++n) v[bj][n] = wsn ? __builtin_convertvector(__builtin_bit_cast(v4i_, acc[ai][bj][m][n]), f32x4) * cs[bj][n] : acc[ai][bj][m][n];
                row(v, u.pm * 256 + ai * 128 + wr * 64 + m * 16 + fr, u.pn, wc, fr, fq, ui);
                if (has_next) init_rg(acc, nxt, ai, m, wr, wc, fr, fq); }
    }
    __device__ __forceinline__ void init(f32x4 (&acc)[2][2][4][2], const Unit& u, int wr, int wc, int fr, int fq) const {
#pragma unroll
        for (int ai = 0; ai < 2; ++ai)
#pragma unroll
            for (int m = 0; m < 4; ++m) init_rg(acc, u, ai, m, wr, wc, fr, fq); }
    EPI_ZERO_INIT()
};
__device__ __forceinline__ void bf8_to_f32(const v4u w, f32x4& lo, f32x4& hi) {
    lo = (f32x4){__uint_as_float(w.x << 16), __uint_as_float(w.x & 0xffff0000u), __uint_as_float(w.y << 16), __uint_as_float(w.y & 0xffff0000u)};
    hi = (f32x4){__uint_as_float(w.z << 16), __uint_as_float(w.z & 0xffff0000u), __uint_as_float(w.w << 16), __uint_as_float(w.w & 0xffff0000u)};
}
template <int MODE> struct EpiRes {
    static constexpr bool PERM = false, AFTER_DRAIN = false;
    const bf16_t* resb; float* out; bf16_t* outb; float* ss; unsigned char* out8; float ascale;
    __device__ __forceinline__ void row(const f32x4 (&v)[2][2], int row, int pn, int wc, int fr, int fq, int ui) const {
        const bool pre = ui >= 0;
        const float alpha = ((MODE == 1) ? 1.0f : 0.5f) * (pre ? ascale : 1.0f);
        const bool live = row < MTOT;
        float sq = 0.f;
#pragma unroll
        for (int bj = 0; bj < 2; ++bj) {
            const int col = pn * 256 + bj * 128 + wc * 32 + 8 * fq;
            f32x4 r0 = (f32x4){0.f, 0.f, 0.f, 0.f}, r1 = r0;
            if (!pre && live) bf8_to_f32(*(const v4u*)(resb + (size_t)row * D + col), r0, r1);
            const f32x4 v0 = r0 + alpha * v[bj][0], v1 = r1 + alpha * v[bj][1];
            if (MODE == 2) { if (live) { __builtin_nontemporal_store(v0, (f32x4*)(out + (size_t)row * D + col)); __builtin_nontemporal_store(v1, (f32x4*)(out + (size_t)row * D + col + 4)); } }
            else {
                v4u w; w.x = pg8::cvt_pk_bf16(v0[0], v0[1]); w.y = pg8::cvt_pk_bf16(v0[2], v0[3]); w.z = pg8::cvt_pk_bf16(v1[0], v1[1]); w.w = pg8::cvt_pk_bf16(v1[2], v1[3]);
                *(v4u*)(outb + (size_t)row * D + col) = w;
                if (MODE == 1 && out8) { v2u w8; w8.x = pk4_fp8(v0[0], v0[1], v0[2], v0[3]); w8.y = pk4_fp8(v1[0], v1[1], v1[2], v1[3]); *(v2u*)(out8 + (size_t)row * D + col) = w8; }
                sq += (v0[0] * v0[0] + v0[1] * v0[1]) + (v0[2] * v0[2] + v0[3] * v0[3]) + (v1[0] * v1[0] + v1[1] * v1[1]) + (v1[2] * v1[2] + v1[3] * v1[3]);
            }
        }
        if (MODE != 2) { sq += __shfl_xor(sq, 16); sq += __shfl_xor(sq, 32); if (fq == 0) ss[(size_t)row * 16 + pn * 4 + wc] = sq; }
    }
    EPI_CALL_ROWS()
    __device__ __forceinline__ void init_rg(f32x4 (&acc)[2][2][4][2], const Unit& u, int ai, int m, int wr, int wc, int fr, int fq) const {
        const float ia = ((MODE == 1) ? 1.0f : 2.0f) / ascale;
        const bf16_t* rp = resb + (size_t)(u.pm * 256 + ai * 128 + wr * 64 + m * 16 + fr) * D + u.pn * 256 + wc * 32 + 8 * fq;
#pragma unroll
        for (int bj = 0; bj < 2; ++bj) { f32x4 lo, hi; bf8_to_f32(*(const v4u*)(rp + bj * 128), lo, hi); acc[ai][bj][m][0] = lo * ia; acc[ai][bj][m][1] = hi * ia; }
    }
};
struct EpiWin {
    static constexpr bool PERM = false, AFTER_DRAIN = false;
    unsigned char* ws; float* out; const float* qn; const float* kn; const LAS float* tab;
    __device__ __forceinline__ void row(const f32x4 (&acc)[2][2], int row, int pn, int wc, int fr, int fq, int ui) const {
        const float* ss = (const float*)(ws + WS_SS1); bf16_t* U = (bf16_t*)(ws + WS_U); bf16_t* GB = (bf16_t*)(ws + WS_GB); float* WI = (float*)(ws + WS_WI); const float* rope = (const float*)(ws + WS_ROPE);
        if (pn == 11 && wc >= 2) return;
        const int type = pn < 4 ? 0 : pn < 6 ? 1 : pn < 8 ? 2 : pn == 8 ? (wc < 2 ? 3 : 4) : pn < 11 ? 5 : (wc == 0 ? 6 : 7);
        const int head = (type == 2) ? 4 * (pn - 6) + wc : (type == 5) ? 4 * (pn - 9) + wc : (type == 3) ? wc : (type == 4) ? wc - 2 : 0;
        const bool live = row < MTOT;
        const float rs = rstd_of(tab, ss, 16, row, ui);
        if (type == 0) {
            const int ch0 = pn * 128 + wc * 32 + 8 * fq;
            const f32x4 u0 = (acc[0][0] * rs) * (acc[1][0] * rs), u1 = (acc[0][1] * rs) * (acc[1][1] * rs);
            v4u w; w.x = pg8::cvt_pk_bf16(u0[0], u0[1]); w.y = pg8::cvt_pk_bf16(u0[2], u0[3]); w.z = pg8::cvt_pk_bf16(u1[0], u1[1]); w.w = pg8::cvt_pk_bf16(u1[2], u1[3]);
            *(v4u*)(U + (size_t)row * 512 + ch0) = w;
            if (row < MP) { const int s = row & (SEQ - 1); if (s >= SEQ - 2) { float* o = out + O_CP + ((size_t)(row >> 11) * 2 + (s - (SEQ - 2))) * 512 + ch0; *(f32x4*)o = u0; *(f32x4*)(o + 4) = u1; } }
            else if (live) { const int sr = row - MP, s = sr & 3; if (s >= 2) { float* o = out + O_CS + ((size_t)(sr >> 2) * 2 + (s - 2)) * 512 + ch0; *(f32x4*)o = u0; *(f32x4*)(o + 4) = u1; } }
        } else if (type == 1) {
#pragma unroll
            for (int bj = 0; bj < 2; ++bj) { const int col = (pn - 4) * 256 + bj * 128 + wc * 32 + 8 * fq; const f32x4 a = acc[bj][0] * rs, b = acc[bj][1] * rs;
                v4u w; w.x = pg8::cvt_pk_bf16(a[0], a[1]); w.y = pg8::cvt_pk_bf16(a[2], a[3]); w.z = pg8::cvt_pk_bf16(b[0], b[1]); w.w = pg8::cvt_pk_bf16(b[2], b[3]);
                *(v4u*)(GB + (size_t)row * 512 + col) = w; }
        } else if (type == 7) {
            if (fq == 0) { *(f32x4*)(WI + (size_t)row * 8) = acc[0][0] * rs; *(f32x4*)(WI + (size_t)row * 8 + 4) = acc[0][1] * rs; }
        } else {
            f32x4 v[2][2];
#pragma unroll
            for (int bj = 0; bj < 2; ++bj) { v[bj][0] = acc[bj][0] * rs; v[bj][1] = acc[bj][1] * rs; }
            if (type == 2 || type == 3) {
                float sq = 0.f;
#pragma unroll
                for (int bj = 0; bj < 2; ++bj)
#pragma unroll
                    for (int h2 = 0; h2 < 2; ++h2) sq += (v[bj][h2][0] * v[bj][h2][0] + v[bj][h2][1] * v[bj][h2][1]) + (v[bj][h2][2] * v[bj][h2][2] + v[bj][h2][3] * v[bj][h2][3]);
                sq += __shfl_xor(sq, 16); sq += __shfl_xor(sq, 32);
                const float sc = __builtin_amdgcn_rsqf(sq * (1.0f / 64.0f) + EPS);
#pragma unroll
                for (int bj = 0; bj < 2; ++bj)
#pragma unroll
                    for (int h2 = 0; h2 < 2; ++h2) { const f32x4 gq = *(const f32x4*)(qn + dstart(bj, fq, h2)), gk = *(const f32x4*)(kn + dstart(bj, fq, h2)); v[bj][h2] = v[bj][h2] * sc * ((type == 2) ? gq : gk); }
            }
            if (type != 4 && fq < 2) {
                const int pidx = row < MP ? (row & (SEQ - 1)) : (live ? SEQ + ((row - MP) & 3) : 0);
                const float* rp = rope + ((size_t)pidx * 8 + 4 * fq) * 2;
                const f32x4 cs0 = *(const f32x4*)rp, cs1 = *(const f32x4*)(rp + 4);
                const f32x4 x1 = v[0][0], x2 = v[0][1];
                const f32x4 c = (f32x4){cs0[0], cs0[2], cs1[0], cs1[2]}, s = (f32x4){cs0[1], cs0[3], cs1[1], cs1[3]};
                v[0][0] = x1 * c - x2 * s; v[0][1] = x2 * c + x1 * s;
            }
            const size_t boff = (type == 2) ? WS_Q : (type == 3) ? WS_KB : (type == 4) ? WS_VB : (type == 5) ? WS_QI : WS_KIB;
            const int bp = (type == 2 || type == 5) ? 512 : (type == 6) ? 64 : 128; const float bsc = (type == 2) ? QSCALE : 1.0f;
            bf16_t* bdst = (bf16_t*)(ws + boff);
            const bool hasf = live && (type == 3 || type == 4 || type == 6);
            const size_t fbase = (type == 3) ? (row < MP ? O_KP : O_KS) : (type == 4) ? (row < MP ? O_VP : O_VS) : (row < MP ? O_IP : O_IS);
            float* fdst = out + fbase + (size_t)(row < MP ? row : row - MP) * (type == 6 ? 64 : 128);
#pragma unroll
            for (int bj = 0; bj < 2; ++bj)
#pragma unroll
                for (int h2 = 0; h2 < 2; ++h2) { const int d = head * 64 + dstart(bj, fq, h2); const f32x4 x = v[bj][h2];
                    if (hasf) { if (row < MP) __builtin_nontemporal_store(x, (f32x4*)(fdst + d)); else *(f32x4*)(fdst + d) = x; }
                    v2u w; w.x = pg8::cvt_pk_bf16(x[0] * bsc, x[1] * bsc); w.y = pg8::cvt_pk_bf16(x[2] * bsc, x[3] * bsc);
                    *(v2u*)(bdst + (size_t)row * bp + d) = w; }
        }
    }
    EPI_CALL_ROWS()
    EPI_ZERO_INIT()
};
template <class Epi> __device__ __forceinline__ void skinny_unit(PG8_LAS unsigned char* lds, const bf16_t* A, const bf16_t* Bt, int K, int pn, int wc, int rg, const Epi& E) {
    const int tid = threadIdx.x, wid = __builtin_amdgcn_readfirstlane(tid >> 6), lane = tid & 63, fr = lane & 15, fq = lane >> 4;
    const int KQ = K >> 3, ns = KQ >> 5;
    const bf16_t* ap = A + (size_t)(MP + 64 * rg + fr) * K + wid * KQ + 8 * fq;
    const bf16_t* bp = Bt + (size_t)(256 * pn + 32 * wc + fr) * K + wid * KQ + 8 * fq;
    pg8::f32x4 acc[4][2][2];
#pragma unroll
    for (int mt = 0; mt < 4; ++mt)
#pragma unroll
        for (int bj = 0; bj < 2; ++bj)
#pragma unroll
            for (int n = 0; n < 2; ++n) acc[mt][bj][n] = (pg8::f32x4){0.f, 0.f, 0.f, 0.f};
    pg8::bf16x8 a0[4], b0[2][2], a1[4], b1[2][2], a2[4], b2[2][2], a3[4], b3[2][2];
#define SK_LOAD(af, bf, s_) do { const int sc_ = (s_) < ns ? (s_) : ns - 1; _Pragma("unroll") for (int mt = 0; mt < 4; ++mt) af[mt] = *(const pg8::bf16x8*)(ap + (size_t)(16 * mt) * K + 32 * sc_); \
        _Pragma("unroll") for (int bj = 0; bj < 2; ++bj) _Pragma("unroll") for (int n = 0; n < 2; ++n) bf[bj][n] = *(const pg8::bf16x8*)(bp + (size_t)(128 * bj + 16 * n) * K + 32 * sc_); } while (0)
#define SK_MMA(af, bf) do { _Pragma("unroll") for (int mt = 0; mt < 4; ++mt) _Pragma("unroll") for (int bj = 0; bj < 2; ++bj) _Pragma("unroll") for (int n = 0; n < 2; ++n) \
        acc[mt][bj][n] = __builtin_amdgcn_mfma_f32_16x16x32_bf16(bf[bj][n], af[mt], acc[mt][bj][n], 0, 0, 0); } while (0)
    SK_LOAD(a0, b0, 0); SK_LOAD(a1, b1, 1); SK_LOAD(a2, b2, 2);
    for (int s = 0; s < ns; s += 4) {
        SK_LOAD(a3, b3, s + 3); SK_MMA(a0, b0);
        if (s + 1 < ns) { SK_LOAD(a0, b0, s + 4); SK_MMA(a1, b1); }
        if (s + 2 < ns) { SK_LOAD(a1, b1, s + 5); SK_MMA(a2, b2); }
        if (s + 3 < ns) { SK_LOAD(a2, b2, s + 6); SK_MMA(a3, b3); }
    }
#undef SK_LOAD
#undef SK_MMA
    PG8_LAS pg8::f32x4* slab = (PG8_LAS pg8::f32x4*)lds;
#pragma unroll
    for (int mt = 0; mt < 4; ++mt)
#pragma unroll
        for (int bj = 0; bj < 2; ++bj)
#pragma unroll
            for (int n = 0; n < 2; ++n) slab[((wid * 4 + mt) * 4 + bj * 2 + n) * 64 + lane] = acc[mt][bj][n];
    __syncthreads();
    if (wid < 4) { pg8::f32x4 v[2][2];
#pragma unroll
      for (int bj = 0; bj < 2; ++bj)
#pragma unroll
          for (int n = 0; n < 2; ++n) { const int o = (wid * 4 + bj * 2 + n) * 64 + lane; pg8::f32x4 t = slab[o];
#pragma unroll
              for (int q = 1; q < 8; ++q) t = t + slab[o + q * 4 * 4 * 64];
              v[bj][n] = t; }
      E.row(v, MP + 64 * rg + 16 * wid + fr, pn, wc, fr, fq, -1); }
    __syncthreads();
}
template <class Epi> __device__ __forceinline__ void skinny_phase(PG8_LAS unsigned char* lds, const bf16_t* A, const bf16_t* Bt, int N, int K, int blk, int G, const Epi& E) {
    const int nu = (N / 256) * 8;
    for (int u = blk; u < nu; u += G) skinny_unit(lds, A, Bt, K, u >> 3, (u >> 1) & 3, u & 1, E);
}
__device__ __forceinline__ void fill_rstd_table(LAS float* tab, const pg8::StaticOrder& S, const float* ss, int nslot, const float* xs = nullptr) {
    const int tid = threadIdx.x; Unit u; int nu = 0;
    while (nu < 11 && S.next(nu, u)) ++nu;
    float sv[6], xsv[6]; int ix[6];
#pragma unroll
    for (int k2 = 0; k2 < 6; ++k2) { const int idx = tid + 512 * k2; ix[k2] = idx; const bool ok = idx < nu * 256; Unit uu_; S.next(ok ? (idx >> 8) : 0, uu_); const int row = uu_.pm * 256 + (idx & 255);
        float s_ = 0.f;
        if (nslot == 1) s_ = ss[row];
        else { const f32x4* p = (const f32x4*)(ss + (size_t)row * 16); const f32x4 a = p[0], b = p[1], c = p[2], d = p[3]; s_ = ((a.x + a.y) + (a.z + a.w)) + ((b.x + b.y) + (b.z + b.w)) + ((c.x + c.y) + (c.z + c.w)) + ((d.x + d.y) + (d.z + d.w)); }
        sv[k2] = s_; xsv[k2] = xs ? xs[row] : 1.0f; }
#pragma unroll
    for (int k2 = 0; k2 < 6; ++k2) if (ix[k2] < nu * 256) tab[ix[k2]] = __builtin_amdgcn_rsqf(sv[k2] * (1.0f / D) + EPS) * xsv[k2];
    __syncthreads();
}
__device__ __forceinline__ void quant_rows_pass(int gw, int NGW, const bf16_t* X, unsigned char* Q, float* XS, int nrows) {
    const int lane = threadIdx.x & 63;
    for (int g8 = gw; g8 < nrows / 8; g8 += NGW) {
        const int m0 = 8 * g8; v4u a[8][2];
#pragma unroll
        for (int r = 0; r < 8; ++r) { a[r][0] = *(const v4u*)(X + (size_t)(m0 + r) * D + 8 * lane); a[r][1] = *(const v4u*)(X + (size_t)(m0 + r) * D + 512 + 8 * lane); }
#pragma unroll
        for (int r = 0; r < 8; ++r) {
            float x[16];
#pragma unroll
            for (int e = 0; e < 4; ++e) { x[2 * e] = __uint_as_float(a[r][0][e] << 16); x[2 * e + 1] = __uint_as_float(a[r][0][e] & 0xffff0000u); x[8 + 2 * e] = __uint_as_float(a[r][1][e] << 16); x[9 + 2 * e] = __uint_as_float(a[r][1][e] & 0xffff0000u); }
            float mx = 0.f;
#pragma unroll
            for (int e = 0; e < 16; ++e) mx = fmaxf(mx, fabsf(x[e]));
            { unsigned v = __float_as_uint(mx), o;
              o = (unsigned)__builtin_amdgcn_update_dpp(0, (int)v, 0xB1, 0xF, 0xF, true); v = o > v ? o : v;
              o = (unsigned)__builtin_amdgcn_update_dpp(0, (int)v, 0x4E, 0xF, 0xF, true); v = o > v ? o : v;
              o = (unsigned)__builtin_amdgcn_update_dpp(0, (int)v, 0x141, 0xF, 0xF, true); v = o > v ? o : v;
              o = (unsigned)__builtin_amdgcn_update_dpp(0, (int)v, 0x140, 0xF, 0xF, true); v = o > v ? o : v;
              const unsigned p0 = (unsigned)__builtin_amdgcn_readlane((int)v, 0), p1 = (unsigned)__builtin_amdgcn_readlane((int)v, 16), p2 = (unsigned)__builtin_amdgcn_readlane((int)v, 32), p3 = (unsigned)__builtin_amdgcn_readlane((int)v, 48);
              const unsigned q0 = p0 > p1 ? p0 : p1, q1 = p2 > p3 ? p2 : p3; mx = __uint_as_float(q0 > q1 ? q0 : q1); }
            const float iq = mx > 0.f ? 127.0f / mx : 0.f;
            unsigned w[4];
#pragma unroll
            for (int e = 0; e < 4; ++e) { const int q0 = (int)__builtin_rintf(x[4 * e] * iq), q1 = (int)__builtin_rintf(x[4 * e + 1] * iq), q2 = (int)__builtin_rintf(x[4 * e + 2] * iq), q3 = (int)__builtin_rintf(x[4 * e + 3] * iq);
                w[e] = (unsigned)(q0 & 0xff) | ((unsigned)(q1 & 0xff) << 8) | ((unsigned)(q2 & 0xff) << 16) | ((unsigned)(q3 & 0xff) << 24); }
            *(v2u*)(Q + (size_t)(m0 + r) * D + 8 * lane) = (v2u){w[0], w[1]};
            *(v2u*)(Q + (size_t)(m0 + r) * D + 512 + 8 * lane) = (v2u){w[2], w[3]};
            if (lane == 0) XS[m0 + r] = mx * (1.0f / 127.0f);
        }
    }
}
struct Frame {
    LAS unsigned char* lds;
    volatile LAS unsigned* MISC;
    gu32* ctl;
    int tid, lane, wave, vcu, G;
    const void* const* in;
    float* out; unsigned char* ws;
};
#define WSP(T, off) ((T*)(F.ws + (off)))

template <class Map> __device__ __forceinline__ void p0_transpose_item(const float* W, int K, int N, const float* gain, bf16* WT, LAS float* scr, int item, int lane, const Map map, unsigned char* WT8 = nullptr) {
    const int nblk = (N + 31) / 32, kb = item / nblk, nb = item % nblk, k0 = 64 * kb, n0 = 32 * nb;
    const bool nok = n0 + (lane & 31) < N;
#pragma unroll 8
    for (int i = 0; i < 32; ++i) { const int kk = 2 * i + (lane >> 5); float v = nok ? __builtin_nontemporal_load(W + (size_t)(k0 + kk) * N + n0 + (lane & 31)) : 0.f; if (gain) v *= gain[k0 + kk]; scr[kk * 33 + (lane & 31)] = v; }
    LDS_WAIT(); asm volatile("" ::: "memory");
    const int c = lane & 7;
#pragma unroll
    for (int j = 0; j < 4; ++j) { const int n = (lane >> 3) + 8 * j; const LAS float* s = scr + (8 * c) * 33 + n;
        v4u o; o.x = pk2(s[0 * 33], s[1 * 33]); o.y = pk2(s[2 * 33], s[3 * 33]); o.z = pk2(s[4 * 33], s[5 * 33]); o.w = pk2(s[6 * 33], s[7 * 33]);
        if (n0 + n < N) { *(GAS v4u*)(WT + (size_t)map(n0 + n) * K + k0 + 8 * c) = o;
            if (WT8) { v2u o8; o8.x = pk4_fp8(s[0 * 33] * W8SCALE, s[1 * 33] * W8SCALE, s[2 * 33] * W8SCALE, s[3 * 33] * W8SCALE); o8.y = pk4_fp8(s[4 * 33] * W8SCALE, s[5 * 33] * W8SCALE, s[6 * 33] * W8SCALE, s[7 * 33] * W8SCALE);
                *(GAS v2u*)(WT8 + (size_t)map(n0 + n) * K + k0 + 8 * c) = o8; } } }
    LDS_WAIT(); asm volatile("" ::: "memory");
}
__device__ __forceinline__ void sincos_d(double a, float& s, float& c) {
    const double TWO_PI = 6.283185307179586476925286766559, PI = 3.14159265358979323846264338327950288;
    double k = __builtin_rint(a / TWO_PI); double r = a - k * TWO_PI;
    double sgn = 1.0; if (r > PI * 0.5) { r = PI - r; sgn = -1.0; } else if (r < -PI * 0.5) { r = -PI - r; sgn = -1.0; }
    const double r2 = r * r;
    double ts = 1.0, tc = 1.0, ps = 1.0, pc = 1.0;
#pragma unroll
    for (int n = 1; n <= 12; ++n) { pc = -pc * r2 / (double)((2 * n - 1) * (2 * n)); ps = -ps * r2 / (double)((2 * n) * (2 * n + 1)); tc += pc; ts += ps; }
    s = (float)(r * ts); c = (float)(sgn * tc);
}
__device__ __forceinline__ void p0_prologue(Frame& F) {
    LAS float* scr = (LAS float*)(F.lds + RING_OFF + F.wave * 16384);
    const int gw = F.vcu * 8 + F.wave, NGW = F.G * 8;
    constexpr int I_G = (D / 64) * (DFF / 32), I_D = (DFF / 64) * (D / 32), I_IN = (D / 64) * ((NIN + 31) / 32), I_O = (D / 64) * (D / 32);
    constexpr int NITEMS = 2 * (2 * I_G + I_D) + I_IN + I_O;
    for (int rep63 = 0; rep63 < (PROBE_DUP == 63 ? 2 : 1); ++rep63)
    for (int it = gw; it < NITEMS; it += NGW) {
        int r = it;
        if (r < I_G) { p0_transpose_item(((const float*)F.in[8]), D, DFF, ((const float*)F.in[7]), WSP(bf16, WS_WGU1), scr, r, F.lane, MapGate()); continue; } r -= I_G;
        if (r < I_G) { p0_transpose_item(((const float*)F.in[9]), D, DFF, ((const float*)F.in[7]), WSP(bf16, WS_WGU1), scr, r, F.lane, MapUp()); continue; } r -= I_G;
        if (r < I_D) { p0_transpose_item(((const float*)F.in[10]), DFF, D, nullptr, WSP(bf16, WS_WD1), scr, r, F.lane, MapLin(), WSP(unsigned char, WS_WD1_8)); continue; } r -= I_D;
        if (r < I_G) { p0_transpose_item(((const float*)F.in[19]), D, DFF, ((const float*)F.in[18]), WSP(bf16, WS_WGU2), scr, r, F.lane, MapGate()); continue; } r -= I_G;
        if (r < I_G) { p0_transpose_item(((const float*)F.in[20]), D, DFF, ((const float*)F.in[18]), WSP(bf16, WS_WGU2), scr, r, F.lane, MapUp()); continue; } r -= I_G;
        if (r < I_D) { p0_transpose_item(((const float*)F.in[21]), DFF, D, nullptr, WSP(bf16, WS_WD2), scr, r, F.lane, MapLin(), WSP(unsigned char, WS_WD2_8)); continue; } r -= I_D;
        if (r < I_IN) { p0_transpose_item(((const float*)F.in[12]), D, NIN, ((const float*)F.in[11]), WSP(bf16, WS_WIN), scr, r, F.lane, MapWin()); continue; } r -= I_IN;
        p0_transpose_item(((const float*)F.in[17]), D, D, nullptr, WSP(bf16, WS_WOUT), scr, r, F.lane, MapLin());
    }
    bf16* XB = WSP(bf16, WS_XB); float* SS0 = WSP(float, WS_SS0);
    for (int rep64 = 0; rep64 < (PROBE_DUP == 64 ? 2 : 1); ++rep64)
    for (int g4 = gw; g4 < MTOT / 4; g4 += NGW) {
        const int m0 = 4 * g4;
        const float* xrow = m0 < MP ? ((const float*)F.in[0]) + (size_t)m0 * D : ((const float*)F.in[1]) + (size_t)(m0 - MP) * D;
        const GAS f32x4* xr = (const GAS f32x4*)xrow + F.lane;
        f32x4 v[4][4]; float s[4];
#pragma unroll
        for (int r = 0; r < 4; ++r)
#pragma unroll
            for (int j = 0; j < 4; ++j) v[r][j] = __builtin_nontemporal_load((const f32x4*)(xr + 256 * r + 64 * j));
#pragma unroll
        for (int r = 0; r < 4; ++r) { s[r] = 0.f;
#pragma unroll
            for (int j = 0; j < 4; ++j) s[r] += (v[r][j].x * v[r][j].x + v[r][j].y * v[r][j].y) + (v[r][j].z * v[r][j].z + v[r][j].w * v[r][j].w); }
#pragma unroll
        for (int o = 1; o < 64; o <<= 1) {
#pragma unroll
            for (int r = 0; r < 4; ++r) s[r] += __shfl_xor(s[r], o); }
        GAS unsigned long long* o8 = (GAS unsigned long long*)(XB + (size_t)m0 * D) + F.lane;
#pragma unroll
        for (int r = 0; r < 4; ++r)
#pragma unroll
            for (int j = 0; j < 4; ++j) o8[256 * r + 64 * j] = (unsigned long long)pk2(v[r][j].x, v[r][j].y) | ((unsigned long long)pk2(v[r][j].z, v[r][j].w) << 32);
        { float mx[4];
#pragma unroll
          for (int r = 0; r < 4; ++r) { mx[r] = 0.f;
#pragma unroll
              for (int j = 0; j < 4; ++j) mx[r] = fmaxf(mx[r], fmaxf(fmaxf(fabsf(v[r][j].x), fabsf(v[r][j].y)), fmaxf(fabsf(v[r][j].z), fabsf(v[r][j].w)))); }
#pragma unroll
          for (int o = 1; o < 64; o <<= 1) {
#pragma unroll
              for (int r = 0; r < 4; ++r) mx[r] = fmaxf(mx[r], __shfl_xor(mx[r], o)); }
          GAS unsigned* q8 = (GAS unsigned*)(WSP(unsigned char, WS_XI8) + (size_t)m0 * D) + F.lane;
#pragma unroll
          for (int r = 0; r < 4; ++r) { const float iq = mx[r] > 0.f ? 127.0f / mx[r] : 0.f;
#pragma unroll
              for (int j = 0; j < 4; ++j) { const int a_ = (int)__builtin_rintf(v[r][j].x * iq), b_ = (int)__builtin_rintf(v[r][j].y * iq), c_ = (int)__builtin_rintf(v[r][j].z * iq), d_ = (int)__builtin_rintf(v[r][j].w * iq);
                  q8[256 * r + 64 * j] = (unsigned)(a_ & 0xff) | ((unsigned)(b_ & 0xff) << 8) | ((unsigned)(c_ & 0xff) << 16) | ((unsigned)(d_ & 0xff) << 24); } }
          if (F.lane < 4) WSP(float, WS_XS)[m0 + F.lane] = (F.lane == 0 ? mx[0] : F.lane == 1 ? mx[1] : F.lane == 2 ? mx[2] : mx[3]) * (1.0f / 127.0f); }
        if (F.lane < 4) SS0[m0 + F.lane] = F.lane == 0 ? s[0] : F.lane == 1 ? s[1] : F.lane == 2 ? s[2] : s[3];
    }
    { float* rope = WSP(float, WS_ROPE);
      const double invf[8] = {1.0, 0.19392274474868576, 0.03760603093086393, 0.007292664737217109, 0.001414213562373095, 0.0002742481756762073, 5.318295896944988e-05, 1.031338537721246e-05};
      for (int rep65 = 0; rep65 < (PROBE_DUP == 65 ? 2 : 1); ++rep65)
      for (int e = (F.vcu * 512 + F.tid); e < 2052 * 8; e += F.G * 512) { const int p = e >> 3, i = e & 7; const double pos = (double)(p < SEQ ? p : PAST + (p - SEQ));
          double f = invf[0];
#pragma unroll
          for (int q = 1; q < 8; ++q) f = (i == q) ? invf[q] : f;
          float s, c; sincos_d(pos * f, s, c); rope[2 * e] = c; rope[2 * e + 1] = s; } }
}

__device__ __forceinline__ void unpack8(const v4u a, float (&o)[8]) {
#pragma unroll
    for (int e = 0; e < 4; ++e) { o[2 * e] = bf2f((unsigned short)(a[e] & 0xffffu)); o[2 * e + 1] = bf2f((unsigned short)(a[e] >> 16)); }
}
__device__ __forceinline__ void p0b_quant_weights(Frame& F) {
    const int gw = F.vcu * 8 + F.wave, NGW = F.G * 8;
    for (int rr = gw; rr < 4 * DFF; rr += NGW) {
        const bool second = rr >= 2 * DFF; const int r = second ? rr - 2 * DFF : rr;
        const bf16* W = second ? WSP(bf16, WS_WGU2) : WSP(bf16, WS_WGU1); unsigned char* Q = second ? WSP(unsigned char, WS_WGU2I8) : WSP(unsigned char, WS_WGU1I8); float* WSN = second ? WSP(float, WS_WSN2) : WSP(float, WS_WSN);
        const v4u a = *(const GAS v4u*)(W + (size_t)r * D + 8 * F.lane), b = *(const GAS v4u*)(W + (size_t)r * D + 512 + 8 * F.lane);
        float x[16]; { float t0[8], t1[8]; unpack8(a, t0); unpack8(b, t1);
#pragma unroll
            for (int e = 0; e < 8; ++e) { x[e] = t0[e]; x[8 + e] = t1[e]; } }
        float mx = 0.f;
#pragma unroll
        for (int e = 0; e < 16; ++e) mx = fmaxf(mx, fabsf(x[e]));
#pragma unroll
        for (int o = 1; o < 64; o <<= 1) mx = fmaxf(mx, __shfl_xor(mx, o));
        const float iq = mx > 0.f ? 127.0f / mx : 0.f;
        unsigned w[4];
#pragma unroll
        for (int e = 0; e < 4; ++e) { const int q0 = (int)__builtin_rintf(x[4 * e] * iq), q1 = (int)__builtin_rintf(x[4 * e + 1] * iq), q2 = (int)__builtin_rintf(x[4 * e + 2] * iq), q3 = (int)__builtin_rintf(x[4 * e + 3] * iq);
            w[e] = (unsigned)(q0 & 0xff) | ((unsigned)(q1 & 0xff) << 8) | ((unsigned)(q2 & 0xff) << 16) | ((unsigned)(q3 & 0xff) << 24); }
        *(GAS v2u*)(Q + (size_t)r * D + 8 * F.lane) = (v2u){w[0], w[1]};
        *(GAS v2u*)(Q + (size_t)r * D + 512 + 8 * F.lane) = (v2u){w[2], w[3]};
        if (F.lane == 0) WSN[r] = mx * (1.0f / 127.0f);
    }
}
__device__ __forceinline__ void p4_conv(Frame& F) {
    const int gw = F.vcu * 8 + F.wave, NGW = F.G * 8, ch = F.lane * 8;
    const bf16* U = WSP(bf16, WS_U); const bf16* GBp = WSP(bf16, WS_GB); bf16* CAT = WSP(bf16, WS_CAT);
    const float* conv_w = (const float*)F.in[13]; const float* conv_b = (const float*)F.in[14]; const float* cache_conv = (const float*)F.in[5];
    float w0[8], w1[8], w2[8], cb[8];
#pragma unroll
    for (int e = 0; e < 8; ++e) { w0[e] = conv_w[ch + e]; w1[e] = conv_w[512 + ch + e]; w2[e] = conv_w[1024 + ch + e]; cb[e] = conv_b[ch + e]; }
    for (int c = gw; c < MTOT / 8; c += NGW) {
        const int r0 = 8 * c;
        v4u ur[10], gr[8];
#pragma unroll
        for (int e = 0; e < 10; ++e) { const int rr = r0 - 2 + e; ur[e] = *(const GAS v4u*)(U + (size_t)(rr < 0 ? 0 : rr) * 512 + ch); }
#pragma unroll
        for (int e = 0; e < 8; ++e) gr[e] = *(const GAS v4u*)(GBp + (size_t)(r0 + e) * 512 + ch);
        float um2[8], um1[8];
        unpack8(ur[0], um2); unpack8(ur[1], um1);
        if (r0 < MP && (r0 & (SEQ - 1)) == 0) {
#pragma unroll
            for (int e = 0; e < 8; ++e) { um2[e] = 0.f; um1[e] = 0.f; } }
#pragma unroll
        for (int e = 0; e < 8; ++e) {
            if (r0 >= MP && (e & 3) == 0) {
                const float* cc = cache_conv + (size_t)((r0 - MP + e) >> 2) * 2 * 512 + ch;
#pragma unroll
                for (int q = 0; q < 8; ++q) { um2[q] = cc[q]; um1[q] = cc[512 + q]; } }
            float u0[8], g[8], y[8]; unpack8(ur[2 + e], u0); unpack8(gr[e], g);
#pragma unroll
            for (int q = 0; q < 8; ++q) { y[q] = g[q] * (cb[q] + w0[q] * um2[q] + w1[q] * um1[q] + w2[q] * u0[q]); um2[q] = um1[q]; um1[q] = u0[q]; }
            v4u o; o.x = pk2(y[0], y[1]); o.y = pk2(y[2], y[3]); o.z = pk2(y[4], y[5]); o.w = pk2(y[6], y[7]);
            *(GAS v4u*)(CAT + (size_t)(r0 + e) * D + ch) = o;
        }
    }
}
__device__ __forceinline__ int crow16(int r, int hi) { return (r & 3) + 8 * (r >> 2) + 4 * hi; }
__device__ __forceinline__ float xhalf_sum(float v) {
    auto rr = __builtin_amdgcn_permlane32_swap(__float_as_uint(v), __float_as_uint(v), false, false);
    return __uint_as_float(rr[0]) + __uint_as_float(rr[1]);
}
__device__ __forceinline__ void p4_sample_scores(Frame& F) {
    const int gw = F.vcu * 8 + F.wave, NGW = F.G * 8, lane = F.lane, r32 = lane & 31, hi = lane >> 5;
    const bf16* QI = WSP(bf16, WS_QI); const float* WIp = WSP(float, WS_WI); float* SSC = WSP(float, WS_SSC);
    const int* page_table = (const int*)F.in[6]; const float* cache_idx_k = (const float*)F.in[4];
    for (int item = gw; item < DB * NPAGES; item += NGW) {
        const int b = item >> 7, pg = item & 127; const int page = page_table[b * NPAGES + pg];
        bf16x8 a[4]; f32x4 w4[4];
        { const bf16* qrow = QI + (size_t)(MP + 4 * b + (r32 >> 3)) * 512 + (r32 & 7) * 64 + 8 * hi;
#pragma unroll
          for (int s = 0; s < 4; ++s) a[s] = *(const GAS bf16x8*)(qrow + 16 * s);
#pragma unroll
          for (int q = 0; q < 4; ++q) w4[q] = *(const GAS f32x4*)(WIp + (size_t)(MP + 4 * b + q) * 8 + 4 * hi); }
        const float* src = cache_idx_k + ((size_t)page * PAGE + r32) * 64 + 8 * hi;
        f32x4 lo[4][4], hh[4][4];
#pragma unroll
        for (int sub = 0; sub < 4; ++sub)
#pragma unroll
            for (int s = 0; s < 4; ++s) { lo[sub][s] = __builtin_nontemporal_load((const f32x4*)(src + sub * 32 * 64 + 16 * s)); hh[sub][s] = __builtin_nontemporal_load((const f32x4*)(src + sub * 32 * 64 + 16 * s + 4)); }
#pragma unroll
        for (int sub = 0; sub < 4; ++sub) {
            f32x16 acc = {};
#pragma unroll
            for (int s = 0; s < 4; ++s) { v4u p; p.x = pk2(lo[sub][s][0], lo[sub][s][1]); p.y = pk2(lo[sub][s][2], lo[sub][s][3]); p.z = pk2(hh[sub][s][0], hh[sub][s][1]); p.w = pk2(hh[sub][s][2], hh[sub][s][3]);
                acc = __builtin_amdgcn_mfma_f32_32x32x16_bf16(a[s], __builtin_bit_cast(bf16x8, p), acc, 0, 0, 0); }
#pragma unroll
            for (int q = 0; q < 4; ++q) {
                float sum = w4[q][0] * fmaxf(acc[4 * q], 0.f) + w4[q][1] * fmaxf(acc[4 * q + 1], 0.f) + w4[q][2] * fmaxf(acc[4 * q + 2], 0.f) + w4[q][3] * fmaxf(acc[4 * q + 3], 0.f);
                sum = xhalf_sum(sum) + 0.0f;
                if ((q >> 1) == hi) SSC[(size_t)(4 * b + q) * SSTR + pg * PAGE + sub * 32 + r32] = sum;
            }
        }
    }
}
__device__ __forceinline__ unsigned fkey(float s) { const unsigned b = __builtin_bit_cast(unsigned, s); return b ^ ((unsigned)((int)b >> 31) | 0x80000000u); }
__device__ __forceinline__ float unfkey(unsigned k) { const unsigned b = (k & 0x80000000u) ? (k ^ 0x80000000u) : ~k; return __builtin_bit_cast(float, b); }
__device__ __forceinline__ unsigned wave_umax(unsigned v) {
    unsigned o;
    o = (unsigned)__builtin_amdgcn_update_dpp(0, (int)v, 0xB1, 0xF, 0xF, true); v = o > v ? o : v;
    o = (unsigned)__builtin_amdgcn_update_dpp(0, (int)v, 0x4E, 0xF, 0xF, true); v = o > v ? o : v;
    o = (unsigned)__builtin_amdgcn_update_dpp(0, (int)v, 0x141, 0xF, 0xF, true); v = o > v ? o : v;
    o = (unsigned)__builtin_amdgcn_update_dpp(0, (int)v, 0x140, 0xF, 0xF, true); v = o > v ? o : v;
    const unsigned a = (unsigned)__builtin_amdgcn_readlane((int)v, 0), b = (unsigned)__builtin_amdgcn_readlane((int)v, 16), c = (unsigned)__builtin_amdgcn_readlane((int)v, 32), d = (unsigned)__builtin_amdgcn_readlane((int)v, 48);
    const unsigned ab = a > b ? a : b, cd = c > d ? c : d; return ab > cd ? ab : cd;
}
__device__ __forceinline__ int wave_count(unsigned cl) {
    int tot = 0;
#pragma unroll
    for (int bb = 0; bb < 6; ++bb) tot += __popcll(__ballot((cl >> bb) & 1u)) << bb;
    return tot;
}
__device__ __forceinline__ void p4_index_preload(Frame& F, int b, int j, bf16x8 (&a)[4][4], float& pwq) {
    const int tid = F.tid, r32 = F.lane & 31, hi = F.lane >> 5; const size_t rowb = (size_t)b * SEQ; const int t0 = 16 * j;
    const bf16* QI = WSP(bf16, WS_QI); const float* WIp = WSP(float, WS_WI);
    pwq = WIp[(rowb + t0 + ((tid & 127) >> 3)) * 8 + (tid & 7)];
#pragma unroll
    for (int rt = 0; rt < 4; ++rt) { const bf16* qrow = QI + (rowb + t0 + 4 * rt + 2 * (r32 >> 4) + ((r32 >> 2) & 1)) * 512 + (4 * ((r32 >> 3) & 1) + (r32 & 3)) * 64 + 8 * hi;
#pragma unroll
        for (int s = 0; s < 4; ++s) a[rt][s] = *(const GAS bf16x8*)(qrow + 16 * s); }
}
__device__ __forceinline__ void p4_index_unit(Frame& F, int b, int j, int useq, bf16x8 (&a)[4][4], float& pwq, int nj) {
    const int tid = F.tid, lane = F.lane, wid = F.wave, r32 = lane & 31, hi = lane >> 5;
    const int ss_id = (F.vcu * 8 + useq) * 8 + wid, ss_item = ss_id >> 2, ss_sub = ss_id & 3, ss_b = ss_item >> 7, ss_pg = ss_item & 127;
    const bool ss_on = F.vcu < 256;
    const int ss_page = ss_on ? ((const int*)F.in[6])[ss_b * NPAGES + ss_pg] : 0;
    const int t0 = 16 * j, nk = t0 + 16, ntile = (nk + 31) >> 5;
    LAS float* S = (LAS float*)(F.lds + RING_OFF);
    LAS float* WQ = (LAS float*)(F.lds + RING_OFF + 131072);
    LAS unsigned long long* MSK = (LAS unsigned long long*)(F.lds + RING_OFF + 131072 + 512);
    LAS unsigned* HW = (LAS unsigned*)(F.lds + RING_OFF + 131072 + 512 + 4096) + wid * 512;
    const bf16* QI = WSP(bf16, WS_QI); const bf16* KIB = WSP(bf16, WS_KIB); const float* WIp = WSP(float, WS_WI);
    unsigned long long* MASK = WSP(unsigned long long, WS_MASK);
    const size_t rowb = (size_t)b * SEQ;
    for (int rep43 = 0; rep43 < (PROBE_DUP == 43 ? 2 : 1); ++rep43)
    if (j >= 16) {
        if (tid < 128) WQ[tid] = pwq;
        const bf16* kbase = KIB + (rowb + r32) * 64 + 8 * hi;
#define IDX_LOADB(dst, kt_) do { const int kc_ = (kt_) < ntile ? (kt_) : ntile - 1; _Pragma("unroll") for (int s = 0; s < 4; ++s) dst[s] = *(const GAS bf16x8*)(kbase + (size_t)kc_ * 32 * 64 + 16 * s); } while (0)
#define RELU_(x_) __builtin_amdgcn_fmed3f((x_), 0.f, inf_)
#define IDX_COMPUTE(bf_, kt_) do { const int key = (kt_) * 32 + r32; \
            _Pragma("unroll") for (int rt = 0; rt < 4; ++rt) { f32x16 acc = {}; \
                _Pragma("unroll") for (int s = 0; s < 4; ++s) acc = __builtin_amdgcn_mfma_f32_32x32x16_bf16(a[rt][s], bf_[s], acc, 0, 0, 0); \
                _Pragma("unroll") for (int qp = 0; qp < 2; ++qp) { const int ql_ = 4 * rt + 2 * qp + hi;                      \
                    const f32x4 wa = *(const LAS f32x4*)(WQ + ql_ * 8), wb = *(const LAS f32x4*)(WQ + ql_ * 8 + 4); \
                    typedef float f2_ __attribute__((ext_vector_type(2))); const f2_ z2_ = {0.f, 0.f};                        \
                    f2_ s2_ = (f2_){RELU_(acc[8 * qp + 0]), RELU_(acc[8 * qp + 1])} * (f2_){wa[0], wa[1]}; \
                    s2_ = (f2_){RELU_(acc[8 * qp + 2]), RELU_(acc[8 * qp + 3])} * (f2_){wa[2], wa[3]} + s2_; \
                    s2_ = (f2_){RELU_(acc[8 * qp + 4]), RELU_(acc[8 * qp + 5])} * (f2_){wb[0], wb[1]} + s2_; \
                    s2_ = (f2_){RELU_(acc[8 * qp + 6]), RELU_(acc[8 * qp + 7])} * (f2_){wb[2], wb[3]} + s2_; \
                    S[ql_ * 2048 + key] = (s2_.x + s2_.y) + 0.0f; } } } while (0)
        float inf_ = __builtin_inff(); asm volatile("" : "+v"(inf_));
        bf16x8 bfA[4], bfB[4];
        IDX_LOADB(bfA, wid);
        __syncthreads();
        for (int kt = wid; kt < ntile; kt += 16) {
            IDX_LOADB(bfB, kt + 8);
            IDX_COMPUTE(bfA, kt);
            if (kt + 8 < ntile) { IDX_LOADB(bfA, kt + 16); IDX_COMPUTE(bfB, kt + 8); }
        }
#undef IDX_LOADB
#undef IDX_COMPUTE
#undef RELU_
        __syncthreads();
    }
    if (nj >= 16) p4_index_preload(F, b, nj, a, pwq);
    bf16x8 ss_a[4]; f32x4 ss_w[4], ss_lo[4], ss_hh[4];
    { const bf16* qrow = QI + (size_t)(MP + 4 * ss_b + (r32 >> 3)) * 512 + (r32 & 7) * 64 + 8 * hi;
      const float* src = ((const float*)F.in[4]) + ((size_t)ss_page * PAGE + ss_sub * 32 + r32) * 64 + 8 * hi;
#pragma unroll
      for (int s = 0; s < 4; ++s) { ss_lo[s] = __builtin_nontemporal_load((const f32x4*)(src + 16 * s)); ss_hh[s] = __builtin_nontemporal_load((const f32x4*)(src + 16 * s + 4)); }
#pragma unroll
      for (int s = 0; s < 4; ++s) ss_a[s] = *(const GAS bf16x8*)(qrow + 16 * s);
#pragma unroll
      for (int q = 0; q < 4; ++q) ss_w[q] = *(const GAS f32x4*)(WIp + (size_t)(MP + 4 * ss_b + q) * 8 + 4 * hi); }
#pragma unroll 1
    for (int qq = 0; qq < (PROBE_DUP == 44 ? 4 : 2); ++qq) {
        const int ql = 2 * wid + (qq & 1), t = t0 + ql;
        unsigned wlo = 0u, whi = 0u;
        if (t < KTOP) {
            const int lo_ = 64 * lane; const unsigned long long w_ = (lo_ + 63 <= t) ? ~0ull : (lo_ > t ? 0ull : ((1ull << (t - lo_ + 1)) - 1ull));
            wlo = (unsigned)w_; whi = (unsigned)(w_ >> 32);
        } else {
            bool done = false;
            { unsigned kv[32]; float amf = 0.f;
              const int ngr = (t >> 8) + 1;
#pragma unroll
              for (int g4 = 0; g4 < 8; ++g4) {
#pragma unroll
                  for (int e = 0; e < 4; ++e) kv[4 * g4 + e] = 0u;
                  if (g4 < ngr) {
                      float s4[4];
#pragma unroll
                      for (int e = 0; e < 4; ++e) s4[e] = S[ql * 2048 + lane + 64 * (4 * g4 + e)];
                      if (g4 == ngr - 1) {
#pragma unroll
                          for (int e = 0; e < 4; ++e) s4[e] = (lane + 64 * (4 * g4 + e) <= t) ? s4[e] : 0.f; }
#pragma unroll
                      for (int e = 0; e < 4; ++e) { kv[4 * g4 + e] = __float_as_uint(s4[e]); amf = fmaxf(amf, fabsf(s4[e])); } } }
              const unsigned am = wave_umax(__float_as_uint(amf));
              const float scale = am ? 0.4999f / __uint_as_float(am) : 0.f;
#pragma unroll
              for (int g4 = 0; g4 < 8; ++g4) if (g4 < ngr) {
#pragma unroll
                  for (int e = 0; e < 4; ++e) { const int jj = 4 * g4 + e; kv[jj] = __float_as_uint(__builtin_fmaf(__uint_as_float(kv[jj]), scale, 1.5f)); }
                  if (g4 == ngr - 1) {
#pragma unroll
                      for (int e = 0; e < 4; ++e) { const int jj = 4 * g4 + e; kv[jj] = (lane + 64 * jj <= t) ? kv[jj] : 0u; } } }
              unsigned pfx = 0x3F800000u, Tv = 0u; int need = KTOP;
              const unsigned hwb = (unsigned)(uintptr_t)HW;
#pragma unroll 1
              for (int pass = 0; pass < 3; ++pass) {
                  const int sh = pass == 0 ? 14 : pass == 1 ? 5 : 0;
                  const unsigned lim = pass == 2 ? 32u : (512u << sh);
                  *(LAS v4u*)(HW + 8 * lane) = (v4u){0u, 0u, 0u, 0u}; *(LAS v4u*)(HW + 8 * lane + 4) = (v4u){0u, 0u, 0u, 0u};
                  asm volatile("" ::: "memory");
#pragma unroll
                  for (int g4 = 0; g4 < 8; ++g4) if (g4 < ngr) {
#pragma unroll
                      for (int e = 0; e < 4; ++e) { const unsigned d_ = kv[4 * g4 + e] ^ pfx;
                          if (d_ < lim) __hip_atomic_fetch_add((LAS unsigned*)(uintptr_t)(hwb + ((d_ >> sh) << 2)), 1u, __ATOMIC_RELAXED, __HIP_MEMORY_SCOPE_WAVEFRONT); } }
                  asm volatile("" ::: "memory");
                  const v4u w0 = *(const LAS v4u*)(HW + 8 * lane), w1 = *(const LAS v4u*)(HW + 8 * lane + 4);
                  asm volatile("" ::: "memory");
                  const unsigned ls = ((w0[0] + w0[1]) + (w0[2] + w0[3])) + ((w1[0] + w1[1]) + (w1[2] + w1[3]));
                  unsigned p = ls;
                  p += (unsigned)__builtin_amdgcn_update_dpp(0, (int)p, 0x111, 0xF, 0xF, false);
                  p += (unsigned)__builtin_amdgcn_update_dpp(0, (int)p, 0x112, 0xF, 0xF, false);
                  p += (unsigned)__builtin_amdgcn_update_dpp(0, (int)p, 0x114, 0xF, 0xF, false);
                  p += (unsigned)__builtin_amdgcn_update_dpp(0, (int)p, 0x118, 0xF, 0xF, false);
                  const unsigned r0 = (unsigned)__builtin_amdgcn_readlane((int)p, 15), r1 = (unsigned)__builtin_amdgcn_readlane((int)p, 31), r2 = (unsigned)__builtin_amdgcn_readlane((int)p, 47), r3 = (unsigned)__builtin_amdgcn_readlane((int)p, 63);
                  const int row_ = lane >> 4; p += (row_ == 0) ? 0u : (row_ == 1) ? r0 : (row_ == 2) ? r0 + r1 : r0 + r1 + r2;
                  const unsigned tot = r0 + r1 + r2 + r3;
                  const unsigned abl = tot - p;
                  const unsigned long long fm = __ballot((int)abl < need && (int)(abl + ls) >= need);
                  const int src = (int)__builtin_ctzll(fm);
                  const unsigned abs_ = (unsigned)__builtin_amdgcn_readlane((int)abl, src);
                  const unsigned ci = ((lane & 15) < 8) ? HW[8 * src + (lane & 7)] : 0u;
                  unsigned sfx = ci;
                  sfx += (unsigned)__builtin_amdgcn_update_dpp(0, (int)sfx, 0x101, 0xF, 0xF, false);
                  sfx += (unsigned)__builtin_amdgcn_update_dpp(0, (int)sfx, 0x102, 0xF, 0xF, false);
                  sfx += (unsigned)__builtin_amdgcn_update_dpp(0, (int)sfx, 0x104, 0xF, 0xF, false);
                  const unsigned abi = abs_ + sfx - ci;
                  const unsigned long long fb = __ballot(lane < 8 && (int)abi < need && (int)(abi + ci) >= need);
                  const int sl2 = (int)__builtin_ctzll(fb);
                  const unsigned dgb = (unsigned)(8 * src + sl2), above = (unsigned)__builtin_amdgcn_readlane((int)abi, sl2), binc = (unsigned)__builtin_amdgcn_readlane((int)ci, sl2);
                  pfx |= dgb << sh; need -= (int)above; Tv = pfx;
                  if ((int)binc == need) { done = true; break; }
              }
              if (done) {
#pragma unroll
                  for (int j4 = 0; j4 < 8; ++j4) if (j4 < ngr) {
                      const unsigned long long wa = __ballot(kv[4 * j4] >= Tv), wb = __ballot(kv[4 * j4 + 1] >= Tv), wc_ = __ballot(kv[4 * j4 + 2] >= Tv), wd = __ballot(kv[4 * j4 + 3] >= Tv);
                      asm("s_nop 1\n\tv_writelane_b32 %0, %2, %10\n\tv_writelane_b32 %1, %3, %10\n\tv_writelane_b32 %0, %4, %11\n\tv_writelane_b32 %1, %5, %11\n\tv_writelane_b32 %0, %6, %12\n\tv_writelane_b32 %1, %7, %12\n\tv_writelane_b32 %0, %8, %13\n\tv_writelane_b32 %1, %9, %13"
                          : "+v"(wlo), "+v"(whi) : "s"((unsigned)wa), "s"((unsigned)(wa >> 32)), "s"((unsigned)wb), "s"((unsigned)(wb >> 32)), "s"((unsigned)wc_), "s"((unsigned)(wc_ >> 32)), "s"((unsigned)wd), "s"((unsigned)(wd >> 32)),
                            "n"(4 * j4), "n"(4 * j4 + 1), "n"(4 * j4 + 2), "n"(4 * j4 + 3));
                  }
              }
            }
            if (!done) {
            unsigned uu[32];
#pragma unroll
            for (int jj = 0; jj < 32; ++jj) { const float s = S[ql * 2048 + lane + 64 * jj]; const unsigned k_ = fkey(s); uu[jj] = (lane + 64 * jj <= t) ? k_ : 0u; }
            const int ng = (t >> 8) + 1;
#define SEL_GRP(g4, CAND) if ((g4) < ng) { unsigned long long m0_, m1_, m2_, m3_; \
                    asm volatile("v_cmp_ge_u32_e64 %0, %4, %8\n\tv_cmp_ge_u32_e64 %1, %5, %8\n\tv_cmp_ge_u32_e64 %2, %6, %8\n\tv_cmp_ge_u32_e64 %3, %7, %8" \
                        : "=&s"(m0_), "=&s"(m1_), "=&s"(m2_), "=&s"(m3_) : "v"(uu[4 * (g4)]), "v"(uu[4 * (g4) + 1]), "v"(uu[4 * (g4) + 2]), "v"(uu[4 * (g4) + 3]), "v"(CAND)); \
                    cnt_ += __popcll(m0_) + __popcll(m1_) + __popcll(m2_) + __popcll(m3_); }
#define SEL_COUNT(CAND, OUT) do { int cnt_ = 0; SEL_GRP(0, CAND) SEL_GRP(1, CAND) SEL_GRP(2, CAND) SEL_GRP(3, CAND) SEL_GRP(4, CAND) SEL_GRP(5, CAND) SEL_GRP(6, CAND) SEL_GRP(7, CAND) OUT = cnt_; } while (0)
            unsigned T = 0u; int clo = t + 1;
#pragma unroll 1
            for (int bit = 31; bit >= 0; --bit) {
                const unsigned cand = T | (1u << bit); int c; SEL_COUNT(cand, c);
                if (c >= KTOP) { T = cand; clo = c; if (c == KTOP) break; }
            }
            if (clo == KTOP) {
#pragma unroll
                for (int jj = 0; jj < 32; ++jj) { const unsigned long long word = __ballot(uu[jj] >= T);
                    asm("s_nop 1\n\tv_writelane_b32 %0, %2, %4\n\tv_writelane_b32 %1, %3, %4" : "+v"(wlo), "+v"(whi) : "s"((unsigned)word), "s"((unsigned)(word >> 32)), "n"(jj));     }
            } else {
                int cgt; { const unsigned Tp = T + 1u; SEL_COUNT(Tp, cgt); }
                const int need = KTOP - cgt; int running = 0;
#pragma unroll
                for (int jj = 0; jj < 32; ++jj) {
                    const unsigned long long eq = __ballot(uu[jj] == T);
                    const int rank = (int)__builtin_amdgcn_mbcnt_hi((unsigned)(eq >> 32), __builtin_amdgcn_mbcnt_lo((unsigned)eq, 0u));
                    const unsigned long long word = __ballot(uu[jj] > T || (uu[jj] == T && running + rank < need));
                    asm("s_nop 1\n\tv_writelane_b32 %0, %2, %4\n\tv_writelane_b32 %1, %3, %4" : "+v"(wlo), "+v"(whi) : "s"((unsigned)word), "s"((unsigned)(word >> 32)), "n"(jj));
                    running += __popcll(eq);
                }
            }
            }
#undef SEL_COUNT
#undef SEL_GRP
        }
        if (lane < 32) MSK[ql * 32 + lane] = ((unsigned long long)whi << 32) | wlo;
    }
    if (ss_on) { f32x16 acc = {};
#pragma unroll
        for (int s = 0; s < 4; ++s) { v4u p; p.x = pk2(ss_lo[s][0], ss_lo[s][1]); p.y = pk2(ss_lo[s][2], ss_lo[s][3]); p.z = pk2(ss_hh[s][0], ss_hh[s][1]); p.w = pk2(ss_hh[s][2], ss_hh[s][3]);
            acc = __builtin_amdgcn_mfma_f32_32x32x16_bf16(ss_a[s], __builtin_bit_cast(bf16x8, p), acc, 0, 0, 0); }
        float* SSC = WSP(float, WS_SSC);
#pragma unroll
        for (int q = 0; q < 4; ++q) {
            float sum = ss_w[q][0] * fmaxf(acc[4 * q], 0.f) + ss_w[q][1] * fmaxf(acc[4 * q + 1], 0.f) + ss_w[q][2] * fmaxf(acc[4 * q + 2], 0.f) + ss_w[q][3] * fmaxf(acc[4 * q + 3], 0.f);
            sum = xhalf_sum(sum) + 0.0f;
            if ((q >> 1) == hi) SSC[(size_t)(4 * ss_b + q) * SSTR + ss_pg * PAGE + ss_sub * 32 + r32] = sum;
        } }
    __syncthreads();
    { const int jt = tid >> 4, ql = tid & 15; MASK[((size_t)b * 32 + jt) * SEQ + t0 + ql] = MSK[ql * 32 + jt]; }
    __syncthreads();
}
__device__ __forceinline__ void p4_index(Frame& F) {
    if (F.vcu >= 256) return;
    const int b = F.vcu >> 4, w = F.vcu & 15;
    bf16x8 pa[4][4]; float pwq;
    p4_index_preload(F, b, 127 - w, pa, pwq);
#pragma unroll 1
    for (int k = 0; k < 4; ++k) { const int j1 = w + 16 * k; p4_index_unit(F, b, 127 - j1, 2 * k, pa, pwq, j1); p4_index_unit(F, b, j1, 2 * k + 1, pa, pwq, k < 3 ? 127 - (j1 + 16) : -1); }
}

__device__ __forceinline__ int block_sum8(LAS int* red, int par, int wid, int lane, int v) {
    if (lane == 0) red[par * 8 + wid] = v;
    __syncthreads();
    int s = 0;
#pragma unroll
    for (int w = 0; w < 8; ++w) s += red[par * 8 + w];
    return s;
}
__device__ __forceinline__ void p5_sample_unit(Frame& F, int sq) {
    const int tid = F.tid, lane = F.lane, wid = F.wave;
    const int b = sq >> 2, qi_ = sq & 3, row = MP + sq;
    LAS unsigned char* L0 = F.lds + RING_OFF;
    LAS int* red = (LAS int*)(L0);
    LAS float* newsc = (LAS float*)(L0 + 64);
    LAS int* wcnt = (LAS int*)(L0 + 128);
    LAS int* eqw = (LAS int*)(L0 + 256);
    LAS int* selidx = (LAS int*)(L0 + 2048);
    LAS float* LG = (LAS float*)(L0 + 4096);
    LAS float* OP = (LAS float*)(L0 + 16384);
    const bf16* QI = WSP(bf16, WS_QI); const bf16* KIB = WSP(bf16, WS_KIB); const float* WIp = WSP(float, WS_WI); const float* SSC = WSP(float, WS_SSC);
    const bf16* Qb = WSP(bf16, WS_Q); bf16* CAT = WSP(bf16, WS_CAT);
    if (tid < 64) {
        const int h = (tid >> 2) & 7, jn = tid & 3; float dot = 0.f;
        const bf16* qp = QI + (size_t)row * 512 + h * 64; const bf16* kp = KIB + (size_t)(MP + 4 * b + jn) * 64;
        for (int d = 0; d < 64; ++d) dot += bf2f(qp[d]) * bf2f(kp[d]);
        float v = WIp[(size_t)row * 8 + h] * fmaxf(dot, 0.f);
        v += __shfl_xor(v, 4); v += __shfl_xor(v, 8); v += __shfl_xor(v, 16);
        if (tid < 4) newsc[tid] = (jn <= qi_) ? (v + 0.0f) : -INFINITY;
    }
    __syncthreads();
    unsigned uu[33];
#pragma unroll
    for (int jj = 0; jj < 32; ++jj) uu[jj] = fkey(SSC[(size_t)sq * SSTR + tid + 512 * jj]);
    uu[32] = tid < 4 ? fkey(newsc[tid]) : 0x007FFFFFu;
    unsigned T = 0u; int par = 0;
#pragma unroll 1
    for (int bit = 31; bit >= 0; --bit) {
        const unsigned cand = T | (1u << bit); int c = 0;
#pragma unroll
        for (int jj = 0; jj < 33; ++jj) c += __popcll(__ballot(uu[jj] >= cand));
        c = block_sum8(red, par, wid, lane, c); par ^= 1;
        if (c >= KTOP) { T = cand; if (c == KTOP) break; }
    }
    int cgt = 0;
#pragma unroll
    for (int jj = 0; jj < 33; ++jj) cgt += __popcll(__ballot(uu[jj] > T));
    cgt = block_sum8(red, par, wid, lane, cgt); par ^= 1;
    const int need = KTOP - cgt;
#pragma unroll
    for (int jj = 0; jj < 33; ++jj) { const int n = __popcll(__ballot(uu[jj] == T)); if (lane == 0) eqw[jj * 8 + wid] = n; }
    __syncthreads();
#define SEL_MASK(jj, eqbase, M) do { int below_ = 0, tot_ = 0; \
        _Pragma("unroll") for (int w = 0; w < 8; ++w) { const int n_ = eqw[(jj) * 8 + w]; tot_ += n_; below_ += (w < wid) ? n_ : 0; } \
        const unsigned long long eq_ = __ballot(uu[jj] == T); \
        const int rank_ = (eqbase) + below_ + (int)__builtin_amdgcn_mbcnt_hi((unsigned)(eq_ >> 32), __builtin_amdgcn_mbcnt_lo((unsigned)eq_, 0u)); \
        M = __ballot(uu[jj] > T || (uu[jj] == T && rank_ < need)); (eqbase) += tot_; } while (0)
    { int cw = 0, eqbase = 0;
#pragma unroll
      for (int jj = 0; jj < 33; ++jj) { unsigned long long m; SEL_MASK(jj, eqbase, m); cw += __popcll(m); }
      if (lane == 0) wcnt[wid] = cw; }
    __syncthreads();
    { int base = 0, eqbase = 0;
#pragma unroll
      for (int w = 0; w < 8; ++w) base += (w < wid) ? wcnt[w] : 0;
#pragma unroll
      for (int jj = 0; jj < 33; ++jj) { unsigned long long m; SEL_MASK(jj, eqbase, m);
          const int pos = base + (int)__builtin_amdgcn_mbcnt_hi((unsigned)(m >> 32), __builtin_amdgcn_mbcnt_lo((unsigned)m, 0u));
          if ((m >> lane) & 1ull) { if (pos < KTOP) selidx[pos] = (jj < 32) ? tid + 512 * jj : PAST + tid; }
          base += __popcll(m); } }
#undef SEL_MASK
    __syncthreads();
    const int kk = lane >> 3, ds = lane & 7;
    const float* kptr[4]; const float* vptr[4];
#pragma unroll
    for (int it = 0; it < 4; ++it) {
        const int kidx = selidx[32 * wid + 8 * it + kk];
        if (kidx < PAST) { const size_t pr = (size_t)((const int*)F.in[6])[b * NPAGES + (kidx >> 7)] * PAGE + (kidx & 127); kptr[it] = ((const float*)F.in[2]) + pr * 128 + 8 * ds; vptr[it] = ((const float*)F.in[3]) + pr * 128 + 8 * ds; }
        else { const size_t nr = (size_t)(4 * b + (kidx - PAST)); kptr[it] = F.out + O_KS + nr * 128 + 8 * ds; vptr[it] = F.out + O_VS + nr * 128 + 8 * ds; }
    }
#pragma unroll 1
    for (int g = 0; g < 2; ++g) {
        float qv[4][8];
#pragma unroll
        for (int r = 0; r < 4; ++r) { const v4u qq = *(const GAS v4u*)(Qb + (size_t)row * 512 + (4 * g + r) * 64 + 8 * ds);
#pragma unroll
            for (int e = 0; e < 4; ++e) { qv[r][2 * e] = bf2f((unsigned short)(qq[e] & 0xffffu)); qv[r][2 * e + 1] = bf2f((unsigned short)(qq[e] >> 16)); } }
#pragma unroll
        for (int it = 0; it < 4; ++it) {
            const f32x4 k0 = *(const f32x4*)(kptr[it] + 64 * g), k1 = *(const f32x4*)(kptr[it] + 64 * g + 4);
#pragma unroll
            for (int r = 0; r < 4; ++r) {
                float d = (qv[r][0] * k0[0] + qv[r][1] * k0[1]) + (qv[r][2] * k0[2] + qv[r][3] * k0[3]) + (qv[r][4] * k1[0] + qv[r][5] * k1[1]) + (qv[r][6] * k1[2] + qv[r][7] * k1[3]);
                d += __shfl_xor(d, 1); d += __shfl_xor(d, 2); d += __shfl_xor(d, 4);
                if (ds == 0) LG[(4 * g + r) * 256 + 32 * wid + 8 * it + kk] = d;
            }
        }
    }
    __syncthreads();
    { float l[4];
#pragma unroll
      for (int e = 0; e < 4; ++e) l[e] = LG[wid * 256 + lane + 64 * e];
      const float m = wave_max(fmaxf(fmaxf(l[0], l[1]), fmaxf(l[2], l[3])));
      float p[4], s = 0.f;
#pragma unroll
      for (int e = 0; e < 4; ++e) { p[e] = __builtin_amdgcn_exp2f(l[e] - m); s += p[e]; }
      s = wave_sum(s); const float inv = 1.0f / s;
#pragma unroll
      for (int e = 0; e < 4; ++e) LG[wid * 256 + lane + 64 * e] = p[e] * inv; }
    __syncthreads();
#pragma unroll 1
    for (int g = 0; g < 2; ++g) {
        float acc[4][8];
#pragma unroll
        for (int r = 0; r < 4; ++r)
#pragma unroll
            for (int e = 0; e < 8; ++e) acc[r][e] = 0.f;
#pragma unroll
        for (int it = 0; it < 4; ++it) {
            const f32x4 v0 = *(const f32x4*)(vptr[it] + 64 * g), v1 = *(const f32x4*)(vptr[it] + 64 * g + 4);
#pragma unroll
            for (int r = 0; r < 4; ++r) { const float p = LG[(4 * g + r) * 256 + 32 * wid + 8 * it + kk];
#pragma unroll
                for (int e = 0; e < 4; ++e) { acc[r][e] += p * v0[e]; acc[r][4 + e] += p * v1[e]; } }
        }
#pragma unroll
        for (int r = 0; r < 4; ++r)
#pragma unroll
            for (int e = 0; e < 8; ++e) { float a = acc[r][e]; a += __shfl_xor(a, 8); a += __shfl_xor(a, 16); a += __shfl_xor(a, 32); if (kk == 0) OP[(wid * 8 + 4 * g + r) * 64 + 8 * ds + e] = a; }
    }
    __syncthreads();
    { const int hd = tid >> 6, d = tid & 63; float o = 0.f;
#pragma unroll
      for (int w = 0; w < 8; ++w) o += OP[(w * 8 + hd) * 64 + d];
      CAT[(size_t)row * D + 512 + hd * 64 + d] = (bf16)f2bf(o); }
    __syncthreads();
}

constexpr int N_PHASES = 9;
struct Args { const void* in[22]; float* out; unsigned char* ws; int ph_lo, ph_hi, use_bar, pad; };
__global__ void __launch_bounds__(512, 2) hymba_fwd(Args args) {
    extern __shared__ __attribute__((aligned(16))) unsigned char lds[];
    Frame F;
    F.lds = (LAS unsigned char*)lds;
    F.MISC = (volatile LAS unsigned*)(F.lds + MISC_OFF);
    F.tid = threadIdx.x; F.lane = F.tid & 63; F.wave = __builtin_amdgcn_readfirstlane(F.tid >> 6);
    F.G = gridDim.x; { const int bx = blockIdx.x; F.vcu = (F.G % 8 == 0) ? (bx % 8) * (F.G / 8) + bx / 8 : bx; }
    F.ws = args.ws; F.out = args.out; F.ctl = (gu32*)(args.ws + WS_CTL);
    F.in = args.in;
    for (int u = F.tid; u < (LDS_BYTES - LDSCTL_OFF) / 4; u += 512) ((LAS unsigned*)(F.lds + LDSCTL_OFF))[u] = 0u;
    __syncthreads();
    XcdBarrier bar; bar.bar = (unsigned*)(F.ctl + CW_BAR); bar.x = 0; bar.st = nullptr;
    if (args.use_bar) bar = xcd_barrier_post((unsigned*)(F.ctl + CW_BAR), F.MISC + 8);
    const int lo = args.ph_lo, hi = args.ph_hi;
#define IN(k) (lo <= (k) && (k) < hi)
#define SEAM(k) do { if (IN(k) && IN((k) + 1)) { xcd_barrier(bar); if (PROBE_DUP == 60) xcd_barrier(bar); } } while (0)
    const int cblk = (int)blockIdx.x;

#ifndef PROBE_DUP
#define PROBE_DUP (-1)
#endif
#define RUNPHASE(k, ...) do { if (IN(k)) { { int t_ = F.tid; asm volatile("" : "+v"(t_)); F.tid = t_; F.lane = t_ & 63; }     \
        __VA_ARGS__; if (PROBE_DUP == (k)) { if (args.use_bar) xcd_barrier(bar); __VA_ARGS__; } } SEAM(k); } while (0)
#define RSTAB ((LAS float*)(F.lds + RING_OFF + 131072))
#define GEMM_PHASE(EPI, A_, B_, N_, K_, SS_, NSLOT_, ...) do { pg8::Gemm g{A_, B_, MP, N_, K_}; pg8::StaticOrder S; S.init(MP, N_, F.G, cblk); \
        if ((NSLOT_) > 0) fill_rstd_table(RSTAB, S, SS_, NSLOT_); \
        EPI E{__VA_ARGS__}; \
        pg8::gemm_phase<EPI, pg8::StaticOrder, true, true>(F.lds + RING_OFF, g, S, E); \
        skinny_phase(F.lds + RING_OFF, A_, B_, N_, K_, cblk, F.G, E); if (PROBE_DUP == 50) skinny_phase(F.lds + RING_OFF, A_, B_, N_, K_, cblk, F.G, E); } while (0)
#define GEMM_PHASE8(EPI, A8_, B8_, A_, B_, N_, K_, SS_, NSLOT_, ...) do { pg8::Gemm g{(const bf16*)(A8_), (const bf16*)(B8_), MP, N_, (K_) / 2}; pg8::StaticOrder S; S.init(MP, N_, F.G, cblk); \
        if ((NSLOT_) > 0) fill_rstd_table(RSTAB, S, SS_, NSLOT_); \
        EPI E{__VA_ARGS__}; \
        pg8::gemm_phase<EPI, pg8::StaticOrder, true, true, 1>(F.lds + RING_OFF, g, S, E); \
        skinny_phase(F.lds + RING_OFF, A_, B_, N_, K_, cblk, F.G, E); if (PROBE_DUP == 52) skinny_phase(F.lds + RING_OFF, A_, B_, N_, K_, cblk, F.G, E); } while (0)
#define GEMM_PHASEI(EPI, A8_, B8_, XS_, A_, B_, N_, K_, SS_, NSLOT_, ...) do { pg8::Gemm g{(const bf16*)(A8_), (const bf16*)(B8_), MP, N_, (K_) / 2}; pg8::StaticOrder S; S.init(MP, N_, F.G, cblk); \
        fill_rstd_table(RSTAB, S, SS_, NSLOT_, XS_); \
        EPI E{__VA_ARGS__}; \
        pg8::gemm_phase<EPI, pg8::StaticOrder, true, true, 2>(F.lds + RING_OFF, g, S, E); \
        skinny_phase(F.lds + RING_OFF, A_, B_, N_, K_, cblk, F.G, E); if (PROBE_DUP == 52) skinny_phase(F.lds + RING_OFF, A_, B_, N_, K_, cblk, F.G, E); } while (0)
    RUNPHASE(0, do { p0_prologue(F); xcd_barrier(bar); p0b_quant_weights(F); } while (0));
    RUNPHASE(1, GEMM_PHASEI(EpiGU, WSP(unsigned char, WS_XI8), WSP(unsigned char, WS_WGU1I8), WSP(float, WS_XS), WSP(bf16, WS_XB), WSP(bf16, WS_WGU1), 2 * DFF, D, WSP(float, WS_SS0), 1, WSP(bf16, WS_H), WSP(float, WS_SS0), 1, RSTAB, 1.0f, WSP(unsigned char, WS_H8), WSP(float, WS_WSN)));
    RUNPHASE(2, GEMM_PHASE8(EpiRes<0>, WSP(unsigned char, WS_H8), WSP(unsigned char, WS_WD1_8), WSP(bf16, WS_H), WSP(bf16, WS_WD1), D, DFF, nullptr, 0, WSP(bf16, WS_XB), nullptr, WSP(bf16, WS_X1B), WSP(float, WS_SS1), nullptr, 1.0f / (W8SCALE * H8SCALE)));
#if PROBE_DUP >= 21 && PROBE_DUP <= 23
    if (IN(2)) { xcd_barrier(bar); pg8::Gemm g{(const bf16*)WSP(unsigned char, WS_H8), (const bf16*)WSP(unsigned char, WS_WD1_8), MP, D, DFF / 2}; pg8::StaticOrder S; S.init(MP, D, F.G, cblk);
        EpiRes<0> E{WSP(bf16, WS_XB), nullptr, WSP(bf16, WS_X2B), WSP(float, WS_SS2), nullptr, 1.0f / (W8SCALE * H8SCALE)};
        pg8::gemm_phase<EpiRes<0>, pg8::StaticOrder, true, true, (PROBE_DUP == 21 ? 1 : PROBE_DUP == 22 ? 2 : 0)>(F.lds + RING_OFF, g, S, E); xcd_barrier(bar); }
#endif
    RUNPHASE(3, GEMM_PHASE(EpiWin, WSP(bf16, WS_X1B), WSP(bf16, WS_WIN), NINP, D, WSP(float, WS_SS1), 16, F.ws, F.out, (const float*)F.in[15], (const float*)F.in[16], RSTAB));
    RUNPHASE(4, do { p4_conv(F); if (PROBE_DUP == 40) p4_conv(F); p4_index(F); if (PROBE_DUP == 42) p4_index(F); } while (0));
    RUNPHASE(5, do { if ((F.vcu & 1) == 0 && F.vcu < 256) { p5_sample_unit(F, F.vcu >> 1); if (PROBE_DUP == 51) p5_sample_unit(F, F.vcu >> 1); }
        const attn_body::AttnTensors AT{(const attn_body::bf16*)WSP(bf16, WS_Q), (const attn_body::bf16*)WSP(bf16, WS_KB), (const attn_body::bf16*)WSP(bf16, WS_VB), WSP(unsigned long long, WS_MASK), (attn_body::bf16*)WSP(bf16, WS_CAT)};
        const attn_body::StaticOrder S(F.vcu); attn_body::attn_phase<attn_body::StaticOrder>((char*)lds + RING_OFF, AT, S); } while (0));
    RUNPHASE(6, do { GEMM_PHASE(EpiRes<1>, WSP(bf16, WS_CAT), WSP(bf16, WS_WOUT), D, D, nullptr, 0, WSP(bf16, WS_X1B), nullptr, WSP(bf16, WS_X2B), WSP(float, WS_SS2), nullptr, 1.0f);
                     xcd_barrier(bar); quant_rows_pass(F.vcu * 8 + F.wave, F.G * 8, WSP(bf16, WS_X2B), WSP(unsigned char, WS_X2I8), WSP(float, WS_XS2), MP); } while (0));
    RUNPHASE(7, GEMM_PHASEI(EpiGU, WSP(unsigned char, WS_X2I8), WSP(unsigned char, WS_WGU2I8), WSP(float, WS_XS2), WSP(bf16, WS_X2B), WSP(bf16, WS_WGU2), 2 * DFF, D, WSP(float, WS_SS2), 16, WSP(bf16, WS_H), WSP(float, WS_SS2), 16, RSTAB, 1.0f, WSP(unsigned char, WS_H8), WSP(float, WS_WSN2)));
    RUNPHASE(8, GEMM_PHASE8(EpiRes<2>, WSP(unsigned char, WS_H8), WSP(unsigned char, WS_WD2_8), WSP(bf16, WS_H), WSP(bf16, WS_WD2), D, DFF, nullptr, 0, WSP(bf16, WS_X2B), F.out, nullptr, nullptr, nullptr, 1.0f / (W8SCALE * H8SCALE)));
#undef RUNPHASE
#undef GEMM_PHASE
#undef GEMM_PHASE8
#undef GEMM_PHASEI
#undef RSTAB
#undef IN
#undef SEAM
}

#ifndef MK_N_LAUNCHES
#define MK_N_LAUNCHES 1
#endif
extern "C" void kernel_launch(void* const* d_in, const int* in_sizes, int n_in, void* d_out, int out_size, void* d_ws, size_t ws_size, hipStream_t stream) {
    static int grid = 0;
    if (grid == 0) {
        if (n_in != 22 || out_size != (int)O_END || ws_size < WS_END) { fprintf(stderr, "kernel_launch: unexpected problem: n_in %d out %d ws %zu (need %zu)\n", n_in, out_size, ws_size, (size_t)WS_END); grid = -1; return; }
        int dev = 0, cus = 0, per_cu = 0;
        if (hipGetDevice(&dev) != hipSuccess || hipDeviceGetAttribute(&cus, hipDeviceAttributeMultiprocessorCount, dev) != hipSuccess) { grid = -1; return; }
        if (hipFuncSetAttribute((const void*)hymba_fwd, hipFuncAttributeMaxDynamicSharedMemorySize, LDS_BYTES) != hipSuccess) { fprintf(stderr, "kernel_launch: hipFuncSetAttribute failed\n"); grid = -1; return; }
        if (hipOccupancyMaxActiveBlocksPerMultiprocessor(&per_cu, (const void*)hymba_fwd, 512, LDS_BYTES) != hipSuccess || per_cu < 1) { fprintf(stderr, "kernel_launch: occupancy query says %d blocks per CU\n", per_cu); (void)hipGetLastError(); grid = -1; return; }
        grid = cus;
        if (grid % 8 != 0 || grid < 8) { fprintf(stderr, "kernel_launch: unexpected CU count %d\n", cus); grid = -1; return; }
    }
    if (grid < 0) return;
    (void)hipMemsetAsync((char*)d_ws + WS_CTL, 0, CTL_ZERO_BYTES, stream);
    Args a{};
    for (int i = 0; i < 22; ++i) a.in[i] = d_in[i];
    a.out = (float*)d_out; a.ws = (unsigned char*)d_ws;
    if (MK_N_LAUNCHES == 1) { a.ph_lo = 0; a.ph_hi = N_PHASES; a.use_bar = 1; hipLaunchKernelGGL(hymba_fwd, dim3(grid), dim3(512), LDS_BYTES, stream, a); }
    else for (int p = 0; p < N_PHASES; ++p) { a.ph_lo = p; a.ph_hi = p + 1; a.use_bar = 0; hipLaunchKernelGGL(hymba_fwd, dim3(grid), dim3(512), LDS_BYTES, stream, a); }
}
```

```cpp
#include <hip/hip_runtime.h>
#include <cstdio>
#include <cstdint>
#include <type_traits>
namespace pg8 {
#define PG8_LAS __attribute__((address_space(3)))
typedef unsigned short bf16_t;
typedef short bf16x8 __attribute__((ext_vector_type(8)));
typedef float f32x4 __attribute__((ext_vector_type(4)));
typedef unsigned u32x4 __attribute__((ext_vector_type(4)));
constexpr int BM = 256, BK = 64, HALF = 128, HTB = HALF * BK * 2  , STAGE_BYTES = 8 * HTB, NXCD = 8, WGM = 8;

__host__ __device__ __forceinline__ int lds_byte(int r, int c) { const int st = (r >> 4) * 2 + (c >> 5), rr = r & 15, cc = c & 31, ob = rr * 64 + cc * 2; return st * 1024 + (ob ^ (((ob >> 9) & 1) << 5)); }
__host__ __device__ __forceinline__ void stage_rc(int b, int& R, int& C) { const int st = b / 1024, sb = b % 1024, swz = sb ^ (((sb >> 9) & 1) << 5); R = (st >> 1) * 16 + swz / 64; C = (st & 1) * 32 + (swz % 64) / 2; }
__host__ __device__ __forceinline__ int perm32(int rho) { const int n = rho >> 4, i = rho & 15; return 8 * (i >> 2) + 4 * n + (i & 3); }

struct Unit { int pm, pn; };
struct Gemm { const bf16_t* A; const bf16_t* Bt; int M, N, K; };

struct StaticOrder {
    int nM, nN, nwg, G, c;
    __host__ __device__ void init(int M, int N, int G_, int c_) { nM = M / BM; nN = N / BM; nwg = nM * nN; G = G_; c = c_; }
    __host__ __device__ bool next(int i, Unit& u) const {
        const long L = (long)i * G + c; if (L >= nwg) return false;
        int wgid = (int)L; { const int q = nwg / NXCD, r = nwg % NXCD, xcd = wgid % NXCD, off = wgid / NXCD; wgid = (xcd < r ? xcd * (q + 1) : r * (q + 1) + (xcd - r) * q) + off; }
        const int nig = WGM * nN, gid = wgid / nig, fm = gid * WGM, gsz = (nM - fm) < WGM ? (nM - fm) : WGM;
        u.pm = fm + ((wgid % nig) % gsz); u.pn = (wgid % nig) / gsz; return true;
    }
    __device__ __forceinline__ void a_ready(const Unit&) const {}
    __device__ __forceinline__ void done(const Unit&) const {}
};
__device__ __forceinline__ unsigned cvt_pk_bf16(float lo, float hi) { unsigned r; asm volatile("v_cvt_pk_bf16_f32 %0, %1, %2" : "=v"(r) : "v"(lo), "v"(hi)); return r; }
template <class Epi, class Sched, bool ALIGN_EPI = false, bool SP2 = false, int QM = 0, int PFD = 0>
__device__ __forceinline__ void gemm_phase(PG8_LAS unsigned char* lds, const Gemm g, const Sched& S, const Epi& E) {
    const int tid = threadIdx.x, wid = __builtin_amdgcn_readfirstlane(tid >> 6), lane = tid & 63, wr = wid >> 2, wc = wid & 3, fr = lane & 15, fq = lane >> 4;
    const int K = g.K, nt = K / BK;
    unsigned voffA[2], voffB[2];
#pragma unroll
    for (int i = 0; i < 2; ++i) { int R, C; stage_rc(tid * 16 + i * 8192, R, C); const int Rb = Epi::PERM ? ((R & ~31) + perm32(R & 31)) : R;
        voffA[i] = (unsigned)(R * K + C) * 2u; voffB[i] = (unsigned)(Rb * K + C) * 2u; }
    unsigned voffP[2];
#pragma unroll
    for (int i = 0; i < 2; ++i) voffP[i] = (unsigned)((32 * wid + 16 * i + (lane >> 2)) * K) * 2u + (unsigned)(lane & 3) * 4u;
#define PG8_PF(s2, kt) do { if constexpr (PFD != 0) { const char* p_ = ((kt) < nt) ? cA + (size_t)(kt) * kstep : nA + (size_t)((kt) - nt) * kstep; \
        __builtin_amdgcn_global_load_lds((const unsigned*)(p_ + voffP[s2]), (PG8_LAS unsigned*)(lds + 143360 + wid * 256), 4, 0, 0); } } while (0)
#define PG8_WAIT_V8() do { if constexpr (PFD != 0) PG8_WAIT_V(10); else PG8_WAIT_V(8); } while (0)
    const size_t kstep = (size_t)(BK * 2);
    const size_t hstep = (size_t)HALF * K * 2;
    const size_t tstep = 2 * hstep;
    const unsigned ldsw = (unsigned)wid * 1024u;
    const int aoff = lds_byte(wr * 64 + fr, fq * 8), boff = lds_byte(wc * 32 + fr, fq * 8);
#define PG8_SA(b, h) (((b) * 2 + (h)) * HTB)
#define PG8_SB(b, h) ((4 + (b) * 2 + (h)) * HTB)
#define PG8_STAGE(bufoff, gbase, voff) do { _Pragma("unroll") for (int _i = 0; _i < 2; ++_i) \
        __builtin_amdgcn_global_load_lds((const unsigned*)((const char*)(gbase) + (voff)[_i]), (PG8_LAS unsigned*)(lds + (bufoff) + ldsw + _i * 8192), 16, 0, 0); } while (0)
#define PG8_LDF(dst_, addr_) do { if constexpr (QM == 1) { const pg8_v4i lo_ = *(const PG8_LAS pg8_v4i*)(addr_), hi_ = *(const PG8_LAS pg8_v4i*)((addr_) + 1024); \
            (dst_).v = __builtin_shufflevector(lo_, hi_, 0, 1, 2, 3, 4, 5, 6, 7); } \
        else { (dst_).k[0] = *(const PG8_LAS bf16x8*)(addr_); (dst_).k[1] = *(const PG8_LAS bf16x8*)((addr_) + 1024); } } while (0)
#define PG8_LDA(dst, b, h) do { _Pragma("unroll") for (int m = 0; m < 4; ++m) PG8_LDF(dst[m], lds + PG8_SA(b, h) + aoff + m * 2048); } while (0)
#define PG8_LDB(dst, b, h) do { _Pragma("unroll") for (int n = 0; n < 2; ++n) PG8_LDF(dst[n], lds + PG8_SB(b, h) + boff + n * 2048); } while (0)
#define PG8_MMA(ai, bj, At, Bt) do { __builtin_amdgcn_s_setprio(1); if constexpr (QM != 0) asm volatile("s_nop 4");     \
        _Pragma("unroll") for (int m = 0; m < 4; ++m) _Pragma("unroll") for (int n = 0; n < 2; ++n) { \
            if constexpr (QM == 1) asm volatile("v_mfma_scale_f32_16x16x128_f8f6f4 %0, %1, %2, %0, %3, %3 op_sel_hi:[0,0,0]" : "+v"(acc[ai][bj][m][n]) : "v"(Bt[n].v), "v"(At[m].v), "v"(scl8_));     \
            else if constexpr (QM == 2) { _Pragma("unroll") for (int k = 0; k < 2; ++k) asm volatile("v_mfma_i32_16x16x64_i8 %0, %1, %2, %0" : "+v"(acc[ai][bj][m][n]) : "v"(Bt[n].k[k]), "v"(At[m].k[k])); } \
            else { _Pragma("unroll") for (int k = 0; k < 2; ++k) acc[ai][bj][m][n] = __builtin_amdgcn_mfma_f32_16x16x32_bf16(Bt[n].k[k], At[m].k[k], acc[ai][bj][m][n], 0, 0, 0); } } \
        __builtin_amdgcn_s_setprio(0); } while (0)
#define PG8_WAIT_V(n) asm volatile("s_waitcnt vmcnt(" #n ")" ::: "memory")
#define PG8_WAIT_L(n) asm volatile("s_waitcnt lgkmcnt(" #n ")" ::: "memory")
#define PG8_BAR __builtin_amdgcn_s_barrier()
#define PG8_SCHED __builtin_amdgcn_sched_barrier(0)
    Unit cur, nxt; int ui = 0;
    if (!S.next(0, cur)) return;
    f32x4 acc[2][2][4][2];
    E.init(acc, cur, wr, wc, fr, fq);
    typedef int pg8_v8i __attribute__((ext_vector_type(8))); typedef int pg8_v4i __attribute__((ext_vector_type(4)));
    struct FragB { bf16x8 k[2]; }; struct Frag8 { pg8_v8i v; };
    typedef typename std::conditional<QM == 1, Frag8, FragB>::type Frag;
    Frag At[4], B0[2], B1[2];
    unsigned scl8_ = 0x7F7F7F7Fu; asm volatile("" : "+v"(scl8_));
    const char* cA = (const char*)g.A + (size_t)cur.pm * tstep; const char* cB = (const char*)g.Bt + (size_t)cur.pn * tstep;
    S.a_ready(cur);
    if constexpr (SP2) {
        PG8_STAGE(PG8_SB(0, 0), cB, voffB); PG8_STAGE(PG8_SB(0, 1), cB + hstep, voffB); PG8_STAGE(PG8_SA(0, 0), cA, voffA); PG8_STAGE(PG8_SA(0, 1), cA + hstep, voffA);
        if (wr == 1) PG8_BAR;
        PG8_WAIT_V(2); PG8_BAR;
        PG8_STAGE(PG8_SB(1, 0), cB + kstep, voffB); PG8_STAGE(PG8_SA(1, 0), cA + kstep, voffA); PG8_STAGE(PG8_SB(1, 1), cB + hstep + kstep, voffB);
        PG8_WAIT_V(6); PG8_BAR;
    } else {
        PG8_STAGE(PG8_SB(0, 0), cB, voffB); PG8_STAGE(PG8_SA(0, 0), cA, voffA); PG8_STAGE(PG8_SB(0, 1), cB + hstep, voffB); PG8_STAGE(PG8_SA(0, 1), cA + hstep, voffA);
        if (wr == 1) PG8_BAR;
        PG8_WAIT_V(4); PG8_BAR;
        PG8_STAGE(PG8_SB(1, 0), cB + kstep, voffB); PG8_STAGE(PG8_SA(1, 0), cA + kstep, voffA); PG8_STAGE(PG8_SB(1, 1), cB + hstep + kstep, voffB);
        PG8_WAIT_V(6); PG8_BAR;
    }
    for (;;) {
        const bool has_next = S.next(ui + 1, nxt);
        const char* nA = has_next ? (const char*)g.A + (size_t)nxt.pm * tstep : cA; const char* nB = has_next ? (const char*)g.Bt + (size_t)nxt.pn * tstep : cB;
#pragma unroll 1
        for (int t = 0; t < nt; t += 2) {
            const bool last = (t == nt - 2);
            const char* a1 = cA + (size_t)(t + 1) * kstep;
            const char* a2 = last ? nA : cA + (size_t)(t + 2) * kstep; const char* b2 = last ? nB : cB + (size_t)(t + 2) * kstep;
            const char* a3 = a2 + kstep; const char* b3 = b2 + kstep;
            if (last && has_next) S.a_ready(nxt);
            if constexpr (SP2) {
            PG8_LDB(B0, 0, 0); PG8_LDB(B1, 0, 1); PG8_SCHED; PG8_LDA(At, 0, 0); PG8_STAGE(PG8_SA(1, 1), a1 + hstep, voffA); PG8_PF(0, t + PFD);
            PG8_WAIT_V8(); PG8_WAIT_L(0); PG8_BAR; PG8_MMA(0, 0, At, B0); PG8_MMA(0, 1, At, B1); PG8_BAR; PG8_SCHED;
            PG8_LDA(At, 0, 1); PG8_STAGE(PG8_SB(0, 0), b2, voffB); PG8_STAGE(PG8_SB(0, 1), b2 + hstep, voffB); PG8_STAGE(PG8_SA(0, 0), a2, voffA); PG8_PF(1, t + PFD);
            PG8_WAIT_V8(); PG8_WAIT_L(0); PG8_BAR; PG8_MMA(1, 0, At, B0); PG8_MMA(1, 1, At, B1); PG8_BAR; PG8_SCHED;
            PG8_LDB(B0, 1, 0); PG8_LDB(B1, 1, 1); PG8_SCHED; PG8_LDA(At, 1, 0); PG8_STAGE(PG8_SA(0, 1), a2 + hstep, voffA); PG8_PF(0, t + 1 + PFD);
            PG8_WAIT_V8(); PG8_WAIT_L(0); PG8_BAR; PG8_MMA(0, 0, At, B0); PG8_MMA(0, 1, At, B1); PG8_BAR; PG8_SCHED;
            PG8_LDA(At, 1, 1); PG8_STAGE(PG8_SB(1, 0), b3, voffB); PG8_STAGE(PG8_SB(1, 1), b3 + hstep, voffB); PG8_STAGE(PG8_SA(1, 0), a3, voffA); PG8_PF(1, t + 1 + PFD);
            PG8_WAIT_V8(); PG8_WAIT_L(0); PG8_BAR; PG8_MMA(1, 0, At, B0); PG8_MMA(1, 1, At, B1); PG8_BAR; PG8_SCHED;
            } else {
            PG8_LDB(B0, 0, 0); PG8_SCHED; PG8_LDA(At, 0, 0); PG8_STAGE(PG8_SA(1, 1), a1 + hstep, voffA);
            PG8_WAIT_L(8); PG8_BAR; PG8_WAIT_L(0); PG8_MMA(0, 0, At, B0); PG8_BAR; PG8_SCHED;
            PG8_LDB(B1, 0, 1); PG8_STAGE(PG8_SB(0, 0), b2, voffB);
            PG8_BAR; PG8_WAIT_L(0); PG8_MMA(0, 1, At, B1); PG8_BAR;
            PG8_LDA(At, 0, 1); PG8_STAGE(PG8_SA(0, 0), a2, voffA);
            PG8_BAR; PG8_WAIT_L(0); PG8_MMA(1, 0, At, B0); PG8_BAR; PG8_SCHED;
            PG8_STAGE(PG8_SB(0, 1), b2 + hstep, voffB);
            PG8_WAIT_V(6); PG8_BAR; PG8_MMA(1, 1, At, B1); PG8_BAR;
            PG8_LDB(B0, 1, 0); PG8_SCHED; PG8_LDA(At, 1, 0); PG8_STAGE(PG8_SA(0, 1), a2 + hstep, voffA);
            PG8_WAIT_L(8); PG8_BAR; PG8_WAIT_L(0); PG8_MMA(0, 0, At, B0); PG8_BAR; PG8_SCHED;
            PG8_LDB(B1, 1, 1); PG8_STAGE(PG8_SB(1, 0), b3, voffB);
            PG8_BAR; PG8_WAIT_L(0); PG8_MMA(0, 1, At, B1); PG8_BAR;
            PG8_LDA(At, 1, 1); PG8_STAGE(PG8_SA(1, 0), a3, voffA);
            PG8_BAR; PG8_WAIT_L(0); PG8_MMA(1, 0, At, B0); PG8_BAR; PG8_SCHED;
            PG8_STAGE(PG8_SB(1, 1), b3 + hstep, voffB);
            PG8_WAIT_V(6); PG8_BAR; PG8_MMA(1, 1, At, B1); PG8_BAR;
            }
        }
        if constexpr (ALIGN_EPI) { if (wr == 0) PG8_BAR; }
        if constexpr (QM != 0) asm volatile("s_nop 15\n\ts_nop 7" ::: "memory");
        if constexpr (!Epi::AFTER_DRAIN) { E(acc, cur, wr, wc, fr, fq, ui, has_next, nxt);
#if defined(PROBE_DUP) && PROBE_DUP == 61
            E(acc, cur, wr, wc, fr, fq, ui, has_next, nxt);
#endif
            S.done(cur); }
        if (!has_next) break;
        cur = nxt; cA = nA; cB = nB; ++ui;
        if constexpr (ALIGN_EPI) { if (wr == 1) PG8_BAR; }
    }
    PG8_WAIT_V(0);
    if constexpr (!ALIGN_EPI) { if (wr == 0) PG8_BAR; }
    PG8_BAR;
    if constexpr (Epi::AFTER_DRAIN) { E.fused(acc, cur, wr, wc, fr, fq, lds, wid, lane); S.done(cur); }
#undef PG8_SA
#undef PG8_PF
#undef PG8_WAIT_V8
#undef PG8_SB
#undef PG8_STAGE
#undef PG8_LDA
#undef PG8_LDF
#undef PG8_LDB
#undef PG8_MMA
#undef PG8_WAIT_V
#undef PG8_WAIT_L
#undef PG8_BAR
#undef PG8_SCHED
}
}
#include <hip/hip_bf16.h>
#include <cmath>
namespace attn_body {
using bf16=__hip_bfloat16;
using bf16x8=__attribute__((ext_vector_type(8)))short;
using s16x4=__attribute__((ext_vector_type(4)))short;
using f32x16=__attribute__((ext_vector_type(16)))float;
using u32x4=__attribute__((ext_vector_type(4)))unsigned;
constexpr int BATCH=16,NHEAD=8,SEQ=2048,D=64;
constexpr int QP=512,KP=128,OP=1024,OOFF=512;
constexpr int NW=8,QBLK=32,QB=QBLK*NW,KVBLK=64,NQB=SEQ/QB;
constexpr int ATTN_UNIT_ROWS=QB;
__device__ __forceinline__ int crow(int r,int hi){return (r&3)+8*(r>>2)+4*hi;}
#define SBAR() __builtin_amdgcn_sched_barrier(0)
#define MSKV(v,W,r) __uint_as_float(__float_as_uint(v)&(unsigned)(((int)((W)<<(31-(((r)&3)+8*((r)>>2)))))>>31))
__device__ __forceinline__ void cmask(f32x16&p0,f32x16&p1,int jb,int qrel,int hi){
  const float NEG=-INFINITY; int kb=64*jb+4*hi;
  #pragma unroll
  for(int r=0;r<16;++r){int kv=kb+(r&3)+8*(r>>2); if(kv>qrel)p0[r]=NEG; if(kv+32>qrel)p1[r]=NEG;}
}

constexpr int NSLOT=3, SLOTB=8192;
constexpr int LDS_K=0, LDS_V=NSLOT*SLOTB, LDS_WS=2*NSLOT*SLOTB, LDS_OST=LDS_WS+NW*64*4, LDS_MSK=LDS_OST+NW*4096, LDS_BYTES=LDS_MSK+NW*8192;
constexpr float C2=0.125f*1.4426950408889634f;
__device__ __forceinline__ void glds16(const void*gsrc,unsigned lds_dst){unsigned keep;
  asm volatile("s_mov_b32 %0, m0\n\ts_mov_b32 m0, %2\n\ts_nop 0\n\tglobal_load_lds_dwordx4 %1, off\n\ts_mov_b32 m0, %0":"=&s"(keep):"v"(gsrc),"s"(lds_dst):"memory");}
__device__ __forceinline__ float max3f(float a,float b,float c){float r;asm("v_max3_f32 %0, %1, %2, %3":"=v"(r):"v"(a),"v"(b),"v"(c));return r;}
__device__ __forceinline__ float max2f(float a,float b){float r;asm("v_max_f32_e32 %0, %1, %2":"=v"(r):"v"(a),"v"(b));return r;}
__device__ __forceinline__ float fadd_s(float a,float b){float r;asm("v_add_f32_e32 %0, %1, %2":"=v"(r):"v"(a),"v"(b));return r;}
__device__ __forceinline__ float fsub_s(float a,float b){float r;asm("v_sub_f32_e32 %0, %1, %2":"=v"(r):"v"(a),"v"(b));return r;}
typedef float f32x2_t __attribute__((ext_vector_type(2))); typedef __bf16 bf16x2_t __attribute__((ext_vector_type(2)));
__device__ __forceinline__ unsigned cvtpk_s(float lo,float hi){f32x2_t v={lo,hi};bf16x2_t b=__builtin_convertvector(v,bf16x2_t);return __builtin_bit_cast(unsigned,b);}
#define WAIT_BAR(N) asm volatile("s_waitcnt vmcnt(" #N ") lgkmcnt(0)\n\ts_barrier":::"memory")

__device__ __forceinline__ void qkt(f32x16&p0,f32x16&p1,const char*Kslot,const bf16x8*qr,const f32x16&negm,int r32,int hi){
  const char*kb=Kslot+hi*1024+r32*16;
  #pragma unroll
  for(int d0=0;d0<4;++d0){
    const bf16x8 b0=*reinterpret_cast<const bf16x8*>(kb+d0*2048);
    const bf16x8 b1=*reinterpret_cast<const bf16x8*>(kb+d0*2048+512);
    if(d0==0){p0=__builtin_amdgcn_mfma_f32_32x32x16_bf16(b0,qr[0],negm,0,0,0);p1=__builtin_amdgcn_mfma_f32_32x32x16_bf16(b1,qr[0],negm,0,0,0);}
    else{p0=__builtin_amdgcn_mfma_f32_32x32x16_bf16(b0,qr[d0],p0,0,0,0);p1=__builtin_amdgcn_mfma_f32_32x32x16_bf16(b1,qr[d0],p1,0,0,0);}}
}
typedef __attribute__((address_space(3))) const char* lds_cptr;
typedef short v4i16_t __attribute__((ext_vector_type(4)));
__device__ __forceinline__ void kload8(bf16x8*kf,lds_cptr kp){
  kf[0]=*(const __attribute__((address_space(3))) bf16x8*)(kp);      kf[1]=*(const __attribute__((address_space(3))) bf16x8*)(kp+512);
  kf[2]=*(const __attribute__((address_space(3))) bf16x8*)(kp+2048); kf[3]=*(const __attribute__((address_space(3))) bf16x8*)(kp+2560);
  kf[4]=*(const __attribute__((address_space(3))) bf16x8*)(kp+4096); kf[5]=*(const __attribute__((address_space(3))) bf16x8*)(kp+4608);
  kf[6]=*(const __attribute__((address_space(3))) bf16x8*)(kp+6144); kf[7]=*(const __attribute__((address_space(3))) bf16x8*)(kp+6656);
}
__device__ __forceinline__ void kload2(bf16x8*kf,lds_cptr kp,int j){ kf[2*j]=*(const __attribute__((address_space(3))) bf16x8*)(kp+j*2048); kf[2*j+1]=*(const __attribute__((address_space(3))) bf16x8*)(kp+j*2048+512); }
__device__ __forceinline__ s16x4 vtr(lds_cptr p){ return __builtin_bit_cast(s16x4,__builtin_amdgcn_ds_read_tr16_b64_v4i16((__attribute__((address_space(3))) v4i16_t*)p)); }
__device__ __forceinline__ float rowmax(const f32x16&p0,const f32x16&p1){
  float a=max3f(p0[0],p0[1],p1[0]),b=max3f(p0[2],p0[3],p1[1]);a=max3f(a,p1[2],p1[3]);
  #pragma unroll
  for(int r=4;r<16;r+=4){a=max3f(a,p0[r],p0[r+1]);b=max3f(b,p0[r+2],p0[r+3]);a=max3f(a,p1[r],p1[r+1]);b=max3f(b,p1[r+2],p1[r+3]);}
  const float m=max2f(a,b);
  auto rr=__builtin_amdgcn_permlane32_swap(__float_as_uint(m),__float_as_uint(m),false,false);
  return max2f(__uint_as_float(rr[0]),__uint_as_float(rr[1]));
}
__device__ __forceinline__ void pv(f32x16*o,int vb,bf16x8 pa0,bf16x8 pa1,bf16x8 pa2,bf16x8 pa3){
  #pragma unroll
  for(int d0=0;d0<2;++d0){s16x4 lo[4],hi[4];
    #pragma unroll
    for(int ks=0;ks<4;++ks){
      asm volatile("ds_read_b64_tr_b16 %0,%1 offset:%c2":"=&v"(lo[ks]):"v"(vb),"i"(d0*4096+ks*1024):"memory");
      asm volatile("ds_read_b64_tr_b16 %0,%1 offset:%c2":"=&v"(hi[ks]):"v"(vb),"i"(d0*4096+ks*1024+512):"memory");}
    asm volatile("s_waitcnt lgkmcnt(0)":::"memory");SBAR();
    #define PK(k) (bf16x8){lo[k][0],lo[k][1],lo[k][2],lo[k][3],hi[k][0],hi[k][1],hi[k][2],hi[k][3]}
    o[d0]=__builtin_amdgcn_mfma_f32_32x32x16_bf16(pa0,PK(0),o[d0],0,0,0);
    o[d0]=__builtin_amdgcn_mfma_f32_32x32x16_bf16(pa1,PK(1),o[d0],0,0,0);
    o[d0]=__builtin_amdgcn_mfma_f32_32x32x16_bf16(pa2,PK(2),o[d0],0,0,0);
    o[d0]=__builtin_amdgcn_mfma_f32_32x32x16_bf16(pa3,PK(3),o[d0],0,0,0);
    #undef PK
  }
}

#ifndef ATTN_STORE16
#define ATTN_STORE16(p,v) (*(u32x4*)(p)=(v))
#endif
template<int THRL> __device__ __forceinline__ void attn_unit(int b,int h,int qb,const bf16*Q,const bf16*K,const bf16*V,const unsigned long long*MK,bf16*O,char*shm){
  const int tid=threadIdx.x,lane=tid&63,r32=lane&31,hi=lane>>5; const int wid=__builtin_amdgcn_readfirstlane(tid>>6);
  const long rowbase=(long)b*SEQ; const int q0=qb*QB;
  const bf16*Qw=Q+(rowbase+q0+wid*QBLK)*QP+h*D;
  const bf16*Kh=K+rowbase*KP+(h>>2)*D,*Vh=V+rowbase*KP+(h>>2)*D;
  const unsigned lds0=(unsigned)(uintptr_t)shm;
  float*wsf=(float*)(shm+LDS_WS)+wid*64;
  const bf16*ksrc=Kh+(long)lane*KP+wid*8;
  const bf16*vsrc=Vh+(long)(16*(wid&3)+(lane>>2))*KP+(wid>>2)*32+(lane&3)*8;
  const unsigned kdst=lds0+LDS_K+wid*1024, vdst=lds0+LDS_V+wid*1024;
  #define DMA_K(t,slot) glds16(ksrc+(long)(t)*KVBLK*KP,(unsigned)__builtin_amdgcn_readfirstlane(kdst+(slot)))
  #define DMA_V(t,slot) glds16(vsrc+(long)(t)*KVBLK*KP,(unsigned)__builtin_amdgcn_readfirstlane(vdst+(slot)))
  const int vb0=(int)(lds0+LDS_V)+((lane>>4)&1)*32+(lane&3)*8+(4*hi+((lane&15)>>2))*64;
  const char*Kbase=shm+LDS_K; bf16x8 kf[8];
  const lds_cptr shm3=(lds_cptr)shm; const lds_cptr kp0=shm3+LDS_K+hi*1024+r32*16; const lds_cptr vp0=shm3+LDS_V+((lane>>4)&1)*32+(lane&3)*8+(4*hi+((lane&15)>>2))*64;
  const int NT=(q0+QB)/KVBLK;
  const __attribute__((address_space(3))) char* shm3m=(const __attribute__((address_space(3))) char*)shm;
  typedef __attribute__((address_space(3))) unsigned long long* lds_u64p;
  const lds_u64p mskw=(lds_u64p)(shm3m+LDS_MSK+wid*8192);
  unsigned long long mtmp[16];
  { const unsigned long long*mq=MK+(q0+wid*QBLK+r32);
    #pragma unroll
    for(int i=0;i<16;++i){int tt=2*i+hi; tt=tt<NT?tt:NT-1; mtmp[i]=mq[(long)tt*SEQ];} }
  DMA_K(0,0);DMA_V(0,0);DMA_K(1,SLOTB);
  bf16x8 qr[4];
  #pragma unroll
  for(int d0=0;d0<4;++d0)qr[d0]=*reinterpret_cast<const bf16x8*>(&Qw[(long)r32*QP+d0*16+hi*8]);
  float mhat=0.f,l_reg=0.f;f32x16 o[2];o[0]=f32x16{};o[1]=f32x16{};f32x16 negm=f32x16{};asm volatile("":"+v"(negm));
  const int qrel=wid*QBLK+r32;
  #define CMASK(P0,P1,t) do{int jb_=(t)-(NT-4); if(jb_>=0)cmask(P0,P1,jb_,qrel,hi);}while(0)
  bool resc=false;
  #define START(P0,P1) do{ const float rm=rowmax(P0,P1); resc=false; \
    { const float dl=rm; mhat=fadd_s(mhat,dl); \
      _Pragma("unroll") for(int r=0;r<16;++r){P0[r]=fsub_s(P0[r],dl);P1[r]=fsub_s(P1[r],dl);} \
      _Pragma("unroll") for(int r=0;r<16;++r)negm[r]=-mhat; asm volatile("":"+v"(negm)); } \
    _Pragma("unroll") for(int r=0;r<16;++r)P0[r]=__builtin_amdgcn_exp2f(P0[r]); }while(0)
  #define RESC() do{ if(resc){ asm volatile("s_waitcnt lgkmcnt(0)":::"memory"); \
      _Pragma("unroll") for(int d_=0;d_<2;++d_) _Pragma("unroll") for(int r=0;r<16;++r)o[d_][r]*=wsf[crow(r,hi)]; } }while(0)
  f32x16 pA0,pA1,pB0,pB1;
  int sl_prev=0,sl_cur=0,sl_next=SLOTB;
  #define ROT() do{sl_prev=sl_cur;sl_cur=sl_next;sl_next=(sl_next==(NSLOT-1)*SLOTB)?0:sl_next+SLOTB;}while(0)
  DMA_K(2,2*SLOTB);
  WAIT_BAR(3);
  #pragma unroll
  for(int i=0;i<16;++i)mskw[(2*i+hi)*32+r32]=mtmp[i];
  #define MLOAD(t,LO,HI) do{ const unsigned long long mw_=mskw[(t)*32+r32]; LO=((unsigned)mw_)>>(4*hi); HI=((unsigned)(mw_>>32))>>(4*hi); }while(0)
  unsigned mlo,mhi; MLOAD(0,mlo,mhi);
  qkt(pA0,pA1,Kbase,qr,negm,r32,hi);asm volatile("s_nop 15\n\ts_nop 7":"+v"(pA0),"+v"(pA1));
  START(pA0,pA1);
  _Pragma("unroll") for(int r=0;r<16;++r)pA1[r]=__builtin_amdgcn_exp2f(pA1[r]);
  _Pragma("unroll") for(int r=0;r<16;++r){pA0[r]=MSKV(pA0[r],mlo,r);pA1[r]=MSKV(pA1[r],mhi,r);}
  WAIT_BAR(0);
  DMA_K(3,0);DMA_V(1,SLOTB);
  ROT();
  kload8(kf,kp0+sl_cur);
  WAIT_BAR(2);
  s16x4 vlo[8],vhi[8]; u32x4 pw0,pw1,pw2,pw3;
  #define PKW(P,B) cvtpk_s(P[B],P[B+1])
  #define PAF(k) __builtin_bit_cast(bf16x8,pw##k)
  #define VFR(i) (bf16x8){vlo[i][0],vlo[i][1],vlo[i][2],vlo[i][3],vhi[i][0],vhi[i][1],vhi[i][2],vhi[i][3]}
  #define PIN(x) asm volatile("":"+v"(x))
  #define MX3(a,b,c) __builtin_fmaxf(__builtin_fmaxf((a),(b)),(c))
  #define GAPA(MF,A0,A1,A2,A3,W0,W1,PW) do{ MF; sacc+=A0; sacc+=A1; sacc+=A2; sacc+=A3; PIN(sacc); W0; W1; PIN(PW); SBAR(); }while(0)
  #define EX(v) __builtin_amdgcn_exp2f(v)
  #define GAPB(MF,X,B,W) do{ MF; X[B]=MSKV(EX(X[B]),W,B); X[B+1]=MSKV(EX(X[B+1]),W,B+1); X[B+2]=MSKV(EX(X[B+2]),W,B+2); X[B+3]=MSKV(EX(X[B+3]),W,B+3); PIN(X); SBAR(); }while(0)
  #define VRD(i) do{ vlo[i]=vtr(vp_+(((i)>>2)*4096+((i)&3)*1024)); vhi[i]=vtr(vp_+(((i)>>2)*4096+((i)&3)*1024+512)); }while(0)
  #define KRD(G,j) do{ if(G){ kload2(kf,kp0+sl_next,j); SBAR(); } }while(0)
  #define STEP(C0,C1,P0,P1,t,GK,GV,GL) do{ SBAR(); \
    const lds_cptr vp_=vp0+sl_prev; MLOAD(t,mlo,mhi); \
    VRD(0); SBAR(); float sacc=(P0[0]+P0[1]); \
    GAPA(C0=__builtin_amdgcn_mfma_f32_32x32x16_bf16(kf[0],qr[0],negm,0,0,0), P0[2],P0[3],P0[4],P0[5],     pw0[0]=PKW(P0,0), pw0[1]=PKW(P0,2), pw0); \
    VRD(4); SBAR(); GAPA(C1=__builtin_amdgcn_mfma_f32_32x32x16_bf16(kf[1],qr[0],negm,0,0,0), P0[6],P0[7],P0[8],P0[9],     pw0[2]=PKW(P0,4), pw0[3]=PKW(P0,6), pw0); \
    VRD(1); SBAR(); GAPA(C0=__builtin_amdgcn_mfma_f32_32x32x16_bf16(kf[2],qr[1],C0,0,0,0),   P0[10],P0[11],P0[12],P0[13], pw1[0]=PKW(P0,8), pw1[1]=PKW(P0,10), pw1); \
    VRD(5); SBAR(); GAPA(C1=__builtin_amdgcn_mfma_f32_32x32x16_bf16(kf[3],qr[1],C1,0,0,0),   P0[14],P0[15],P1[0],P1[1],   pw1[2]=PKW(P0,12),pw1[3]=PKW(P0,14), pw1); \
    VRD(2); SBAR(); GAPA(C0=__builtin_amdgcn_mfma_f32_32x32x16_bf16(kf[4],qr[2],C0,0,0,0),   P1[2],P1[3],P1[4],P1[5],     pw2[0]=PKW(P1,0), pw2[1]=PKW(P1,2), pw2); \
    VRD(6); SBAR(); GAPA(C1=__builtin_amdgcn_mfma_f32_32x32x16_bf16(kf[5],qr[2],C1,0,0,0),   P1[6],P1[7],P1[8],P1[9],     pw2[2]=PKW(P1,4), pw2[3]=PKW(P1,6), pw2); \
    VRD(3); SBAR(); GAPA(C0=__builtin_amdgcn_mfma_f32_32x32x16_bf16(kf[6],qr[3],C0,0,0,0),   P1[10],P1[11],P1[12],P1[13], pw3[0]=PKW(P1,8), pw3[1]=PKW(P1,10), pw3); \
    VRD(7); SBAR(); GAPA(C1=__builtin_amdgcn_mfma_f32_32x32x16_bf16(kf[7],qr[3],C1,0,0,0),   P1[14],P1[15],0.f,0.f,       pw3[2]=PKW(P1,12),pw3[3]=PKW(P1,14), pw3); \
    l_reg+=sacc; \
    if(GK){DMA_K((t)+3,sl_cur);} if(GV){DMA_V((t)+1,sl_next);} \
    { float a=MX3(C0[0],C0[1],C1[0]),b=MX3(C0[2],C0[3],C1[1]); a=MX3(a,C1[2],C1[3]); \
      _Pragma("unroll") for(int r=4;r<16;r+=4){a=MX3(a,C0[r],C0[r+1]);b=MX3(b,C0[r+2],C0[r+3]);a=MX3(a,C1[r],C1[r+1]);b=MX3(b,C1[r+2],C1[r+3]);} \
      float rm=__builtin_fmaxf(a,b); { auto rr=__builtin_amdgcn_permlane32_swap(__float_as_uint(rm),__float_as_uint(rm),false,false); rm=__builtin_fmaxf(__uint_as_float(rr[0]),__uint_as_float(rr[1])); } \
      resc=false; \
      if(__builtin_expect(__any(rm>(float)THRL),0)){ const float dl=__builtin_fmaxf(rm,0.f); mhat+=dl; \
        _Pragma("unroll") for(int r=0;r<16;++r){C0[r]-=dl;C1[r]-=dl;} \
        _Pragma("unroll") for(int r=0;r<16;++r)negm[r]=-mhat; asm volatile("":"+v"(negm)); \
        const float f=__builtin_amdgcn_exp2f(-dl); l_reg*=f; if(hi==0)wsf[r32]=f; resc=true; } } \
    SBAR(); \
    GAPB(o[0]=__builtin_amdgcn_mfma_f32_32x32x16_bf16(PAF(0),VFR(0),o[0],0,0,0), C0,0,mlo); \
    GAPB(o[1]=__builtin_amdgcn_mfma_f32_32x32x16_bf16(PAF(0),VFR(4),o[1],0,0,0), C0,4,mlo); \
    KRD(GL,0); GAPB(o[0]=__builtin_amdgcn_mfma_f32_32x32x16_bf16(PAF(1),VFR(1),o[0],0,0,0), C0,8,mlo); \
    KRD(GL,1); GAPB(o[1]=__builtin_amdgcn_mfma_f32_32x32x16_bf16(PAF(1),VFR(5),o[1],0,0,0), C0,12,mlo); \
    KRD(GL,2); GAPB(o[0]=__builtin_amdgcn_mfma_f32_32x32x16_bf16(PAF(2),VFR(2),o[0],0,0,0), C1,0,mhi); \
    KRD(GL,3); GAPB(o[1]=__builtin_amdgcn_mfma_f32_32x32x16_bf16(PAF(2),VFR(6),o[1],0,0,0), C1,4,mhi); \
    GAPB(o[0]=__builtin_amdgcn_mfma_f32_32x32x16_bf16(PAF(3),VFR(3),o[0],0,0,0), C1,8,mhi); \
    GAPB(o[1]=__builtin_amdgcn_mfma_f32_32x32x16_bf16(PAF(3),VFR(7),o[1],0,0,0), C1,12,mhi); \
    }while(0)
  int t=1;
  #undef CMASK
  #define CMASK(P0,P1,t) do{}while(0)
  for(;t+5<NT;t+=2){
    STEP(pB0,pB1,pA0,pA1,t,true,true,true);     WAIT_BAR(2); RESC(); ROT();
    STEP(pA0,pA1,pB0,pB1,t+1,true,true,true);   WAIT_BAR(2); RESC(); ROT();
  }
  #undef CMASK
  #define CMASK(P0,P1,t) do{int jb_=(t)-(NT-4); if(jb_>=0)cmask(P0,P1,jb_,qrel,hi);}while(0)
  #define ENDW(tt) do{ if((tt)+3<NT){WAIT_BAR(2);} else if((tt)+2<NT){WAIT_BAR(1);} else {WAIT_BAR(0);} }while(0)
  for(;t+1<NT;t+=2){
    STEP(pB0,pB1,pA0,pA1,t,(t+3<NT),(t+1<NT),(t+1<NT));       ENDW(t);   RESC(); ROT();
    STEP(pA0,pA1,pB0,pB1,t+1,(t+4<NT),(t+2<NT),(t+2<NT));     ENDW(t+1); RESC(); ROT();
  }
  STEP(pB0,pB1,pA0,pA1,NT-1,false,false,false); RESC();
  { float sacc=pB0[0]+pB0[1]; _Pragma("unroll") for(int r=2;r<16;++r)sacc+=pB0[r]; _Pragma("unroll") for(int r=0;r<16;++r)sacc+=pB1[r]; l_reg+=sacc;
    pw0=(u32x4){PKW(pB0,0),PKW(pB0,2),PKW(pB0,4),PKW(pB0,6)};pw1=(u32x4){PKW(pB0,8),PKW(pB0,10),PKW(pB0,12),PKW(pB0,14)};pw2=(u32x4){PKW(pB1,0),PKW(pB1,2),PKW(pB1,4),PKW(pB1,6)};pw3=(u32x4){PKW(pB1,8),PKW(pB1,10),PKW(pB1,12),PKW(pB1,14)};
    SBAR(); pv(o,vb0+sl_cur,PAF(0),PAF(1),PAF(2),PAF(3)); }
  #undef PKW
  #undef PAF
  #undef VFR
  #undef PIN
  #undef MX3
  #undef GAPA
  #undef GAPB
  #undef EX
  #undef VRD
  #undef KRD
  #undef STEP
  #undef ENDW
  {auto rr=__builtin_amdgcn_permlane32_swap(__float_as_uint(l_reg),__float_as_uint(l_reg),false,false);l_reg=__uint_as_float(rr[0])+__uint_as_float(rr[1]);}
  if(hi==0)wsf[32+r32]=l_reg;asm volatile("s_waitcnt lgkmcnt(0)":::"memory");
  float rli[16];
  #pragma unroll
  for(int r=0;r<16;++r)rli[r]=__builtin_amdgcn_rcpf(wsf[32+crow(r,hi)]);
  bf16*Ow=O+(rowbase+q0+wid*QBLK)*OP+OOFF+h*D;
  { bf16*stg=(bf16*)(shm+LDS_OST)+wid*2048;
    #pragma unroll
    for(int r=0;r<16;++r){const int orow=crow(r,hi);
      #pragma unroll
      for(int d0=0;d0<2;++d0)stg[orow*64+d0*32+r32]=__float2bfloat16(o[d0][r]*rli[r]);}
    asm volatile("s_waitcnt lgkmcnt(0)":::"memory");
    #pragma unroll
    for(int i=0;i<4;++i){const int row=i*8+(lane>>3),ch=lane&7; const u32x4 v=*(const u32x4*)(stg+row*64+ch*8); ATTN_STORE16(Ow+(long)row*OP+ch*8,v);} }
  asm volatile("s_waitcnt lgkmcnt(0)\n\ts_barrier":::"memory");
  #undef DMA_K
  #undef DMA_V
  #undef CMASK
  #undef START
  #undef RESC
  #undef ROT
}
constexpr int ATTN_LDS_BYTES=LDS_BYTES;
struct AttnTensors { const bf16* Q; const bf16* K; const bf16* V; const unsigned long long* MK; bf16* O; };
struct AttnUnit { int bh; int qb; };
struct StaticOrder {
  int vcu;
  __device__ __forceinline__ explicit StaticOrder(int vcu_):vcu(vcu_){}
  __device__ __forceinline__ bool next(int i,AttnUnit&u)const{ if(vcu>=256)return false; const int s=vcu&1; u.bh=vcu>>1; if(s){ if(i>=5)return false; u.qb=5-i; } else { if(i>=3)return false; u.qb=(i==0)?7:(i==1)?6:0; } return true; }
};
template<class Sched,int THRL=8> __device__ __forceinline__ void attn_phase(char*lds,const AttnTensors&T,const Sched&S){
  AttnUnit u;
  for(int i=0;S.next(i,u);++i){ const int b=u.bh/NHEAD; attn_unit<THRL>(b,u.bh%NHEAD,u.qb,T.Q,T.K,T.V,T.MK+(long)b*32*SEQ,T.O,lds); }
}
#undef SBAR
#undef WAIT_BAR
}
#ifndef PROBE_DUP
#define PROBE_DUP (-1)
#endif
constexpr int D = 1024, NB = 16, SEQ = 2048, MP = NB * SEQ, DB = 32, DS = 4, MS = DB * DS, MTOT = MP + MS, MPAD = 33024;
constexpr int DFF = 2816, NIN = 2888, NINP = 3072, DCONV = 512;
constexpr int PAST = 16384, PAGE = 128, NPAGES = 128, KTOP = 256;
constexpr float EPS = 1e-6f, LOG2E = 1.4426950408889634f;
constexpr float QSCALE = 0.125f * LOG2E;
constexpr size_t O_YP = 0, O_YS = O_YP + (size_t)MP * D, O_KP = O_YS + (size_t)MS * D, O_VP = O_KP + (size_t)MP * 128, O_IP = O_VP + (size_t)MP * 128,
                 O_CP = O_IP + (size_t)MP * 64, O_KS = O_CP + 16 * 2 * 512, O_VS = O_KS + MS * 128, O_IS = O_VS + MS * 128, O_CS = O_IS + MS * 64, O_END = O_CS + 32 * 2 * 512;
static_assert(O_END == 44261376, "output size");

constexpr size_t al(size_t x) { return (x + 0xFFFFF) & ~(size_t)0xFFFFF; }
constexpr size_t WS_CTL = 0, CTL_ZERO_BYTES = 1u << 20;
constexpr size_t WS_ROPE = al(WS_CTL + CTL_ZERO_BYTES);
constexpr size_t WS_WGU1 = al(WS_ROPE + 2052 * 8 * 2 * 4);
constexpr size_t WS_WD1 = al(WS_WGU1 + (size_t)2 * DFF * D * 2);
constexpr size_t WS_WIN = al(WS_WD1 + (size_t)D * DFF * 2);
constexpr size_t WS_WOUT = al(WS_WIN + (size_t)NINP * D * 2);
constexpr size_t WS_WGU2 = al(WS_WOUT + (size_t)D * D * 2);
constexpr size_t WS_WD2 = al(WS_WGU2 + (size_t)2 * DFF * D * 2);
constexpr size_t WS_XB = al(WS_WD2 + (size_t)D * DFF * 2);
constexpr size_t WS_SS0 = al(WS_XB + (size_t)MPAD * D * 2);
constexpr size_t WS_SS1 = al(WS_SS0 + (size_t)MPAD * 4);
constexpr size_t WS_SS2 = al(WS_SS1 + (size_t)MPAD * 64);
constexpr size_t WS_H = al(WS_SS2 + (size_t)MPAD * 64);
constexpr size_t WS_X1 = al(WS_H + (size_t)MPAD * DFF * 2);
constexpr size_t WS_X1B = al(WS_X1 + (size_t)MPAD * D * 4);
constexpr size_t WS_X2 = al(WS_X1B + (size_t)MPAD * D * 2);
constexpr size_t WS_X2B = al(WS_X2 + (size_t)MPAD * D * 4);
constexpr size_t WS_U = al(WS_X2B + (size_t)MPAD * D * 2);
constexpr size_t WS_GB = al(WS_U + (size_t)MPAD * 512 * 2);
constexpr size_t WS_Q = al(WS_GB + (size_t)MPAD * 512 * 2);
constexpr size_t WS_QI = al(WS_Q + (size_t)MPAD * 512 * 2);
constexpr size_t WS_KB = al(WS_QI + (size_t)MPAD * 512 * 2);
constexpr size_t WS_VB = al(WS_KB + (size_t)MPAD * 128 * 2);
constexpr size_t WS_KIB = al(WS_VB + (size_t)MPAD * 128 * 2);
constexpr size_t WS_WI = al(WS_KIB + (size_t)MPAD * 64 * 2);
constexpr size_t WS_CAT = al(WS_WI + (size_t)MPAD * 8 * 4);
constexpr size_t WS_MASK = al(WS_CAT + (size_t)MPAD * D * 2);
constexpr int SSTR = 16384;
constexpr size_t WS_SSC = al(WS_MASK + (size_t)NB * 32 * SEQ * 8);
constexpr size_t WS_XB8 = al(WS_SSC + (size_t)MS * SSTR * 4);
constexpr size_t WS_X2B8 = al(WS_XB8 + (size_t)MPAD * D);
constexpr size_t WS_WGU1_8 = al(WS_X2B8 + (size_t)MPAD * D);
constexpr size_t WS_WGU2_8 = al(WS_WGU1_8 + (size_t)2 * DFF * D);
constexpr size_t WS_WD2_8 = al(WS_WGU2_8 + (size_t)2 * DFF * D);
constexpr size_t WS_H8 = al(WS_WD2_8 + (size_t)D * DFF);
constexpr size_t WS_XI8 = al(WS_H8 + (size_t)MP * DFF);
constexpr size_t WS_XS = al(WS_XI8 + (size_t)MPAD * D);
constexpr size_t WS_WGU1I8 = al(WS_XS + (size_t)MPAD * 4);
constexpr size_t WS_WSN = al(WS_WGU1I8 + (size_t)2 * DFF * D);
constexpr size_t WS_X2I8 = al(WS_WSN + (size_t)2 * DFF * 4);
constexpr size_t WS_XS2 = al(WS_X2I8 + (size_t)MPAD * D);
constexpr size_t WS_WGU2I8 = al(WS_XS2 + (size_t)MPAD * 4);
constexpr size_t WS_WSN2 = al(WS_WGU2I8 + (size_t)2 * DFF * D);
constexpr size_t WS_WD1_8 = al(WS_WSN2 + (size_t)2 * DFF * 4);
constexpr size_t WS_END = al(WS_WD1_8 + (size_t)D * DFF);
constexpr float H8SCALE = 4.0f;
constexpr float W8SCALE = 32.0f;

constexpr int CW_TMO = 0, CW_CODE = 1, CW_BAR = 4096;

constexpr int RING_OFF = 0, RING_BYTES = 152576;
constexpr int LDSCTL_OFF = RING_BYTES, MISC_OFF = LDSCTL_OFF + 320;
constexpr int LDS_BYTES = 158720;
static_assert(MISC_OFF + 128 <= LDS_BYTES && attn_body::ATTN_LDS_BYTES <= RING_BYTES && pg8::STAGE_BYTES <= RING_BYTES, "LDS map");

#define GAS __attribute__((address_space(1)))
#define LAS __attribute__((address_space(3)))
typedef unsigned short bf16;
typedef unsigned v4u __attribute__((ext_vector_type(4)));
typedef unsigned v2u __attribute__((ext_vector_type(2)));
typedef float f32x4 __attribute__((ext_vector_type(4)));
typedef float f32x16 __attribute__((ext_vector_type(16)));
typedef short bf16x8 __attribute__((ext_vector_type(8)));
typedef GAS unsigned gu32;
#define RLX_AGENT __ATOMIC_RELAXED, __HIP_MEMORY_SCOPE_AGENT
#define LDS_WAIT() asm volatile("s_waitcnt lgkmcnt(0)" ::: "memory")
#define VM_WAIT() asm volatile("s_waitcnt vmcnt(0)" ::: "memory")
__device__ __forceinline__ unsigned f2bf(float f) { unsigned u = __builtin_bit_cast(unsigned, f); return (u + 0x7fffu + ((u >> 16) & 1u)) >> 16; }
__device__ __forceinline__ unsigned pk2(float lo, float hi) { return f2bf(lo) | (f2bf(hi) << 16); }
__device__ __forceinline__ float bf2f(unsigned short h) { return __builtin_bit_cast(float, (unsigned)h << 16); }
__device__ __forceinline__ float wave_sum(float v) {
#pragma unroll
    for (int o = 1; o < 64; o <<= 1) v += __shfl_xor(v, o);
    return v;
}
__device__ __forceinline__ float wave_max(float v) {
#pragma unroll
    for (int o = 1; o < 64; o <<= 1) v = fmaxf(v, __shfl_xor(v, o));
    return v;
}

#define XB_TMO      128
#define XB_XCNT(j)  (256  + 64 * (j))
#define XB_XSUB(j)  (1280 + 64 * (j))
#define XB_XGEN(j)  (2304 + 64 * (j))
#define XB_TOP      3328
#define XB_TOPGEN   3392
#define XCD_BAR_WORDS 3456
#define XB_SPIN_CAP (1u << 18)

__device__ __forceinline__ unsigned xb_ld(unsigned* p)              { return __hip_atomic_load(p, __ATOMIC_RELAXED, __HIP_MEMORY_SCOPE_AGENT); }
__device__ __forceinline__ unsigned xb_add(unsigned* p, unsigned v) { return __hip_atomic_fetch_add(p, v, __ATOMIC_RELAXED, __HIP_MEMORY_SCOPE_AGENT); }
__device__ __forceinline__ unsigned xb_xcc_id() { return (unsigned)__builtin_amdgcn_s_getreg((3 << 11) | 20) & 0xFu; }
#define XB_SPIN(cond, bar) do { unsigned _sp = 0; while (cond) { __builtin_amdgcn_s_sleep(1); \
    if ((++_sp & 255u) == 0u) { if (xb_ld(&(bar)[XB_TMO])) break; if (_sp > XB_SPIN_CAP) { atomicAdd(&(bar)[XB_TMO], 1u); break; } } } } while (0)

struct XcdBarrier {
    unsigned* bar; unsigned x;
    volatile LAS unsigned* st;
};

__device__ __forceinline__ XcdBarrier xcd_barrier_post(unsigned* bar, volatile LAS unsigned* st) {
    XcdBarrier b; b.bar = bar; b.x = xb_xcc_id(); b.st = st;
    if (threadIdx.x == 0) (void)xb_add(&bar[XB_XCNT(b.x)], 1u);
    return b;
}
__device__ __forceinline__ void xcd_barrier_complete(unsigned* bar, unsigned x, unsigned& nloc, unsigned& nx) {
    const unsigned G = gridDim.x * gridDim.y * gridDim.z;
    unsigned sum, cnt, mine, sp = 0u;
    for (;;) {
        sum = 0u; cnt = 0u; mine = 0u;
#pragma unroll
        for (unsigned j = 0; j < 16; ++j) { const unsigned c = xb_ld(&bar[XB_XCNT(j)]); sum += c; cnt += (c > 0u) ? 1u : 0u; mine = (j == x) ? c : mine; }
        if (sum == G) break;
        __builtin_amdgcn_s_sleep(1);
        if ((++sp & 255u) == 0u) { if (xb_ld(&bar[XB_TMO])) break; if (sp > XB_SPIN_CAP) { atomicAdd(&bar[XB_TMO], 1u); break; } }
    }
    nloc = mine > 0u ? mine : 1u; nx = cnt > 0u ? cnt : 1u;
}

__device__ __forceinline__ void xcd_barrier(const XcdBarrier& b) {
    asm volatile("s_waitcnt vmcnt(0)" ::: "memory");
    __syncthreads();
    if (threadIdx.x == 0) {
        unsigned* bar = b.bar;
        __builtin_amdgcn_s_waitcnt(0);
        unsigned nloc = b.st[0], nx = b.st[1];
        if (nloc == 0u) { xcd_barrier_complete(bar, b.x, nloc, nx); b.st[0] = nloc; b.st[1] = nx; }
        const unsigned old = xb_add(&bar[XB_XSUB(b.x)], 1u);
        const unsigned gen = old / nloc;
        if (old + 1u == (gen + 1u) * nloc) {
            __builtin_amdgcn_fence(__ATOMIC_RELEASE, "agent");
            asm volatile("s_waitcnt vmcnt(0)" ::: "memory");
            const unsigned og = xb_add(&bar[XB_TOP], 1u);
            const unsigned tg = og / nx;
            if (og + 1u == (tg + 1u) * nx) xb_add(&bar[XB_TOPGEN], 1u);
            else XB_SPIN(xb_ld(&bar[XB_TOPGEN]) == tg, bar);
            __builtin_amdgcn_fence(__ATOMIC_ACQUIRE, "agent");
            xb_add(&bar[XB_XGEN(b.x)], 1u);
            asm volatile("s_waitcnt vmcnt(0)" ::: "memory");
        } else {
            XB_SPIN(xb_ld(&bar[XB_TOPGEN]) == gen, bar);
            __builtin_amdgcn_fence(__ATOMIC_ACQUIRE, "agent");
            asm volatile("s_waitcnt vmcnt(0)" ::: "memory");
        }
    }
    __syncthreads();
}
__host__ __device__ __forceinline__ int r32map(int P) { return 16 * ((P >> 2) & 1) + 4 * (P >> 3) + (P & 3); }
__host__ __device__ __forceinline__ int p128(int x) { return (x & ~31) + r32map(x & 31); }
__host__ __device__ __forceinline__ int hdmap(int d) { if (d >= 16) return d; const int fq = (d >> 2) & 1, j = (d & 3) + 4 * (d >> 3); return 8 * fq + j; }
__host__ __device__ __forceinline__ int head_row(int wc, int d) { const int x = hdmap(d); return 128 * (x >> 5) + 32 * wc + r32map(x & 31); }
__device__ __forceinline__ int dstart(int bj, int fq, int half) { return (bj == 0 && fq < 2) ? 4 * fq + 8 * half : 32 * bj + 8 * fq + 4 * half; }

struct MapGate { __device__ __forceinline__ int operator()(int c) const { return 256 * (c >> 7) + p128(c & 127); } };
struct MapUp   { __device__ __forceinline__ int operator()(int c) const { return 256 * (c >> 7) + 128 + p128(c & 127); } };
struct MapLin  { __device__ __forceinline__ int operator()(int c) const { return (c & ~127) + p128(c & 127); } };
struct MapWin  { __device__ __forceinline__ int operator()(int c) const {
    if (c < 512) return 1024 + (c & ~127) + p128(c & 127);
    if (c < 1024) { const int ch = c - 512; return 256 * (ch >> 7) + p128(ch & 127); }
    if (c < 1536) { const int ch = c - 1024; return 256 * (ch >> 7) + 128 + p128(ch & 127); }
    if (c < 2048) { const int x = c - 1536, hd = x >> 6; return 256 * (6 + (hd >> 2)) + head_row(hd & 3, x & 63); }
    if (c < 2176) { const int x = c - 2048; return 256 * 8 + head_row(x >> 6, x & 63); }
    if (c < 2304) { const int x = c - 2176; return 256 * 8 + head_row(2 + (x >> 6), x & 63); }
    if (c < 2816) { const int x = c - 2304, hd = x >> 6; return 256 * (9 + (hd >> 2)) + head_row(hd & 3, x & 63); }
    if (c < 2880) return 256 * 11 + head_row(0, c - 2816);
    return 256 * 11 + 32 + r32map(c - 2880);
} };

using pg8::Unit; using pg8::bf16_t;
__device__ __forceinline__ float rstd_from(const float* ss, int row, int nslot) {
    float s = 0.f;
    if (nslot == 1) s = ss[row];
    else { const f32x4* p = (const f32x4*)(ss + (size_t)row * 16); const f32x4 a = p[0], b = p[1], c = p[2], d = p[3]; s = ((a.x + a.y) + (a.z + a.w)) + ((b.x + b.y) + (b.z + b.w)) + ((c.x + c.y) + (c.z + c.w)) + ((d.x + d.y) + (d.z + d.w)); }
    return __builtin_amdgcn_rsqf(s * (1.0f / D) + EPS);
}
__device__ __forceinline__ float clamp8(float x) { return __builtin_amdgcn_fmed3f(x, -440.0f, 440.0f); }
__device__ __forceinline__ unsigned pk4_fp8(float a, float b, float c, float d) { int w = __builtin_amdgcn_cvt_pk_fp8_f32(clamp8(a), clamp8(b), 0, false); w = __builtin_amdgcn_cvt_pk_fp8_f32(clamp8(c), clamp8(d), w, true); return (unsigned)w; }
#define EPI_CALL_ROWS() \
    __device__ __forceinline__ void operator()(f32x4 (&acc)[2][2][4][2], const Unit& u, int wr, int wc, int fr, int fq, int ui, bool has_next, const Unit& nxt) const { \
        _Pragma("unroll") for (int ai = 0; ai < 2; ++ai) _Pragma("unroll") for (int m = 0; m < 4; ++m) { \
            const f32x4 v[2][2] = {{acc[ai][0][m][0], acc[ai][0][m][1]}, {acc[ai][1][m][0], acc[ai][1][m][1]}}; \
            row(v, u.pm * 256 + ai * 128 + wr * 64 + m * 16 + fr, u.pn, wc, fr, fq, ui); \
            if (has_next) init_rg(acc, nxt, ai, m, wr, wc, fr, fq); } }                        \
    __device__ __forceinline__ void init(f32x4 (&acc)[2][2][4][2], const Unit& u, int wr, int wc, int fr, int fq) const { \
        _Pragma("unroll") for (int ai = 0; ai < 2; ++ai) _Pragma("unroll") for (int m = 0; m < 4; ++m) init_rg(acc, u, ai, m, wr, wc, fr, fq); }
#define EPI_ZERO_INIT() \
    __device__ __forceinline__ void init_rg(f32x4 (&acc)[2][2][4][2], const Unit&, int ai, int m, int, int, int, int) const { \
        _Pragma("unroll") for (int b = 0; b < 2; ++b) _Pragma("unroll") for (int n = 0; n < 2; ++n) acc[ai][b][m][n] = (f32x4){0.f, 0.f, 0.f, 0.f}; }
__device__ __forceinline__ float rstd_of(const LAS float* tab, const float* ss, int nslot, int row, int ui) { return (ui >= 0 && tab) ? tab[ui * 256 + (row & 255)] : rstd_from(ss, row, nslot); }
struct EpiGU {
    static constexpr bool PERM = false, AFTER_DRAIN = false;
    bf16_t* H; const float* ss; int nslot; const LAS float* tab; float wscale; unsigned char* H8; const float* wsn;
    __device__ __forceinline__ void row(const f32x4 (&v)[2][2], int row, int pn, int wc, int fr, int fq, int ui) const {
        typedef float f32x2 __attribute__((ext_vector_type(2)));
        const int col0 = pn * 128 + wc * 32 + 8 * fq;
        const float rs = rstd_of(tab, ss, nslot, row, ui) * (ui >= 0 ? wscale : 1.0f);
        const float c1 = -rs * LOG2E, rs2 = rs * rs;
        const bool f8 = (ui >= 0) && H8 != nullptr;
        const float rs2s = f8 ? rs2 * H8SCALE : rs2;
        f32x2 hh[4];
#pragma unroll
        for (int n = 0; n < 2; ++n)
#pragma unroll
            for (int i = 0; i < 4; i += 2) { const f32x2 ag = {v[0][n][i], v[0][n][i + 1]}, au = {v[1][n][i], v[1][n][i + 1]};
                const f32x2 a = ag * c1; f32x2 e; e.x = __builtin_amdgcn_exp2f(a.x); e.y = __builtin_amdgcn_exp2f(a.y);
                const f32x2 d = e + 1.0f; f32x2 r; r.x = __builtin_amdgcn_rcpf(d.x); r.y = __builtin_amdgcn_rcpf(d.y);
                hh[2 * n + (i >> 1)] = (ag * au) * (r * rs2s); }
        if (f8) { v2u w8; w8.x = pk4_fp8(hh[0].x, hh[0].y, hh[1].x, hh[1].y); w8.y = pk4_fp8(hh[2].x, hh[2].y, hh[3].x, hh[3].y);
            __builtin_nontemporal_store(w8, (v2u*)(H8 + (size_t)row * DFF + col0)); }
        else { v4u w; w.x = pg8::cvt_pk_bf16(hh[0].x, hh[0].y); w.y = pg8::cvt_pk_bf16(hh[1].x, hh[1].y); w.z = pg8::cvt_pk_bf16(hh[2].x, hh[2].y); w.w = pg8::cvt_pk_bf16(hh[3].x, hh[3].y);
        __builtin_nontemporal_store(w, (v4u*)(H + (size_t)row * DFF + col0)); }
    }
    __device__ __forceinline__ void operator()(f32x4 (&acc)[2][2][4][2], const Unit& u, int wr, int wc, int fr, int fq, int ui, bool has_next, const Unit& nxt) const {
        typedef int v4i_ __attribute__((ext_vector_type(4)));
        f32x4 cs[2][2];
#pragma unroll
        for (int bj = 0; bj < 2; ++bj)
#pragma unroll
            for (int n = 0; n < 2; ++n) cs[bj][n] = wsn ? *(const f32x4*)(wsn + u.pn * 256 + bj * 128 + wc * 32 + n * 16 + 4 * fq) : (f32x4){1.f, 1.f, 1.f, 1.f};
#pragma unroll
        for (int ai = 0; ai < 2; ++ai)
#pragma unroll
            for (int m = 0; m < 4; ++m) {
                f32x4 v[2][2];
#pragma unroll
                for (int bj = 0; bj < 2; ++bj)
#pragma unroll
                    for (int n = 0; n < 2; ++n) v[bj][n] = wsn ? __builtin_convertvector(__builtin_bit_cast(v4i_, acc[ai][bj][m][n]), f32x4) * cs[bj][n] : acc[ai][bj][m][n];
                row(v, u.pm * 256 + ai * 128 + wr * 64 + m * 16 + fr, u.pn, wc, fr, fq, ui);
                if (has_next) init_rg(acc, nxt, ai, m, wr, wc, fr, fq); }
    }
    __device__ __forceinline__ void init(f32x4 (&acc)[2][2][4][2], const Unit& u, int wr, int wc, int fr, int fq) const {
#pragma unroll
        for (int ai = 0; ai < 2; ++ai)
#pragma unroll
            for (int m = 0; m < 4; ++m) init_rg(acc, u, ai, m, wr, wc, fr, fq); }
    EPI_ZERO_INIT()
};
__device__ __forceinline__ void bf8_to_f32(const v4u w, f32x4& lo, f32x4& hi) {
    lo = (f32x4){__uint_as_float(w.x << 16), __uint_as_float(w.x & 0xffff0000u), __uint_as_float(w.y << 16), __uint_as_float(w.y & 0xffff0000u)};
    hi = (f32x4){__uint_as_float(w.z << 16), __uint_as_float(w.z & 0xffff0000u), __uint_as_float(w.w << 16), __uint_as_float(w.w & 0xffff0000u)};
}
template <int MODE> struct EpiRes {
    static constexpr bool PERM = false, AFTER_DRAIN = false;
    const bf16_t* resb; float* out; bf16_t* outb; float* ss; unsigned char* out8; float ascale;
    __device__ __forceinline__ void row(const f32x4 (&v)[2][2], int row, int pn, int wc, int fr, int fq, int ui) const {
        const bool pre = ui >= 0;
        const float alpha = ((MODE == 1) ? 1.0f : 0.5f) * (pre ? ascale : 1.0f);
        const bool live = row < MTOT;
        float sq = 0.f;
#pragma unroll
        for (int bj = 0; bj < 2; ++bj) {
            const int col = pn * 256 + bj * 128 + wc * 32 + 8 * fq;
            f32x4 r0 = (f32x4){0.f, 0.f, 0.f, 0.f}, r1 = r0;
            if (!pre && live) bf8_to_f32(*(const v4u*)(resb + (size_t)row * D + col), r0, r1);
            const f32x4 v0 = r0 + alpha * v[bj][0], v1 = r1 + alpha * v[bj][1];
            if (MODE == 2) { if (live) { __builtin_nontemporal_store(v0, (f32x4*)(out + (size_t)row * D + col)); __builtin_nontemporal_store(v1, (f32x4*)(out + (size_t)row * D + col + 4)); } }
            else {
                v4u w; w.x = pg8::cvt_pk_bf16(v0[0], v0[1]); w.y = pg8::cvt_pk_bf16(v0[2], v0[3]); w.z = pg8::cvt_pk_bf16(v1[0], v1[1]); w.w = pg8::cvt_pk_bf16(v1[2], v1[3]);
                *(v4u*)(outb + (size_t)row * D + col) = w;
                if (MODE == 1 && out8) { v2u w8; w8.x = pk4_fp8(v0[0], v0[1], v0[2], v0[3]); w8.y = pk4_fp8(v1[0], v1[1], v1[2], v1[3]); *(v2u*)(out8 + (size_t)row * D + col) = w8; }
                sq += (v0[0] * v0[0] + v0[1] * v0[1]) + (v0[2] * v0[2] + v0[3] * v0[3]) + (v1[0] * v1[0] + v1[1] * v1[1]) + (v1[2] * v1[2] + v1[3] * v1[3]);
            }
        }
        if (MODE != 2) { sq += __shfl_xor(sq, 16); sq += __shfl_xor(sq, 32); if (fq == 0) ss[(size_t)row * 16 + pn * 4 + wc] = sq; }
    }
    EPI_CALL_ROWS()
    __device__ __forceinline__ void init_rg(f32x4 (&acc)[2][2][4][2], const Unit& u, int ai, int m, int wr, int wc, int fr, int fq) const {
        const float ia = ((MODE == 1) ? 1.0f : 2.0f) / ascale;
        const bf16_t* rp = resb + (size_t)(u.pm * 256 + ai * 128 + wr * 64 + m * 16 + fr) * D + u.pn * 256 + wc * 32 + 8 * fq;
#pragma unroll
        for (int bj = 0; bj < 2; ++bj) { f32x4 lo, hi; bf8_to_f32(*(const v4u*)(rp + bj * 128), lo, hi); acc[ai][bj][m][0] = lo * ia; acc[ai][bj][m][1] = hi * ia; }
    }
};
struct EpiWin {
    static constexpr bool PERM = false, AFTER_DRAIN = false;
    unsigned char* ws; float* out; const float* qn; const float* kn; const LAS float* tab;
    __device__ __forceinline__ void row(const f32x4 (&acc)[2][2], int row, int pn, int wc, int fr, int fq, int ui) const {
        const float* ss = (const float*)(ws + WS_SS1); bf16_t* U = (bf16_t*)(ws + WS_U); bf16_t* GB = (bf16_t*)(ws + WS_GB); float* WI = (float*)(ws + WS_WI); const float* rope = (const float*)(ws + WS_ROPE);
        if (pn == 11 && wc >= 2) return;
        const int type = pn < 4 ? 0 : pn < 6 ? 1 : pn < 8 ? 2 : pn == 8 ? (wc < 2 ? 3 : 4) : pn < 11 ? 5 : (wc == 0 ? 6 : 7);
        const int head = (type == 2) ? 4 * (pn - 6) + wc : (type == 5) ? 4 * (pn - 9) + wc : (type == 3) ? wc : (type == 4) ? wc - 2 : 0;
        const bool live = row < MTOT;
        const float rs = rstd_of(tab, ss, 16, row, ui);
        if (type == 0) {
            const int ch0 = pn * 128 + wc * 32 + 8 * fq;
            const f32x4 u0 = (acc[0][0] * rs) * (acc[1][0] * rs), u1 = (acc[0][1] * rs) * (acc[1][1] * rs);
            v4u w; w.x = pg8::cvt_pk_bf16(u0[0], u0[1]); w.y = pg8::cvt_pk_bf16(u0[2], u0[3]); w.z = pg8::cvt_pk_bf16(u1[0], u1[1]); w.w = pg8::cvt_pk_bf16(u1[2], u1[3]);
            *(v4u*)(U + (size_t)row * 512 + ch0) = w;
            if (row < MP) { const int s = row & (SEQ - 1); if (s >= SEQ - 2) { float* o = out + O_CP + ((size_t)(row >> 11) * 2 + (s - (SEQ - 2))) * 512 + ch0; *(f32x4*)o = u0; *(f32x4*)(o + 4) = u1; } }
            else if (live) { const int sr = row - MP, s = sr & 3; if (s >= 2) { float* o = out + O_CS + ((size_t)(sr >> 2) * 2 + (s - 2)) * 512 + ch0; *(f32x4*)o = u0; *(f32x4*)(o + 4) = u1; } }
        } else if (type == 1) {
#pragma unroll
            for (int bj = 0; bj < 2; ++bj) { const int col = (pn - 4) * 256 + bj * 128 + wc * 32 + 8 * fq; const f32x4 a = acc[bj][0] * rs, b = acc[bj][1] * rs;
                v4u w; w.x = pg8::cvt_pk_bf16(a[0], a[1]); w.y = pg8::cvt_pk_bf16(a[2], a[3]); w.z = pg8::cvt_pk_bf16(b[0], b[1]); w.w = pg8::cvt_pk_bf16(b[2], b[3]);
                *(v4u*)(GB + (size_t)row * 512 + col) = w; }
        } else if (type == 7) {
            if (fq == 0) { *(f32x4*)(WI + (size_t)row * 8) = acc[0][0] * rs; *(f32x4*)(WI + (size_t)row * 8 + 4) = acc[0][1] * rs; }
        } else {
            f32x4 v[2][2];
#pragma unroll
            for (int bj = 0; bj < 2; ++bj) { v[bj][0] = acc[bj][0] * rs; v[bj][1] = acc[bj][1] * rs; }
            if (type == 2 || type == 3) {
                float sq = 0.f;
#pragma unroll
                for (int bj = 0; bj < 2; ++bj)
#pragma unroll
                    for (int h2 = 0; h2 < 2; ++h2) sq += (v[bj][h2][0] * v[bj][h2][0] + v[bj][h2][1] * v[bj][h2][1]) + (v[bj][h2][2] * v[bj][h2][2] + v[bj][h2][3] * v[bj][h2][3]);
                sq += __shfl_xor(sq, 16); sq += __shfl_xor(sq, 32);
                const float sc = __builtin_amdgcn_rsqf(sq * (1.0f / 64.0f) + EPS);
#pragma unroll
                for (int bj = 0; bj < 2; ++bj)
#pragma unroll
                    for (int h2 = 0; h2 < 2; ++h2) { const f32x4 gq = *(const f32x4*)(qn + dstart(bj, fq, h2)), gk = *(const f32x4*)(kn + dstart(bj, fq, h2)); v[bj][h2] = v[bj][h2] * sc * ((type == 2) ? gq : gk); }
            }
            if (type != 4 && fq < 2) {
                const int pidx = row < MP ? (row & (SEQ - 1)) : (live ? SEQ + ((row - MP) & 3) : 0);
                const float* rp = rope + ((size_t)pidx * 8 + 4 * fq) * 2;
                const f32x4 cs0 = *(const f32x4*)rp, cs1 = *(const f32x4*)(rp + 4);
                const f32x4 x1 = v[0][0], x2 = v[0][1];
                const f32x4 c = (f32x4){cs0[0], cs0[2], cs1[0], cs1[2]}, s = (f32x4){cs0[1], cs0[3], cs1[1], cs1[3]};
                v[0][0] = x1 * c - x2 * s; v[0][1] = x2 * c + x1 * s;
            }
            const size_t boff = (type == 2) ? WS_Q : (type == 3) ? WS_KB : (type == 4) ? WS_VB : (type == 5) ? WS_QI : WS_KIB;
            const int bp = (type == 2 || type == 5) ? 512 : (type == 6) ? 64 : 128; const float bsc = (type == 2) ? QSCALE : 1.0f;
            bf16_t* bdst = (bf16_t*)(ws + boff);
            const bool hasf = live && (type == 3 || type == 4 || type == 6);
            const size_t fbase = (type == 3) ? (row < MP ? O_KP : O_KS) : (type == 4) ? (row < MP ? O_VP : O_VS) : (row < MP ? O_IP : O_IS);
            float* fdst = out + fbase + (size_t)(row < MP ? row : row - MP) * (type == 6 ? 64 : 128);
#pragma unroll
            for (int bj = 0; bj < 2; ++bj)
#pragma unroll
                for (int h2 = 0; h2 < 2; ++h2) { const int d = head * 64 + dstart(bj, fq, h2); const f32x4 x = v[bj][h2];
                    if (hasf) { if (row < MP) __builtin_nontemporal_store(x, (f32x4*)(fdst + d)); else *(f32x4*)(fdst + d) = x; }
                    v2u w; w.x = pg8::cvt_pk_bf16(x[0] * bsc, x[1] * bsc); w.y = pg8::cvt_pk_bf16(x[2] * bsc, x[3] * bsc);
                    *(v2u*)(bdst + (size_t)row * bp + d) = w; }
        }
    }
    EPI_CALL_ROWS()
    EPI_ZERO_INIT()
};
template <class Epi> __device__ __forceinline__ void skinny_unit(PG8_LAS unsigned char* lds, const bf16_t* A, const bf16_t* Bt, int K, int pn, int wc, int rg, const Epi& E) {
    const int tid = threadIdx.x, wid = __builtin_amdgcn_readfirstlane(tid >> 6), lane = tid & 63, fr = lane & 15, fq = lane >> 4;
    const int KQ = K >> 3, ns = KQ >> 5;
    const bf16_t* ap = A + (size_t)(MP + 64 * rg + fr) * K + wid * KQ + 8 * fq;
    const bf16_t* bp = Bt + (size_t)(256 * pn + 32 * wc + fr) * K + wid * KQ + 8 * fq;
    pg8::f32x4 acc[4][2][2];
#pragma unroll
    for (int mt = 0; mt < 4; ++mt)
#pragma unroll
        for (int bj = 0; bj < 2; ++bj)
#pragma unroll
            for (int n = 0; n < 2; ++n) acc[mt][bj][n] = (pg8::f32x4){0.f, 0.f, 0.f, 0.f};
    pg8::bf16x8 a0[4], b0[2][2], a1[4], b1[2][2], a2[4], b2[2][2], a3[4], b3[2][2];
#define SK_LOAD(af, bf, s_) do { const int sc_ = (s_) < ns ? (s_) : ns - 1; _Pragma("unroll") for (int mt = 0; mt < 4; ++mt) af[mt] = *(const pg8::bf16x8*)(ap + (size_t)(16 * mt) * K + 32 * sc_); \
        _Pragma("unroll") for (int bj = 0; bj < 2; ++bj) _Pragma("unroll") for (int n = 0; n < 2; ++n) bf[bj][n] = *(const pg8::bf16x8*)(bp + (size_t)(128 * bj + 16 * n) * K + 32 * sc_); } while (0)
#define SK_MMA(af, bf) do { _Pragma("unroll") for (int mt = 0; mt < 4; ++mt) _Pragma("unroll") for (int bj = 0; bj < 2; ++bj) _Pragma("unroll") for (int n = 0; n < 2; ++n) \
        acc[mt][bj][n] = __builtin_amdgcn_mfma_f32_16x16x32_bf16(bf[bj][n], af[mt], acc[mt][bj][n], 0, 0, 0); } while (0)
    SK_LOAD(a0, b0, 0); SK_LOAD(a1, b1, 1); SK_LOAD(a2, b2, 2);
    for (int s = 0; s < ns; s += 4) {
        SK_LOAD(a3, b3, s + 3); SK_MMA(a0, b0);
        if (s + 1 < ns) { SK_LOAD(a0, b0, s + 4); SK_MMA(a1, b1); }
        if (s + 2 < ns) { SK_LOAD(a1, b1, s + 5); SK_MMA(a2, b2); }
        if (s + 3 < ns) { SK_LOAD(a2, b2, s + 6); SK_MMA(a3, b3); }
    }
#undef SK_LOAD
#undef SK_MMA
    PG8_LAS pg8::f32x4* slab = (PG8_LAS pg8::f32x4*)lds;
#pragma unroll
    for (int mt = 0; mt < 4; ++mt)
#pragma unroll
        for (int bj = 0; bj < 2; ++bj)
#pragma unroll
            for (int n = 0; n < 2; ++n) slab[((wid * 4 + mt) * 4 + bj * 2 + n) * 64 + lane] = acc[mt][bj][n];
    __syncthreads();
    if (wid < 4) { pg8::f32x4 v[2][2];
#pragma unroll
      for (int bj = 0; bj < 2; ++bj)
#pragma unroll
          for (int n = 0; n < 2; ++n) { const int o = (wid * 4 + bj * 2 + n) * 64 + lane; pg8::f32x4 t = slab[o];
#pragma unroll
              for (int q = 1; q < 8; ++q) t = t + slab[o + q * 4 * 4 * 64];
              v[bj][n] = t; }
      E.row(v, MP + 64 * rg + 16 * wid + fr, pn, wc, fr, fq, -1); }
    __syncthreads();
}
template <class Epi> __device__ __forceinline__ void skinny_phase(PG8_LAS unsigned char* lds, const bf16_t* A, const bf16_t* Bt, int N, int K, int blk, int G, const Epi& E) {
    const int nu = (N / 256) * 8;
    for (int u = blk; u < nu; u += G) skinny_unit(lds, A, Bt, K, u >> 3, (u >> 1) & 3, u & 1, E);
}
__device__ __forceinline__ void fill_rstd_table(LAS float* tab, const pg8::StaticOrder& S, const float* ss, int nslot, const float* xs = nullptr) {
    const int tid = threadIdx.x; Unit u; int nu = 0;
    while (nu < 11 && S.next(nu, u)) ++nu;
    float sv[6], xsv[6]; int ix[6];
#pragma unroll
    for (int k2 = 0; k2 < 6; ++k2) { const int idx = tid + 512 * k2; ix[k2] = idx; const bool ok = idx < nu * 256; Unit uu_; S.next(ok ? (idx >> 8) : 0, uu_); const int row = uu_.pm * 256 + (idx & 255);
        float s_ = 0.f;
        if (nslot == 1) s_ = ss[row];
        else { const f32x4* p = (const f32x4*)(ss + (size_t)row * 16); const f32x4 a = p[0], b = p[1], c = p[2], d = p[3]; s_ = ((a.x + a.y) + (a.z + a.w)) + ((b.x + b.y) + (b.z + b.w)) + ((c.x + c.y) + (c.z + c.w)) + ((d.x + d.y) + (d.z + d.w)); }
        sv[k2] = s_; xsv[k2] = xs ? xs[row] : 1.0f; }
#pragma unroll
    for (int k2 = 0; k2 < 6; ++k2) if (ix[k2] < nu * 256) tab[ix[k2]] = __builtin_amdgcn_rsqf(sv[k2] * (1.0f / D) + EPS) * xsv[k2];
    __syncthreads();
}
__device__ __forceinline__ void quant_rows_pass(int gw, int NGW, const bf16_t* X, unsigned char* Q, float* XS, int nrows) {
    const int lane = threadIdx.x & 63;
    for (int g8 = gw; g8 < nrows / 8; g8 += NGW) {
        const int m0 = 8 * g8; v4u a[8][2];
#pragma unroll
        for (int r = 0; r < 8; ++r) { a[r][0] = *(const v4u*)(X + (size_t)(m0 + r) * D + 8 * lane); a[r][1] = *(const v4u*)(X + (size_t)(m0 + r) * D + 512 + 8 * lane); }
#pragma unroll
        for (int r = 0; r < 8; ++r) {
            float x[16];
#pragma unroll
            for (int e = 0; e < 4; ++e) { x[2 * e] = __uint_as_float(a[r][0][e] << 16); x[2 * e + 1] = __uint_as_float(a[r][0][e] & 0xffff0000u); x[8 + 2 * e] = __uint_as_float(a[r][1][e] << 16); x[9 + 2 * e] = __uint_as_float(a[r][1][e] & 0xffff0000u); }
            float mx = 0.f;
#pragma unroll
            for (int e = 0; e < 16; ++e) mx = fmaxf(mx, fabsf(x[e]));
            { unsigned v = __float_as_uint(mx), o;
              o = (unsigned)__builtin_amdgcn_update_dpp(0, (int)v, 0xB1, 0xF, 0xF, true); v = o > v ? o : v;
              o = (unsigned)__builtin_amdgcn_update_dpp(0, (int)v, 0x4E, 0xF, 0xF, true); v = o > v ? o : v;
              o = (unsigned)__builtin_amdgcn_update_dpp(0, (int)v, 0x141, 0xF, 0xF, true); v = o > v ? o : v;
              o = (unsigned)__builtin_amdgcn_update_dpp(0, (int)v, 0x140, 0xF, 0xF, true); v = o > v ? o : v;
              const unsigned p0 = (unsigned)__builtin_amdgcn_readlane((int)v, 0), p1 = (unsigned)__builtin_amdgcn_readlane((int)v, 16), p2 = (unsigned)__builtin_amdgcn_readlane((int)v, 32), p3 = (unsigned)__builtin_amdgcn_readlane((int)v, 48);
              const unsigned q0 = p0 > p1 ? p0 : p1, q1 = p2 > p3 ? p2 : p3; mx = __uint_as_float(q0 > q1 ? q0 : q1); }
            const float iq = mx > 0.f ? 127.0f / mx : 0.f;
            unsigned w[4];
#pragma unroll
            for (int e = 0; e < 4; ++e) { const int q0 = (int)__builtin_rintf(x[4 * e] * iq), q1 = (int)__builtin_rintf(x[4 * e + 1] * iq), q2 = (int)__builtin_rintf(x[4 * e + 2] * iq), q3 = (int)__builtin_rintf(x[4 * e + 3] * iq);
                w[e] = (unsigned)(q0 & 0xff) | ((unsigned)(q1 & 0xff) << 8) | ((unsigned)(q2 & 0xff) << 16) | ((unsigned)(q3 & 0xff) << 24); }
            *(v2u*)(Q + (size_t)(m0 + r) * D + 8 * lane) = (v2u){w[0], w[1]};
            *(v2u*)(Q + (size_t)(m0 + r) * D + 512 + 8 * lane) = (v2u){w[2], w[3]};
            if (lane == 0) XS[m0 + r] = mx * (1.0f / 127.0f);
        }
    }
}
struct Frame {
    LAS unsigned char* lds;
    volatile LAS unsigned* MISC;
    gu32* ctl;
    int tid, lane, wave, vcu, G;
    const void* const* in;
    float* out; unsigned char* ws;
};
#define WSP(T, off) ((T*)(F.ws + (off)))

template <class Map> __device__ __forceinline__ void p0_transpose_item(const float* W, int K, int N, const float* gain, bf16* WT, LAS float* scr, int item, int lane, const Map map, unsigned char* WT8 = nullptr) {
    const int nblk = (N + 31) / 32, kb = item / nblk, nb = item % nblk, k0 = 64 * kb, n0 = 32 * nb;
    const bool nok = n0 + (lane & 31) < N;
#pragma unroll 8
    for (int i = 0; i < 32; ++i) { const int kk = 2 * i + (lane >> 5); float v = nok ? __builtin_nontemporal_load(W + (size_t)(k0 + kk) * N + n0 + (lane & 31)) : 0.f; if (gain) v *= gain[k0 + kk]; scr[kk * 33 + (lane & 31)] = v; }
    LDS_WAIT(); asm volatile("" ::: "memory");
    const int c = lane & 7;
#pragma unroll
    for (int j = 0; j < 4; ++j) { const int n = (lane >> 3) + 8 * j; const LAS float* s = scr + (8 * c) * 33 + n;
        v4u o; o.x = pk2(s[0 * 33], s[1 * 33]); o.y = pk2(s[2 * 33], s[3 * 33]); o.z = pk2(s[4 * 33], s[5 * 33]); o.w = pk2(s[6 * 33], s[7 * 33]);
        if (n0 + n < N) { *(GAS v4u*)(WT + (size_t)map(n0 + n) * K + k0 + 8 * c) = o;
            if (WT8) { v2u o8; o8.x = pk4_fp8(s[0 * 33] * W8SCALE, s[1 * 33] * W8SCALE, s[2 * 33] * W8SCALE, s[3 * 33] * W8SCALE); o8.y = pk4_fp8(s[4 * 33] * W8SCALE, s[5 * 33] * W8SCALE, s[6 * 33] * W8SCALE, s[7 * 33] * W8SCALE);
                *(GAS v2u*)(WT8 + (size_t)map(n0 + n) * K + k0 + 8 * c) = o8; } } }
    LDS_WAIT(); asm volatile("" ::: "memory");
}
__device__ __forceinline__ void sincos_d(double a, float& s, float& c) {
    const double TWO_PI = 6.283185307179586476925286766559, PI = 3.14159265358979323846264338327950288;
    double k = __builtin_rint(a / TWO_PI); double r = a - k * TWO_PI;
    double sgn = 1.0; if (r > PI * 0.5) { r = PI - r; sgn = -1.0; } else if (r < -PI * 0.5) { r = -PI - r; sgn = -1.0; }
    const double r2 = r * r;
    double ts = 1.0, tc = 1.0, ps = 1.0, pc = 1.0;
#pragma unroll
    for (int n = 1; n <= 12; ++n) { pc = -pc * r2 / (double)((2 * n - 1) * (2 * n)); ps = -ps * r2 / (double)((2 * n) * (2 * n + 1)); tc += pc; ts += ps; }
    s = (float)(r * ts); c = (float)(sgn * tc);
}
__device__ __forceinline__ void p0_prologue(Frame& F) {
    LAS float* scr = (LAS float*)(F.lds + RING_OFF + F.wave * 16384);
    const int gw = F.vcu * 8 + F.wave, NGW = F.G * 8;
    constexpr int I_G = (D / 64) * (DFF / 32), I_D = (DFF / 64) * (D / 32), I_IN = (D / 64) * ((NIN + 31) / 32), I_O = (D / 64) * (D / 32);
    constexpr int NITEMS = 2 * (2 * I_G + I_D) + I_IN + I_O;
    for (int rep63 = 0; rep63 < (PROBE_DUP == 63 ? 2 : 1); ++rep63)
    for (int it = gw; it < NITEMS; it += NGW) {
        int r = it;
        if (r < I_G) { p0_transpose_item(((const float*)F.in[8]), D, DFF, ((const float*)F.in[7]), WSP(bf16, WS_WGU1), scr, r, F.lane, MapGate()); continue; } r -= I_G;
        if (r < I_G) { p0_transpose_item(((const float*)F.in[9]), D, DFF, ((const float*)F.in[7]), WSP(bf16, WS_WGU1), scr, r, F.lane, MapUp()); continue; } r -= I_G;
        if (r < I_D) { p0_transpose_item(((const float*)F.in[10]), DFF, D, nullptr, WSP(bf16, WS_WD1), scr, r, F.lane, MapLin(), WSP(unsigned char, WS_WD1_8)); continue; } r -= I_D;
        if (r < I_G) { p0_transpose_item(((const float*)F.in[19]), D, DFF, ((const float*)F.in[18]), WSP(bf16, WS_WGU2), scr, r, F.lane, MapGate()); continue; } r -= I_G;
        if (r < I_G) { p0_transpose_item(((const float*)F.in[20]), D, DFF, ((const float*)F.in[18]), WSP(bf16, WS_WGU2), scr, r, F.lane, MapUp()); continue; } r -= I_G;
        if (r < I_D) { p0_transpose_item(((const float*)F.in[21]), DFF, D, nullptr, WSP(bf16, WS_WD2), scr, r, F.lane, MapLin(), WSP(unsigned char, WS_WD2_8)); continue; } r -= I_D;
        if (r < I_IN) { p0_transpose_item(((const float*)F.in[12]), D, NIN, ((const float*)F.in[11]), WSP(bf16, WS_WIN), scr, r, F.lane, MapWin()); continue; } r -= I_IN;
        p0_transpose_item(((const float*)F.in[17]), D, D, nullptr, WSP(bf16, WS_WOUT), scr, r, F.lane, MapLin());
    }
    bf16* XB = WSP(bf16, WS_XB); float* SS0 = WSP(float, WS_SS0);
    for (int rep64 = 0; rep64 < (PROBE_DUP == 64 ? 2 : 1); ++rep64)
    for (int g4 = gw; g4 < MTOT / 4; g4 += NGW) {
        const int m0 = 4 * g4;
        const float* xrow = m0 < MP ? ((const float*)F.in[0]) + (size_t)m0 * D : ((const float*)F.in[1]) + (size_t)(m0 - MP) * D;
        const GAS f32x4* xr = (const GAS f32x4*)xrow + F.lane;
        f32x4 v[4][4]; float s[4];
#pragma unroll
        for (int r = 0; r < 4; ++r)
#pragma unroll
            for (int j = 0; j < 4; ++j) v[r][j] = __builtin_nontemporal_load((const f32x4*)(xr + 256 * r + 64 * j));
#pragma unroll
        for (int r = 0; r < 4; ++r) { s[r] = 0.f;
#pragma unroll
            for (int j = 0; j < 4; ++j) s[r] += (v[r][j].x * v[r][j].x + v[r][j].y * v[r][j].y) + (v[r][j].z * v[r][j].z + v[r][j].w * v[r][j].w); }
#pragma unroll
        for (int o = 1; o < 64; o <<= 1) {
#pragma unroll
            for (int r = 0; r < 4; ++r) s[r] += __shfl_xor(s[r], o); }
        GAS unsigned long long* o8 = (GAS unsigned long long*)(XB + (size_t)m0 * D) + F.lane;
#pragma unroll
        for (int r = 0; r < 4; ++r)
#pragma unroll
            for (int j = 0; j < 4; ++j) o8[256 * r + 64 * j] = (unsigned long long)pk2(v[r][j].x, v[r][j].y) | ((unsigned long long)pk2(v[r][j].z, v[r][j].w) << 32);
        { float mx[4];
#pragma unroll
          for (int r = 0; r < 4; ++r) { mx[r] = 0.f;
#pragma unroll
              for (int j = 0; j < 4; ++j) mx[r] = fmaxf(mx[r], fmaxf(fmaxf(fabsf(v[r][j].x), fabsf(v[r][j].y)), fmaxf(fabsf(v[r][j].z), fabsf(v[r][j].w)))); }
#pragma unroll
          for (int o = 1; o < 64; o <<= 1) {
#pragma unroll
              for (int r = 0; r < 4; ++r) mx[r] = fmaxf(mx[r], __shfl_xor(mx[r], o)); }
          GAS unsigned* q8 = (GAS unsigned*)(WSP(unsigned char, WS_XI8) + (size_t)m0 * D) + F.lane;
#pragma unroll
          for (int r = 0; r < 4; ++r) { const float iq = mx[r] > 0.f ? 127.0f / mx[r] : 0.f;
#pragma unroll
              for (int j = 0; j < 4; ++j) { const int a_ = (int)__builtin_rintf(v[r][j].x * iq), b_ = (int)__builtin_rintf(v[r][j].y * iq), c_ = (int)__builtin_rintf(v[r][j].z * iq), d_ = (int)__builtin_rintf(v[r][j].w * iq);
                  q8[256 * r + 64 * j] = (unsigned)(a_ & 0xff) | ((unsigned)(b_ & 0xff) << 8) | ((unsigned)(c_ & 0xff) << 16) | ((unsigned)(d_ & 0xff) << 24); } }
          if (F.lane < 4) WSP(float, WS_XS)[m0 + F.lane] = (F.lane == 0 ? mx[0] : F.lane == 1 ? mx[1] : F.lane == 2 ? mx[2] : mx[3]) * (1.0f / 127.0f); }
        if (F.lane < 4) SS0[m0 + F.lane] = F.lane == 0 ? s[0] : F.lane == 1 ? s[1] : F.lane == 2 ? s[2] : s[3];
    }
    { float* rope = WSP(float, WS_ROPE);
      const double invf[8] = {1.0, 0.19392274474868576, 0.03760603093086393, 0.007292664737217109, 0.001414213562373095, 0.0002742481756762073, 5.318295896944988e-05, 1.031338537721246e-05};
      for (int rep65 = 0; rep65 < (PROBE_DUP == 65 ? 2 : 1); ++rep65)
      for (int e = (F.vcu * 512 + F.tid); e < 2052 * 8; e += F.G * 512) { const int p = e >> 3, i = e & 7; const double pos = (double)(p < SEQ ? p : PAST + (p - SEQ));
          double f = invf[0];
#pragma unroll
          for (int q = 1; q < 8; ++q) f = (i == q) ? invf[q] : f;
          float s, c; sincos_d(pos * f, s, c); rope[2 * e] = c; rope[2 * e + 1] = s; } }
}

__device__ __forceinline__ void unpack8(const v4u a, float (&o)[8]) {
#pragma unroll
    for (int e = 0; e < 4; ++e) { o[2 * e] = bf2f((unsigned short)(a[e] & 0xffffu)); o[2 * e + 1] = bf2f((unsigned short)(a[e] >> 16)); }
}
__device__ __forceinline__ void p0b_quant_weights(Frame& F) {
    const int gw = F.vcu * 8 + F.wave, NGW = F.G * 8;
    for (int rr = gw; rr < 4 * DFF; rr += NGW) {
        const bool second = rr >= 2 * DFF; const int r = second ? rr - 2 * DFF : rr;
        const bf16* W = second ? WSP(bf16, WS_WGU2) : WSP(bf16, WS_WGU1); unsigned char* Q = second ? WSP(unsigned char, WS_WGU2I8) : WSP(unsigned char, WS_WGU1I8); float* WSN = second ? WSP(float, WS_WSN2) : WSP(float, WS_WSN);
        const v4u a = *(const GAS v4u*)(W + (size_t)r * D + 8 * F.lane), b = *(const GAS v4u*)(W + (size_t)r * D + 512 + 8 * F.lane);
        float x[16]; { float t0[8], t1[8]; unpack8(a, t0); unpack8(b, t1);
#pragma unroll
            for (int e = 0; e < 8; ++e) { x[e] = t0[e]; x[8 + e] = t1[e]; } }
        float mx = 0.f;
#pragma unroll
        for (int e = 0; e < 16; ++e) mx = fmaxf(mx, fabsf(x[e]));
#pragma unroll
        for (int o = 1; o < 64; o <<= 1) mx = fmaxf(mx, __shfl_xor(mx, o));
        const float iq = mx > 0.f ? 127.0f / mx : 0.f;
        unsigned w[4];
#pragma unroll
        for (int e = 0; e < 4; ++e) { const int q0 = (int)__builtin_rintf(x[4 * e] * iq), q1 = (int)__builtin_rintf(x[4 * e + 1] * iq), q2 = (int)__builtin_rintf(x[4 * e + 2] * iq), q3 = (int)__builtin_rintf(x[4 * e + 3] * iq);
            w[e] = (unsigned)(q0 & 0xff) | ((unsigned)(q1 & 0xff) << 8) | ((unsigned)(q2 & 0xff) << 16) | ((unsigned)(q3 & 0xff) << 24); }
        *(GAS v2u*)(Q + (size_t)r * D + 8 * F.lane) = (v2u){w[0], w[1]};
        *(GAS v2u*)(Q + (size_t)r * D + 512 + 8 * F.lane) = (v2u){w[2], w[3]};
        if (F.lane == 0) WSN[r] = mx * (1.0f / 127.0f);
    }
}
__device__ __forceinline__ void p4_conv(Frame& F) {
    const int gw = F.vcu * 8 + F.wave, NGW = F.G * 8, ch = F.lane * 8;
    const bf16* U = WSP(bf16, WS_U); const bf16* GBp = WSP(bf16, WS_GB); bf16* CAT = WSP(bf16, WS_CAT);
    const float* conv_w = (const float*)F.in[13]; const float* conv_b = (const float*)F.in[14]; const float* cache_conv = (const float*)F.in[5];
    float w0[8], w1[8], w2[8], cb[8];
#pragma unroll
    for (int e = 0; e < 8; ++e) { w0[e] = conv_w[ch + e]; w1[e] = conv_w[512 + ch + e]; w2[e] = conv_w[1024 + ch + e]; cb[e] = conv_b[ch + e]; }
    for (int c = gw; c < MTOT / 8; c += NGW) {
        const int r0 = 8 * c;
        v4u ur[10], gr[8];
#pragma unroll
        for (int e = 0; e < 10; ++e) { const int rr = r0 - 2 + e; ur[e] = *(const GAS v4u*)(U + (size_t)(rr < 0 ? 0 : rr) * 512 + ch); }
#pragma unroll
        for (int e = 0; e < 8; ++e) gr[e] = *(const GAS v4u*)(GBp + (size_t)(r0 + e) * 512 + ch);
        float um2[8], um1[8];
        unpack8(ur[0], um2); unpack8(ur[1], um1);
        if (r0 < MP && (r0 & (SEQ - 1)) == 0) {
#pragma unroll
            for (int e = 0; e < 8; ++e) { um2[e] = 0.f; um1[e] = 0.f; } }
#pragma unroll
        for (int e = 0; e < 8; ++e) {
            if (r0 >= MP && (e & 3) == 0) {
                const float* cc = cache_conv + (size_t)((r0 - MP + e) >> 2) * 2 * 512 + ch;
#pragma unroll
                for (int q = 0; q < 8; ++q) { um2[q] = cc[q]; um1[q] = cc[512 + q]; } }
            float u0[8], g[8], y[8]; unpack8(ur[2 + e], u0); unpack8(gr[e], g);
#pragma unroll
            for (int q = 0; q < 8; ++q) { y[q] = g[q] * (cb[q] + w0[q] * um2[q] + w1[q] * um1[q] + w2[q] * u0[q]); um2[q] = um1[q]; um1[q] = u0[q]; }
            v4u o; o.x = pk2(y[0], y[1]); o.y = pk2(y[2], y[3]); o.z = pk2(y[4], y[5]); o.w = pk2(y[6], y[7]);
            *(GAS v4u*)(CAT + (size_t)(r0 + e) * D + ch) = o;
        }
    }
}
__device__ __forceinline__ int crow16(int r, int hi) { return (r & 3) + 8 * (r >> 2) + 4 * hi; }
__device__ __forceinline__ float xhalf_sum(float v) {
    auto rr = __builtin_amdgcn_permlane32_swap(__float_as_uint(v), __float_as_uint(v), false, false);
    return __uint_as_float(rr[0]) + __uint_as_float(rr[1]);
}
__device__ __forceinline__ void p4_sample_scores(Frame& F) {
    const int gw = F.vcu * 8 + F.wave, NGW = F.G * 8, lane = F.lane, r32 = lane & 31, hi = lane >> 5;
    const bf16* QI = WSP(bf16, WS_QI); const float* WIp = WSP(float, WS_WI); float* SSC = WSP(float, WS_SSC);
    const int* page_table = (const int*)F.in[6]; const float* cache_idx_k = (const float*)F.in[4];
    for (int item = gw; item < DB * NPAGES; item += NGW) {
        const int b = item >> 7, pg = item & 127; const int page = page_table[b * NPAGES + pg];
        bf16x8 a[4]; f32x4 w4[4];
        { const bf16* qrow = QI + (size_t)(MP + 4 * b + (r32 >> 3)) * 512 + (r32 & 7) * 64 + 8 * hi;
#pragma unroll
          for (int s = 0; s < 4; ++s) a[s] = *(const GAS bf16x8*)(qrow + 16 * s);
#pragma unroll
          for (int q = 0; q < 4; ++q) w4[q] = *(const GAS f32x4*)(WIp + (size_t)(MP + 4 * b + q) * 8 + 4 * hi); }
        const float* src = cache_idx_k + ((size_t)page * PAGE + r32) * 64 + 8 * hi;
        f32x4 lo[4][4], hh[4][4];
#pragma unroll
        for (int sub = 0; sub < 4; ++sub)
#pragma unroll
            for (int s = 0; s < 4; ++s) { lo[sub][s] = __builtin_nontemporal_load((const f32x4*)(src + sub * 32 * 64 + 16 * s)); hh[sub][s] = __builtin_nontemporal_load((const f32x4*)(src + sub * 32 * 64 + 16 * s + 4)); }
#pragma unroll
        for (int sub = 0; sub < 4; ++sub) {
            f32x16 acc = {};
#pragma unroll
            for (int s = 0; s < 4; ++s) { v4u p; p.x = pk2(lo[sub][s][0], lo[sub][s][1]); p.y = pk2(lo[sub][s][2], lo[sub][s][3]); p.z = pk2(hh[sub][s][0], hh[sub][s][1]); p.w = pk2(hh[sub][s][2], hh[sub][s][3]);
                acc = __builtin_amdgcn_mfma_f32_32x32x16_bf16(a[s], __builtin_bit_cast(bf16x8, p), acc, 0, 0, 0); }
#pragma unroll
            for (int q = 0; q < 4; ++q) {
                float sum = w4[q][0] * fmaxf(acc[4 * q], 0.f) + w4[q][1] * fmaxf(acc[4 * q + 1], 0.f) + w4[q][2] * fmaxf(acc[4 * q + 2], 0.f) + w4[q][3] * fmaxf(acc[4 * q + 3], 0.f);
                sum = xhalf_sum(sum) + 0.0f;
                if ((q >> 1) == hi) SSC[(size_t)(4 * b + q) * SSTR + pg * PAGE + sub * 32 + r32] = sum;
            }
        }
    }
}
__device__ __forceinline__ unsigned fkey(float s) { const unsigned b = __builtin_bit_cast(unsigned, s); return b ^ ((unsigned)((int)b >> 31) | 0x80000000u); }
__device__ __forceinline__ float unfkey(unsigned k) { const unsigned b = (k & 0x80000000u) ? (k ^ 0x80000000u) : ~k; return __builtin_bit_cast(float, b); }
__device__ __forceinline__ unsigned wave_umax(unsigned v) {
    unsigned o;
    o = (unsigned)__builtin_amdgcn_update_dpp(0, (int)v, 0xB1, 0xF, 0xF, true); v = o > v ? o : v;
    o = (unsigned)__builtin_amdgcn_update_dpp(0, (int)v, 0x4E, 0xF, 0xF, true); v = o > v ? o : v;
    o = (unsigned)__builtin_amdgcn_update_dpp(0, (int)v, 0x141, 0xF, 0xF, true); v = o > v ? o : v;
    o = (unsigned)__builtin_amdgcn_update_dpp(0, (int)v, 0x140, 0xF, 0xF, true); v = o > v ? o : v;
    const unsigned a = (unsigned)__builtin_amdgcn_readlane((int)v, 0), b = (unsigned)__builtin_amdgcn_readlane((int)v, 16), c = (unsigned)__builtin_amdgcn_readlane((int)v, 32), d = (unsigned)__builtin_amdgcn_readlane((int)v, 48);
    const unsigned ab = a > b ? a : b, cd = c > d ? c : d; return ab > cd ? ab : cd;
}
__device__ __forceinline__ int wave_count(unsigned cl) {
    int tot = 0;
#pragma unroll
    for (int bb = 0; bb < 6; ++bb) tot += __popcll(__ballot((cl >> bb) & 1u)) << bb;
    return tot;
}
__device__ __forceinline__ void p4_index_preload(Frame& F, int b, int j, bf16x8 (&a)[4][4], float& pwq) {
    const int tid = F.tid, r32 = F.lane & 31, hi = F.lane >> 5; const size_t rowb = (size_t)b * SEQ; const int t0 = 16 * j;
    const bf16* QI = WSP(bf16, WS_QI); const float* WIp = WSP(float, WS_WI);
    pwq = WIp[(rowb + t0 + ((tid & 127) >> 3)) * 8 + (tid & 7)];
#pragma unroll
    for (int rt = 0; rt < 4; ++rt) { const bf16* qrow = QI + (rowb + t0 + 4 * rt + 2 * (r32 >> 4) + ((r32 >> 2) & 1)) * 512 + (4 * ((r32 >> 3) & 1) + (r32 & 3)) * 64 + 8 * hi;
#pragma unroll
        for (int s = 0; s < 4; ++s) a[rt][s] = *(const GAS bf16x8*)(qrow + 16 * s); }
}
__device__ __forceinline__ void p4_index_unit(Frame& F, int b, int j, int useq, bf16x8 (&a)[4][4], float& pwq, int nj) {
    int tid_ = F.tid; asm volatile("" : "+v"(tid_));
    const int tid = tid_, lane = tid & 63, wid = F.wave, r32 = lane & 31, hi = lane >> 5;
    const int ss_id = (F.vcu * 8 + useq) * 8 + wid, ss_item = ss_id >> 2, ss_sub = ss_id & 3, ss_b = ss_item >> 7, ss_pg = ss_item & 127;
    const bool ss_on = F.vcu < 256;
    const int ss_page = ss_on ? ((const int*)F.in[6])[ss_b * NPAGES + ss_pg] : 0;
    const int t0 = 16 * j, nk = t0 + 16, ntile = (nk + 31) >> 5;
    LAS float* S = (LAS float*)(F.lds + RING_OFF);
    LAS float* WQ = (LAS float*)(F.lds + RING_OFF + 131072);
    LAS unsigned long long* MSK = (LAS unsigned long long*)(F.lds + RING_OFF + 131072 + 512);
    LAS unsigned* HW = (LAS unsigned*)(F.lds + RING_OFF + 131072 + 512 + 4096) + wid * 512;
    const bf16* QI = WSP(bf16, WS_QI); const bf16* KIB = WSP(bf16, WS_KIB); const float* WIp = WSP(float, WS_WI);
    unsigned long long* MASK = WSP(unsigned long long, WS_MASK);
    const size_t rowb = (size_t)b * SEQ;
    for (int rep43 = 0; rep43 < (PROBE_DUP == 43 ? 2 : 1); ++rep43)
    if (j >= 16) {
        if (tid < 128) WQ[tid] = pwq;
        const bf16* kbase = KIB + (rowb + r32) * 64 + 8 * hi;
#define IDX_LOADB(dst, kt_) do { const int kc_ = (kt_) < ntile ? (kt_) : ntile - 1; _Pragma("unroll") for (int s = 0; s < 4; ++s) dst[s] = *(const GAS bf16x8*)(kbase + (size_t)kc_ * 32 * 64 + 16 * s); } while (0)
#define IDX_COMPUTE(bf_, kt_) do { const int key = (kt_) * 32 + r32; \
            _Pragma("unroll") for (int rt = 0; rt < 4; ++rt) { f32x16 acc = {}; \
                _Pragma("unroll") for (int s = 0; s < 4; ++s) acc = __builtin_amdgcn_mfma_f32_32x32x16_bf16(a[rt][s], bf_[s], acc, 0, 0, 0); \
                _Pragma("unroll") for (int qp = 0; qp < 2; ++qp) { const int ql_ = 4 * rt + 2 * qp + hi;                      \
                    const f32x4 wa = *(const LAS f32x4*)(WQ + ql_ * 8), wb = *(const LAS f32x4*)(WQ + ql_ * 8 + 4); \
                    typedef float f2_ __attribute__((ext_vector_type(2))); const f2_ z2_ = {0.f, 0.f};                        \
                    f2_ s2_ = __builtin_elementwise_max((f2_){acc[8 * qp], acc[8 * qp + 1]}, z2_) * (f2_){wa[0], wa[1]}; \
                    s2_ = __builtin_elementwise_max((f2_){acc[8 * qp + 2], acc[8 * qp + 3]}, z2_) * (f2_){wa[2], wa[3]} + s2_; \
                    s2_ = __builtin_elementwise_max((f2_){acc[8 * qp + 4], acc[8 * qp + 5]}, z2_) * (f2_){wb[0], wb[1]} + s2_; \
                    s2_ = __builtin_elementwise_max((f2_){acc[8 * qp + 6], acc[8 * qp + 7]}, z2_) * (f2_){wb[2], wb[3]} + s2_; \
                    S[ql_ * 2048 + key] = (s2_.x + s2_.y) + 0.0f; } } } while (0)
        bf16x8 bfA[4], bfB[4];
        IDX_LOADB(bfA, wid);
        __syncthreads();
        for (int kt = wid; kt < ntile; kt += 16) {
            IDX_LOADB(bfB, kt + 8);
            IDX_COMPUTE(bfA, kt);
            if (kt + 8 < ntile) { IDX_LOADB(bfA, kt + 16); IDX_COMPUTE(bfB, kt + 8); }
        }
#undef IDX_LOADB
#undef IDX_COMPUTE
        __syncthreads();
    }
    f32x4 ss_lo[4], ss_hh[4];
    { const float* src = ((const float*)F.in[4]) + ((size_t)ss_page * PAGE + ss_sub * 32 + r32) * 64 + 8 * hi;
#pragma unroll
      for (int s = 0; s < 4; ++s) { ss_lo[s] = __builtin_nontemporal_load((const f32x4*)(src + 16 * s)); ss_hh[s] = __builtin_nontemporal_load((const f32x4*)(src + 16 * s + 4)); }
    }
#pragma unroll 1
    for (int rep44 = 0; rep44 < (PROBE_DUP == 44 ? 2 : 1); ++rep44) {
        const int qlA = 2 * wid, tA = t0 + qlA, tB = tA + 1;
        unsigned wloA = 0u, whiA = 0u, wloB = 0u, whiB = 0u;
        if (tA < KTOP) {
            const int lo_ = 64 * lane;
            const unsigned long long wA_ = (lo_ + 63 <= tA) ? ~0ull : (lo_ > tA ? 0ull : ((1ull << (tA - lo_ + 1)) - 1ull)), wB_ = (lo_ + 63 <= tB) ? ~0ull : (lo_ > tB ? 0ull : ((1ull << (tB - lo_ + 1)) - 1ull));
            wloA = (unsigned)wA_; whiA = (unsigned)(wA_ >> 32); wloB = (unsigned)wB_; whiB = (unsigned)(wB_ >> 32);
        } else {
            bool doneA = false, doneB = false;
            { unsigned kvA[32], kvB[32]; float amA = 0.f, amB = 0.f;
              const int ngr = (tA >> 8) + 1;
#pragma unroll
              for (int g4 = 0; g4 < 8; ++g4) {
#pragma unroll
                  for (int e = 0; e < 4; ++e) { kvA[4 * g4 + e] = 0u; kvB[4 * g4 + e] = 0u; }
                  if (g4 < ngr) {
                      float sA[4], sB[4];
#pragma unroll
                      for (int e = 0; e < 4; ++e) { sA[e] = S[qlA * 2048 + lane + 64 * (4 * g4 + e)]; sB[e] = S[qlA * 2048 + 2048 + lane + 64 * (4 * g4 + e)]; }
                      if (g4 == ngr - 1) {
#pragma unroll
                          for (int e = 0; e < 4; ++e) { const int ki = lane + 64 * (4 * g4 + e); sA[e] = (ki <= tA) ? sA[e] : 0.f; sB[e] = (ki <= tB) ? sB[e] : 0.f; } }
#pragma unroll
                      for (int e = 0; e < 4; ++e) { kvA[4 * g4 + e] = __float_as_uint(sA[e]); amA = fmaxf(amA, fabsf(sA[e])); kvB[4 * g4 + e] = __float_as_uint(sB[e]); amB = fmaxf(amB, fabsf(sB[e])); } } }
              const unsigned umA = wave_umax(__float_as_uint(amA)), umB = wave_umax(__float_as_uint(amB));
              const float scaleA = umA ? 0.4999f / __uint_as_float(umA) : 0.f, scaleB = umB ? 0.4999f / __uint_as_float(umB) : 0.f;
#pragma unroll
              for (int g4 = 0; g4 < 8; ++g4) if (g4 < ngr) {
#pragma unroll
                  for (int e = 0; e < 4; ++e) { const int jj = 4 * g4 + e; kvA[jj] = __float_as_uint(__builtin_fmaf(__uint_as_float(kvA[jj]), scaleA, 1.5f)); kvB[jj] = __float_as_uint(__builtin_fmaf(__uint_as_float(kvB[jj]), scaleB, 1.5f)); }
                  if (g4 == ngr - 1) {
#pragma unroll
                      for (int e = 0; e < 4; ++e) { const int jj = 4 * g4 + e; kvA[jj] = (lane + 64 * jj <= tA) ? kvA[jj] : 0u; kvB[jj] = (lane + 64 * jj <= tB) ? kvB[jj] : 0u; } } }
              unsigned pfxA = 0x3F800000u, pfxB = 0x3F800000u, TvA = 0u, TvB = 0u; int needA = KTOP, needB = KTOP;
              const unsigned hwbA = (unsigned)(uintptr_t)HW, hwbB = hwbA + 1024u;
              LAS unsigned* HWB = HW + 256;
#pragma unroll 1
              for (int pass = 0; pass < 3; ++pass) {
                  const int sh = pass == 0 ? 15 : pass == 1 ? 7 : 0;
                  const unsigned lim = pass == 2 ? 128u : (256u << sh);
                  const unsigned limA = doneA ? 0u : lim, limB = doneB ? 0u : lim;
                  *(LAS v4u*)(HW + 4 * lane) = (v4u){0u, 0u, 0u, 0u}; *(LAS v4u*)(HWB + 4 * lane) = (v4u){0u, 0u, 0u, 0u};
                  asm volatile("" ::: "memory");
#pragma unroll
                  for (int g4 = 0; g4 < 8; ++g4) if (g4 < ngr) {
#pragma unroll
                      for (int e = 0; e < 4; ++e) { const unsigned dA_ = kvA[4 * g4 + e] ^ pfxA, dB_ = kvB[4 * g4 + e] ^ pfxB;
                          if (dA_ < limA) __hip_atomic_fetch_add((LAS unsigned*)(uintptr_t)(hwbA + ((dA_ >> sh) << 2)), 1u, __ATOMIC_RELAXED, __HIP_MEMORY_SCOPE_WAVEFRONT);
                          if (dB_ < limB) __hip_atomic_fetch_add((LAS unsigned*)(uintptr_t)(hwbB + ((dB_ >> sh) << 2)), 1u, __ATOMIC_RELAXED, __HIP_MEMORY_SCOPE_WAVEFRONT); } }
                  asm volatile("" ::: "memory");
                  const v4u wA4 = *(const LAS v4u*)(HW + 4 * lane), wB4 = *(const LAS v4u*)(HWB + 4 * lane);
                  asm volatile("" ::: "memory");
#define SEL_SCAN(w4_, need_, HWX_, dgb_, above_, binc_) do { \
                      const unsigned ls_ = (w4_[0] + w4_[1]) + (w4_[2] + w4_[3]); unsigned p_ = ls_; \
                      p_ += (unsigned)__builtin_amdgcn_update_dpp(0, (int)p_, 0x111, 0xF, 0xF, false); p_ += (unsigned)__builtin_amdgcn_update_dpp(0, (int)p_, 0x112, 0xF, 0xF, false); \
                      p_ += (unsigned)__builtin_amdgcn_update_dpp(0, (int)p_, 0x114, 0xF, 0xF, false); p_ += (unsigned)__builtin_amdgcn_update_dpp(0, (int)p_, 0x118, 0xF, 0xF, false); \
                      const unsigned r0_ = (unsigned)__builtin_amdgcn_readlane((int)p_, 15), r1_ = (unsigned)__builtin_amdgcn_readlane((int)p_, 31), r2_ = (unsigned)__builtin_amdgcn_readlane((int)p_, 47), r3_ = (unsigned)__builtin_amdgcn_readlane((int)p_, 63); \
                      const int row_ = lane >> 4; p_ += (row_ == 0) ? 0u : (row_ == 1) ? r0_ : (row_ == 2) ? r0_ + r1_ : r0_ + r1_ + r2_; \
                      const unsigned abl_ = (r0_ + r1_ + r2_ + r3_) - p_;                                    \
                      const unsigned long long fm_ = __ballot((int)abl_ < (need_) && (int)(abl_ + ls_) >= (need_)); \
                      const int src_ = (int)__builtin_ctzll(fm_) & 63; \
                      const unsigned abs_ = (unsigned)__builtin_amdgcn_readlane((int)abl_, src_); \
                      const unsigned ci_ = ((lane & 15) < 4) ? (HWX_)[4 * src_ + (lane & 3)] : 0u;          \
                      unsigned sfx_ = ci_; \
                      sfx_ += (unsigned)__builtin_amdgcn_update_dpp(0, (int)sfx_, 0x101, 0xF, 0xF, false); sfx_ += (unsigned)__builtin_amdgcn_update_dpp(0, (int)sfx_, 0x102, 0xF, 0xF, false); \
                      const unsigned abi_ = abs_ + sfx_ - ci_;                                                \
                      const unsigned long long fb_ = __ballot(lane < 4 && (int)abi_ < (need_) && (int)(abi_ + ci_) >= (need_)); \
                      const int sl2_ = (int)__builtin_ctzll(fb_) & 63; \
                      dgb_ = (unsigned)(4 * src_ + sl2_); above_ = (unsigned)__builtin_amdgcn_readlane((int)abi_, sl2_); binc_ = (unsigned)__builtin_amdgcn_readlane((int)ci_, sl2_); } while (0)
                  unsigned dgA, abvA, bcA, dgB, abvB, bcB;
                  SEL_SCAN(wA4, needA, HW, dgA, abvA, bcA);
                  SEL_SCAN(wB4, needB, HWB, dgB, abvB, bcB);
#undef SEL_SCAN
                  if (!doneA) { pfxA |= dgA << sh; needA -= (int)abvA; TvA = pfxA; doneA = ((int)bcA == needA); }
                  if (!doneB) { pfxB |= dgB << sh; needB -= (int)abvB; TvB = pfxB; doneB = ((int)bcB == needB); }
                  if (doneA && doneB) break;
              }
#define SEL_MASK(kv_, Tv_, wlo_, whi_) do { _Pragma("unroll") for (int j4 = 0; j4 < 8; ++j4) if (j4 < ngr) { \
                      const unsigned long long wa = __ballot(kv_[4 * j4] >= Tv_), wb = __ballot(kv_[4 * j4 + 1] >= Tv_), wc_ = __ballot(kv_[4 * j4 + 2] >= Tv_), wd = __ballot(kv_[4 * j4 + 3] >= Tv_); \
                      asm("s_nop 1\n\tv_writelane_b32 %0, %2, %10\n\tv_writelane_b32 %1, %3, %10\n\tv_writelane_b32 %0, %4, %11\n\tv_writelane_b32 %1, %5, %11\n\tv_writelane_b32 %0, %6, %12\n\tv_writelane_b32 %1, %7, %12\n\tv_writelane_b32 %0, %8, %13\n\tv_writelane_b32 %1, %9, %13" \
                          : "+v"(wlo_), "+v"(whi_) : "s"((unsigned)wa), "s"((unsigned)(wa >> 32)), "s"((unsigned)wb), "s"((unsigned)(wb >> 32)), "s"((unsigned)wc_), "s"((unsigned)(wc_ >> 32)), "s"((unsigned)wd), "s"((unsigned)(wd >> 32)), \
                            "n"(4 * j4), "n"(4 * j4 + 1), "n"(4 * j4 + 2), "n"(4 * j4 + 3)); } } while (0)
              if (doneA) SEL_MASK(kvA, TvA, wloA, whiA);
              if (doneB) SEL_MASK(kvB, TvB, wloB, whiB);
#undef SEL_MASK
            }
#pragma unroll 1
            for (int q2 = 0; q2 < 2; ++q2) {
            if (q2 == 0 ? doneA : doneB) continue;
            const int ql = qlA + q2, t = tA + q2; unsigned wlo = 0u, whi = 0u;
            unsigned uu[32];
#pragma unroll
            for (int jj = 0; jj < 32; ++jj) { const float s = S[ql * 2048 + lane + 64 * jj]; const unsigned k_ = fkey(s); uu[jj] = (lane + 64 * jj <= t) ? k_ : 0u; }
            const int ng = (t >> 8) + 1;
#define SEL_GRP(g4, CAND) if ((g4) < ng) { unsigned long long m0_, m1_, m2_, m3_; \
                    asm volatile("v_cmp_ge_u32_e64 %0, %4, %8\n\tv_cmp_ge_u32_e64 %1, %5, %8\n\tv_cmp_ge_u32_e64 %2, %6, %8\n\tv_cmp_ge_u32_e64 %3, %7, %8" \
                        : "=&s"(m0_), "=&s"(m1_), "=&s"(m2_), "=&s"(m3_) : "v"(uu[4 * (g4)]), "v"(uu[4 * (g4) + 1]), "v"(uu[4 * (g4) + 2]), "v"(uu[4 * (g4) + 3]), "v"(CAND)); \
                    cnt_ += __popcll(m0_) + __popcll(m1_) + __popcll(m2_) + __popcll(m3_); }
#define SEL_COUNT(CAND, OUT) do { int cnt_ = 0; SEL_GRP(0, CAND) SEL_GRP(1, CAND) SEL_GRP(2, CAND) SEL_GRP(3, CAND) SEL_GRP(4, CAND) SEL_GRP(5, CAND) SEL_GRP(6, CAND) SEL_GRP(7, CAND) OUT = cnt_; } while (0)
            unsigned T = 0u; int clo = t + 1;
#pragma unroll 1
            for (int bit = 31; bit >= 0; --bit) {
                const unsigned cand = T | (1u << bit); int c; SEL_COUNT(cand, c);
                if (c >= KTOP) { T = cand; clo = c; if (c == KTOP) break; }
            }
            if (clo == KTOP) {
#pragma unroll
                for (int jj = 0; jj < 32; ++jj) { const unsigned long long word = __ballot(uu[jj] >= T);
                    asm("s_nop 1\n\tv_writelane_b32 %0, %2, %4\n\tv_writelane_b32 %1, %3, %4" : "+v"(wlo), "+v"(whi) : "s"((unsigned)word), "s"((unsigned)(word >> 32)), "n"(jj));     }
            } else {
                int cgt; { const unsigned Tp = T + 1u; SEL_COUNT(Tp, cgt); }
                const int need = KTOP - cgt; int running = 0;
#pragma unroll
                for (int jj = 0; jj < 32; ++jj) {
                    const unsigned long long eq = __ballot(uu[jj] == T);
                    const int rank = (int)__builtin_amdgcn_mbcnt_hi((unsigned)(eq >> 32), __builtin_amdgcn_mbcnt_lo((unsigned)eq, 0u));
                    const unsigned long long word = __ballot(uu[jj] > T || (uu[jj] == T && running + rank < need));
                    asm("s_nop 1\n\tv_writelane_b32 %0, %2, %4\n\tv_writelane_b32 %1, %3, %4" : "+v"(wlo), "+v"(whi) : "s"((unsigned)word), "s"((unsigned)(word >> 32)), "n"(jj));
                    running += __popcll(eq);
                }
            }
            if (q2 == 0) { wloA = wlo; whiA = whi; } else { wloB = wlo; whiB = whi; }
            }
#undef SEL_COUNT
#undef SEL_GRP
        }
        if (lane < 32) { MSK[qlA * 32 + lane] = ((unsigned long long)whiA << 32) | wloA; MSK[qlA * 32 + 32 + lane] = ((unsigned long long)whiB << 32) | wloB; }
    }
    bf16x8 ss_a[4]; f32x4 ss_w[4];
    { const bf16* qrow = QI + (size_t)(MP + 4 * ss_b + (r32 >> 3)) * 512 + (r32 & 7) * 64 + 8 * hi;
#pragma unroll
      for (int s = 0; s < 4; ++s) ss_a[s] = *(const GAS bf16x8*)(qrow + 16 * s);
#pragma unroll
      for (int q = 0; q < 4; ++q) ss_w[q] = *(const GAS f32x4*)(WIp + (size_t)(MP + 4 * ss_b + q) * 8 + 4 * hi); }
    if (nj >= 16) p4_index_preload(F, b, nj, a, pwq);
    if (ss_on) { f32x16 acc = {};
#pragma unroll
        for (int s = 0; s < 4; ++s) { v4u p; p.x = pk2(ss_lo[s][0], ss_lo[s][1]); p.y = pk2(ss_lo[s][2], ss_lo[s][3]); p.z = pk2(ss_hh[s][0], ss_hh[s][1]); p.w = pk2(ss_hh[s][2], ss_hh[s][3]);
            acc = __builtin_amdgcn_mfma_f32_32x32x16_bf16(ss_a[s], __builtin_bit_cast(bf16x8, p), acc, 0, 0, 0); }
        float* SSC = WSP(float, WS_SSC);
#pragma unroll
        for (int q = 0; q < 4; ++q) {
            float sum = ss_w[q][0] * fmaxf(acc[4 * q], 0.f) + ss_w[q][1] * fmaxf(acc[4 * q + 1], 0.f) + ss_w[q][2] * fmaxf(acc[4 * q + 2], 0.f) + ss_w[q][3] * fmaxf(acc[4 * q + 3], 0.f);
            sum = xhalf_sum(sum) + 0.0f;
            if ((q >> 1) == hi) SSC[(size_t)(4 * ss_b + q) * SSTR + ss_pg * PAGE + ss_sub * 32 + r32] = sum;
        } }
    __syncthreads();
    { const int jt = tid >> 4, ql = tid & 15; MASK[((size_t)b * 32 + jt) * SEQ + t0 + ql] = MSK[ql * 32 + jt]; }
    __syncthreads();
}
__device__ __forceinline__ void p4_index(Frame& F) {
    if (F.vcu >= 256) return;
    const int b = F.vcu >> 4, w = F.vcu & 15;
    bf16x8 pa[4][4]; float pwq;
    p4_index_preload(F, b, 127 - w, pa, pwq);
#pragma unroll 1
    for (int k = 0; k < 4; ++k) { const int j1 = w + 16 * k; p4_index_unit(F, b, 127 - j1, 2 * k, pa, pwq, j1); p4_index_unit(F, b, j1, 2 * k + 1, pa, pwq, k < 3 ? 127 - (j1 + 16) : -1); }
}

__device__ __forceinline__ int block_sum8(LAS int* red, int par, int wid, int lane, int v) {
    if (lane == 0) red[par * 8 + wid] = v;
    __syncthreads();
    int s = 0;
#pragma unroll
    for (int w = 0; w < 8; ++w) s += red[par * 8 + w];
    return s;
}
__device__ __forceinline__ void p5_sample_unit(Frame& F, int sq) {
    const int tid = F.tid, lane = F.lane, wid = F.wave;
    const int b = sq >> 2, qi_ = sq & 3, row = MP + sq;
    LAS unsigned char* L0 = F.lds + RING_OFF;
    LAS int* red = (LAS int*)(L0);
    LAS float* newsc = (LAS float*)(L0 + 64);
    LAS int* wcnt = (LAS int*)(L0 + 128);
    LAS int* eqw = (LAS int*)(L0 + 256);
    LAS int* selidx = (LAS int*)(L0 + 2048);
    LAS float* LG = (LAS float*)(L0 + 4096);
    LAS float* OP = (LAS float*)(L0 + 16384);
    const bf16* QI = WSP(bf16, WS_QI); const bf16* KIB = WSP(bf16, WS_KIB); const float* WIp = WSP(float, WS_WI); const float* SSC = WSP(float, WS_SSC);
    const bf16* Qb = WSP(bf16, WS_Q); bf16* CAT = WSP(bf16, WS_CAT);
    if (tid < 64) {
        const int h = (tid >> 2) & 7, jn = tid & 3; float dot = 0.f;
        const bf16* qp = QI + (size_t)row * 512 + h * 64; const bf16* kp = KIB + (size_t)(MP + 4 * b + jn) * 64;
        for (int d = 0; d < 64; ++d) dot += bf2f(qp[d]) * bf2f(kp[d]);
        float v = WIp[(size_t)row * 8 + h] * fmaxf(dot, 0.f);
        v += __shfl_xor(v, 4); v += __shfl_xor(v, 8); v += __shfl_xor(v, 16);
        if (tid < 4) newsc[tid] = (jn <= qi_) ? (v + 0.0f) : -INFINITY;
    }
    __syncthreads();
    unsigned uu[33];
#pragma unroll
    for (int jj = 0; jj < 32; ++jj) uu[jj] = fkey(SSC[(size_t)sq * SSTR + tid + 512 * jj]);
    uu[32] = tid < 4 ? fkey(newsc[tid]) : 0x007FFFFFu;
    unsigned T = 0u; int par = 0;
#pragma unroll 1
    for (int bit = 31; bit >= 0; --bit) {
        const unsigned cand = T | (1u << bit); int c = 0;
#pragma unroll
        for (int jj = 0; jj < 33; ++jj) c += __popcll(__ballot(uu[jj] >= cand));
        c = block_sum8(red, par, wid, lane, c); par ^= 1;
        if (c >= KTOP) { T = cand; if (c == KTOP) break; }
    }
    int cgt = 0;
#pragma unroll
    for (int jj = 0; jj < 33; ++jj) cgt += __popcll(__ballot(uu[jj] > T));
    cgt = block_sum8(red, par, wid, lane, cgt); par ^= 1;
    const int need = KTOP - cgt;
#pragma unroll
    for (int jj = 0; jj < 33; ++jj) { const int n = __popcll(__ballot(uu[jj] == T)); if (lane == 0) eqw[jj * 8 + wid] = n; }
    __syncthreads();
#define SEL_MASK(jj, eqbase, M) do { int below_ = 0, tot_ = 0; \
        _Pragma("unroll") for (int w = 0; w < 8; ++w) { const int n_ = eqw[(jj) * 8 + w]; tot_ += n_; below_ += (w < wid) ? n_ : 0; } \
        const unsigned long long eq_ = __ballot(uu[jj] == T); \
        const int rank_ = (eqbase) + below_ + (int)__builtin_amdgcn_mbcnt_hi((unsigned)(eq_ >> 32), __builtin_amdgcn_mbcnt_lo((unsigned)eq_, 0u)); \
        M = __ballot(uu[jj] > T || (uu[jj] == T && rank_ < need)); (eqbase) += tot_; } while (0)
    { int cw = 0, eqbase = 0;
#pragma unroll
      for (int jj = 0; jj < 33; ++jj) { unsigned long long m; SEL_MASK(jj, eqbase, m); cw += __popcll(m); }
      if (lane == 0) wcnt[wid] = cw; }
    __syncthreads();
    { int base = 0, eqbase = 0;
#pragma unroll
      for (int w = 0; w < 8; ++w) base += (w < wid) ? wcnt[w] : 0;
#pragma unroll
      for (int jj = 0; jj < 33; ++jj) { unsigned long long m; SEL_MASK(jj, eqbase, m);
          const int pos = base + (int)__builtin_amdgcn_mbcnt_hi((unsigned)(m >> 32), __builtin_amdgcn_mbcnt_lo((unsigned)m, 0u));
          if ((m >> lane) & 1ull) { if (pos < KTOP) selidx[pos] = (jj < 32) ? tid + 512 * jj : PAST + tid; }
          base += __popcll(m); } }
#undef SEL_MASK
    __syncthreads();
    const int kk = lane >> 3, ds = lane & 7;
    const float* kptr[4]; const float* vptr[4];
#pragma unroll
    for (int it = 0; it < 4; ++it) {
        const int kidx = selidx[32 * wid + 8 * it + kk];
        if (kidx < PAST) { const size_t pr = (size_t)((const int*)F.in[6])[b * NPAGES + (kidx >> 7)] * PAGE + (kidx & 127); kptr[it] = ((const float*)F.in[2]) + pr * 128 + 8 * ds; vptr[it] = ((const float*)F.in[3]) + pr * 128 + 8 * ds; }
        else { const size_t nr = (size_t)(4 * b + (kidx - PAST)); kptr[it] = F.out + O_KS + nr * 128 + 8 * ds; vptr[it] = F.out + O_VS + nr * 128 + 8 * ds; }
    }
#pragma unroll 1
    for (int g = 0; g < 2; ++g) {
        float qv[4][8];
#pragma unroll
        for (int r = 0; r < 4; ++r) { const v4u qq = *(const GAS v4u*)(Qb + (size_t)row * 512 + (4 * g + r) * 64 + 8 * ds);
#pragma unroll
            for (int e = 0; e < 4; ++e) { qv[r][2 * e] = bf2f((unsigned short)(qq[e] & 0xffffu)); qv[r][2 * e + 1] = bf2f((unsigned short)(qq[e] >> 16)); } }
#pragma unroll
        for (int it = 0; it < 4; ++it) {
            const f32x4 k0 = *(const f32x4*)(kptr[it] + 64 * g), k1 = *(const f32x4*)(kptr[it] + 64 * g + 4);
#pragma unroll
            for (int r = 0; r < 4; ++r) {
                float d = (qv[r][0] * k0[0] + qv[r][1] * k0[1]) + (qv[r][2] * k0[2] + qv[r][3] * k0[3]) + (qv[r][4] * k1[0] + qv[r][5] * k1[1]) + (qv[r][6] * k1[2] + qv[r][7] * k1[3]);
                d += __shfl_xor(d, 1); d += __shfl_xor(d, 2); d += __shfl_xor(d, 4);
                if (ds == 0) LG[(4 * g + r) * 256 + 32 * wid + 8 * it + kk] = d;
            }
        }
    }
    __syncthreads();
    { float l[4];
#pragma unroll
      for (int e = 0; e < 4; ++e) l[e] = LG[wid * 256 + lane + 64 * e];
      const float m = wave_max(fmaxf(fmaxf(l[0], l[1]), fmaxf(l[2], l[3])));
      float p[4], s = 0.f;
#pragma unroll
      for (int e = 0; e < 4; ++e) { p[e] = __builtin_amdgcn_exp2f(l[e] - m); s += p[e]; }
      s = wave_sum(s); const float inv = 1.0f / s;
#pragma unroll
      for (int e = 0; e < 4; ++e) LG[wid * 256 + lane + 64 * e] = p[e] * inv; }
    __syncthreads();
#pragma unroll 1
    for (int g = 0; g < 2; ++g) {
        float acc[4][8];
#pragma unroll
        for (int r = 0; r < 4; ++r)
#pragma unroll
            for (int e = 0; e < 8; ++e) acc[r][e] = 0.f;
#pragma unroll
        for (int it = 0; it < 4; ++it) {
            const f32x4 v0 = *(const f32x4*)(vptr[it] + 64 * g), v1 = *(const f32x4*)(vptr[it] + 64 * g + 4);
#pragma unroll
            for (int r = 0; r < 4; ++r) { const float p = LG[(4 * g + r) * 256 + 32 * wid + 8 * it + kk];
#pragma unroll
                for (int e = 0; e < 4; ++e) { acc[r][e] += p * v0[e]; acc[r][4 + e] += p * v1[e]; } }
        }
#pragma unroll
        for (int r = 0; r < 4; ++r)
#pragma unroll
            for (int e = 0; e < 8; ++e) { float a = acc[r][e]; a += __shfl_xor(a, 8); a += __shfl_xor(a, 16); a += __shfl_xor(a, 32); if (kk == 0) OP[(wid * 8 + 4 * g + r) * 64 + 8 * ds + e] = a; }
    }
    __syncthreads();
    { const int hd = tid >> 6, d = tid & 63; float o = 0.f;
#pragma unroll
      for (int w = 0; w < 8; ++w) o += OP[(w * 8 + hd) * 64 + d];
      CAT[(size_t)row * D + 512 + hd * 64 + d] = (bf16)f2bf(o); }
    __syncthreads();
}

constexpr int N_PHASES = 9;
struct Args { const void* in[22]; float* out; unsigned char* ws; int ph_lo, ph_hi, use_bar, pad; };
__global__ void __launch_bounds__(512, 2) hymba_fwd(Args args) {
    extern __shared__ __attribute__((aligned(16))) unsigned char lds[];
    Frame F;
    F.lds = (LAS unsigned char*)lds;
    F.MISC = (volatile LAS unsigned*)(F.lds + MISC_OFF);
    F.tid = threadIdx.x; F.lane = F.tid & 63; F.wave = __builtin_amdgcn_readfirstlane(F.tid >> 6);
    F.G = gridDim.x; { const int bx = blockIdx.x; F.vcu = (F.G % 8 == 0) ? (bx % 8) * (F.G / 8) + bx / 8 : bx; }
    F.ws = args.ws; F.out = args.out; F.ctl = (gu32*)(args.ws + WS_CTL);
    F.in = args.in;
    for (int u = F.tid; u < (LDS_BYTES - LDSCTL_OFF) / 4; u += 512) ((LAS unsigned*)(F.lds + LDSCTL_OFF))[u] = 0u;
    __syncthreads();
    XcdBarrier bar; bar.bar = (unsigned*)(F.ctl + CW_BAR); bar.x = 0; bar.st = nullptr;
    if (args.use_bar) bar = xcd_barrier_post((unsigned*)(F.ctl + CW_BAR), F.MISC + 8);
    const int lo = args.ph_lo, hi = args.ph_hi;
#define IN(k) (lo <= (k) && (k) < hi)
#define SEAM(k) do { if (IN(k) && IN((k) + 1)) { xcd_barrier(bar); if (PROBE_DUP == 60) xcd_barrier(bar); } } while (0)
    const int cblk = (int)blockIdx.x;

#ifndef PROBE_DUP
#define PROBE_DUP (-1)
#endif
#define RUNPHASE(k, ...) do { if (IN(k)) { { int t_ = F.tid; asm volatile("" : "+v"(t_)); F.tid = t_; F.lane = t_ & 63; }     \
        __VA_ARGS__; if (PROBE_DUP == (k)) { if (args.use_bar) xcd_barrier(bar); __VA_ARGS__; } } SEAM(k); } while (0)
#define RSTAB ((LAS float*)(F.lds + RING_OFF + 131072))
#define GEMM_PHASE(EPI, A_, B_, N_, K_, SS_, NSLOT_, ...) do { pg8::Gemm g{A_, B_, MP, N_, K_}; pg8::StaticOrder S; S.init(MP, N_, F.G, cblk); \
        if ((NSLOT_) > 0) fill_rstd_table(RSTAB, S, SS_, NSLOT_); \
        EPI E{__VA_ARGS__}; \
        pg8::gemm_phase<EPI, pg8::StaticOrder, true, true>(F.lds + RING_OFF, g, S, E); \
        skinny_phase(F.lds + RING_OFF, A_, B_, N_, K_, cblk, F.G, E); if (PROBE_DUP == 50) skinny_phase(F.lds + RING_OFF, A_, B_, N_, K_, cblk, F.G, E); } while (0)
#define GEMM_PHASE8(EPI, A8_, B8_, A_, B_, N_, K_, SS_, NSLOT_, ...) do { pg8::Gemm g{(const bf16*)(A8_), (const bf16*)(B8_), MP, N_, (K_) / 2}; pg8::StaticOrder S; S.init(MP, N_, F.G, cblk); \
        if ((NSLOT_) > 0) fill_rstd_table(RSTAB, S, SS_, NSLOT_); \
        EPI E{__VA_ARGS__}; \
        pg8::gemm_phase<EPI, pg8::StaticOrder, true, true, 1>(F.lds + RING_OFF, g, S, E); \
        skinny_phase(F.lds + RING_OFF, A_, B_, N_, K_, cblk, F.G, E); if (PROBE_DUP == 52) skinny_phase(F.lds + RING_OFF, A_, B_, N_, K_, cblk, F.G, E); } while (0)
#define GEMM_PHASEI(EPI, A8_, B8_, XS_, A_, B_, N_, K_, SS_, NSLOT_, ...) do { pg8::Gemm g{(const bf16*)(A8_), (const bf16*)(B8_), MP, N_, (K_) / 2}; pg8::StaticOrder S; S.init(MP, N_, F.G, cblk); \
        fill_rstd_table(RSTAB, S, SS_, NSLOT_, XS_); \
        EPI E{__VA_ARGS__}; \
        pg8::gemm_phase<EPI, pg8::StaticOrder, true, true, 2>(F.lds + RING_OFF, g, S, E); \
        skinny_phase(F.lds + RING_OFF, A_, B_, N_, K_, cblk, F.G, E); if (PROBE_DUP == 52) skinny_phase(F.lds + RING_OFF, A_, B_, N_, K_, cblk, F.G, E); } while (0)
    RUNPHASE(0, do { p0_prologue(F); xcd_barrier(bar); p0b_quant_weights(F); } while (0));
    RUNPHASE(1, GEMM_PHASEI(EpiGU, WSP(unsigned char, WS_XI8), WSP(unsigned char, WS_WGU1I8), WSP(float, WS_XS), WSP(bf16, WS_XB), WSP(bf16, WS_WGU1), 2 * DFF, D, WSP(float, WS_SS0), 1, WSP(bf16, WS_H), WSP(float, WS_SS0), 1, RSTAB, 1.0f, WSP(unsigned char, WS_H8), WSP(float, WS_WSN)));
    RUNPHASE(2, GEMM_PHASE8(EpiRes<0>, WSP(unsigned char, WS_H8), WSP(unsigned char, WS_WD1_8), WSP(bf16, WS_H), WSP(bf16, WS_WD1), D, DFF, nullptr, 0, WSP(bf16, WS_XB), nullptr, WSP(bf16, WS_X1B), WSP(float, WS_SS1), nullptr, 1.0f / (W8SCALE * H8SCALE)));
#if PROBE_DUP >= 21 && PROBE_DUP <= 23
    if (IN(2)) { xcd_barrier(bar); pg8::Gemm g{(const bf16*)WSP(unsigned char, WS_H8), (const bf16*)WSP(unsigned char, WS_WD1_8), MP, D, DFF / 2}; pg8::StaticOrder S; S.init(MP, D, F.G, cblk);
        EpiRes<0> E{WSP(bf16, WS_XB), nullptr, WSP(bf16, WS_X2B), WSP(float, WS_SS2), nullptr, 1.0f / (W8SCALE * H8SCALE)};
        pg8::gemm_phase<EpiRes<0>, pg8::StaticOrder, true, true, (PROBE_DUP == 21 ? 1 : PROBE_DUP == 22 ? 2 : 0)>(F.lds + RING_OFF, g, S, E); xcd_barrier(bar); }
#endif
    RUNPHASE(3, GEMM_PHASE(EpiWin, WSP(bf16, WS_X1B), WSP(bf16, WS_WIN), NINP, D, WSP(float, WS_SS1), 16, F.ws, F.out, (const float*)F.in[15], (const float*)F.in[16], RSTAB));
    RUNPHASE(4, do { p4_conv(F); if (PROBE_DUP == 40) p4_conv(F); p4_index(F); if (PROBE_DUP == 42) p4_index(F); } while (0));
    RUNPHASE(5, do { if ((F.vcu & 1) == 0 && F.vcu < 256) { p5_sample_unit(F, F.vcu >> 1); if (PROBE_DUP == 51) p5_sample_unit(F, F.vcu >> 1); }
        const attn_body::AttnTensors AT{(const attn_body::bf16*)WSP(bf16, WS_Q), (const attn_body::bf16*)WSP(bf16, WS_KB), (const attn_body::bf16*)WSP(bf16, WS_VB), WSP(unsigned long long, WS_MASK), (attn_body::bf16*)WSP(bf16, WS_CAT)};
        const attn_body::StaticOrder S(F.vcu); attn_body::attn_phase<attn_body::StaticOrder>((char*)lds + RING_OFF, AT, S); } while (0));
    RUNPHASE(6, do { GEMM_PHASE(EpiRes<1>, WSP(bf16, WS_CAT), WSP(bf16, WS_WOUT), D, D, nullptr, 0, WSP(bf16, WS_X1B), nullptr, WSP(bf16, WS_X2B), WSP(float, WS_SS2), nullptr, 1.0f);
                     xcd_barrier(bar); quant_rows_pass(F.vcu * 8 + F.wave, F.G * 8, WSP(bf16, WS_X2B), WSP(unsigned char, WS_X2I8), WSP(float, WS_XS2), MP); } while (0));
    RUNPHASE(7, GEMM_PHASEI(EpiGU, WSP(unsigned char, WS_X2I8), WSP(unsigned char, WS_WGU2I8), WSP(float, WS_XS2), WSP(bf16, WS_X2B), WSP(bf16, WS_WGU2), 2 * DFF, D, WSP(float, WS_SS2), 16, WSP(bf16, WS_H), WSP(float, WS_SS2), 16, RSTAB, 1.0f, WSP(unsigned char, WS_H8), WSP(float, WS_WSN2)));
    RUNPHASE(8, GEMM_PHASE8(EpiRes<2>, WSP(unsigned char, WS_H8), WSP(unsigned char, WS_WD2_8), WSP(bf16, WS_H), WSP(bf16, WS_WD2), D, DFF, nullptr, 0, WSP(bf16, WS_X2B), F.out, nullptr, nullptr, nullptr, 1.0f / (W8SCALE * H8SCALE)));
#undef RUNPHASE
#undef GEMM_PHASE
#undef GEMM_PHASE8
#undef GEMM_PHASEI
#undef RSTAB
#undef IN
#undef SEAM
}

#ifndef MK_N_LAUNCHES
#define MK_N_LAUNCHES 1
#endif
extern "C" void kernel_launch(void* const* d_in, const int* in_sizes, int n_in, void* d_out, int out_size, void* d_ws, size_t ws_size, hipStream_t stream) {
    static int grid = 0;
    if (grid == 0) {
        if (n_in != 22 || out_size != (int)O_END || ws_size < WS_END) { fprintf(stderr, "kernel_launch: unexpected problem: n_in %d out %d ws %zu (need %zu)\n", n_in, out_size, ws_size, (size_t)WS_END); grid = -1; return; }
        int dev = 0, cus = 0, per_cu = 0;
        if (hipGetDevice(&dev) != hipSuccess || hipDeviceGetAttribute(&cus, hipDeviceAttributeMultiprocessorCount, dev) != hipSuccess) { grid = -1; return; }
        if (hipFuncSetAttribute((const void*)hymba_fwd, hipFuncAttributeMaxDynamicSharedMemorySize, LDS_BYTES) != hipSuccess) { fprintf(stderr, "kernel_launch: hipFuncSetAttribute failed\n"); grid = -1; return; }
        if (hipOccupancyMaxActiveBlocksPerMultiprocessor(&per_cu, (const void*)hymba_fwd, 512, LDS_BYTES) != hipSuccess || per_cu < 1) { fprintf(stderr, "kernel_launch: occupancy query says %d blocks per CU\n", per_cu); (void)hipGetLastError(); grid = -1; return; }
        grid = cus;
        if (grid % 8 != 0 || grid < 8) { fprintf(stderr, "kernel_launch: unexpected CU count %d\n", cus); grid = -1; return; }
    }
    if (grid < 0) return;
    (void)hipMemsetAsync((char*)d_ws + WS_CTL, 0, CTL_ZERO_BYTES, stream);
    Args a{};
    for (int i = 0; i < 22; ++i) a.in[i] = d_in[i];
    a.out = (float*)d_out; a.ws = (unsigned char*)d_ws;
    if (MK_N_LAUNCHES == 1) { a.ph_lo = 0; a.ph_hi = N_PHASES; a.use_bar = 1; hipLaunchKernelGGL(hymba_fwd, dim3(grid), dim3(512), LDS_BYTES, stream, a); }
    else for (int p = 0; p < N_PHASES; ++p) { a.ph_lo = p; a.ph_hi = p + 1; a.use_bar = 0; hipLaunchKernelGGL(hymba_fwd, dim3(grid), dim3(512), LDS_BYTES, stream, a); }
}
```

```cpp
#include <hip/hip_runtime.h>
#include <cstdio>
#include <cstdint>
#include <type_traits>
namespace pg8 {
#define PG8_LAS __attribute__((address_space(3)))
typedef unsigned short bf16_t;
typedef short bf16x8 __attribute__((ext_vector_type(8)));
typedef float f32x4 __attribute__((ext_vector_type(4)));
typedef unsigned u32x4 __attribute__((ext_vector_type(4)));
constexpr int BM = 256, BK = 64, HALF = 128, HTB = HALF * BK * 2  , STAGE_BYTES = 8 * HTB, NXCD = 8, WGM = 8;

__host__ __device__ __forceinline__ int lds_byte(int r, int c) { const int st = (r >> 4) * 2 + (c >> 5), rr = r & 15, cc = c & 31, ob = rr * 64 + cc * 2; return st * 1024 + (ob ^ (((ob >> 9) & 1) << 5)); }
__host__ __device__ __forceinline__ void stage_rc(int b, int& R, int& C) { const int st = b / 1024, sb = b % 1024, swz = sb ^ (((sb >> 9) & 1) << 5); R = (st >> 1) * 16 + swz / 64; C = (st & 1) * 32 + (swz % 64) / 2; }
__host__ __device__ __forceinline__ int perm32(int rho) { const int n = rho >> 4, i = rho & 15; return 8 * (i >> 2) + 4 * n + (i & 3); }

struct Unit { int pm, pn; };
struct Gemm { const bf16_t* A; const bf16_t* Bt; int M, N, K; };

struct StaticOrder {
    int nM, nN, nwg, G, c;
    __host__ __device__ void init(int M, int N, int G_, int c_) { nM = M / BM; nN = N / BM; nwg = nM * nN; G = G_; c = c_; }
    __host__ __device__ bool next(int i, Unit& u) const {
        const long L = (long)i * G + c; if (L >= nwg) return false;
        int wgid = (int)L; { const int q = nwg / NXCD, r = nwg % NXCD, xcd = wgid % NXCD, off = wgid / NXCD; wgid = (xcd < r ? xcd * (q + 1) : r * (q + 1) + (xcd - r) * q) + off; }
        const int nig = WGM * nN, gid = wgid / nig, fm = gid * WGM, gsz = (nM - fm) < WGM ? (nM - fm) : WGM;
        u.pm = fm + ((wgid % nig) % gsz); u.pn = (wgid % nig) / gsz; return true;
    }
    __device__ __forceinline__ void a_ready(const Unit&) const {}
    __device__ __forceinline__ void done(const Unit&) const {}
};
__device__ __forceinline__ unsigned cvt_pk_bf16(float lo, float hi) { unsigned r; asm volatile("v_cvt_pk_bf16_f32 %0, %1, %2" : "=v"(r) : "v"(lo), "v"(hi)); return r; }
template <class Epi, class Sched, bool ALIGN_EPI = false, bool SP2 = false, int QM = 0, int PFD = 0>
__device__ __forceinline__ void gemm_phase(PG8_LAS unsigned char* lds, const Gemm g, const Sched& S, const Epi& E) {
    const int tid = threadIdx.x, wid = __builtin_amdgcn_readfirstlane(tid >> 6), lane = tid & 63, wr = wid >> 2, wc = wid & 3, fr = lane & 15, fq = lane >> 4;
    const int K = g.K, nt = K / BK;
    unsigned voffA[2], voffB[2];
#pragma unroll
    for (int i = 0; i < 2; ++i) { int R, C; stage_rc(tid * 16 + i * 8192, R, C); const int Rb = Epi::PERM ? ((R & ~31) + perm32(R & 31)) : R;
        voffA[i] = (unsigned)(R * K + C) * 2u; voffB[i] = (unsigned)(Rb * K + C) * 2u; }
    unsigned voffP[2];
#pragma unroll
    for (int i = 0; i < 2; ++i) voffP[i] = (unsigned)((32 * wid + 16 * i + (lane >> 2)) * K) * 2u + (unsigned)(lane & 3) * 4u;
#define PG8_PF(s2, kt) do { if constexpr (PFD != 0) { const char* p_ = ((kt) < nt) ? cA + (size_t)(kt) * kstep : nA + (size_t)((kt) - nt) * kstep; \
        __builtin_amdgcn_global_load_lds((const unsigned*)(p_ + voffP[s2]), (PG8_LAS unsigned*)(lds + 143360 + wid * 256), 4, 0, 0); } } while (0)
#define PG8_WAIT_V8() do { if constexpr (PFD != 0) PG8_WAIT_V(10); else PG8_WAIT_V(8); } while (0)
    const size_t kstep = (size_t)(BK * 2);
    const size_t hstep = (size_t)HALF * K * 2;
    const size_t tstep = 2 * hstep;
    const unsigned ldsw = (unsigned)wid * 1024u;
    const int aoff = lds_byte(wr * 64 + fr, fq * 8), boff = lds_byte(wc * 32 + fr, fq * 8);
#define PG8_SA(b, h) (((b) * 2 + (h)) * HTB)
#define PG8_SB(b, h) ((4 + (b) * 2 + (h)) * HTB)
#define PG8_STAGE(bufoff, gbase, voff) do { _Pragma("unroll") for (int _i = 0; _i < 2; ++_i) \
        __builtin_amdgcn_global_load_lds((const unsigned*)((const char*)(gbase) + (voff)[_i]), (PG8_LAS unsigned*)(lds + (bufoff) + ldsw + _i * 8192), 16, 0, 0); } while (0)
#define PG8_LDF(dst_, addr_) do { if constexpr (QM == 1) { const pg8_v4i lo_ = *(const PG8_LAS pg8_v4i*)(addr_), hi_ = *(const PG8_LAS pg8_v4i*)((addr_) + 1024); \
            (dst_).v = __builtin_shufflevector(lo_, hi_, 0, 1, 2, 3, 4, 5, 6, 7); } \
        else { (dst_).k[0] = *(const PG8_LAS bf16x8*)(addr_); (dst_).k[1] = *(const PG8_LAS bf16x8*)((addr_) + 1024); } } while (0)
#define PG8_LDA(dst, b, h) do { _Pragma("unroll") for (int m = 0; m < 4; ++m) PG8_LDF(dst[m], lds + PG8_SA(b, h) + aoff + m * 2048); } while (0)
#define PG8_LDB(dst, b, h) do { _Pragma("unroll") for (int n = 0; n < 2; ++n) PG8_LDF(dst[n], lds + PG8_SB(b, h) + boff + n * 2048); } while (0)
#define PG8_MMA(ai, bj, At, Bt) do { __builtin_amdgcn_s_setprio(1); if constexpr (QM != 0) asm volatile("s_nop 4");     \
        _Pragma("unroll") for (int m = 0; m < 4; ++m) _Pragma("unroll") for (int n = 0; n < 2; ++n) { \
            if constexpr (QM == 1) asm volatile("v_mfma_scale_f32_16x16x128_f8f6f4 %0, %1, %2, %0, %3, %3 op_sel_hi:[0,0,0]" : "+v"(acc[ai][bj][m][n]) : "v"(Bt[n].v), "v"(At[m].v), "v"(scl8_));     \
            else if constexpr (QM == 2) { _Pragma("unroll") for (int k = 0; k < 2; ++k) asm volatile("v_mfma_i32_16x16x64_i8 %0, %1, %2, %0" : "+v"(acc[ai][bj][m][n]) : "v"(Bt[n].k[k]), "v"(At[m].k[k])); } \
            else { _Pragma("unroll") for (int k = 0; k < 2; ++k) acc[ai][bj][m][n] = __builtin_amdgcn_mfma_f32_16x16x32_bf16(Bt[n].k[k], At[m].k[k], acc[ai][bj][m][n], 0, 0, 0); } } \
        __builtin_amdgcn_s_setprio(0); } while (0)
#define PG8_WAIT_V(n) asm volatile("s_waitcnt vmcnt(" #n ")" ::: "memory")
#define PG8_WAIT_L(n) asm volatile("s_waitcnt lgkmcnt(" #n ")" ::: "memory")
#define PG8_BAR __builtin_amdgcn_s_barrier()
#define PG8_SCHED __builtin_amdgcn_sched_barrier(0)
    Unit cur, nxt; int ui = 0;
    if (!S.next(0, cur)) return;
    f32x4 acc[2][2][4][2];
    E.init(acc, cur, wr, wc, fr, fq);
    typedef int pg8_v8i __attribute__((ext_vector_type(8))); typedef int pg8_v4i __attribute__((ext_vector_type(4)));
    struct FragB { bf16x8 k[2]; }; struct Frag8 { pg8_v8i v; };
    typedef typename std::conditional<QM == 1, Frag8, FragB>::type Frag;
    Frag At[4], B0[2], B1[2];
    unsigned scl8_ = 0x7F7F7F7Fu; asm volatile("" : "+v"(scl8_));
    const char* cA = (const char*)g.A + (size_t)cur.pm * tstep; const char* cB = (const char*)g.Bt + (size_t)cur.pn * tstep;
    S.a_ready(cur);
    if constexpr (SP2) {
        PG8_STAGE(PG8_SB(0, 0), cB, voffB); PG8_STAGE(PG8_SB(0, 1), cB + hstep, voffB); PG8_STAGE(PG8_SA(0, 0), cA, voffA); PG8_STAGE(PG8_SA(0, 1), cA + hstep, voffA);
        if (wr == 1) PG8_BAR;
        PG8_WAIT_V(2); PG8_BAR;
        PG8_STAGE(PG8_SB(1, 0), cB + kstep, voffB); PG8_STAGE(PG8_SA(1, 0), cA + kstep, voffA); PG8_STAGE(PG8_SB(1, 1), cB + hstep + kstep, voffB);
        PG8_WAIT_V(6); PG8_BAR;
    } else {
        PG8_STAGE(PG8_SB(0, 0), cB, voffB); PG8_STAGE(PG8_SA(0, 0), cA, voffA); PG8_STAGE(PG8_SB(0, 1), cB + hstep, voffB); PG8_STAGE(PG8_SA(0, 1), cA + hstep, voffA);
        if (wr == 1) PG8_BAR;
        PG8_WAIT_V(4); PG8_BAR;
        PG8_STAGE(PG8_SB(1, 0), cB + kstep, voffB); PG8_STAGE(PG8_SA(1, 0), cA + kstep, voffA); PG8_STAGE(PG8_SB(1, 1), cB + hstep + kstep, voffB);
        PG8_WAIT_V(6); PG8_BAR;
    }
    for (;;) {
        const bool has_next = S.next(ui + 1, nxt);
        const char* nA = has_next ? (const char*)g.A + (size_t)nxt.pm * tstep : cA; const char* nB = has_next ? (const char*)g.Bt + (size_t)nxt.pn * tstep : cB;
#pragma unroll 1
        for (int t = 0; t < nt; t += 2) {
            const bool last = (t == nt - 2);
            const char* a1 = cA + (size_t)(t + 1) * kstep;
            const char* a2 = last ? nA : cA + (size_t)(t + 2) * kstep; const char* b2 = last ? nB : cB + (size_t)(t + 2) * kstep;
            const char* a3 = a2 + kstep; const char* b3 = b2 + kstep;
            if (last && has_next) S.a_ready(nxt);
            if constexpr (SP2) {
            PG8_LDB(B0, 0, 0); PG8_LDB(B1, 0, 1); PG8_SCHED; PG8_LDA(At, 0, 0); PG8_STAGE(PG8_SA(1, 1), a1 + hstep, voffA); PG8_PF(0, t + PFD);
            PG8_WAIT_V8(); PG8_WAIT_L(0); PG8_BAR; PG8_MMA(0, 0, At, B0); PG8_MMA(0, 1, At, B1); PG8_BAR; PG8_SCHED;
            PG8_LDA(At, 0, 1); PG8_STAGE(PG8_SB(0, 0), b2, voffB); PG8_STAGE(PG8_SB(0, 1), b2 + hstep, voffB); PG8_STAGE(PG8_SA(0, 0), a2, voffA); PG8_PF(1, t + PFD);
            PG8_WAIT_V8(); PG8_WAIT_L(0); PG8_BAR; PG8_MMA(1, 0, At, B0); PG8_MMA(1, 1, At, B1); PG8_BAR; PG8_SCHED;
            PG8_LDB(B0, 1, 0); PG8_LDB(B1, 1, 1); PG8_SCHED; PG8_LDA(At, 1, 0); PG8_STAGE(PG8_SA(0, 1), a2 + hstep, voffA); PG8_PF(0, t + 1 + PFD);
            PG8_WAIT_V8(); PG8_WAIT_L(0); PG8_BAR; PG8_MMA(0, 0, At, B0); PG8_MMA(0, 1, At, B1); PG8_BAR; PG8_SCHED;
            PG8_LDA(At, 1, 1); PG8_STAGE(PG8_SB(1, 0), b3, voffB); PG8_STAGE(PG8_SB(1, 1), b3 + hstep, voffB); PG8_STAGE(PG8_SA(1, 0), a3, voffA); PG8_PF(1, t + 1 + PFD);
            PG8_WAIT_V8(); PG8_WAIT_L(0); PG8_BAR; PG8_MMA(1, 0, At, B0); PG8_MMA(1, 1, At, B1); PG8_BAR; PG8_SCHED;
            } else {
            PG8_LDB(B0, 0, 0); PG8_SCHED; PG8_LDA(At, 0, 0); PG8_STAGE(PG8_SA(1, 1), a1 + hstep, voffA);
            PG8_WAIT_L(8); PG8_BAR; PG8_WAIT_L(0); PG8_MMA(0, 0, At, B0); PG8_BAR; PG8_SCHED;
            PG8_LDB(B1, 0, 1); PG8_STAGE(PG8_SB(0, 0), b2, voffB);
            PG8_BAR; PG8_WAIT_L(0); PG8_MMA(0, 1, At, B1); PG8_BAR;
            PG8_LDA(At, 0, 1); PG8_STAGE(PG8_SA(0, 0), a2, voffA);
            PG8_BAR; PG8_WAIT_L(0); PG8_MMA(1, 0, At, B0); PG8_BAR; PG8_SCHED;
            PG8_STAGE(PG8_SB(0, 1), b2 + hstep, voffB);
            PG8_WAIT_V(6); PG8_BAR; PG8_MMA(1, 1, At, B1); PG8_BAR;
            PG8_LDB(B0, 1, 0); PG8_SCHED; PG8_LDA(At, 1, 0); PG8_STAGE(PG8_SA(0, 1), a2 + hstep, voffA);
            PG8_WAIT_L(8); PG8_BAR; PG8_WAIT_L(0); PG8_MMA(0, 0, At, B0); PG8_BAR; PG8_SCHED;
            PG8_LDB(B1, 1, 1); PG8_STAGE(PG8_SB(1, 0), b3, voffB);
            PG8_BAR; PG8_WAIT_L(0); PG8_MMA(0, 1, At, B1); PG8_BAR;
            PG8_LDA(At, 1, 1); PG8_STAGE(PG8_SA(1, 0), a3, voffA);
            PG8_BAR; PG8_WAIT_L(0); PG8_MMA(1, 0, At, B0); PG8_BAR; PG8_SCHED;
            PG8_STAGE(PG8_SB(1, 1), b3 + hstep, voffB);
            PG8_WAIT_V(6); PG8_BAR; PG8_MMA(1, 1, At, B1); PG8_BAR;
            }
        }
        if constexpr (ALIGN_EPI) { if (wr == 0) PG8_BAR; }
        if constexpr (QM != 0) asm volatile("s_nop 15\n\ts_nop 7" ::: "memory");
        if constexpr (!Epi::AFTER_DRAIN) { E(acc, cur, wr, wc, fr, fq, ui, has_next, nxt);
#if defined(PROBE_DUP) && PROBE_DUP == 61
            E(acc, cur, wr, wc, fr, fq, ui, has_next, nxt);
#endif
            S.done(cur); }
        if (!has_next) break;
        cur = nxt; cA = nA; cB = nB; ++ui;
        if constexpr (ALIGN_EPI) { if (wr == 1) PG8_BAR; }
    }
    PG8_WAIT_V(0);
    if constexpr (!ALIGN_EPI) { if (wr == 0) PG8_BAR; }
    PG8_BAR;
    if constexpr (Epi::AFTER_DRAIN) { E.fused(acc, cur, wr, wc, fr, fq, lds, wid, lane); S.done(cur); }
#undef PG8_SA
#undef PG8_PF
#undef PG8_WAIT_V8
#undef PG8_SB
#undef PG8_STAGE
#undef PG8_LDA
#undef PG8_LDF
#undef PG8_LDB
#undef PG8_MMA
#undef PG8_WAIT_V
#undef PG8_WAIT_L
#undef PG8_BAR
#undef PG8_SCHED
}
}
#include <hip/hip_bf16.h>
#include <cmath>
namespace attn_body {
using bf16=__hip_bfloat16;
using bf16x8=__attribute__((ext_vector_type(8)))short;
using s16x4=__attribute__((ext_vector_type(4)))short;
using f32x16=__attribute__((ext_vector_type(16)))float;
using u32x4=__attribute__((ext_vector_type(4)))unsigned;
constexpr int BATCH=16,NHEAD=8,SEQ=2048,D=64;
constexpr int QP=512,KP=128,OP=1024,OOFF=512;
constexpr int NW=8,QBLK=32,QB=QBLK*NW,KVBLK=64,NQB=SEQ/QB;
constexpr int ATTN_UNIT_ROWS=QB;
__device__ __forceinline__ int crow(int r,int hi){return (r&3)+8*(r>>2)+4*hi;}
#define SBAR() __builtin_amdgcn_sched_barrier(0)
#define MSKV(v,W,r) __uint_as_float(__float_as_uint(v)&(unsigned)(((int)((W)<<(31-(((r)&3)+8*((r)>>2)))))>>31))
__device__ __forceinline__ void cmask(f32x16&p0,f32x16&p1,int jb,int qrel,int hi){
  const float NEG=-INFINITY; int kb=64*jb+4*hi;
  #pragma unroll
  for(int r=0;r<16;++r){int kv=kb+(r&3)+8*(r>>2); if(kv>qrel)p0[r]=NEG; if(kv+32>qrel)p1[r]=NEG;}
}

constexpr int NSLOT=3, SLOTB=8192;
constexpr int LDS_K=0, LDS_V=NSLOT*SLOTB, LDS_WS=2*NSLOT*SLOTB, LDS_OST=LDS_WS+NW*64*4, LDS_MSK=LDS_OST+NW*4096, LDS_BYTES=LDS_MSK+NW*8192;
constexpr float C2=0.125f*1.4426950408889634f;
__device__ __forceinline__ void glds16(const void*gsrc,unsigned lds_dst){unsigned keep;
  asm volatile("s_mov_b32 %0, m0\n\ts_mov_b32 m0, %2\n\ts_nop 0\n\tglobal_load_lds_dwordx4 %1, off\n\ts_mov_b32 m0, %0":"=&s"(keep):"v"(gsrc),"s"(lds_dst):"memory");}
__device__ __forceinline__ float max3f(float a,float b,float c){float r;asm("v_max3_f32 %0, %1, %2, %3":"=v"(r):"v"(a),"v"(b),"v"(c));return r;}
__device__ __forceinline__ float max2f(float a,float b){float r;asm("v_max_f32_e32 %0, %1, %2":"=v"(r):"v"(a),"v"(b));return r;}
__device__ __forceinline__ float fadd_s(float a,float b){float r;asm("v_add_f32_e32 %0, %1, %2":"=v"(r):"v"(a),"v"(b));return r;}
__device__ __forceinline__ float fsub_s(float a,float b){float r;asm("v_sub_f32_e32 %0, %1, %2":"=v"(r):"v"(a),"v"(b));return r;}
typedef float f32x2_t __attribute__((ext_vector_type(2))); typedef __bf16 bf16x2_t __attribute__((ext_vector_type(2)));
__device__ __forceinline__ unsigned cvtpk_s(float lo,float hi){f32x2_t v={lo,hi};bf16x2_t b=__builtin_convertvector(v,bf16x2_t);return __builtin_bit_cast(unsigned,b);}
#define WAIT_BAR(N) asm volatile("s_waitcnt vmcnt(" #N ") lgkmcnt(0)\n\ts_barrier":::"memory")

__device__ __forceinline__ void qkt(f32x16&p0,f32x16&p1,const char*Kslot,const bf16x8*qr,const f32x16&negm,int r32,int hi){
  const char*kb=Kslot+hi*1024+r32*16;
  #pragma unroll
  for(int d0=0;d0<4;++d0){
    const bf16x8 b0=*reinterpret_cast<const bf16x8*>(kb+d0*2048);
    const bf16x8 b1=*reinterpret_cast<const bf16x8*>(kb+d0*2048+512);
    if(d0==0){p0=__builtin_amdgcn_mfma_f32_32x32x16_bf16(b0,qr[0],negm,0,0,0);p1=__builtin_amdgcn_mfma_f32_32x32x16_bf16(b1,qr[0],negm,0,0,0);}
    else{p0=__builtin_amdgcn_mfma_f32_32x32x16_bf16(b0,qr[d0],p0,0,0,0);p1=__builtin_amdgcn_mfma_f32_32x32x16_bf16(b1,qr[d0],p1,0,0,0);}}
}
typedef __attribute__((address_space(3))) const char* lds_cptr;
typedef short v4i16_t __attribute__((ext_vector_type(4)));
__device__ __forceinline__ void kload8(bf16x8*kf,lds_cptr kp){
  kf[0]=*(const __attribute__((address_space(3))) bf16x8*)(kp);      kf[1]=*(const __attribute__((address_space(3))) bf16x8*)(kp+512);
  kf[2]=*(const __attribute__((address_space(3))) bf16x8*)(kp+2048); kf[3]=*(const __attribute__((address_space(3))) bf16x8*)(kp+2560);
  kf[4]=*(const __attribute__((address_space(3))) bf16x8*)(kp+4096); kf[5]=*(const __attribute__((address_space(3))) bf16x8*)(kp+4608);
  kf[6]=*(const __attribute__((address_space(3))) bf16x8*)(kp+6144); kf[7]=*(const __attribute__((address_space(3))) bf16x8*)(kp+6656);
}
__device__ __forceinline__ void kload2(bf16x8*kf,lds_cptr kp,int j){ kf[2*j]=*(const __attribute__((address_space(3))) bf16x8*)(kp+j*2048); kf[2*j+1]=*(const __attribute__((address_space(3))) bf16x8*)(kp+j*2048+512); }
__device__ __forceinline__ s16x4 vtr(lds_cptr p){ return __builtin_bit_cast(s16x4,__builtin_amdgcn_ds_read_tr16_b64_v4i16((__attribute__((address_space(3))) v4i16_t*)p)); }
__device__ __forceinline__ float rowmax(const f32x16&p0,const f32x16&p1){
  float a=max3f(p0[0],p0[1],p1[0]),b=max3f(p0[2],p0[3],p1[1]);a=max3f(a,p1[2],p1[3]);
  #pragma unroll
  for(int r=4;r<16;r+=4){a=max3f(a,p0[r],p0[r+1]);b=max3f(b,p0[r+2],p0[r+3]);a=max3f(a,p1[r],p1[r+1]);b=max3f(b,p1[r+2],p1[r+3]);}
  const float m=max2f(a,b);
  auto rr=__builtin_amdgcn_permlane32_swap(__float_as_uint(m),__float_as_uint(m),false,false);
  return max2f(__uint_as_float(rr[0]),__uint_as_float(rr[1]));
}
__device__ __forceinline__ void pv(f32x16*o,int vb,bf16x8 pa0,bf16x8 pa1,bf16x8 pa2,bf16x8 pa3){
  #pragma unroll
  for(int d0=0;d0<2;++d0){s16x4 lo[4],hi[4];
    #pragma unroll
    for(int ks=0;ks<4;++ks){
      asm volatile("ds_read_b64_tr_b16 %0,%1 offset:%c2":"=&v"(lo[ks]):"v"(vb),"i"(d0*4096+ks*1024):"memory");
      asm volatile("ds_read_b64_tr_b16 %0,%1 offset:%c2":"=&v"(hi[ks]):"v"(vb),"i"(d0*4096+ks*1024+512):"memory");}
    asm volatile("s_waitcnt lgkmcnt(0)":::"memory");SBAR();
    #define PK(k) (bf16x8){lo[k][0],lo[k][1],lo[k][2],lo[k][3],hi[k][0],hi[k][1],hi[k][2],hi[k][3]}
    o[d0]=__builtin_amdgcn_mfma_f32_32x32x16_bf16(pa0,PK(0),o[d0],0,0,0);
    o[d0]=__builtin_amdgcn_mfma_f32_32x32x16_bf16(pa1,PK(1),o[d0],0,0,0);
    o[d0]=__builtin_amdgcn_mfma_f32_32x32x16_bf16(pa2,PK(2),o[d0],0,0,0);
    o[d0]=__builtin_amdgcn_mfma_f32_32x32x16_bf16(pa3,PK(3),o[d0],0,0,0);
    #undef PK
  }
}

#ifndef ATTN_STORE16
#define ATTN_STORE16(p,v) (*(u32x4*)(p)=(v))
#endif
template<int THRL> __device__ __forceinline__ void attn_unit(int b,int h,int qb,const bf16*Q,const bf16*K,const bf16*V,const unsigned long long*MK,bf16*O,char*shm){
  const int tid=threadIdx.x,lane=tid&63,r32=lane&31,hi=lane>>5; const int wid=__builtin_amdgcn_readfirstlane(tid>>6);
  const long rowbase=(long)b*SEQ; const int q0=qb*QB;
  const bf16*Qw=Q+(rowbase+q0+wid*QBLK)*QP+h*D;
  const bf16*Kh=K+rowbase*KP+(h>>2)*D,*Vh=V+rowbase*KP+(h>>2)*D;
  const unsigned lds0=(unsigned)(uintptr_t)shm;
  float*wsf=(float*)(shm+LDS_WS)+wid*64;
  const bf16*ksrc=Kh+(long)lane*KP+wid*8;
  const bf16*vsrc=Vh+(long)(16*(wid&3)+(lane>>2))*KP+(wid>>2)*32+(lane&3)*8;
  const unsigned kdst=lds0+LDS_K+wid*1024, vdst=lds0+LDS_V+wid*1024;
  #define DMA_K(t,slot) glds16(ksrc+(long)(t)*KVBLK*KP,(unsigned)__builtin_amdgcn_readfirstlane(kdst+(slot)))
  #define DMA_V(t,slot) glds16(vsrc+(long)(t)*KVBLK*KP,(unsigned)__builtin_amdgcn_readfirstlane(vdst+(slot)))
  const int vb0=(int)(lds0+LDS_V)+((lane>>4)&1)*32+(lane&3)*8+(4*hi+((lane&15)>>2))*64;
  const char*Kbase=shm+LDS_K; bf16x8 kf[8];
  const lds_cptr shm3=(lds_cptr)shm; const lds_cptr kp0=shm3+LDS_K+hi*1024+r32*16; const lds_cptr vp0=shm3+LDS_V+((lane>>4)&1)*32+(lane&3)*8+(4*hi+((lane&15)>>2))*64;
  const int NT=(q0+QB)/KVBLK;
  const __attribute__((address_space(3))) char* shm3m=(const __attribute__((address_space(3))) char*)shm;
  typedef __attribute__((address_space(3))) unsigned long long* lds_u64p;
  const lds_u64p mskw=(lds_u64p)(shm3m+LDS_MSK+wid*8192);
  unsigned long long mtmp[16];
  { const unsigned long long*mq=MK+(q0+wid*QBLK+r32);
    #pragma unroll
    for(int i=0;i<16;++i){int tt=2*i+hi; tt=tt<NT?tt:NT-1; mtmp[i]=mq[(long)tt*SEQ];} }
  DMA_K(0,0);DMA_V(0,0);DMA_K(1,SLOTB);
  bf16x8 qr[4];
  #pragma unroll
  for(int d0=0;d0<4;++d0)qr[d0]=*reinterpret_cast<const bf16x8*>(&Qw[(long)r32*QP+d0*16+hi*8]);
  float mhat=0.f,l_reg=0.f;f32x16 o[2];o[0]=f32x16{};o[1]=f32x16{};f32x16 negm=f32x16{};asm volatile("":"+v"(negm));
  const int qrel=wid*QBLK+r32;
  #define CMASK(P0,P1,t) do{int jb_=(t)-(NT-4); if(jb_>=0)cmask(P0,P1,jb_,qrel,hi);}while(0)
  bool resc=false;
  #define START(P0,P1) do{ const float rm=rowmax(P0,P1); resc=false; \
    { const float dl=rm; mhat=fadd_s(mhat,dl); \
      _Pragma("unroll") for(int r=0;r<16;++r){P0[r]=fsub_s(P0[r],dl);P1[r]=fsub_s(P1[r],dl);} \
      _Pragma("unroll") for(int r=0;r<16;++r)negm[r]=-mhat; asm volatile("":"+v"(negm)); } \
    _Pragma("unroll") for(int r=0;r<16;++r)P0[r]=__builtin_amdgcn_exp2f(P0[r]); }while(0)
  #define RESC() do{ if(resc){ asm volatile("s_waitcnt lgkmcnt(0)":::"memory"); \
      _Pragma("unroll") for(int d_=0;d_<2;++d_) _Pragma("unroll") for(int r=0;r<16;++r)o[d_][r]*=wsf[crow(r,hi)]; } }while(0)
  f32x16 pA0,pA1,pB0,pB1;
  int sl_prev=0,sl_cur=0,sl_next=SLOTB;
  #define ROT() do{sl_prev=sl_cur;sl_cur=sl_next;sl_next=(sl_next==(NSLOT-1)*SLOTB)?0:sl_next+SLOTB;}while(0)
  DMA_K(2,2*SLOTB);
  WAIT_BAR(3);
  #pragma unroll
  for(int i=0;i<16;++i)mskw[(2*i+hi)*32+r32]=mtmp[i];
  #define MLOAD(t,LO,HI) do{ const unsigned long long mw_=mskw[(t)*32+r32]; LO=((unsigned)mw_)>>(4*hi); HI=((unsigned)(mw_>>32))>>(4*hi); }while(0)
  unsigned mlo,mhi; MLOAD(0,mlo,mhi);
  qkt(pA0,pA1,Kbase,qr,negm,r32,hi);asm volatile("s_nop 15\n\ts_nop 7":"+v"(pA0),"+v"(pA1));
  START(pA0,pA1);
  _Pragma("unroll") for(int r=0;r<16;++r)pA1[r]=__builtin_amdgcn_exp2f(pA1[r]);
  _Pragma("unroll") for(int r=0;r<16;++r){pA0[r]=MSKV(pA0[r],mlo,r);pA1[r]=MSKV(pA1[r],mhi,r);}
  WAIT_BAR(0);
  DMA_K(3,0);DMA_V(1,SLOTB);
  ROT();
  kload8(kf,kp0+sl_cur);
  WAIT_BAR(2);
  s16x4 vlo[8],vhi[8]; u32x4 pw0,pw1,pw2,pw3;
  #define PKW(P,B) cvtpk_s(P[B],P[B+1])
  #define PAF(k) __builtin_bit_cast(bf16x8,pw##k)
  #define VFR(i) (bf16x8){vlo[i][0],vlo[i][1],vlo[i][2],vlo[i][3],vhi[i][0],vhi[i][1],vhi[i][2],vhi[i][3]}
  #define PIN(x) asm volatile("":"+v"(x))
  #define MX3(a,b,c) __builtin_fmaxf(__builtin_fmaxf((a),(b)),(c))
  #define GAPA(MF,A0,A1,A2,A3,W0,W1,PW) do{ MF; sacc+=A0; sacc+=A1; sacc+=A2; sacc+=A3; PIN(sacc); W0; W1; PIN(PW); SBAR(); }while(0)
  #define EX(v) __builtin_amdgcn_exp2f(v)
  #define GAPB(MF,X,B,W) do{ MF; X[B]=MSKV(EX(X[B]),W,B); X[B+1]=MSKV(EX(X[B+1]),W,B+1); X[B+2]=MSKV(EX(X[B+2]),W,B+2); X[B+3]=MSKV(EX(X[B+3]),W,B+3); PIN(X); SBAR(); }while(0)
  #define VRD(i) do{ vlo[i]=vtr(vp_+(((i)>>2)*4096+((i)&3)*1024)); vhi[i]=vtr(vp_+(((i)>>2)*4096+((i)&3)*1024+512)); }while(0)
  #define KRD(G,j) do{ if(G){ kload2(kf,kp0+sl_next,j); SBAR(); } }while(0)
  #define STEP(C0,C1,P0,P1,t,GK,GV,GL) do{ SBAR(); \
    const lds_cptr vp_=vp0+sl_prev; MLOAD(t,mlo,mhi); \
    VRD(0); SBAR(); float sacc=(P0[0]+P0[1]); \
    GAPA(C0=__builtin_amdgcn_mfma_f32_32x32x16_bf16(kf[0],qr[0],negm,0,0,0), P0[2],P0[3],P0[4],P0[5],     pw0[0]=PKW(P0,0), pw0[1]=PKW(P0,2), pw0); \
    VRD(4); SBAR(); GAPA(C1=__builtin_amdgcn_mfma_f32_32x32x16_bf16(kf[1],qr[0],negm,0,0,0), P0[6],P0[7],P0[8],P0[9],     pw0[2]=PKW(P0,4), pw0[3]=PKW(P0,6), pw0); \
    VRD(1); SBAR(); GAPA(C0=__builtin_amdgcn_mfma_f32_32x32x16_bf16(kf[2],qr[1],C0,0,0,0),   P0[10],P0[11],P0[12],P0[13], pw1[0]=PKW(P0,8), pw1[1]=PKW(P0,10), pw1); \
    VRD(5); SBAR(); GAPA(C1=__builtin_amdgcn_mfma_f32_32x32x16_bf16(kf[3],qr[1],C1,0,0,0),   P0[14],P0[15],P1[0],P1[1],   pw1[2]=PKW(P0,12),pw1[3]=PKW(P0,14), pw1); \
    VRD(2); SBAR(); GAPA(C0=__builtin_amdgcn_mfma_f32_32x32x16_bf16(kf[4],qr[2],C0,0,0,0),   P1[2],P1[3],P1[4],P1[5],     pw2[0]=PKW(P1,0), pw2[1]=PKW(P1,2), pw2); \
    VRD(6); SBAR(); GAPA(C1=__builtin_amdgcn_mfma_f32_32x32x16_bf16(kf[5],qr[2],C1,0,0,0),   P1[6],P1[7],P1[8],P1[9],     pw2[2]=PKW(P1,4), pw2[3]=PKW(P1,6), pw2); \
    VRD(3); SBAR(); GAPA(C0=__builtin_amdgcn_mfma_f32_32x32x16_bf16(kf[6],qr[3],C0,0,0,0),   P1[10],P1[11],P1[12],P1[13], pw3[0]=PKW(P1,8), pw3[1]=PKW(P1,10), pw3); \
    VRD(7); SBAR(); GAPA(C1=__builtin_amdgcn_mfma_f32_32x32x16_bf16(kf[7],qr[3],C1,0,0,0),   P1[14],P1[15],0.f,0.f,       pw3[2]=PKW(P1,12),pw3[3]=PKW(P1,14), pw3); \
    l_reg+=sacc; \
    if(GK){DMA_K((t)+3,sl_cur);} if(GV){DMA_V((t)+1,sl_next);} \
    { float a=MX3(C0[0],C0[1],C1[0]),b=MX3(C0[2],C0[3],C1[1]); a=MX3(a,C1[2],C1[3]); \
      _Pragma("unroll") for(int r=4;r<16;r+=4){a=MX3(a,C0[r],C0[r+1]);b=MX3(b,C0[r+2],C0[r+3]);a=MX3(a,C1[r],C1[r+1]);b=MX3(b,C1[r+2],C1[r+3]);} \
      float rm=__builtin_fmaxf(a,b); { auto rr=__builtin_amdgcn_permlane32_swap(__float_as_uint(rm),__float_as_uint(rm),false,false); rm=__builtin_fmaxf(__uint_as_float(rr[0]),__uint_as_float(rr[1])); } \
      resc=false; \
      if(__builtin_expect(__any(rm>(float)THRL),0)){ const float dl=__builtin_fmaxf(rm,0.f); mhat+=dl; \
        _Pragma("unroll") for(int r=0;r<16;++r){C0[r]-=dl;C1[r]-=dl;} \
        _Pragma("unroll") for(int r=0;r<16;++r)negm[r]=-mhat; asm volatile("":"+v"(negm)); \
        const float f=__builtin_amdgcn_exp2f(-dl); l_reg*=f; if(hi==0)wsf[r32]=f; resc=true; } } \
    SBAR(); \
    GAPB(o[0]=__builtin_amdgcn_mfma_f32_32x32x16_bf16(PAF(0),VFR(0),o[0],0,0,0), C0,0,mlo); \
    GAPB(o[1]=__builtin_amdgcn_mfma_f32_32x32x16_bf16(PAF(0),VFR(4),o[1],0,0,0), C0,4,mlo); \
    KRD(GL,0); GAPB(o[0]=__builtin_amdgcn_mfma_f32_32x32x16_bf16(PAF(1),VFR(1),o[0],0,0,0), C0,8,mlo); \
    KRD(GL,1); GAPB(o[1]=__builtin_amdgcn_mfma_f32_32x32x16_bf16(PAF(1),VFR(5),o[1],0,0,0), C0,12,mlo); \
    KRD(GL,2); GAPB(o[0]=__builtin_amdgcn_mfma_f32_32x32x16_bf16(PAF(2),VFR(2),o[0],0,0,0), C1,0,mhi); \
    KRD(GL,3); GAPB(o[1]=__builtin_amdgcn_mfma_f32_32x32x16_bf16(PAF(2),VFR(6),o[1],0,0,0), C1,4,mhi); \
    GAPB(o[0]=__builtin_amdgcn_mfma_f32_32x32x16_bf16(PAF(3),VFR(3),o[0],0,0,0), C1,8,mhi); \
    GAPB(o[1]=__builtin_amdgcn_mfma_f32_32x32x16_bf16(PAF(3),VFR(7),o[1],0,0,0), C1,12,mhi); \
    }while(0)
  int t=1;
  #undef CMASK
  #define CMASK(P0,P1,t) do{}while(0)
  for(;t+5<NT;t+=2){
    STEP(pB0,pB1,pA0,pA1,t,true,true,true);     WAIT_BAR(2); RESC(); ROT();
    STEP(pA0,pA1,pB0,pB1,t+1,true,true,true);   WAIT_BAR(2); RESC(); ROT();
  }
  #undef CMASK
  #define CMASK(P0,P1,t) do{int jb_=(t)-(NT-4); if(jb_>=0)cmask(P0,P1,jb_,qrel,hi);}while(0)
  #define ENDW(tt) do{ if((tt)+3<NT){WAIT_BAR(2);} else if((tt)+2<NT){WAIT_BAR(1);} else {WAIT_BAR(0);} }while(0)
  for(;t+1<NT;t+=2){
    STEP(pB0,pB1,pA0,pA1,t,(t+3<NT),(t+1<NT),(t+1<NT));       ENDW(t);   RESC(); ROT();
    STEP(pA0,pA1,pB0,pB1,t+1,(t+4<NT),(t+2<NT),(t+2<NT));     ENDW(t+1); RESC(); ROT();
  }
  STEP(pB0,pB1,pA0,pA1,NT-1,false,false,false); RESC();
  { float sacc=pB0[0]+pB0[1]; _Pragma("unroll") for(int r=2;r<16;++r)sacc+=pB0[r]; _Pragma("unroll") for(int r=0;r<16;++r)sacc+=pB1[r]; l_reg+=sacc;
    pw0=(u32x4){PKW(pB0,0),PKW(pB0,2),PKW(pB0,4),PKW(pB0,6)};pw1=(u32x4){PKW(pB0,8),PKW(pB0,10),PKW(pB0,12),PKW(pB0,14)};pw2=(u32x4){PKW(pB1,0),PKW(pB1,2),PKW(pB1,4),PKW(pB1,6)};pw3=(u32x4){PKW(pB1,8),PKW(pB1,10),PKW(pB1,12),PKW(pB1,14)};
    SBAR(); pv(o,vb0+sl_cur,PAF(0),PAF(1),PAF(2),PAF(3)); }
  #undef PKW
  #undef PAF
  #undef VFR
  #undef PIN
  #undef MX3
  #undef GAPA
  #undef GAPB
  #undef EX
  #undef VRD
  #undef KRD
  #undef STEP
  #undef ENDW
  {auto rr=__builtin_amdgcn_permlane32_swap(__float_as_uint(l_reg),__float_as_uint(l_reg),false,false);l_reg=__uint_as_float(rr[0])+__uint_as_float(rr[1]);}
  if(hi==0)wsf[32+r32]=l_reg;asm volatile("s_waitcnt lgkmcnt(0)":::"memory");
  float rli[16];
  #pragma unroll
  for(int r=0;r<16;++r)rli[r]=__builtin_amdgcn_rcpf(wsf[32+crow(r,hi)]);
  bf16*Ow=O+(rowbase+q0+wid*QBLK)*OP+OOFF+h*D;
  { bf16*stg=(bf16*)(shm+LDS_OST)+wid*2048;
    #pragma unroll
    for(int r=0;r<16;++r){const int orow=crow(r,hi);
      #pragma unroll
      for(int d0=0;d0<2;++d0)stg[orow*64+d0*32+r32]=__float2bfloat16(o[d0][r]*rli[r]);}
    asm volatile("s_waitcnt lgkmcnt(0)":::"memory");
    #pragma unroll
    for(int i=0;i<4;++i){const int row=i*8+(lane>>3),ch=lane&7; const u32x4 v=*(const u32x4*)(stg+row*64+ch*8); ATTN_STORE16(Ow+(long)row*OP+ch*8,v);} }
  asm volatile("s_waitcnt lgkmcnt(0)\n\ts_barrier":::"memory");
  #undef DMA_K
  #undef DMA_V
  #undef CMASK
  #undef START
  #undef RESC
  #undef ROT
}
constexpr int ATTN_LDS_BYTES=LDS_BYTES;
struct AttnTensors { const bf16* Q; const bf16* K; const bf16* V; const unsigned long long* MK; bf16* O; };
struct AttnUnit { int bh; int qb; };
struct StaticOrder {
  int vcu;
  __device__ __forceinline__ explicit StaticOrder(int vcu_):vcu(vcu_){}
  __device__ __forceinline__ bool next(int i,AttnUnit&u)const{ if(vcu>=256)return false; const int s=vcu&1; u.bh=vcu>>1; if(s){ if(i>=5)return false; u.qb=5-i; } else { if(i>=3)return false; u.qb=(i==0)?7:(i==1)?6:0; } return true; }
};
template<class Sched,int THRL=8> __device__ __forceinline__ void attn_phase(char*lds,const AttnTensors&T,const Sched&S){
  AttnUnit u;
  for(int i=0;S.next(i,u);++i){ const int b=u.bh/NHEAD; attn_unit<THRL>(b,u.bh%NHEAD,u.qb,T.Q,T.K,T.V,T.MK+(long)b*32*SEQ,T.O,lds); }
}
#undef SBAR
#undef WAIT_BAR
}
#ifndef PROBE_DUP
#define PROBE_DUP (-1)
#endif
constexpr int D = 1024, NB = 16, SEQ = 2048, MP = NB * SEQ, DB = 32, DS = 4, MS = DB * DS, MTOT = MP + MS, MPAD = 33024;
constexpr int DFF = 2816, NIN = 2888, NINP = 3072, DCONV = 512;
constexpr int PAST = 16384, PAGE = 128, NPAGES = 128, KTOP = 256;
constexpr float EPS = 1e-6f, LOG2E = 1.4426950408889634f;
constexpr float QSCALE = 0.125f * LOG2E;
constexpr size_t O_YP = 0, O_YS = O_YP + (size_t)MP * D, O_KP = O_YS + (size_t)MS * D, O_VP = O_KP + (size_t)MP * 128, O_IP = O_VP + (size_t)MP * 128,
                 O_CP = O_IP + (size_t)MP * 64, O_KS = O_CP + 16 * 2 * 512, O_VS = O_KS + MS * 128, O_IS = O_VS + MS * 128, O_CS = O_IS + MS * 64, O_END = O_CS + 32 * 2 * 512;
static_assert(O_END == 44261376, "output size");

constexpr size_t al(size_t x) { return (x + 0xFFFFF) & ~(size_t)0xFFFFF; }
constexpr size_t WS_CTL = 0, CTL_ZERO_BYTES = 1u << 20;
constexpr size_t WS_ROPE = al(WS_CTL + CTL_ZERO_BYTES);
constexpr size_t WS_WGU1 = al(WS_ROPE + 2052 * 8 * 2 * 4);
constexpr size_t WS_WD1 = al(WS_WGU1 + (size_t)2 * DFF * D * 2);
constexpr size_t WS_WIN = al(WS_WD1 + (size_t)D * DFF * 2);
constexpr size_t WS_WOUT = al(WS_WIN + (size_t)NINP * D * 2);
constexpr size_t WS_WGU2 = al(WS_WOUT + (size_t)D * D * 2);
constexpr size_t WS_WD2 = al(WS_WGU2 + (size_t)2 * DFF * D * 2);
constexpr size_t WS_XB = al(WS_WD2 + (size_t)D * DFF * 2);
constexpr size_t WS_SS0 = al(WS_XB + (size_t)MPAD * D * 2);
constexpr size_t WS_SS1 = al(WS_SS0 + (size_t)MPAD * 4);
constexpr size_t WS_SS2 = al(WS_SS1 + (size_t)MPAD * 64);
constexpr size_t WS_H = al(WS_SS2 + (size_t)MPAD * 64);
constexpr size_t WS_X1 = al(WS_H + (size_t)MPAD * DFF * 2);
constexpr size_t WS_X1B = al(WS_X1 + (size_t)MPAD * D * 4);
constexpr size_t WS_X2 = al(WS_X1B + (size_t)MPAD * D * 2);
constexpr size_t WS_X2B = al(WS_X2 + (size_t)MPAD * D * 4);
constexpr size_t WS_U = al(WS_X2B + (size_t)MPAD * D * 2);
constexpr size_t WS_GB = al(WS_U + (size_t)MPAD * 512 * 2);
constexpr size_t WS_Q = al(WS_GB + (size_t)MPAD * 512 * 2);
constexpr size_t WS_QI = al(WS_Q + (size_t)MPAD * 512 * 2);
constexpr size_t WS_KB = al(WS_QI + (size_t)MPAD * 512 * 2);
constexpr size_t WS_VB = al(WS_KB + (size_t)MPAD * 128 * 2);
constexpr size_t WS_KIB = al(WS_VB + (size_t)MPAD * 128 * 2);
constexpr size_t WS_WI = al(WS_KIB + (size_t)MPAD * 64 * 2);
constexpr size_t WS_CAT = al(WS_WI + (size_t)MPAD * 8 * 4);
constexpr size_t WS_MASK = al(WS_CAT + (size_t)MPAD * D * 2);
constexpr int SSTR = 16384;
constexpr size_t WS_SSC = al(WS_MASK + (size_t)NB * 32 * SEQ * 8);
constexpr size_t WS_XB8 = al(WS_SSC + (size_t)MS * SSTR * 4);
constexpr size_t WS_X2B8 = al(WS_XB8 + (size_t)MPAD * D);
constexpr size_t WS_WGU1_8 = al(WS_X2B8 + (size_t)MPAD * D);
constexpr size_t WS_WGU2_8 = al(WS_WGU1_8 + (size_t)2 * DFF * D);
constexpr size_t WS_WD2_8 = al(WS_WGU2_8 + (size_t)2 * DFF * D);
constexpr size_t WS_H8 = al(WS_WD2_8 + (size_t)D * DFF);
constexpr size_t WS_XI8 = al(WS_H8 + (size_t)MP * DFF);
constexpr size_t WS_XS = al(WS_XI8 + (size_t)MPAD * D);
constexpr size_t WS_WGU1I8 = al(WS_XS + (size_t)MPAD * 4);
constexpr size_t WS_WSN = al(WS_WGU1I8 + (size_t)2 * DFF * D);
constexpr size_t WS_X2I8 = al(WS_WSN + (size_t)2 * DFF * 4);
constexpr size_t WS_XS2 = al(WS_X2I8 + (size_t)MPAD * D);
constexpr size_t WS_WGU2I8 = al(WS_XS2 + (size_t)MPAD * 4);
constexpr size_t WS_WSN2 = al(WS_WGU2I8 + (size_t)2 * DFF * D);
constexpr size_t WS_WD1_8 = al(WS_WSN2 + (size_t)2 * DFF * 4);
constexpr size_t WS_END = al(WS_WD1_8 + (size_t)D * DFF);
constexpr float H8SCALE = 4.0f;
constexpr float W8SCALE = 32.0f;

constexpr int CW_TMO = 0, CW_CODE = 1, CW_BAR = 4096;

constexpr int RING_OFF = 0, RING_BYTES = 152576;
constexpr int LDSCTL_OFF = RING_BYTES, MISC_OFF = LDSCTL_OFF + 320;
constexpr int LDS_BYTES = 158720;
static_assert(MISC_OFF + 128 <= LDS_BYTES && attn_body::ATTN_LDS_BYTES <= RING_BYTES && pg8::STAGE_BYTES <= RING_BYTES, "LDS map");

#define GAS __attribute__((address_space(1)))
#define LAS __attribute__((address_space(3)))
typedef unsigned short bf16;
typedef unsigned v4u __attribute__((ext_vector_type(4)));
typedef unsigned v2u __attribute__((ext_vector_type(2)));
typedef float f32x4 __attribute__((ext_vector_type(4)));
typedef float f32x16 __attribute__((ext_vector_type(16)));
typedef short bf16x8 __attribute__((ext_vector_type(8)));
typedef GAS unsigned gu32;
#define RLX_AGENT __ATOMIC_RELAXED, __HIP_MEMORY_SCOPE_AGENT
#define LDS_WAIT() asm volatile("s_waitcnt lgkmcnt(0)" ::: "memory")
#define VM_WAIT() asm volatile("s_waitcnt vmcnt(0)" ::: "memory")
__device__ __forceinline__ unsigned f2bf(float f) { unsigned u = __builtin_bit_cast(unsigned, f); return (u + 0x7fffu + ((u >> 16) & 1u)) >> 16; }
__device__ __forceinline__ unsigned pk2(float lo, float hi) { return f2bf(lo) | (f2bf(hi) << 16); }
__device__ __forceinline__ float bf2f(unsigned short h) { return __builtin_bit_cast(float, (unsigned)h << 16); }
__device__ __forceinline__ float wave_sum(float v) {
#pragma unroll
    for (int o = 1; o < 64; o <<= 1) v += __shfl_xor(v, o);
    return v;
}
__device__ __forceinline__ float wave_max(float v) {
#pragma unroll
    for (int o = 1; o < 64; o <<= 1) v = fmaxf(v, __shfl_xor(v, o));
    return v;
}

#define XB_TMO      128
#define XB_XCNT(j)  (256  + 64 * (j))
#define XB_XSUB(j)  (1280 + 64 * (j))
#define XB_XGEN(j)  (2304 + 64 * (j))
#define XB_TOP      3328
#define XB_TOPGEN   3392
#define XCD_BAR_WORDS 3456
#define XB_SPIN_CAP (1u << 18)

__device__ __forceinline__ unsigned xb_ld(unsigned* p)              { return __hip_atomic_load(p, __ATOMIC_RELAXED, __HIP_MEMORY_SCOPE_AGENT); }
__device__ __forceinline__ unsigned xb_add(unsigned* p, unsigned v) { return __hip_atomic_fetch_add(p, v, __ATOMIC_RELAXED, __HIP_MEMORY_SCOPE_AGENT); }
__device__ __forceinline__ unsigned xb_xcc_id() { return (unsigned)__builtin_amdgcn_s_getreg((3 << 11) | 20) & 0xFu; }
#define XB_SPIN(cond, bar) do { unsigned _sp = 0; while (cond) { __builtin_amdgcn_s_sleep(1); \
    if ((++_sp & 255u) == 0u) { if (xb_ld(&(bar)[XB_TMO])) break; if (_sp > XB_SPIN_CAP) { atomicAdd(&(bar)[XB_TMO], 1u); break; } } } } while (0)

struct XcdBarrier {
    unsigned* bar; unsigned x;
    volatile LAS unsigned* st;
};

__device__ __forceinline__ XcdBarrier xcd_barrier_post(unsigned* bar, volatile LAS unsigned* st) {
    XcdBarrier b; b.bar = bar; b.x = xb_xcc_id(); b.st = st;
    if (threadIdx.x == 0) (void)xb_add(&bar[XB_XCNT(b.x)], 1u);
    return b;
}
__device__ __forceinline__ void xcd_barrier_complete(unsigned* bar, unsigned x, unsigned& nloc, unsigned& nx) {
    const unsigned G = gridDim.x * gridDim.y * gridDim.z;
    unsigned sum, cnt, mine, sp = 0u;
    for (;;) {
        sum = 0u; cnt = 0u; mine = 0u;
#pragma unroll
        for (unsigned j = 0; j < 16; ++j) { const unsigned c = xb_ld(&bar[XB_XCNT(j)]); sum += c; cnt += (c > 0u) ? 1u : 0u; mine = (j == x) ? c : mine; }
        if (sum == G) break;
        __builtin_amdgcn_s_sleep(1);
        if ((++sp & 255u) == 0u) { if (xb_ld(&bar[XB_TMO])) break; if (sp > XB_SPIN_CAP) { atomicAdd(&bar[XB_TMO], 1u); break; } }
    }
    nloc = mine > 0u ? mine : 1u; nx = cnt > 0u ? cnt : 1u;
}

__device__ __forceinline__ void xcd_barrier(const XcdBarrier& b) {
    asm volatile("s_waitcnt vmcnt(0)" ::: "memory");
    __syncthreads();
    if (threadIdx.x == 0) {
        unsigned* bar = b.bar;
        __builtin_amdgcn_s_waitcnt(0);
        unsigned nloc = b.st[0], nx = b.st[1];
        if (nloc == 0u) { xcd_barrier_complete(bar, b.x, nloc, nx); b.st[0] = nloc; b.st[1] = nx; }
        const unsigned old = xb_add(&bar[XB_XSUB(b.x)], 1u);
        const unsigned gen = old / nloc;
        if (old + 1u == (gen + 1u) * nloc) {
            __builtin_amdgcn_fence(__ATOMIC_RELEASE, "agent");
            asm volatile("s_waitcnt vmcnt(0)" ::: "memory");
            const unsigned og = xb_add(&bar[XB_TOP], 1u);
            const unsigned tg = og / nx;
            if (og + 1u == (tg + 1u) * nx) xb_add(&bar[XB_TOPGEN], 1u);
            else XB_SPIN(xb_ld(&bar[XB_TOPGEN]) == tg, bar);
            __builtin_amdgcn_fence(__ATOMIC_ACQUIRE, "agent");
            xb_add(&bar[XB_XGEN(b.x)], 1u);
            asm volatile("s_waitcnt vmcnt(0)" ::: "memory");
        } else {
            XB_SPIN(xb_ld(&bar[XB_TOPGEN]) == gen, bar);
            __builtin_amdgcn_fence(__ATOMIC_ACQUIRE, "agent");
            asm volatile("s_waitcnt vmcnt(0)" ::: "memory");
        }
    }
    __syncthreads();
}
__host__ __device__ __forceinline__ int r32map(int P) { return 16 * ((P >> 2) & 1) + 4 * (P >> 3) + (P & 3); }
__host__ __device__ __forceinline__ int p128(int x) { return (x & ~31) + r32map(x & 31); }
__host__ __device__ __forceinline__ int hdmap(int d) { if (d >= 16) return d; const int fq = (d >> 2) & 1, j = (d & 3) + 4 * (d >> 3); return 8 * fq + j; }
__host__ __device__ __forceinline__ int head_row(int wc, int d) { const int x = hdmap(d); return 128 * (x >> 5) + 32 * wc + r32map(x & 31); }
__device__ __forceinline__ int dstart(int bj, int fq, int half) { return (bj == 0 && fq < 2) ? 4 * fq + 8 * half : 32 * bj + 8 * fq + 4 * half; }

struct MapGate { __device__ __forceinline__ int operator()(int c) const { return 256 * (c >> 7) + p128(c & 127); } };
struct MapUp   { __device__ __forceinline__ int operator()(int c) const { return 256 * (c >> 7) + 128 + p128(c & 127); } };
struct MapLin  { __device__ __forceinline__ int operator()(int c) const { return (c & ~127) + p128(c & 127); } };
struct MapWin  { __device__ __forceinline__ int operator()(int c) const {
    if (c < 512) return 1024 + (c & ~127) + p128(c & 127);
    if (c < 1024) { const int ch = c - 512; return 256 * (ch >> 7) + p128(ch & 127); }
    if (c < 1536) { const int ch = c - 1024; return 256 * (ch >> 7) + 128 + p128(ch & 127); }
    if (c < 2048) { const int x = c - 1536, hd = x >> 6; return 256 * (6 + (hd >> 2)) + head_row(hd & 3, x & 63); }
    if (c < 2176) { const int x = c - 2048; return 256 * 8 + head_row(x >> 6, x & 63); }
    if (c < 2304) { const int x = c - 2176; return 256 * 8 + head_row(2 + (x >> 6), x & 63); }
    if (c < 2816) { const int x = c - 2304, hd = x >> 6; return 256 * (9 + (hd >> 2)) + head_row(hd & 3, x & 63); }
    if (c < 2880) return 256 * 11 + head_row(0, c - 2816);
    return 256 * 11 + 32 + r32map(c - 2880);
} };

using pg8::Unit; using pg8::bf16_t;
__device__ __forceinline__ float rstd_from(const float* ss, int row, int nslot) {
    float s = 0.f;
    if (nslot == 1) s = ss[row];
    else { const f32x4* p = (const f32x4*)(ss + (size_t)row * 16); const f32x4 a = p[0], b = p[1], c = p[2], d = p[3]; s = ((a.x + a.y) + (a.z + a.w)) + ((b.x + b.y) + (b.z + b.w)) + ((c.x + c.y) + (c.z + c.w)) + ((d.x + d.y) + (d.z + d.w)); }
    return __builtin_amdgcn_rsqf(s * (1.0f / D) + EPS);
}
__device__ __forceinline__ float clamp8(float x) { return __builtin_amdgcn_fmed3f(x, -440.0f, 440.0f); }
__device__ __forceinline__ unsigned pk4_fp8(float a, float b, float c, float d) { int w = __builtin_amdgcn_cvt_pk_fp8_f32(clamp8(a), clamp8(b), 0, false); w = __builtin_amdgcn_cvt_pk_fp8_f32(clamp8(c), clamp8(d), w, true); return (unsigned)w; }
#define EPI_CALL_ROWS() \
    __device__ __forceinline__ void operator()(f32x4 (&acc)[2][2][4][2], const Unit& u, int wr, int wc, int fr, int fq, int ui, bool has_next, const Unit& nxt) const { \
        _Pragma("unroll") for (int ai = 0; ai < 2; ++ai) _Pragma("unroll") for (int m = 0; m < 4; ++m) { \
            const f32x4 v[2][2] = {{acc[ai][0][m][0], acc[ai][0][m][1]}, {acc[ai][1][m][0], acc[ai][1][m][1]}}; \
            row(v, u.pm * 256 + ai * 128 + wr * 64 + m * 16 + fr, u.pn, wc, fr, fq, ui); \
            if (has_next) init_rg(acc, nxt, ai, m, wr, wc, fr, fq); } }                        \
    __device__ __forceinline__ void init(f32x4 (&acc)[2][2][4][2], const Unit& u, int wr, int wc, int fr, int fq) const { \
        _Pragma("unroll") for (int ai = 0; ai < 2; ++ai) _Pragma("unroll") for (int m = 0; m < 4; ++m) init_rg(acc, u, ai, m, wr, wc, fr, fq); }
#define EPI_ZERO_INIT() \
    __device__ __forceinline__ void init_rg(f32x4 (&acc)[2][2][4][2], const Unit&, int ai, int m, int, int, int, int) const { \
        _Pragma("unroll") for (int b = 0; b < 2; ++b) _Pragma("unroll") for (int n = 0; n < 2; ++n) acc[ai][b][m][n] = (f32x4){0.f, 0.f, 0.f, 0.f}; }
__device__ __forceinline__ float rstd_of(const LAS float* tab, const float* ss, int nslot, int row, int ui) { return (ui >= 0 && tab) ? tab[ui * 256 + (row & 255)] : rstd_from(ss, row, nslot); }
struct EpiGU {
    static constexpr bool PERM = false, AFTER_DRAIN = false;
    bf16_t* H; const float* ss; int nslot; const LAS float* tab; float wscale; unsigned char* H8; const float* wsn;
    __device__ __forceinline__ void row(const f32x4 (&v)[2][2], int row, int pn, int wc, int fr, int fq, int ui) const {
        typedef float f32x2 __attribute__((ext_vector_type(2)));
        const int col0 = pn * 128 + wc * 32 + 8 * fq;
        const float rs = rstd_of(tab, ss, nslot, row, ui) * (ui >= 0 ? wscale : 1.0f);
        const float c1 = -rs * LOG2E, rs2 = rs * rs;
        const bool f8 = (ui >= 0) && H8 != nullptr;
        const float rs2s = f8 ? rs2 * H8SCALE : rs2;
        f32x2 hh[4];
#pragma unroll
        for (int n = 0; n < 2; ++n)
#pragma unroll
            for (int i = 0; i < 4; i += 2) { const f32x2 ag = {v[0][n][i], v[0][n][i + 1]}, au = {v[1][n][i], v[1][n][i + 1]};
                const f32x2 a = ag * c1; f32x2 e; e.x = __builtin_amdgcn_exp2f(a.x); e.y = __builtin_amdgcn_exp2f(a.y);
                const f32x2 d = e + 1.0f; f32x2 r; r.x = __builtin_amdgcn_rcpf(d.x); r.y = __builtin_amdgcn_rcpf(d.y);
                hh[2 * n + (i >> 1)] = (ag * au) * (r * rs2s); }
        if (f8) { v2u w8; w8.x = pk4_fp8(hh[0].x, hh[0].y, hh[1].x, hh[1].y); w8.y = pk4_fp8(hh[2].x, hh[2].y, hh[3].x, hh[3].y);
            __builtin_nontemporal_store(w8, (v2u*)(H8 + (size_t)row * DFF + col0)); }
        else { v4u w; w.x = pg8::cvt_pk_bf16(hh[0].x, hh[0].y); w.y = pg8::cvt_pk_bf16(hh[1].x, hh[1].y); w.z = pg8::cvt_pk_bf16(hh[2].x, hh[2].y); w.w = pg8::cvt_pk_bf16(hh[3].x, hh[3].y);
        __builtin_nontemporal_store(w, (v4u*)(H + (size_t)row * DFF + col0)); }
    }
    __device__ __forceinline__ void operator()(f32x4 (&acc)[2][2][4][2], const Unit& u, int wr, int wc, int fr, int fq, int ui, bool has_next, const Unit& nxt) const {
        typedef int v4i_ __attribute__((ext_vector_type(4)));
        f32x4 cs[2][2];
#pragma unroll
        for (int bj = 0; bj < 2; ++bj)
#pragma unroll
            for (int n = 0; n < 2; ++n) cs[bj][n] = wsn ? *(const f32x4*)(wsn + u.pn * 256 + bj * 128 + wc * 32 + n * 16 + 4 * fq) : (f32x4){1.f, 1.f, 1.f, 1.f};
#pragma unroll
        for (int ai = 0; ai < 2; ++ai)
#pragma unroll
            for (int m = 0; m < 4; ++m) {
                f32x4 v[2][2];
#pragma unroll
                for (int bj = 0; bj < 2; ++bj)
#pragma unroll
                    for (int n = 0; n < 2; ++n) v[bj][n] = wsn ? __builtin_convertvector(__builtin_bit_cast(v4i_, acc[ai][bj][m][n]), f32x4) * cs[bj][n] : acc[ai][bj][m][n];
                row(v, u.pm * 256 + ai * 128 + wr * 64 + m * 16 + fr, u.pn, wc, fr, fq, ui);
                if (has_next) init_rg(acc, nxt, ai, m, wr, wc, fr, fq); }
    }
    __device__ __forceinline__ void init(f32x4 (&acc)[2][2][4][2], const Unit& u, int wr, int wc, int fr, int fq) const {
#pragma unroll
        for (int ai = 0; ai < 2; ++ai)
#pragma unroll
            for (int m = 0; m < 4; ++m) init_rg(acc, u, ai, m, wr, wc, fr, fq); }
    EPI_ZERO_INIT()
};
__device__ __forceinline__ void bf8_to_f32(const v4u w, f32x4& lo, f32x4& hi) {
    lo = (f32x4){__uint_as_float(w.x << 16), __uint_as_float(w.x & 0xffff0000u), __uint_as_float(w.y << 16), __uint_as_float(w.y & 0xffff0000u)};
    hi = (f32x4){__uint_as_float(w.z << 16), __uint_as_float(w.z & 0xffff0000u), __uint_as_float(w.w << 16), __uint_as_float(w.w & 0xffff0000u)};
}
template <int MODE> struct EpiRes {
    static constexpr bool PERM = false, AFTER_DRAIN = false;
    const bf16_t* resb; float* out; bf16_t* outb; float* ss; unsigned char* out8; float ascale; const float* resf = nullptr; const float* resfs = nullptr;
    __device__ __forceinline__ void row(const f32x4 (&v)[2][2], int row, int pn, int wc, int fr, int fq, int ui) const {
        const bool pre = ui >= 0;
        const float alpha = ((MODE == 1) ? 1.0f : 0.5f) * (pre ? ascale : 1.0f);
        const bool live = row < MTOT;
        float sq = 0.f;
#pragma unroll
        for (int bj = 0; bj < 2; ++bj) {
            const int col = pn * 256 + bj * 128 + wc * 32 + 8 * fq;
            f32x4 r0 = (f32x4){0.f, 0.f, 0.f, 0.f}, r1 = r0;
            if (!pre && live) { if constexpr (MODE == 0) { r0 = *(const f32x4*)(resfs + (size_t)(row - MP) * D + col); r1 = *(const f32x4*)(resfs + (size_t)(row - MP) * D + col + 4); } else bf8_to_f32(*(const v4u*)(resb + (size_t)row * D + col), r0, r1); }
            const f32x4 v0 = r0 + alpha * v[bj][0], v1 = r1 + alpha * v[bj][1];
            if (MODE == 2) { if (live) { __builtin_nontemporal_store(v0, (f32x4*)(out + (size_t)row * D + col)); __builtin_nontemporal_store(v1, (f32x4*)(out + (size_t)row * D + col + 4)); } }
            else {
                v4u w; w.x = pg8::cvt_pk_bf16(v0[0], v0[1]); w.y = pg8::cvt_pk_bf16(v0[2], v0[3]); w.z = pg8::cvt_pk_bf16(v1[0], v1[1]); w.w = pg8::cvt_pk_bf16(v1[2], v1[3]);
                *(v4u*)(outb + (size_t)row * D + col) = w;
                if (MODE == 1 && out8) { v2u w8; w8.x = pk4_fp8(v0[0], v0[1], v0[2], v0[3]); w8.y = pk4_fp8(v1[0], v1[1], v1[2], v1[3]); *(v2u*)(out8 + (size_t)row * D + col) = w8; }
                sq += (v0[0] * v0[0] + v0[1] * v0[1]) + (v0[2] * v0[2] + v0[3] * v0[3]) + (v1[0] * v1[0] + v1[1] * v1[1]) + (v1[2] * v1[2] + v1[3] * v1[3]);
            }
        }
        if (MODE != 2) { sq += __shfl_xor(sq, 16); sq += __shfl_xor(sq, 32); if (fq == 0) ss[(size_t)row * 16 + pn * 4 + wc] = sq; }
    }
    EPI_CALL_ROWS()
    __device__ __forceinline__ void init_rg(f32x4 (&acc)[2][2][4][2], const Unit& u, int ai, int m, int wr, int wc, int fr, int fq) const {
        const float ia = ((MODE == 1) ? 1.0f : 2.0f) / ascale;
        const size_t ro = (size_t)(u.pm * 256 + ai * 128 + wr * 64 + m * 16 + fr) * D + u.pn * 256 + wc * 32 + 8 * fq;
#pragma unroll
        for (int bj = 0; bj < 2; ++bj) { f32x4 lo, hi;
            if constexpr (MODE == 0) { lo = *(const f32x4*)(resf + ro + bj * 128); hi = *(const f32x4*)(resf + ro + bj * 128 + 4); } else bf8_to_f32(*(const v4u*)(resb + ro + bj * 128), lo, hi);
            acc[ai][bj][m][0] = lo * ia; acc[ai][bj][m][1] = hi * ia; }
    }
};
struct EpiWin {
    static constexpr bool PERM = false, AFTER_DRAIN = false;
    unsigned char* ws; float* out; const float* qn; const float* kn; const LAS float* tab;
    __device__ __forceinline__ void row(const f32x4 (&acc)[2][2], int row, int pn, int wc, int fr, int fq, int ui) const {
        const float* ss = (const float*)(ws + WS_SS1); bf16_t* U = (bf16_t*)(ws + WS_U); bf16_t* GB = (bf16_t*)(ws + WS_GB); float* WI = (float*)(ws + WS_WI); const float* rope = (const float*)(ws + WS_ROPE);
        if (pn == 11 && wc >= 2) return;
        const int type = pn < 4 ? 0 : pn < 6 ? 1 : pn < 8 ? 2 : pn == 8 ? (wc < 2 ? 3 : 4) : pn < 11 ? 5 : (wc == 0 ? 6 : 7);
        const int head = (type == 2) ? 4 * (pn - 6) + wc : (type == 5) ? 4 * (pn - 9) + wc : (type == 3) ? wc : (type == 4) ? wc - 2 : 0;
        const bool live = row < MTOT;
        const float rs = rstd_of(tab, ss, 16, row, ui);
        if (type == 0) {
            const int ch0 = pn * 128 + wc * 32 + 8 * fq;
            const f32x4 u0 = (acc[0][0] * rs) * (acc[1][0] * rs), u1 = (acc[0][1] * rs) * (acc[1][1] * rs);
            v4u w; w.x = pg8::cvt_pk_bf16(u0[0], u0[1]); w.y = pg8::cvt_pk_bf16(u0[2], u0[3]); w.z = pg8::cvt_pk_bf16(u1[0], u1[1]); w.w = pg8::cvt_pk_bf16(u1[2], u1[3]);
            *(v4u*)(U + (size_t)row * 512 + ch0) = w;
            if (row < MP) { const int s = row & (SEQ - 1); if (s >= SEQ - 2) { float* o = out + O_CP + ((size_t)(row >> 11) * 2 + (s - (SEQ - 2))) * 512 + ch0; *(f32x4*)o = u0; *(f32x4*)(o + 4) = u1; } }
            else if (live) { const int sr = row - MP, s = sr & 3; if (s >= 2) { float* o = out + O_CS + ((size_t)(sr >> 2) * 2 + (s - 2)) * 512 + ch0; *(f32x4*)o = u0; *(f32x4*)(o + 4) = u1; } }
        } else if (type == 1) {
#pragma unroll
            for (int bj = 0; bj < 2; ++bj) { const int col = (pn - 4) * 256 + bj * 128 + wc * 32 + 8 * fq; const f32x4 a = acc[bj][0] * rs, b = acc[bj][1] * rs;
                v4u w; w.x = pg8::cvt_pk_bf16(a[0], a[1]); w.y = pg8::cvt_pk_bf16(a[2], a[3]); w.z = pg8::cvt_pk_bf16(b[0], b[1]); w.w = pg8::cvt_pk_bf16(b[2], b[3]);
                *(v4u*)(GB + (size_t)row * 512 + col) = w; }
        } else if (type == 7) {
            if (fq == 0) { *(f32x4*)(WI + (size_t)row * 8) = acc[0][0] * rs; *(f32x4*)(WI + (size_t)row * 8 + 4) = acc[0][1] * rs; }
        } else {
            f32x4 v[2][2];
#pragma unroll
            for (int bj = 0; bj < 2; ++bj) { v[bj][0] = acc[bj][0] * rs; v[bj][1] = acc[bj][1] * rs; }
            if (type == 2 || type == 3) {
                float sq = 0.f;
#pragma unroll
                for (int bj = 0; bj < 2; ++bj)
#pragma unroll
                    for (int h2 = 0; h2 < 2; ++h2) sq += (v[bj][h2][0] * v[bj][h2][0] + v[bj][h2][1] * v[bj][h2][1]) + (v[bj][h2][2] * v[bj][h2][2] + v[bj][h2][3] * v[bj][h2][3]);
                sq += __shfl_xor(sq, 16); sq += __shfl_xor(sq, 32);
                const float sc = __builtin_amdgcn_rsqf(sq * (1.0f / 64.0f) + EPS);
#pragma unroll
                for (int bj = 0; bj < 2; ++bj)
#pragma unroll
                    for (int h2 = 0; h2 < 2; ++h2) { const f32x4 gq = *(const f32x4*)(qn + dstart(bj, fq, h2)), gk = *(const f32x4*)(kn + dstart(bj, fq, h2)); v[bj][h2] = v[bj][h2] * sc * ((type == 2) ? gq : gk); }
            }
            if (type != 4 && fq < 2) {
                const int pidx = row < MP ? (row & (SEQ - 1)) : (live ? SEQ + ((row - MP) & 3) : 0);
                const float* rp = rope + ((size_t)pidx * 8 + 4 * fq) * 2;
                const f32x4 cs0 = *(const f32x4*)rp, cs1 = *(const f32x4*)(rp + 4);
                const f32x4 x1 = v[0][0], x2 = v[0][1];
                const f32x4 c = (f32x4){cs0[0], cs0[2], cs1[0], cs1[2]}, s = (f32x4){cs0[1], cs0[3], cs1[1], cs1[3]};
                v[0][0] = x1 * c - x2 * s; v[0][1] = x2 * c + x1 * s;
            }
            const size_t boff = (type == 2) ? WS_Q : (type == 3) ? WS_KB : (type == 4) ? WS_VB : (type == 5) ? WS_QI : WS_KIB;
            const int bp = (type == 2 || type == 5) ? 512 : (type == 6) ? 64 : 128; const float bsc = (type == 2) ? QSCALE : 1.0f;
            bf16_t* bdst = (bf16_t*)(ws + boff);
            const bool hasf = live && (type == 3 || type == 4 || type == 6);
            const size_t fbase = (type == 3) ? (row < MP ? O_KP : O_KS) : (type == 4) ? (row < MP ? O_VP : O_VS) : (row < MP ? O_IP : O_IS);
            float* fdst = out + fbase + (size_t)(row < MP ? row : row - MP) * (type == 6 ? 64 : 128);
#pragma unroll
            for (int bj = 0; bj < 2; ++bj)
#pragma unroll
                for (int h2 = 0; h2 < 2; ++h2) { const int d = head * 64 + dstart(bj, fq, h2); const f32x4 x = v[bj][h2];
                    if (hasf) { if (row < MP) __builtin_nontemporal_store(x, (f32x4*)(fdst + d)); else *(f32x4*)(fdst + d) = x; }
                    v2u w; w.x = pg8::cvt_pk_bf16(x[0] * bsc, x[1] * bsc); w.y = pg8::cvt_pk_bf16(x[2] * bsc, x[3] * bsc);
                    *(v2u*)(bdst + (size_t)row * bp + d) = w; }
        }
    }
    EPI_CALL_ROWS()
    EPI_ZERO_INIT()
};
template <class Epi> __device__ __forceinline__ void skinny_unit(PG8_LAS unsigned char* lds, const bf16_t* A, const bf16_t* Bt, int K, int pn, int wc, int rg, const Epi& E) {
    const int tid = threadIdx.x, wid = __builtin_amdgcn_readfirstlane(tid >> 6), lane = tid & 63, fr = lane & 15, fq = lane >> 4;
    const int KQ = K >> 3, ns = KQ >> 5;
    const bf16_t* ap = A + (size_t)(MP + 64 * rg + fr) * K + wid * KQ + 8 * fq;
    const bf16_t* bp = Bt + (size_t)(256 * pn + 32 * wc + fr) * K + wid * KQ + 8 * fq;
    pg8::f32x4 acc[4][2][2];
#pragma unroll
    for (int mt = 0; mt < 4; ++mt)
#pragma unroll
        for (int bj = 0; bj < 2; ++bj)
#pragma unroll
            for (int n = 0; n < 2; ++n) acc[mt][bj][n] = (pg8::f32x4){0.f, 0.f, 0.f, 0.f};
    pg8::bf16x8 a0[4], b0[2][2], a1[4], b1[2][2], a2[4], b2[2][2], a3[4], b3[2][2];
#define SK_LOAD(af, bf, s_) do { const int sc_ = (s_) < ns ? (s_) : ns - 1; _Pragma("unroll") for (int mt = 0; mt < 4; ++mt) af[mt] = *(const pg8::bf16x8*)(ap + (size_t)(16 * mt) * K + 32 * sc_); \
        _Pragma("unroll") for (int bj = 0; bj < 2; ++bj) _Pragma("unroll") for (int n = 0; n < 2; ++n) bf[bj][n] = *(const pg8::bf16x8*)(bp + (size_t)(128 * bj + 16 * n) * K + 32 * sc_); } while (0)
#define SK_MMA(af, bf) do { _Pragma("unroll") for (int mt = 0; mt < 4; ++mt) _Pragma("unroll") for (int bj = 0; bj < 2; ++bj) _Pragma("unroll") for (int n = 0; n < 2; ++n) \
        acc[mt][bj][n] = __builtin_amdgcn_mfma_f32_16x16x32_bf16(bf[bj][n], af[mt], acc[mt][bj][n], 0, 0, 0); } while (0)
    SK_LOAD(a0, b0, 0); SK_LOAD(a1, b1, 1); SK_LOAD(a2, b2, 2);
    for (int s = 0; s < ns; s += 4) {
        SK_LOAD(a3, b3, s + 3); SK_MMA(a0, b0);
        if (s + 1 < ns) { SK_LOAD(a0, b0, s + 4); SK_MMA(a1, b1); }
        if (s + 2 < ns) { SK_LOAD(a1, b1, s + 5); SK_MMA(a2, b2); }
        if (s + 3 < ns) { SK_LOAD(a2, b2, s + 6); SK_MMA(a3, b3); }
    }
#undef SK_LOAD
#undef SK_MMA
    PG8_LAS pg8::f32x4* slab = (PG8_LAS pg8::f32x4*)lds;
#pragma unroll
    for (int mt = 0; mt < 4; ++mt)
#pragma unroll
        for (int bj = 0; bj < 2; ++bj)
#pragma unroll
            for (int n = 0; n < 2; ++n) slab[((wid * 4 + mt) * 4 + bj * 2 + n) * 64 + lane] = acc[mt][bj][n];
    __syncthreads();
    if (wid < 4) { pg8::f32x4 v[2][2];
#pragma unroll
      for (int bj = 0; bj < 2; ++bj)
#pragma unroll
          for (int n = 0; n < 2; ++n) { const int o = (wid * 4 + bj * 2 + n) * 64 + lane; pg8::f32x4 t = slab[o];
#pragma unroll
              for (int q = 1; q < 8; ++q) t = t + slab[o + q * 4 * 4 * 64];
              v[bj][n] = t; }
      E.row(v, MP + 64 * rg + 16 * wid + fr, pn, wc, fr, fq, -1); }
    __syncthreads();
}
template <class Epi> __device__ __forceinline__ void skinny_phase(PG8_LAS unsigned char* lds, const bf16_t* A, const bf16_t* Bt, int N, int K, int blk, int G, const Epi& E) {
    const int nu = (N / 256) * 8;
    for (int u = blk; u < nu; u += G) skinny_unit(lds, A, Bt, K, u >> 3, (u >> 1) & 3, u & 1, E);
}
__device__ __forceinline__ void fill_rstd_table(LAS float* tab, const pg8::StaticOrder& S, const float* ss, int nslot, const float* xs = nullptr) {
    const int tid = threadIdx.x; Unit u; int nu = 0;
    while (nu < 11 && S.next(nu, u)) ++nu;
    float sv[6], xsv[6]; int ix[6];
#pragma unroll
    for (int k2 = 0; k2 < 6; ++k2) { const int idx = tid + 512 * k2; ix[k2] = idx; const bool ok = idx < nu * 256; Unit uu_; S.next(ok ? (idx >> 8) : 0, uu_); const int row = uu_.pm * 256 + (idx & 255);
        float s_ = 0.f;
        if (nslot == 1) s_ = ss[row];
        else { const f32x4* p = (const f32x4*)(ss + (size_t)row * 16); const f32x4 a = p[0], b = p[1], c = p[2], d = p[3]; s_ = ((a.x + a.y) + (a.z + a.w)) + ((b.x + b.y) + (b.z + b.w)) + ((c.x + c.y) + (c.z + c.w)) + ((d.x + d.y) + (d.z + d.w)); }
        sv[k2] = s_; xsv[k2] = xs ? xs[row] : 1.0f; }
#pragma unroll
    for (int k2 = 0; k2 < 6; ++k2) if (ix[k2] < nu * 256) tab[ix[k2]] = __builtin_amdgcn_rsqf(sv[k2] * (1.0f / D) + EPS) * xsv[k2];
    __syncthreads();
}
__device__ __forceinline__ void quant_rows_pass(int gw, int NGW, const bf16_t* X, unsigned char* Q, float* XS, int nrows) {
    const int lane = threadIdx.x & 63;
    for (int g8 = gw; g8 < nrows / 8; g8 += NGW) {
        const int m0 = 8 * g8; v4u a[8][2];
#pragma unroll
        for (int r = 0; r < 8; ++r) { a[r][0] = *(const v4u*)(X + (size_t)(m0 + r) * D + 8 * lane); a[r][1] = *(const v4u*)(X + (size_t)(m0 + r) * D + 512 + 8 * lane); }
#pragma unroll
        for (int r = 0; r < 8; ++r) {
            float x[16];
#pragma unroll
            for (int e = 0; e < 4; ++e) { x[2 * e] = __uint_as_float(a[r][0][e] << 16); x[2 * e + 1] = __uint_as_float(a[r][0][e] & 0xffff0000u); x[8 + 2 * e] = __uint_as_float(a[r][1][e] << 16); x[9 + 2 * e] = __uint_as_float(a[r][1][e] & 0xffff0000u); }
            float mx = 0.f;
#pragma unroll
            for (int e = 0; e < 16; ++e) mx = fmaxf(mx, fabsf(x[e]));
            { unsigned v = __float_as_uint(mx), o;
              o = (unsigned)__builtin_amdgcn_update_dpp(0, (int)v, 0xB1, 0xF, 0xF, true); v = o > v ? o : v;
              o = (unsigned)__builtin_amdgcn_update_dpp(0, (int)v, 0x4E, 0xF, 0xF, true); v = o > v ? o : v;
              o = (unsigned)__builtin_amdgcn_update_dpp(0, (int)v, 0x141, 0xF, 0xF, true); v = o > v ? o : v;
              o = (unsigned)__builtin_amdgcn_update_dpp(0, (int)v, 0x140, 0xF, 0xF, true); v = o > v ? o : v;
              const unsigned p0 = (unsigned)__builtin_amdgcn_readlane((int)v, 0), p1 = (unsigned)__builtin_amdgcn_readlane((int)v, 16), p2 = (unsigned)__builtin_amdgcn_readlane((int)v, 32), p3 = (unsigned)__builtin_amdgcn_readlane((int)v, 48);
              const unsigned q0 = p0 > p1 ? p0 : p1, q1 = p2 > p3 ? p2 : p3; mx = __uint_as_float(q0 > q1 ? q0 : q1); }
            const float iq = mx > 0.f ? 127.0f / mx : 0.f;
            unsigned w[4];
#pragma unroll
            for (int e = 0; e < 4; ++e) { const int q0 = (int)__builtin_rintf(x[4 * e] * iq), q1 = (int)__builtin_rintf(x[4 * e + 1] * iq), q2 = (int)__builtin_rintf(x[4 * e + 2] * iq), q3 = (int)__builtin_rintf(x[4 * e + 3] * iq);
                w[e] = (unsigned)(q0 & 0xff) | ((unsigned)(q1 & 0xff) << 8) | ((unsigned)(q2 & 0xff) << 16) | ((unsigned)(q3 & 0xff) << 24); }
            *(v2u*)(Q + (size_t)(m0 + r) * D + 8 * lane) = (v2u){w[0], w[1]};
            *(v2u*)(Q + (size_t)(m0 + r) * D + 512 + 8 * lane) = (v2u){w[2], w[3]};
            if (lane == 0) XS[m0 + r] = mx * (1.0f / 127.0f);
        }
    }
}
struct Frame {
    LAS unsigned char* lds;
    volatile LAS unsigned* MISC;
    gu32* ctl;
    int tid, lane, wave, vcu, G;
    const void* const* in;
    float* out; unsigned char* ws;
};
#define WSP(T, off) ((T*)(F.ws + (off)))

template <class Map> __device__ __forceinline__ void p0_transpose_item(const float* W, int K, int N, const float* gain, bf16* WT, LAS float* scr, int item, int lane, const Map map, unsigned char* WT8 = nullptr) {
    const int nblk = (N + 31) / 32, kb = item / nblk, nb = item % nblk, k0 = 64 * kb, n0 = 32 * nb;
    const bool nok = n0 + (lane & 31) < N;
#pragma unroll 8
    for (int i = 0; i < 32; ++i) { const int kk = 2 * i + (lane >> 5); float v = nok ? __builtin_nontemporal_load(W + (size_t)(k0 + kk) * N + n0 + (lane & 31)) : 0.f; if (gain) v *= gain[k0 + kk]; scr[kk * 33 + (lane & 31)] = v; }
    LDS_WAIT(); asm volatile("" ::: "memory");
    const int c = lane & 7;
#pragma unroll
    for (int j = 0; j < 4; ++j) { const int n = (lane >> 3) + 8 * j; const LAS float* s = scr + (8 * c) * 33 + n;
        v4u o; o.x = pk2(s[0 * 33], s[1 * 33]); o.y = pk2(s[2 * 33], s[3 * 33]); o.z = pk2(s[4 * 33], s[5 * 33]); o.w = pk2(s[6 * 33], s[7 * 33]);
        if (n0 + n < N) { *(GAS v4u*)(WT + (size_t)map(n0 + n) * K + k0 + 8 * c) = o;
            if (WT8) { v2u o8; o8.x = pk4_fp8(s[0 * 33] * W8SCALE, s[1 * 33] * W8SCALE, s[2 * 33] * W8SCALE, s[3 * 33] * W8SCALE); o8.y = pk4_fp8(s[4 * 33] * W8SCALE, s[5 * 33] * W8SCALE, s[6 * 33] * W8SCALE, s[7 * 33] * W8SCALE);
                *(GAS v2u*)(WT8 + (size_t)map(n0 + n) * K + k0 + 8 * c) = o8; } } }
    LDS_WAIT(); asm volatile("" ::: "memory");
}
__device__ __forceinline__ void sincos_d(double a, float& s, float& c) {
    const double TWO_PI = 6.283185307179586476925286766559, PI = 3.14159265358979323846264338327950288;
    double k = __builtin_rint(a / TWO_PI); double r = a - k * TWO_PI;
    double sgn = 1.0; if (r > PI * 0.5) { r = PI - r; sgn = -1.0; } else if (r < -PI * 0.5) { r = -PI - r; sgn = -1.0; }
    const double r2 = r * r;
    double ts = 1.0, tc = 1.0, ps = 1.0, pc = 1.0;
#pragma unroll
    for (int n = 1; n <= 12; ++n) { pc = -pc * r2 / (double)((2 * n - 1) * (2 * n)); ps = -ps * r2 / (double)((2 * n) * (2 * n + 1)); tc += pc; ts += ps; }
    s = (float)(r * ts); c = (float)(sgn * tc);
}
__device__ __forceinline__ void p0_prologue(Frame& F) {
    LAS float* scr = (LAS float*)(F.lds + RING_OFF + F.wave * 16384);
    const int gw = F.vcu * 8 + F.wave, NGW = F.G * 8;
    constexpr int I_G = (D / 64) * (DFF / 32), I_D = (DFF / 64) * (D / 32), I_IN = (D / 64) * ((NIN + 31) / 32), I_O = (D / 64) * (D / 32);
    constexpr int NITEMS = 2 * (2 * I_G + I_D) + I_IN + I_O;
    for (int rep63 = 0; rep63 < (PROBE_DUP == 63 ? 2 : 1); ++rep63)
    for (int it = gw; it < NITEMS; it += NGW) {
        int r = it;
        if (r < I_G) { p0_transpose_item(((const float*)F.in[8]), D, DFF, ((const float*)F.in[7]), WSP(bf16, WS_WGU1), scr, r, F.lane, MapGate()); continue; } r -= I_G;
        if (r < I_G) { p0_transpose_item(((const float*)F.in[9]), D, DFF, ((const float*)F.in[7]), WSP(bf16, WS_WGU1), scr, r, F.lane, MapUp()); continue; } r -= I_G;
        if (r < I_D) { p0_transpose_item(((const float*)F.in[10]), DFF, D, nullptr, WSP(bf16, WS_WD1), scr, r, F.lane, MapLin(), WSP(unsigned char, WS_WD1_8)); continue; } r -= I_D;
        if (r < I_G) { p0_transpose_item(((const float*)F.in[19]), D, DFF, ((const float*)F.in[18]), WSP(bf16, WS_WGU2), scr, r, F.lane, MapGate()); continue; } r -= I_G;
        if (r < I_G) { p0_transpose_item(((const float*)F.in[20]), D, DFF, ((const float*)F.in[18]), WSP(bf16, WS_WGU2), scr, r, F.lane, MapUp()); continue; } r -= I_G;
        if (r < I_D) { p0_transpose_item(((const float*)F.in[21]), DFF, D, nullptr, WSP(bf16, WS_WD2), scr, r, F.lane, MapLin(), WSP(unsigned char, WS_WD2_8)); continue; } r -= I_D;
        if (r < I_IN) { p0_transpose_item(((const float*)F.in[12]), D, NIN, ((const float*)F.in[11]), WSP(bf16, WS_WIN), scr, r, F.lane, MapWin()); continue; } r -= I_IN;
        p0_transpose_item(((const float*)F.in[17]), D, D, nullptr, WSP(bf16, WS_WOUT), scr, r, F.lane, MapLin());
    }
    bf16* XB = WSP(bf16, WS_XB); float* SS0 = WSP(float, WS_SS0);
    for (int rep64 = 0; rep64 < (PROBE_DUP == 64 ? 2 : 1); ++rep64)
    for (int g4 = gw; g4 < MTOT / 4; g4 += NGW) {
        const int m0 = 4 * g4;
        const float* xrow = m0 < MP ? ((const float*)F.in[0]) + (size_t)m0 * D : ((const float*)F.in[1]) + (size_t)(m0 - MP) * D;
        const GAS f32x4* xr = (const GAS f32x4*)xrow + F.lane;
        f32x4 v[4][4]; float s[4];
#pragma unroll
        for (int r = 0; r < 4; ++r)
#pragma unroll
            for (int j = 0; j < 4; ++j) v[r][j] = __builtin_nontemporal_load((const f32x4*)(xr + 256 * r + 64 * j));
#pragma unroll
        for (int r = 0; r < 4; ++r) { s[r] = 0.f;
#pragma unroll
            for (int j = 0; j < 4; ++j) s[r] += (v[r][j].x * v[r][j].x + v[r][j].y * v[r][j].y) + (v[r][j].z * v[r][j].z + v[r][j].w * v[r][j].w); }
#pragma unroll
        for (int o = 1; o < 64; o <<= 1) {
#pragma unroll
            for (int r = 0; r < 4; ++r) s[r] += __shfl_xor(s[r], o); }
        if (m0 >= MP) {
        GAS unsigned long long* o8 = (GAS unsigned long long*)(XB + (size_t)m0 * D) + F.lane;
#pragma unroll
        for (int r = 0; r < 4; ++r)
#pragma unroll
            for (int j = 0; j < 4; ++j) o8[256 * r + 64 * j] = (unsigned long long)pk2(v[r][j].x, v[r][j].y) | ((unsigned long long)pk2(v[r][j].z, v[r][j].w) << 32); }
        { float mx[4];
#pragma unroll
          for (int r = 0; r < 4; ++r) { mx[r] = 0.f;
#pragma unroll
              for (int j = 0; j < 4; ++j) mx[r] = fmaxf(mx[r], fmaxf(fmaxf(fabsf(v[r][j].x), fabsf(v[r][j].y)), fmaxf(fabsf(v[r][j].z), fabsf(v[r][j].w)))); }
#pragma unroll
          for (int o = 1; o < 64; o <<= 1) {
#pragma unroll
              for (int r = 0; r < 4; ++r) mx[r] = fmaxf(mx[r], __shfl_xor(mx[r], o)); }
          GAS unsigned* q8 = (GAS unsigned*)(WSP(unsigned char, WS_XI8) + (size_t)m0 * D) + F.lane;
#pragma unroll
          for (int r = 0; r < 4; ++r) { const float iq = mx[r] > 0.f ? 127.0f / mx[r] : 0.f;
#pragma unroll
              for (int j = 0; j < 4; ++j) { const int a_ = (int)__builtin_rintf(v[r][j].x * iq), b_ = (int)__builtin_rintf(v[r][j].y * iq), c_ = (int)__builtin_rintf(v[r][j].z * iq), d_ = (int)__builtin_rintf(v[r][j].w * iq);
                  q8[256 * r + 64 * j] = (unsigned)(a_ & 0xff) | ((unsigned)(b_ & 0xff) << 8) | ((unsigned)(c_ & 0xff) << 16) | ((unsigned)(d_ & 0xff) << 24); } }
          if (F.lane < 4) WSP(float, WS_XS)[m0 + F.lane] = (F.lane == 0 ? mx[0] : F.lane == 1 ? mx[1] : F.lane == 2 ? mx[2] : mx[3]) * (1.0f / 127.0f); }
        if (F.lane < 4) SS0[m0 + F.lane] = F.lane == 0 ? s[0] : F.lane == 1 ? s[1] : F.lane == 2 ? s[2] : s[3];
    }
    { float* rope = WSP(float, WS_ROPE);
      const double invf[8] = {1.0, 0.19392274474868576, 0.03760603093086393, 0.007292664737217109, 0.001414213562373095, 0.0002742481756762073, 5.318295896944988e-05, 1.031338537721246e-05};
      for (int rep65 = 0; rep65 < (PROBE_DUP == 65 ? 2 : 1); ++rep65)
      for (int e = (F.vcu * 512 + F.tid); e < 2052 * 8; e += F.G * 512) { const int p = e >> 3, i = e & 7; const double pos = (double)(p < SEQ ? p : PAST + (p - SEQ));
          double f = invf[0];
#pragma unroll
          for (int q = 1; q < 8; ++q) f = (i == q) ? invf[q] : f;
          float s, c; sincos_d(pos * f, s, c); rope[2 * e] = c; rope[2 * e + 1] = s; } }
}

__device__ __forceinline__ void unpack8(const v4u a, float (&o)[8]) {
#pragma unroll
    for (int e = 0; e < 4; ++e) { o[2 * e] = bf2f((unsigned short)(a[e] & 0xffffu)); o[2 * e + 1] = bf2f((unsigned short)(a[e] >> 16)); }
}
__device__ __forceinline__ void p0b_quant_weights(Frame& F) {
    const int gw = F.vcu * 8 + F.wave, NGW = F.G * 8;
    for (int rr = gw; rr < 4 * DFF; rr += NGW) {
        const bool second = rr >= 2 * DFF; const int r = second ? rr - 2 * DFF : rr;
        const bf16* W = second ? WSP(bf16, WS_WGU2) : WSP(bf16, WS_WGU1); unsigned char* Q = second ? WSP(unsigned char, WS_WGU2I8) : WSP(unsigned char, WS_WGU1I8); float* WSN = second ? WSP(float, WS_WSN2) : WSP(float, WS_WSN);
        const v4u a = *(const GAS v4u*)(W + (size_t)r * D + 8 * F.lane), b = *(const GAS v4u*)(W + (size_t)r * D + 512 + 8 * F.lane);
        float x[16]; { float t0[8], t1[8]; unpack8(a, t0); unpack8(b, t1);
#pragma unroll
            for (int e = 0; e < 8; ++e) { x[e] = t0[e]; x[8 + e] = t1[e]; } }
        float mx = 0.f;
#pragma unroll
        for (int e = 0; e < 16; ++e) mx = fmaxf(mx, fabsf(x[e]));
#pragma unroll
        for (int o = 1; o < 64; o <<= 1) mx = fmaxf(mx, __shfl_xor(mx, o));
        const float iq = mx > 0.f ? 127.0f / mx : 0.f;
        unsigned w[4];
#pragma unroll
        for (int e = 0; e < 4; ++e) { const int q0 = (int)__builtin_rintf(x[4 * e] * iq), q1 = (int)__builtin_rintf(x[4 * e + 1] * iq), q2 = (int)__builtin_rintf(x[4 * e + 2] * iq), q3 = (int)__builtin_rintf(x[4 * e + 3] * iq);
            w[e] = (unsigned)(q0 & 0xff) | ((unsigned)(q1 & 0xff) << 8) | ((unsigned)(q2 & 0xff) << 16) | ((unsigned)(q3 & 0xff) << 24); }
        *(GAS v2u*)(Q + (size_t)r * D + 8 * F.lane) = (v2u){w[0], w[1]};
        *(GAS v2u*)(Q + (size_t)r * D + 512 + 8 * F.lane) = (v2u){w[2], w[3]};
        if (F.lane == 0) WSN[r] = mx * (1.0f / 127.0f);
    }
}
__device__ __forceinline__ void p4_conv(Frame& F) {
    const int gw = F.vcu * 8 + F.wave, NGW = F.G * 8, ch = F.lane * 8;
    const bf16* U = WSP(bf16, WS_U); const bf16* GBp = WSP(bf16, WS_GB); bf16* CAT = WSP(bf16, WS_CAT);
    const float* conv_w = (const float*)F.in[13]; const float* conv_b = (const float*)F.in[14]; const float* cache_conv = (const float*)F.in[5];
    float w0[8], w1[8], w2[8], cb[8];
#pragma unroll
    for (int e = 0; e < 8; ++e) { w0[e] = conv_w[ch + e]; w1[e] = conv_w[512 + ch + e]; w2[e] = conv_w[1024 + ch + e]; cb[e] = conv_b[ch + e]; }
    for (int c = gw; c < MTOT / 8; c += NGW) {
        const int r0 = 8 * c;
        v4u ur[10], gr[8];
#pragma unroll
        for (int e = 0; e < 10; ++e) { const int rr = r0 - 2 + e; ur[e] = *(const GAS v4u*)(U + (size_t)(rr < 0 ? 0 : rr) * 512 + ch); }
#pragma unroll
        for (int e = 0; e < 8; ++e) gr[e] = *(const GAS v4u*)(GBp + (size_t)(r0 + e) * 512 + ch);
        float um2[8], um1[8];
        unpack8(ur[0], um2); unpack8(ur[1], um1);
        if (r0 < MP && (r0 & (SEQ - 1)) == 0) {
#pragma unroll
            for (int e = 0; e < 8; ++e) { um2[e] = 0.f; um1[e] = 0.f; } }
#pragma unroll
        for (int e = 0; e < 8; ++e) {
            if (r0 >= MP && (e & 3) == 0) {
                const float* cc = cache_conv + (size_t)((r0 - MP + e) >> 2) * 2 * 512 + ch;
#pragma unroll
                for (int q = 0; q < 8; ++q) { um2[q] = cc[q]; um1[q] = cc[512 + q]; } }
            float u0[8], g[8], y[8]; unpack8(ur[2 + e], u0); unpack8(gr[e], g);
#pragma unroll
            for (int q = 0; q < 8; ++q) { y[q] = g[q] * (cb[q] + w0[q] * um2[q] + w1[q] * um1[q] + w2[q] * u0[q]); um2[q] = um1[q]; um1[q] = u0[q]; }
            v4u o; o.x = pk2(y[0], y[1]); o.y = pk2(y[2], y[3]); o.z = pk2(y[4], y[5]); o.w = pk2(y[6], y[7]);
            *(GAS v4u*)(CAT + (size_t)(r0 + e) * D + ch) = o;
        }
    }
}
__device__ __forceinline__ int crow16(int r, int hi) { return (r & 3) + 8 * (r >> 2) + 4 * hi; }
__device__ __forceinline__ float xhalf_sum(float v) {
    auto rr = __builtin_amdgcn_permlane32_swap(__float_as_uint(v), __float_as_uint(v), false, false);
    return __uint_as_float(rr[0]) + __uint_as_float(rr[1]);
}
__device__ __forceinline__ void p4_sample_scores(Frame& F) {
    const int gw = F.vcu * 8 + F.wave, NGW = F.G * 8, lane = F.lane, r32 = lane & 31, hi = lane >> 5;
    const bf16* QI = WSP(bf16, WS_QI); const float* WIp = WSP(float, WS_WI); float* SSC = WSP(float, WS_SSC);
    const int* page_table = (const int*)F.in[6]; const float* cache_idx_k = (const float*)F.in[4];
    for (int item = gw; item < DB * NPAGES; item += NGW) {
        const int b = item >> 7, pg = item & 127; const int page = page_table[b * NPAGES + pg];
        bf16x8 a[4]; f32x4 w4[4];
        { const bf16* qrow = QI + (size_t)(MP + 4 * b + (r32 >> 3)) * 512 + (r32 & 7) * 64 + 8 * hi;
#pragma unroll
          for (int s = 0; s < 4; ++s) a[s] = *(const GAS bf16x8*)(qrow + 16 * s);
#pragma unroll
          for (int q = 0; q < 4; ++q) w4[q] = *(const GAS f32x4*)(WIp + (size_t)(MP + 4 * b + q) * 8 + 4 * hi); }
        const float* src = cache_idx_k + ((size_t)page * PAGE + r32) * 64 + 8 * hi;
        f32x4 lo[4][4], hh[4][4];
#pragma unroll
        for (int sub = 0; sub < 4; ++sub)
#pragma unroll
            for (int s = 0; s < 4; ++s) { lo[sub][s] = __builtin_nontemporal_load((const f32x4*)(src + sub * 32 * 64 + 16 * s)); hh[sub][s] = __builtin_nontemporal_load((const f32x4*)(src + sub * 32 * 64 + 16 * s + 4)); }
#pragma unroll
        for (int sub = 0; sub < 4; ++sub) {
            f32x16 acc = {};
#pragma unroll
            for (int s = 0; s < 4; ++s) { v4u p; p.x = pk2(lo[sub][s][0], lo[sub][s][1]); p.y = pk2(lo[sub][s][2], lo[sub][s][3]); p.z = pk2(hh[sub][s][0], hh[sub][s][1]); p.w = pk2(hh[sub][s][2], hh[sub][s][3]);
                acc = __builtin_amdgcn_mfma_f32_32x32x16_bf16(a[s], __builtin_bit_cast(bf16x8, p), acc, 0, 0, 0); }
#pragma unroll
            for (int q = 0; q < 4; ++q) {
                float sum = w4[q][0] * fmaxf(acc[4 * q], 0.f) + w4[q][1] * fmaxf(acc[4 * q + 1], 0.f) + w4[q][2] * fmaxf(acc[4 * q + 2], 0.f) + w4[q][3] * fmaxf(acc[4 * q + 3], 0.f);
                sum = xhalf_sum(sum) + 0.0f;
                if ((q >> 1) == hi) SSC[(size_t)(4 * b + q) * SSTR + pg * PAGE + sub * 32 + r32] = sum;
            }
        }
    }
}
__device__ __forceinline__ unsigned fkey(float s) { const unsigned b = __builtin_bit_cast(unsigned, s); return b ^ ((unsigned)((int)b >> 31) | 0x80000000u); }
__device__ __forceinline__ float unfkey(unsigned k) { const unsigned b = (k & 0x80000000u) ? (k ^ 0x80000000u) : ~k; return __builtin_bit_cast(float, b); }
__device__ __forceinline__ unsigned wave_umax(unsigned v) {
    unsigned o;
    o = (unsigned)__builtin_amdgcn_update_dpp(0, (int)v, 0xB1, 0xF, 0xF, true); v = o > v ? o : v;
    o = (unsigned)__builtin_amdgcn_update_dpp(0, (int)v, 0x4E, 0xF, 0xF, true); v = o > v ? o : v;
    o = (unsigned)__builtin_amdgcn_update_dpp(0, (int)v, 0x141, 0xF, 0xF, true); v = o > v ? o : v;
    o = (unsigned)__builtin_amdgcn_update_dpp(0, (int)v, 0x140, 0xF, 0xF, true); v = o > v ? o : v;
    const unsigned a = (unsigned)__builtin_amdgcn_readlane((int)v, 0), b = (unsigned)__builtin_amdgcn_readlane((int)v, 16), c = (unsigned)__builtin_amdgcn_readlane((int)v, 32), d = (unsigned)__builtin_amdgcn_readlane((int)v, 48);
    const unsigned ab = a > b ? a : b, cd = c > d ? c : d; return ab > cd ? ab : cd;
}
__device__ __forceinline__ int wave_count(unsigned cl) {
    int tot = 0;
#pragma unroll
    for (int bb = 0; bb < 6; ++bb) tot += __popcll(__ballot((cl >> bb) & 1u)) << bb;
    return tot;
}
__device__ __forceinline__ void p4_index_preload(Frame& F, int b, int j, bf16x8 (&a)[4][4], float& pwq) {
    const int tid = F.tid, r32 = F.lane & 31, hi = F.lane >> 5; const size_t rowb = (size_t)b * SEQ; const int t0 = 16 * j;
    const bf16* QI = WSP(bf16, WS_QI); const float* WIp = WSP(float, WS_WI);
    pwq = WIp[(rowb + t0 + ((tid & 127) >> 3)) * 8 + (tid & 7)];
#pragma unroll
    for (int rt = 0; rt < 4; ++rt) { const bf16* qrow = QI + (rowb + t0 + 4 * rt + 2 * (r32 >> 4) + ((r32 >> 2) & 1)) * 512 + (4 * ((r32 >> 3) & 1) + (r32 & 3)) * 64 + 8 * hi;
#pragma unroll
        for (int s = 0; s < 4; ++s) a[rt][s] = *(const GAS bf16x8*)(qrow + 16 * s); }
}
__device__ __forceinline__ void p4_index_unit(Frame& F, int b, int j, int useq, bf16x8 (&a)[4][4], float& pwq, int nj) {
    int tid_ = F.tid; asm volatile("" : "+v"(tid_));
    const int tid = tid_, lane = tid & 63, wid = F.wave, r32 = lane & 31, hi = lane >> 5;
    const int ss_id = (F.vcu * 8 + useq) * 8 + wid, ss_item = ss_id >> 2, ss_sub = ss_id & 3, ss_b = ss_item >> 7, ss_pg = ss_item & 127;
    const bool ss_on = F.vcu < 256;
    const int ss_page = ss_on ? ((const int*)F.in[6])[ss_b * NPAGES + ss_pg] : 0;
    const int t0 = 16 * j, nk = t0 + 16, ntile = (nk + 31) >> 5;
    LAS float* S = (LAS float*)(F.lds + RING_OFF);
    LAS float* WQ = (LAS float*)(F.lds + RING_OFF + 131072);
    LAS unsigned long long* MSK = (LAS unsigned long long*)(F.lds + RING_OFF + 131072 + 512);
    LAS unsigned* HW = (LAS unsigned*)(F.lds + RING_OFF + 131072 + 512 + 4096) + wid * 512;
    const bf16* QI = WSP(bf16, WS_QI); const bf16* KIB = WSP(bf16, WS_KIB); const float* WIp = WSP(float, WS_WI);
    unsigned long long* MASK = WSP(unsigned long long, WS_MASK);
    const size_t rowb = (size_t)b * SEQ;
    for (int rep43 = 0; rep43 < (PROBE_DUP == 43 ? 2 : 1); ++rep43)
    if (j >= 16) {
        if (tid < 128) WQ[tid] = pwq;
        const bf16* kbase = KIB + (rowb + r32) * 64 + 8 * hi;
#define IDX_LOADB(dst, kt_) do { const int kc_ = (kt_) < ntile ? (kt_) : ntile - 1; _Pragma("unroll") for (int s = 0; s < 4; ++s) dst[s] = *(const GAS bf16x8*)(kbase + (size_t)kc_ * 32 * 64 + 16 * s); } while (0)
#define RELU_(x_) __builtin_amdgcn_fmed3f((x_), 0.f, inf_)
#define IDX_COMPUTE(bf_, kt_) do { const int key = (kt_) * 32 + r32; \
            _Pragma("unroll") for (int rt = 0; rt < 4; ++rt) { f32x16 acc = {}; \
                _Pragma("unroll") for (int s = 0; s < 4; ++s) acc = __builtin_amdgcn_mfma_f32_32x32x16_bf16(a[rt][s], bf_[s], acc, 0, 0, 0); \
                _Pragma("unroll") for (int qp = 0; qp < 2; ++qp) { const int ql_ = 4 * rt + 2 * qp + hi;                      \
                    const f32x4 wa = *(const LAS f32x4*)(WQ + ql_ * 8), wb = *(const LAS f32x4*)(WQ + ql_ * 8 + 4); \
                      \
                    float e0_ = RELU_(acc[8 * qp + 0]) * wa[0], e1_ = RELU_(acc[8 * qp + 1]) * wa[1]; \
                    e0_ = __builtin_fmaf(RELU_(acc[8 * qp + 2]), wa[2], e0_); e1_ = __builtin_fmaf(RELU_(acc[8 * qp + 3]), wa[3], e1_); \
                    e0_ = __builtin_fmaf(RELU_(acc[8 * qp + 4]), wb[0], e0_); e1_ = __builtin_fmaf(RELU_(acc[8 * qp + 5]), wb[1], e1_); \
                    e0_ = __builtin_fmaf(RELU_(acc[8 * qp + 6]), wb[2], e0_); e1_ = __builtin_fmaf(RELU_(acc[8 * qp + 7]), wb[3], e1_); \
                    S[ql_ * 2048 + key] = (e0_ + e1_) + 0.0f; } } } while (0)
        float inf_ = __builtin_inff(); asm volatile("" : "+v"(inf_));
        bf16x8 bfA[4], bfB[4];
        IDX_LOADB(bfA, wid);
        __syncthreads();
        for (int kt = wid; kt < ntile; kt += 16) {
            IDX_LOADB(bfB, kt + 8);
            IDX_COMPUTE(bfA, kt);
            if (kt + 8 < ntile) { IDX_LOADB(bfA, kt + 16); IDX_COMPUTE(bfB, kt + 8); }
        }
#undef IDX_LOADB
#undef IDX_COMPUTE
#undef RELU_
        __syncthreads();
    }
    f32x4 ss_lo[4], ss_hh[4];
    { const float* src = ((const float*)F.in[4]) + ((size_t)ss_page * PAGE + ss_sub * 32 + r32) * 64 + 8 * hi;
#pragma unroll
      for (int s = 0; s < 4; ++s) { ss_lo[s] = __builtin_nontemporal_load((const f32x4*)(src + 16 * s)); ss_hh[s] = __builtin_nontemporal_load((const f32x4*)(src + 16 * s + 4)); }
    }
#pragma unroll 1
    for (int rep44 = 0; rep44 < (PROBE_DUP == 44 ? 2 : 1); ++rep44) {
        const int qlA = 2 * wid, tA = t0 + qlA, tB = tA + 1;
        unsigned wloA = 0u, whiA = 0u, wloB = 0u, whiB = 0u;
        if (tA < KTOP) {
            const int lo_ = 64 * lane;
            const unsigned long long wA_ = (lo_ + 63 <= tA) ? ~0ull : (lo_ > tA ? 0ull : ((1ull << (tA - lo_ + 1)) - 1ull)), wB_ = (lo_ + 63 <= tB) ? ~0ull : (lo_ > tB ? 0ull : ((1ull << (tB - lo_ + 1)) - 1ull));
            wloA = (unsigned)wA_; whiA = (unsigned)(wA_ >> 32); wloB = (unsigned)wB_; whiB = (unsigned)(wB_ >> 32);
        } else {
            bool doneA = false, doneB = false;
            { unsigned kvA[32], kvB[32]; float amA = 0.f, amB = 0.f;
              const int ngr = (tA >> 8) + 1;
#pragma unroll
              for (int g4 = 0; g4 < 8; ++g4) {
#pragma unroll
                  for (int e = 0; e < 4; ++e) { kvA[4 * g4 + e] = 0u; kvB[4 * g4 + e] = 0u; }
                  if (g4 < ngr) {
                      float sA[4], sB[4];
#pragma unroll
                      for (int e = 0; e < 4; ++e) { sA[e] = S[qlA * 2048 + lane + 64 * (4 * g4 + e)]; sB[e] = S[qlA * 2048 + 2048 + lane + 64 * (4 * g4 + e)]; }
                      if (g4 == ngr - 1) {
#pragma unroll
                          for (int e = 0; e < 4; ++e) { const int ki = lane + 64 * (4 * g4 + e); sA[e] = (ki <= tA) ? sA[e] : 0.f; sB[e] = (ki <= tB) ? sB[e] : 0.f; } }
#pragma unroll
                      for (int e = 0; e < 4; ++e) { kvA[4 * g4 + e] = __float_as_uint(sA[e]); amA = fmaxf(amA, fabsf(sA[e])); kvB[4 * g4 + e] = __float_as_uint(sB[e]); amB = fmaxf(amB, fabsf(sB[e])); } } }
              const unsigned umA = wave_umax(__float_as_uint(amA)), umB = wave_umax(__float_as_uint(amB));
              const float scaleA = umA ? 0.4999f / __uint_as_float(umA) : 0.f, scaleB = umB ? 0.4999f / __uint_as_float(umB) : 0.f;
#pragma unroll
              for (int g4 = 0; g4 < 8; ++g4) if (g4 < ngr) {
#pragma unroll
                  for (int e = 0; e < 4; ++e) { const int jj = 4 * g4 + e; kvA[jj] = __float_as_uint(__builtin_fmaf(__uint_as_float(kvA[jj]), scaleA, 1.5f)); kvB[jj] = __float_as_uint(__builtin_fmaf(__uint_as_float(kvB[jj]), scaleB, 1.5f)); }
                  if (g4 == ngr - 1) {
#pragma unroll
                      for (int e = 0; e < 4; ++e) { const int jj = 4 * g4 + e; kvA[jj] = (lane + 64 * jj <= tA) ? kvA[jj] : 0u; kvB[jj] = (lane + 64 * jj <= tB) ? kvB[jj] : 0u; } } }
              unsigned pfxA = 0x3F800000u, pfxB = 0x3F800000u, TvA = 0u, TvB = 0u; int needA = KTOP, needB = KTOP;
              const unsigned hwbA = (unsigned)(uintptr_t)HW, hwbB = hwbA + 1024u;
              LAS unsigned* HWB = HW + 256;
#pragma unroll 1
              for (int pass = 0; pass < 3; ++pass) {
                  const int sh = pass == 0 ? 15 : pass == 1 ? 7 : 0;
                  const unsigned lim = pass == 2 ? 128u : (256u << sh);
                  const unsigned limA = doneA ? 0u : lim, limB = doneB ? 0u : lim;
                  *(LAS v4u*)(HW + 4 * lane) = (v4u){0u, 0u, 0u, 0u}; *(LAS v4u*)(HWB + 4 * lane) = (v4u){0u, 0u, 0u, 0u};
                  asm volatile("" ::: "memory");
#pragma unroll
                  for (int g4 = 0; g4 < 8; ++g4) if (g4 < ngr) {
#pragma unroll
                      for (int e = 0; e < 4; ++e) { const unsigned dA_ = kvA[4 * g4 + e] ^ pfxA, dB_ = kvB[4 * g4 + e] ^ pfxB;
                          if (dA_ < limA) __hip_atomic_fetch_add((LAS unsigned*)(uintptr_t)(hwbA + ((dA_ >> sh) << 2)), 1u, __ATOMIC_RELAXED, __HIP_MEMORY_SCOPE_WAVEFRONT);
                          if (dB_ < limB) __hip_atomic_fetch_add((LAS unsigned*)(uintptr_t)(hwbB + ((dB_ >> sh) << 2)), 1u, __ATOMIC_RELAXED, __HIP_MEMORY_SCOPE_WAVEFRONT); } }
                  asm volatile("" ::: "memory");
                  const v4u wA4 = *(const LAS v4u*)(HW + 4 * lane), wB4 = *(const LAS v4u*)(HWB + 4 * lane);
                  asm volatile("" ::: "memory");
#define SEL_SCAN(w4_, need_, HWX_, dgb_, above_, binc_) do { \
                      const unsigned ls_ = (w4_[0] + w4_[1]) + (w4_[2] + w4_[3]); unsigned p_ = ls_; \
                      p_ += (unsigned)__builtin_amdgcn_update_dpp(0, (int)p_, 0x111, 0xF, 0xF, false); p_ += (unsigned)__builtin_amdgcn_update_dpp(0, (int)p_, 0x112, 0xF, 0xF, false); \
                      p_ += (unsigned)__builtin_amdgcn_update_dpp(0, (int)p_, 0x114, 0xF, 0xF, false); p_ += (unsigned)__builtin_amdgcn_update_dpp(0, (int)p_, 0x118, 0xF, 0xF, false); \
                      const unsigned r0_ = (unsigned)__builtin_amdgcn_readlane((int)p_, 15), r1_ = (unsigned)__builtin_amdgcn_readlane((int)p_, 31), r2_ = (unsigned)__builtin_amdgcn_readlane((int)p_, 47), r3_ = (unsigned)__builtin_amdgcn_readlane((int)p_, 63); \
                      const int row_ = lane >> 4; p_ += (row_ == 0) ? 0u : (row_ == 1) ? r0_ : (row_ == 2) ? r0_ + r1_ : r0_ + r1_ + r2_; \
                      const unsigned abl_ = (r0_ + r1_ + r2_ + r3_) - p_;                                    \
                      const unsigned long long fm_ = __ballot((int)abl_ < (need_) && (int)(abl_ + ls_) >= (need_)); \
                      const int src_ = (int)__builtin_ctzll(fm_) & 63; \
                      const unsigned abs_ = (unsigned)__builtin_amdgcn_readlane((int)abl_, src_); \
                      const unsigned ci_ = ((lane & 15) < 4) ? (HWX_)[4 * src_ + (lane & 3)] : 0u;          \
                      unsigned sfx_ = ci_; \
                      sfx_ += (unsigned)__builtin_amdgcn_update_dpp(0, (int)sfx_, 0x101, 0xF, 0xF, false); sfx_ += (unsigned)__builtin_amdgcn_update_dpp(0, (int)sfx_, 0x102, 0xF, 0xF, false); \
                      const unsigned abi_ = abs_ + sfx_ - ci_;                                                \
                      const unsigned long long fb_ = __ballot(lane < 4 && (int)abi_ < (need_) && (int)(abi_ + ci_) >= (need_)); \
                      const int sl2_ = (int)__builtin_ctzll(fb_) & 63; \
                      dgb_ = (unsigned)(4 * src_ + sl2_); above_ = (unsigned)__builtin_amdgcn_readlane((int)abi_, sl2_); binc_ = (unsigned)__builtin_amdgcn_readlane((int)ci_, sl2_); } while (0)
                  unsigned dgA, abvA, bcA, dgB, abvB, bcB;
                  SEL_SCAN(wA4, needA, HW, dgA, abvA, bcA);
                  SEL_SCAN(wB4, needB, HWB, dgB, abvB, bcB);
#undef SEL_SCAN
                  if (!doneA) { pfxA |= dgA << sh; needA -= (int)abvA; TvA = pfxA; doneA = ((int)bcA == needA); }
                  if (!doneB) { pfxB |= dgB << sh; needB -= (int)abvB; TvB = pfxB; doneB = ((int)bcB == needB); }
                  if (doneA && doneB) break;
              }
#define SEL_MASK(kv_, Tv_, wlo_, whi_) do { _Pragma("unroll") for (int j4 = 0; j4 < 8; ++j4) if (j4 < ngr) { \
                      const unsigned long long wa = __ballot(kv_[4 * j4] >= Tv_), wb = __ballot(kv_[4 * j4 + 1] >= Tv_), wc_ = __ballot(kv_[4 * j4 + 2] >= Tv_), wd = __ballot(kv_[4 * j4 + 3] >= Tv_); \
                      asm("s_nop 1\n\tv_writelane_b32 %0, %2, %10\n\tv_writelane_b32 %1, %3, %10\n\tv_writelane_b32 %0, %4, %11\n\tv_writelane_b32 %1, %5, %11\n\tv_writelane_b32 %0, %6, %12\n\tv_writelane_b32 %1, %7, %12\n\tv_writelane_b32 %0, %8, %13\n\tv_writelane_b32 %1, %9, %13" \
                          : "+v"(wlo_), "+v"(whi_) : "s"((unsigned)wa), "s"((unsigned)(wa >> 32)), "s"((unsigned)wb), "s"((unsigned)(wb >> 32)), "s"((unsigned)wc_), "s"((unsigned)(wc_ >> 32)), "s"((unsigned)wd), "s"((unsigned)(wd >> 32)), \
                            "n"(4 * j4), "n"(4 * j4 + 1), "n"(4 * j4 + 2), "n"(4 * j4 + 3)); } } while (0)
              if (doneA) SEL_MASK(kvA, TvA, wloA, whiA);
              if (doneB) SEL_MASK(kvB, TvB, wloB, whiB);
#undef SEL_MASK
            }
#pragma unroll 1
            for (int q2 = 0; q2 < 2; ++q2) {
            if (q2 == 0 ? doneA : doneB) continue;
            const int ql = qlA + q2, t = tA + q2; unsigned wlo = 0u, whi = 0u;
            unsigned uu[32];
#pragma unroll
            for (int jj = 0; jj < 32; ++jj) { const float s = S[ql * 2048 + lane + 64 * jj]; const unsigned k_ = fkey(s); uu[jj] = (lane + 64 * jj <= t) ? k_ : 0u; }
            const int ng = (t >> 8) + 1;
#define SEL_GRP(g4, CAND) if ((g4) < ng) { unsigned long long m0_, m1_, m2_, m3_; \
                    asm volatile("v_cmp_ge_u32_e64 %0, %4, %8\n\tv_cmp_ge_u32_e64 %1, %5, %8\n\tv_cmp_ge_u32_e64 %2, %6, %8\n\tv_cmp_ge_u32_e64 %3, %7, %8" \
                        : "=&s"(m0_), "=&s"(m1_), "=&s"(m2_), "=&s"(m3_) : "v"(uu[4 * (g4)]), "v"(uu[4 * (g4) + 1]), "v"(uu[4 * (g4) + 2]), "v"(uu[4 * (g4) + 3]), "v"(CAND)); \
                    cnt_ += __popcll(m0_) + __popcll(m1_) + __popcll(m2_) + __popcll(m3_); }
#define SEL_COUNT(CAND, OUT) do { int cnt_ = 0; SEL_GRP(0, CAND) SEL_GRP(1, CAND) SEL_GRP(2, CAND) SEL_GRP(3, CAND) SEL_GRP(4, CAND) SEL_GRP(5, CAND) SEL_GRP(6, CAND) SEL_GRP(7, CAND) OUT = cnt_; } while (0)
            unsigned T = 0u; int clo = t + 1;
#pragma unroll 1
            for (int bit = 31; bit >= 0; --bit) {
                const unsigned cand = T | (1u << bit); int c; SEL_COUNT(cand, c);
                if (c >= KTOP) { T = cand; clo = c; if (c == KTOP) break; }
            }
            if (clo == KTOP) {
#pragma unroll
                for (int jj = 0; jj < 32; ++jj) { const unsigned long long word = __ballot(uu[jj] >= T);
                    asm("s_nop 1\n\tv_writelane_b32 %0, %2, %4\n\tv_writelane_b32 %1, %3, %4" : "+v"(wlo), "+v"(whi) : "s"((unsigned)word), "s"((unsigned)(word >> 32)), "n"(jj));     }
            } else {
                int cgt; { const unsigned Tp = T + 1u; SEL_COUNT(Tp, cgt); }
                const int need = KTOP - cgt; int running = 0;
#pragma unroll
                for (int jj = 0; jj < 32; ++jj) {
                    const unsigned long long eq = __ballot(uu[jj] == T);
                    const int rank = (int)__builtin_amdgcn_mbcnt_hi((unsigned)(eq >> 32), __builtin_amdgcn_mbcnt_lo((unsigned)eq, 0u));
                    const unsigned long long word = __ballot(uu[jj] > T || (uu[jj] == T && running + rank < need));
                    asm("s_nop 1\n\tv_writelane_b32 %0, %2, %4\n\tv_writelane_b32 %1, %3, %4" : "+v"(wlo), "+v"(whi) : "s"((unsigned)word), "s"((unsigned)(word >> 32)), "n"(jj));
                    running += __popcll(eq);
                }
            }
            if (q2 == 0) { wloA = wlo; whiA = whi; } else { wloB = wlo; whiB = whi; }
            }
#undef SEL_COUNT
#undef SEL_GRP
        }
        if (lane < 32) { MSK[qlA * 32 + lane] = ((unsigned long long)whiA << 32) | wloA; MSK[qlA * 32 + 32 + lane] = ((unsigned long long)whiB << 32) | wloB; }
    }
    bf16x8 ss_a[4]; f32x4 ss_w[4];
    { const bf16* qrow = QI + (size_t)(MP + 4 * ss_b + (r32 >> 3)) * 512 + (r32 & 7) * 64 + 8 * hi;
#pragma unroll
      for (int s = 0; s < 4; ++s) ss_a[s] = *(const GAS bf16x8*)(qrow + 16 * s);
#pragma unroll
      for (int q = 0; q < 4; ++q) ss_w[q] = *(const GAS f32x4*)(WIp + (size_t)(MP + 4 * ss_b + q) * 8 + 4 * hi); }
    if (nj >= 16) p4_index_preload(F, b, nj, a, pwq);
    if (ss_on) { f32x16 acc = {};
#pragma unroll
        for (int s = 0; s < 4; ++s) { v4u p; p.x = pk2(ss_lo[s][0], ss_lo[s][1]); p.y = pk2(ss_lo[s][2], ss_lo[s][3]); p.z = pk2(ss_hh[s][0], ss_hh[s][1]); p.w = pk2(ss_hh[s][2], ss_hh[s][3]);
            acc = __builtin_amdgcn_mfma_f32_32x32x16_bf16(ss_a[s], __builtin_bit_cast(bf16x8, p), acc, 0, 0, 0); }
        float* SSC = WSP(float, WS_SSC);
#pragma unroll
        for (int q = 0; q < 4; ++q) {
            float sum = ss_w[q][0] * fmaxf(acc[4 * q], 0.f) + ss_w[q][1] * fmaxf(acc[4 * q + 1], 0.f) + ss_w[q][2] * fmaxf(acc[4 * q + 2], 0.f) + ss_w[q][3] * fmaxf(acc[4 * q + 3], 0.f);
            sum = xhalf_sum(sum) + 0.0f;
            if ((q >> 1) == hi) SSC[(size_t)(4 * ss_b + q) * SSTR + ss_pg * PAGE + ss_sub * 32 + r32] = sum;
        } }
    __syncthreads();
    { const int jt = tid >> 4, ql = tid & 15; MASK[((size_t)b * 32 + jt) * SEQ + t0 + ql] = MSK[ql * 32 + jt]; }
    __syncthreads();
}
__device__ __forceinline__ void p4_index(Frame& F) {
    if (F.vcu >= 256) return;
    const int b = F.vcu >> 4, w = F.vcu & 15;
    bf16x8 pa[4][4]; float pwq;
    p4_index_preload(F, b, 127 - w, pa, pwq);
#pragma unroll 1
    for (int k = 0; k < 4; ++k) { const int j1 = w + 16 * k; p4_index_unit(F, b, 127 - j1, 2 * k, pa, pwq, j1); p4_index_unit(F, b, j1, 2 * k + 1, pa, pwq, k < 3 ? 127 - (j1 + 16) : -1); }
}

__device__ __forceinline__ int block_sum8(LAS int* red, int par, int wid, int lane, int v) {
    if (lane == 0) red[par * 8 + wid] = v;
    __syncthreads();
    int s = 0;
#pragma unroll
    for (int w = 0; w < 8; ++w) s += red[par * 8 + w];
    return s;
}
__device__ __forceinline__ void p5_sample_unit(Frame& F, int sq) {
    const int tid = F.tid, lane = F.lane, wid = F.wave;
    const int b = sq >> 2, qi_ = sq & 3, row = MP + sq;
    LAS unsigned char* L0 = F.lds + RING_OFF;
    LAS int* red = (LAS int*)(L0);
    LAS float* newsc = (LAS float*)(L0 + 64);
    LAS int* wcnt = (LAS int*)(L0 + 128);
    LAS int* eqw = (LAS int*)(L0 + 256);
    LAS int* selidx = (LAS int*)(L0 + 2048);
    LAS float* LG = (LAS float*)(L0 + 4096);
    LAS float* OP = (LAS float*)(L0 + 16384);
    const bf16* QI = WSP(bf16, WS_QI); const bf16* KIB = WSP(bf16, WS_KIB); const float* WIp = WSP(float, WS_WI); const float* SSC = WSP(float, WS_SSC);
    const bf16* Qb = WSP(bf16, WS_Q); bf16* CAT = WSP(bf16, WS_CAT);
    if (tid < 64) {
        const int h = (tid >> 2) & 7, jn = tid & 3; float dot = 0.f;
        const bf16* qp = QI + (size_t)row * 512 + h * 64; const bf16* kp = KIB + (size_t)(MP + 4 * b + jn) * 64;
        for (int d = 0; d < 64; ++d) dot += bf2f(qp[d]) * bf2f(kp[d]);
        float v = WIp[(size_t)row * 8 + h] * fmaxf(dot, 0.f);
        v += __shfl_xor(v, 4); v += __shfl_xor(v, 8); v += __shfl_xor(v, 16);
        if (tid < 4) newsc[tid] = (jn <= qi_) ? (v + 0.0f) : -INFINITY;
    }
    __syncthreads();
    unsigned uu[33];
#pragma unroll
    for (int jj = 0; jj < 32; ++jj) uu[jj] = fkey(SSC[(size_t)sq * SSTR + tid + 512 * jj]);
    uu[32] = tid < 4 ? fkey(newsc[tid]) : 0x007FFFFFu;
    unsigned T = 0u; int par = 0;
#pragma unroll 1
    for (int bit = 31; bit >= 0; --bit) {
        const unsigned cand = T | (1u << bit); int c = 0;
#pragma unroll
        for (int jj = 0; jj < 33; ++jj) c += __popcll(__ballot(uu[jj] >= cand));
        c = block_sum8(red, par, wid, lane, c); par ^= 1;
        if (c >= KTOP) { T = cand; if (c == KTOP) break; }
    }
    int cgt = 0;
#pragma unroll
    for (int jj = 0; jj < 33; ++jj) cgt += __popcll(__ballot(uu[jj] > T));
    cgt = block_sum8(red, par, wid, lane, cgt); par ^= 1;
    const int need = KTOP - cgt;
#pragma unroll
    for (int jj = 0; jj < 33; ++jj) { const int n = __popcll(__ballot(uu[jj] == T)); if (lane == 0) eqw[jj * 8 + wid] = n; }
    __syncthreads();
#define SEL_MASK(jj, eqbase, M) do { int below_ = 0, tot_ = 0; \
        _Pragma("unroll") for (int w = 0; w < 8; ++w) { const int n_ = eqw[(jj) * 8 + w]; tot_ += n_; below_ += (w < wid) ? n_ : 0; } \
        const unsigned long long eq_ = __ballot(uu[jj] == T); \
        const int rank_ = (eqbase) + below_ + (int)__builtin_amdgcn_mbcnt_hi((unsigned)(eq_ >> 32), __builtin_amdgcn_mbcnt_lo((unsigned)eq_, 0u)); \
        M = __ballot(uu[jj] > T || (uu[jj] == T && rank_ < need)); (eqbase) += tot_; } while (0)
    { int cw = 0, eqbase = 0;
#pragma unroll
      for (int jj = 0; jj < 33; ++jj) { unsigned long long m; SEL_MASK(jj, eqbase, m); cw += __popcll(m); }
      if (lane == 0) wcnt[wid] = cw; }
    __syncthreads();
    { int base = 0, eqbase = 0;
#pragma unroll
      for (int w = 0; w < 8; ++w) base += (w < wid) ? wcnt[w] : 0;
#pragma unroll
      for (int jj = 0; jj < 33; ++jj) { unsigned long long m; SEL_MASK(jj, eqbase, m);
          const int pos = base + (int)__builtin_amdgcn_mbcnt_hi((unsigned)(m >> 32), __builtin_amdgcn_mbcnt_lo((unsigned)m, 0u));
          if ((m >> lane) & 1ull) { if (pos < KTOP) selidx[pos] = (jj < 32) ? tid + 512 * jj : PAST + tid; }
          base += __popcll(m); } }
#undef SEL_MASK
    __syncthreads();
    const int kk = lane >> 3, ds = lane & 7;
    const float* kptr[4]; const float* vptr[4];
#pragma unroll
    for (int it = 0; it < 4; ++it) {
        const int kidx = selidx[32 * wid + 8 * it + kk];
        if (kidx < PAST) { const size_t pr = (size_t)((const int*)F.in[6])[b * NPAGES + (kidx >> 7)] * PAGE + (kidx & 127); kptr[it] = ((const float*)F.in[2]) + pr * 128 + 8 * ds; vptr[it] = ((const float*)F.in[3]) + pr * 128 + 8 * ds; }
        else { const size_t nr = (size_t)(4 * b + (kidx - PAST)); kptr[it] = F.out + O_KS + nr * 128 + 8 * ds; vptr[it] = F.out + O_VS + nr * 128 + 8 * ds; }
    }
#pragma unroll 1
    for (int g = 0; g < 2; ++g) {
        float qv[4][8];
#pragma unroll
        for (int r = 0; r < 4; ++r) { const v4u qq = *(const GAS v4u*)(Qb + (size_t)row * 512 + (4 * g + r) * 64 + 8 * ds);
#pragma unroll
            for (int e = 0; e < 4; ++e) { qv[r][2 * e] = bf2f((unsigned short)(qq[e] & 0xffffu)); qv[r][2 * e + 1] = bf2f((unsigned short)(qq[e] >> 16)); } }
#pragma unroll
        for (int it = 0; it < 4; ++it) {
            const f32x4 k0 = *(const f32x4*)(kptr[it] + 64 * g), k1 = *(const f32x4*)(kptr[it] + 64 * g + 4);
#pragma unroll
            for (int r = 0; r < 4; ++r) {
                float d = (qv[r][0] * k0[0] + qv[r][1] * k0[1]) + (qv[r][2] * k0[2] + qv[r][3] * k0[3]) + (qv[r][4] * k1[0] + qv[r][5] * k1[1]) + (qv[r][6] * k1[2] + qv[r][7] * k1[3]);
                d += __shfl_xor(d, 1); d += __shfl_xor(d, 2); d += __shfl_xor(d, 4);
                if (ds == 0) LG[(4 * g + r) * 256 + 32 * wid + 8 * it + kk] = d;
            }
        }
    }
    __syncthreads();
    { float l[4];
#pragma unroll
      for (int e = 0; e < 4; ++e) l[e] = LG[wid * 256 + lane + 64 * e];
      const float m = wave_max(fmaxf(fmaxf(l[0], l[1]), fmaxf(l[2], l[3])));
      float p[4], s = 0.f;
#pragma unroll
      for (int e = 0; e < 4; ++e) { p[e] = __builtin_amdgcn_exp2f(l[e] - m); s += p[e]; }
      s = wave_sum(s); const float inv = 1.0f / s;
#pragma unroll
      for (int e = 0; e < 4; ++e) LG[wid * 256 + lane + 64 * e] = p[e] * inv; }
    __syncthreads();
#pragma unroll 1
    for (int g = 0; g < 2; ++g) {
        float acc[4][8];
#pragma unroll
        for (int r = 0; r < 4; ++r)
#pragma unroll
            for (int e = 0; e < 8; ++e) acc[r][e] = 0.f;
#pragma unroll
        for (int it = 0; it < 4; ++it) {
            const f32x4 v0 = *(const f32x4*)(vptr[it] + 64 * g), v1 = *(const f32x4*)(vptr[it] + 64 * g + 4);
#pragma unroll
            for (int r = 0; r < 4; ++r) { const float p = LG[(4 * g + r) * 256 + 32 * wid + 8 * it + kk];
#pragma unroll
                for (int e = 0; e < 4; ++e) { acc[r][e] += p * v0[e]; acc[r][4 + e] += p * v1[e]; } }
        }
#pragma unroll
        for (int r = 0; r < 4; ++r)
#pragma unroll
            for (int e = 0; e < 8; ++e) { float a = acc[r][e]; a += __shfl_xor(a, 8); a += __shfl_xor(a, 16); a += __shfl_xor(a, 32); if (kk == 0) OP[(wid * 8 + 4 * g + r) * 64 + 8 * ds + e] = a; }
    }
    __syncthreads();
    { const int hd = tid >> 6, d = tid & 63; float o = 0.f;
#pragma unroll
      for (int w = 0; w < 8; ++w) o += OP[(w * 8 + hd) * 64 + d];
      CAT[(size_t)row * D + 512 + hd * 64 + d] = (bf16)f2bf(o); }
    __syncthreads();
}

constexpr int N_PHASES = 9;
struct Args { const void* in[22]; float* out; unsigned char* ws; int ph_lo, ph_hi, use_bar, pad; };
__global__ void __launch_bounds__(512, 2) hymba_fwd(Args args) {
    extern __shared__ __attribute__((aligned(16))) unsigned char lds[];
    Frame F;
    F.lds = (LAS unsigned char*)lds;
    F.MISC = (volatile LAS unsigned*)(F.lds + MISC_OFF);
    F.tid = threadIdx.x; F.lane = F.tid & 63; F.wave = __builtin_amdgcn_readfirstlane(F.tid >> 6);
    F.G = gridDim.x; { const int bx = blockIdx.x; F.vcu = (F.G % 8 == 0) ? (bx % 8) * (F.G / 8) + bx / 8 : bx; }
    F.ws = args.ws; F.out = args.out; F.ctl = (gu32*)(args.ws + WS_CTL);
    F.in = args.in;
    for (int u = F.tid; u < (LDS_BYTES - LDSCTL_OFF) / 4; u += 512) ((LAS unsigned*)(F.lds + LDSCTL_OFF))[u] = 0u;
    __syncthreads();
    XcdBarrier bar; bar.bar = (unsigned*)(F.ctl + CW_BAR); bar.x = 0; bar.st = nullptr;
    if (args.use_bar) bar = xcd_barrier_post((unsigned*)(F.ctl + CW_BAR), F.MISC + 8);
    const int lo = args.ph_lo, hi = args.ph_hi;
#define IN(k) (lo <= (k) && (k) < hi)
#define SEAM(k) do { if (IN(k) && IN((k) + 1)) { xcd_barrier(bar); if (PROBE_DUP == 60) xcd_barrier(bar); } } while (0)
    const int cblk = (int)blockIdx.x;

#ifndef PROBE_DUP
#define PROBE_DUP (-1)
#endif
#define RUNPHASE(k, ...) do { if (IN(k)) { { int t_ = F.tid; asm volatile("" : "+v"(t_)); F.tid = t_; F.lane = t_ & 63; }     \
        __VA_ARGS__; if (PROBE_DUP == (k)) { if (args.use_bar) xcd_barrier(bar); __VA_ARGS__; } } SEAM(k); } while (0)
#define RSTAB ((LAS float*)(F.lds + RING_OFF + 131072))
#define GEMM_PHASE(EPI, A_, B_, N_, K_, SS_, NSLOT_, ...) do { pg8::Gemm g{A_, B_, MP, N_, K_}; pg8::StaticOrder S; S.init(MP, N_, F.G, cblk); \
        if ((NSLOT_) > 0) fill_rstd_table(RSTAB, S, SS_, NSLOT_); \
        EPI E{__VA_ARGS__}; \
        pg8::gemm_phase<EPI, pg8::StaticOrder, true, true>(F.lds + RING_OFF, g, S, E); \
        skinny_phase(F.lds + RING_OFF, A_, B_, N_, K_, cblk, F.G, E); if (PROBE_DUP == 50) skinny_phase(F.lds + RING_OFF, A_, B_, N_, K_, cblk, F.G, E); } while (0)
#define GEMM_PHASE8(EPI, A8_, B8_, A_, B_, N_, K_, SS_, NSLOT_, ...) do { pg8::Gemm g{(const bf16*)(A8_), (const bf16*)(B8_), MP, N_, (K_) / 2}; pg8::StaticOrder S; S.init(MP, N_, F.G, cblk); \
        if ((NSLOT_) > 0) fill_rstd_table(RSTAB, S, SS_, NSLOT_); \
        EPI E{__VA_ARGS__}; \
        pg8::gemm_phase<EPI, pg8::StaticOrder, true, true, 1>(F.lds + RING_OFF, g, S, E); \
        skinny_phase(F.lds + RING_OFF, A_, B_, N_, K_, cblk, F.G, E); if (PROBE_DUP == 52) skinny_phase(F.lds + RING_OFF, A_, B_, N_, K_, cblk, F.G, E); } while (0)
#define GEMM_PHASEI(EPI, A8_, B8_, XS_, A_, B_, N_, K_, SS_, NSLOT_, ...) do { pg8::Gemm g{(const bf16*)(A8_), (const bf16*)(B8_), MP, N_, (K_) / 2}; pg8::StaticOrder S; S.init(MP, N_, F.G, cblk); \
        fill_rstd_table(RSTAB, S, SS_, NSLOT_, XS_); \
        EPI E{__VA_ARGS__}; \
        pg8::gemm_phase<EPI, pg8::StaticOrder, true, true, 2>(F.lds + RING_OFF, g, S, E); \
        skinny_phase(F.lds + RING_OFF, A_, B_, N_, K_, cblk, F.G, E); if (PROBE_DUP == 52) skinny_phase(F.lds + RING_OFF, A_, B_, N_, K_, cblk, F.G, E); } while (0)
    RUNPHASE(0, do { p0_prologue(F); xcd_barrier(bar); p0b_quant_weights(F); } while (0));
    RUNPHASE(1, GEMM_PHASEI(EpiGU, WSP(unsigned char, WS_XI8), WSP(unsigned char, WS_WGU1I8), WSP(float, WS_XS), WSP(bf16, WS_XB), WSP(bf16, WS_WGU1), 2 * DFF, D, WSP(float, WS_SS0), 1, WSP(bf16, WS_H), WSP(float, WS_SS0), 1, RSTAB, 1.0f, WSP(unsigned char, WS_H8), WSP(float, WS_WSN)));
    RUNPHASE(2, GEMM_PHASE8(EpiRes<0>, WSP(unsigned char, WS_H8), WSP(unsigned char, WS_WD1_8), WSP(bf16, WS_H), WSP(bf16, WS_WD1), D, DFF, nullptr, 0, WSP(bf16, WS_XB), nullptr, WSP(bf16, WS_X1B), WSP(float, WS_SS1), nullptr, 1.0f / (W8SCALE * H8SCALE), (const float*)F.in[0], (const float*)F.in[1]));
#if PROBE_DUP >= 21 && PROBE_DUP <= 23
    if (IN(2)) { xcd_barrier(bar); pg8::Gemm g{(const bf16*)WSP(unsigned char, WS_H8), (const bf16*)WSP(unsigned char, WS_WD1_8), MP, D, DFF / 2}; pg8::StaticOrder S; S.init(MP, D, F.G, cblk);
        EpiRes<0> E{WSP(bf16, WS_XB), nullptr, WSP(bf16, WS_X2B), WSP(float, WS_SS2), nullptr, 1.0f / (W8SCALE * H8SCALE), (const float*)F.in[0], (const float*)F.in[1]};
        pg8::gemm_phase<EpiRes<0>, pg8::StaticOrder, true, true, (PROBE_DUP == 21 ? 1 : PROBE_DUP == 22 ? 2 : 0)>(F.lds + RING_OFF, g, S, E); xcd_barrier(bar); }
#endif
    RUNPHASE(3, GEMM_PHASE(EpiWin, WSP(bf16, WS_X1B), WSP(bf16, WS_WIN), NINP, D, WSP(float, WS_SS1), 16, F.ws, F.out, (const float*)F.in[15], (const float*)F.in[16], RSTAB));
    RUNPHASE(4, do { p4_conv(F); if (PROBE_DUP == 40) p4_conv(F); p4_index(F); if (PROBE_DUP == 42) p4_index(F); } while (0));
    RUNPHASE(5, do { if ((F.vcu & 1) == 0 && F.vcu < 256) { p5_sample_unit(F, F.vcu >> 1); if (PROBE_DUP == 51) p5_sample_unit(F, F.vcu >> 1); }
        const attn_body::AttnTensors AT{(const attn_body::bf16*)WSP(bf16, WS_Q), (const attn_body::bf16*)WSP(bf16, WS_KB), (const attn_body::bf16*)WSP(bf16, WS_VB), WSP(unsigned long long, WS_MASK), (attn_body::bf16*)WSP(bf16, WS_CAT)};
        const attn_body::StaticOrder S(F.vcu); attn_body::attn_phase<attn_body::StaticOrder>((char*)lds + RING_OFF, AT, S); } while (0));
    RUNPHASE(6, do { GEMM_PHASE(EpiRes<1>, WSP(bf16, WS_CAT), WSP(bf16, WS_WOUT), D, D, nullptr, 0, WSP(bf16, WS_X1B), nullptr, WSP(bf16, WS_X2B), WSP(float, WS_SS2), nullptr, 1.0f);
                     xcd_barrier(bar); quant_rows_pass(F.vcu * 8 + F.wave, F.G * 8, WSP(bf16, WS_X2B), WSP(unsigned char, WS_X2I8), WSP(float, WS_XS2), MP); } while (0));
    RUNPHASE(7, GEMM_PHASEI(EpiGU, WSP(unsigned char, WS_X2I8), WSP(unsigned char, WS_WGU2I8), WSP(float, WS_XS2), WSP(bf16, WS_X2B), WSP(bf16, WS_WGU2), 2 * DFF, D, WSP(float, WS_SS2), 16, WSP(bf16, WS_H), WSP(float, WS_SS2), 16, RSTAB, 1.0f, WSP(unsigned char, WS_H8), WSP(float, WS_WSN2)));
    RUNPHASE(8, GEMM_PHASE8(EpiRes<2>, WSP(unsigned char, WS_H8), WSP(unsigned char, WS_WD2_8), WSP(bf16, WS_H), WSP(bf16, WS_WD2), D, DFF, nullptr, 0, WSP(bf16, WS_X2B), F.out, nullptr, nullptr, nullptr, 1.0f / (W8SCALE * H8SCALE)));
#undef RUNPHASE
#undef GEMM_PHASE
#undef GEMM_PHASE8
#undef GEMM_PHASEI
#undef RSTAB
#undef IN
#undef SEAM
}

#ifndef MK_N_LAUNCHES
#define MK_N_LAUNCHES 1
#endif
extern "C" void kernel_launch(void* const* d_in, const int* in_sizes, int n_in, void* d_out, int out_size, void* d_ws, size_t ws_size, hipStream_t stream) {
    static int grid = 0;
    if (grid == 0) {
        if (n_in != 22 || out_size != (int)O_END || ws_size < WS_END) { fprintf(stderr, "kernel_launch: unexpected problem: n_in %d out %d ws %zu (need %zu)\n", n_in, out_size, ws_size, (size_t)WS_END); grid = -1; return; }
        int dev = 0, cus = 0, per_cu = 0;
        if (hipGetDevice(&dev) != hipSuccess || hipDeviceGetAttribute(&cus, hipDeviceAttributeMultiprocessorCount, dev) != hipSuccess) { grid = -1; return; }
        if (hipFuncSetAttribute((const void*)hymba_fwd, hipFuncAttributeMaxDynamicSharedMemorySize, LDS_BYTES) != hipSuccess) { fprintf(stderr, "kernel_launch: hipFuncSetAttribute failed\n"); grid = -1; return; }
        if (hipOccupancyMaxActiveBlocksPerMultiprocessor(&per_cu, (const void*)hymba_fwd, 512, LDS_BYTES) != hipSuccess || per_cu < 1) { fprintf(stderr, "kernel_launch: occupancy query says %d blocks per CU\n", per_cu); (void)hipGetLastError(); grid = -1; return; }
        grid = cus;
        if (grid % 8 != 0 || grid < 8) { fprintf(stderr, "kernel_launch: unexpected CU count %d\n", cus); grid = -1; return; }
    }
    if (grid < 0) return;
    (void)hipMemsetAsync((char*)d_ws + WS_CTL, 0, CTL_ZERO_BYTES, stream);
    Args a{};
    for (int i = 0; i < 22; ++i) a.in[i] = d_in[i];
    a.out = (float*)d_out; a.ws = (unsigned char*)d_ws;
    if (MK_N_LAUNCHES == 1) { a.ph_lo = 0; a.ph_hi = N_PHASES; a.use_bar = 1; hipLaunchKernelGGL(hymba_fwd, dim3(grid), dim3(512), LDS_BYTES, stream, a); }
    else for (int p = 0; p < N_PHASES; ++p) { a.ph_lo = p; a.ph_hi = p + 1; a.use_bar = 0; hipLaunchKernelGGL(hymba_fwd, dim3(grid), dim3(512), LDS_BYTES, stream, a); }
}
```

```cpp
#include <hip/hip_runtime.h>
#include <cstdio>
#include <cstdint>
#include <type_traits>
namespace pg8 {
#define PG8_LAS __attribute__((address_space(3)))
typedef unsigned short bf16_t;
typedef short bf16x8 __attribute__((ext_vector_type(8)));
typedef float f32x4 __attribute__((ext_vector_type(4)));
typedef unsigned u32x4 __attribute__((ext_vector_type(4)));
constexpr int BM = 256, BK = 64, HALF = 128, HTB = HALF * BK * 2  , STAGE_BYTES = 8 * HTB, NXCD = 8, WGM = 8;

__host__ __device__ __forceinline__ int lds_byte(int r, int c) { const int st = (r >> 4) * 2 + (c >> 5), rr = r & 15, cc = c & 31, ob = rr * 64 + cc * 2; return st * 1024 + (ob ^ (((ob >> 9) & 1) << 5)); }
__host__ __device__ __forceinline__ void stage_rc(int b, int& R, int& C) { const int st = b / 1024, sb = b % 1024, swz = sb ^ (((sb >> 9) & 1) << 5); R = (st >> 1) * 16 + swz / 64; C = (st & 1) * 32 + (swz % 64) / 2; }
__host__ __device__ __forceinline__ int perm32(int rho) { const int n = rho >> 4, i = rho & 15; return 8 * (i >> 2) + 4 * n + (i & 3); }

struct Unit { int pm, pn; };
struct Gemm { const bf16_t* A; const bf16_t* Bt; int M, N, K; };

struct StaticOrder {
    int nM, nN, nwg, G, c;
    __host__ __device__ void init(int M, int N, int G_, int c_) { nM = M / BM; nN = N / BM; nwg = nM * nN; G = G_; c = c_; }
    __host__ __device__ bool next(int i, Unit& u) const {
        const long L = (long)i * G + c; if (L >= nwg) return false;
        int wgid = (int)L; { const int q = nwg / NXCD, r = nwg % NXCD, xcd = wgid % NXCD, off = wgid / NXCD; wgid = (xcd < r ? xcd * (q + 1) : r * (q + 1) + (xcd - r) * q) + off; }
        const int nig = WGM * nN, gid = wgid / nig, fm = gid * WGM, gsz = (nM - fm) < WGM ? (nM - fm) : WGM;
        u.pm = fm + ((wgid % nig) % gsz); u.pn = (wgid % nig) / gsz; return true;
    }
    __device__ __forceinline__ void a_ready(const Unit&) const {}
    __device__ __forceinline__ void done(const Unit&) const {}
};
__device__ __forceinline__ unsigned cvt_pk_bf16(float lo, float hi) { unsigned r; asm volatile("v_cvt_pk_bf16_f32 %0, %1, %2" : "=v"(r) : "v"(lo), "v"(hi)); return r; }
template <class Epi, class Sched, bool ALIGN_EPI = false, bool SP2 = false, int QM = 0, int PFD = 0>
__device__ __forceinline__ void gemm_phase(PG8_LAS unsigned char* lds, const Gemm g, const Sched& S, const Epi& E) {
    const int tid = threadIdx.x, wid = __builtin_amdgcn_readfirstlane(tid >> 6), lane = tid & 63, wr = wid >> 2, wc = wid & 3, fr = lane & 15, fq = lane >> 4;
    const int K = g.K, nt = K / BK;
    unsigned voffA[2], voffB[2];
#pragma unroll
    for (int i = 0; i < 2; ++i) { int R, C; stage_rc(tid * 16 + i * 8192, R, C); const int Rb = Epi::PERM ? ((R & ~31) + perm32(R & 31)) : R;
        voffA[i] = (unsigned)(R * K + C) * 2u; voffB[i] = (unsigned)(Rb * K + C) * 2u; }
    unsigned voffP[2];
#pragma unroll
    for (int i = 0; i < 2; ++i) voffP[i] = (unsigned)((32 * wid + 16 * i + (lane >> 2)) * K) * 2u + (unsigned)(lane & 3) * 4u;
#define PG8_PF(s2, kt) do { if constexpr (PFD != 0) { const char* p_ = ((kt) < nt) ? cA + (size_t)(kt) * kstep : nA + (size_t)((kt) - nt) * kstep; \
        __builtin_amdgcn_global_load_lds((const unsigned*)(p_ + voffP[s2]), (PG8_LAS unsigned*)(lds + 143360 + wid * 256), 4, 0, 0); } } while (0)
#define PG8_WAIT_V8() do { if constexpr (PFD != 0) PG8_WAIT_V(10); else PG8_WAIT_V(8); } while (0)
    const size_t kstep = (size_t)(BK * 2);
    const size_t hstep = (size_t)HALF * K * 2;
    const size_t tstep = 2 * hstep;
    const unsigned ldsw = (unsigned)wid * 1024u;
    const int aoff = lds_byte(wr * 64 + fr, fq * 8), boff = lds_byte(wc * 32 + fr, fq * 8);
#define PG8_SA(b, h) (((b) * 2 + (h)) * HTB)
#define PG8_SB(b, h) ((4 + (b) * 2 + (h)) * HTB)
#define PG8_STAGE(bufoff, gbase, voff) do { _Pragma("unroll") for (int _i = 0; _i < 2; ++_i) \
        __builtin_amdgcn_global_load_lds((const unsigned*)((const char*)(gbase) + (voff)[_i]), (PG8_LAS unsigned*)(lds + (bufoff) + ldsw + _i * 8192), 16, 0, 0); } while (0)
#define PG8_LDF(dst_, addr_) do { if constexpr (QM == 1) { const pg8_v4i lo_ = *(const PG8_LAS pg8_v4i*)(addr_), hi_ = *(const PG8_LAS pg8_v4i*)((addr_) + 1024); \
            (dst_).v = __builtin_shufflevector(lo_, hi_, 0, 1, 2, 3, 4, 5, 6, 7); } \
        else { (dst_).k[0] = *(const PG8_LAS bf16x8*)(addr_); (dst_).k[1] = *(const PG8_LAS bf16x8*)((addr_) + 1024); } } while (0)
#define PG8_LDA(dst, b, h) do { _Pragma("unroll") for (int m = 0; m < 4; ++m) PG8_LDF(dst[m], lds + PG8_SA(b, h) + aoff + m * 2048); } while (0)
#define PG8_LDB(dst, b, h) do { _Pragma("unroll") for (int n = 0; n < 2; ++n) PG8_LDF(dst[n], lds + PG8_SB(b, h) + boff + n * 2048); } while (0)
#define PG8_MMA(ai, bj, At, Bt) do { __builtin_amdgcn_s_setprio(1); if constexpr (QM != 0) asm volatile("s_nop 4");     \
        _Pragma("unroll") for (int m = 0; m < 4; ++m) _Pragma("unroll") for (int n = 0; n < 2; ++n) { \
            if constexpr (QM == 1) asm volatile("v_mfma_scale_f32_16x16x128_f8f6f4 %0, %1, %2, %0, %3, %3 op_sel_hi:[0,0,0]" : "+v"(acc[ai][bj][m][n]) : "v"(Bt[n].v), "v"(At[m].v), "v"(scl8_));     \
            else if constexpr (QM == 2) { _Pragma("unroll") for (int k = 0; k < 2; ++k) asm volatile("v_mfma_i32_16x16x64_i8 %0, %1, %2, %0" : "+v"(acc[ai][bj][m][n]) : "v"(Bt[n].k[k]), "v"(At[m].k[k])); } \
            else { _Pragma("unroll") for (int k = 0; k < 2; ++k) acc[ai][bj][m][n] = __builtin_amdgcn_mfma_f32_16x16x32_bf16(Bt[n].k[k], At[m].k[k], acc[ai][bj][m][n], 0, 0, 0); } } \
        __builtin_amdgcn_s_setprio(0); } while (0)
#define PG8_WAIT_V(n) asm volatile("s_waitcnt vmcnt(" #n ")" ::: "memory")
#define PG8_WAIT_L(n) asm volatile("s_waitcnt lgkmcnt(" #n ")" ::: "memory")
#define PG8_BAR __builtin_amdgcn_s_barrier()
#define PG8_SCHED __builtin_amdgcn_sched_barrier(0)
    Unit cur, nxt; int ui = 0;
    if (!S.next(0, cur)) return;
    f32x4 acc[2][2][4][2];
    E.init(acc, cur, wr, wc, fr, fq);
    typedef int pg8_v8i __attribute__((ext_vector_type(8))); typedef int pg8_v4i __attribute__((ext_vector_type(4)));
    struct FragB { bf16x8 k[2]; }; struct Frag8 { pg8_v8i v; };
    typedef typename std::conditional<QM == 1, Frag8, FragB>::type Frag;
    Frag At[4], B0[2], B1[2];
    unsigned scl8_ = 0x7F7F7F7Fu; asm volatile("" : "+v"(scl8_));
    const char* cA = (const char*)g.A + (size_t)cur.pm * tstep; const char* cB = (const char*)g.Bt + (size_t)cur.pn * tstep;
    S.a_ready(cur);
    if constexpr (SP2) {
        PG8_STAGE(PG8_SB(0, 0), cB, voffB); PG8_STAGE(PG8_SB(0, 1), cB + hstep, voffB); PG8_STAGE(PG8_SA(0, 0), cA, voffA); PG8_STAGE(PG8_SA(0, 1), cA + hstep, voffA);
        if (wr == 1) PG8_BAR;
        PG8_WAIT_V(2); PG8_BAR;
        PG8_STAGE(PG8_SB(1, 0), cB + kstep, voffB); PG8_STAGE(PG8_SA(1, 0), cA + kstep, voffA); PG8_STAGE(PG8_SB(1, 1), cB + hstep + kstep, voffB);
        PG8_WAIT_V(6); PG8_BAR;
    } else {
        PG8_STAGE(PG8_SB(0, 0), cB, voffB); PG8_STAGE(PG8_SA(0, 0), cA, voffA); PG8_STAGE(PG8_SB(0, 1), cB + hstep, voffB); PG8_STAGE(PG8_SA(0, 1), cA + hstep, voffA);
        if (wr == 1) PG8_BAR;
        PG8_WAIT_V(4); PG8_BAR;
        PG8_STAGE(PG8_SB(1, 0), cB + kstep, voffB); PG8_STAGE(PG8_SA(1, 0), cA + kstep, voffA); PG8_STAGE(PG8_SB(1, 1), cB + hstep + kstep, voffB);
        PG8_WAIT_V(6); PG8_BAR;
    }
    for (;;) {
        const bool has_next = S.next(ui + 1, nxt);
        const char* nA = has_next ? (const char*)g.A + (size_t)nxt.pm * tstep : cA; const char* nB = has_next ? (const char*)g.Bt + (size_t)nxt.pn * tstep : cB;
#pragma unroll 1
        for (int t = 0; t < nt; t += 2) {
            const bool last = (t == nt - 2);
            const char* a1 = cA + (size_t)(t + 1) * kstep;
            const char* a2 = last ? nA : cA + (size_t)(t + 2) * kstep; const char* b2 = last ? nB : cB + (size_t)(t + 2) * kstep;
            const char* a3 = a2 + kstep; const char* b3 = b2 + kstep;
            if (last && has_next) S.a_ready(nxt);
            if constexpr (SP2) {
            PG8_LDB(B0, 0, 0); PG8_LDB(B1, 0, 1); PG8_SCHED; PG8_LDA(At, 0, 0); PG8_STAGE(PG8_SA(1, 1), a1 + hstep, voffA); PG8_PF(0, t + PFD);
            PG8_WAIT_V8(); PG8_WAIT_L(0); PG8_BAR; PG8_MMA(0, 0, At, B0); PG8_MMA(0, 1, At, B1); PG8_BAR; PG8_SCHED;
            PG8_LDA(At, 0, 1); PG8_STAGE(PG8_SB(0, 0), b2, voffB); PG8_STAGE(PG8_SB(0, 1), b2 + hstep, voffB); PG8_STAGE(PG8_SA(0, 0), a2, voffA); PG8_PF(1, t + PFD);
            PG8_WAIT_V8(); PG8_WAIT_L(0); PG8_BAR; PG8_MMA(1, 0, At, B0); PG8_MMA(1, 1, At, B1); PG8_BAR; PG8_SCHED;
            PG8_LDB(B0, 1, 0); PG8_LDB(B1, 1, 1); PG8_SCHED; PG8_LDA(At, 1, 0); PG8_STAGE(PG8_SA(0, 1), a2 + hstep, voffA); PG8_PF(0, t + 1 + PFD);
            PG8_WAIT_V8(); PG8_WAIT_L(0); PG8_BAR; PG8_MMA(0, 0, At, B0); PG8_MMA(0, 1, At, B1); PG8_BAR; PG8_SCHED;
            PG8_LDA(At, 1, 1); PG8_STAGE(PG8_SB(1, 0), b3, voffB); PG8_STAGE(PG8_SB(1, 1), b3 + hstep, voffB); PG8_STAGE(PG8_SA(1, 0), a3, voffA); PG8_PF(1, t + 1 + PFD);
            PG8_WAIT_V8(); PG8_WAIT_L(0); PG8_BAR; PG8_MMA(1, 0, At, B0); PG8_MMA(1, 1, At, B1); PG8_BAR; PG8_SCHED;
            } else {
            PG8_LDB(B0, 0, 0); PG8_SCHED; PG8_LDA(At, 0, 0); PG8_STAGE(PG8_SA(1, 1), a1 + hstep, voffA);
            PG8_WAIT_L(8); PG8_BAR; PG8_WAIT_L(0); PG8_MMA(0, 0, At, B0); PG8_BAR; PG8_SCHED;
            PG8_LDB(B1, 0, 1); PG8_STAGE(PG8_SB(0, 0), b2, voffB);
            PG8_BAR; PG8_WAIT_L(0); PG8_MMA(0, 1, At, B1); PG8_BAR;
            PG8_LDA(At, 0, 1); PG8_STAGE(PG8_SA(0, 0), a2, voffA);
            PG8_BAR; PG8_WAIT_L(0); PG8_MMA(1, 0, At, B0); PG8_BAR; PG8_SCHED;
            PG8_STAGE(PG8_SB(0, 1), b2 + hstep, voffB);
            PG8_WAIT_V(6); PG8_BAR; PG8_MMA(1, 1, At, B1); PG8_BAR;
            PG8_LDB(B0, 1, 0); PG8_SCHED; PG8_LDA(At, 1, 0); PG8_STAGE(PG8_SA(0, 1), a2 + hstep, voffA);
            PG8_WAIT_L(8); PG8_BAR; PG8_WAIT_L(0); PG8_MMA(0, 0, At, B0); PG8_BAR; PG8_SCHED;
            PG8_LDB(B1, 1, 1); PG8_STAGE(PG8_SB(1, 0), b3, voffB);
            PG8_BAR; PG8_WAIT_L(0); PG8_MMA(0, 1, At, B1); PG8_BAR;
            PG8_LDA(At, 1, 1); PG8_STAGE(PG8_SA(1, 0), a3, voffA);
            PG8_BAR; PG8_WAIT_L(0); PG8_MMA(1, 0, At, B0); PG8_BAR; PG8_SCHED;
            PG8_STAGE(PG8_SB(1, 1), b3 + hstep, voffB);
            PG8_WAIT_V(6); PG8_BAR; PG8_MMA(1, 1, At, B1); PG8_BAR;
            }
        }
        if constexpr (ALIGN_EPI) { if (wr == 0) PG8_BAR; }
        if constexpr (QM != 0) asm volatile("s_nop 15\n\ts_nop 7" ::: "memory");
        if constexpr (!Epi::AFTER_DRAIN) { E(acc, cur, wr, wc, fr, fq, ui, has_next, nxt);
#if defined(PROBE_DUP) && PROBE_DUP == 61
            E(acc, cur, wr, wc, fr, fq, ui, has_next, nxt);
#endif
            S.done(cur); }
        if (!has_next) break;
        cur = nxt; cA = nA; cB = nB; ++ui;
        if constexpr (ALIGN_EPI) { if (wr == 1) PG8_BAR; }
    }
    PG8_WAIT_V(0);
    if constexpr (!ALIGN_EPI) { if (wr == 0) PG8_BAR; }
    PG8_BAR;
    if constexpr (Epi::AFTER_DRAIN) { E.fused(acc, cur, wr, wc, fr, fq, lds, wid, lane); S.done(cur); }
#undef PG8_SA
#undef PG8_PF
#undef PG8_WAIT_V8
#undef PG8_SB
#undef PG8_STAGE
#undef PG8_LDA
#undef PG8_LDF
#undef PG8_LDB
#undef PG8_MMA
#undef PG8_WAIT_V
#undef PG8_WAIT_L
#undef PG8_BAR
#undef PG8_SCHED
}
}
#include <hip/hip_bf16.h>
#include <cmath>
namespace attn_body {
using bf16=__hip_bfloat16;
using bf16x8=__attribute__((ext_vector_type(8)))short;
using s16x4=__attribute__((ext_vector_type(4)))short;
using f32x16=__attribute__((ext_vector_type(16)))float;
using u32x4=__attribute__((ext_vector_type(4)))unsigned;
constexpr int BATCH=16,NHEAD=8,SEQ=2048,D=64;
constexpr int QP=512,KP=128,OP=1024,OOFF=512;
constexpr int NW=8,QBLK=32,QB=QBLK*NW,KVBLK=64,NQB=SEQ/QB;
constexpr int ATTN_UNIT_ROWS=QB;
__device__ __forceinline__ int crow(int r,int hi){return (r&3)+8*(r>>2)+4*hi;}
#define SBAR() __builtin_amdgcn_sched_barrier(0)
#define MSKV(v,W,r) __uint_as_float(__float_as_uint(v)&(unsigned)(((int)((W)<<(31-(((r)&3)+8*((r)>>2)))))>>31))
__device__ __forceinline__ void cmask(f32x16&p0,f32x16&p1,int jb,int qrel,int hi){
  const float NEG=-INFINITY; int kb=64*jb+4*hi;
  #pragma unroll
  for(int r=0;r<16;++r){int kv=kb+(r&3)+8*(r>>2); if(kv>qrel)p0[r]=NEG; if(kv+32>qrel)p1[r]=NEG;}
}

constexpr int NSLOT=3, SLOTB=8192;
constexpr int LDS_K=0, LDS_V=NSLOT*SLOTB, LDS_WS=2*NSLOT*SLOTB, LDS_OST=LDS_WS+NW*64*4, LDS_MSK=LDS_OST+NW*4096, LDS_BYTES=LDS_MSK+NW*8192;
constexpr float C2=0.125f*1.4426950408889634f;
__device__ __forceinline__ void glds16(const void*gsrc,unsigned lds_dst){unsigned keep;
  asm volatile("s_mov_b32 %0, m0\n\ts_mov_b32 m0, %2\n\ts_nop 0\n\tglobal_load_lds_dwordx4 %1, off\n\ts_mov_b32 m0, %0":"=&s"(keep):"v"(gsrc),"s"(lds_dst):"memory");}
__device__ __forceinline__ float max3f(float a,float b,float c){float r;asm("v_max3_f32 %0, %1, %2, %3":"=v"(r):"v"(a),"v"(b),"v"(c));return r;}
__device__ __forceinline__ float max2f(float a,float b){float r;asm("v_max_f32_e32 %0, %1, %2":"=v"(r):"v"(a),"v"(b));return r;}
__device__ __forceinline__ float fadd_s(float a,float b){float r;asm("v_add_f32_e32 %0, %1, %2":"=v"(r):"v"(a),"v"(b));return r;}
__device__ __forceinline__ float fsub_s(float a,float b){float r;asm("v_sub_f32_e32 %0, %1, %2":"=v"(r):"v"(a),"v"(b));return r;}
typedef float f32x2_t __attribute__((ext_vector_type(2))); typedef __bf16 bf16x2_t __attribute__((ext_vector_type(2)));
__device__ __forceinline__ unsigned cvtpk_s(float lo,float hi){f32x2_t v={lo,hi};bf16x2_t b=__builtin_convertvector(v,bf16x2_t);return __builtin_bit_cast(unsigned,b);}
#define WAIT_BAR(N) asm volatile("s_waitcnt vmcnt(" #N ") lgkmcnt(0)\n\ts_barrier":::"memory")

__device__ __forceinline__ void qkt(f32x16&p0,f32x16&p1,const char*Kslot,const bf16x8*qr,const f32x16&negm,int r32,int hi){
  const char*kb=Kslot+hi*1024+r32*16;
  #pragma unroll
  for(int d0=0;d0<4;++d0){
    const bf16x8 b0=*reinterpret_cast<const bf16x8*>(kb+d0*2048);
    const bf16x8 b1=*reinterpret_cast<const bf16x8*>(kb+d0*2048+512);
    if(d0==0){p0=__builtin_amdgcn_mfma_f32_32x32x16_bf16(b0,qr[0],negm,0,0,0);p1=__builtin_amdgcn_mfma_f32_32x32x16_bf16(b1,qr[0],negm,0,0,0);}
    else{p0=__builtin_amdgcn_mfma_f32_32x32x16_bf16(b0,qr[d0],p0,0,0,0);p1=__builtin_amdgcn_mfma_f32_32x32x16_bf16(b1,qr[d0],p1,0,0,0);}}
}
typedef __attribute__((address_space(3))) const char* lds_cptr;
typedef short v4i16_t __attribute__((ext_vector_type(4)));
__device__ __forceinline__ void kload8(bf16x8*kf,lds_cptr kp){
  kf[0]=*(const __attribute__((address_space(3))) bf16x8*)(kp);      kf[1]=*(const __attribute__((address_space(3))) bf16x8*)(kp+512);
  kf[2]=*(const __attribute__((address_space(3))) bf16x8*)(kp+2048); kf[3]=*(const __attribute__((address_space(3))) bf16x8*)(kp+2560);
  kf[4]=*(const __attribute__((address_space(3))) bf16x8*)(kp+4096); kf[5]=*(const __attribute__((address_space(3))) bf16x8*)(kp+4608);
  kf[6]=*(const __attribute__((address_space(3))) bf16x8*)(kp+6144); kf[7]=*(const __attribute__((address_space(3))) bf16x8*)(kp+6656);
}
__device__ __forceinline__ void kload2(bf16x8*kf,lds_cptr kp,int j){ kf[2*j]=*(const __attribute__((address_space(3))) bf16x8*)(kp+j*2048); kf[2*j+1]=*(const __attribute__((address_space(3))) bf16x8*)(kp+j*2048+512); }
__device__ __forceinline__ s16x4 vtr(lds_cptr p){ return __builtin_bit_cast(s16x4,__builtin_amdgcn_ds_read_tr16_b64_v4i16((__attribute__((address_space(3))) v4i16_t*)p)); }
__device__ __forceinline__ float rowmax(const f32x16&p0,const f32x16&p1){
  float a=max3f(p0[0],p0[1],p1[0]),b=max3f(p0[2],p0[3],p1[1]);a=max3f(a,p1[2],p1[3]);
  #pragma unroll
  for(int r=4;r<16;r+=4){a=max3f(a,p0[r],p0[r+1]);b=max3f(b,p0[r+2],p0[r+3]);a=max3f(a,p1[r],p1[r+1]);b=max3f(b,p1[r+2],p1[r+3]);}
  const float m=max2f(a,b);
  auto rr=__builtin_amdgcn_permlane32_swap(__float_as_uint(m),__float_as_uint(m),false,false);
  return max2f(__uint_as_float(rr[0]),__uint_as_float(rr[1]));
}
__device__ __forceinline__ void pv(f32x16*o,int vb,bf16x8 pa0,bf16x8 pa1,bf16x8 pa2,bf16x8 pa3){
  #pragma unroll
  for(int d0=0;d0<2;++d0){s16x4 lo[4],hi[4];
    #pragma unroll
    for(int ks=0;ks<4;++ks){
      asm volatile("ds_read_b64_tr_b16 %0,%1 offset:%c2":"=&v"(lo[ks]):"v"(vb),"i"(d0*4096+ks*1024):"memory");
      asm volatile("ds_read_b64_tr_b16 %0,%1 offset:%c2":"=&v"(hi[ks]):"v"(vb),"i"(d0*4096+ks*1024+512):"memory");}
    asm volatile("s_waitcnt lgkmcnt(0)":::"memory");SBAR();
    #define PK(k) (bf16x8){lo[k][0],lo[k][1],lo[k][2],lo[k][3],hi[k][0],hi[k][1],hi[k][2],hi[k][3]}
    o[d0]=__builtin_amdgcn_mfma_f32_32x32x16_bf16(pa0,PK(0),o[d0],0,0,0);
    o[d0]=__builtin_amdgcn_mfma_f32_32x32x16_bf16(pa1,PK(1),o[d0],0,0,0);
    o[d0]=__builtin_amdgcn_mfma_f32_32x32x16_bf16(pa2,PK(2),o[d0],0,0,0);
    o[d0]=__builtin_amdgcn_mfma_f32_32x32x16_bf16(pa3,PK(3),o[d0],0,0,0);
    #undef PK
  }
}

#ifndef ATTN_STORE16
#define ATTN_STORE16(p,v) (*(u32x4*)(p)=(v))
#endif
template<int THRL> __device__ __forceinline__ void attn_unit(int b,int h,int qb,const bf16*Q,const bf16*K,const bf16*V,const unsigned long long*MK,bf16*O,char*shm){
  const int tid=threadIdx.x,lane=tid&63,r32=lane&31,hi=lane>>5; const int wid=__builtin_amdgcn_readfirstlane(tid>>6);
  const long rowbase=(long)b*SEQ; const int q0=qb*QB;
  const bf16*Qw=Q+(rowbase+q0+wid*QBLK)*QP+h*D;
  const bf16*Kh=K+rowbase*KP+(h>>2)*D,*Vh=V+rowbase*KP+(h>>2)*D;
  const unsigned lds0=(unsigned)(uintptr_t)shm;
  float*wsf=(float*)(shm+LDS_WS)+wid*64;
  const bf16*ksrc=Kh+(long)lane*KP+wid*8;
  const bf16*vsrc=Vh+(long)(16*(wid&3)+(lane>>2))*KP+(wid>>2)*32+(lane&3)*8;
  const unsigned kdst=lds0+LDS_K+wid*1024, vdst=lds0+LDS_V+wid*1024;
  #define DMA_K(t,slot) glds16(ksrc+(long)(t)*KVBLK*KP,(unsigned)__builtin_amdgcn_readfirstlane(kdst+(slot)))
  #define DMA_V(t,slot) glds16(vsrc+(long)(t)*KVBLK*KP,(unsigned)__builtin_amdgcn_readfirstlane(vdst+(slot)))
  const int vb0=(int)(lds0+LDS_V)+((lane>>4)&1)*32+(lane&3)*8+(4*hi+((lane&15)>>2))*64;
  const char*Kbase=shm+LDS_K; bf16x8 kf[8];
  const lds_cptr shm3=(lds_cptr)shm; const lds_cptr kp0=shm3+LDS_K+hi*1024+r32*16; const lds_cptr vp0=shm3+LDS_V+((lane>>4)&1)*32+(lane&3)*8+(4*hi+((lane&15)>>2))*64;
  const int NT=(q0+QB)/KVBLK;
  const __attribute__((address_space(3))) char* shm3m=(const __attribute__((address_space(3))) char*)shm;
  typedef __attribute__((address_space(3))) unsigned long long* lds_u64p;
  const lds_u64p mskw=(lds_u64p)(shm3m+LDS_MSK+wid*8192);
  unsigned long long mtmp[16];
  { const unsigned long long*mq=MK+(q0+wid*QBLK+r32);
    #pragma unroll
    for(int i=0;i<16;++i){int tt=2*i+hi; tt=tt<NT?tt:NT-1; mtmp[i]=mq[(long)tt*SEQ];} }
  DMA_K(0,0);DMA_V(0,0);DMA_K(1,SLOTB);
  bf16x8 qr[4];
  #pragma unroll
  for(int d0=0;d0<4;++d0)qr[d0]=*reinterpret_cast<const bf16x8*>(&Qw[(long)r32*QP+d0*16+hi*8]);
  float mhat=0.f,l_reg=0.f;f32x16 o[2];o[0]=f32x16{};o[1]=f32x16{};f32x16 negm=f32x16{};asm volatile("":"+v"(negm));
  const int qrel=wid*QBLK+r32;
  #define CMASK(P0,P1,t) do{int jb_=(t)-(NT-4); if(jb_>=0)cmask(P0,P1,jb_,qrel,hi);}while(0)
  bool resc=false;
  #define START(P0,P1) do{ const float rm=rowmax(P0,P1); resc=false; \
    { const float dl=rm; mhat=fadd_s(mhat,dl); \
      _Pragma("unroll") for(int r=0;r<16;++r){P0[r]=fsub_s(P0[r],dl);P1[r]=fsub_s(P1[r],dl);} \
      _Pragma("unroll") for(int r=0;r<16;++r)negm[r]=-mhat; asm volatile("":"+v"(negm)); } \
    _Pragma("unroll") for(int r=0;r<16;++r)P0[r]=__builtin_amdgcn_exp2f(P0[r]); }while(0)
  #define RESC() do{ if(resc){ asm volatile("s_waitcnt lgkmcnt(0)":::"memory"); \
      _Pragma("unroll") for(int d_=0;d_<2;++d_) _Pragma("unroll") for(int r=0;r<16;++r)o[d_][r]*=wsf[crow(r,hi)]; } }while(0)
  f32x16 pA0,pA1,pB0,pB1;
  int sl_prev=0,sl_cur=0,sl_next=SLOTB;
  #define ROT() do{sl_prev=sl_cur;sl_cur=sl_next;sl_next=(sl_next==(NSLOT-1)*SLOTB)?0:sl_next+SLOTB;}while(0)
  DMA_K(2,2*SLOTB);
  WAIT_BAR(3);
  #pragma unroll
  for(int i=0;i<16;++i)mskw[(2*i+hi)*32+r32]=mtmp[i];
  #define MLOAD(t,LO,HI) do{ const unsigned long long mw_=mskw[(t)*32+r32]; LO=((unsigned)mw_)>>(4*hi); HI=((unsigned)(mw_>>32))>>(4*hi); }while(0)
  unsigned mlo,mhi; MLOAD(0,mlo,mhi);
  qkt(pA0,pA1,Kbase,qr,negm,r32,hi);asm volatile("s_nop 15\n\ts_nop 7":"+v"(pA0),"+v"(pA1));
  START(pA0,pA1);
  _Pragma("unroll") for(int r=0;r<16;++r)pA1[r]=__builtin_amdgcn_exp2f(pA1[r]);
  _Pragma("unroll") for(int r=0;r<16;++r){pA0[r]=MSKV(pA0[r],mlo,r);pA1[r]=MSKV(pA1[r],mhi,r);}
  WAIT_BAR(0);
  DMA_K(3,0);DMA_V(1,SLOTB);
  ROT();
  kload8(kf,kp0+sl_cur);
  WAIT_BAR(2);
  s16x4 vlo[8],vhi[8]; u32x4 pw0,pw1,pw2,pw3;
  #define PKW(P,B) cvtpk_s(P[B],P[B+1])
  #define PAF(k) __builtin_bit_cast(bf16x8,pw##k)
  #define VFR(i) (bf16x8){vlo[i][0],vlo[i][1],vlo[i][2],vlo[i][3],vhi[i][0],vhi[i][1],vhi[i][2],vhi[i][3]}
  #define PIN(x) asm volatile("":"+v"(x))
  #define MX3(a,b,c) __builtin_fmaxf(__builtin_fmaxf((a),(b)),(c))
  #define GAPA(MF,A0,A1,A2,A3,W0,W1,PW) do{ MF; sacc+=A0; sacc+=A1; sacc+=A2; sacc+=A3; PIN(sacc); W0; W1; PIN(PW); SBAR(); }while(0)
  #define EX(v) __builtin_amdgcn_exp2f(v)
  #define GAPB(MF,X,B,W) do{ MF; X[B]=MSKV(EX(X[B]),W,B); X[B+1]=MSKV(EX(X[B+1]),W,B+1); X[B+2]=MSKV(EX(X[B+2]),W,B+2); X[B+3]=MSKV(EX(X[B+3]),W,B+3); PIN(X); SBAR(); }while(0)
  #define VRD(i) do{ vlo[i]=vtr(vp_+(((i)>>2)*4096+((i)&3)*1024)); vhi[i]=vtr(vp_+(((i)>>2)*4096+((i)&3)*1024+512)); }while(0)
  #define KRD(G,j) do{ if(G){ kload2(kf,kp0+sl_next,j); SBAR(); } }while(0)
  #define STEP(C0,C1,P0,P1,t,GK,GV,GL) do{ SBAR(); \
    const lds_cptr vp_=vp0+sl_prev; MLOAD(t,mlo,mhi); \
    VRD(0); SBAR(); float sacc=(P0[0]+P0[1]); \
    GAPA(C0=__builtin_amdgcn_mfma_f32_32x32x16_bf16(kf[0],qr[0],negm,0,0,0), P0[2],P0[3],P0[4],P0[5],     pw0[0]=PKW(P0,0), pw0[1]=PKW(P0,2), pw0); \
    VRD(4); SBAR(); GAPA(C1=__builtin_amdgcn_mfma_f32_32x32x16_bf16(kf[1],qr[0],negm,0,0,0), P0[6],P0[7],P0[8],P0[9],     pw0[2]=PKW(P0,4), pw0[3]=PKW(P0,6), pw0); \
    VRD(1); SBAR(); GAPA(C0=__builtin_amdgcn_mfma_f32_32x32x16_bf16(kf[2],qr[1],C0,0,0,0),   P0[10],P0[11],P0[12],P0[13], pw1[0]=PKW(P0,8), pw1[1]=PKW(P0,10), pw1); \
    VRD(5); SBAR(); GAPA(C1=__builtin_amdgcn_mfma_f32_32x32x16_bf16(kf[3],qr[1],C1,0,0,0),   P0[14],P0[15],P1[0],P1[1],   pw1[2]=PKW(P0,12),pw1[3]=PKW(P0,14), pw1); \
    VRD(2); SBAR(); GAPA(C0=__builtin_amdgcn_mfma_f32_32x32x16_bf16(kf[4],qr[2],C0,0,0,0),   P1[2],P1[3],P1[4],P1[5],     pw2[0]=PKW(P1,0), pw2[1]=PKW(P1,2), pw2); \
    VRD(6); SBAR(); GAPA(C1=__builtin_amdgcn_mfma_f32_32x32x16_bf16(kf[5],qr[2],C1,0,0,0),   P1[6],P1[7],P1[8],P1[9],     pw2[2]=PKW(P1,4), pw2[3]=PKW(P1,6), pw2); \
    VRD(3); SBAR(); GAPA(C0=__builtin_amdgcn_mfma_f32_32x32x16_bf16(kf[6],qr[3],C0,0,0,0),   P1[10],P1[11],P1[12],P1[13], pw3[0]=PKW(P1,8), pw3[1]=PKW(P1,10), pw3); \
    VRD(7); SBAR(); GAPA(C1=__builtin_amdgcn_mfma_f32_32x32x16_bf16(kf[7],qr[3],C1,0,0,0),   P1[14],P1[15],0.f,0.f,       pw3[2]=PKW(P1,12),pw3[3]=PKW(P1,14), pw3); \
    l_reg+=sacc; \
    if(GK){DMA_K((t)+3,sl_cur);} if(GV){DMA_V((t)+1,sl_next);} \
    { float a=MX3(C0[0],C0[1],C1[0]),b=MX3(C0[2],C0[3],C1[1]); a=MX3(a,C1[2],C1[3]); \
      _Pragma("unroll") for(int r=4;r<16;r+=4){a=MX3(a,C0[r],C0[r+1]);b=MX3(b,C0[r+2],C0[r+3]);a=MX3(a,C1[r],C1[r+1]);b=MX3(b,C1[r+2],C1[r+3]);} \
      float rm=__builtin_fmaxf(a,b); { auto rr=__builtin_amdgcn_permlane32_swap(__float_as_uint(rm),__float_as_uint(rm),false,false); rm=__builtin_fmaxf(__uint_as_float(rr[0]),__uint_as_float(rr[1])); } \
      resc=false; \
      if(__builtin_expect(__any(rm>(float)THRL),0)){ const float dl=__builtin_fmaxf(rm,0.f); mhat+=dl; \
        _Pragma("unroll") for(int r=0;r<16;++r){C0[r]-=dl;C1[r]-=dl;} \
        _Pragma("unroll") for(int r=0;r<16;++r)negm[r]=-mhat; asm volatile("":"+v"(negm)); \
        const float f=__builtin_amdgcn_exp2f(-dl); l_reg*=f; if(hi==0)wsf[r32]=f; resc=true; } } \
    SBAR(); \
    GAPB(o[0]=__builtin_amdgcn_mfma_f32_32x32x16_bf16(PAF(0),VFR(0),o[0],0,0,0), C0,0,mlo); \
    GAPB(o[1]=__builtin_amdgcn_mfma_f32_32x32x16_bf16(PAF(0),VFR(4),o[1],0,0,0), C0,4,mlo); \
    KRD(GL,0); GAPB(o[0]=__builtin_amdgcn_mfma_f32_32x32x16_bf16(PAF(1),VFR(1),o[0],0,0,0), C0,8,mlo); \
    KRD(GL,1); GAPB(o[1]=__builtin_amdgcn_mfma_f32_32x32x16_bf16(PAF(1),VFR(5),o[1],0,0,0), C0,12,mlo); \
    KRD(GL,2); GAPB(o[0]=__builtin_amdgcn_mfma_f32_32x32x16_bf16(PAF(2),VFR(2),o[0],0,0,0), C1,0,mhi); \
    KRD(GL,3); GAPB(o[1]=__builtin_amdgcn_mfma_f32_32x32x16_bf16(PAF(2),VFR(6),o[1],0,0,0), C1,4,mhi); \
    GAPB(o[0]=__builtin_amdgcn_mfma_f32_32x32x16_bf16(PAF(3),VFR(3),o[0],0,0,0), C1,8,mhi); \
    GAPB(o[1]=__builtin_amdgcn_mfma_f32_32x32x16_bf16(PAF(3),VFR(7),o[1],0,0,0), C1,12,mhi); \
    }while(0)
  int t=1;
  #undef CMASK
  #define CMASK(P0,P1,t) do{}while(0)
  for(;t+5<NT;t+=2){
    STEP(pB0,pB1,pA0,pA1,t,true,true,true);     WAIT_BAR(2); RESC(); ROT();
    STEP(pA0,pA1,pB0,pB1,t+1,true,true,true);   WAIT_BAR(2); RESC(); ROT();
  }
  #undef CMASK
  #define CMASK(P0,P1,t) do{int jb_=(t)-(NT-4); if(jb_>=0)cmask(P0,P1,jb_,qrel,hi);}while(0)
  #define ENDW(tt) do{ if((tt)+3<NT){WAIT_BAR(2);} else if((tt)+2<NT){WAIT_BAR(1);} else {WAIT_BAR(0);} }while(0)
  for(;t+1<NT;t+=2){
    STEP(pB0,pB1,pA0,pA1,t,(t+3<NT),(t+1<NT),(t+1<NT));       ENDW(t);   RESC(); ROT();
    STEP(pA0,pA1,pB0,pB1,t+1,(t+4<NT),(t+2<NT),(t+2<NT));     ENDW(t+1); RESC(); ROT();
  }
  STEP(pB0,pB1,pA0,pA1,NT-1,false,false,false); RESC();
  { float sacc=pB0[0]+pB0[1]; _Pragma("unroll") for(int r=2;r<16;++r)sacc+=pB0[r]; _Pragma("unroll") for(int r=0;r<16;++r)sacc+=pB1[r]; l_reg+=sacc;
    pw0=(u32x4){PKW(pB0,0),PKW(pB0,2),PKW(pB0,4),PKW(pB0,6)};pw1=(u32x4){PKW(pB0,8),PKW(pB0,10),PKW(pB0,12),PKW(pB0,14)};pw2=(u32x4){PKW(pB1,0),PKW(pB1,2),PKW(pB1,4),PKW(pB1,6)};pw3=(u32x4){PKW(pB1,8),PKW(pB1,10),PKW(pB1,12),PKW(pB1,14)};
    SBAR(); pv(o,vb0+sl_cur,PAF(0),PAF(1),PAF(2),PAF(3)); }
  #undef PKW
  #undef PAF
  #undef VFR
  #undef PIN
  #undef MX3
  #undef GAPA
  #undef GAPB
  #undef EX
  #undef VRD
  #undef KRD
  #undef STEP
  #undef ENDW
  {auto rr=__builtin_amdgcn_permlane32_swap(__float_as_uint(l_reg),__float_as_uint(l_reg),false,false);l_reg=__uint_as_float(rr[0])+__uint_as_float(rr[1]);}
  if(hi==0)wsf[32+r32]=l_reg;asm volatile("s_waitcnt lgkmcnt(0)":::"memory");
  float rli[16];
  #pragma unroll
  for(int r=0;r<16;++r)rli[r]=__builtin_amdgcn_rcpf(wsf[32+crow(r,hi)]);
  bf16*Ow=O+(rowbase+q0+wid*QBLK)*OP+OOFF+h*D;
  { bf16*stg=(bf16*)(shm+LDS_OST)+wid*2048;
    #pragma unroll
    for(int r=0;r<16;++r){const int orow=crow(r,hi);
      #pragma unroll
      for(int d0=0;d0<2;++d0)stg[orow*64+d0*32+r32]=__float2bfloat16(o[d0][r]*rli[r]);}
    asm volatile("s_waitcnt lgkmcnt(0)":::"memory");
    #pragma unroll
    for(int i=0;i<4;++i){const int row=i*8+(lane>>3),ch=lane&7; const u32x4 v=*(const u32x4*)(stg+row*64+ch*8); ATTN_STORE16(Ow+(long)row*OP+ch*8,v);} }
  asm volatile("s_waitcnt lgkmcnt(0)\n\ts_barrier":::"memory");
  #undef DMA_K
  #undef DMA_V
  #undef CMASK
  #undef START
  #undef RESC
  #undef ROT
}
constexpr int ATTN_LDS_BYTES=LDS_BYTES;
struct AttnTensors { const bf16* Q; const bf16* K; const bf16* V; const unsigned long long* MK; bf16* O; };
struct AttnUnit { int bh; int qb; };
struct StaticOrder {
  int vcu;
  __device__ __forceinline__ explicit StaticOrder(int vcu_):vcu(vcu_){}
  __device__ __forceinline__ bool next(int i,AttnUnit&u)const{ if(vcu>=256)return false; const int s=vcu&1; u.bh=vcu>>1; if(s){ if(i>=5)return false; u.qb=5-i; } else { if(i>=3)return false; u.qb=(i==0)?7:(i==1)?6:0; } return true; }
};
template<class Sched,int THRL=8> __device__ __forceinline__ void attn_phase(char*lds,const AttnTensors&T,const Sched&S){
  AttnUnit u;
  for(int i=0;S.next(i,u);++i){ const int b=u.bh/NHEAD; attn_unit<THRL>(b,u.bh%NHEAD,u.qb,T.Q,T.K,T.V,T.MK+(long)b*32*SEQ,T.O,lds); }
}
#undef SBAR
#undef WAIT_BAR
}
#ifndef PROBE_DUP
#define PROBE_DUP (-1)
#endif
constexpr int D = 1024, NB = 16, SEQ = 2048, MP = NB * SEQ, DB = 32, DS = 4, MS = DB * DS, MTOT = MP + MS, MPAD = 33024;
constexpr int DFF = 2816, NIN = 2888, NINP = 3072, DCONV = 512;
constexpr int PAST = 16384, PAGE = 128, NPAGES = 128, KTOP = 256;
constexpr float EPS = 1e-6f, LOG2E = 1.4426950408889634f;
constexpr float QSCALE = 0.125f * LOG2E;
constexpr size_t O_YP = 0, O_YS = O_YP + (size_t)MP * D, O_KP = O_YS + (size_t)MS * D, O_VP = O_KP + (size_t)MP * 128, O_IP = O_VP + (size_t)MP * 128,
                 O_CP = O_IP + (size_t)MP * 64, O_KS = O_CP + 16 * 2 * 512, O_VS = O_KS + MS * 128, O_IS = O_VS + MS * 128, O_CS = O_IS + MS * 64, O_END = O_CS + 32 * 2 * 512;
static_assert(O_END == 44261376, "output size");

constexpr size_t al(size_t x) { return (x + 0xFFFFF) & ~(size_t)0xFFFFF; }
constexpr size_t WS_CTL = 0, CTL_ZERO_BYTES = 1u << 20;
constexpr size_t WS_ROPE = al(WS_CTL + CTL_ZERO_BYTES);
constexpr size_t WS_WGU1 = al(WS_ROPE + 2052 * 8 * 2 * 4);
constexpr size_t WS_WD1 = al(WS_WGU1 + (size_t)2 * DFF * D * 2);
constexpr size_t WS_WIN = al(WS_WD1 + (size_t)D * DFF * 2);
constexpr size_t WS_WOUT = al(WS_WIN + (size_t)NINP * D * 2);
constexpr size_t WS_WGU2 = al(WS_WOUT + (size_t)D * D * 2);
constexpr size_t WS_WD2 = al(WS_WGU2 + (size_t)2 * DFF * D * 2);
constexpr size_t WS_XB = al(WS_WD2 + (size_t)D * DFF * 2);
constexpr size_t WS_SS0 = al(WS_XB + (size_t)MPAD * D * 2);
constexpr size_t WS_SS1 = al(WS_SS0 + (size_t)MPAD * 4);
constexpr size_t WS_SS2 = al(WS_SS1 + (size_t)MPAD * 64);
constexpr size_t WS_H = al(WS_SS2 + (size_t)MPAD * 64);
constexpr size_t WS_X1 = al(WS_H + (size_t)MPAD * DFF * 2);
constexpr size_t WS_X1B = al(WS_X1 + (size_t)MPAD * D * 4);
constexpr size_t WS_X2 = al(WS_X1B + (size_t)MPAD * D * 2);
constexpr size_t WS_X2B = al(WS_X2 + (size_t)MPAD * D * 4);
constexpr size_t WS_U = al(WS_X2B + (size_t)MPAD * D * 2);
constexpr size_t WS_GB = al(WS_U + (size_t)MPAD * 512 * 2);
constexpr size_t WS_Q = al(WS_GB + (size_t)MPAD * 512 * 2);
constexpr size_t WS_QI = al(WS_Q + (size_t)MPAD * 512 * 2);
constexpr size_t WS_KB = al(WS_QI + (size_t)MPAD * 512 * 2);
constexpr size_t WS_VB = al(WS_KB + (size_t)MPAD * 128 * 2);
constexpr size_t WS_KIB = al(WS_VB + (size_t)MPAD * 128 * 2);
constexpr size_t WS_WI = al(WS_KIB + (size_t)MPAD * 64 * 2);
constexpr size_t WS_CAT = al(WS_WI + (size_t)MPAD * 8 * 4);
constexpr size_t WS_MASK = al(WS_CAT + (size_t)MPAD * D * 2);
constexpr int SSTR = 16384;
constexpr size_t WS_SSC = al(WS_MASK + (size_t)NB * 32 * SEQ * 8);
constexpr size_t WS_XB8 = al(WS_SSC + (size_t)MS * SSTR * 4);
constexpr size_t WS_X2B8 = al(WS_XB8 + (size_t)MPAD * D);
constexpr size_t WS_WGU1_8 = al(WS_X2B8 + (size_t)MPAD * D);
constexpr size_t WS_WGU2_8 = al(WS_WGU1_8 + (size_t)2 * DFF * D);
constexpr size_t WS_WD2_8 = al(WS_WGU2_8 + (size_t)2 * DFF * D);
constexpr size_t WS_H8 = al(WS_WD2_8 + (size_t)D * DFF);
constexpr size_t WS_XI8 = al(WS_H8 + (size_t)MPAD * DFF);
constexpr size_t WS_XS = al(WS_XI8 + (size_t)MPAD * D);
constexpr size_t WS_WGU1I8 = al(WS_XS + (size_t)MPAD * 4);
constexpr size_t WS_WSN = al(WS_WGU1I8 + (size_t)2 * DFF * D);
constexpr size_t WS_X2I8 = al(WS_WSN + (size_t)2 * DFF * 4);
constexpr size_t WS_XS2 = al(WS_X2I8 + (size_t)MPAD * D);
constexpr size_t WS_WGU2I8 = al(WS_XS2 + (size_t)MPAD * 4);
constexpr size_t WS_WSN2 = al(WS_WGU2I8 + (size_t)2 * DFF * D);
constexpr size_t WS_WD1_8 = al(WS_WSN2 + (size_t)2 * DFF * 4);
constexpr size_t WS_END = al(WS_WD1_8 + (size_t)D * DFF);
constexpr float H8SCALE = 4.0f;
constexpr float W8SCALE = 32.0f;

constexpr int CW_TMO = 0, CW_CODE = 1, CW_BAR = 4096;

constexpr int RING_OFF = 0, RING_BYTES = 152576;
constexpr int LDSCTL_OFF = RING_BYTES, MISC_OFF = LDSCTL_OFF + 320;
constexpr int LDS_BYTES = 158720;
static_assert(MISC_OFF + 128 <= LDS_BYTES && attn_body::ATTN_LDS_BYTES <= RING_BYTES && pg8::STAGE_BYTES <= RING_BYTES, "LDS map");

#define GAS __attribute__((address_space(1)))
#define LAS __attribute__((address_space(3)))
typedef unsigned short bf16;
typedef unsigned v4u __attribute__((ext_vector_type(4)));
typedef unsigned v2u __attribute__((ext_vector_type(2)));
typedef float f32x4 __attribute__((ext_vector_type(4)));
typedef float f32x16 __attribute__((ext_vector_type(16)));
typedef short bf16x8 __attribute__((ext_vector_type(8)));
typedef GAS unsigned gu32;
#define RLX_AGENT __ATOMIC_RELAXED, __HIP_MEMORY_SCOPE_AGENT
#define LDS_WAIT() asm volatile("s_waitcnt lgkmcnt(0)" ::: "memory")
#define VM_WAIT() asm volatile("s_waitcnt vmcnt(0)" ::: "memory")
__device__ __forceinline__ unsigned f2bf(float f) { unsigned u = __builtin_bit_cast(unsigned, f); return (u + 0x7fffu + ((u >> 16) & 1u)) >> 16; }
__device__ __forceinline__ unsigned pk2(float lo, float hi) { return f2bf(lo) | (f2bf(hi) << 16); }
__device__ __forceinline__ float bf2f(unsigned short h) { return __builtin_bit_cast(float, (unsigned)h << 16); }
__device__ __forceinline__ float wave_sum(float v) {
#pragma unroll
    for (int o = 1; o < 64; o <<= 1) v += __shfl_xor(v, o);
    return v;
}
__device__ __forceinline__ float wave_max(float v) {
#pragma unroll
    for (int o = 1; o < 64; o <<= 1) v = fmaxf(v, __shfl_xor(v, o));
    return v;
}

#define XB_TMO      128
#define XB_XCNT(j)  (256  + 64 * (j))
#define XB_XSUB(j)  (1280 + 64 * (j))
#define XB_XGEN(j)  (2304 + 64 * (j))
#define XB_TOP      3328
#define XB_TOPGEN   3392
#define XCD_BAR_WORDS 3456
#define XB_SPIN_CAP (1u << 18)

__device__ __forceinline__ unsigned xb_ld(unsigned* p)              { return __hip_atomic_load(p, __ATOMIC_RELAXED, __HIP_MEMORY_SCOPE_AGENT); }
__device__ __forceinline__ unsigned xb_add(unsigned* p, unsigned v) { return __hip_atomic_fetch_add(p, v, __ATOMIC_RELAXED, __HIP_MEMORY_SCOPE_AGENT); }
__device__ __forceinline__ unsigned xb_xcc_id() { return (unsigned)__builtin_amdgcn_s_getreg((3 << 11) | 20) & 0xFu; }
#define XB_SPIN(cond, bar) do { unsigned _sp = 0; while (cond) { __builtin_amdgcn_s_sleep(1); \
    if ((++_sp & 255u) == 0u) { if (xb_ld(&(bar)[XB_TMO])) break; if (_sp > XB_SPIN_CAP) { atomicAdd(&(bar)[XB_TMO], 1u); break; } } } } while (0)

struct XcdBarrier {
    unsigned* bar; unsigned x;
    volatile LAS unsigned* st;
};

__device__ __forceinline__ XcdBarrier xcd_barrier_post(unsigned* bar, volatile LAS unsigned* st) {
    XcdBarrier b; b.bar = bar; b.x = xb_xcc_id(); b.st = st;
    if (threadIdx.x == 0) (void)xb_add(&bar[XB_XCNT(b.x)], 1u);
    return b;
}
__device__ __forceinline__ void xcd_barrier_complete(unsigned* bar, unsigned x, unsigned& nloc, unsigned& nx) {
    const unsigned G = gridDim.x * gridDim.y * gridDim.z;
    unsigned sum, cnt, mine, sp = 0u;
    for (;;) {
        sum = 0u; cnt = 0u; mine = 0u;
#pragma unroll
        for (unsigned j = 0; j < 16; ++j) { const unsigned c = xb_ld(&bar[XB_XCNT(j)]); sum += c; cnt += (c > 0u) ? 1u : 0u; mine = (j == x) ? c : mine; }
        if (sum == G) break;
        __builtin_amdgcn_s_sleep(1);
        if ((++sp & 255u) == 0u) { if (xb_ld(&bar[XB_TMO])) break; if (sp > XB_SPIN_CAP) { atomicAdd(&bar[XB_TMO], 1u); break; } }
    }
    nloc = mine > 0u ? mine : 1u; nx = cnt > 0u ? cnt : 1u;
}

__device__ __forceinline__ void xcd_barrier(const XcdBarrier& b) {
    asm volatile("s_waitcnt vmcnt(0)" ::: "memory");
    __syncthreads();
    if (threadIdx.x == 0) {
        unsigned* bar = b.bar;
        __builtin_amdgcn_s_waitcnt(0);
        unsigned nloc = b.st[0], nx = b.st[1];
        if (nloc == 0u) { xcd_barrier_complete(bar, b.x, nloc, nx); b.st[0] = nloc; b.st[1] = nx; }
        const unsigned old = xb_add(&bar[XB_XSUB(b.x)], 1u);
        const unsigned gen = old / nloc;
        if (old + 1u == (gen + 1u) * nloc) {
            __builtin_amdgcn_fence(__ATOMIC_RELEASE, "agent");
            asm volatile("s_waitcnt vmcnt(0)" ::: "memory");
            const unsigned og = xb_add(&bar[XB_TOP], 1u);
            const unsigned tg = og / nx;
            if (og + 1u == (tg + 1u) * nx) xb_add(&bar[XB_TOPGEN], 1u);
            else XB_SPIN(xb_ld(&bar[XB_TOPGEN]) == tg, bar);
            __builtin_amdgcn_fence(__ATOMIC_ACQUIRE, "agent");
            xb_add(&bar[XB_XGEN(b.x)], 1u);
            asm volatile("s_waitcnt vmcnt(0)" ::: "memory");
        } else {
            XB_SPIN(xb_ld(&bar[XB_TOPGEN]) == gen, bar);
            __builtin_amdgcn_fence(__ATOMIC_ACQUIRE, "agent");
            asm volatile("s_waitcnt vmcnt(0)" ::: "memory");
        }
    }
    __syncthreads();
}
__host__ __device__ __forceinline__ int r32map(int P) { return 16 * ((P >> 2) & 1) + 4 * (P >> 3) + (P & 3); }
__host__ __device__ __forceinline__ int p128(int x) { return (x & ~31) + r32map(x & 31); }
__host__ __device__ __forceinline__ int hdmap(int d) { if (d >= 16) return d; const int fq = (d >> 2) & 1, j = (d & 3) + 4 * (d >> 3); return 8 * fq + j; }
__host__ __device__ __forceinline__ int head_row(int wc, int d) { const int x = hdmap(d); return 128 * (x >> 5) + 32 * wc + r32map(x & 31); }
__device__ __forceinline__ int dstart(int bj, int fq, int half) { return (bj == 0 && fq < 2) ? 4 * fq + 8 * half : 32 * bj + 8 * fq + 4 * half; }

struct MapGate { __device__ __forceinline__ int operator()(int c) const { return 256 * (c >> 7) + p128(c & 127); } };
struct MapUp   { __device__ __forceinline__ int operator()(int c) const { return 256 * (c >> 7) + 128 + p128(c & 127); } };
struct MapLin  { __device__ __forceinline__ int operator()(int c) const { return (c & ~127) + p128(c & 127); } };
struct MapWin  { __device__ __forceinline__ int operator()(int c) const {
    if (c < 512) return 1024 + (c & ~127) + p128(c & 127);
    if (c < 1024) { const int ch = c - 512; return 256 * (ch >> 7) + p128(ch & 127); }
    if (c < 1536) { const int ch = c - 1024; return 256 * (ch >> 7) + 128 + p128(ch & 127); }
    if (c < 2048) { const int x = c - 1536, hd = x >> 6; return 256 * (6 + (hd >> 2)) + head_row(hd & 3, x & 63); }
    if (c < 2176) { const int x = c - 2048; return 256 * 8 + head_row(x >> 6, x & 63); }
    if (c < 2304) { const int x = c - 2176; return 256 * 8 + head_row(2 + (x >> 6), x & 63); }
    if (c < 2816) { const int x = c - 2304, hd = x >> 6; return 256 * (9 + (hd >> 2)) + head_row(hd & 3, x & 63); }
    if (c < 2880) return 256 * 11 + head_row(0, c - 2816);
    return 256 * 11 + 32 + r32map(c - 2880);
} };

using pg8::Unit; using pg8::bf16_t;
__device__ __forceinline__ float rstd_from(const float* ss, int row, int nslot) {
    float s = 0.f;
    if (nslot == 1) s = ss[row];
    else { const f32x4* p = (const f32x4*)(ss + (size_t)row * 16); const f32x4 a = p[0], b = p[1], c = p[2], d = p[3]; s = ((a.x + a.y) + (a.z + a.w)) + ((b.x + b.y) + (b.z + b.w)) + ((c.x + c.y) + (c.z + c.w)) + ((d.x + d.y) + (d.z + d.w)); }
    return __builtin_amdgcn_rsqf(s * (1.0f / D) + EPS);
}
__device__ __forceinline__ float clamp8(float x) { return __builtin_amdgcn_fmed3f(x, -440.0f, 440.0f); }
__device__ __forceinline__ unsigned pk4_fp8(float a, float b, float c, float d) { int w = __builtin_amdgcn_cvt_pk_fp8_f32(clamp8(a), clamp8(b), 0, false); w = __builtin_amdgcn_cvt_pk_fp8_f32(clamp8(c), clamp8(d), w, true); return (unsigned)w; }
#define EPI_CALL_ROWS() \
    __device__ __forceinline__ void operator()(f32x4 (&acc)[2][2][4][2], const Unit& u, int wr, int wc, int fr, int fq, int ui, bool has_next, const Unit& nxt) const { \
        _Pragma("unroll") for (int ai = 0; ai < 2; ++ai) _Pragma("unroll") for (int m = 0; m < 4; ++m) { \
            const f32x4 v[2][2] = {{acc[ai][0][m][0], acc[ai][0][m][1]}, {acc[ai][1][m][0], acc[ai][1][m][1]}}; \
            row(v, u.pm * 256 + ai * 128 + wr * 64 + m * 16 + fr, u.pn, wc, fr, fq, ui); \
            if (has_next) init_rg(acc, nxt, ai, m, wr, wc, fr, fq); } }                        \
    __device__ __forceinline__ void init(f32x4 (&acc)[2][2][4][2], const Unit& u, int wr, int wc, int fr, int fq) const { \
        _Pragma("unroll") for (int ai = 0; ai < 2; ++ai) _Pragma("unroll") for (int m = 0; m < 4; ++m) init_rg(acc, u, ai, m, wr, wc, fr, fq); }
#define EPI_ZERO_INIT() \
    __device__ __forceinline__ void init_rg(f32x4 (&acc)[2][2][4][2], const Unit&, int ai, int m, int, int, int, int) const { \
        _Pragma("unroll") for (int b = 0; b < 2; ++b) _Pragma("unroll") for (int n = 0; n < 2; ++n) acc[ai][b][m][n] = (f32x4){0.f, 0.f, 0.f, 0.f}; }
__device__ __forceinline__ float rstd_of(const LAS float* tab, const float* ss, int nslot, int row, int ui) { return (ui >= 0 && tab) ? tab[ui * 256 + (row & 255)] : rstd_from(ss, row, nslot); }
struct EpiGU {
    static constexpr bool PERM = false, AFTER_DRAIN = false;
    bf16_t* H; const float* ss; int nslot; const LAS float* tab; float wscale; unsigned char* H8; const float* wsn;
    __device__ __forceinline__ void row(const f32x4 (&v)[2][2], int row, int pn, int wc, int fr, int fq, int ui) const {
        typedef float f32x2 __attribute__((ext_vector_type(2)));
        const int col0 = pn * 128 + wc * 32 + 8 * fq;
        const float rs = rstd_of(tab, ss, nslot, row, ui) * (ui >= 0 ? wscale : 1.0f);
        const float c1 = -rs * LOG2E, rs2 = rs * rs;
        const bool f8 = H8 != nullptr;
        const float rs2s = f8 ? rs2 * H8SCALE : rs2;
        f32x2 hh[4];
#pragma unroll
        for (int n = 0; n < 2; ++n)
#pragma unroll
            for (int i = 0; i < 4; i += 2) { const f32x2 ag = {v[0][n][i], v[0][n][i + 1]}, au = {v[1][n][i], v[1][n][i + 1]};
                const f32x2 a = ag * c1; f32x2 e; e.x = __builtin_amdgcn_exp2f(a.x); e.y = __builtin_amdgcn_exp2f(a.y);
                const f32x2 d = e + 1.0f; f32x2 r; r.x = __builtin_amdgcn_rcpf(d.x); r.y = __builtin_amdgcn_rcpf(d.y);
                hh[2 * n + (i >> 1)] = (ag * au) * (r * rs2s); }
        if (f8) { v2u w8; w8.x = pk4_fp8(hh[0].x, hh[0].y, hh[1].x, hh[1].y); w8.y = pk4_fp8(hh[2].x, hh[2].y, hh[3].x, hh[3].y);
            __builtin_nontemporal_store(w8, (v2u*)(H8 + (size_t)row * DFF + col0)); }
        else { v4u w; w.x = pg8::cvt_pk_bf16(hh[0].x, hh[0].y); w.y = pg8::cvt_pk_bf16(hh[1].x, hh[1].y); w.z = pg8::cvt_pk_bf16(hh[2].x, hh[2].y); w.w = pg8::cvt_pk_bf16(hh[3].x, hh[3].y);
        __builtin_nontemporal_store(w, (v4u*)(H + (size_t)row * DFF + col0)); }
    }
    __device__ __forceinline__ void operator()(f32x4 (&acc)[2][2][4][2], const Unit& u, int wr, int wc, int fr, int fq, int ui, bool has_next, const Unit& nxt) const {
        typedef int v4i_ __attribute__((ext_vector_type(4)));
        f32x4 cs[2][2];
#pragma unroll
        for (int bj = 0; bj < 2; ++bj)
#pragma unroll
            for (int n = 0; n < 2; ++n) cs[bj][n] = wsn ? *(const f32x4*)(wsn + u.pn * 256 + bj * 128 + wc * 32 + n * 16 + 4 * fq) : (f32x4){1.f, 1.f, 1.f, 1.f};
#pragma unroll
        for (int ai = 0; ai < 2; ++ai)
#pragma unroll
            for (int m = 0; m < 4; ++m) {
                f32x4 v[2][2];
#pragma unroll
                for (int bj = 0; bj < 2; ++bj)
#pragma unroll
                    for (int n = 0; n < 2; ++n) v[bj][n] = wsn ? __builtin_convertvector(__builtin_bit_cast(v4i_, acc[ai][bj][m][n]), f32x4) * cs[bj][n] : acc[ai][bj][m][n];
                row(v, u.pm * 256 + ai * 128 + wr * 64 + m * 16 + fr, u.pn, wc, fr, fq, ui);
                if (has_next) init_rg(acc, nxt, ai, m, wr, wc, fr, fq); }
    }
    __device__ __forceinline__ void init(f32x4 (&acc)[2][2][4][2], const Unit& u, int wr, int wc, int fr, int fq) const {
#pragma unroll
        for (int ai = 0; ai < 2; ++ai)
#pragma unroll
            for (int m = 0; m < 4; ++m) init_rg(acc, u, ai, m, wr, wc, fr, fq); }
    EPI_ZERO_INIT()
};
__device__ __forceinline__ void bf8_to_f32(const v4u w, f32x4& lo, f32x4& hi) {
    lo = (f32x4){__uint_as_float(w.x << 16), __uint_as_float(w.x & 0xffff0000u), __uint_as_float(w.y << 16), __uint_as_float(w.y & 0xffff0000u)};
    hi = (f32x4){__uint_as_float(w.z << 16), __uint_as_float(w.z & 0xffff0000u), __uint_as_float(w.w << 16), __uint_as_float(w.w & 0xffff0000u)};
}
template <int MODE> struct EpiRes {
    static constexpr bool PERM = false, AFTER_DRAIN = false;
    const bf16_t* resb; float* out; bf16_t* outb; float* ss; unsigned char* out8; float ascale; const float* resf = nullptr; const float* resfs = nullptr;
    __device__ __forceinline__ void row(const f32x4 (&v)[2][2], int row, int pn, int wc, int fr, int fq, int ui) const {
        const bool pre = ui >= 0;
        const float alpha = ((MODE == 1) ? 1.0f : 0.5f) * (pre ? ascale : 1.0f);
        const bool live = row < MTOT;
        float sq = 0.f;
#pragma unroll
        for (int bj = 0; bj < 2; ++bj) {
            const int col = pn * 256 + bj * 128 + wc * 32 + 8 * fq;
            f32x4 r0 = (f32x4){0.f, 0.f, 0.f, 0.f}, r1 = r0;
            if (!pre && live) { if constexpr (MODE == 0) { r0 = *(const f32x4*)(resfs + (size_t)(row - MP) * D + col); r1 = *(const f32x4*)(resfs + (size_t)(row - MP) * D + col + 4); } else bf8_to_f32(*(const v4u*)(resb + (size_t)row * D + col), r0, r1); }
            const f32x4 v0 = r0 + alpha * v[bj][0], v1 = r1 + alpha * v[bj][1];
            if (MODE == 2) { if (live) { __builtin_nontemporal_store(v0, (f32x4*)(out + (size_t)row * D + col)); __builtin_nontemporal_store(v1, (f32x4*)(out + (size_t)row * D + col + 4)); } }
            else {
                v4u w; w.x = pg8::cvt_pk_bf16(v0[0], v0[1]); w.y = pg8::cvt_pk_bf16(v0[2], v0[3]); w.z = pg8::cvt_pk_bf16(v1[0], v1[1]); w.w = pg8::cvt_pk_bf16(v1[2], v1[3]);
                *(v4u*)(outb + (size_t)row * D + col) = w;
                if (MODE == 1 && out8) { v2u w8; w8.x = pk4_fp8(v0[0], v0[1], v0[2], v0[3]); w8.y = pk4_fp8(v1[0], v1[1], v1[2], v1[3]); *(v2u*)(out8 + (size_t)row * D + col) = w8; }
                sq += (v0[0] * v0[0] + v0[1] * v0[1]) + (v0[2] * v0[2] + v0[3] * v0[3]) + (v1[0] * v1[0] + v1[1] * v1[1]) + (v1[2] * v1[2] + v1[3] * v1[3]);
            }
        }
        if (MODE != 2) { sq += __shfl_xor(sq, 16); sq += __shfl_xor(sq, 32); if (fq == 0) ss[(size_t)row * 16 + pn * 4 + wc] = sq; }
    }
    EPI_CALL_ROWS()
    __device__ __forceinline__ void init_rg(f32x4 (&acc)[2][2][4][2], const Unit& u, int ai, int m, int wr, int wc, int fr, int fq) const {
        const float ia = ((MODE == 1) ? 1.0f : 2.0f) / ascale;
        const size_t ro = (size_t)(u.pm * 256 + ai * 128 + wr * 64 + m * 16 + fr) * D + u.pn * 256 + wc * 32 + 8 * fq;
#pragma unroll
        for (int bj = 0; bj < 2; ++bj) { f32x4 lo, hi;
            if constexpr (MODE == 0) { lo = *(const f32x4*)(resf + ro + bj * 128); hi = *(const f32x4*)(resf + ro + bj * 128 + 4); } else bf8_to_f32(*(const v4u*)(resb + ro + bj * 128), lo, hi);
            acc[ai][bj][m][0] = lo * ia; acc[ai][bj][m][1] = hi * ia; }
    }
};
struct EpiWin {
    static constexpr bool PERM = false, AFTER_DRAIN = false;
    unsigned char* ws; float* out; const float* qn; const float* kn; const LAS float* tab;
    __device__ __forceinline__ void row(const f32x4 (&acc)[2][2], int row, int pn, int wc, int fr, int fq, int ui) const {
        const float* ss = (const float*)(ws + WS_SS1); bf16_t* U = (bf16_t*)(ws + WS_U); bf16_t* GB = (bf16_t*)(ws + WS_GB); float* WI = (float*)(ws + WS_WI); const float* rope = (const float*)(ws + WS_ROPE);
        if (pn == 11 && wc >= 2) return;
        const int type = pn < 4 ? 0 : pn < 6 ? 1 : pn < 8 ? 2 : pn == 8 ? (wc < 2 ? 3 : 4) : pn < 11 ? 5 : (wc == 0 ? 6 : 7);
        const int head = (type == 2) ? 4 * (pn - 6) + wc : (type == 5) ? 4 * (pn - 9) + wc : (type == 3) ? wc : (type == 4) ? wc - 2 : 0;
        const bool live = row < MTOT;
        const float rs = rstd_of(tab, ss, 16, row, ui);
        if (type == 0) {
            const int ch0 = pn * 128 + wc * 32 + 8 * fq;
            const f32x4 u0 = (acc[0][0] * rs) * (acc[1][0] * rs), u1 = (acc[0][1] * rs) * (acc[1][1] * rs);
            v4u w; w.x = pg8::cvt_pk_bf16(u0[0], u0[1]); w.y = pg8::cvt_pk_bf16(u0[2], u0[3]); w.z = pg8::cvt_pk_bf16(u1[0], u1[1]); w.w = pg8::cvt_pk_bf16(u1[2], u1[3]);
            *(v4u*)(U + (size_t)row * 512 + ch0) = w;
            if (row < MP) { const int s = row & (SEQ - 1); if (s >= SEQ - 2) { float* o = out + O_CP + ((size_t)(row >> 11) * 2 + (s - (SEQ - 2))) * 512 + ch0; *(f32x4*)o = u0; *(f32x4*)(o + 4) = u1; } }
            else if (live) { const int sr = row - MP, s = sr & 3; if (s >= 2) { float* o = out + O_CS + ((size_t)(sr >> 2) * 2 + (s - 2)) * 512 + ch0; *(f32x4*)o = u0; *(f32x4*)(o + 4) = u1; } }
        } else if (type == 1) {
#pragma unroll
            for (int bj = 0; bj < 2; ++bj) { const int col = (pn - 4) * 256 + bj * 128 + wc * 32 + 8 * fq; const f32x4 a = acc[bj][0] * rs, b = acc[bj][1] * rs;
                v4u w; w.x = pg8::cvt_pk_bf16(a[0], a[1]); w.y = pg8::cvt_pk_bf16(a[2], a[3]); w.z = pg8::cvt_pk_bf16(b[0], b[1]); w.w = pg8::cvt_pk_bf16(b[2], b[3]);
                *(v4u*)(GB + (size_t)row * 512 + col) = w; }
        } else if (type == 7) {
            if (fq == 0) { *(f32x4*)(WI + (size_t)row * 8) = acc[0][0] * rs; *(f32x4*)(WI + (size_t)row * 8 + 4) = acc[0][1] * rs; }
        } else {
            f32x4 v[2][2];
#pragma unroll
            for (int bj = 0; bj < 2; ++bj) { v[bj][0] = acc[bj][0] * rs; v[bj][1] = acc[bj][1] * rs; }
            if (type == 2 || type == 3) {
                float sq = 0.f;
#pragma unroll
                for (int bj = 0; bj < 2; ++bj)
#pragma unroll
                    for (int h2 = 0; h2 < 2; ++h2) sq += (v[bj][h2][0] * v[bj][h2][0] + v[bj][h2][1] * v[bj][h2][1]) + (v[bj][h2][2] * v[bj][h2][2] + v[bj][h2][3] * v[bj][h2][3]);
                sq += __shfl_xor(sq, 16); sq += __shfl_xor(sq, 32);
                const float sc = __builtin_amdgcn_rsqf(sq * (1.0f / 64.0f) + EPS);
#pragma unroll
                for (int bj = 0; bj < 2; ++bj)
#pragma unroll
                    for (int h2 = 0; h2 < 2; ++h2) { const f32x4 gq = *(const f32x4*)(qn + dstart(bj, fq, h2)), gk = *(const f32x4*)(kn + dstart(bj, fq, h2)); v[bj][h2] = v[bj][h2] * sc * ((type == 2) ? gq : gk); }
            }
            if (type != 4 && fq < 2) {
                const int pidx = row < MP ? (row & (SEQ - 1)) : (live ? SEQ + ((row - MP) & 3) : 0);
                const float* rp = rope + ((size_t)pidx * 8 + 4 * fq) * 2;
                const f32x4 cs0 = *(const f32x4*)rp, cs1 = *(const f32x4*)(rp + 4);
                const f32x4 x1 = v[0][0], x2 = v[0][1];
                const f32x4 c = (f32x4){cs0[0], cs0[2], cs1[0], cs1[2]}, s = (f32x4){cs0[1], cs0[3], cs1[1], cs1[3]};
                v[0][0] = x1 * c - x2 * s; v[0][1] = x2 * c + x1 * s;
            }
            const size_t boff = (type == 2) ? WS_Q : (type == 3) ? WS_KB : (type == 4) ? WS_VB : (type == 5) ? WS_QI : WS_KIB;
            const int bp = (type == 2 || type == 5) ? 512 : (type == 6) ? 64 : 128; const float bsc = (type == 2) ? QSCALE : 1.0f;
            bf16_t* bdst = (bf16_t*)(ws + boff);
            const bool hasf = live && (type == 3 || type == 4 || type == 6);
            const size_t fbase = (type == 3) ? (row < MP ? O_KP : O_KS) : (type == 4) ? (row < MP ? O_VP : O_VS) : (row < MP ? O_IP : O_IS);
            float* fdst = out + fbase + (size_t)(row < MP ? row : row - MP) * (type == 6 ? 64 : 128);
#pragma unroll
            for (int bj = 0; bj < 2; ++bj)
#pragma unroll
                for (int h2 = 0; h2 < 2; ++h2) { const int d = head * 64 + dstart(bj, fq, h2); const f32x4 x = v[bj][h2];
                    if (hasf) { if (row < MP) __builtin_nontemporal_store(x, (f32x4*)(fdst + d)); else *(f32x4*)(fdst + d) = x; }
                    v2u w; w.x = pg8::cvt_pk_bf16(x[0] * bsc, x[1] * bsc); w.y = pg8::cvt_pk_bf16(x[2] * bsc, x[3] * bsc);
                    *(v2u*)(bdst + (size_t)row * bp + d) = w; }
        }
    }
    EPI_CALL_ROWS()
    EPI_ZERO_INIT()
};
template <class Epi, int MT, int QM> __device__ __forceinline__ void skinny_unit(PG8_LAS unsigned char* lds, const unsigned char* A, const unsigned char* Bt, int KB, int pn, int wc, int rg, const Epi& E,
                                                                                const float* xs, const float* wsn, float oscale) {
    typedef int v4i_ __attribute__((ext_vector_type(4)));
    const int tid = threadIdx.x, wid = __builtin_amdgcn_readfirstlane(tid >> 6), lane = tid & 63, fr = lane & 15, fq = lane >> 4;
    const int TP = KB >> 7, base = TP >> 3, rem = TP & 7;
    const int np = base + (wid < rem ? 1 : 0), p0 = wid * base + (wid < rem ? wid : rem);
    const unsigned char* ap = A + (size_t)(MP + 16 * MT * rg + fr) * KB + p0 * 128 + 16 * fq;
    const unsigned char* bp = Bt + (size_t)(256 * pn + 32 * wc + fr) * KB + p0 * 128 + 16 * fq;
    pg8::f32x4 acc[MT][2][2];
#pragma unroll
    for (int mt = 0; mt < MT; ++mt)
#pragma unroll
        for (int bj = 0; bj < 2; ++bj)
#pragma unroll
            for (int n = 0; n < 2; ++n) acc[mt][bj][n] = (pg8::f32x4){0.f, 0.f, 0.f, 0.f};
    v4i_ a0[MT], b0[2][2], a1[MT], b1[2][2], a2[MT], b2[2][2], a3[MT], b3[2][2];
#define SK_LOADP(afe, bfe, afo, bfo, p_) do { \
        _Pragma("unroll") for (int mt = 0; mt < MT; ++mt) { afe[mt] = *(const v4i_*)(ap + (size_t)(16 * mt) * KB + 128 * (p_)); afo[mt] = *(const v4i_*)(ap + (size_t)(16 * mt) * KB + 128 * (p_) + 64); } \
        _Pragma("unroll") for (int bj = 0; bj < 2; ++bj) _Pragma("unroll") for (int n = 0; n < 2; ++n) { bfe[bj][n] = *(const v4i_*)(bp + (size_t)(128 * bj + 16 * n) * KB + 128 * (p_)); bfo[bj][n] = *(const v4i_*)(bp + (size_t)(128 * bj + 16 * n) * KB + 128 * (p_) + 64); } } while (0)
#define SK_MMA(af, bf) do { _Pragma("unroll") for (int mt = 0; mt < MT; ++mt) _Pragma("unroll") for (int bj = 0; bj < 2; ++bj) _Pragma("unroll") for (int n = 0; n < 2; ++n) { \
        if constexpr (QM == 0) acc[mt][bj][n] = __builtin_amdgcn_mfma_f32_16x16x32_bf16(__builtin_bit_cast(pg8::bf16x8, bf[bj][n]), __builtin_bit_cast(pg8::bf16x8, af[mt]), acc[mt][bj][n], 0, 0, 0); \
        else if constexpr (QM == 2) acc[mt][bj][n] = __builtin_bit_cast(pg8::f32x4, __builtin_amdgcn_mfma_i32_16x16x64_i8(bf[bj][n], af[mt], __builtin_bit_cast(v4i_, acc[mt][bj][n]), 0, 0, 0)); \
        else { typedef long l2_ __attribute__((ext_vector_type(2))); const l2_ bl_ = __builtin_bit_cast(l2_, bf[bj][n]), al_ = __builtin_bit_cast(l2_, af[mt]); \
            acc[mt][bj][n] = __builtin_amdgcn_mfma_f32_16x16x32_fp8_fp8(bl_[0], al_[0], acc[mt][bj][n], 0, 0, 0); acc[mt][bj][n] = __builtin_amdgcn_mfma_f32_16x16x32_fp8_fp8(bl_[1], al_[1], acc[mt][bj][n], 0, 0, 0); } } } while (0)
    SK_LOADP(a0, b0, a1, b1, 0); if (np > 1) SK_LOADP(a2, b2, a3, b3, 1);
    for (int p = 0; p < np; p += 2) {
        SK_MMA(a0, b0); SK_MMA(a1, b1);
        if (p + 2 < np) SK_LOADP(a0, b0, a1, b1, p + 2);
        if (p + 1 < np) { SK_MMA(a2, b2); SK_MMA(a3, b3);
            if (p + 3 < np) SK_LOADP(a2, b2, a3, b3, p + 3); }
    }
#undef SK_LOADP
#undef SK_MMA
    PG8_LAS pg8::f32x4* slab = (PG8_LAS pg8::f32x4*)lds;
#pragma unroll
    for (int mt = 0; mt < MT; ++mt)
#pragma unroll
        for (int bj = 0; bj < 2; ++bj)
#pragma unroll
            for (int n = 0; n < 2; ++n) { pg8::f32x4 t = acc[mt][bj][n];
                if constexpr (QM == 2) { const v4i_ ti = __builtin_bit_cast(v4i_, t); t = (pg8::f32x4){(float)ti[0], (float)ti[1], (float)ti[2], (float)ti[3]}; }
                slab[((wid * MT + mt) * 4 + bj * 2 + n) * 64 + lane] = t; }
    __syncthreads();
    if (wid < MT) { pg8::f32x4 v[2][2]; const int row = MP + 16 * MT * rg + 16 * wid + fr;
      float rsc = oscale; if constexpr (QM == 2) rsc = xs[row];
#pragma unroll
      for (int bj = 0; bj < 2; ++bj)
#pragma unroll
          for (int n = 0; n < 2; ++n) { const int o = (wid * 4 + bj * 2 + n) * 64 + lane; pg8::f32x4 t = slab[o];
#pragma unroll
              for (int q = 1; q < 8; ++q) t = t + slab[o + q * MT * 4 * 64];
              if constexpr (QM == 2) t = t * (*(const pg8::f32x4*)(wsn + 256 * pn + 128 * bj + 32 * wc + 16 * n + 4 * fq)) * rsc;
              else if constexpr (QM == 1) t = t * rsc;
              v[bj][n] = t; }
      E.row(v, row, pn, wc, fr, fq, -1); }
    __syncthreads();
}
template <class Epi, int MT, int QM> __device__ __forceinline__ void skinny_phase(PG8_LAS unsigned char* lds, const void* A, const void* Bt, int N, int KB, int blk, int G, const Epi& E,
                                                                                 const float* xs = nullptr, const float* wsn = nullptr, float oscale = 1.0f) {
    constexpr int NRG = 8 / MT; const int nu = (N / 256) * 4 * NRG;
    for (int u = blk; u < nu; u += G) skinny_unit<Epi, MT, QM>(lds, (const unsigned char*)A, (const unsigned char*)Bt, KB, u / (4 * NRG), (u / NRG) & 3, u % NRG, E, xs, wsn, oscale);
}
__device__ __forceinline__ void fill_rstd_table(LAS float* tab, const pg8::StaticOrder& S, const float* ss, int nslot, const float* xs = nullptr) {
    const int tid = threadIdx.x; Unit u; int nu = 0;
    while (nu < 11 && S.next(nu, u)) ++nu;
    float sv[6], xsv[6]; int ix[6];
#pragma unroll
    for (int k2 = 0; k2 < 6; ++k2) { const int idx = tid + 512 * k2; ix[k2] = idx; const bool ok = idx < nu * 256; Unit uu_; S.next(ok ? (idx >> 8) : 0, uu_); const int row = uu_.pm * 256 + (idx & 255);
        float s_ = 0.f;
        if (nslot == 1) s_ = ss[row];
        else { const f32x4* p = (const f32x4*)(ss + (size_t)row * 16); const f32x4 a = p[0], b = p[1], c = p[2], d = p[3]; s_ = ((a.x + a.y) + (a.z + a.w)) + ((b.x + b.y) + (b.z + b.w)) + ((c.x + c.y) + (c.z + c.w)) + ((d.x + d.y) + (d.z + d.w)); }
        sv[k2] = s_; xsv[k2] = xs ? xs[row] : 1.0f; }
#pragma unroll
    for (int k2 = 0; k2 < 6; ++k2) if (ix[k2] < nu * 256) tab[ix[k2]] = __builtin_amdgcn_rsqf(sv[k2] * (1.0f / D) + EPS) * xsv[k2];
    __syncthreads();
}
__device__ __forceinline__ void quant_rows_pass(int gw, int NGW, const bf16_t* X, unsigned char* Q, float* XS, int nrows) {
    const int lane = threadIdx.x & 63;
    for (int g8 = gw; g8 < nrows / 8; g8 += NGW) {
        const int m0 = 8 * g8; v4u a[8][2];
#pragma unroll
        for (int r = 0; r < 8; ++r) { a[r][0] = *(const v4u*)(X + (size_t)(m0 + r) * D + 8 * lane); a[r][1] = *(const v4u*)(X + (size_t)(m0 + r) * D + 512 + 8 * lane); }
#pragma unroll
        for (int r = 0; r < 8; ++r) {
            float x[16];
#pragma unroll
            for (int e = 0; e < 4; ++e) { x[2 * e] = __uint_as_float(a[r][0][e] << 16); x[2 * e + 1] = __uint_as_float(a[r][0][e] & 0xffff0000u); x[8 + 2 * e] = __uint_as_float(a[r][1][e] << 16); x[9 + 2 * e] = __uint_as_float(a[r][1][e] & 0xffff0000u); }
            float mx = 0.f;
#pragma unroll
            for (int e = 0; e < 16; ++e) mx = fmaxf(mx, fabsf(x[e]));
            { unsigned v = __float_as_uint(mx), o;
              o = (unsigned)__builtin_amdgcn_update_dpp(0, (int)v, 0xB1, 0xF, 0xF, true); v = o > v ? o : v;
              o = (unsigned)__builtin_amdgcn_update_dpp(0, (int)v, 0x4E, 0xF, 0xF, true); v = o > v ? o : v;
              o = (unsigned)__builtin_amdgcn_update_dpp(0, (int)v, 0x141, 0xF, 0xF, true); v = o > v ? o : v;
              o = (unsigned)__builtin_amdgcn_update_dpp(0, (int)v, 0x140, 0xF, 0xF, true); v = o > v ? o : v;
              const unsigned p0 = (unsigned)__builtin_amdgcn_readlane((int)v, 0), p1 = (unsigned)__builtin_amdgcn_readlane((int)v, 16), p2 = (unsigned)__builtin_amdgcn_readlane((int)v, 32), p3 = (unsigned)__builtin_amdgcn_readlane((int)v, 48);
              const unsigned q0 = p0 > p1 ? p0 : p1, q1 = p2 > p3 ? p2 : p3; mx = __uint_as_float(q0 > q1 ? q0 : q1); }
            const float iq = mx > 0.f ? 127.0f / mx : 0.f;
            unsigned w[4];
#pragma unroll
            for (int e = 0; e < 4; ++e) { const int q0 = (int)__builtin_rintf(x[4 * e] * iq), q1 = (int)__builtin_rintf(x[4 * e + 1] * iq), q2 = (int)__builtin_rintf(x[4 * e + 2] * iq), q3 = (int)__builtin_rintf(x[4 * e + 3] * iq);
                w[e] = (unsigned)(q0 & 0xff) | ((unsigned)(q1 & 0xff) << 8) | ((unsigned)(q2 & 0xff) << 16) | ((unsigned)(q3 & 0xff) << 24); }
            *(v2u*)(Q + (size_t)(m0 + r) * D + 8 * lane) = (v2u){w[0], w[1]};
            *(v2u*)(Q + (size_t)(m0 + r) * D + 512 + 8 * lane) = (v2u){w[2], w[3]};
            if (lane == 0) XS[m0 + r] = mx * (1.0f / 127.0f);
        }
    }
}
struct Frame {
    LAS unsigned char* lds;
    volatile LAS unsigned* MISC;
    gu32* ctl;
    int tid, lane, wave, vcu, G;
    const void* const* in;
    float* out; unsigned char* ws;
};
#define WSP(T, off) ((T*)(F.ws + (off)))

template <class Map> __device__ __forceinline__ void p0_transpose_item(const float* W, int K, int N, const float* gain, bf16* WT, LAS float* scr, int item, int lane, const Map map, unsigned char* WT8 = nullptr) {
    const int nblk = (N + 31) / 32, kb = item / nblk, nb = item % nblk, k0 = 64 * kb, n0 = 32 * nb;
    const bool nok = n0 + (lane & 31) < N;
#pragma unroll 8
    for (int i = 0; i < 32; ++i) { const int kk = 2 * i + (lane >> 5); float v = nok ? __builtin_nontemporal_load(W + (size_t)(k0 + kk) * N + n0 + (lane & 31)) : 0.f; if (gain) v *= gain[k0 + kk]; scr[kk * 33 + (lane & 31)] = v; }
    LDS_WAIT(); asm volatile("" ::: "memory");
    const int c = lane & 7;
#pragma unroll
    for (int j = 0; j < 4; ++j) { const int n = (lane >> 3) + 8 * j; const LAS float* s = scr + (8 * c) * 33 + n;
        v4u o; o.x = pk2(s[0 * 33], s[1 * 33]); o.y = pk2(s[2 * 33], s[3 * 33]); o.z = pk2(s[4 * 33], s[5 * 33]); o.w = pk2(s[6 * 33], s[7 * 33]);
        if (n0 + n < N) { *(GAS v4u*)(WT + (size_t)map(n0 + n) * K + k0 + 8 * c) = o;
            if (WT8) { v2u o8; o8.x = pk4_fp8(s[0 * 33] * W8SCALE, s[1 * 33] * W8SCALE, s[2 * 33] * W8SCALE, s[3 * 33] * W8SCALE); o8.y = pk4_fp8(s[4 * 33] * W8SCALE, s[5 * 33] * W8SCALE, s[6 * 33] * W8SCALE, s[7 * 33] * W8SCALE);
                *(GAS v2u*)(WT8 + (size_t)map(n0 + n) * K + k0 + 8 * c) = o8; } } }
    LDS_WAIT(); asm volatile("" ::: "memory");
}
__device__ __forceinline__ void sincos_d(double a, float& s, float& c) {
    const double TWO_PI = 6.283185307179586476925286766559, PI = 3.14159265358979323846264338327950288;
    double k = __builtin_rint(a / TWO_PI); double r = a - k * TWO_PI;
    double sgn = 1.0; if (r > PI * 0.5) { r = PI - r; sgn = -1.0; } else if (r < -PI * 0.5) { r = -PI - r; sgn = -1.0; }
    const double r2 = r * r;
    double ts = 1.0, tc = 1.0, ps = 1.0, pc = 1.0;
#pragma unroll
    for (int n = 1; n <= 12; ++n) { pc = -pc * r2 / (double)((2 * n - 1) * (2 * n)); ps = -ps * r2 / (double)((2 * n) * (2 * n + 1)); tc += pc; ts += ps; }
    s = (float)(r * ts); c = (float)(sgn * tc);
}
__device__ __forceinline__ void p0_prologue(Frame& F) {
    LAS float* scr = (LAS float*)(F.lds + RING_OFF + F.wave * 16384);
    const int gw = F.vcu * 8 + F.wave, NGW = F.G * 8;
    constexpr int I_G = (D / 64) * (DFF / 32), I_D = (DFF / 64) * (D / 32), I_IN = (D / 64) * ((NIN + 31) / 32), I_O = (D / 64) * (D / 32);
    constexpr int NITEMS = 2 * (2 * I_G + I_D) + I_IN + I_O;
    for (int rep63 = 0; rep63 < (PROBE_DUP == 63 ? 2 : 1); ++rep63)
    for (int it = gw; it < NITEMS; it += NGW) {
        int r = it;
        if (r < I_G) { p0_transpose_item(((const float*)F.in[8]), D, DFF, ((const float*)F.in[7]), WSP(bf16, WS_WGU1), scr, r, F.lane, MapGate()); continue; } r -= I_G;
        if (r < I_G) { p0_transpose_item(((const float*)F.in[9]), D, DFF, ((const float*)F.in[7]), WSP(bf16, WS_WGU1), scr, r, F.lane, MapUp()); continue; } r -= I_G;
        if (r < I_D) { p0_transpose_item(((const float*)F.in[10]), DFF, D, nullptr, WSP(bf16, WS_WD1), scr, r, F.lane, MapLin(), WSP(unsigned char, WS_WD1_8)); continue; } r -= I_D;
        if (r < I_G) { p0_transpose_item(((const float*)F.in[19]), D, DFF, ((const float*)F.in[18]), WSP(bf16, WS_WGU2), scr, r, F.lane, MapGate()); continue; } r -= I_G;
        if (r < I_G) { p0_transpose_item(((const float*)F.in[20]), D, DFF, ((const float*)F.in[18]), WSP(bf16, WS_WGU2), scr, r, F.lane, MapUp()); continue; } r -= I_G;
        if (r < I_D) { p0_transpose_item(((const float*)F.in[21]), DFF, D, nullptr, WSP(bf16, WS_WD2), scr, r, F.lane, MapLin(), WSP(unsigned char, WS_WD2_8)); continue; } r -= I_D;
        if (r < I_IN) { p0_transpose_item(((const float*)F.in[12]), D, NIN, ((const float*)F.in[11]), WSP(bf16, WS_WIN), scr, r, F.lane, MapWin()); continue; } r -= I_IN;
        p0_transpose_item(((const float*)F.in[17]), D, D, nullptr, WSP(bf16, WS_WOUT), scr, r, F.lane, MapLin());
    }
    bf16* XB = WSP(bf16, WS_XB); float* SS0 = WSP(float, WS_SS0);
    for (int rep64 = 0; rep64 < (PROBE_DUP == 64 ? 2 : 1); ++rep64)
    for (int g4 = gw; g4 < MTOT / 4; g4 += NGW) {
        const int m0 = 4 * g4;
        const float* xrow = m0 < MP ? ((const float*)F.in[0]) + (size_t)m0 * D : ((const float*)F.in[1]) + (size_t)(m0 - MP) * D;
        const GAS f32x4* xr = (const GAS f32x4*)xrow + F.lane;
        f32x4 v[4][4]; float s[4];
#pragma unroll
        for (int r = 0; r < 4; ++r)
#pragma unroll
            for (int j = 0; j < 4; ++j) v[r][j] = __builtin_nontemporal_load((const f32x4*)(xr + 256 * r + 64 * j));
#pragma unroll
        for (int r = 0; r < 4; ++r) { s[r] = 0.f;
#pragma unroll
            for (int j = 0; j < 4; ++j) s[r] += (v[r][j].x * v[r][j].x + v[r][j].y * v[r][j].y) + (v[r][j].z * v[r][j].z + v[r][j].w * v[r][j].w); }
#pragma unroll
        for (int o = 1; o < 64; o <<= 1) {
#pragma unroll
            for (int r = 0; r < 4; ++r) s[r] += __shfl_xor(s[r], o); }
        if (m0 >= MP) {
        GAS unsigned long long* o8 = (GAS unsigned long long*)(XB + (size_t)m0 * D) + F.lane;
#pragma unroll
        for (int r = 0; r < 4; ++r)
#pragma unroll
            for (int j = 0; j < 4; ++j) o8[256 * r + 64 * j] = (unsigned long long)pk2(v[r][j].x, v[r][j].y) | ((unsigned long long)pk2(v[r][j].z, v[r][j].w) << 32); }
        { float mx[4];
#pragma unroll
          for (int r = 0; r < 4; ++r) { mx[r] = 0.f;
#pragma unroll
              for (int j = 0; j < 4; ++j) mx[r] = fmaxf(mx[r], fmaxf(fmaxf(fabsf(v[r][j].x), fabsf(v[r][j].y)), fmaxf(fabsf(v[r][j].z), fabsf(v[r][j].w)))); }
#pragma unroll
          for (int o = 1; o < 64; o <<= 1) {
#pragma unroll
              for (int r = 0; r < 4; ++r) mx[r] = fmaxf(mx[r], __shfl_xor(mx[r], o)); }
          GAS unsigned* q8 = (GAS unsigned*)(WSP(unsigned char, WS_XI8) + (size_t)m0 * D) + F.lane;
#pragma unroll
          for (int r = 0; r < 4; ++r) { const float iq = mx[r] > 0.f ? 127.0f / mx[r] : 0.f;
#pragma unroll
              for (int j = 0; j < 4; ++j) { const int a_ = (int)__builtin_rintf(v[r][j].x * iq), b_ = (int)__builtin_rintf(v[r][j].y * iq), c_ = (int)__builtin_rintf(v[r][j].z * iq), d_ = (int)__builtin_rintf(v[r][j].w * iq);
                  q8[256 * r + 64 * j] = (unsigned)(a_ & 0xff) | ((unsigned)(b_ & 0xff) << 8) | ((unsigned)(c_ & 0xff) << 16) | ((unsigned)(d_ & 0xff) << 24); } }
          if (F.lane < 4) WSP(float, WS_XS)[m0 + F.lane] = (F.lane == 0 ? mx[0] : F.lane == 1 ? mx[1] : F.lane == 2 ? mx[2] : mx[3]) * (1.0f / 127.0f); }
        if (F.lane < 4) SS0[m0 + F.lane] = F.lane == 0 ? s[0] : F.lane == 1 ? s[1] : F.lane == 2 ? s[2] : s[3];
    }
    { float* rope = WSP(float, WS_ROPE);
      const double invf[8] = {1.0, 0.19392274474868576, 0.03760603093086393, 0.007292664737217109, 0.001414213562373095, 0.0002742481756762073, 5.318295896944988e-05, 1.031338537721246e-05};
      for (int rep65 = 0; rep65 < (PROBE_DUP == 65 ? 2 : 1); ++rep65)
      for (int e = (F.vcu * 512 + F.tid); e < 2052 * 8; e += F.G * 512) { const int p = e >> 3, i = e & 7; const double pos = (double)(p < SEQ ? p : PAST + (p - SEQ));
          double f = invf[0];
#pragma unroll
          for (int q = 1; q < 8; ++q) f = (i == q) ? invf[q] : f;
          float s, c; sincos_d(pos * f, s, c); rope[2 * e] = c; rope[2 * e + 1] = s; } }
}

__device__ __forceinline__ void unpack8(const v4u a, float (&o)[8]) {
#pragma unroll
    for (int e = 0; e < 4; ++e) { o[2 * e] = bf2f((unsigned short)(a[e] & 0xffffu)); o[2 * e + 1] = bf2f((unsigned short)(a[e] >> 16)); }
}
__device__ __forceinline__ void p0b_quant_weights(Frame& F) {
    const int gw = F.vcu * 8 + F.wave, NGW = F.G * 8;
    for (int rr = gw; rr < 4 * DFF; rr += NGW) {
        const bool second = rr >= 2 * DFF; const int r = second ? rr - 2 * DFF : rr;
        const bf16* W = second ? WSP(bf16, WS_WGU2) : WSP(bf16, WS_WGU1); unsigned char* Q = second ? WSP(unsigned char, WS_WGU2I8) : WSP(unsigned char, WS_WGU1I8); float* WSN = second ? WSP(float, WS_WSN2) : WSP(float, WS_WSN);
        const v4u a = *(const GAS v4u*)(W + (size_t)r * D + 8 * F.lane), b = *(const GAS v4u*)(W + (size_t)r * D + 512 + 8 * F.lane);
        float x[16]; { float t0[8], t1[8]; unpack8(a, t0); unpack8(b, t1);
#pragma unroll
            for (int e = 0; e < 8; ++e) { x[e] = t0[e]; x[8 + e] = t1[e]; } }
        float mx = 0.f;
#pragma unroll
        for (int e = 0; e < 16; ++e) mx = fmaxf(mx, fabsf(x[e]));
#pragma unroll
        for (int o = 1; o < 64; o <<= 1) mx = fmaxf(mx, __shfl_xor(mx, o));
        const float iq = mx > 0.f ? 127.0f / mx : 0.f;
        unsigned w[4];
#pragma unroll
        for (int e = 0; e < 4; ++e) { const int q0 = (int)__builtin_rintf(x[4 * e] * iq), q1 = (int)__builtin_rintf(x[4 * e + 1] * iq), q2 = (int)__builtin_rintf(x[4 * e + 2] * iq), q3 = (int)__builtin_rintf(x[4 * e + 3] * iq);
            w[e] = (unsigned)(q0 & 0xff) | ((unsigned)(q1 & 0xff) << 8) | ((unsigned)(q2 & 0xff) << 16) | ((unsigned)(q3 & 0xff) << 24); }
        *(GAS v2u*)(Q + (size_t)r * D + 8 * F.lane) = (v2u){w[0], w[1]};
        *(GAS v2u*)(Q + (size_t)r * D + 512 + 8 * F.lane) = (v2u){w[2], w[3]};
        if (F.lane == 0) WSN[r] = mx * (1.0f / 127.0f);
    }
}
__device__ __forceinline__ void p4_conv(Frame& F) {
    const int gw = F.vcu * 8 + F.wave, NGW = F.G * 8, ch = F.lane * 8;
    const bf16* U = WSP(bf16, WS_U); const bf16* GBp = WSP(bf16, WS_GB); bf16* CAT = WSP(bf16, WS_CAT);
    const float* conv_w = (const float*)F.in[13]; const float* conv_b = (const float*)F.in[14]; const float* cache_conv = (const float*)F.in[5];
    float w0[8], w1[8], w2[8], cb[8];
#pragma unroll
    for (int e = 0; e < 8; ++e) { w0[e] = conv_w[ch + e]; w1[e] = conv_w[512 + ch + e]; w2[e] = conv_w[1024 + ch + e]; cb[e] = conv_b[ch + e]; }
    for (int c = gw; c < MTOT / 8; c += NGW) {
        const int r0 = 8 * c;
        v4u ur[10], gr[8];
#pragma unroll
        for (int e = 0; e < 10; ++e) { const int rr = r0 - 2 + e; ur[e] = *(const GAS v4u*)(U + (size_t)(rr < 0 ? 0 : rr) * 512 + ch); }
#pragma unroll
        for (int e = 0; e < 8; ++e) gr[e] = *(const GAS v4u*)(GBp + (size_t)(r0 + e) * 512 + ch);
        float um2[8], um1[8];
        unpack8(ur[0], um2); unpack8(ur[1], um1);
        if (r0 < MP && (r0 & (SEQ - 1)) == 0) {
#pragma unroll
            for (int e = 0; e < 8; ++e) { um2[e] = 0.f; um1[e] = 0.f; } }
#pragma unroll
        for (int e = 0; e < 8; ++e) {
            if (r0 >= MP && (e & 3) == 0) {
                const float* cc = cache_conv + (size_t)((r0 - MP + e) >> 2) * 2 * 512 + ch;
#pragma unroll
                for (int q = 0; q < 8; ++q) { um2[q] = cc[q]; um1[q] = cc[512 + q]; } }
            float u0[8], g[8], y[8]; unpack8(ur[2 + e], u0); unpack8(gr[e], g);
#pragma unroll
            for (int q = 0; q < 8; ++q) { y[q] = g[q] * (cb[q] + w0[q] * um2[q] + w1[q] * um1[q] + w2[q] * u0[q]); um2[q] = um1[q]; um1[q] = u0[q]; }
            v4u o; o.x = pk2(y[0], y[1]); o.y = pk2(y[2], y[3]); o.z = pk2(y[4], y[5]); o.w = pk2(y[6], y[7]);
            *(GAS v4u*)(CAT + (size_t)(r0 + e) * D + ch) = o;
        }
    }
}
__device__ __forceinline__ int crow16(int r, int hi) { return (r & 3) + 8 * (r >> 2) + 4 * hi; }
__device__ __forceinline__ float xhalf_sum(float v) {
    auto rr = __builtin_amdgcn_permlane32_swap(__float_as_uint(v), __float_as_uint(v), false, false);
    return __uint_as_float(rr[0]) + __uint_as_float(rr[1]);
}
__device__ __forceinline__ void p4_sample_scores(Frame& F) {
    const int gw = F.vcu * 8 + F.wave, NGW = F.G * 8, lane = F.lane, r32 = lane & 31, hi = lane >> 5;
    const bf16* QI = WSP(bf16, WS_QI); const float* WIp = WSP(float, WS_WI); float* SSC = WSP(float, WS_SSC);
    const int* page_table = (const int*)F.in[6]; const float* cache_idx_k = (const float*)F.in[4];
    for (int item = gw; item < DB * NPAGES; item += NGW) {
        const int b = item >> 7, pg = item & 127; const int page = page_table[b * NPAGES + pg];
        bf16x8 a[4]; f32x4 w4[4];
        { const bf16* qrow = QI + (size_t)(MP + 4 * b + (r32 >> 3)) * 512 + (r32 & 7) * 64 + 8 * hi;
#pragma unroll
          for (int s = 0; s < 4; ++s) a[s] = *(const GAS bf16x8*)(qrow + 16 * s);
#pragma unroll
          for (int q = 0; q < 4; ++q) w4[q] = *(const GAS f32x4*)(WIp + (size_t)(MP + 4 * b + q) * 8 + 4 * hi); }
        const float* src = cache_idx_k + ((size_t)page * PAGE + r32) * 64 + 8 * hi;
        f32x4 lo[4][4], hh[4][4];
#pragma unroll
        for (int sub = 0; sub < 4; ++sub)
#pragma unroll
            for (int s = 0; s < 4; ++s) { lo[sub][s] = __builtin_nontemporal_load((const f32x4*)(src + sub * 32 * 64 + 16 * s)); hh[sub][s] = __builtin_nontemporal_load((const f32x4*)(src + sub * 32 * 64 + 16 * s + 4)); }
#pragma unroll
        for (int sub = 0; sub < 4; ++sub) {
            f32x16 acc = {};
#pragma unroll
            for (int s = 0; s < 4; ++s) { v4u p; p.x = pk2(lo[sub][s][0], lo[sub][s][1]); p.y = pk2(lo[sub][s][2], lo[sub][s][3]); p.z = pk2(hh[sub][s][0], hh[sub][s][1]); p.w = pk2(hh[sub][s][2], hh[sub][s][3]);
                acc = __builtin_amdgcn_mfma_f32_32x32x16_bf16(a[s], __builtin_bit_cast(bf16x8, p), acc, 0, 0, 0); }
#pragma unroll
            for (int q = 0; q < 4; ++q) {
                float sum = w4[q][0] * fmaxf(acc[4 * q], 0.f) + w4[q][1] * fmaxf(acc[4 * q + 1], 0.f) + w4[q][2] * fmaxf(acc[4 * q + 2], 0.f) + w4[q][3] * fmaxf(acc[4 * q + 3], 0.f);
                sum = xhalf_sum(sum) + 0.0f;
                if ((q >> 1) == hi) SSC[(size_t)(4 * b + q) * SSTR + pg * PAGE + sub * 32 + r32] = sum;
            }
        }
    }
}
__device__ __forceinline__ unsigned fkey(float s) { const unsigned b = __builtin_bit_cast(unsigned, s); return b ^ ((unsigned)((int)b >> 31) | 0x80000000u); }
__device__ __forceinline__ float unfkey(unsigned k) { const unsigned b = (k & 0x80000000u) ? (k ^ 0x80000000u) : ~k; return __builtin_bit_cast(float, b); }
__device__ __forceinline__ unsigned wave_umax(unsigned v) {
    unsigned o;
    o = (unsigned)__builtin_amdgcn_update_dpp(0, (int)v, 0xB1, 0xF, 0xF, true); v = o > v ? o : v;
    o = (unsigned)__builtin_amdgcn_update_dpp(0, (int)v, 0x4E, 0xF, 0xF, true); v = o > v ? o : v;
    o = (unsigned)__builtin_amdgcn_update_dpp(0, (int)v, 0x141, 0xF, 0xF, true); v = o > v ? o : v;
    o = (unsigned)__builtin_amdgcn_update_dpp(0, (int)v, 0x140, 0xF, 0xF, true); v = o > v ? o : v;
    const unsigned a = (unsigned)__builtin_amdgcn_readlane((int)v, 0), b = (unsigned)__builtin_amdgcn_readlane((int)v, 16), c = (unsigned)__builtin_amdgcn_readlane((int)v, 32), d = (unsigned)__builtin_amdgcn_readlane((int)v, 48);
    const unsigned ab = a > b ? a : b, cd = c > d ? c : d; return ab > cd ? ab : cd;
}
__device__ __forceinline__ int wave_count(unsigned cl) {
    int tot = 0;
#pragma unroll
    for (int bb = 0; bb < 6; ++bb) tot += __popcll(__ballot((cl >> bb) & 1u)) << bb;
    return tot;
}
__device__ __forceinline__ void p4_index_preload(Frame& F, int b, int j, bf16x8 (&a)[4][4], float& pwq) {
    const int tid = F.tid, r32 = F.lane & 31, hi = F.lane >> 5; const size_t rowb = (size_t)b * SEQ; const int t0 = 16 * j;
    const bf16* QI = WSP(bf16, WS_QI); const float* WIp = WSP(float, WS_WI);
    pwq = WIp[(rowb + t0 + ((tid & 127) >> 3)) * 8 + (tid & 7)];
#pragma unroll
    for (int rt = 0; rt < 4; ++rt) { const bf16* qrow = QI + (rowb + t0 + 4 * rt + 2 * (r32 >> 4) + ((r32 >> 2) & 1)) * 512 + (4 * ((r32 >> 3) & 1) + (r32 & 3)) * 64 + 8 * hi;
#pragma unroll
        for (int s = 0; s < 4; ++s) a[rt][s] = *(const GAS bf16x8*)(qrow + 16 * s); }
}
__device__ __forceinline__ void p4_index_unit(Frame& F, int b, int j, int useq, bf16x8 (&a)[4][4], float& pwq, int nj) {
    int tid_ = F.tid; asm volatile("" : "+v"(tid_));
    const int tid = tid_, lane = tid & 63, wid = F.wave, r32 = lane & 31, hi = lane >> 5;
    const int ss_id = (F.vcu * 8 + useq) * 8 + wid, ss_item = ss_id >> 2, ss_sub = ss_id & 3, ss_b = ss_item >> 7, ss_pg = ss_item & 127;
    const bool ss_on = F.vcu < 256;
    const int ss_page = ss_on ? ((const int*)F.in[6])[ss_b * NPAGES + ss_pg] : 0;
    const int t0 = 16 * j, nk = t0 + 16, ntile = (nk + 31) >> 5;
    LAS float* S = (LAS float*)(F.lds + RING_OFF);
    LAS float* WQ = (LAS float*)(F.lds + RING_OFF + 131072);
    LAS unsigned long long* MSK = (LAS unsigned long long*)(F.lds + RING_OFF + 131072 + 512);
    LAS unsigned* HW = (LAS unsigned*)(F.lds + RING_OFF + 131072 + 512 + 4096) + wid * 512;
    const bf16* QI = WSP(bf16, WS_QI); const bf16* KIB = WSP(bf16, WS_KIB); const float* WIp = WSP(float, WS_WI);
    unsigned long long* MASK = WSP(unsigned long long, WS_MASK);
    const size_t rowb = (size_t)b * SEQ;
    for (int rep43 = 0; rep43 < (PROBE_DUP == 43 ? 2 : 1); ++rep43)
    if (j >= 16) {
        if (tid < 128) WQ[tid] = pwq;
        const bf16* kbase = KIB + (rowb + r32) * 64 + 8 * hi;
#define IDX_LOADB(dst, kt_) do { const int kc_ = (kt_) < ntile ? (kt_) : ntile - 1; _Pragma("unroll") for (int s = 0; s < 4; ++s) dst[s] = *(const GAS bf16x8*)(kbase + (size_t)kc_ * 32 * 64 + 16 * s); } while (0)
#define RELU_(x_) __builtin_amdgcn_fmed3f((x_), 0.f, inf_)
#define IDX_COMPUTE(bf_, kt_) do { const int key = (kt_) * 32 + r32; \
            _Pragma("unroll") for (int rt = 0; rt < 4; ++rt) { f32x16 acc = {}; \
                _Pragma("unroll") for (int s = 0; s < 4; ++s) acc = __builtin_amdgcn_mfma_f32_32x32x16_bf16(a[rt][s], bf_[s], acc, 0, 0, 0); \
                _Pragma("unroll") for (int qp = 0; qp < 2; ++qp) { const int ql_ = 4 * rt + 2 * qp + hi;                      \
                    const f32x4 wa = *(const LAS f32x4*)(WQ + ql_ * 8), wb = *(const LAS f32x4*)(WQ + ql_ * 8 + 4); \
                      \
                    float e0_ = RELU_(acc[8 * qp + 0]) * wa[0], e1_ = RELU_(acc[8 * qp + 1]) * wa[1]; \
                    e0_ = __builtin_fmaf(RELU_(acc[8 * qp + 2]), wa[2], e0_); e1_ = __builtin_fmaf(RELU_(acc[8 * qp + 3]), wa[3], e1_); \
                    e0_ = __builtin_fmaf(RELU_(acc[8 * qp + 4]), wb[0], e0_); e1_ = __builtin_fmaf(RELU_(acc[8 * qp + 5]), wb[1], e1_); \
                    e0_ = __builtin_fmaf(RELU_(acc[8 * qp + 6]), wb[2], e0_); e1_ = __builtin_fmaf(RELU_(acc[8 * qp + 7]), wb[3], e1_); \
                    S[ql_ * 2048 + key] = (e0_ + e1_) + 0.0f; } } } while (0)
        float inf_ = __builtin_inff(); asm volatile("" : "+v"(inf_));
        bf16x8 bfA[4], bfB[4];
        IDX_LOADB(bfA, wid);
        __syncthreads();
        for (int kt = wid; kt < ntile; kt += 16) {
            IDX_LOADB(bfB, kt + 8);
            IDX_COMPUTE(bfA, kt);
            if (kt + 8 < ntile) { IDX_LOADB(bfA, kt + 16); IDX_COMPUTE(bfB, kt + 8); }
        }
#undef IDX_LOADB
#undef IDX_COMPUTE
#undef RELU_
        __syncthreads();
    }
    f32x4 ss_lo[4], ss_hh[4];
    { const float* src = ((const float*)F.in[4]) + ((size_t)ss_page * PAGE + ss_sub * 32 + r32) * 64 + 8 * hi;
#pragma unroll
      for (int s = 0; s < 4; ++s) { ss_lo[s] = __builtin_nontemporal_load((const f32x4*)(src + 16 * s)); ss_hh[s] = __builtin_nontemporal_load((const f32x4*)(src + 16 * s + 4)); }
    }
#pragma unroll 1
    for (int rep44 = 0; rep44 < (PROBE_DUP == 44 ? 2 : 1); ++rep44) {
        const int qlA = 2 * wid, tA = t0 + qlA, tB = tA + 1;
        unsigned wloA = 0u, whiA = 0u, wloB = 0u, whiB = 0u;
        if (tA < KTOP) {
            const int lo_ = 64 * lane;
            const unsigned long long wA_ = (lo_ + 63 <= tA) ? ~0ull : (lo_ > tA ? 0ull : ((1ull << (tA - lo_ + 1)) - 1ull)), wB_ = (lo_ + 63 <= tB) ? ~0ull : (lo_ > tB ? 0ull : ((1ull << (tB - lo_ + 1)) - 1ull));
            wloA = (unsigned)wA_; whiA = (unsigned)(wA_ >> 32); wloB = (unsigned)wB_; whiB = (unsigned)(wB_ >> 32);
        } else {
            bool doneA = false, doneB = false;
            { unsigned kvA[32], kvB[32]; float amA = 0.f, amB = 0.f;
              const int ngr = (tA >> 8) + 1;
#pragma unroll
              for (int g4 = 0; g4 < 8; ++g4) {
#pragma unroll
                  for (int e = 0; e < 4; ++e) { kvA[4 * g4 + e] = 0u; kvB[4 * g4 + e] = 0u; }
                  if (g4 < ngr) {
                      float sA[4], sB[4];
#pragma unroll
                      for (int e = 0; e < 4; ++e) { sA[e] = S[qlA * 2048 + lane + 64 * (4 * g4 + e)]; sB[e] = S[qlA * 2048 + 2048 + lane + 64 * (4 * g4 + e)]; }
                      if (g4 == ngr - 1) {
#pragma unroll
                          for (int e = 0; e < 4; ++e) { const int ki = lane + 64 * (4 * g4 + e); sA[e] = (ki <= tA) ? sA[e] : 0.f; sB[e] = (ki <= tB) ? sB[e] : 0.f; } }
#pragma unroll
                      for (int e = 0; e < 4; ++e) { kvA[4 * g4 + e] = __float_as_uint(sA[e]); amA = fmaxf(amA, fabsf(sA[e])); kvB[4 * g4 + e] = __float_as_uint(sB[e]); amB = fmaxf(amB, fabsf(sB[e])); } } }
              const unsigned umA = wave_umax(__float_as_uint(amA)), umB = wave_umax(__float_as_uint(amB));
              const float scaleA = umA ? 0.4999f / __uint_as_float(umA) : 0.f, scaleB = umB ? 0.4999f / __uint_as_float(umB) : 0.f;
#pragma unroll
              for (int g4 = 0; g4 < 8; ++g4) if (g4 < ngr) {
#pragma unroll
                  for (int e = 0; e < 4; ++e) { const int jj = 4 * g4 + e; kvA[jj] = __float_as_uint(__builtin_fmaf(__uint_as_float(kvA[jj]), scaleA, 1.5f)); kvB[jj] = __float_as_uint(__builtin_fmaf(__uint_as_float(kvB[jj]), scaleB, 1.5f)); }
                  if (g4 == ngr - 1) {
#pragma unroll
                      for (int e = 0; e < 4; ++e) { const int jj = 4 * g4 + e; kvA[jj] = (lane + 64 * jj <= tA) ? kvA[jj] : 0u; kvB[jj] = (lane + 64 * jj <= tB) ? kvB[jj] : 0u; } } }
              unsigned pfxA = 0x3F800000u, pfxB = 0x3F800000u, TvA = 0u, TvB = 0u; int needA = KTOP, needB = KTOP;
              const unsigned hwbA = (unsigned)(uintptr_t)HW, hwbB = hwbA + 1024u;
              LAS unsigned* HWB = HW + 256;
#pragma unroll 1
              for (int pass = 0; pass < 3; ++pass) {
                  const int sh = pass == 0 ? 15 : pass == 1 ? 7 : 0;
                  const unsigned lim = pass == 2 ? 128u : (256u << sh);
                  const unsigned limA = doneA ? 0u : lim, limB = doneB ? 0u : lim;
                  *(LAS v4u*)(HW + 4 * lane) = (v4u){0u, 0u, 0u, 0u}; *(LAS v4u*)(HWB + 4 * lane) = (v4u){0u, 0u, 0u, 0u};
                  asm volatile("" ::: "memory");
#pragma unroll
                  for (int g4 = 0; g4 < 8; ++g4) if (g4 < ngr) {
#pragma unroll
                      for (int e = 0; e < 4; ++e) { const unsigned dA_ = kvA[4 * g4 + e] ^ pfxA, dB_ = kvB[4 * g4 + e] ^ pfxB;
                          if (dA_ < limA) __hip_atomic_fetch_add((LAS unsigned*)(uintptr_t)(hwbA + ((dA_ >> sh) << 2)), 1u, __ATOMIC_RELAXED, __HIP_MEMORY_SCOPE_WAVEFRONT);
                          if (dB_ < limB) __hip_atomic_fetch_add((LAS unsigned*)(uintptr_t)(hwbB + ((dB_ >> sh) << 2)), 1u, __ATOMIC_RELAXED, __HIP_MEMORY_SCOPE_WAVEFRONT); } }
                  asm volatile("" ::: "memory");
                  const v4u wA4 = *(const LAS v4u*)(HW + 4 * lane), wB4 = *(const LAS v4u*)(HWB + 4 * lane);
                  asm volatile("" ::: "memory");
#define SEL_SCAN(w4_, need_, HWX_, dgb_, above_, binc_) do { \
                      const unsigned ls_ = (w4_[0] + w4_[1]) + (w4_[2] + w4_[3]); unsigned p_ = ls_; \
                      p_ += (unsigned)__builtin_amdgcn_update_dpp(0, (int)p_, 0x111, 0xF, 0xF, false); p_ += (unsigned)__builtin_amdgcn_update_dpp(0, (int)p_, 0x112, 0xF, 0xF, false); \
                      p_ += (unsigned)__builtin_amdgcn_update_dpp(0, (int)p_, 0x114, 0xF, 0xF, false); p_ += (unsigned)__builtin_amdgcn_update_dpp(0, (int)p_, 0x118, 0xF, 0xF, false); \
                      const unsigned r0_ = (unsigned)__builtin_amdgcn_readlane((int)p_, 15), r1_ = (unsigned)__builtin_amdgcn_readlane((int)p_, 31), r2_ = (unsigned)__builtin_amdgcn_readlane((int)p_, 47), r3_ = (unsigned)__builtin_amdgcn_readlane((int)p_, 63); \
                      const int row_ = lane >> 4; p_ += (row_ == 0) ? 0u : (row_ == 1) ? r0_ : (row_ == 2) ? r0_ + r1_ : r0_ + r1_ + r2_; \
                      const unsigned abl_ = (r0_ + r1_ + r2_ + r3_) - p_;                                    \
                      const unsigned long long fm_ = __ballot((int)abl_ < (need_) && (int)(abl_ + ls_) >= (need_)); \
                      const int src_ = (int)__builtin_ctzll(fm_) & 63; \
                      const unsigned abs_ = (unsigned)__builtin_amdgcn_readlane((int)abl_, src_); \
                      const unsigned ci_ = ((lane & 15) < 4) ? (HWX_)[4 * src_ + (lane & 3)] : 0u;          \
                      unsigned sfx_ = ci_; \
                      sfx_ += (unsigned)__builtin_amdgcn_update_dpp(0, (int)sfx_, 0x101, 0xF, 0xF, false); sfx_ += (unsigned)__builtin_amdgcn_update_dpp(0, (int)sfx_, 0x102, 0xF, 0xF, false); \
                      const unsigned abi_ = abs_ + sfx_ - ci_;                                                \
                      const unsigned long long fb_ = __ballot(lane < 4 && (int)abi_ < (need_) && (int)(abi_ + ci_) >= (need_)); \
                      const int sl2_ = (int)__builtin_ctzll(fb_) & 63; \
                      dgb_ = (unsigned)(4 * src_ + sl2_); above_ = (unsigned)__builtin_amdgcn_readlane((int)abi_, sl2_); binc_ = (unsigned)__builtin_amdgcn_readlane((int)ci_, sl2_); } while (0)
                  unsigned dgA, abvA, bcA, dgB, abvB, bcB;
                  SEL_SCAN(wA4, needA, HW, dgA, abvA, bcA);
                  SEL_SCAN(wB4, needB, HWB, dgB, abvB, bcB);
#undef SEL_SCAN
                  if (!doneA) { pfxA |= dgA << sh; needA -= (int)abvA; TvA = pfxA; doneA = ((int)bcA == needA); }
                  if (!doneB) { pfxB |= dgB << sh; needB -= (int)abvB; TvB = pfxB; doneB = ((int)bcB == needB); }
                  if (doneA && doneB) break;
              }
#define SEL_MASK(kv_, Tv_, wlo_, whi_) do { _Pragma("unroll") for (int j4 = 0; j4 < 8; ++j4) if (j4 < ngr) { \
                      const unsigned long long wa = __ballot(kv_[4 * j4] >= Tv_), wb = __ballot(kv_[4 * j4 + 1] >= Tv_), wc_ = __ballot(kv_[4 * j4 + 2] >= Tv_), wd = __ballot(kv_[4 * j4 + 3] >= Tv_); \
                      asm("s_nop 1\n\tv_writelane_b32 %0, %2, %10\n\tv_writelane_b32 %1, %3, %10\n\tv_writelane_b32 %0, %4, %11\n\tv_writelane_b32 %1, %5, %11\n\tv_writelane_b32 %0, %6, %12\n\tv_writelane_b32 %1, %7, %12\n\tv_writelane_b32 %0, %8, %13\n\tv_writelane_b32 %1, %9, %13" \
                          : "+v"(wlo_), "+v"(whi_) : "s"((unsigned)wa), "s"((unsigned)(wa >> 32)), "s"((unsigned)wb), "s"((unsigned)(wb >> 32)), "s"((unsigned)wc_), "s"((unsigned)(wc_ >> 32)), "s"((unsigned)wd), "s"((unsigned)(wd >> 32)), \
                            "n"(4 * j4), "n"(4 * j4 + 1), "n"(4 * j4 + 2), "n"(4 * j4 + 3)); } } while (0)
              if (doneA) SEL_MASK(kvA, TvA, wloA, whiA);
              if (doneB) SEL_MASK(kvB, TvB, wloB, whiB);
#undef SEL_MASK
            }
#pragma unroll 1
            for (int q2 = 0; q2 < 2; ++q2) {
            if (q2 == 0 ? doneA : doneB) continue;
            const int ql = qlA + q2, t = tA + q2; unsigned wlo = 0u, whi = 0u;
            unsigned uu[32];
#pragma unroll
            for (int jj = 0; jj < 32; ++jj) { const float s = S[ql * 2048 + lane + 64 * jj]; const unsigned k_ = fkey(s); uu[jj] = (lane + 64 * jj <= t) ? k_ : 0u; }
            const int ng = (t >> 8) + 1;
#define SEL_GRP(g4, CAND) if ((g4) < ng) { unsigned long long m0_, m1_, m2_, m3_; \
                    asm volatile("v_cmp_ge_u32_e64 %0, %4, %8\n\tv_cmp_ge_u32_e64 %1, %5, %8\n\tv_cmp_ge_u32_e64 %2, %6, %8\n\tv_cmp_ge_u32_e64 %3, %7, %8" \
                        : "=&s"(m0_), "=&s"(m1_), "=&s"(m2_), "=&s"(m3_) : "v"(uu[4 * (g4)]), "v"(uu[4 * (g4) + 1]), "v"(uu[4 * (g4) + 2]), "v"(uu[4 * (g4) + 3]), "v"(CAND)); \
                    cnt_ += __popcll(m0_) + __popcll(m1_) + __popcll(m2_) + __popcll(m3_); }
#define SEL_COUNT(CAND, OUT) do { int cnt_ = 0; SEL_GRP(0, CAND) SEL_GRP(1, CAND) SEL_GRP(2, CAND) SEL_GRP(3, CAND) SEL_GRP(4, CAND) SEL_GRP(5, CAND) SEL_GRP(6, CAND) SEL_GRP(7, CAND) OUT = cnt_; } while (0)
            unsigned T = 0u; int clo = t + 1;
#pragma unroll 1
            for (int bit = 31; bit >= 0; --bit) {
                const unsigned cand = T | (1u << bit); int c; SEL_COUNT(cand, c);
                if (c >= KTOP) { T = cand; clo = c; if (c == KTOP) break; }
            }
            if (clo == KTOP) {
#pragma unroll
                for (int jj = 0; jj < 32; ++jj) { const unsigned long long word = __ballot(uu[jj] >= T);
                    asm("s_nop 1\n\tv_writelane_b32 %0, %2, %4\n\tv_writelane_b32 %1, %3, %4" : "+v"(wlo), "+v"(whi) : "s"((unsigned)word), "s"((unsigned)(word >> 32)), "n"(jj));     }
            } else {
                int cgt; { const unsigned Tp = T + 1u; SEL_COUNT(Tp, cgt); }
                const int need = KTOP - cgt; int running = 0;
#pragma unroll
                for (int jj = 0; jj < 32; ++jj) {
                    const unsigned long long eq = __ballot(uu[jj] == T);
                    const int rank = (int)__builtin_amdgcn_mbcnt_hi((unsigned)(eq >> 32), __builtin_amdgcn_mbcnt_lo((unsigned)eq, 0u));
                    const unsigned long long word = __ballot(uu[jj] > T || (uu[jj] == T && running + rank < need));
                    asm("s_nop 1\n\tv_writelane_b32 %0, %2, %4\n\tv_writelane_b32 %1, %3, %4" : "+v"(wlo), "+v"(whi) : "s"((unsigned)word), "s"((unsigned)(word >> 32)), "n"(jj));
                    running += __popcll(eq);
                }
            }
            if (q2 == 0) { wloA = wlo; whiA = whi; } else { wloB = wlo; whiB = whi; }
            }
#undef SEL_COUNT
#undef SEL_GRP
        }
        if (lane < 32) { MSK[qlA * 32 + lane] = ((unsigned long long)whiA << 32) | wloA; MSK[qlA * 32 + 32 + lane] = ((unsigned long long)whiB << 32) | wloB; }
    }
    bf16x8 ss_a[4]; f32x4 ss_w[4];
    { const bf16* qrow = QI + (size_t)(MP + 4 * ss_b + (r32 >> 3)) * 512 + (r32 & 7) * 64 + 8 * hi;
#pragma unroll
      for (int s = 0; s < 4; ++s) ss_a[s] = *(const GAS bf16x8*)(qrow + 16 * s);
#pragma unroll
      for (int q = 0; q < 4; ++q) ss_w[q] = *(const GAS f32x4*)(WIp + (size_t)(MP + 4 * ss_b + q) * 8 + 4 * hi); }
    if (nj >= 16) p4_index_preload(F, b, nj, a, pwq);
    if (ss_on) { f32x16 acc = {};
#pragma unroll
        for (int s = 0; s < 4; ++s) { v4u p; p.x = pk2(ss_lo[s][0], ss_lo[s][1]); p.y = pk2(ss_lo[s][2], ss_lo[s][3]); p.z = pk2(ss_hh[s][0], ss_hh[s][1]); p.w = pk2(ss_hh[s][2], ss_hh[s][3]);
            acc = __builtin_amdgcn_mfma_f32_32x32x16_bf16(ss_a[s], __builtin_bit_cast(bf16x8, p), acc, 0, 0, 0); }
        float* SSC = WSP(float, WS_SSC);
#pragma unroll
        for (int q = 0; q < 4; ++q) {
            float sum = ss_w[q][0] * fmaxf(acc[4 * q], 0.f) + ss_w[q][1] * fmaxf(acc[4 * q + 1], 0.f) + ss_w[q][2] * fmaxf(acc[4 * q + 2], 0.f) + ss_w[q][3] * fmaxf(acc[4 * q + 3], 0.f);
            sum = xhalf_sum(sum) + 0.0f;
            if ((q >> 1) == hi) SSC[(size_t)(4 * ss_b + q) * SSTR + ss_pg * PAGE + ss_sub * 32 + r32] = sum;
        } }
    __syncthreads();
    { const int jt = tid >> 4, ql = tid & 15; MASK[((size_t)b * 32 + jt) * SEQ + t0 + ql] = MSK[ql * 32 + jt]; }
    __syncthreads();
}
__device__ __forceinline__ void p4_index(Frame& F) {
    if (F.vcu >= 256) return;
    const int b = F.vcu >> 4, w = F.vcu & 15;
    bf16x8 pa[4][4]; float pwq;
    p4_index_preload(F, b, 127 - w, pa, pwq);
#pragma unroll 1
    for (int k = 0; k < 4; ++k) { const int j1 = w + 16 * k; p4_index_unit(F, b, 127 - j1, 2 * k, pa, pwq, j1); p4_index_unit(F, b, j1, 2 * k + 1, pa, pwq, k < 3 ? 127 - (j1 + 16) : -1); }
}

__device__ __forceinline__ int block_sum8(LAS int* red, int par, int wid, int lane, int v) {
    if (lane == 0) red[par * 8 + wid] = v;
    __syncthreads();
    int s = 0;
#pragma unroll
    for (int w = 0; w < 8; ++w) s += red[par * 8 + w];
    return s;
}
__device__ __forceinline__ void p5_sample_unit(Frame& F, int sq) {
    const int tid = F.tid, lane = F.lane, wid = F.wave;
    const int b = sq >> 2, qi_ = sq & 3, row = MP + sq;
    LAS unsigned char* L0 = F.lds + RING_OFF;
    LAS int* red = (LAS int*)(L0);
    LAS float* newsc = (LAS float*)(L0 + 64);
    LAS int* wcnt = (LAS int*)(L0 + 128);
    LAS int* eqw = (LAS int*)(L0 + 256);
    LAS int* selidx = (LAS int*)(L0 + 2048);
    LAS float* LG = (LAS float*)(L0 + 4096);
    LAS float* OP = (LAS float*)(L0 + 16384);
    const bf16* QI = WSP(bf16, WS_QI); const bf16* KIB = WSP(bf16, WS_KIB); const float* WIp = WSP(float, WS_WI); const float* SSC = WSP(float, WS_SSC);
    const bf16* Qb = WSP(bf16, WS_Q); bf16* CAT = WSP(bf16, WS_CAT);
    if (tid < 64) {
        const int h = (tid >> 2) & 7, jn = tid & 3; float dot = 0.f;
        const bf16* qp = QI + (size_t)row * 512 + h * 64; const bf16* kp = KIB + (size_t)(MP + 4 * b + jn) * 64;
        for (int d = 0; d < 64; ++d) dot += bf2f(qp[d]) * bf2f(kp[d]);
        float v = WIp[(size_t)row * 8 + h] * fmaxf(dot, 0.f);
        v += __shfl_xor(v, 4); v += __shfl_xor(v, 8); v += __shfl_xor(v, 16);
        if (tid < 4) newsc[tid] = (jn <= qi_) ? (v + 0.0f) : -INFINITY;
    }
    __syncthreads();
    unsigned uu[33];
#pragma unroll
    for (int jj = 0; jj < 32; ++jj) uu[jj] = fkey(SSC[(size_t)sq * SSTR + tid + 512 * jj]);
    uu[32] = tid < 4 ? fkey(newsc[tid]) : 0x007FFFFFu;
    unsigned T = 0u; int par = 0;
#pragma unroll 1
    for (int bit = 31; bit >= 0; --bit) {
        const unsigned cand = T | (1u << bit); int c = 0;
#pragma unroll
        for (int jj = 0; jj < 33; ++jj) c += __popcll(__ballot(uu[jj] >= cand));
        c = block_sum8(red, par, wid, lane, c); par ^= 1;
        if (c >= KTOP) { T = cand; if (c == KTOP) break; }
    }
    int cgt = 0;
#pragma unroll
    for (int jj = 0; jj < 33; ++jj) cgt += __popcll(__ballot(uu[jj] > T));
    cgt = block_sum8(red, par, wid, lane, cgt); par ^= 1;
    const int need = KTOP - cgt;
#pragma unroll
    for (int jj = 0; jj < 33; ++jj) { const int n = __popcll(__ballot(uu[jj] == T)); if (lane == 0) eqw[jj * 8 + wid] = n; }
    __syncthreads();
#define SEL_MASK(jj, eqbase, M) do { int below_ = 0, tot_ = 0; \
        _Pragma("unroll") for (int w = 0; w < 8; ++w) { const int n_ = eqw[(jj) * 8 + w]; tot_ += n_; below_ += (w < wid) ? n_ : 0; } \
        const unsigned long long eq_ = __ballot(uu[jj] == T); \
        const int rank_ = (eqbase) + below_ + (int)__builtin_amdgcn_mbcnt_hi((unsigned)(eq_ >> 32), __builtin_amdgcn_mbcnt_lo((unsigned)eq_, 0u)); \
        M = __ballot(uu[jj] > T || (uu[jj] == T && rank_ < need)); (eqbase) += tot_; } while (0)
    { int cw = 0, eqbase = 0;
#pragma unroll
      for (int jj = 0; jj < 33; ++jj) { unsigned long long m; SEL_MASK(jj, eqbase, m); cw += __popcll(m); }
      if (lane == 0) wcnt[wid] = cw; }
    __syncthreads();
    { int base = 0, eqbase = 0;
#pragma unroll
      for (int w = 0; w < 8; ++w) base += (w < wid) ? wcnt[w] : 0;
#pragma unroll
      for (int jj = 0; jj < 33; ++jj) { unsigned long long m; SEL_MASK(jj, eqbase, m);
          const int pos = base + (int)__builtin_amdgcn_mbcnt_hi((unsigned)(m >> 32), __builtin_amdgcn_mbcnt_lo((unsigned)m, 0u));
          if ((m >> lane) & 1ull) { if (pos < KTOP) selidx[pos] = (jj < 32) ? tid + 512 * jj : PAST + tid; }
          base += __popcll(m); } }
#undef SEL_MASK
    __syncthreads();
    const int kk = lane >> 3, ds = lane & 7;
    const float* kptr[4]; const float* vptr[4];
#pragma unroll
    for (int it = 0; it < 4; ++it) {
        const int kidx = selidx[32 * wid + 8 * it + kk];
        if (kidx < PAST) { const size_t pr = (size_t)((const int*)F.in[6])[b * NPAGES + (kidx >> 7)] * PAGE + (kidx & 127); kptr[it] = ((const float*)F.in[2]) + pr * 128 + 8 * ds; vptr[it] = ((const float*)F.in[3]) + pr * 128 + 8 * ds; }
        else { const size_t nr = (size_t)(4 * b + (kidx - PAST)); kptr[it] = F.out + O_KS + nr * 128 + 8 * ds; vptr[it] = F.out + O_VS + nr * 128 + 8 * ds; }
    }
#pragma unroll 1
    for (int g = 0; g < 2; ++g) {
        float qv[4][8];
#pragma unroll
        for (int r = 0; r < 4; ++r) { const v4u qq = *(const GAS v4u*)(Qb + (size_t)row * 512 + (4 * g + r) * 64 + 8 * ds);
#pragma unroll
            for (int e = 0; e < 4; ++e) { qv[r][2 * e] = bf2f((unsigned short)(qq[e] & 0xffffu)); qv[r][2 * e + 1] = bf2f((unsigned short)(qq[e] >> 16)); } }
#pragma unroll
        for (int it = 0; it < 4; ++it) {
            const f32x4 k0 = *(const f32x4*)(kptr[it] + 64 * g), k1 = *(const f32x4*)(kptr[it] + 64 * g + 4);
#pragma unroll
            for (int r = 0; r < 4; ++r) {
                float d = (qv[r][0] * k0[0] + qv[r][1] * k0[1]) + (qv[r][2] * k0[2] + qv[r][3] * k0[3]) + (qv[r][4] * k1[0] + qv[r][5] * k1[1]) + (qv[r][6] * k1[2] + qv[r][7] * k1[3]);
                d += __shfl_xor(d, 1); d += __shfl_xor(d, 2); d += __shfl_xor(d, 4);
                if (ds == 0) LG[(4 * g + r) * 256 + 32 * wid + 8 * it + kk] = d;
            }
        }
    }
    __syncthreads();
    { float l[4];
#pragma unroll
      for (int e = 0; e < 4; ++e) l[e] = LG[wid * 256 + lane + 64 * e];
      const float m = wave_max(fmaxf(fmaxf(l[0], l[1]), fmaxf(l[2], l[3])));
      float p[4], s = 0.f;
#pragma unroll
      for (int e = 0; e < 4; ++e) { p[e] = __builtin_amdgcn_exp2f(l[e] - m); s += p[e]; }
      s = wave_sum(s); const float inv = 1.0f / s;
#pragma unroll
      for (int e = 0; e < 4; ++e) LG[wid * 256 + lane + 64 * e] = p[e] * inv; }
    __syncthreads();
#pragma unroll 1
    for (int g = 0; g < 2; ++g) {
        float acc[4][8];
#pragma unroll
        for (int r = 0; r < 4; ++r)
#pragma unroll
            for (int e = 0; e < 8; ++e) acc[r][e] = 0.f;
#pragma unroll
        for (int it = 0; it < 4; ++it) {
            const f32x4 v0 = *(const f32x4*)(vptr[it] + 64 * g), v1 = *(const f32x4*)(vptr[it] + 64 * g + 4);
#pragma unroll
            for (int r = 0; r < 4; ++r) { const float p = LG[(4 * g + r) * 256 + 32 * wid + 8 * it + kk];
#pragma unroll
                for (int e = 0; e < 4; ++e) { acc[r][e] += p * v0[e]; acc[r][4 + e] += p * v1[e]; } }
        }
#pragma unroll
        for (int r = 0; r < 4; ++r)
#pragma unroll
            for (int e = 0; e < 8; ++e) { float a = acc[r][e]; a += __shfl_xor(a, 8); a += __shfl_xor(a, 16); a += __shfl_xor(a, 32); if (kk == 0) OP[(wid * 8 + 4 * g + r) * 64 + 8 * ds + e] = a; }
    }
    __syncthreads();
    { const int hd = tid >> 6, d = tid & 63; float o = 0.f;
#pragma unroll
      for (int w = 0; w < 8; ++w) o += OP[(w * 8 + hd) * 64 + d];
      CAT[(size_t)row * D + 512 + hd * 64 + d] = (bf16)f2bf(o); }
    __syncthreads();
}

constexpr int N_PHASES = 9;
struct Args { const void* in[22]; float* out; unsigned char* ws; int ph_lo, ph_hi, use_bar, pad; };
__global__ void __launch_bounds__(512, 2) hymba_fwd(Args args) {
    extern __shared__ __attribute__((aligned(16))) unsigned char lds[];
    Frame F;
    F.lds = (LAS unsigned char*)lds;
    F.MISC = (volatile LAS unsigned*)(F.lds + MISC_OFF);
    F.tid = threadIdx.x; F.lane = F.tid & 63; F.wave = __builtin_amdgcn_readfirstlane(F.tid >> 6);
    F.G = gridDim.x; { const int bx = blockIdx.x; F.vcu = (F.G % 8 == 0) ? (bx % 8) * (F.G / 8) + bx / 8 : bx; }
    F.ws = args.ws; F.out = args.out; F.ctl = (gu32*)(args.ws + WS_CTL);
    F.in = args.in;
    for (int u = F.tid; u < (LDS_BYTES - LDSCTL_OFF) / 4; u += 512) ((LAS unsigned*)(F.lds + LDSCTL_OFF))[u] = 0u;
    __syncthreads();
    XcdBarrier bar; bar.bar = (unsigned*)(F.ctl + CW_BAR); bar.x = 0; bar.st = nullptr;
    if (args.use_bar) bar = xcd_barrier_post((unsigned*)(F.ctl + CW_BAR), F.MISC + 8);
    const int lo = args.ph_lo, hi = args.ph_hi;
#define IN(k) (lo <= (k) && (k) < hi)
#define SEAM(k) do { if (IN(k) && IN((k) + 1)) { xcd_barrier(bar); if (PROBE_DUP == 60) xcd_barrier(bar); } } while (0)
    const int cblk = (int)blockIdx.x;

#ifndef PROBE_DUP
#define PROBE_DUP (-1)
#endif
#define RUNPHASE(k, ...) do { if (IN(k)) { { int t_ = F.tid; asm volatile("" : "+v"(t_)); F.tid = t_; F.lane = t_ & 63; }     \
        __VA_ARGS__; if (PROBE_DUP == (k)) { if (args.use_bar) xcd_barrier(bar); __VA_ARGS__; } } SEAM(k); } while (0)
#define RSTAB ((LAS float*)(F.lds + RING_OFF + 131072))
#define GEMM_PHASE(EPI, A_, B_, N_, K_, SS_, NSLOT_, ...) do { pg8::Gemm g{A_, B_, MP, N_, K_}; pg8::StaticOrder S; S.init(MP, N_, F.G, cblk); \
        if ((NSLOT_) > 0) fill_rstd_table(RSTAB, S, SS_, NSLOT_); \
        EPI E{__VA_ARGS__}; \
        pg8::gemm_phase<EPI, pg8::StaticOrder, true, true>(F.lds + RING_OFF, g, S, E); \
        { int nrep_ = (PROBE_DUP == 50) ? 2 : 1; asm volatile("" : "+s"(nrep_)); for (int rep_ = 0; rep_ < nrep_; ++rep_) skinny_phase<EPI, 2, 0>(F.lds + RING_OFF, A_, B_, N_, (K_) * 2, cblk, F.G, E); } } while (0)
#define GEMM_PHASE8(EPI, A8_, B8_, OSC_, N_, K_, SS_, NSLOT_, ...) do { pg8::Gemm g{(const bf16*)(A8_), (const bf16*)(B8_), MP, N_, (K_) / 2}; pg8::StaticOrder S; S.init(MP, N_, F.G, cblk); \
        if ((NSLOT_) > 0) fill_rstd_table(RSTAB, S, SS_, NSLOT_); \
        EPI E{__VA_ARGS__}; \
        pg8::gemm_phase<EPI, pg8::StaticOrder, true, true, 1>(F.lds + RING_OFF, g, S, E); \
        { int nrep_ = (PROBE_DUP == 55) ? 2 : 1; asm volatile("" : "+s"(nrep_)); for (int rep_ = 0; rep_ < nrep_; ++rep_) skinny_phase<EPI, 2, 1>(F.lds + RING_OFF, A8_, B8_, N_, K_, cblk, F.G, E, nullptr, nullptr, OSC_); } } while (0)
#define GEMM_PHASEI(EPI, A8_, B8_, XS_, WSN_, N_, K_, SS_, NSLOT_, ...) do { pg8::Gemm g{(const bf16*)(A8_), (const bf16*)(B8_), MP, N_, (K_) / 2}; pg8::StaticOrder S; S.init(MP, N_, F.G, cblk); \
        fill_rstd_table(RSTAB, S, SS_, NSLOT_, XS_); \
        EPI E{__VA_ARGS__}; \
        pg8::gemm_phase<EPI, pg8::StaticOrder, true, true, 2>(F.lds + RING_OFF, g, S, E); \
        { int nrep_ = (PROBE_DUP == 55) ? 2 : 1; asm volatile("" : "+s"(nrep_)); for (int rep_ = 0; rep_ < nrep_; ++rep_) skinny_phase<EPI, 4, 2>(F.lds + RING_OFF, A8_, B8_, N_, K_, cblk, F.G, E, XS_, WSN_); } } while (0)
    RUNPHASE(0, do { p0_prologue(F); xcd_barrier(bar); p0b_quant_weights(F); } while (0));
    RUNPHASE(1, GEMM_PHASEI(EpiGU, WSP(unsigned char, WS_XI8), WSP(unsigned char, WS_WGU1I8), WSP(float, WS_XS), WSP(float, WS_WSN), 2 * DFF, D, WSP(float, WS_SS0), 1, WSP(bf16, WS_H), WSP(float, WS_SS0), 1, RSTAB, 1.0f, WSP(unsigned char, WS_H8), WSP(float, WS_WSN)));
    RUNPHASE(2, GEMM_PHASE8(EpiRes<0>, WSP(unsigned char, WS_H8), WSP(unsigned char, WS_WD1_8), 1.0f / (W8SCALE * H8SCALE), D, DFF, nullptr, 0, WSP(bf16, WS_XB), nullptr, WSP(bf16, WS_X1B), WSP(float, WS_SS1), nullptr, 1.0f / (W8SCALE * H8SCALE), (const float*)F.in[0], (const float*)F.in[1]));
#if PROBE_DUP >= 21 && PROBE_DUP <= 23
    if (IN(2)) { xcd_barrier(bar); pg8::Gemm g{(const bf16*)WSP(unsigned char, WS_H8), (const bf16*)WSP(unsigned char, WS_WD1_8), MP, D, DFF / 2}; pg8::StaticOrder S; S.init(MP, D, F.G, cblk);
        EpiRes<0> E{WSP(bf16, WS_XB), nullptr, WSP(bf16, WS_X2B), WSP(float, WS_SS2), nullptr, 1.0f / (W8SCALE * H8SCALE), (const float*)F.in[0], (const float*)F.in[1]};
        pg8::gemm_phase<EpiRes<0>, pg8::StaticOrder, true, true, (PROBE_DUP == 21 ? 1 : PROBE_DUP == 22 ? 2 : 0)>(F.lds + RING_OFF, g, S, E); xcd_barrier(bar); }
#endif
    RUNPHASE(3, GEMM_PHASE(EpiWin, WSP(bf16, WS_X1B), WSP(bf16, WS_WIN), NINP, D, WSP(float, WS_SS1), 16, F.ws, F.out, (const float*)F.in[15], (const float*)F.in[16], RSTAB));
    RUNPHASE(4, do { p4_conv(F); if (PROBE_DUP == 40) p4_conv(F); p4_index(F); if (PROBE_DUP == 42) p4_index(F); } while (0));
    RUNPHASE(5, do { if ((F.vcu & 1) == 0 && F.vcu < 256) { p5_sample_unit(F, F.vcu >> 1); if (PROBE_DUP == 51) p5_sample_unit(F, F.vcu >> 1); }
        const attn_body::AttnTensors AT{(const attn_body::bf16*)WSP(bf16, WS_Q), (const attn_body::bf16*)WSP(bf16, WS_KB), (const attn_body::bf16*)WSP(bf16, WS_VB), WSP(unsigned long long, WS_MASK), (attn_body::bf16*)WSP(bf16, WS_CAT)};
        const attn_body::StaticOrder S(F.vcu); attn_body::attn_phase<attn_body::StaticOrder>((char*)lds + RING_OFF, AT, S); } while (0));
    RUNPHASE(6, do { GEMM_PHASE(EpiRes<1>, WSP(bf16, WS_CAT), WSP(bf16, WS_WOUT), D, D, nullptr, 0, WSP(bf16, WS_X1B), nullptr, WSP(bf16, WS_X2B), WSP(float, WS_SS2), nullptr, 1.0f);
                     xcd_barrier(bar); quant_rows_pass(F.vcu * 8 + F.wave, F.G * 8, WSP(bf16, WS_X2B), WSP(unsigned char, WS_X2I8), WSP(float, WS_XS2), MTOT); } while (0));
    RUNPHASE(7, GEMM_PHASEI(EpiGU, WSP(unsigned char, WS_X2I8), WSP(unsigned char, WS_WGU2I8), WSP(float, WS_XS2), WSP(float, WS_WSN2), 2 * DFF, D, WSP(float, WS_SS2), 16, WSP(bf16, WS_H), WSP(float, WS_SS2), 16, RSTAB, 1.0f, WSP(unsigned char, WS_H8), WSP(float, WS_WSN2)));
    RUNPHASE(8, GEMM_PHASE8(EpiRes<2>, WSP(unsigned char, WS_H8), WSP(unsigned char, WS_WD2_8), 1.0f / (W8SCALE * H8SCALE), D, DFF, nullptr, 0, WSP(bf16, WS_X2B), F.out, nullptr, nullptr, nullptr, 1.0f / (W8SCALE * H8SCALE)));
#undef RUNPHASE
#undef GEMM_PHASE
#undef GEMM_PHASE8
#undef GEMM_PHASEI
#undef RSTAB
#undef IN
#undef SEAM
}

#ifndef MK_N_LAUNCHES
#define MK_N_LAUNCHES 1
#endif
extern "C" void kernel_launch(void* const* d_in, const int* in_sizes, int n_in, void* d_out, int out_size, void* d_ws, size_t ws_size, hipStream_t stream) {
    static int grid = 0;
    if (grid == 0) {
        if (n_in != 22 || out_size != (int)O_END || ws_size < WS_END) { fprintf(stderr, "kernel_launch: unexpected problem: n_in %d out %d ws %zu (need %zu)\n", n_in, out_size, ws_size, (size_t)WS_END); grid = -1; return; }
        int dev = 0, cus = 0, per_cu = 0;
        if (hipGetDevice(&dev) != hipSuccess || hipDeviceGetAttribute(&cus, hipDeviceAttributeMultiprocessorCount, dev) != hipSuccess) { grid = -1; return; }
        if (hipFuncSetAttribute((const void*)hymba_fwd, hipFuncAttributeMaxDynamicSharedMemorySize, LDS_BYTES) != hipSuccess) { fprintf(stderr, "kernel_launch: hipFuncSetAttribute failed\n"); grid = -1; return; }
        if (hipOccupancyMaxActiveBlocksPerMultiprocessor(&per_cu, (const void*)hymba_fwd, 512, LDS_BYTES) != hipSuccess || per_cu < 1) { fprintf(stderr, "kernel_launch: occupancy query says %d blocks per CU\n", per_cu); (void)hipGetLastError(); grid = -1; return; }
        grid = cus;
        if (grid % 8 != 0 || grid < 8) { fprintf(stderr, "kernel_launch: unexpected CU count %d\n", cus); grid = -1; return; }
    }
    if (grid < 0) return;
    (void)hipMemsetAsync((char*)d_ws + WS_CTL, 0, CTL_ZERO_BYTES, stream);
    Args a{};
    for (int i = 0; i < 22; ++i) a.in[i] = d_in[i];
    a.out = (float*)d_out; a.ws = (unsigned char*)d_ws;
    if (MK_N_LAUNCHES == 1) { a.ph_lo = 0; a.ph_hi = N_PHASES; a.use_bar = 1; hipLaunchKernelGGL(hymba_fwd, dim3(grid), dim3(512), LDS_BYTES, stream, a); }
    else for (int p = 0; p < N_PHASES; ++p) { a.ph_lo = p; a.ph_hi = p + 1; a.use_bar = 0; hipLaunchKernelGGL(hymba_fwd, dim3(grid), dim3(512), LDS_BYTES, stream, a); }
}
```

```cpp
#include <hip/hip_runtime.h>
#include <cstdio>
#include <cstdint>
#include <type_traits>
namespace pg8 {
#define PG8_LAS __attribute__((address_space(3)))
typedef unsigned short bf16_t;
typedef short bf16x8 __attribute__((ext_vector_type(8)));
typedef float f32x4 __attribute__((ext_vector_type(4)));
typedef unsigned u32x4 __attribute__((ext_vector_type(4)));
constexpr int BM = 256, BK = 64, HALF = 128, HTB = HALF * BK * 2  , STAGE_BYTES = 8 * HTB, NXCD = 8, WGM = 8;

__host__ __device__ __forceinline__ int lds_byte(int r, int c) { const int st = (r >> 4) * 2 + (c >> 5), rr = r & 15, cc = c & 31, ob = rr * 64 + cc * 2; return st * 1024 + (ob ^ (((ob >> 9) & 1) << 5)); }
__host__ __device__ __forceinline__ void stage_rc(int b, int& R, int& C) { const int st = b / 1024, sb = b % 1024, swz = sb ^ (((sb >> 9) & 1) << 5); R = (st >> 1) * 16 + swz / 64; C = (st & 1) * 32 + (swz % 64) / 2; }
__host__ __device__ __forceinline__ int perm32(int rho) { const int n = rho >> 4, i = rho & 15; return 8 * (i >> 2) + 4 * n + (i & 3); }

struct Unit { int pm, pn; };
struct Gemm { const bf16_t* A; const bf16_t* Bt; int M, N, K; };

struct StaticOrder {
    int nM, nN, nwg, G, c;
    __host__ __device__ void init(int M, int N, int G_, int c_) { nM = M / BM; nN = N / BM; nwg = nM * nN; G = G_; c = c_; }
    __host__ __device__ bool next(int i, Unit& u) const {
        const long L = (long)i * G + c; if (L >= nwg) return false;
        int wgid = (int)L; { const int q = nwg / NXCD, r = nwg % NXCD, xcd = wgid % NXCD, off = wgid / NXCD; wgid = (xcd < r ? xcd * (q + 1) : r * (q + 1) + (xcd - r) * q) + off; }
        const int nig = WGM * nN, gid = wgid / nig, fm = gid * WGM, gsz = (nM - fm) < WGM ? (nM - fm) : WGM;
        u.pm = fm + ((wgid % nig) % gsz); u.pn = (wgid % nig) / gsz; return true;
    }
    __device__ __forceinline__ void a_ready(const Unit&) const {}
    __device__ __forceinline__ void done(const Unit&) const {}
};
__device__ __forceinline__ unsigned cvt_pk_bf16(float lo, float hi) { unsigned r; asm volatile("v_cvt_pk_bf16_f32 %0, %1, %2" : "=v"(r) : "v"(lo), "v"(hi)); return r; }
template <class Epi, class Sched, bool ALIGN_EPI = false, bool SP2 = false, int QM = 0, int PFD = 0>
__device__ __forceinline__ void gemm_phase(PG8_LAS unsigned char* lds, const Gemm g, const Sched& S, const Epi& E) {
    const int tid = threadIdx.x, wid = __builtin_amdgcn_readfirstlane(tid >> 6), lane = tid & 63, wr = wid >> 2, wc = wid & 3, fr = lane & 15, fq = lane >> 4;
    const int K = g.K, nt = K / BK;
    unsigned voffA[2], voffB[2];
#pragma unroll
    for (int i = 0; i < 2; ++i) { int R, C; stage_rc(tid * 16 + i * 8192, R, C); const int Rb = Epi::PERM ? ((R & ~31) + perm32(R & 31)) : R;
        voffA[i] = (unsigned)(R * K + C) * 2u; voffB[i] = (unsigned)(Rb * K + C) * 2u; }
    unsigned voffP[2];
#pragma unroll
    for (int i = 0; i < 2; ++i) voffP[i] = (unsigned)((32 * wid + 16 * i + (lane >> 2)) * K) * 2u + (unsigned)(lane & 3) * 4u;
#define PG8_PF(s2, kt) do { if constexpr (PFD != 0) { const char* p_ = ((kt) < nt) ? cA + (size_t)(kt) * kstep : nA + (size_t)((kt) - nt) * kstep; \
        __builtin_amdgcn_global_load_lds((const unsigned*)(p_ + voffP[s2]), (PG8_LAS unsigned*)(lds + 143360 + wid * 256), 4, 0, 0); } } while (0)
#define PG8_WAIT_V8() do { if constexpr (PFD != 0) PG8_WAIT_V(10); else PG8_WAIT_V(8); } while (0)
    const size_t kstep = (size_t)(BK * 2);
    const size_t hstep = (size_t)HALF * K * 2;
    const size_t tstep = 2 * hstep;
    const unsigned ldsw = (unsigned)wid * 1024u;
    const int aoff = lds_byte(wr * 64 + fr, fq * 8), boff = lds_byte(wc * 32 + fr, fq * 8);
#define PG8_SA(b, h) (((b) * 2 + (h)) * HTB)
#define PG8_SB(b, h) ((4 + (b) * 2 + (h)) * HTB)
#define PG8_STAGE(bufoff, gbase, voff) do { _Pragma("unroll") for (int _i = 0; _i < 2; ++_i) \
        __builtin_amdgcn_global_load_lds((const unsigned*)((const char*)(gbase) + (voff)[_i]), (PG8_LAS unsigned*)(lds + (bufoff) + ldsw + _i * 8192), 16, 0, 0); } while (0)
#define PG8_LDF(dst_, addr_) do { if constexpr (QM == 1) { const pg8_v4i lo_ = *(const PG8_LAS pg8_v4i*)(addr_), hi_ = *(const PG8_LAS pg8_v4i*)((addr_) + 1024); \
            (dst_).v = __builtin_shufflevector(lo_, hi_, 0, 1, 2, 3, 4, 5, 6, 7); } \
        else { (dst_).k[0] = *(const PG8_LAS bf16x8*)(addr_); (dst_).k[1] = *(const PG8_LAS bf16x8*)((addr_) + 1024); } } while (0)
#define PG8_LDA(dst, b, h) do { _Pragma("unroll") for (int m = 0; m < 4; ++m) PG8_LDF(dst[m], lds + PG8_SA(b, h) + aoff + m * 2048); } while (0)
#define PG8_LDB(dst, b, h) do { _Pragma("unroll") for (int n = 0; n < 2; ++n) PG8_LDF(dst[n], lds + PG8_SB(b, h) + boff + n * 2048); } while (0)
#define PG8_MMA(ai, bj, At, Bt) do { __builtin_amdgcn_s_setprio(1); if constexpr (QM != 0) asm volatile("s_nop 4");     \
        _Pragma("unroll") for (int m = 0; m < 4; ++m) _Pragma("unroll") for (int n = 0; n < 2; ++n) { \
            if constexpr (QM == 1) asm volatile("v_mfma_scale_f32_16x16x128_f8f6f4 %0, %1, %2, %0, %3, %3 op_sel_hi:[0,0,0]" : "+v"(acc[ai][bj][m][n]) : "v"(Bt[n].v), "v"(At[m].v), "v"(scl8_));     \
            else if constexpr (QM == 2) { _Pragma("unroll") for (int k = 0; k < 2; ++k) asm volatile("v_mfma_i32_16x16x64_i8 %0, %1, %2, %0" : "+v"(acc[ai][bj][m][n]) : "v"(Bt[n].k[k]), "v"(At[m].k[k])); } \
            else { _Pragma("unroll") for (int k = 0; k < 2; ++k) acc[ai][bj][m][n] = __builtin_amdgcn_mfma_f32_16x16x32_bf16(Bt[n].k[k], At[m].k[k], acc[ai][bj][m][n], 0, 0, 0); } } \
        __builtin_amdgcn_s_setprio(0); } while (0)
#define PG8_WAIT_V(n) asm volatile("s_waitcnt vmcnt(" #n ")" ::: "memory")
#define PG8_WAIT_L(n) asm volatile("s_waitcnt lgkmcnt(" #n ")" ::: "memory")
#define PG8_BAR __builtin_amdgcn_s_barrier()
#define PG8_SCHED __builtin_amdgcn_sched_barrier(0)
    Unit cur, nxt; int ui = 0;
    if (!S.next(0, cur)) return;
    f32x4 acc[2][2][4][2];
    E.init(acc, cur, wr, wc, fr, fq);
    typedef int pg8_v8i __attribute__((ext_vector_type(8))); typedef int pg8_v4i __attribute__((ext_vector_type(4)));
    struct FragB { bf16x8 k[2]; }; struct Frag8 { pg8_v8i v; };
    typedef typename std::conditional<QM == 1, Frag8, FragB>::type Frag;
    Frag At[4], B0[2], B1[2];
    unsigned scl8_ = 0x7F7F7F7Fu; asm volatile("" : "+v"(scl8_));
    const char* cA = (const char*)g.A + (size_t)cur.pm * tstep; const char* cB = (const char*)g.Bt + (size_t)cur.pn * tstep;
    S.a_ready(cur);
    if constexpr (SP2) {
        PG8_STAGE(PG8_SB(0, 0), cB, voffB); PG8_STAGE(PG8_SB(0, 1), cB + hstep, voffB); PG8_STAGE(PG8_SA(0, 0), cA, voffA); PG8_STAGE(PG8_SA(0, 1), cA + hstep, voffA);
        if (wr == 1) PG8_BAR;
        PG8_WAIT_V(2); PG8_BAR;
        PG8_STAGE(PG8_SB(1, 0), cB + kstep, voffB); PG8_STAGE(PG8_SA(1, 0), cA + kstep, voffA); PG8_STAGE(PG8_SB(1, 1), cB + hstep + kstep, voffB);
        PG8_WAIT_V(6); PG8_BAR;
    } else {
        PG8_STAGE(PG8_SB(0, 0), cB, voffB); PG8_STAGE(PG8_SA(0, 0), cA, voffA); PG8_STAGE(PG8_SB(0, 1), cB + hstep, voffB); PG8_STAGE(PG8_SA(0, 1), cA + hstep, voffA);
        if (wr == 1) PG8_BAR;
        PG8_WAIT_V(4); PG8_BAR;
        PG8_STAGE(PG8_SB(1, 0), cB + kstep, voffB); PG8_STAGE(PG8_SA(1, 0), cA + kstep, voffA); PG8_STAGE(PG8_SB(1, 1), cB + hstep + kstep, voffB);
        PG8_WAIT_V(6); PG8_BAR;
    }
    for (;;) {
        const bool has_next = S.next(ui + 1, nxt);
        const char* nA = has_next ? (const char*)g.A + (size_t)nxt.pm * tstep : cA; const char* nB = has_next ? (const char*)g.Bt + (size_t)nxt.pn * tstep : cB;
#pragma unroll 1
        for (int t = 0; t < nt; t += 2) {
            const bool last = (t == nt - 2);
            const char* a1 = cA + (size_t)(t + 1) * kstep;
            const char* a2 = last ? nA : cA + (size_t)(t + 2) * kstep; const char* b2 = last ? nB : cB + (size_t)(t + 2) * kstep;
            const char* a3 = a2 + kstep; const char* b3 = b2 + kstep;
            if (last && has_next) S.a_ready(nxt);
            if constexpr (SP2) {
            PG8_LDB(B0, 0, 0); PG8_LDB(B1, 0, 1); PG8_SCHED; PG8_LDA(At, 0, 0); PG8_STAGE(PG8_SA(1, 1), a1 + hstep, voffA); PG8_PF(0, t + PFD);
            PG8_WAIT_V8(); PG8_WAIT_L(0); PG8_BAR; PG8_MMA(0, 0, At, B0); PG8_MMA(0, 1, At, B1); PG8_BAR; PG8_SCHED;
            PG8_LDA(At, 0, 1); PG8_STAGE(PG8_SB(0, 0), b2, voffB); PG8_STAGE(PG8_SB(0, 1), b2 + hstep, voffB); PG8_STAGE(PG8_SA(0, 0), a2, voffA); PG8_PF(1, t + PFD);
            PG8_WAIT_V8(); PG8_WAIT_L(0); PG8_BAR; PG8_MMA(1, 0, At, B0); PG8_MMA(1, 1, At, B1); PG8_BAR; PG8_SCHED;
            PG8_LDB(B0, 1, 0); PG8_LDB(B1, 1, 1); PG8_SCHED; PG8_LDA(At, 1, 0); PG8_STAGE(PG8_SA(0, 1), a2 + hstep, voffA); PG8_PF(0, t + 1 + PFD);
            PG8_WAIT_V8(); PG8_WAIT_L(0); PG8_BAR; PG8_MMA(0, 0, At, B0); PG8_MMA(0, 1, At, B1); PG8_BAR; PG8_SCHED;
            PG8_LDA(At, 1, 1); PG8_STAGE(PG8_SB(1, 0), b3, voffB); PG8_STAGE(PG8_SB(1, 1), b3 + hstep, voffB); PG8_STAGE(PG8_SA(1, 0), a3, voffA); PG8_PF(1, t + 1 + PFD);
            PG8_WAIT_V8(); PG8_WAIT_L(0); PG8_BAR; PG8_MMA(1, 0, At, B0); PG8_MMA(1, 1, At, B1); PG8_BAR; PG8_SCHED;
            } else {
            PG8_LDB(B0, 0, 0); PG8_SCHED; PG8_LDA(At, 0, 0); PG8_STAGE(PG8_SA(1, 1), a1 + hstep, voffA);
            PG8_WAIT_L(8); PG8_BAR; PG8_WAIT_L(0); PG8_MMA(0, 0, At, B0); PG8_BAR; PG8_SCHED;
            PG8_LDB(B1, 0, 1); PG8_STAGE(PG8_SB(0, 0), b2, voffB);
            PG8_BAR; PG8_WAIT_L(0); PG8_MMA(0, 1, At, B1); PG8_BAR;
            PG8_LDA(At, 0, 1); PG8_STAGE(PG8_SA(0, 0), a2, voffA);
            PG8_BAR; PG8_WAIT_L(0); PG8_MMA(1, 0, At, B0); PG8_BAR; PG8_SCHED;
            PG8_STAGE(PG8_SB(0, 1), b2 + hstep, voffB);
            PG8_WAIT_V(6); PG8_BAR; PG8_MMA(1, 1, At, B1); PG8_BAR;
            PG8_LDB(B0, 1, 0); PG8_SCHED; PG8_LDA(At, 1, 0); PG8_STAGE(PG8_SA(0, 1), a2 + hstep, voffA);
            PG8_WAIT_L(8); PG8_BAR; PG8_WAIT_L(0); PG8_MMA(0, 0, At, B0); PG8_BAR; PG8_SCHED;
            PG8_LDB(B1, 1, 1); PG8_STAGE(PG8_SB(1, 0), b3, voffB);
            PG8_BAR; PG8_WAIT_L(0); PG8_MMA(0, 1, At, B1); PG8_BAR;
            PG8_LDA(At, 1, 1); PG8_STAGE(PG8_SA(1, 0), a3, voffA);
            PG8_BAR; PG8_WAIT_L(0); PG8_MMA(1, 0, At, B0); PG8_BAR; PG8_SCHED;
            PG8_STAGE(PG8_SB(1, 1), b3 + hstep, voffB);
            PG8_WAIT_V(6); PG8_BAR; PG8_MMA(1, 1, At, B1); PG8_BAR;
            }
        }
        if constexpr (ALIGN_EPI) { if (wr == 0) PG8_BAR; }
        if constexpr (QM != 0) asm volatile("s_nop 15\n\ts_nop 7" ::: "memory");
        if constexpr (!Epi::AFTER_DRAIN) { E(acc, cur, wr, wc, fr, fq, ui, has_next, nxt);
#if defined(PROBE_DUP) && PROBE_DUP == 61
            E(acc, cur, wr, wc, fr, fq, ui, has_next, nxt);
#endif
            S.done(cur); }
        if (!has_next) break;
        cur = nxt; cA = nA; cB = nB; ++ui;
        if constexpr (ALIGN_EPI) { if (wr == 1) PG8_BAR; }
    }
    PG8_WAIT_V(0);
    if constexpr (!ALIGN_EPI) { if (wr == 0) PG8_BAR; }
    PG8_BAR;
    if constexpr (Epi::AFTER_DRAIN) { E.fused(acc, cur, wr, wc, fr, fq, lds, wid, lane); S.done(cur); }
#undef PG8_SA
#undef PG8_PF
#undef PG8_WAIT_V8
#undef PG8_SB
#undef PG8_STAGE
#undef PG8_LDA
#undef PG8_LDF
#undef PG8_LDB
#undef PG8_MMA
#undef PG8_WAIT_V
#undef PG8_WAIT_L
#undef PG8_BAR
#undef PG8_SCHED
}
}
#include <hip/hip_bf16.h>
#include <cmath>
namespace attn_body {
using bf16=__hip_bfloat16;
using bf16x8=__attribute__((ext_vector_type(8)))short;
using s16x4=__attribute__((ext_vector_type(4)))short;
using f32x16=__attribute__((ext_vector_type(16)))float;
using u32x4=__attribute__((ext_vector_type(4)))unsigned;
constexpr int BATCH=16,NHEAD=8,SEQ=2048,D=64;
constexpr int QP=512,KP=128,OP=1024,OOFF=512;
constexpr int NW=8,QBLK=32,QB=QBLK*NW,KVBLK=64,NQB=SEQ/QB;
constexpr int ATTN_UNIT_ROWS=QB;
__device__ __forceinline__ int crow(int r,int hi){return (r&3)+8*(r>>2)+4*hi;}
#define SBAR() __builtin_amdgcn_sched_barrier(0)
#define MSKV(v,W,r) __uint_as_float(__float_as_uint(v)&(unsigned)(((int)((W)<<(31-(((r)&3)+8*((r)>>2)))))>>31))
__device__ __forceinline__ void cmask(f32x16&p0,f32x16&p1,int jb,int qrel,int hi){
  const float NEG=-INFINITY; int kb=64*jb+4*hi;
  #pragma unroll
  for(int r=0;r<16;++r){int kv=kb+(r&3)+8*(r>>2); if(kv>qrel)p0[r]=NEG; if(kv+32>qrel)p1[r]=NEG;}
}

constexpr int NSLOT=3, SLOTB=8192;
constexpr int LDS_K=0, LDS_V=NSLOT*SLOTB, LDS_WS=2*NSLOT*SLOTB, LDS_OST=LDS_WS+NW*64*4, LDS_MSK=LDS_OST+NW*4096, LDS_BYTES=LDS_MSK+NW*8192;
constexpr float C2=0.125f*1.4426950408889634f;
__device__ __forceinline__ void glds16(const void*gsrc,unsigned lds_dst){unsigned keep;
  asm volatile("s_mov_b32 %0, m0\n\ts_mov_b32 m0, %2\n\ts_nop 0\n\tglobal_load_lds_dwordx4 %1, off\n\ts_mov_b32 m0, %0":"=&s"(keep):"v"(gsrc),"s"(lds_dst):"memory");}
__device__ __forceinline__ float max3f(float a,float b,float c){float r;asm("v_max3_f32 %0, %1, %2, %3":"=v"(r):"v"(a),"v"(b),"v"(c));return r;}
__device__ __forceinline__ float max2f(float a,float b){float r;asm("v_max_f32_e32 %0, %1, %2":"=v"(r):"v"(a),"v"(b));return r;}
__device__ __forceinline__ float fadd_s(float a,float b){float r;asm("v_add_f32_e32 %0, %1, %2":"=v"(r):"v"(a),"v"(b));return r;}
__device__ __forceinline__ float fsub_s(float a,float b){float r;asm("v_sub_f32_e32 %0, %1, %2":"=v"(r):"v"(a),"v"(b));return r;}
typedef float f32x2_t __attribute__((ext_vector_type(2))); typedef __bf16 bf16x2_t __attribute__((ext_vector_type(2)));
__device__ __forceinline__ unsigned cvtpk_s(float lo,float hi){f32x2_t v={lo,hi};bf16x2_t b=__builtin_convertvector(v,bf16x2_t);return __builtin_bit_cast(unsigned,b);}
#define WAIT_BAR(N) asm volatile("s_waitcnt vmcnt(" #N ") lgkmcnt(0)\n\ts_barrier":::"memory")

__device__ __forceinline__ void qkt(f32x16&p0,f32x16&p1,const char*Kslot,const bf16x8*qr,const f32x16&negm,int r32,int hi){
  const char*kb=Kslot+hi*1024+r32*16;
  #pragma unroll
  for(int d0=0;d0<4;++d0){
    const bf16x8 b0=*reinterpret_cast<const bf16x8*>(kb+d0*2048);
    const bf16x8 b1=*reinterpret_cast<const bf16x8*>(kb+d0*2048+512);
    if(d0==0){p0=__builtin_amdgcn_mfma_f32_32x32x16_bf16(b0,qr[0],negm,0,0,0);p1=__builtin_amdgcn_mfma_f32_32x32x16_bf16(b1,qr[0],negm,0,0,0);}
    else{p0=__builtin_amdgcn_mfma_f32_32x32x16_bf16(b0,qr[d0],p0,0,0,0);p1=__builtin_amdgcn_mfma_f32_32x32x16_bf16(b1,qr[d0],p1,0,0,0);}}
}
typedef __attribute__((address_space(3))) const char* lds_cptr;
typedef short v4i16_t __attribute__((ext_vector_type(4)));
__device__ __forceinline__ void kload8(bf16x8*kf,lds_cptr kp){
  kf[0]=*(const __attribute__((address_space(3))) bf16x8*)(kp);      kf[1]=*(const __attribute__((address_space(3))) bf16x8*)(kp+512);
  kf[2]=*(const __attribute__((address_space(3))) bf16x8*)(kp+2048); kf[3]=*(const __attribute__((address_space(3))) bf16x8*)(kp+2560);
  kf[4]=*(const __attribute__((address_space(3))) bf16x8*)(kp+4096); kf[5]=*(const __attribute__((address_space(3))) bf16x8*)(kp+4608);
  kf[6]=*(const __attribute__((address_space(3))) bf16x8*)(kp+6144); kf[7]=*(const __attribute__((address_space(3))) bf16x8*)(kp+6656);
}
__device__ __forceinline__ void kload2(bf16x8*kf,lds_cptr kp,int j){ kf[2*j]=*(const __attribute__((address_space(3))) bf16x8*)(kp+j*2048); kf[2*j+1]=*(const __attribute__((address_space(3))) bf16x8*)(kp+j*2048+512); }
__device__ __forceinline__ s16x4 vtr(lds_cptr p){ return __builtin_bit_cast(s16x4,__builtin_amdgcn_ds_read_tr16_b64_v4i16((__attribute__((address_space(3))) v4i16_t*)p)); }
__device__ __forceinline__ float rowmax(const f32x16&p0,const f32x16&p1){
  float a=max3f(p0[0],p0[1],p1[0]),b=max3f(p0[2],p0[3],p1[1]);a=max3f(a,p1[2],p1[3]);
  #pragma unroll
  for(int r=4;r<16;r+=4){a=max3f(a,p0[r],p0[r+1]);b=max3f(b,p0[r+2],p0[r+3]);a=max3f(a,p1[r],p1[r+1]);b=max3f(b,p1[r+2],p1[r+3]);}
  const float m=max2f(a,b);
  auto rr=__builtin_amdgcn_permlane32_swap(__float_as_uint(m),__float_as_uint(m),false,false);
  return max2f(__uint_as_float(rr[0]),__uint_as_float(rr[1]));
}
__device__ __forceinline__ void pv(f32x16*o,int vb,bf16x8 pa0,bf16x8 pa1,bf16x8 pa2,bf16x8 pa3){
  #pragma unroll
  for(int d0=0;d0<2;++d0){s16x4 lo[4],hi[4];
    #pragma unroll
    for(int ks=0;ks<4;++ks){
      asm volatile("ds_read_b64_tr_b16 %0,%1 offset:%c2":"=&v"(lo[ks]):"v"(vb),"i"(d0*4096+ks*1024):"memory");
      asm volatile("ds_read_b64_tr_b16 %0,%1 offset:%c2":"=&v"(hi[ks]):"v"(vb),"i"(d0*4096+ks*1024+512):"memory");}
    asm volatile("s_waitcnt lgkmcnt(0)":::"memory");SBAR();
    #define PK(k) (bf16x8){lo[k][0],lo[k][1],lo[k][2],lo[k][3],hi[k][0],hi[k][1],hi[k][2],hi[k][3]}
    o[d0]=__builtin_amdgcn_mfma_f32_32x32x16_bf16(pa0,PK(0),o[d0],0,0,0);
    o[d0]=__builtin_amdgcn_mfma_f32_32x32x16_bf16(pa1,PK(1),o[d0],0,0,0);
    o[d0]=__builtin_amdgcn_mfma_f32_32x32x16_bf16(pa2,PK(2),o[d0],0,0,0);
    o[d0]=__builtin_amdgcn_mfma_f32_32x32x16_bf16(pa3,PK(3),o[d0],0,0,0);
    #undef PK
  }
}

#ifndef ATTN_STORE16
#define ATTN_STORE16(p,v) (*(u32x4*)(p)=(v))
#endif
template<int THRL> __device__ __forceinline__ void attn_unit(int b,int h,int qb,const bf16*Q,const bf16*K,const bf16*V,const unsigned long long*MK,bf16*O,char*shm){
  const int tid=threadIdx.x,lane=tid&63,r32=lane&31,hi=lane>>5; const int wid=__builtin_amdgcn_readfirstlane(tid>>6);
  const long rowbase=(long)b*SEQ; const int q0=qb*QB;
  const bf16*Qw=Q+(rowbase+q0+wid*QBLK)*QP+h*D;
  const bf16*Kh=K+rowbase*KP+(h>>2)*D,*Vh=V+rowbase*KP+(h>>2)*D;
  const unsigned lds0=(unsigned)(uintptr_t)shm;
  float*wsf=(float*)(shm+LDS_WS)+wid*64;
  const bf16*ksrc=Kh+(long)lane*KP+wid*8;
  const bf16*vsrc=Vh+(long)(16*(wid&3)+(lane>>2))*KP+(wid>>2)*32+(lane&3)*8;
  const unsigned kdst=lds0+LDS_K+wid*1024, vdst=lds0+LDS_V+wid*1024;
  #define DMA_K(t,slot) glds16(ksrc+(long)(t)*KVBLK*KP,(unsigned)__builtin_amdgcn_readfirstlane(kdst+(slot)))
  #define DMA_V(t,slot) glds16(vsrc+(long)(t)*KVBLK*KP,(unsigned)__builtin_amdgcn_readfirstlane(vdst+(slot)))
  const int vb0=(int)(lds0+LDS_V)+((lane>>4)&1)*32+(lane&3)*8+(4*hi+((lane&15)>>2))*64;
  const char*Kbase=shm+LDS_K; bf16x8 kf[8];
  const lds_cptr shm3=(lds_cptr)shm; const lds_cptr kp0=shm3+LDS_K+hi*1024+r32*16; const lds_cptr vp0=shm3+LDS_V+((lane>>4)&1)*32+(lane&3)*8+(4*hi+((lane&15)>>2))*64;
  const int NT=(q0+QB)/KVBLK;
  const __attribute__((address_space(3))) char* shm3m=(const __attribute__((address_space(3))) char*)shm;
  typedef __attribute__((address_space(3))) unsigned long long* lds_u64p;
  const lds_u64p mskw=(lds_u64p)(shm3m+LDS_MSK+wid*8192);
  unsigned long long mtmp[16];
  { const unsigned long long*mq=MK+(q0+wid*QBLK+r32);
    #pragma unroll
    for(int i=0;i<16;++i){int tt=2*i+hi; tt=tt<NT?tt:NT-1; mtmp[i]=mq[(long)tt*SEQ];} }
  DMA_K(0,0);DMA_V(0,0);DMA_K(1,SLOTB);
  bf16x8 qr[4];
  #pragma unroll
  for(int d0=0;d0<4;++d0)qr[d0]=*reinterpret_cast<const bf16x8*>(&Qw[(long)r32*QP+d0*16+hi*8]);
  float mhat=0.f,l_reg=0.f;f32x16 o[2];o[0]=f32x16{};o[1]=f32x16{};f32x16 negm=f32x16{};asm volatile("":"+v"(negm));
  const int qrel=wid*QBLK+r32;
  #define CMASK(P0,P1,t) do{int jb_=(t)-(NT-4); if(jb_>=0)cmask(P0,P1,jb_,qrel,hi);}while(0)
  bool resc=false;
  #define START(P0,P1) do{ const float rm=rowmax(P0,P1); resc=false; \
    { const float dl=rm; mhat=fadd_s(mhat,dl); \
      _Pragma("unroll") for(int r=0;r<16;++r){P0[r]=fsub_s(P0[r],dl);P1[r]=fsub_s(P1[r],dl);} \
      _Pragma("unroll") for(int r=0;r<16;++r)negm[r]=-mhat; asm volatile("":"+v"(negm)); } \
    _Pragma("unroll") for(int r=0;r<16;++r)P0[r]=__builtin_amdgcn_exp2f(P0[r]); }while(0)
  #define RESC() do{ if(resc){ asm volatile("s_waitcnt lgkmcnt(0)":::"memory"); \
      _Pragma("unroll") for(int d_=0;d_<2;++d_) _Pragma("unroll") for(int r=0;r<16;++r)o[d_][r]*=wsf[crow(r,hi)]; } }while(0)
  f32x16 pA0,pA1,pB0,pB1;
  int sl_prev=0,sl_cur=0,sl_next=SLOTB;
  #define ROT() do{sl_prev=sl_cur;sl_cur=sl_next;sl_next=(sl_next==(NSLOT-1)*SLOTB)?0:sl_next+SLOTB;}while(0)
  DMA_K(2,2*SLOTB);
  WAIT_BAR(3);
  #pragma unroll
  for(int i=0;i<16;++i)mskw[(2*i+hi)*32+r32]=mtmp[i];
  #define MLOAD(t,LO,HI) do{ const unsigned long long mw_=mskw[(t)*32+r32]; LO=((unsigned)mw_)>>(4*hi); HI=((unsigned)(mw_>>32))>>(4*hi); }while(0)
  unsigned mlo,mhi; MLOAD(0,mlo,mhi);
  qkt(pA0,pA1,Kbase,qr,negm,r32,hi);asm volatile("s_nop 15\n\ts_nop 7":"+v"(pA0),"+v"(pA1));
  START(pA0,pA1);
  _Pragma("unroll") for(int r=0;r<16;++r)pA1[r]=__builtin_amdgcn_exp2f(pA1[r]);
  _Pragma("unroll") for(int r=0;r<16;++r){pA0[r]=MSKV(pA0[r],mlo,r);pA1[r]=MSKV(pA1[r],mhi,r);}
  WAIT_BAR(0);
  DMA_K(3,0);DMA_V(1,SLOTB);
  ROT();
  kload8(kf,kp0+sl_cur);
  WAIT_BAR(2);
  s16x4 vlo[8],vhi[8]; u32x4 pw0,pw1,pw2,pw3;
  #define PKW(P,B) cvtpk_s(P[B],P[B+1])
  #define PAF(k) __builtin_bit_cast(bf16x8,pw##k)
  #define VFR(i) (bf16x8){vlo[i][0],vlo[i][1],vlo[i][2],vlo[i][3],vhi[i][0],vhi[i][1],vhi[i][2],vhi[i][3]}
  #define PIN(x) asm volatile("":"+v"(x))
  #define MX3(a,b,c) __builtin_fmaxf(__builtin_fmaxf((a),(b)),(c))
  #define GAPA(MF,A0,A1,A2,A3,W0,W1,PW) do{ MF; sacc+=A0; sacc+=A1; sacc+=A2; sacc+=A3; PIN(sacc); W0; W1; PIN(PW); SBAR(); }while(0)
  #define EX(v) __builtin_amdgcn_exp2f(v)
  #define GAPB(MF,X,B,W) do{ MF; X[B]=MSKV(EX(X[B]),W,B); X[B+1]=MSKV(EX(X[B+1]),W,B+1); X[B+2]=MSKV(EX(X[B+2]),W,B+2); X[B+3]=MSKV(EX(X[B+3]),W,B+3); PIN(X); SBAR(); }while(0)
  #define VRD(i) do{ vlo[i]=vtr(vp_+(((i)>>2)*4096+((i)&3)*1024)); vhi[i]=vtr(vp_+(((i)>>2)*4096+((i)&3)*1024+512)); }while(0)
  #define KRD(G,j) do{ if(G){ kload2(kf,kp0+sl_next,j); SBAR(); } }while(0)
  #define STEP(C0,C1,P0,P1,t,GK,GV,GL) do{ SBAR(); \
    const lds_cptr vp_=vp0+sl_prev; MLOAD(t,mlo,mhi); \
    VRD(0); SBAR(); float sacc=(P0[0]+P0[1]); \
    GAPA(C0=__builtin_amdgcn_mfma_f32_32x32x16_bf16(kf[0],qr[0],negm,0,0,0), P0[2],P0[3],P0[4],P0[5],     pw0[0]=PKW(P0,0), pw0[1]=PKW(P0,2), pw0); \
    VRD(4); SBAR(); GAPA(C1=__builtin_amdgcn_mfma_f32_32x32x16_bf16(kf[1],qr[0],negm,0,0,0), P0[6],P0[7],P0[8],P0[9],     pw0[2]=PKW(P0,4), pw0[3]=PKW(P0,6), pw0); \
    VRD(1); SBAR(); GAPA(C0=__builtin_amdgcn_mfma_f32_32x32x16_bf16(kf[2],qr[1],C0,0,0,0),   P0[10],P0[11],P0[12],P0[13], pw1[0]=PKW(P0,8), pw1[1]=PKW(P0,10), pw1); \
    VRD(5); SBAR(); GAPA(C1=__builtin_amdgcn_mfma_f32_32x32x16_bf16(kf[3],qr[1],C1,0,0,0),   P0[14],P0[15],P1[0],P1[1],   pw1[2]=PKW(P0,12),pw1[3]=PKW(P0,14), pw1); \
    VRD(2); SBAR(); GAPA(C0=__builtin_amdgcn_mfma_f32_32x32x16_bf16(kf[4],qr[2],C0,0,0,0),   P1[2],P1[3],P1[4],P1[5],     pw2[0]=PKW(P1,0), pw2[1]=PKW(P1,2), pw2); \
    VRD(6); SBAR(); GAPA(C1=__builtin_amdgcn_mfma_f32_32x32x16_bf16(kf[5],qr[2],C1,0,0,0),   P1[6],P1[7],P1[8],P1[9],     pw2[2]=PKW(P1,4), pw2[3]=PKW(P1,6), pw2); \
    VRD(3); SBAR(); GAPA(C0=__builtin_amdgcn_mfma_f32_32x32x16_bf16(kf[6],qr[3],C0,0,0,0),   P1[10],P1[11],P1[12],P1[13], pw3[0]=PKW(P1,8), pw3[1]=PKW(P1,10), pw3); \
    VRD(7); SBAR(); GAPA(C1=__builtin_amdgcn_mfma_f32_32x32x16_bf16(kf[7],qr[3],C1,0,0,0),   P1[14],P1[15],0.f,0.f,       pw3[2]=PKW(P1,12),pw3[3]=PKW(P1,14), pw3); \
    l_reg+=sacc; \
    if(GK){DMA_K((t)+3,sl_cur);} if(GV){DMA_V((t)+1,sl_next);} \
    { float a=MX3(C0[0],C0[1],C1[0]),b=MX3(C0[2],C0[3],C1[1]); a=MX3(a,C1[2],C1[3]); \
      _Pragma("unroll") for(int r=4;r<16;r+=4){a=MX3(a,C0[r],C0[r+1]);b=MX3(b,C0[r+2],C0[r+3]);a=MX3(a,C1[r],C1[r+1]);b=MX3(b,C1[r+2],C1[r+3]);} \
      float rm=__builtin_fmaxf(a,b); { auto rr=__builtin_amdgcn_permlane32_swap(__float_as_uint(rm),__float_as_uint(rm),false,false); rm=__builtin_fmaxf(__uint_as_float(rr[0]),__uint_as_float(rr[1])); } \
      resc=false; \
      if(__builtin_expect(__any(rm>(float)THRL),0)){ const float dl=__builtin_fmaxf(rm,0.f); mhat+=dl; \
        _Pragma("unroll") for(int r=0;r<16;++r){C0[r]-=dl;C1[r]-=dl;} \
        _Pragma("unroll") for(int r=0;r<16;++r)negm[r]=-mhat; asm volatile("":"+v"(negm)); \
        const float f=__builtin_amdgcn_exp2f(-dl); l_reg*=f; if(hi==0)wsf[r32]=f; resc=true; } } \
    SBAR(); \
    GAPB(o[0]=__builtin_amdgcn_mfma_f32_32x32x16_bf16(PAF(0),VFR(0),o[0],0,0,0), C0,0,mlo); \
    GAPB(o[1]=__builtin_amdgcn_mfma_f32_32x32x16_bf16(PAF(0),VFR(4),o[1],0,0,0), C0,4,mlo); \
    KRD(GL,0); GAPB(o[0]=__builtin_amdgcn_mfma_f32_32x32x16_bf16(PAF(1),VFR(1),o[0],0,0,0), C0,8,mlo); \
    KRD(GL,1); GAPB(o[1]=__builtin_amdgcn_mfma_f32_32x32x16_bf16(PAF(1),VFR(5),o[1],0,0,0), C0,12,mlo); \
    KRD(GL,2); GAPB(o[0]=__builtin_amdgcn_mfma_f32_32x32x16_bf16(PAF(2),VFR(2),o[0],0,0,0), C1,0,mhi); \
    KRD(GL,3); GAPB(o[1]=__builtin_amdgcn_mfma_f32_32x32x16_bf16(PAF(2),VFR(6),o[1],0,0,0), C1,4,mhi); \
    GAPB(o[0]=__builtin_amdgcn_mfma_f32_32x32x16_bf16(PAF(3),VFR(3),o[0],0,0,0), C1,8,mhi); \
    GAPB(o[1]=__builtin_amdgcn_mfma_f32_32x32x16_bf16(PAF(3),VFR(7),o[1],0,0,0), C1,12,mhi); \
    }while(0)
  int t=1;
  #undef CMASK
  #define CMASK(P0,P1,t) do{}while(0)
  for(;t+5<NT;t+=2){
    STEP(pB0,pB1,pA0,pA1,t,true,true,true);     WAIT_BAR(2); RESC(); ROT();
    STEP(pA0,pA1,pB0,pB1,t+1,true,true,true);   WAIT_BAR(2); RESC(); ROT();
  }
  #undef CMASK
  #define CMASK(P0,P1,t) do{int jb_=(t)-(NT-4); if(jb_>=0)cmask(P0,P1,jb_,qrel,hi);}while(0)
  #define ENDW(tt) do{ if((tt)+3<NT){WAIT_BAR(2);} else if((tt)+2<NT){WAIT_BAR(1);} else {WAIT_BAR(0);} }while(0)
  for(;t+1<NT;t+=2){
    STEP(pB0,pB1,pA0,pA1,t,(t+3<NT),(t+1<NT),(t+1<NT));       ENDW(t);   RESC(); ROT();
    STEP(pA0,pA1,pB0,pB1,t+1,(t+4<NT),(t+2<NT),(t+2<NT));     ENDW(t+1); RESC(); ROT();
  }
  STEP(pB0,pB1,pA0,pA1,NT-1,false,false,false); RESC();
  { float sacc=pB0[0]+pB0[1]; _Pragma("unroll") for(int r=2;r<16;++r)sacc+=pB0[r]; _Pragma("unroll") for(int r=0;r<16;++r)sacc+=pB1[r]; l_reg+=sacc;
    pw0=(u32x4){PKW(pB0,0),PKW(pB0,2),PKW(pB0,4),PKW(pB0,6)};pw1=(u32x4){PKW(pB0,8),PKW(pB0,10),PKW(pB0,12),PKW(pB0,14)};pw2=(u32x4){PKW(pB1,0),PKW(pB1,2),PKW(pB1,4),PKW(pB1,6)};pw3=(u32x4){PKW(pB1,8),PKW(pB1,10),PKW(pB1,12),PKW(pB1,14)};
    SBAR(); pv(o,vb0+sl_cur,PAF(0),PAF(1),PAF(2),PAF(3)); }
  #undef PKW
  #undef PAF
  #undef VFR
  #undef PIN
  #undef MX3
  #undef GAPA
  #undef GAPB
  #undef EX
  #undef VRD
  #undef KRD
  #undef STEP
  #undef ENDW
  {auto rr=__builtin_amdgcn_permlane32_swap(__float_as_uint(l_reg),__float_as_uint(l_reg),false,false);l_reg=__uint_as_float(rr[0])+__uint_as_float(rr[1]);}
  if(hi==0)wsf[32+r32]=l_reg;asm volatile("s_waitcnt lgkmcnt(0)":::"memory");
  float rli[16];
  #pragma unroll
  for(int r=0;r<16;++r)rli[r]=__builtin_amdgcn_rcpf(wsf[32+crow(r,hi)]);
  bf16*Ow=O+(rowbase+q0+wid*QBLK)*OP+OOFF+h*D;
  { bf16*stg=(bf16*)(shm+LDS_OST)+wid*2048;
    #pragma unroll
    for(int r=0;r<16;++r){const int orow=crow(r,hi);
      #pragma unroll
      for(int d0=0;d0<2;++d0)stg[orow*64+d0*32+r32]=__float2bfloat16(o[d0][r]*rli[r]);}
    asm volatile("s_waitcnt lgkmcnt(0)":::"memory");
    #pragma unroll
    for(int i=0;i<4;++i){const int row=i*8+(lane>>3),ch=lane&7; const u32x4 v=*(const u32x4*)(stg+row*64+ch*8); ATTN_STORE16(Ow+(long)row*OP+ch*8,v);} }
  asm volatile("s_waitcnt lgkmcnt(0)\n\ts_barrier":::"memory");
  #undef DMA_K
  #undef DMA_V
  #undef CMASK
  #undef START
  #undef RESC
  #undef ROT
}
constexpr int ATTN_LDS_BYTES=LDS_BYTES;
struct AttnTensors { const bf16* Q; const bf16* K; const bf16* V; const unsigned long long* MK; bf16* O; };
struct AttnUnit { int bh; int qb; };
struct StaticOrder {
  int vcu;
  __device__ __forceinline__ explicit StaticOrder(int vcu_):vcu(vcu_){}
  __device__ __forceinline__ bool next(int i,AttnUnit&u)const{ if(vcu>=256)return false; const int s=vcu&1; u.bh=vcu>>1; if(s){ if(i>=5)return false; u.qb=5-i; } else { if(i>=3)return false; u.qb=(i==0)?7:(i==1)?6:0; } return true; }
};
template<class Sched,int THRL=8> __device__ __forceinline__ void attn_phase(char*lds,const AttnTensors&T,const Sched&S){
  AttnUnit u;
  for(int i=0;S.next(i,u);++i){ const int b=u.bh/NHEAD; attn_unit<THRL>(b,u.bh%NHEAD,u.qb,T.Q,T.K,T.V,T.MK+(long)b*32*SEQ,T.O,lds); }
}
#undef SBAR
#undef WAIT_BAR
}
#ifndef PROBE_DUP
#define PROBE_DUP (-1)
#endif
constexpr int D = 1024, NB = 16, SEQ = 2048, MP = NB * SEQ, DB = 32, DS = 4, MS = DB * DS, MTOT = MP + MS, MPAD = 33024;
constexpr int DFF = 2816, NIN = 2888, NINP = 3072, DCONV = 512;
constexpr int PAST = 16384, PAGE = 128, NPAGES = 128, KTOP = 256;
constexpr float EPS = 1e-6f, LOG2E = 1.4426950408889634f;
constexpr float QSCALE = 0.125f * LOG2E;
constexpr size_t O_YP = 0, O_YS = O_YP + (size_t)MP * D, O_KP = O_YS + (size_t)MS * D, O_VP = O_KP + (size_t)MP * 128, O_IP = O_VP + (size_t)MP * 128,
                 O_CP = O_IP + (size_t)MP * 64, O_KS = O_CP + 16 * 2 * 512, O_VS = O_KS + MS * 128, O_IS = O_VS + MS * 128, O_CS = O_IS + MS * 64, O_END = O_CS + 32 * 2 * 512;
static_assert(O_END == 44261376, "output size");

constexpr size_t al(size_t x) { return (x + 0xFFFFF) & ~(size_t)0xFFFFF; }
constexpr size_t WS_CTL = 0, CTL_ZERO_BYTES = 1u << 20;
constexpr size_t WS_ROPE = al(WS_CTL + CTL_ZERO_BYTES);
constexpr size_t WS_WGU1 = al(WS_ROPE + 2052 * 8 * 2 * 4);
constexpr size_t WS_WD1 = al(WS_WGU1 + (size_t)2 * DFF * D * 2);
constexpr size_t WS_WIN = al(WS_WD1 + (size_t)D * DFF * 2);
constexpr size_t WS_WOUT = al(WS_WIN + (size_t)NINP * D * 2);
constexpr size_t WS_WGU2 = al(WS_WOUT + (size_t)D * D * 2);
constexpr size_t WS_WD2 = al(WS_WGU2 + (size_t)2 * DFF * D * 2);
constexpr size_t WS_XB = al(WS_WD2 + (size_t)D * DFF * 2);
constexpr size_t WS_SS0 = al(WS_XB + (size_t)MPAD * D * 2);
constexpr size_t WS_SS1 = al(WS_SS0 + (size_t)MPAD * 4);
constexpr size_t WS_SS2 = al(WS_SS1 + (size_t)MPAD * 64);
constexpr size_t WS_H = al(WS_SS2 + (size_t)MPAD * 64);
constexpr size_t WS_X1 = al(WS_H + (size_t)MPAD * DFF * 2);
constexpr size_t WS_X1B = al(WS_X1 + (size_t)MPAD * D * 4);
constexpr size_t WS_X2 = al(WS_X1B + (size_t)MPAD * D * 2);
constexpr size_t WS_X2B = al(WS_X2 + (size_t)MPAD * D * 4);
constexpr size_t WS_U = al(WS_X2B + (size_t)MPAD * D * 2);
constexpr size_t WS_GB = al(WS_U + (size_t)MPAD * 512 * 2);
constexpr size_t WS_Q = al(WS_GB + (size_t)MPAD * 512 * 2);
constexpr size_t WS_QI = al(WS_Q + (size_t)MPAD * 512 * 2);
constexpr size_t WS_KB = al(WS_QI + (size_t)MPAD * 512 * 2);
constexpr size_t WS_VB = al(WS_KB + (size_t)MPAD * 128 * 2);
constexpr size_t WS_KIB = al(WS_VB + (size_t)MPAD * 128 * 2);
constexpr size_t WS_WI = al(WS_KIB + (size_t)MPAD * 64 * 2);
constexpr size_t WS_CAT = al(WS_WI + (size_t)MPAD * 8 * 4);
constexpr size_t WS_MASK = al(WS_CAT + (size_t)MPAD * D * 2);
constexpr int SSTR = 16384;
constexpr size_t WS_SSC = al(WS_MASK + (size_t)NB * 32 * SEQ * 8);
constexpr size_t WS_XB8 = al(WS_SSC + (size_t)MS * SSTR * 4);
constexpr size_t WS_X2B8 = al(WS_XB8 + (size_t)MPAD * D);
constexpr size_t WS_WGU1_8 = al(WS_X2B8 + (size_t)MPAD * D);
constexpr size_t WS_WGU2_8 = al(WS_WGU1_8 + (size_t)2 * DFF * D);
constexpr size_t WS_WD2_8 = al(WS_WGU2_8 + (size_t)2 * DFF * D);
constexpr size_t WS_H8 = al(WS_WD2_8 + (size_t)D * DFF);
constexpr size_t WS_XI8 = al(WS_H8 + (size_t)MPAD * DFF);
constexpr size_t WS_XS = al(WS_XI8 + (size_t)MPAD * D);
constexpr size_t WS_WGU1I8 = al(WS_XS + (size_t)MPAD * 4);
constexpr size_t WS_WSN = al(WS_WGU1I8 + (size_t)2 * DFF * D);
constexpr size_t WS_X2I8 = al(WS_WSN + (size_t)2 * DFF * 4);
constexpr size_t WS_XS2 = al(WS_X2I8 + (size_t)MPAD * D);
constexpr size_t WS_WGU2I8 = al(WS_XS2 + (size_t)MPAD * 4);
constexpr size_t WS_WSN2 = al(WS_WGU2I8 + (size_t)2 * DFF * D);
constexpr size_t WS_WD1_8 = al(WS_WSN2 + (size_t)2 * DFF * 4);
constexpr size_t WS_END = al(WS_WD1_8 + (size_t)D * DFF);
constexpr float H8SCALE = 4.0f;
constexpr float W8SCALE = 32.0f;

constexpr int CW_TMO = 0, CW_CODE = 1, CW_BAR = 4096;

constexpr int RING_OFF = 0, RING_BYTES = 152576;
constexpr int LDSCTL_OFF = RING_BYTES, MISC_OFF = LDSCTL_OFF + 320;
constexpr int LDS_BYTES = 158720;
static_assert(MISC_OFF + 128 <= LDS_BYTES && attn_body::ATTN_LDS_BYTES <= RING_BYTES && pg8::STAGE_BYTES <= RING_BYTES, "LDS map");

#define GAS __attribute__((address_space(1)))
#define LAS __attribute__((address_space(3)))
typedef unsigned short bf16;
typedef unsigned v4u __attribute__((ext_vector_type(4)));
typedef unsigned v2u __attribute__((ext_vector_type(2)));
typedef float f32x4 __attribute__((ext_vector_type(4)));
typedef float f32x16 __attribute__((ext_vector_type(16)));
typedef short bf16x8 __attribute__((ext_vector_type(8)));
typedef GAS unsigned gu32;
#define RLX_AGENT __ATOMIC_RELAXED, __HIP_MEMORY_SCOPE_AGENT
#define LDS_WAIT() asm volatile("s_waitcnt lgkmcnt(0)" ::: "memory")
#define VM_WAIT() asm volatile("s_waitcnt vmcnt(0)" ::: "memory")
__device__ __forceinline__ unsigned f2bf(float f) { unsigned u = __builtin_bit_cast(unsigned, f); return (u + 0x7fffu + ((u >> 16) & 1u)) >> 16; }
__device__ __forceinline__ unsigned pk2(float lo, float hi) { return f2bf(lo) | (f2bf(hi) << 16); }
__device__ __forceinline__ float bf2f(unsigned short h) { return __builtin_bit_cast(float, (unsigned)h << 16); }
__device__ __forceinline__ float wave_sum(float v) {
#pragma unroll
    for (int o = 1; o < 64; o <<= 1) v += __shfl_xor(v, o);
    return v;
}
__device__ __forceinline__ float wave_max(float v) {
#pragma unroll
    for (int o = 1; o < 64; o <<= 1) v = fmaxf(v, __shfl_xor(v, o));
    return v;
}

#define XB_TMO      128
#define XB_XCNT(j)  (256  + 64 * (j))
#define XB_XSUB(j)  (1280 + 64 * (j))
#define XB_XGEN(j)  (2304 + 64 * (j))
#define XB_TOP      3328
#define XB_TOPGEN   3392
#define XCD_BAR_WORDS 3456
#define XB_SPIN_CAP (1u << 18)

__device__ __forceinline__ unsigned xb_ld(unsigned* p)              { return __hip_atomic_load(p, __ATOMIC_RELAXED, __HIP_MEMORY_SCOPE_AGENT); }
__device__ __forceinline__ unsigned xb_add(unsigned* p, unsigned v) { return __hip_atomic_fetch_add(p, v, __ATOMIC_RELAXED, __HIP_MEMORY_SCOPE_AGENT); }
__device__ __forceinline__ unsigned xb_xcc_id() { return (unsigned)__builtin_amdgcn_s_getreg((3 << 11) | 20) & 0xFu; }
#define XB_SPIN(cond, bar) do { unsigned _sp = 0; while (cond) { __builtin_amdgcn_s_sleep(1); \
    if ((++_sp & 255u) == 0u) { if (xb_ld(&(bar)[XB_TMO])) break; if (_sp > XB_SPIN_CAP) { atomicAdd(&(bar)[XB_TMO], 1u); break; } } } } while (0)

struct XcdBarrier {
    unsigned* bar; unsigned x;
    volatile LAS unsigned* st;
};

__device__ __forceinline__ XcdBarrier xcd_barrier_post(unsigned* bar, volatile LAS unsigned* st) {
    XcdBarrier b; b.bar = bar; b.x = xb_xcc_id(); b.st = st;
    if (threadIdx.x == 0) (void)xb_add(&bar[XB_XCNT(b.x)], 1u);
    return b;
}
__device__ __forceinline__ void xcd_barrier_complete(unsigned* bar, unsigned x, unsigned& nloc, unsigned& nx) {
    const unsigned G = gridDim.x * gridDim.y * gridDim.z;
    unsigned sum, cnt, mine, sp = 0u;
    for (;;) {
        sum = 0u; cnt = 0u; mine = 0u;
#pragma unroll
        for (unsigned j = 0; j < 16; ++j) { const unsigned c = xb_ld(&bar[XB_XCNT(j)]); sum += c; cnt += (c > 0u) ? 1u : 0u; mine = (j == x) ? c : mine; }
        if (sum == G) break;
        __builtin_amdgcn_s_sleep(1);
        if ((++sp & 255u) == 0u) { if (xb_ld(&bar[XB_TMO])) break; if (sp > XB_SPIN_CAP) { atomicAdd(&bar[XB_TMO], 1u); break; } }
    }
    nloc = mine > 0u ? mine : 1u; nx = cnt > 0u ? cnt : 1u;
}

__device__ __forceinline__ void xcd_barrier(const XcdBarrier& b) {
    asm volatile("s_waitcnt vmcnt(0)" ::: "memory");
    __syncthreads();
    if (threadIdx.x == 0) {
        unsigned* bar = b.bar;
        __builtin_amdgcn_s_waitcnt(0);
        unsigned nloc = b.st[0], nx = b.st[1];
        if (nloc == 0u) { xcd_barrier_complete(bar, b.x, nloc, nx); b.st[0] = nloc; b.st[1] = nx; }
        const unsigned old = xb_add(&bar[XB_XSUB(b.x)], 1u);
        const unsigned gen = old / nloc;
        if (old + 1u == (gen + 1u) * nloc) {
            __builtin_amdgcn_fence(__ATOMIC_RELEASE, "agent");
            asm volatile("s_waitcnt vmcnt(0)" ::: "memory");
            const unsigned og = xb_add(&bar[XB_TOP], 1u);
            const unsigned tg = og / nx;
            if (og + 1u == (tg + 1u) * nx) xb_add(&bar[XB_TOPGEN], 1u);
            else XB_SPIN(xb_ld(&bar[XB_TOPGEN]) == tg, bar);
            __builtin_amdgcn_fence(__ATOMIC_ACQUIRE, "agent");
            xb_add(&bar[XB_XGEN(b.x)], 1u);
            asm volatile("s_waitcnt vmcnt(0)" ::: "memory");
        } else {
            XB_SPIN(xb_ld(&bar[XB_TOPGEN]) == gen, bar);
            __builtin_amdgcn_fence(__ATOMIC_ACQUIRE, "agent");
            asm volatile("s_waitcnt vmcnt(0)" ::: "memory");
        }
    }
    __syncthreads();
}
__host__ __device__ __forceinline__ int r32map(int P) { return 16 * ((P >> 2) & 1) + 4 * (P >> 3) + (P & 3); }
__host__ __device__ __forceinline__ int p128(int x) { return (x & ~31) + r32map(x & 31); }
__host__ __device__ __forceinline__ int hdmap(int d) { if (d >= 16) return d; const int fq = (d >> 2) & 1, j = (d & 3) + 4 * (d >> 3); return 8 * fq + j; }
__host__ __device__ __forceinline__ int head_row(int wc, int d) { const int x = hdmap(d); return 128 * (x >> 5) + 32 * wc + r32map(x & 31); }
__device__ __forceinline__ int dstart(int bj, int fq, int half) { return (bj == 0 && fq < 2) ? 4 * fq + 8 * half : 32 * bj + 8 * fq + 4 * half; }

struct MapGate { __device__ __forceinline__ int operator()(int c) const { return 256 * (c >> 7) + p128(c & 127); } };
struct MapUp   { __device__ __forceinline__ int operator()(int c) const { return 256 * (c >> 7) + 128 + p128(c & 127); } };
struct MapLin  { __device__ __forceinline__ int operator()(int c) const { return (c & ~127) + p128(c & 127); } };
struct MapWin  { __device__ __forceinline__ int operator()(int c) const {
    if (c < 512) return 1024 + (c & ~127) + p128(c & 127);
    if (c < 1024) { const int ch = c - 512; return 256 * (ch >> 7) + p128(ch & 127); }
    if (c < 1536) { const int ch = c - 1024; return 256 * (ch >> 7) + 128 + p128(ch & 127); }
    if (c < 2048) { const int x = c - 1536, hd = x >> 6; return 256 * (6 + (hd >> 2)) + head_row(hd & 3, x & 63); }
    if (c < 2176) { const int x = c - 2048; return 256 * 8 + head_row(x >> 6, x & 63); }
    if (c < 2304) { const int x = c - 2176; return 256 * 8 + head_row(2 + (x >> 6), x & 63); }
    if (c < 2816) { const int x = c - 2304, hd = x >> 6; return 256 * (9 + (hd >> 2)) + head_row(hd & 3, x & 63); }
    if (c < 2880) return 256 * 11 + head_row(0, c - 2816);
    return 256 * 11 + 32 + r32map(c - 2880);
} };

using pg8::Unit; using pg8::bf16_t;
__device__ __forceinline__ float rstd_from(const float* ss, int row, int nslot) {
    float s = 0.f;
    if (nslot == 1) s = ss[row];
    else { const f32x4* p = (const f32x4*)(ss + (size_t)row * 16); const f32x4 a = p[0], b = p[1], c = p[2], d = p[3]; s = ((a.x + a.y) + (a.z + a.w)) + ((b.x + b.y) + (b.z + b.w)) + ((c.x + c.y) + (c.z + c.w)) + ((d.x + d.y) + (d.z + d.w)); }
    return __builtin_amdgcn_rsqf(s * (1.0f / D) + EPS);
}
__device__ __forceinline__ float clamp8(float x) { return __builtin_amdgcn_fmed3f(x, -440.0f, 440.0f); }
__device__ __forceinline__ unsigned pk4_fp8(float a, float b, float c, float d) { int w = __builtin_amdgcn_cvt_pk_fp8_f32(clamp8(a), clamp8(b), 0, false); w = __builtin_amdgcn_cvt_pk_fp8_f32(clamp8(c), clamp8(d), w, true); return (unsigned)w; }
#define EPI_CALL_ROWS() \
    __device__ __forceinline__ void operator()(f32x4 (&acc)[2][2][4][2], const Unit& u, int wr, int wc, int fr, int fq, int ui, bool has_next, const Unit& nxt) const { \
        _Pragma("unroll") for (int ai = 0; ai < 2; ++ai) _Pragma("unroll") for (int m = 0; m < 4; ++m) { \
            const f32x4 v[2][2] = {{acc[ai][0][m][0], acc[ai][0][m][1]}, {acc[ai][1][m][0], acc[ai][1][m][1]}}; \
            row(v, u.pm * 256 + ai * 128 + wr * 64 + m * 16 + fr, u.pn, wc, fr, fq, ui); \
            if (has_next) init_rg(acc, nxt, ai, m, wr, wc, fr, fq); } }                        \
    __device__ __forceinline__ void init(f32x4 (&acc)[2][2][4][2], const Unit& u, int wr, int wc, int fr, int fq) const { \
        _Pragma("unroll") for (int ai = 0; ai < 2; ++ai) _Pragma("unroll") for (int m = 0; m < 4; ++m) init_rg(acc, u, ai, m, wr, wc, fr, fq); }
#define EPI_ZERO_INIT() \
    __device__ __forceinline__ void init_rg(f32x4 (&acc)[2][2][4][2], const Unit&, int ai, int m, int, int, int, int) const { \
        _Pragma("unroll") for (int b = 0; b < 2; ++b) _Pragma("unroll") for (int n = 0; n < 2; ++n) acc[ai][b][m][n] = (f32x4){0.f, 0.f, 0.f, 0.f}; }
__device__ __forceinline__ float rstd_of(const LAS float* tab, const float* ss, int nslot, int row, int ui) { return (ui >= 0 && tab) ? tab[ui * 256 + (row & 255)] : rstd_from(ss, row, nslot); }
struct EpiGU {
    static constexpr bool PERM = false, AFTER_DRAIN = false;
    bf16_t* H; const float* ss; int nslot; const LAS float* tab; float wscale; unsigned char* H8; const float* wsn;
    __device__ __forceinline__ void row(const f32x4 (&v)[2][2], int row, int pn, int wc, int fr, int fq, int ui) const {
        typedef float f32x2 __attribute__((ext_vector_type(2)));
        const int col0 = pn * 128 + wc * 32 + 8 * fq;
        const float rs = rstd_of(tab, ss, nslot, row, ui) * (ui >= 0 ? wscale : 1.0f);
        const float c1 = -rs * LOG2E, rs2 = rs * rs;
        const bool f8 = H8 != nullptr;
        const float rs2s = f8 ? rs2 * H8SCALE : rs2;
        f32x2 hh[4];
#pragma unroll
        for (int n = 0; n < 2; ++n)
#pragma unroll
            for (int i = 0; i < 4; i += 2) { const f32x2 ag = {v[0][n][i], v[0][n][i + 1]}, au = {v[1][n][i], v[1][n][i + 1]};
                const f32x2 a = ag * c1; f32x2 e; e.x = __builtin_amdgcn_exp2f(a.x); e.y = __builtin_amdgcn_exp2f(a.y);
                const f32x2 d = e + 1.0f; f32x2 r; r.x = __builtin_amdgcn_rcpf(d.x); r.y = __builtin_amdgcn_rcpf(d.y);
                hh[2 * n + (i >> 1)] = (ag * au) * (r * rs2s); }
        if (f8) { v2u w8; w8.x = pk4_fp8(hh[0].x, hh[0].y, hh[1].x, hh[1].y); w8.y = pk4_fp8(hh[2].x, hh[2].y, hh[3].x, hh[3].y);
            *(v2u*)(H8 + (size_t)row * DFF + col0) = w8; }
        else { v4u w; w.x = pg8::cvt_pk_bf16(hh[0].x, hh[0].y); w.y = pg8::cvt_pk_bf16(hh[1].x, hh[1].y); w.z = pg8::cvt_pk_bf16(hh[2].x, hh[2].y); w.w = pg8::cvt_pk_bf16(hh[3].x, hh[3].y);
        __builtin_nontemporal_store(w, (v4u*)(H + (size_t)row * DFF + col0)); }
    }
    __device__ __forceinline__ void operator()(f32x4 (&acc)[2][2][4][2], const Unit& u, int wr, int wc, int fr, int fq, int ui, bool has_next, const Unit& nxt) const {
        typedef int v4i_ __attribute__((ext_vector_type(4)));
        f32x4 cs[2][2];
#pragma unroll
        for (int bj = 0; bj < 2; ++bj)
#pragma unroll
            for (int n = 0; n < 2; ++n) cs[bj][n] = wsn ? *(const f32x4*)(wsn + u.pn * 256 + bj * 128 + wc * 32 + n * 16 + 4 * fq) : (f32x4){1.f, 1.f, 1.f, 1.f};
#pragma unroll
        for (int ai = 0; ai < 2; ++ai)
#pragma unroll
            for (int m = 0; m < 4; ++m) {
                f32x4 v[2][2];
#pragma unroll
                for (int bj = 0; bj < 2; ++bj)
#pragma unroll
                    for (int n = 0; n < 2; ++n) v[bj][n] = wsn ? __builtin_convertvector(__builtin_bit_cast(v4i_, acc[ai][bj][m][n]), f32x4) * cs[bj][n] : acc[ai][bj][m][n];
                row(v, u.pm * 256 + ai * 128 + wr * 64 + m * 16 + fr, u.pn, wc, fr, fq, ui);
                if (has_next) init_rg(acc, nxt, ai, m, wr, wc, fr, fq); }
    }
    __device__ __forceinline__ void init(f32x4 (&acc)[2][2][4][2], const Unit& u, int wr, int wc, int fr, int fq) const {
#pragma unroll
        for (int ai = 0; ai < 2; ++ai)
#pragma unroll
            for (int m = 0; m < 4; ++m) init_rg(acc, u, ai, m, wr, wc, fr, fq); }
    EPI_ZERO_INIT()
};
__device__ __forceinline__ void bf8_to_f32(const v4u w, f32x4& lo, f32x4& hi) {
    lo = (f32x4){__uint_as_float(w.x << 16), __uint_as_float(w.x & 0xffff0000u), __uint_as_float(w.y << 16), __uint_as_float(w.y & 0xffff0000u)};
    hi = (f32x4){__uint_as_float(w.z << 16), __uint_as_float(w.z & 0xffff0000u), __uint_as_float(w.w << 16), __uint_as_float(w.w & 0xffff0000u)};
}
template <int MODE> struct EpiRes {
    static constexpr bool PERM = false, AFTER_DRAIN = false;
    const bf16_t* resb; float* out; bf16_t* outb; float* ss; unsigned char* out8; float ascale; const float* resf = nullptr; const float* resfs = nullptr;
    __device__ __forceinline__ void row(const f32x4 (&v)[2][2], int row, int pn, int wc, int fr, int fq, int ui) const {
        const bool pre = ui >= 0;
        const float alpha = ((MODE == 1) ? 1.0f : 0.5f) * (pre ? ascale : 1.0f);
        const bool live = row < MTOT;
        float sq = 0.f;
#pragma unroll
        for (int bj = 0; bj < 2; ++bj) {
            const int col = pn * 256 + bj * 128 + wc * 32 + 8 * fq;
            f32x4 r0 = (f32x4){0.f, 0.f, 0.f, 0.f}, r1 = r0;
            if (!pre && live) { if constexpr (MODE == 0) { r0 = *(const f32x4*)(resfs + (size_t)(row - MP) * D + col); r1 = *(const f32x4*)(resfs + (size_t)(row - MP) * D + col + 4); } else bf8_to_f32(*(const v4u*)(resb + (size_t)row * D + col), r0, r1); }
            const f32x4 v0 = r0 + alpha * v[bj][0], v1 = r1 + alpha * v[bj][1];
            if (MODE == 2) { if (live) { __builtin_nontemporal_store(v0, (f32x4*)(out + (size_t)row * D + col)); __builtin_nontemporal_store(v1, (f32x4*)(out + (size_t)row * D + col + 4)); } }
            else {
                v4u w; w.x = pg8::cvt_pk_bf16(v0[0], v0[1]); w.y = pg8::cvt_pk_bf16(v0[2], v0[3]); w.z = pg8::cvt_pk_bf16(v1[0], v1[1]); w.w = pg8::cvt_pk_bf16(v1[2], v1[3]);
                *(v4u*)(outb + (size_t)row * D + col) = w;
                if (MODE == 1 && out8) { v2u w8; w8.x = pk4_fp8(v0[0], v0[1], v0[2], v0[3]); w8.y = pk4_fp8(v1[0], v1[1], v1[2], v1[3]); *(v2u*)(out8 + (size_t)row * D + col) = w8; }
                sq += (v0[0] * v0[0] + v0[1] * v0[1]) + (v0[2] * v0[2] + v0[3] * v0[3]) + (v1[0] * v1[0] + v1[1] * v1[1]) + (v1[2] * v1[2] + v1[3] * v1[3]);
            }
        }
        if (MODE != 2) { sq += __shfl_xor(sq, 16); sq += __shfl_xor(sq, 32); if (fq == 0) ss[(size_t)row * 16 + pn * 4 + wc] = sq; }
    }
    EPI_CALL_ROWS()
    __device__ __forceinline__ void init_rg(f32x4 (&acc)[2][2][4][2], const Unit& u, int ai, int m, int wr, int wc, int fr, int fq) const {
        const float ia = ((MODE == 1) ? 1.0f : 2.0f) / ascale;
        const size_t ro = (size_t)(u.pm * 256 + ai * 128 + wr * 64 + m * 16 + fr) * D + u.pn * 256 + wc * 32 + 8 * fq;
#pragma unroll
        for (int bj = 0; bj < 2; ++bj) { f32x4 lo, hi;
            if constexpr (MODE == 0) { lo = *(const f32x4*)(resf + ro + bj * 128); hi = *(const f32x4*)(resf + ro + bj * 128 + 4); } else bf8_to_f32(*(const v4u*)(resb + ro + bj * 128), lo, hi);
            acc[ai][bj][m][0] = lo * ia; acc[ai][bj][m][1] = hi * ia; }
    }
};
struct EpiWin {
    static constexpr bool PERM = false, AFTER_DRAIN = false;
    unsigned char* ws; float* out; const float* qn; const float* kn; const LAS float* tab;
    __device__ __forceinline__ void row(const f32x4 (&acc)[2][2], int row, int pn, int wc, int fr, int fq, int ui) const {
        const float* ss = (const float*)(ws + WS_SS1); bf16_t* U = (bf16_t*)(ws + WS_U); bf16_t* GB = (bf16_t*)(ws + WS_GB); float* WI = (float*)(ws + WS_WI); const float* rope = (const float*)(ws + WS_ROPE);
        if (pn == 11 && wc >= 2) return;
        const int type = pn < 4 ? 0 : pn < 6 ? 1 : pn < 8 ? 2 : pn == 8 ? (wc < 2 ? 3 : 4) : pn < 11 ? 5 : (wc == 0 ? 6 : 7);
        const int head = (type == 2) ? 4 * (pn - 6) + wc : (type == 5) ? 4 * (pn - 9) + wc : (type == 3) ? wc : (type == 4) ? wc - 2 : 0;
        const bool live = row < MTOT;
        const float rs = rstd_of(tab, ss, 16, row, ui);
        if (type == 0) {
            const int ch0 = pn * 128 + wc * 32 + 8 * fq;
            const f32x4 u0 = (acc[0][0] * rs) * (acc[1][0] * rs), u1 = (acc[0][1] * rs) * (acc[1][1] * rs);
            v4u w; w.x = pg8::cvt_pk_bf16(u0[0], u0[1]); w.y = pg8::cvt_pk_bf16(u0[2], u0[3]); w.z = pg8::cvt_pk_bf16(u1[0], u1[1]); w.w = pg8::cvt_pk_bf16(u1[2], u1[3]);
            *(v4u*)(U + (size_t)row * 512 + ch0) = w;
            if (row < MP) { const int s = row & (SEQ - 1); if (s >= SEQ - 2) { float* o = out + O_CP + ((size_t)(row >> 11) * 2 + (s - (SEQ - 2))) * 512 + ch0; *(f32x4*)o = u0; *(f32x4*)(o + 4) = u1; } }
            else if (live) { const int sr = row - MP, s = sr & 3; if (s >= 2) { float* o = out + O_CS + ((size_t)(sr >> 2) * 2 + (s - 2)) * 512 + ch0; *(f32x4*)o = u0; *(f32x4*)(o + 4) = u1; } }
        } else if (type == 1) {
#pragma unroll
            for (int bj = 0; bj < 2; ++bj) { const int col = (pn - 4) * 256 + bj * 128 + wc * 32 + 8 * fq; const f32x4 a = acc[bj][0] * rs, b = acc[bj][1] * rs;
                v4u w; w.x = pg8::cvt_pk_bf16(a[0], a[1]); w.y = pg8::cvt_pk_bf16(a[2], a[3]); w.z = pg8::cvt_pk_bf16(b[0], b[1]); w.w = pg8::cvt_pk_bf16(b[2], b[3]);
                *(v4u*)(GB + (size_t)row * 512 + col) = w; }
        } else if (type == 7) {
            if (fq == 0) { *(f32x4*)(WI + (size_t)row * 8) = acc[0][0] * rs; *(f32x4*)(WI + (size_t)row * 8 + 4) = acc[0][1] * rs; }
        } else {
            f32x4 v[2][2];
#pragma unroll
            for (int bj = 0; bj < 2; ++bj) { v[bj][0] = acc[bj][0] * rs; v[bj][1] = acc[bj][1] * rs; }
            if (type == 2 || type == 3) {
                float sq = 0.f;
#pragma unroll
                for (int bj = 0; bj < 2; ++bj)
#pragma unroll
                    for (int h2 = 0; h2 < 2; ++h2) sq += (v[bj][h2][0] * v[bj][h2][0] + v[bj][h2][1] * v[bj][h2][1]) + (v[bj][h2][2] * v[bj][h2][2] + v[bj][h2][3] * v[bj][h2][3]);
                sq += __shfl_xor(sq, 16); sq += __shfl_xor(sq, 32);
                const float sc = __builtin_amdgcn_rsqf(sq * (1.0f / 64.0f) + EPS);
#pragma unroll
                for (int bj = 0; bj < 2; ++bj)
#pragma unroll
                    for (int h2 = 0; h2 < 2; ++h2) { const f32x4 gq = *(const f32x4*)(qn + dstart(bj, fq, h2)), gk = *(const f32x4*)(kn + dstart(bj, fq, h2)); v[bj][h2] = v[bj][h2] * sc * ((type == 2) ? gq : gk); }
            }
            if (type != 4 && fq < 2) {
                const int pidx = row < MP ? (row & (SEQ - 1)) : (live ? SEQ + ((row - MP) & 3) : 0);
                const float* rp = rope + ((size_t)pidx * 8 + 4 * fq) * 2;
                const f32x4 cs0 = *(const f32x4*)rp, cs1 = *(const f32x4*)(rp + 4);
                const f32x4 x1 = v[0][0], x2 = v[0][1];
                const f32x4 c = (f32x4){cs0[0], cs0[2], cs1[0], cs1[2]}, s = (f32x4){cs0[1], cs0[3], cs1[1], cs1[3]};
                v[0][0] = x1 * c - x2 * s; v[0][1] = x2 * c + x1 * s;
            }
            const size_t boff = (type == 2) ? WS_Q : (type == 3) ? WS_KB : (type == 4) ? WS_VB : (type == 5) ? WS_QI : WS_KIB;
            const int bp = (type == 2 || type == 5) ? 512 : (type == 6) ? 64 : 128; const float bsc = (type == 2) ? QSCALE : 1.0f;
            bf16_t* bdst = (bf16_t*)(ws + boff);
            const bool hasf = live && (type == 3 || type == 4 || type == 6);
            const size_t fbase = (type == 3) ? (row < MP ? O_KP : O_KS) : (type == 4) ? (row < MP ? O_VP : O_VS) : (row < MP ? O_IP : O_IS);
            float* fdst = out + fbase + (size_t)(row < MP ? row : row - MP) * (type == 6 ? 64 : 128);
#pragma unroll
            for (int bj = 0; bj < 2; ++bj)
#pragma unroll
                for (int h2 = 0; h2 < 2; ++h2) { const int d = head * 64 + dstart(bj, fq, h2); const f32x4 x = v[bj][h2];
                    if (hasf) { if (row < MP) __builtin_nontemporal_store(x, (f32x4*)(fdst + d)); else *(f32x4*)(fdst + d) = x; }
                    v2u w; w.x = pg8::cvt_pk_bf16(x[0] * bsc, x[1] * bsc); w.y = pg8::cvt_pk_bf16(x[2] * bsc, x[3] * bsc);
                    *(v2u*)(bdst + (size_t)row * bp + d) = w; }
        }
    }
    EPI_CALL_ROWS()
    EPI_ZERO_INIT()
};
template <class Epi, int MT, int QM> __device__ __forceinline__ void skinny_unit(PG8_LAS unsigned char* lds, const unsigned char* A, const unsigned char* Bt, int KB, int pn, int wc, int rg, const Epi& E,
                                                                                const float* xs, const float* wsn, float oscale) {
    typedef int v4i_ __attribute__((ext_vector_type(4)));
    const int tid = threadIdx.x, wid = __builtin_amdgcn_readfirstlane(tid >> 6), lane = tid & 63, fr = lane & 15, fq = lane >> 4;
    const int TP = KB >> 7, base = TP >> 3, rem = TP & 7;
    const int np = base + (wid < rem ? 1 : 0), p0 = wid * base + (wid < rem ? wid : rem);
    const unsigned char* ap = A + (size_t)(MP + 16 * MT * rg + fr) * KB + p0 * 128 + 16 * fq;
    const unsigned char* bp = Bt + (size_t)(256 * pn + 32 * wc + fr) * KB + p0 * 128 + 16 * fq;
    pg8::f32x4 acc[MT][2][2];
#pragma unroll
    for (int mt = 0; mt < MT; ++mt)
#pragma unroll
        for (int bj = 0; bj < 2; ++bj)
#pragma unroll
            for (int n = 0; n < 2; ++n) acc[mt][bj][n] = (pg8::f32x4){0.f, 0.f, 0.f, 0.f};
    v4i_ a0[MT], b0[2][2], a1[MT], b1[2][2], a2[MT], b2[2][2], a3[MT], b3[2][2];
#define SK_LOADP(afe, bfe, afo, bfo, p_) do { \
        _Pragma("unroll") for (int mt = 0; mt < MT; ++mt) { afe[mt] = *(const v4i_*)(ap + (size_t)(16 * mt) * KB + 128 * (p_)); afo[mt] = *(const v4i_*)(ap + (size_t)(16 * mt) * KB + 128 * (p_) + 64); } \
        _Pragma("unroll") for (int bj = 0; bj < 2; ++bj) _Pragma("unroll") for (int n = 0; n < 2; ++n) { bfe[bj][n] = *(const v4i_*)(bp + (size_t)(128 * bj + 16 * n) * KB + 128 * (p_)); bfo[bj][n] = *(const v4i_*)(bp + (size_t)(128 * bj + 16 * n) * KB + 128 * (p_) + 64); } } while (0)
#define SK_MMA(af, bf) do { _Pragma("unroll") for (int mt = 0; mt < MT; ++mt) _Pragma("unroll") for (int bj = 0; bj < 2; ++bj) _Pragma("unroll") for (int n = 0; n < 2; ++n) { \
        if constexpr (QM == 0) acc[mt][bj][n] = __builtin_amdgcn_mfma_f32_16x16x32_bf16(__builtin_bit_cast(pg8::bf16x8, bf[bj][n]), __builtin_bit_cast(pg8::bf16x8, af[mt]), acc[mt][bj][n], 0, 0, 0); \
        else if constexpr (QM == 2) acc[mt][bj][n] = __builtin_bit_cast(pg8::f32x4, __builtin_amdgcn_mfma_i32_16x16x64_i8(bf[bj][n], af[mt], __builtin_bit_cast(v4i_, acc[mt][bj][n]), 0, 0, 0)); \
        else { typedef long l2_ __attribute__((ext_vector_type(2))); const l2_ bl_ = __builtin_bit_cast(l2_, bf[bj][n]), al_ = __builtin_bit_cast(l2_, af[mt]); \
            acc[mt][bj][n] = __builtin_amdgcn_mfma_f32_16x16x32_fp8_fp8(bl_[0], al_[0], acc[mt][bj][n], 0, 0, 0); acc[mt][bj][n] = __builtin_amdgcn_mfma_f32_16x16x32_fp8_fp8(bl_[1], al_[1], acc[mt][bj][n], 0, 0, 0); } } } while (0)
    SK_LOADP(a0, b0, a1, b1, 0); if (np > 1) SK_LOADP(a2, b2, a3, b3, 1);
    for (int p = 0; p < np; p += 2) {
        SK_MMA(a0, b0); SK_MMA(a1, b1);
        if (p + 2 < np) SK_LOADP(a0, b0, a1, b1, p + 2);
        if (p + 1 < np) { SK_MMA(a2, b2); SK_MMA(a3, b3);
            if (p + 3 < np) SK_LOADP(a2, b2, a3, b3, p + 3); }
    }
#undef SK_LOADP
#undef SK_MMA
    PG8_LAS pg8::f32x4* slab = (PG8_LAS pg8::f32x4*)lds;
#pragma unroll
    for (int mt = 0; mt < MT; ++mt)
#pragma unroll
        for (int bj = 0; bj < 2; ++bj)
#pragma unroll
            for (int n = 0; n < 2; ++n) { pg8::f32x4 t = acc[mt][bj][n];
                if constexpr (QM == 2) { const v4i_ ti = __builtin_bit_cast(v4i_, t); t = (pg8::f32x4){(float)ti[0], (float)ti[1], (float)ti[2], (float)ti[3]}; }
                slab[((wid * MT + mt) * 4 + bj * 2 + n) * 64 + lane] = t; }
    __syncthreads();
    if (wid < MT) { pg8::f32x4 v[2][2]; const int row = MP + 16 * MT * rg + 16 * wid + fr;
      float rsc = oscale; if constexpr (QM == 2) rsc = xs[row];
#pragma unroll
      for (int bj = 0; bj < 2; ++bj)
#pragma unroll
          for (int n = 0; n < 2; ++n) { const int o = (wid * 4 + bj * 2 + n) * 64 + lane; pg8::f32x4 t = slab[o];
#pragma unroll
              for (int q = 1; q < 8; ++q) t = t + slab[o + q * MT * 4 * 64];
              if constexpr (QM == 2) t = t * (*(const pg8::f32x4*)(wsn + 256 * pn + 128 * bj + 32 * wc + 16 * n + 4 * fq)) * rsc;
              else if constexpr (QM == 1) t = t * rsc;
              v[bj][n] = t; }
      E.row(v, row, pn, wc, fr, fq, -1); }
    __syncthreads();
}
template <class Epi, int MT, int QM> __device__ __forceinline__ void skinny_phase(PG8_LAS unsigned char* lds, const void* A, const void* Bt, int N, int KB, int blk, int G, const Epi& E,
                                                                                 const float* xs = nullptr, const float* wsn = nullptr, float oscale = 1.0f) {
    constexpr int NRG = 8 / MT; const int nu = (N / 256) * 4 * NRG;
    for (int u = blk; u < nu; u += G) skinny_unit<Epi, MT, QM>(lds, (const unsigned char*)A, (const unsigned char*)Bt, KB, u / (4 * NRG), (u / NRG) & 3, u % NRG, E, xs, wsn, oscale);
}
__device__ __forceinline__ void fill_rstd_table(LAS float* tab, const pg8::StaticOrder& S, const float* ss, int nslot, const float* xs = nullptr) {
    const int tid = threadIdx.x; Unit u; int nu = 0;
    while (nu < 11 && S.next(nu, u)) ++nu;
    float sv[6], xsv[6]; int ix[6];
#pragma unroll
    for (int k2 = 0; k2 < 6; ++k2) { const int idx = tid + 512 * k2; ix[k2] = idx; const bool ok = idx < nu * 256; Unit uu_; S.next(ok ? (idx >> 8) : 0, uu_); const int row = uu_.pm * 256 + (idx & 255);
        float s_ = 0.f;
        if (nslot == 1) s_ = ss[row];
        else { const f32x4* p = (const f32x4*)(ss + (size_t)row * 16); const f32x4 a = p[0], b = p[1], c = p[2], d = p[3]; s_ = ((a.x + a.y) + (a.z + a.w)) + ((b.x + b.y) + (b.z + b.w)) + ((c.x + c.y) + (c.z + c.w)) + ((d.x + d.y) + (d.z + d.w)); }
        sv[k2] = s_; xsv[k2] = xs ? xs[row] : 1.0f; }
#pragma unroll
    for (int k2 = 0; k2 < 6; ++k2) if (ix[k2] < nu * 256) tab[ix[k2]] = __builtin_amdgcn_rsqf(sv[k2] * (1.0f / D) + EPS) * xsv[k2];
    __syncthreads();
}
__device__ __forceinline__ void quant_rows_pass(int gw, int NGW, const bf16_t* X, unsigned char* Q, float* XS, int nrows) {
    const int lane = threadIdx.x & 63;
    for (int g8 = gw; g8 < nrows / 8; g8 += NGW) {
        const int m0 = 8 * g8; v4u a[8][2];
#pragma unroll
        for (int r = 0; r < 8; ++r) { a[r][0] = *(const v4u*)(X + (size_t)(m0 + r) * D + 8 * lane); a[r][1] = *(const v4u*)(X + (size_t)(m0 + r) * D + 512 + 8 * lane); }
#pragma unroll
        for (int r = 0; r < 8; ++r) {
            float x[16];
#pragma unroll
            for (int e = 0; e < 4; ++e) { x[2 * e] = __uint_as_float(a[r][0][e] << 16); x[2 * e + 1] = __uint_as_float(a[r][0][e] & 0xffff0000u); x[8 + 2 * e] = __uint_as_float(a[r][1][e] << 16); x[9 + 2 * e] = __uint_as_float(a[r][1][e] & 0xffff0000u); }
            float mx = 0.f;
#pragma unroll
            for (int e = 0; e < 16; ++e) mx = fmaxf(mx, fabsf(x[e]));
            { unsigned v = __float_as_uint(mx), o;
              o = (unsigned)__builtin_amdgcn_update_dpp(0, (int)v, 0xB1, 0xF, 0xF, true); v = o > v ? o : v;
              o = (unsigned)__builtin_amdgcn_update_dpp(0, (int)v, 0x4E, 0xF, 0xF, true); v = o > v ? o : v;
              o = (unsigned)__builtin_amdgcn_update_dpp(0, (int)v, 0x141, 0xF, 0xF, true); v = o > v ? o : v;
              o = (unsigned)__builtin_amdgcn_update_dpp(0, (int)v, 0x140, 0xF, 0xF, true); v = o > v ? o : v;
              const unsigned p0 = (unsigned)__builtin_amdgcn_readlane((int)v, 0), p1 = (unsigned)__builtin_amdgcn_readlane((int)v, 16), p2 = (unsigned)__builtin_amdgcn_readlane((int)v, 32), p3 = (unsigned)__builtin_amdgcn_readlane((int)v, 48);
              const unsigned q0 = p0 > p1 ? p0 : p1, q1 = p2 > p3 ? p2 : p3; mx = __uint_as_float(q0 > q1 ? q0 : q1); }
            const float iq = mx > 0.f ? 127.0f / mx : 0.f;
            unsigned w[4];
#pragma unroll
            for (int e = 0; e < 4; ++e) { const int q0 = (int)__builtin_rintf(x[4 * e] * iq), q1 = (int)__builtin_rintf(x[4 * e + 1] * iq), q2 = (int)__builtin_rintf(x[4 * e + 2] * iq), q3 = (int)__builtin_rintf(x[4 * e + 3] * iq);
                w[e] = (unsigned)(q0 & 0xff) | ((unsigned)(q1 & 0xff) << 8) | ((unsigned)(q2 & 0xff) << 16) | ((unsigned)(q3 & 0xff) << 24); }
            *(v2u*)(Q + (size_t)(m0 + r) * D + 8 * lane) = (v2u){w[0], w[1]};
            *(v2u*)(Q + (size_t)(m0 + r) * D + 512 + 8 * lane) = (v2u){w[2], w[3]};
            if (lane == 0) XS[m0 + r] = mx * (1.0f / 127.0f);
        }
    }
}
struct Frame {
    LAS unsigned char* lds;
    volatile LAS unsigned* MISC;
    gu32* ctl;
    int tid, lane, wave, vcu, G;
    const void* const* in;
    float* out; unsigned char* ws;
};
#define WSP(T, off) ((T*)(F.ws + (off)))

template <class Map> __device__ __forceinline__ void p0_transpose_item(const float* W, int K, int N, const float* gain, bf16* WT, LAS float* scr, int item, int lane, const Map map, unsigned char* WT8 = nullptr) {
    const int nblk = (N + 31) / 32, kb = item / nblk, nb = item % nblk, k0 = 64 * kb, n0 = 32 * nb;
    const bool nok = n0 + (lane & 31) < N;
#pragma unroll 8
    for (int i = 0; i < 32; ++i) { const int kk = 2 * i + (lane >> 5); float v = nok ? __builtin_nontemporal_load(W + (size_t)(k0 + kk) * N + n0 + (lane & 31)) : 0.f; if (gain) v *= gain[k0 + kk]; scr[kk * 33 + (lane & 31)] = v; }
    LDS_WAIT(); asm volatile("" ::: "memory");
    const int c = lane & 7;
#pragma unroll
    for (int j = 0; j < 4; ++j) { const int n = (lane >> 3) + 8 * j; const LAS float* s = scr + (8 * c) * 33 + n;
        v4u o; o.x = pk2(s[0 * 33], s[1 * 33]); o.y = pk2(s[2 * 33], s[3 * 33]); o.z = pk2(s[4 * 33], s[5 * 33]); o.w = pk2(s[6 * 33], s[7 * 33]);
        if (n0 + n < N) { if (WT) *(GAS v4u*)(WT + (size_t)map(n0 + n) * K + k0 + 8 * c) = o;
            if (WT8) { v2u o8; o8.x = pk4_fp8(s[0 * 33] * W8SCALE, s[1 * 33] * W8SCALE, s[2 * 33] * W8SCALE, s[3 * 33] * W8SCALE); o8.y = pk4_fp8(s[4 * 33] * W8SCALE, s[5 * 33] * W8SCALE, s[6 * 33] * W8SCALE, s[7 * 33] * W8SCALE);
                *(GAS v2u*)(WT8 + (size_t)map(n0 + n) * K + k0 + 8 * c) = o8; } } }
    LDS_WAIT(); asm volatile("" ::: "memory");
}
__device__ __forceinline__ void sincos_d(double a, float& s, float& c) {
    const double TWO_PI = 6.283185307179586476925286766559, PI = 3.14159265358979323846264338327950288;
    double k = __builtin_rint(a / TWO_PI); double r = a - k * TWO_PI;
    double sgn = 1.0; if (r > PI * 0.5) { r = PI - r; sgn = -1.0; } else if (r < -PI * 0.5) { r = -PI - r; sgn = -1.0; }
    const double r2 = r * r;
    double ts = 1.0, tc = 1.0, ps = 1.0, pc = 1.0;
#pragma unroll
    for (int n = 1; n <= 12; ++n) { pc = -pc * r2 / (double)((2 * n - 1) * (2 * n)); ps = -ps * r2 / (double)((2 * n) * (2 * n + 1)); tc += pc; ts += ps; }
    s = (float)(r * ts); c = (float)(sgn * tc);
}
__device__ __forceinline__ void p0_prologue(Frame& F) {
    LAS float* scr = (LAS float*)(F.lds + RING_OFF + F.wave * 16384);
    const int gw = F.vcu * 8 + F.wave, NGW = F.G * 8;
    constexpr int I_G = (D / 64) * (DFF / 32), I_D = (DFF / 64) * (D / 32), I_IN = (D / 64) * ((NIN + 31) / 32), I_O = (D / 64) * (D / 32);
    constexpr int NITEMS = 2 * (2 * I_G + I_D) + I_IN + I_O;
    for (int rep63 = 0; rep63 < (PROBE_DUP == 63 ? 2 : 1); ++rep63)
    for (int it = gw; it < NITEMS; it += NGW) {
        int r = it;
        if (r < I_G) { p0_transpose_item(((const float*)F.in[8]), D, DFF, ((const float*)F.in[7]), WSP(bf16, WS_WGU1), scr, r, F.lane, MapGate()); continue; } r -= I_G;
        if (r < I_G) { p0_transpose_item(((const float*)F.in[9]), D, DFF, ((const float*)F.in[7]), WSP(bf16, WS_WGU1), scr, r, F.lane, MapUp()); continue; } r -= I_G;
        if (r < I_D) { p0_transpose_item(((const float*)F.in[10]), DFF, D, nullptr, (bf16*)nullptr, scr, r, F.lane, MapLin(), WSP(unsigned char, WS_WD1_8)); continue; } r -= I_D;
        if (r < I_G) { p0_transpose_item(((const float*)F.in[19]), D, DFF, ((const float*)F.in[18]), WSP(bf16, WS_WGU2), scr, r, F.lane, MapGate()); continue; } r -= I_G;
        if (r < I_G) { p0_transpose_item(((const float*)F.in[20]), D, DFF, ((const float*)F.in[18]), WSP(bf16, WS_WGU2), scr, r, F.lane, MapUp()); continue; } r -= I_G;
        if (r < I_D) { p0_transpose_item(((const float*)F.in[21]), DFF, D, nullptr, (bf16*)nullptr, scr, r, F.lane, MapLin(), WSP(unsigned char, WS_WD2_8)); continue; } r -= I_D;
        if (r < I_IN) { p0_transpose_item(((const float*)F.in[12]), D, NIN, ((const float*)F.in[11]), WSP(bf16, WS_WIN), scr, r, F.lane, MapWin()); continue; } r -= I_IN;
        p0_transpose_item(((const float*)F.in[17]), D, D, nullptr, WSP(bf16, WS_WOUT), scr, r, F.lane, MapLin());
    }
    float* SS0 = WSP(float, WS_SS0);
    for (int rep64 = 0; rep64 < (PROBE_DUP == 64 ? 2 : 1); ++rep64)
    for (int g4 = gw; g4 < MTOT / 4; g4 += NGW) {
        const int m0 = 4 * g4;
        const float* xrow = m0 < MP ? ((const float*)F.in[0]) + (size_t)m0 * D : ((const float*)F.in[1]) + (size_t)(m0 - MP) * D;
        const GAS f32x4* xr = (const GAS f32x4*)xrow + F.lane;
        f32x4 v[4][4]; float s[4];
#pragma unroll
        for (int r = 0; r < 4; ++r)
#pragma unroll
            for (int j = 0; j < 4; ++j) v[r][j] = __builtin_nontemporal_load((const f32x4*)(xr + 256 * r + 64 * j));
#pragma unroll
        for (int r = 0; r < 4; ++r) { s[r] = 0.f;
#pragma unroll
            for (int j = 0; j < 4; ++j) s[r] += (v[r][j].x * v[r][j].x + v[r][j].y * v[r][j].y) + (v[r][j].z * v[r][j].z + v[r][j].w * v[r][j].w); }
#pragma unroll
        for (int o = 1; o < 64; o <<= 1) {
#pragma unroll
            for (int r = 0; r < 4; ++r) s[r] += __shfl_xor(s[r], o); }
        { float mx[4];
#pragma unroll
          for (int r = 0; r < 4; ++r) { mx[r] = 0.f;
#pragma unroll
              for (int j = 0; j < 4; ++j) mx[r] = fmaxf(mx[r], fmaxf(fmaxf(fabsf(v[r][j].x), fabsf(v[r][j].y)), fmaxf(fabsf(v[r][j].z), fabsf(v[r][j].w)))); }
#pragma unroll
          for (int o = 1; o < 64; o <<= 1) {
#pragma unroll
              for (int r = 0; r < 4; ++r) mx[r] = fmaxf(mx[r], __shfl_xor(mx[r], o)); }
          GAS unsigned* q8 = (GAS unsigned*)(WSP(unsigned char, WS_XI8) + (size_t)m0 * D) + F.lane;
#pragma unroll
          for (int r = 0; r < 4; ++r) { const float iq = mx[r] > 0.f ? 127.0f / mx[r] : 0.f;
#pragma unroll
              for (int j = 0; j < 4; ++j) { const int a_ = (int)__builtin_rintf(v[r][j].x * iq), b_ = (int)__builtin_rintf(v[r][j].y * iq), c_ = (int)__builtin_rintf(v[r][j].z * iq), d_ = (int)__builtin_rintf(v[r][j].w * iq);
                  q8[256 * r + 64 * j] = (unsigned)(a_ & 0xff) | ((unsigned)(b_ & 0xff) << 8) | ((unsigned)(c_ & 0xff) << 16) | ((unsigned)(d_ & 0xff) << 24); } }
          if (F.lane < 4) WSP(float, WS_XS)[m0 + F.lane] = (F.lane == 0 ? mx[0] : F.lane == 1 ? mx[1] : F.lane == 2 ? mx[2] : mx[3]) * (1.0f / 127.0f); }
        if (F.lane < 4) SS0[m0 + F.lane] = F.lane == 0 ? s[0] : F.lane == 1 ? s[1] : F.lane == 2 ? s[2] : s[3];
    }
    { float* rope = WSP(float, WS_ROPE);
      const double invf[8] = {1.0, 0.19392274474868576, 0.03760603093086393, 0.007292664737217109, 0.001414213562373095, 0.0002742481756762073, 5.318295896944988e-05, 1.031338537721246e-05};
      for (int rep65 = 0; rep65 < (PROBE_DUP == 65 ? 2 : 1); ++rep65)
      for (int e = (F.vcu * 512 + F.tid); e < 2052 * 8; e += F.G * 512) { const int p = e >> 3, i = e & 7; const double pos = (double)(p < SEQ ? p : PAST + (p - SEQ));
          double f = invf[0];
#pragma unroll
          for (int q = 1; q < 8; ++q) f = (i == q) ? invf[q] : f;
          float s, c; sincos_d(pos * f, s, c); rope[2 * e] = c; rope[2 * e + 1] = s; } }
}

__device__ __forceinline__ void unpack8(const v4u a, float (&o)[8]) {
#pragma unroll
    for (int e = 0; e < 4; ++e) { o[2 * e] = bf2f((unsigned short)(a[e] & 0xffffu)); o[2 * e + 1] = bf2f((unsigned short)(a[e] >> 16)); }
}
__device__ __forceinline__ void p0b_quant_weights(Frame& F) {
    const int gw = F.vcu * 8 + F.wave, NGW = F.G * 8;
    for (int rr = gw; rr < 4 * DFF; rr += NGW) {
        const bool second = rr >= 2 * DFF; const int r = second ? rr - 2 * DFF : rr;
        const bf16* W = second ? WSP(bf16, WS_WGU2) : WSP(bf16, WS_WGU1); unsigned char* Q = second ? WSP(unsigned char, WS_WGU2I8) : WSP(unsigned char, WS_WGU1I8); float* WSN = second ? WSP(float, WS_WSN2) : WSP(float, WS_WSN);
        const v4u a = *(const GAS v4u*)(W + (size_t)r * D + 8 * F.lane), b = *(const GAS v4u*)(W + (size_t)r * D + 512 + 8 * F.lane);
        float x[16]; { float t0[8], t1[8]; unpack8(a, t0); unpack8(b, t1);
#pragma unroll
            for (int e = 0; e < 8; ++e) { x[e] = t0[e]; x[8 + e] = t1[e]; } }
        float mx = 0.f;
#pragma unroll
        for (int e = 0; e < 16; ++e) mx = fmaxf(mx, fabsf(x[e]));
#pragma unroll
        for (int o = 1; o < 64; o <<= 1) mx = fmaxf(mx, __shfl_xor(mx, o));
        const float iq = mx > 0.f ? 127.0f / mx : 0.f;
        unsigned w[4];
#pragma unroll
        for (int e = 0; e < 4; ++e) { const int q0 = (int)__builtin_rintf(x[4 * e] * iq), q1 = (int)__builtin_rintf(x[4 * e + 1] * iq), q2 = (int)__builtin_rintf(x[4 * e + 2] * iq), q3 = (int)__builtin_rintf(x[4 * e + 3] * iq);
            w[e] = (unsigned)(q0 & 0xff) | ((unsigned)(q1 & 0xff) << 8) | ((unsigned)(q2 & 0xff) << 16) | ((unsigned)(q3 & 0xff) << 24); }
        *(GAS v2u*)(Q + (size_t)r * D + 8 * F.lane) = (v2u){w[0], w[1]};
        *(GAS v2u*)(Q + (size_t)r * D + 512 + 8 * F.lane) = (v2u){w[2], w[3]};
        if (F.lane == 0) WSN[r] = mx * (1.0f / 127.0f);
    }
}
__device__ __forceinline__ void p4_conv(Frame& F) {
    const int gw = F.vcu * 8 + F.wave, NGW = F.G * 8, ch = F.lane * 8;
    const bf16* U = WSP(bf16, WS_U); const bf16* GBp = WSP(bf16, WS_GB); bf16* CAT = WSP(bf16, WS_CAT);
    const float* conv_w = (const float*)F.in[13]; const float* conv_b = (const float*)F.in[14]; const float* cache_conv = (const float*)F.in[5];
    float w0[8], w1[8], w2[8], cb[8];
#pragma unroll
    for (int e = 0; e < 8; ++e) { w0[e] = conv_w[ch + e]; w1[e] = conv_w[512 + ch + e]; w2[e] = conv_w[1024 + ch + e]; cb[e] = conv_b[ch + e]; }
    for (int c = gw; c < MTOT / 8; c += NGW) {
        const int r0 = 8 * c;
        v4u ur[10], gr[8];
#pragma unroll
        for (int e = 0; e < 10; ++e) { const int rr = r0 - 2 + e; ur[e] = *(const GAS v4u*)(U + (size_t)(rr < 0 ? 0 : rr) * 512 + ch); }
#pragma unroll
        for (int e = 0; e < 8; ++e) gr[e] = *(const GAS v4u*)(GBp + (size_t)(r0 + e) * 512 + ch);
        float um2[8], um1[8];
        unpack8(ur[0], um2); unpack8(ur[1], um1);
        if (r0 < MP && (r0 & (SEQ - 1)) == 0) {
#pragma unroll
            for (int e = 0; e < 8; ++e) { um2[e] = 0.f; um1[e] = 0.f; } }
#pragma unroll
        for (int e = 0; e < 8; ++e) {
            if (r0 >= MP && (e & 3) == 0) {
                const float* cc = cache_conv + (size_t)((r0 - MP + e) >> 2) * 2 * 512 + ch;
#pragma unroll
                for (int q = 0; q < 8; ++q) { um2[q] = cc[q]; um1[q] = cc[512 + q]; } }
            float u0[8], g[8], y[8]; unpack8(ur[2 + e], u0); unpack8(gr[e], g);
#pragma unroll
            for (int q = 0; q < 8; ++q) { y[q] = g[q] * (cb[q] + w0[q] * um2[q] + w1[q] * um1[q] + w2[q] * u0[q]); um2[q] = um1[q]; um1[q] = u0[q]; }
            v4u o; o.x = pk2(y[0], y[1]); o.y = pk2(y[2], y[3]); o.z = pk2(y[4], y[5]); o.w = pk2(y[6], y[7]);
            *(GAS v4u*)(CAT + (size_t)(r0 + e) * D + ch) = o;
        }
    }
}
__device__ __forceinline__ int crow16(int r, int hi) { return (r & 3) + 8 * (r >> 2) + 4 * hi; }
__device__ __forceinline__ float xhalf_sum(float v) {
    auto rr = __builtin_amdgcn_permlane32_swap(__float_as_uint(v), __float_as_uint(v), false, false);
    return __uint_as_float(rr[0]) + __uint_as_float(rr[1]);
}
__device__ __forceinline__ void p4_sample_scores(Frame& F) {
    const int gw = F.vcu * 8 + F.wave, NGW = F.G * 8, lane = F.lane, r32 = lane & 31, hi = lane >> 5;
    const bf16* QI = WSP(bf16, WS_QI); const float* WIp = WSP(float, WS_WI); float* SSC = WSP(float, WS_SSC);
    const int* page_table = (const int*)F.in[6]; const float* cache_idx_k = (const float*)F.in[4];
    for (int item = gw; item < DB * NPAGES; item += NGW) {
        const int b = item >> 7, pg = item & 127; const int page = page_table[b * NPAGES + pg];
        bf16x8 a[4]; f32x4 w4[4];
        { const bf16* qrow = QI + (size_t)(MP + 4 * b + (r32 >> 3)) * 512 + (r32 & 7) * 64 + 8 * hi;
#pragma unroll
          for (int s = 0; s < 4; ++s) a[s] = *(const GAS bf16x8*)(qrow + 16 * s);
#pragma unroll
          for (int q = 0; q < 4; ++q) w4[q] = *(const GAS f32x4*)(WIp + (size_t)(MP + 4 * b + q) * 8 + 4 * hi); }
        const float* src = cache_idx_k + ((size_t)page * PAGE + r32) * 64 + 8 * hi;
        f32x4 lo[4][4], hh[4][4];
#pragma unroll
        for (int sub = 0; sub < 4; ++sub)
#pragma unroll
            for (int s = 0; s < 4; ++s) { lo[sub][s] = __builtin_nontemporal_load((const f32x4*)(src + sub * 32 * 64 + 16 * s)); hh[sub][s] = __builtin_nontemporal_load((const f32x4*)(src + sub * 32 * 64 + 16 * s + 4)); }
#pragma unroll
        for (int sub = 0; sub < 4; ++sub) {
            f32x16 acc = {};
#pragma unroll
            for (int s = 0; s < 4; ++s) { v4u p; p.x = pk2(lo[sub][s][0], lo[sub][s][1]); p.y = pk2(lo[sub][s][2], lo[sub][s][3]); p.z = pk2(hh[sub][s][0], hh[sub][s][1]); p.w = pk2(hh[sub][s][2], hh[sub][s][3]);
                acc = __builtin_amdgcn_mfma_f32_32x32x16_bf16(a[s], __builtin_bit_cast(bf16x8, p), acc, 0, 0, 0); }
#pragma unroll
            for (int q = 0; q < 4; ++q) {
                float sum = w4[q][0] * fmaxf(acc[4 * q], 0.f) + w4[q][1] * fmaxf(acc[4 * q + 1], 0.f) + w4[q][2] * fmaxf(acc[4 * q + 2], 0.f) + w4[q][3] * fmaxf(acc[4 * q + 3], 0.f);
                sum = xhalf_sum(sum) + 0.0f;
                if ((q >> 1) == hi) SSC[(size_t)(4 * b + q) * SSTR + pg * PAGE + sub * 32 + r32] = sum;
            }
        }
    }
}
__device__ __forceinline__ unsigned fkey(float s) { const unsigned b = __builtin_bit_cast(unsigned, s); return b ^ ((unsigned)((int)b >> 31) | 0x80000000u); }
__device__ __forceinline__ float unfkey(unsigned k) { const unsigned b = (k & 0x80000000u) ? (k ^ 0x80000000u) : ~k; return __builtin_bit_cast(float, b); }
__device__ __forceinline__ unsigned wave_umax(unsigned v) {
    unsigned o;
    o = (unsigned)__builtin_amdgcn_update_dpp(0, (int)v, 0xB1, 0xF, 0xF, true); v = o > v ? o : v;
    o = (unsigned)__builtin_amdgcn_update_dpp(0, (int)v, 0x4E, 0xF, 0xF, true); v = o > v ? o : v;
    o = (unsigned)__builtin_amdgcn_update_dpp(0, (int)v, 0x141, 0xF, 0xF, true); v = o > v ? o : v;
    o = (unsigned)__builtin_amdgcn_update_dpp(0, (int)v, 0x140, 0xF, 0xF, true); v = o > v ? o : v;
    const unsigned a = (unsigned)__builtin_amdgcn_readlane((int)v, 0), b = (unsigned)__builtin_amdgcn_readlane((int)v, 16), c = (unsigned)__builtin_amdgcn_readlane((int)v, 32), d = (unsigned)__builtin_amdgcn_readlane((int)v, 48);
    const unsigned ab = a > b ? a : b, cd = c > d ? c : d; return ab > cd ? ab : cd;
}
__device__ __forceinline__ int wave_count(unsigned cl) {
    int tot = 0;
#pragma unroll
    for (int bb = 0; bb < 6; ++bb) tot += __popcll(__ballot((cl >> bb) & 1u)) << bb;
    return tot;
}
__device__ __forceinline__ void p4_index_preload(Frame& F, int b, int j, bf16x8 (&a)[4][4], float& pwq) {
    const int tid = F.tid, r32 = F.lane & 31, hi = F.lane >> 5; const size_t rowb = (size_t)b * SEQ; const int t0 = 16 * j;
    const bf16* QI = WSP(bf16, WS_QI); const float* WIp = WSP(float, WS_WI);
    pwq = WIp[(rowb + t0 + ((tid & 127) >> 3)) * 8 + (tid & 7)];
#pragma unroll
    for (int rt = 0; rt < 4; ++rt) { const bf16* qrow = QI + (rowb + t0 + 4 * rt + 2 * (r32 >> 4) + ((r32 >> 2) & 1)) * 512 + (4 * ((r32 >> 3) & 1) + (r32 & 3)) * 64 + 8 * hi;
#pragma unroll
        for (int s = 0; s < 4; ++s) a[rt][s] = *(const GAS bf16x8*)(qrow + 16 * s); }
}
__device__ __forceinline__ void p4_index_unit(Frame& F, int b, int j, int useq, bf16x8 (&a)[4][4], float& pwq, int nj) {
    int tid_ = F.tid; asm volatile("" : "+v"(tid_));
    const int tid = tid_, lane = tid & 63, wid = F.wave, r32 = lane & 31, hi = lane >> 5;
    const int ss_id = (F.vcu * 8 + useq) * 8 + wid, ss_item = ss_id >> 2, ss_sub = ss_id & 3, ss_b = ss_item >> 7, ss_pg = ss_item & 127;
    const bool ss_on = F.vcu < 256;
    const int ss_page = ss_on ? ((const int*)F.in[6])[ss_b * NPAGES + ss_pg] : 0;
    const int t0 = 16 * j, nk = t0 + 16, ntile = (nk + 31) >> 5;
    LAS float* S = (LAS float*)(F.lds + RING_OFF);
    LAS float* WQ = (LAS float*)(F.lds + RING_OFF + 131072);
    LAS unsigned long long* MSK = (LAS unsigned long long*)(F.lds + RING_OFF + 131072 + 512);
    LAS unsigned* HW = (LAS unsigned*)(F.lds + RING_OFF + 131072 + 512 + 4096) + wid * 512;
    const bf16* QI = WSP(bf16, WS_QI); const bf16* KIB = WSP(bf16, WS_KIB); const float* WIp = WSP(float, WS_WI);
    unsigned long long* MASK = WSP(unsigned long long, WS_MASK);
    const size_t rowb = (size_t)b * SEQ;
    for (int rep43 = 0; rep43 < (PROBE_DUP == 43 ? 2 : 1); ++rep43)
    if (j >= 16) {
        if (tid < 128) WQ[tid] = pwq;
        const bf16* kbase = KIB + (rowb + r32) * 64 + 8 * hi;
#define IDX_LOADB(dst, kt_) do { const int kc_ = (kt_) < ntile ? (kt_) : ntile - 1; _Pragma("unroll") for (int s = 0; s < 4; ++s) dst[s] = *(const GAS bf16x8*)(kbase + (size_t)kc_ * 32 * 64 + 16 * s); } while (0)
#define RELU_(x_) __builtin_amdgcn_fmed3f((x_), 0.f, inf_)
#define IDX_COMPUTE(bf_, kt_) do { const int key = (kt_) * 32 + r32; \
            _Pragma("unroll") for (int rt = 0; rt < 4; ++rt) { f32x16 acc = {}; \
                _Pragma("unroll") for (int s = 0; s < 4; ++s) acc = __builtin_amdgcn_mfma_f32_32x32x16_bf16(a[rt][s], bf_[s], acc, 0, 0, 0); \
                _Pragma("unroll") for (int qp = 0; qp < 2; ++qp) { const int ql_ = 4 * rt + 2 * qp + hi;                      \
                    const f32x4 wa = *(const LAS f32x4*)(WQ + ql_ * 8), wb = *(const LAS f32x4*)(WQ + ql_ * 8 + 4); \
                      \
                    float e0_ = RELU_(acc[8 * qp + 0]) * wa[0], e1_ = RELU_(acc[8 * qp + 1]) * wa[1]; \
                    e0_ = __builtin_fmaf(RELU_(acc[8 * qp + 2]), wa[2], e0_); e1_ = __builtin_fmaf(RELU_(acc[8 * qp + 3]), wa[3], e1_); \
                    e0_ = __builtin_fmaf(RELU_(acc[8 * qp + 4]), wb[0], e0_); e1_ = __builtin_fmaf(RELU_(acc[8 * qp + 5]), wb[1], e1_); \
                    e0_ = __builtin_fmaf(RELU_(acc[8 * qp + 6]), wb[2], e0_); e1_ = __builtin_fmaf(RELU_(acc[8 * qp + 7]), wb[3], e1_); \
                    S[ql_ * 2048 + key] = (e0_ + e1_) + 0.0f; } } } while (0)
        float inf_ = __builtin_inff(); asm volatile("" : "+v"(inf_));
        bf16x8 bfA[4], bfB[4];
        IDX_LOADB(bfA, wid);
        __syncthreads();
        for (int kt = wid; kt < ntile; kt += 16) {
            IDX_LOADB(bfB, kt + 8);
            IDX_COMPUTE(bfA, kt);
            if (kt + 8 < ntile) { IDX_LOADB(bfA, kt + 16); IDX_COMPUTE(bfB, kt + 8); }
        }
#undef IDX_LOADB
#undef IDX_COMPUTE
#undef RELU_
        __syncthreads();
    }
    f32x4 ss_lo[4], ss_hh[4];
    { const float* src = ((const float*)F.in[4]) + ((size_t)ss_page * PAGE + ss_sub * 32 + r32) * 64 + 8 * hi;
#pragma unroll
      for (int s = 0; s < 4; ++s) { ss_lo[s] = __builtin_nontemporal_load((const f32x4*)(src + 16 * s)); ss_hh[s] = __builtin_nontemporal_load((const f32x4*)(src + 16 * s + 4)); }
    }
#pragma unroll 1
    for (int rep44 = 0; rep44 < (PROBE_DUP == 44 ? 2 : 1); ++rep44) {
        const int qlA = 2 * wid, tA = t0 + qlA, tB = tA + 1;
        unsigned wloA = 0u, whiA = 0u, wloB = 0u, whiB = 0u;
        if (tA < KTOP) {
            const int lo_ = 64 * lane;
            const unsigned long long wA_ = (lo_ + 63 <= tA) ? ~0ull : (lo_ > tA ? 0ull : ((1ull << (tA - lo_ + 1)) - 1ull)), wB_ = (lo_ + 63 <= tB) ? ~0ull : (lo_ > tB ? 0ull : ((1ull << (tB - lo_ + 1)) - 1ull));
            wloA = (unsigned)wA_; whiA = (unsigned)(wA_ >> 32); wloB = (unsigned)wB_; whiB = (unsigned)(wB_ >> 32);
        } else {
            bool doneA = false, doneB = false;
            { unsigned kvA[32], kvB[32]; float amA = 0.f, amB = 0.f;
              const int ngr = (tA >> 8) + 1;
#pragma unroll
              for (int g4 = 0; g4 < 8; ++g4) {
#pragma unroll
                  for (int e = 0; e < 4; ++e) { kvA[4 * g4 + e] = 0u; kvB[4 * g4 + e] = 0u; }
                  if (g4 < ngr) {
                      float sA[4], sB[4];
#pragma unroll
                      for (int e = 0; e < 4; ++e) { sA[e] = S[qlA * 2048 + lane + 64 * (4 * g4 + e)]; sB[e] = S[qlA * 2048 + 2048 + lane + 64 * (4 * g4 + e)]; }
                      if (g4 == ngr - 1) {
#pragma unroll
                          for (int e = 0; e < 4; ++e) { const int ki = lane + 64 * (4 * g4 + e); sA[e] = (ki <= tA) ? sA[e] : 0.f; sB[e] = (ki <= tB) ? sB[e] : 0.f; } }
#pragma unroll
                      for (int e = 0; e < 4; ++e) { kvA[4 * g4 + e] = __float_as_uint(sA[e]); amA = fmaxf(amA, fabsf(sA[e])); kvB[4 * g4 + e] = __float_as_uint(sB[e]); amB = fmaxf(amB, fabsf(sB[e])); } } }
              const unsigned umA = wave_umax(__float_as_uint(amA)), umB = wave_umax(__float_as_uint(amB));
              const float scaleA = umA ? 0.4999f / __uint_as_float(umA) : 0.f, scaleB = umB ? 0.4999f / __uint_as_float(umB) : 0.f;
#pragma unroll
              for (int g4 = 0; g4 < 8; ++g4) if (g4 < ngr) {
#pragma unroll
                  for (int e = 0; e < 4; ++e) { const int jj = 4 * g4 + e; kvA[jj] = __float_as_uint(__builtin_fmaf(__uint_as_float(kvA[jj]), scaleA, 1.5f)); kvB[jj] = __float_as_uint(__builtin_fmaf(__uint_as_float(kvB[jj]), scaleB, 1.5f)); }
                  if (g4 == ngr - 1) {
#pragma unroll
                      for (int e = 0; e < 4; ++e) { const int jj = 4 * g4 + e; kvA[jj] = (lane + 64 * jj <= tA) ? kvA[jj] : 0u; kvB[jj] = (lane + 64 * jj <= tB) ? kvB[jj] : 0u; } } }
              unsigned pfxA = 0x3F800000u, pfxB = 0x3F800000u, TvA = 0u, TvB = 0u; int needA = KTOP, needB = KTOP;
              const unsigned hwbA = (unsigned)(uintptr_t)HW, hwbB = hwbA + 1024u;
              LAS unsigned* HWB = HW + 256;
#pragma unroll 1
              for (int pass = 0; pass < 3; ++pass) {
                  const int sh = pass == 0 ? 15 : pass == 1 ? 7 : 0;
                  const unsigned lim = pass == 2 ? 128u : (256u << sh);
                  const unsigned limA = doneA ? 0u : lim, limB = doneB ? 0u : lim;
                  *(LAS v4u*)(HW + 4 * lane) = (v4u){0u, 0u, 0u, 0u}; *(LAS v4u*)(HWB + 4 * lane) = (v4u){0u, 0u, 0u, 0u};
                  asm volatile("" ::: "memory");
#pragma unroll
                  for (int g4 = 0; g4 < 8; ++g4) if (g4 < ngr) {
#pragma unroll
                      for (int e = 0; e < 4; ++e) { const unsigned dA_ = kvA[4 * g4 + e] ^ pfxA, dB_ = kvB[4 * g4 + e] ^ pfxB;
                          if (dA_ < limA) __hip_atomic_fetch_add((LAS unsigned*)(uintptr_t)(hwbA + ((dA_ >> sh) << 2)), 1u, __ATOMIC_RELAXED, __HIP_MEMORY_SCOPE_WAVEFRONT);
                          if (dB_ < limB) __hip_atomic_fetch_add((LAS unsigned*)(uintptr_t)(hwbB + ((dB_ >> sh) << 2)), 1u, __ATOMIC_RELAXED, __HIP_MEMORY_SCOPE_WAVEFRONT); } }
                  asm volatile("" ::: "memory");
                  const v4u wA4 = *(const LAS v4u*)(HW + 4 * lane), wB4 = *(const LAS v4u*)(HWB + 4 * lane);
                  asm volatile("" ::: "memory");
#define SEL_SCAN(w4_, need_, HWX_, dgb_, above_, binc_) do { \
                      const unsigned ls_ = (w4_[0] + w4_[1]) + (w4_[2] + w4_[3]); unsigned p_ = ls_; \
                      p_ += (unsigned)__builtin_amdgcn_update_dpp(0, (int)p_, 0x111, 0xF, 0xF, false); p_ += (unsigned)__builtin_amdgcn_update_dpp(0, (int)p_, 0x112, 0xF, 0xF, false); \
                      p_ += (unsigned)__builtin_amdgcn_update_dpp(0, (int)p_, 0x114, 0xF, 0xF, false); p_ += (unsigned)__builtin_amdgcn_update_dpp(0, (int)p_, 0x118, 0xF, 0xF, false); \
                      const unsigned r0_ = (unsigned)__builtin_amdgcn_readlane((int)p_, 15), r1_ = (unsigned)__builtin_amdgcn_readlane((int)p_, 31), r2_ = (unsigned)__builtin_amdgcn_readlane((int)p_, 47), r3_ = (unsigned)__builtin_amdgcn_readlane((int)p_, 63); \
                      const int row_ = lane >> 4; p_ += (row_ == 0) ? 0u : (row_ == 1) ? r0_ : (row_ == 2) ? r0_ + r1_ : r0_ + r1_ + r2_; \
                      const unsigned abl_ = (r0_ + r1_ + r2_ + r3_) - p_;                                    \
                      const unsigned long long fm_ = __ballot((int)abl_ < (need_) && (int)(abl_ + ls_) >= (need_)); \
                      const int src_ = (int)__builtin_ctzll(fm_) & 63; \
                      const unsigned abs_ = (unsigned)__builtin_amdgcn_readlane((int)abl_, src_); \
                      const unsigned ci_ = ((lane & 15) < 4) ? (HWX_)[4 * src_ + (lane & 3)] : 0u;          \
                      unsigned sfx_ = ci_; \
                      sfx_ += (unsigned)__builtin_amdgcn_update_dpp(0, (int)sfx_, 0x101, 0xF, 0xF, false); sfx_ += (unsigned)__builtin_amdgcn_update_dpp(0, (int)sfx_, 0x102, 0xF, 0xF, false); \
                      const unsigned abi_ = abs_ + sfx_ - ci_;                                                \
                      const unsigned long long fb_ = __ballot(lane < 4 && (int)abi_ < (need_) && (int)(abi_ + ci_) >= (need_)); \
                      const int sl2_ = (int)__builtin_ctzll(fb_) & 63; \
                      dgb_ = (unsigned)(4 * src_ + sl2_); above_ = (unsigned)__builtin_amdgcn_readlane((int)abi_, sl2_); binc_ = (unsigned)__builtin_amdgcn_readlane((int)ci_, sl2_); } while (0)
                  unsigned dgA, abvA, bcA, dgB, abvB, bcB;
                  SEL_SCAN(wA4, needA, HW, dgA, abvA, bcA);
                  SEL_SCAN(wB4, needB, HWB, dgB, abvB, bcB);
#undef SEL_SCAN
                  if (!doneA) { pfxA |= dgA << sh; needA -= (int)abvA; TvA = pfxA; doneA = ((int)bcA == needA); }
                  if (!doneB) { pfxB |= dgB << sh; needB -= (int)abvB; TvB = pfxB; doneB = ((int)bcB == needB); }
                  if (doneA && doneB) break;
              }
#define SEL_MASK(kv_, Tv_, wlo_, whi_) do { _Pragma("unroll") for (int j4 = 0; j4 < 8; ++j4) if (j4 < ngr) { \
                      const unsigned long long wa = __ballot(kv_[4 * j4] >= Tv_), wb = __ballot(kv_[4 * j4 + 1] >= Tv_), wc_ = __ballot(kv_[4 * j4 + 2] >= Tv_), wd = __ballot(kv_[4 * j4 + 3] >= Tv_); \
                      asm("s_nop 1\n\tv_writelane_b32 %0, %2, %10\n\tv_writelane_b32 %1, %3, %10\n\tv_writelane_b32 %0, %4, %11\n\tv_writelane_b32 %1, %5, %11\n\tv_writelane_b32 %0, %6, %12\n\tv_writelane_b32 %1, %7, %12\n\tv_writelane_b32 %0, %8, %13\n\tv_writelane_b32 %1, %9, %13" \
                          : "+v"(wlo_), "+v"(whi_) : "s"((unsigned)wa), "s"((unsigned)(wa >> 32)), "s"((unsigned)wb), "s"((unsigned)(wb >> 32)), "s"((unsigned)wc_), "s"((unsigned)(wc_ >> 32)), "s"((unsigned)wd), "s"((unsigned)(wd >> 32)), \
                            "n"(4 * j4), "n"(4 * j4 + 1), "n"(4 * j4 + 2), "n"(4 * j4 + 3)); } } while (0)
              if (doneA) SEL_MASK(kvA, TvA, wloA, whiA);
              if (doneB) SEL_MASK(kvB, TvB, wloB, whiB);
#undef SEL_MASK
            }
#pragma unroll 1
            for (int q2 = 0; q2 < 2; ++q2) {
            if (q2 == 0 ? doneA : doneB) continue;
            const int ql = qlA + q2, t = tA + q2; unsigned wlo = 0u, whi = 0u;
            unsigned uu[32];
#pragma unroll
            for (int jj = 0; jj < 32; ++jj) { const float s = S[ql * 2048 + lane + 64 * jj]; const unsigned k_ = fkey(s); uu[jj] = (lane + 64 * jj <= t) ? k_ : 0u; }
            const int ng = (t >> 8) + 1;
#define SEL_GRP(g4, CAND) if ((g4) < ng) { unsigned long long m0_, m1_, m2_, m3_; \
                    asm volatile("v_cmp_ge_u32_e64 %0, %4, %8\n\tv_cmp_ge_u32_e64 %1, %5, %8\n\tv_cmp_ge_u32_e64 %2, %6, %8\n\tv_cmp_ge_u32_e64 %3, %7, %8" \
                        : "=&s"(m0_), "=&s"(m1_), "=&s"(m2_), "=&s"(m3_) : "v"(uu[4 * (g4)]), "v"(uu[4 * (g4) + 1]), "v"(uu[4 * (g4) + 2]), "v"(uu[4 * (g4) + 3]), "v"(CAND)); \
                    cnt_ += __popcll(m0_) + __popcll(m1_) + __popcll(m2_) + __popcll(m3_); }
#define SEL_COUNT(CAND, OUT) do { int cnt_ = 0; SEL_GRP(0, CAND) SEL_GRP(1, CAND) SEL_GRP(2, CAND) SEL_GRP(3, CAND) SEL_GRP(4, CAND) SEL_GRP(5, CAND) SEL_GRP(6, CAND) SEL_GRP(7, CAND) OUT = cnt_; } while (0)
            unsigned T = 0u; int clo = t + 1;
#pragma unroll 1
            for (int bit = 31; bit >= 0; --bit) {
                const unsigned cand = T | (1u << bit); int c; SEL_COUNT(cand, c);
                if (c >= KTOP) { T = cand; clo = c; if (c == KTOP) break; }
            }
            if (clo == KTOP) {
#pragma unroll
                for (int jj = 0; jj < 32; ++jj) { const unsigned long long word = __ballot(uu[jj] >= T);
                    asm("s_nop 1\n\tv_writelane_b32 %0, %2, %4\n\tv_writelane_b32 %1, %3, %4" : "+v"(wlo), "+v"(whi) : "s"((unsigned)word), "s"((unsigned)(word >> 32)), "n"(jj));     }
            } else {
                int cgt; { const unsigned Tp = T + 1u; SEL_COUNT(Tp, cgt); }
                const int need = KTOP - cgt; int running = 0;
#pragma unroll
                for (int jj = 0; jj < 32; ++jj) {
                    const unsigned long long eq = __ballot(uu[jj] == T);
                    const int rank = (int)__builtin_amdgcn_mbcnt_hi((unsigned)(eq >> 32), __builtin_amdgcn_mbcnt_lo((unsigned)eq, 0u));
                    const unsigned long long word = __ballot(uu[jj] > T || (uu[jj] == T && running + rank < need));
                    asm("s_nop 1\n\tv_writelane_b32 %0, %2, %4\n\tv_writelane_b32 %1, %3, %4" : "+v"(wlo), "+v"(whi) : "s"((unsigned)word), "s"((unsigned)(word >> 32)), "n"(jj));
                    running += __popcll(eq);
                }
            }
            if (q2 == 0) { wloA = wlo; whiA = whi; } else { wloB = wlo; whiB = whi; }
            }
#undef SEL_COUNT
#undef SEL_GRP
        }
        if (lane < 32) { MSK[qlA * 32 + lane] = ((unsigned long long)whiA << 32) | wloA; MSK[qlA * 32 + 32 + lane] = ((unsigned long long)whiB << 32) | wloB; }
    }
    bf16x8 ss_a[4]; f32x4 ss_w[4];
    { const bf16* qrow = QI + (size_t)(MP + 4 * ss_b + (r32 >> 3)) * 512 + (r32 & 7) * 64 + 8 * hi;
#pragma unroll
      for (int s = 0; s < 4; ++s) ss_a[s] = *(const GAS bf16x8*)(qrow + 16 * s);
#pragma unroll
      for (int q = 0; q < 4; ++q) ss_w[q] = *(const GAS f32x4*)(WIp + (size_t)(MP + 4 * ss_b + q) * 8 + 4 * hi); }
    if (nj >= 16) p4_index_preload(F, b, nj, a, pwq);
    if (ss_on) { f32x16 acc = {};
#pragma unroll
        for (int s = 0; s < 4; ++s) { v4u p; p.x = pk2(ss_lo[s][0], ss_lo[s][1]); p.y = pk2(ss_lo[s][2], ss_lo[s][3]); p.z = pk2(ss_hh[s][0], ss_hh[s][1]); p.w = pk2(ss_hh[s][2], ss_hh[s][3]);
            acc = __builtin_amdgcn_mfma_f32_32x32x16_bf16(ss_a[s], __builtin_bit_cast(bf16x8, p), acc, 0, 0, 0); }
        float* SSC = WSP(float, WS_SSC);
#pragma unroll
        for (int q = 0; q < 4; ++q) {
            float sum = ss_w[q][0] * fmaxf(acc[4 * q], 0.f) + ss_w[q][1] * fmaxf(acc[4 * q + 1], 0.f) + ss_w[q][2] * fmaxf(acc[4 * q + 2], 0.f) + ss_w[q][3] * fmaxf(acc[4 * q + 3], 0.f);
            sum = xhalf_sum(sum) + 0.0f;
            if ((q >> 1) == hi) SSC[(size_t)(4 * ss_b + q) * SSTR + ss_pg * PAGE + ss_sub * 32 + r32] = sum;
        } }
    __syncthreads();
    { const int jt = tid >> 4, ql = tid & 15; MASK[((size_t)b * 32 + jt) * SEQ + t0 + ql] = MSK[ql * 32 + jt]; }
    __syncthreads();
}
__device__ __forceinline__ void p4_index(Frame& F) {
    if (F.vcu >= 256) return;
    const int b = F.vcu >> 4, w = F.vcu & 15;
    bf16x8 pa[4][4]; float pwq;
    p4_index_preload(F, b, 127 - w, pa, pwq);
#pragma unroll 1
    for (int k = 0; k < 4; ++k) { const int j1 = w + 16 * k; p4_index_unit(F, b, 127 - j1, 2 * k, pa, pwq, j1); p4_index_unit(F, b, j1, 2 * k + 1, pa, pwq, k < 3 ? 127 - (j1 + 16) : -1); }
}

__device__ __forceinline__ int block_sum8(LAS int* red, int par, int wid, int lane, int v) {
    if (lane == 0) red[par * 8 + wid] = v;
    __syncthreads();
    int s = 0;
#pragma unroll
    for (int w = 0; w < 8; ++w) s += red[par * 8 + w];
    return s;
}
__device__ __forceinline__ void p5_sample_unit(Frame& F, int sq) {
    const int tid = F.tid, lane = F.lane, wid = F.wave;
    const int b = sq >> 2, qi_ = sq & 3, row = MP + sq;
    LAS unsigned char* L0 = F.lds + RING_OFF;
    LAS int* red = (LAS int*)(L0);
    LAS float* newsc = (LAS float*)(L0 + 64);
    LAS int* wcnt = (LAS int*)(L0 + 128);
    LAS int* eqw = (LAS int*)(L0 + 256);
    LAS int* selidx = (LAS int*)(L0 + 2048);
    LAS float* LG = (LAS float*)(L0 + 4096);
    LAS float* OP = (LAS float*)(L0 + 16384);
    const bf16* QI = WSP(bf16, WS_QI); const bf16* KIB = WSP(bf16, WS_KIB); const float* WIp = WSP(float, WS_WI); const float* SSC = WSP(float, WS_SSC);
    const bf16* Qb = WSP(bf16, WS_Q); bf16* CAT = WSP(bf16, WS_CAT);
    if (tid < 64) {
        const int h = (tid >> 2) & 7, jn = tid & 3; float dot = 0.f;
        const bf16* qp = QI + (size_t)row * 512 + h * 64; const bf16* kp = KIB + (size_t)(MP + 4 * b + jn) * 64;
        for (int d = 0; d < 64; ++d) dot += bf2f(qp[d]) * bf2f(kp[d]);
        float v = WIp[(size_t)row * 8 + h] * fmaxf(dot, 0.f);
        v += __shfl_xor(v, 4); v += __shfl_xor(v, 8); v += __shfl_xor(v, 16);
        if (tid < 4) newsc[tid] = (jn <= qi_) ? (v + 0.0f) : -INFINITY;
    }
    __syncthreads();
    unsigned uu[33];
#pragma unroll
    for (int jj = 0; jj < 32; ++jj) uu[jj] = fkey(SSC[(size_t)sq * SSTR + tid + 512 * jj]);
    uu[32] = tid < 4 ? fkey(newsc[tid]) : 0x007FFFFFu;
    unsigned T = 0u; int par = 0;
#pragma unroll 1
    for (int bit = 31; bit >= 0; --bit) {
        const unsigned cand = T | (1u << bit); int c = 0;
#pragma unroll
        for (int jj = 0; jj < 33; ++jj) c += __popcll(__ballot(uu[jj] >= cand));
        c = block_sum8(red, par, wid, lane, c); par ^= 1;
        if (c >= KTOP) { T = cand; if (c == KTOP) break; }
    }
    int cgt = 0;
#pragma unroll
    for (int jj = 0; jj < 33; ++jj) cgt += __popcll(__ballot(uu[jj] > T));
    cgt = block_sum8(red, par, wid, lane, cgt); par ^= 1;
    const int need = KTOP - cgt;
#pragma unroll
    for (int jj = 0; jj < 33; ++jj) { const int n = __popcll(__ballot(uu[jj] == T)); if (lane == 0) eqw[jj * 8 + wid] = n; }
    __syncthreads();
#define SEL_MASK(jj, eqbase, M) do { int below_ = 0, tot_ = 0; \
        _Pragma("unroll") for (int w = 0; w < 8; ++w) { const int n_ = eqw[(jj) * 8 + w]; tot_ += n_; below_ += (w < wid) ? n_ : 0; } \
        const unsigned long long eq_ = __ballot(uu[jj] == T); \
        const int rank_ = (eqbase) + below_ + (int)__builtin_amdgcn_mbcnt_hi((unsigned)(eq_ >> 32), __builtin_amdgcn_mbcnt_lo((unsigned)eq_, 0u)); \
        M = __ballot(uu[jj] > T || (uu[jj] == T && rank_ < need)); (eqbase) += tot_; } while (0)
    { int cw = 0, eqbase = 0;
#pragma unroll
      for (int jj = 0; jj < 33; ++jj) { unsigned long long m; SEL_MASK(jj, eqbase, m); cw += __popcll(m); }
      if (lane == 0) wcnt[wid] = cw; }
    __syncthreads();
    { int base = 0, eqbase = 0;
#pragma unroll
      for (int w = 0; w < 8; ++w) base += (w < wid) ? wcnt[w] : 0;
#pragma unroll
      for (int jj = 0; jj < 33; ++jj) { unsigned long long m; SEL_MASK(jj, eqbase, m);
          const int pos = base + (int)__builtin_amdgcn_mbcnt_hi((unsigned)(m >> 32), __builtin_amdgcn_mbcnt_lo((unsigned)m, 0u));
          if ((m >> lane) & 1ull) { if (pos < KTOP) selidx[pos] = (jj < 32) ? tid + 512 * jj : PAST + tid; }
          base += __popcll(m); } }
#undef SEL_MASK
    __syncthreads();
    const int kk = lane >> 3, ds = lane & 7;
    const float* kptr[4]; const float* vptr[4];
#pragma unroll
    for (int it = 0; it < 4; ++it) {
        const int kidx = selidx[32 * wid + 8 * it + kk];
        if (kidx < PAST) { const size_t pr = (size_t)((const int*)F.in[6])[b * NPAGES + (kidx >> 7)] * PAGE + (kidx & 127); kptr[it] = ((const float*)F.in[2]) + pr * 128 + 8 * ds; vptr[it] = ((const float*)F.in[3]) + pr * 128 + 8 * ds; }
        else { const size_t nr = (size_t)(4 * b + (kidx - PAST)); kptr[it] = F.out + O_KS + nr * 128 + 8 * ds; vptr[it] = F.out + O_VS + nr * 128 + 8 * ds; }
    }
#pragma unroll 1
    for (int g = 0; g < 2; ++g) {
        float qv[4][8];
#pragma unroll
        for (int r = 0; r < 4; ++r) { const v4u qq = *(const GAS v4u*)(Qb + (size_t)row * 512 + (4 * g + r) * 64 + 8 * ds);
#pragma unroll
            for (int e = 0; e < 4; ++e) { qv[r][2 * e] = bf2f((unsigned short)(qq[e] & 0xffffu)); qv[r][2 * e + 1] = bf2f((unsigned short)(qq[e] >> 16)); } }
#pragma unroll
        for (int it = 0; it < 4; ++it) {
            const f32x4 k0 = *(const f32x4*)(kptr[it] + 64 * g), k1 = *(const f32x4*)(kptr[it] + 64 * g + 4);
#pragma unroll
            for (int r = 0; r < 4; ++r) {
                float d = (qv[r][0] * k0[0] + qv[r][1] * k0[1]) + (qv[r][2] * k0[2] + qv[r][3] * k0[3]) + (qv[r][4] * k1[0] + qv[r][5] * k1[1]) + (qv[r][6] * k1[2] + qv[r][7] * k1[3]);
                d += __shfl_xor(d, 1); d += __shfl_xor(d, 2); d += __shfl_xor(d, 4);
                if (ds == 0) LG[(4 * g + r) * 256 + 32 * wid + 8 * it + kk] = d;
            }
        }
    }
    __syncthreads();
    { float l[4];
#pragma unroll
      for (int e = 0; e < 4; ++e) l[e] = LG[wid * 256 + lane + 64 * e];
      const float m = wave_max(fmaxf(fmaxf(l[0], l[1]), fmaxf(l[2], l[3])));
      float p[4], s = 0.f;
#pragma unroll
      for (int e = 0; e < 4; ++e) { p[e] = __builtin_amdgcn_exp2f(l[e] - m); s += p[e]; }
      s = wave_sum(s); const float inv = 1.0f / s;
#pragma unroll
      for (int e = 0; e < 4; ++e) LG[wid * 256 + lane + 64 * e] = p[e] * inv; }
    __syncthreads();
#pragma unroll 1
    for (int g = 0; g < 2; ++g) {
        float acc[4][8];
#pragma unroll
        for (int r = 0; r < 4; ++r)
#pragma unroll
            for (int e = 0; e < 8; ++e) acc[r][e] = 0.f;
#pragma unroll
        for (int it = 0; it < 4; ++it) {
            const f32x4 v0 = *(const f32x4*)(vptr[it] + 64 * g), v1 = *(const f32x4*)(vptr[it] + 64 * g + 4);
#pragma unroll
            for (int r = 0; r < 4; ++r) { const float p = LG[(4 * g + r) * 256 + 32 * wid + 8 * it + kk];
#pragma unroll
                for (int e = 0; e < 4; ++e) { acc[r][e] += p * v0[e]; acc[r][4 + e] += p * v1[e]; } }
        }
#pragma unroll
        for (int r = 0; r < 4; ++r)
#pragma unroll
            for (int e = 0; e < 8; ++e) { float a = acc[r][e]; a += __shfl_xor(a, 8); a += __shfl_xor(a, 16); a += __shfl_xor(a, 32); if (kk == 0) OP[(wid * 8 + 4 * g + r) * 64 + 8 * ds + e] = a; }
    }
    __syncthreads();
    { const int hd = tid >> 6, d = tid & 63; float o = 0.f;
#pragma unroll
      for (int w = 0; w < 8; ++w) o += OP[(w * 8 + hd) * 64 + d];
      CAT[(size_t)row * D + 512 + hd * 64 + d] = (bf16)f2bf(o); }
    __syncthreads();
}

constexpr int N_PHASES = 9;
struct Args { const void* in[22]; float* out; unsigned char* ws; int ph_lo, ph_hi, use_bar, pad; };
__global__ void __launch_bounds__(512, 2) hymba_fwd(Args args) {
    extern __shared__ __attribute__((aligned(16))) unsigned char lds[];
    Frame F;
    F.lds = (LAS unsigned char*)lds;
    F.MISC = (volatile LAS unsigned*)(F.lds + MISC_OFF);
    F.tid = threadIdx.x; F.lane = F.tid & 63; F.wave = __builtin_amdgcn_readfirstlane(F.tid >> 6);
    F.G = gridDim.x; { const int bx = blockIdx.x; F.vcu = (F.G % 8 == 0) ? (bx % 8) * (F.G / 8) + bx / 8 : bx; }
    F.ws = args.ws; F.out = args.out; F.ctl = (gu32*)(args.ws + WS_CTL);
    F.in = args.in;
    for (int u = F.tid; u < (LDS_BYTES - LDSCTL_OFF) / 4; u += 512) ((LAS unsigned*)(F.lds + LDSCTL_OFF))[u] = 0u;
    __syncthreads();
    XcdBarrier bar; bar.bar = (unsigned*)(F.ctl + CW_BAR); bar.x = 0; bar.st = nullptr;
    if (args.use_bar) bar = xcd_barrier_post((unsigned*)(F.ctl + CW_BAR), F.MISC + 8);
    const int lo = args.ph_lo, hi = args.ph_hi;
#define IN(k) (lo <= (k) && (k) < hi)
#define SEAM(k) do { if (IN(k) && IN((k) + 1)) { xcd_barrier(bar); if (PROBE_DUP == 60) xcd_barrier(bar); } } while (0)
    const int cblk = (int)blockIdx.x;

#ifndef PROBE_DUP
#define PROBE_DUP (-1)
#endif
#define RUNPHASE(k, ...) do { if (IN(k)) { { int t_ = F.tid; asm volatile("" : "+v"(t_)); F.tid = t_; F.lane = t_ & 63; }     \
        __VA_ARGS__; if (PROBE_DUP == (k)) { if (args.use_bar) xcd_barrier(bar); __VA_ARGS__; } } SEAM(k); } while (0)
#define RSTAB ((LAS float*)(F.lds + RING_OFF + 131072))
#define GEMM_PHASE(EPI, A_, B_, N_, K_, SS_, NSLOT_, ...) do { pg8::Gemm g{A_, B_, MP, N_, K_}; pg8::StaticOrder S; S.init(MP, N_, F.G, cblk); \
        if ((NSLOT_) > 0) fill_rstd_table(RSTAB, S, SS_, NSLOT_); \
        EPI E{__VA_ARGS__}; \
        pg8::gemm_phase<EPI, pg8::StaticOrder, true, true>(F.lds + RING_OFF, g, S, E); \
        { int nrep_ = (PROBE_DUP == 50) ? 2 : 1; asm volatile("" : "+s"(nrep_)); for (int rep_ = 0; rep_ < nrep_; ++rep_) skinny_phase<EPI, 2, 0>(F.lds + RING_OFF, A_, B_, N_, (K_) * 2, cblk, F.G, E); } } while (0)
#define GEMM_PHASE8(EPI, A8_, B8_, OSC_, N_, K_, SS_, NSLOT_, ...) do { pg8::Gemm g{(const bf16*)(A8_), (const bf16*)(B8_), MP, N_, (K_) / 2}; pg8::StaticOrder S; S.init(MP, N_, F.G, cblk); \
        if ((NSLOT_) > 0) fill_rstd_table(RSTAB, S, SS_, NSLOT_); \
        EPI E{__VA_ARGS__}; \
        pg8::gemm_phase<EPI, pg8::StaticOrder, true, true, 1>(F.lds + RING_OFF, g, S, E); \
        { int nrep_ = (PROBE_DUP == 55) ? 2 : 1; asm volatile("" : "+s"(nrep_)); for (int rep_ = 0; rep_ < nrep_; ++rep_) skinny_phase<EPI, 2, 1>(F.lds + RING_OFF, A8_, B8_, N_, K_, cblk, F.G, E, nullptr, nullptr, OSC_); } } while (0)
#define GEMM_PHASEI(EPI, A8_, B8_, XS_, WSN_, N_, K_, SS_, NSLOT_, ...) do { pg8::Gemm g{(const bf16*)(A8_), (const bf16*)(B8_), MP, N_, (K_) / 2}; pg8::StaticOrder S; S.init(MP, N_, F.G, cblk); \
        fill_rstd_table(RSTAB, S, SS_, NSLOT_, XS_); \
        EPI E{__VA_ARGS__}; \
        pg8::gemm_phase<EPI, pg8::StaticOrder, true, true, 2>(F.lds + RING_OFF, g, S, E); \
        { int nrep_ = (PROBE_DUP == 55) ? 2 : 1; asm volatile("" : "+s"(nrep_)); for (int rep_ = 0; rep_ < nrep_; ++rep_) skinny_phase<EPI, 4, 2>(F.lds + RING_OFF, A8_, B8_, N_, K_, cblk, F.G, E, XS_, WSN_); } } while (0)
    RUNPHASE(0, do { p0_prologue(F); xcd_barrier(bar); p0b_quant_weights(F); } while (0));
    RUNPHASE(1, GEMM_PHASEI(EpiGU, WSP(unsigned char, WS_XI8), WSP(unsigned char, WS_WGU1I8), WSP(float, WS_XS), WSP(float, WS_WSN), 2 * DFF, D, WSP(float, WS_SS0), 1, WSP(bf16, WS_H), WSP(float, WS_SS0), 1, RSTAB, 1.0f, WSP(unsigned char, WS_H8), WSP(float, WS_WSN)));
    RUNPHASE(2, GEMM_PHASE8(EpiRes<0>, WSP(unsigned char, WS_H8), WSP(unsigned char, WS_WD1_8), 1.0f / (W8SCALE * H8SCALE), D, DFF, nullptr, 0, WSP(bf16, WS_XB), nullptr, WSP(bf16, WS_X1B), WSP(float, WS_SS1), nullptr, 1.0f / (W8SCALE * H8SCALE), (const float*)F.in[0], (const float*)F.in[1]));
#if PROBE_DUP >= 21 && PROBE_DUP <= 23
    if (IN(2)) { xcd_barrier(bar); pg8::Gemm g{(const bf16*)WSP(unsigned char, WS_H8), (const bf16*)WSP(unsigned char, WS_WD1_8), MP, D, DFF / 2}; pg8::StaticOrder S; S.init(MP, D, F.G, cblk);
        EpiRes<0> E{WSP(bf16, WS_XB), nullptr, WSP(bf16, WS_X2B), WSP(float, WS_SS2), nullptr, 1.0f / (W8SCALE * H8SCALE), (const float*)F.in[0], (const float*)F.in[1]};
        pg8::gemm_phase<EpiRes<0>, pg8::StaticOrder, true, true, (PROBE_DUP == 21 ? 1 : PROBE_DUP == 22 ? 2 : 0)>(F.lds + RING_OFF, g, S, E); xcd_barrier(bar); }
#endif
    RUNPHASE(3, GEMM_PHASE(EpiWin, WSP(bf16, WS_X1B), WSP(bf16, WS_WIN), NINP, D, WSP(float, WS_SS1), 16, F.ws, F.out, (const float*)F.in[15], (const float*)F.in[16], RSTAB));
    RUNPHASE(4, do { p4_conv(F); if (PROBE_DUP == 40) p4_conv(F); p4_index(F); if (PROBE_DUP == 42) p4_index(F); } while (0));
    RUNPHASE(5, do { if ((F.vcu & 1) == 0 && F.vcu < 256) { p5_sample_unit(F, F.vcu >> 1); if (PROBE_DUP == 51) p5_sample_unit(F, F.vcu >> 1); }
        const attn_body::AttnTensors AT{(const attn_body::bf16*)WSP(bf16, WS_Q), (const attn_body::bf16*)WSP(bf16, WS_KB), (const attn_body::bf16*)WSP(bf16, WS_VB), WSP(unsigned long long, WS_MASK), (attn_body::bf16*)WSP(bf16, WS_CAT)};
        const attn_body::StaticOrder S(F.vcu); attn_body::attn_phase<attn_body::StaticOrder>((char*)lds + RING_OFF, AT, S); } while (0));
    RUNPHASE(6, do { GEMM_PHASE(EpiRes<1>, WSP(bf16, WS_CAT), WSP(bf16, WS_WOUT), D, D, nullptr, 0, WSP(bf16, WS_X1B), nullptr, WSP(bf16, WS_X2B), WSP(float, WS_SS2), nullptr, 1.0f);
                     xcd_barrier(bar); quant_rows_pass(F.vcu * 8 + F.wave, F.G * 8, WSP(bf16, WS_X2B), WSP(unsigned char, WS_X2I8), WSP(float, WS_XS2), MTOT); } while (0));
    RUNPHASE(7, GEMM_PHASEI(EpiGU, WSP(unsigned char, WS_X2I8), WSP(unsigned char, WS_WGU2I8), WSP(float, WS_XS2), WSP(float, WS_WSN2), 2 * DFF, D, WSP(float, WS_SS2), 16, WSP(bf16, WS_H), WSP(float, WS_SS2), 16, RSTAB, 1.0f, WSP(unsigned char, WS_H8), WSP(float, WS_WSN2)));
    RUNPHASE(8, GEMM_PHASE8(EpiRes<2>, WSP(unsigned char, WS_H8), WSP(unsigned char, WS_WD2_8), 1.0f / (W8SCALE * H8SCALE), D, DFF, nullptr, 0, WSP(bf16, WS_X2B), F.out, nullptr, nullptr, nullptr, 1.0f / (W8SCALE * H8SCALE)));
#undef RUNPHASE
#undef GEMM_PHASE
#undef GEMM_PHASE8
#undef GEMM_PHASEI
#undef RSTAB
#undef IN
#undef SEAM
}

#ifndef MK_N_LAUNCHES
#define MK_N_LAUNCHES 1
#endif
extern "C" void kernel_launch(void* const* d_in, const int* in_sizes, int n_in, void* d_out, int out_size, void* d_ws, size_t ws_size, hipStream_t stream) {
    static int grid = 0;
    if (grid == 0) {
        if (n_in != 22 || out_size != (int)O_END || ws_size < WS_END) { fprintf(stderr, "kernel_launch: unexpected problem: n_in %d out %d ws %zu (need %zu)\n", n_in, out_size, ws_size, (size_t)WS_END); grid = -1; return; }
        int dev = 0, cus = 0, per_cu = 0;
        if (hipGetDevice(&dev) != hipSuccess || hipDeviceGetAttribute(&cus, hipDeviceAttributeMultiprocessorCount, dev) != hipSuccess) { grid = -1; return; }
        if (hipFuncSetAttribute((const void*)hymba_fwd, hipFuncAttributeMaxDynamicSharedMemorySize, LDS_BYTES) != hipSuccess) { fprintf(stderr, "kernel_launch: hipFuncSetAttribute failed\n"); grid = -1; return; }
        if (hipOccupancyMaxActiveBlocksPerMultiprocessor(&per_cu, (const void*)hymba_fwd, 512, LDS_BYTES) != hipSuccess || per_cu < 1) { fprintf(stderr, "kernel_launch: occupancy query says %d blocks per CU\n", per_cu); (void)hipGetLastError(); grid = -1; return; }
        grid = cus;
        if (grid % 8 != 0 || grid < 8) { fprintf(stderr, "kernel_launch: unexpected CU count %d\n", cus); grid = -1; return; }
    }
    if (grid < 0) return;
    (void)hipMemsetAsync((char*)d_ws + WS_CTL, 0, CTL_ZERO_BYTES, stream);
    Args a{};
    for (int i = 0; i < 22; ++i) a.in[i] = d_in[i];
    a.out = (float*)d_out; a.ws = (unsigned char*)d_ws;
    if (MK_N_LAUNCHES == 1) { a.ph_lo = 0; a.ph_hi = N_PHASES; a.use_bar = 1; hipLaunchKernelGGL(hymba_fwd, dim3(grid), dim3(512), LDS_BYTES, stream, a); }
    else for (int p = 0; p < N_PHASES; ++p) { a.ph_lo = p; a.ph_hi = p + 1; a.use_bar = 0; hipLaunchKernelGGL(hymba_fwd, dim3(grid), dim3(512), LDS_BYTES, stream, a); }
}
```

```cpp
#include <hip/hip_runtime.h>
#include <cstdio>
#include <cstdint>
#include <type_traits>
namespace pg8 {
#define PG8_LAS __attribute__((address_space(3)))
typedef unsigned short bf16_t;
typedef short bf16x8 __attribute__((ext_vector_type(8)));
typedef float f32x4 __attribute__((ext_vector_type(4)));
typedef unsigned u32x4 __attribute__((ext_vector_type(4)));
constexpr int BM = 256, BK = 64, HALF = 128, HTB = HALF * BK * 2  , STAGE_BYTES = 8 * HTB, NXCD = 8, WGM = 8;

__host__ __device__ __forceinline__ int lds_byte(int r, int c) { const int st = (r >> 4) * 2 + (c >> 5), rr = r & 15, cc = c & 31, ob = rr * 64 + cc * 2; return st * 1024 + (ob ^ (((ob >> 9) & 1) << 5)); }
__host__ __device__ __forceinline__ void stage_rc(int b, int& R, int& C) { const int st = b / 1024, sb = b % 1024, swz = sb ^ (((sb >> 9) & 1) << 5); R = (st >> 1) * 16 + swz / 64; C = (st & 1) * 32 + (swz % 64) / 2; }
__host__ __device__ __forceinline__ int perm32(int rho) { const int n = rho >> 4, i = rho & 15; return 8 * (i >> 2) + 4 * n + (i & 3); }

struct Unit { int pm, pn; };
struct Gemm { const bf16_t* A; const bf16_t* Bt; int M, N, K; };

struct StaticOrder {
    int nM, nN, nwg, G, c;
    __host__ __device__ void init(int M, int N, int G_, int c_) { nM = M / BM; nN = N / BM; nwg = nM * nN; G = G_; c = c_; }
    __host__ __device__ bool next(int i, Unit& u) const {
        const long L = (long)i * G + c; if (L >= nwg) return false;
        int wgid = (int)L; { const int q = nwg / NXCD, r = nwg % NXCD, xcd = wgid % NXCD, off = wgid / NXCD; wgid = (xcd < r ? xcd * (q + 1) : r * (q + 1) + (xcd - r) * q) + off; }
        const int nig = WGM * nN, gid = wgid / nig, fm = gid * WGM, gsz = (nM - fm) < WGM ? (nM - fm) : WGM;
        u.pm = fm + ((wgid % nig) % gsz); u.pn = (wgid % nig) / gsz; return true;
    }
    __device__ __forceinline__ void a_ready(const Unit&) const {}
    __device__ __forceinline__ void done(const Unit&) const {}
};
__device__ __forceinline__ unsigned cvt_pk_bf16(float lo, float hi) { unsigned r; asm volatile("v_cvt_pk_bf16_f32 %0, %1, %2" : "=v"(r) : "v"(lo), "v"(hi)); return r; }
template <class Epi, class Sched, bool ALIGN_EPI = false, bool SP2 = false, int QM = 0, int PFD = 0>
__device__ __forceinline__ void gemm_phase(PG8_LAS unsigned char* lds, const Gemm g, const Sched& S, const Epi& E) {
    const int tid = threadIdx.x, wid = __builtin_amdgcn_readfirstlane(tid >> 6), lane = tid & 63, wr = wid >> 2, wc = wid & 3, fr = lane & 15, fq = lane >> 4;
    const int K = g.K, nt = K / BK;
    unsigned voffA[2], voffB[2];
#pragma unroll
    for (int i = 0; i < 2; ++i) { int R, C; stage_rc(tid * 16 + i * 8192, R, C); const int Rb = Epi::PERM ? ((R & ~31) + perm32(R & 31)) : R;
        voffA[i] = (unsigned)(R * K + C) * 2u; voffB[i] = (unsigned)(Rb * K + C) * 2u; }
    unsigned voffP[2];
#pragma unroll
    for (int i = 0; i < 2; ++i) voffP[i] = (unsigned)((32 * wid + 16 * i + (lane >> 2)) * K) * 2u + (unsigned)(lane & 3) * 4u;
#define PG8_PF(s2, kt) do { if constexpr (PFD != 0) { const char* p_ = ((kt) < nt) ? cA + (size_t)(kt) * kstep : nA + (size_t)((kt) - nt) * kstep; \
        __builtin_amdgcn_global_load_lds((const unsigned*)(p_ + voffP[s2]), (PG8_LAS unsigned*)(lds + 143360 + wid * 256), 4, 0, 0); } } while (0)
#define PG8_WAIT_V8() do { if constexpr (PFD != 0) PG8_WAIT_V(10); else PG8_WAIT_V(8); } while (0)
    const size_t kstep = (size_t)(BK * 2);
    const size_t hstep = (size_t)HALF * K * 2;
    const size_t tstep = 2 * hstep;
    const unsigned ldsw = (unsigned)wid * 1024u;
    const int aoff = lds_byte(wr * 64 + fr, fq * 8), boff = lds_byte(wc * 32 + fr, fq * 8);
#define PG8_SA(b, h) (((b) * 2 + (h)) * HTB)
#define PG8_SB(b, h) ((4 + (b) * 2 + (h)) * HTB)
#define PG8_STAGE(bufoff, gbase, voff) do { _Pragma("unroll") for (int _i = 0; _i < 2; ++_i) \
        __builtin_amdgcn_global_load_lds((const unsigned*)((const char*)(gbase) + (voff)[_i]), (PG8_LAS unsigned*)(lds + (bufoff) + ldsw + _i * 8192), 16, 0, 0); } while (0)
#define PG8_LDF(dst_, addr_) do { if constexpr (QM == 1) { const pg8_v4i lo_ = *(const PG8_LAS pg8_v4i*)(addr_), hi_ = *(const PG8_LAS pg8_v4i*)((addr_) + 1024); \
            (dst_).v = __builtin_shufflevector(lo_, hi_, 0, 1, 2, 3, 4, 5, 6, 7); } \
        else { (dst_).k[0] = *(const PG8_LAS bf16x8*)(addr_); (dst_).k[1] = *(const PG8_LAS bf16x8*)((addr_) + 1024); } } while (0)
#define PG8_LDA(dst, b, h) do { _Pragma("unroll") for (int m = 0; m < 4; ++m) PG8_LDF(dst[m], lds + PG8_SA(b, h) + aoff + m * 2048); } while (0)
#define PG8_LDB(dst, b, h) do { _Pragma("unroll") for (int n = 0; n < 2; ++n) PG8_LDF(dst[n], lds + PG8_SB(b, h) + boff + n * 2048); } while (0)
#define PG8_MMA(ai, bj, At, Bt) do { __builtin_amdgcn_s_setprio(1); if constexpr (QM != 0) asm volatile("s_nop 4");     \
        _Pragma("unroll") for (int m = 0; m < 4; ++m) _Pragma("unroll") for (int n = 0; n < 2; ++n) { \
            if constexpr (QM == 1) asm volatile("v_mfma_scale_f32_16x16x128_f8f6f4 %0, %1, %2, %0, %3, %3 op_sel_hi:[0,0,0]" : "+v"(acc[ai][bj][m][n]) : "v"(Bt[n].v), "v"(At[m].v), "v"(scl8_));     \
            else if constexpr (QM == 2) { _Pragma("unroll") for (int k = 0; k < 2; ++k) asm volatile("v_mfma_i32_16x16x64_i8 %0, %1, %2, %0" : "+v"(acc[ai][bj][m][n]) : "v"(Bt[n].k[k]), "v"(At[m].k[k])); } \
            else { _Pragma("unroll") for (int k = 0; k < 2; ++k) acc[ai][bj][m][n] = __builtin_amdgcn_mfma_f32_16x16x32_bf16(Bt[n].k[k], At[m].k[k], acc[ai][bj][m][n], 0, 0, 0); } } \
        __builtin_amdgcn_s_setprio(0); } while (0)
#define PG8_WAIT_V(n) asm volatile("s_waitcnt vmcnt(" #n ")" ::: "memory")
#define PG8_WAIT_L(n) asm volatile("s_waitcnt lgkmcnt(" #n ")" ::: "memory")
#define PG8_BAR __builtin_amdgcn_s_barrier()
#define PG8_SCHED __builtin_amdgcn_sched_barrier(0)
    Unit cur, nxt; int ui = 0;
    if (!S.next(0, cur)) return;
    f32x4 acc[2][2][4][2];
    E.init(acc, cur, wr, wc, fr, fq);
    typedef int pg8_v8i __attribute__((ext_vector_type(8))); typedef int pg8_v4i __attribute__((ext_vector_type(4)));
    struct FragB { bf16x8 k[2]; }; struct Frag8 { pg8_v8i v; };
    typedef typename std::conditional<QM == 1, Frag8, FragB>::type Frag;
    Frag At[4], B0[2], B1[2];
    unsigned scl8_ = 0x7F7F7F7Fu; asm volatile("" : "+v"(scl8_));
    const char* cA = (const char*)g.A + (size_t)cur.pm * tstep; const char* cB = (const char*)g.Bt + (size_t)cur.pn * tstep;
    S.a_ready(cur);
    if constexpr (SP2) {
        PG8_STAGE(PG8_SB(0, 0), cB, voffB); PG8_STAGE(PG8_SB(0, 1), cB + hstep, voffB); PG8_STAGE(PG8_SA(0, 0), cA, voffA); PG8_STAGE(PG8_SA(0, 1), cA + hstep, voffA);
        if (wr == 1) PG8_BAR;
        PG8_WAIT_V(2); PG8_BAR;
        PG8_STAGE(PG8_SB(1, 0), cB + kstep, voffB); PG8_STAGE(PG8_SA(1, 0), cA + kstep, voffA); PG8_STAGE(PG8_SB(1, 1), cB + hstep + kstep, voffB);
        PG8_WAIT_V(6); PG8_BAR;
    } else {
        PG8_STAGE(PG8_SB(0, 0), cB, voffB); PG8_STAGE(PG8_SA(0, 0), cA, voffA); PG8_STAGE(PG8_SB(0, 1), cB + hstep, voffB); PG8_STAGE(PG8_SA(0, 1), cA + hstep, voffA);
        if (wr == 1) PG8_BAR;
        PG8_WAIT_V(4); PG8_BAR;
        PG8_STAGE(PG8_SB(1, 0), cB + kstep, voffB); PG8_STAGE(PG8_SA(1, 0), cA + kstep, voffA); PG8_STAGE(PG8_SB(1, 1), cB + hstep + kstep, voffB);
        PG8_WAIT_V(6); PG8_BAR;
    }
    for (;;) {
        const bool has_next = S.next(ui + 1, nxt);
        const char* nA = has_next ? (const char*)g.A + (size_t)nxt.pm * tstep : cA; const char* nB = has_next ? (const char*)g.Bt + (size_t)nxt.pn * tstep : cB;
#pragma unroll 1
        for (int t = 0; t < nt; t += 2) {
            const bool last = (t == nt - 2);
            const char* a1 = cA + (size_t)(t + 1) * kstep;
            const char* a2 = last ? nA : cA + (size_t)(t + 2) * kstep; const char* b2 = last ? nB : cB + (size_t)(t + 2) * kstep;
            const char* a3 = a2 + kstep; const char* b3 = b2 + kstep;
            if (last && has_next) S.a_ready(nxt);
            if constexpr (SP2) {
            PG8_LDB(B0, 0, 0); PG8_LDB(B1, 0, 1); PG8_SCHED; PG8_LDA(At, 0, 0); PG8_STAGE(PG8_SA(1, 1), a1 + hstep, voffA); PG8_PF(0, t + PFD);
            PG8_WAIT_V8(); PG8_WAIT_L(0); PG8_BAR; PG8_MMA(0, 0, At, B0); PG8_MMA(0, 1, At, B1); PG8_BAR; PG8_SCHED;
            PG8_LDA(At, 0, 1); PG8_STAGE(PG8_SB(0, 0), b2, voffB); PG8_STAGE(PG8_SB(0, 1), b2 + hstep, voffB); PG8_STAGE(PG8_SA(0, 0), a2, voffA); PG8_PF(1, t + PFD);
            PG8_WAIT_V8(); PG8_WAIT_L(0); PG8_BAR; PG8_MMA(1, 0, At, B0); PG8_MMA(1, 1, At, B1); PG8_BAR; PG8_SCHED;
            PG8_LDB(B0, 1, 0); PG8_LDB(B1, 1, 1); PG8_SCHED; PG8_LDA(At, 1, 0); PG8_STAGE(PG8_SA(0, 1), a2 + hstep, voffA); PG8_PF(0, t + 1 + PFD);
            PG8_WAIT_V8(); PG8_WAIT_L(0); PG8_BAR; PG8_MMA(0, 0, At, B0); PG8_MMA(0, 1, At, B1); PG8_BAR; PG8_SCHED;
            PG8_LDA(At, 1, 1); PG8_STAGE(PG8_SB(1, 0), b3, voffB); PG8_STAGE(PG8_SB(1, 1), b3 + hstep, voffB); PG8_STAGE(PG8_SA(1, 0), a3, voffA); PG8_PF(1, t + 1 + PFD);
            PG8_WAIT_V8(); PG8_WAIT_L(0); PG8_BAR; PG8_MMA(1, 0, At, B0); PG8_MMA(1, 1, At, B1); PG8_BAR; PG8_SCHED;
            } else {
            PG8_LDB(B0, 0, 0); PG8_SCHED; PG8_LDA(At, 0, 0); PG8_STAGE(PG8_SA(1, 1), a1 + hstep, voffA);
            PG8_WAIT_L(8); PG8_BAR; PG8_WAIT_L(0); PG8_MMA(0, 0, At, B0); PG8_BAR; PG8_SCHED;
            PG8_LDB(B1, 0, 1); PG8_STAGE(PG8_SB(0, 0), b2, voffB);
            PG8_BAR; PG8_WAIT_L(0); PG8_MMA(0, 1, At, B1); PG8_BAR;
            PG8_LDA(At, 0, 1); PG8_STAGE(PG8_SA(0, 0), a2, voffA);
            PG8_BAR; PG8_WAIT_L(0); PG8_MMA(1, 0, At, B0); PG8_BAR; PG8_SCHED;
            PG8_STAGE(PG8_SB(0, 1), b2 + hstep, voffB);
            PG8_WAIT_V(6); PG8_BAR; PG8_MMA(1, 1, At, B1); PG8_BAR;
            PG8_LDB(B0, 1, 0); PG8_SCHED; PG8_LDA(At, 1, 0); PG8_STAGE(PG8_SA(0, 1), a2 + hstep, voffA);
            PG8_WAIT_L(8); PG8_BAR; PG8_WAIT_L(0); PG8_MMA(0, 0, At, B0); PG8_BAR; PG8_SCHED;
            PG8_LDB(B1, 1, 1); PG8_STAGE(PG8_SB(1, 0), b3, voffB);
            PG8_BAR; PG8_WAIT_L(0); PG8_MMA(0, 1, At, B1); PG8_BAR;
            PG8_LDA(At, 1, 1); PG8_STAGE(PG8_SA(1, 0), a3, voffA);
            PG8_BAR; PG8_WAIT_L(0); PG8_MMA(1, 0, At, B0); PG8_BAR; PG8_SCHED;
            PG8_STAGE(PG8_SB(1, 1), b3 + hstep, voffB);
            PG8_WAIT_V(6); PG8_BAR; PG8_MMA(1, 1, At, B1); PG8_BAR;
            }
        }
        if constexpr (ALIGN_EPI) { if (wr == 0) PG8_BAR; }
        if constexpr (QM != 0) asm volatile("s_nop 15\n\ts_nop 7" ::: "memory");
        if constexpr (!Epi::AFTER_DRAIN) { E(acc, cur, wr, wc, fr, fq, ui, has_next, nxt);
#if defined(PROBE_DUP) && PROBE_DUP == 61
            E(acc, cur, wr, wc, fr, fq, ui, has_next, nxt);
#endif
            S.done(cur); }
        if (!has_next) break;
        cur = nxt; cA = nA; cB = nB; ++ui;
        if constexpr (ALIGN_EPI) { if (wr == 1) PG8_BAR; }
    }
    PG8_WAIT_V(0);
    if constexpr (!ALIGN_EPI) { if (wr == 0) PG8_BAR; }
    PG8_BAR;
    if constexpr (Epi::AFTER_DRAIN) { E.fused(acc, cur, wr, wc, fr, fq, lds, wid, lane); S.done(cur); }
#undef PG8_SA
#undef PG8_PF
#undef PG8_WAIT_V8
#undef PG8_SB
#undef PG8_STAGE
#undef PG8_LDA
#undef PG8_LDF
#undef PG8_LDB
#undef PG8_MMA
#undef PG8_WAIT_V
#undef PG8_WAIT_L
#undef PG8_BAR
#undef PG8_SCHED
}
}
#include <hip/hip_bf16.h>
#include <cmath>
namespace attn_body {
using bf16=__hip_bfloat16;
using bf16x8=__attribute__((ext_vector_type(8)))short;
using s16x4=__attribute__((ext_vector_type(4)))short;
using f32x16=__attribute__((ext_vector_type(16)))float;
using u32x4=__attribute__((ext_vector_type(4)))unsigned;
constexpr int BATCH=16,NHEAD=8,SEQ=2048,D=64;
constexpr int QP=512,KP=128,OP=1024,OOFF=512;
constexpr int NW=8,QBLK=32,QB=QBLK*NW,KVBLK=64,NQB=SEQ/QB;
constexpr int ATTN_UNIT_ROWS=QB;
__device__ __forceinline__ int crow(int r,int hi){return (r&3)+8*(r>>2)+4*hi;}
#define SBAR() __builtin_amdgcn_sched_barrier(0)
#define MSKV(v,W,r) __uint_as_float(__float_as_uint(v)&(unsigned)(((int)((W)<<(31-(((r)&3)+8*((r)>>2)))))>>31))
__device__ __forceinline__ void cmask(f32x16&p0,f32x16&p1,int jb,int qrel,int hi){
  const float NEG=-INFINITY; int kb=64*jb+4*hi;
  #pragma unroll
  for(int r=0;r<16;++r){int kv=kb+(r&3)+8*(r>>2); if(kv>qrel)p0[r]=NEG; if(kv+32>qrel)p1[r]=NEG;}
}

constexpr int NSLOT=3, SLOTB=8192;
constexpr int LDS_K=0, LDS_V=NSLOT*SLOTB, LDS_WS=2*NSLOT*SLOTB, LDS_OST=LDS_WS+NW*64*4, LDS_MSK=LDS_OST+NW*4096, LDS_BYTES=LDS_MSK+NW*8192;
constexpr float C2=0.125f*1.4426950408889634f;
__device__ __forceinline__ void glds16(const void*gsrc,unsigned lds_dst){unsigned keep;
  asm volatile("s_mov_b32 %0, m0\n\ts_mov_b32 m0, %2\n\ts_nop 0\n\tglobal_load_lds_dwordx4 %1, off\n\ts_mov_b32 m0, %0":"=&s"(keep):"v"(gsrc),"s"(lds_dst):"memory");}
__device__ __forceinline__ float max3f(float a,float b,float c){float r;asm("v_max3_f32 %0, %1, %2, %3":"=v"(r):"v"(a),"v"(b),"v"(c));return r;}
__device__ __forceinline__ float max2f(float a,float b){float r;asm("v_max_f32_e32 %0, %1, %2":"=v"(r):"v"(a),"v"(b));return r;}
__device__ __forceinline__ float fadd_s(float a,float b){float r;asm("v_add_f32_e32 %0, %1, %2":"=v"(r):"v"(a),"v"(b));return r;}
__device__ __forceinline__ float fsub_s(float a,float b){float r;asm("v_sub_f32_e32 %0, %1, %2":"=v"(r):"v"(a),"v"(b));return r;}
typedef float f32x2_t __attribute__((ext_vector_type(2))); typedef __bf16 bf16x2_t __attribute__((ext_vector_type(2)));
__device__ __forceinline__ unsigned cvtpk_s(float lo,float hi){f32x2_t v={lo,hi};bf16x2_t b=__builtin_convertvector(v,bf16x2_t);return __builtin_bit_cast(unsigned,b);}
#define WAIT_BAR(N) asm volatile("s_waitcnt vmcnt(" #N ") lgkmcnt(0)\n\ts_barrier":::"memory")

__device__ __forceinline__ void qkt(f32x16&p0,f32x16&p1,const char*Kslot,const bf16x8*qr,const f32x16&negm,int r32,int hi){
  const char*kb=Kslot+hi*1024+r32*16;
  #pragma unroll
  for(int d0=0;d0<4;++d0){
    const bf16x8 b0=*reinterpret_cast<const bf16x8*>(kb+d0*2048);
    const bf16x8 b1=*reinterpret_cast<const bf16x8*>(kb+d0*2048+512);
    if(d0==0){p0=__builtin_amdgcn_mfma_f32_32x32x16_bf16(b0,qr[0],negm,0,0,0);p1=__builtin_amdgcn_mfma_f32_32x32x16_bf16(b1,qr[0],negm,0,0,0);}
    else{p0=__builtin_amdgcn_mfma_f32_32x32x16_bf16(b0,qr[d0],p0,0,0,0);p1=__builtin_amdgcn_mfma_f32_32x32x16_bf16(b1,qr[d0],p1,0,0,0);}}
}
typedef __attribute__((address_space(3))) const char* lds_cptr;
typedef short v4i16_t __attribute__((ext_vector_type(4)));
__device__ __forceinline__ void kload8(bf16x8*kf,lds_cptr kp){
  kf[0]=*(const __attribute__((address_space(3))) bf16x8*)(kp);      kf[1]=*(const __attribute__((address_space(3))) bf16x8*)(kp+512);
  kf[2]=*(const __attribute__((address_space(3))) bf16x8*)(kp+2048); kf[3]=*(const __attribute__((address_space(3))) bf16x8*)(kp+2560);
  kf[4]=*(const __attribute__((address_space(3))) bf16x8*)(kp+4096); kf[5]=*(const __attribute__((address_space(3))) bf16x8*)(kp+4608);
  kf[6]=*(const __attribute__((address_space(3))) bf16x8*)(kp+6144); kf[7]=*(const __attribute__((address_space(3))) bf16x8*)(kp+6656);
}
__device__ __forceinline__ void kload2(bf16x8*kf,lds_cptr kp,int j){ kf[2*j]=*(const __attribute__((address_space(3))) bf16x8*)(kp+j*2048); kf[2*j+1]=*(const __attribute__((address_space(3))) bf16x8*)(kp+j*2048+512); }
__device__ __forceinline__ s16x4 vtr(lds_cptr p){ return __builtin_bit_cast(s16x4,__builtin_amdgcn_ds_read_tr16_b64_v4i16((__attribute__((address_space(3))) v4i16_t*)p)); }
__device__ __forceinline__ float rowmax(const f32x16&p0,const f32x16&p1){
  float a=max3f(p0[0],p0[1],p1[0]),b=max3f(p0[2],p0[3],p1[1]);a=max3f(a,p1[2],p1[3]);
  #pragma unroll
  for(int r=4;r<16;r+=4){a=max3f(a,p0[r],p0[r+1]);b=max3f(b,p0[r+2],p0[r+3]);a=max3f(a,p1[r],p1[r+1]);b=max3f(b,p1[r+2],p1[r+3]);}
  const float m=max2f(a,b);
  auto rr=__builtin_amdgcn_permlane32_swap(__float_as_uint(m),__float_as_uint(m),false,false);
  return max2f(__uint_as_float(rr[0]),__uint_as_float(rr[1]));
}
__device__ __forceinline__ void pv(f32x16*o,int vb,bf16x8 pa0,bf16x8 pa1,bf16x8 pa2,bf16x8 pa3){
  #pragma unroll
  for(int d0=0;d0<2;++d0){s16x4 lo[4],hi[4];
    #pragma unroll
    for(int ks=0;ks<4;++ks){
      asm volatile("ds_read_b64_tr_b16 %0,%1 offset:%c2":"=&v"(lo[ks]):"v"(vb),"i"(d0*4096+ks*1024):"memory");
      asm volatile("ds_read_b64_tr_b16 %0,%1 offset:%c2":"=&v"(hi[ks]):"v"(vb),"i"(d0*4096+ks*1024+512):"memory");}
    asm volatile("s_waitcnt lgkmcnt(0)":::"memory");SBAR();
    #define PK(k) (bf16x8){lo[k][0],lo[k][1],lo[k][2],lo[k][3],hi[k][0],hi[k][1],hi[k][2],hi[k][3]}
    o[d0]=__builtin_amdgcn_mfma_f32_32x32x16_bf16(pa0,PK(0),o[d0],0,0,0);
    o[d0]=__builtin_amdgcn_mfma_f32_32x32x16_bf16(pa1,PK(1),o[d0],0,0,0);
    o[d0]=__builtin_amdgcn_mfma_f32_32x32x16_bf16(pa2,PK(2),o[d0],0,0,0);
    o[d0]=__builtin_amdgcn_mfma_f32_32x32x16_bf16(pa3,PK(3),o[d0],0,0,0);
    #undef PK
  }
}

#ifndef ATTN_STORE16
#define ATTN_STORE16(p,v) (*(u32x4*)(p)=(v))
#endif
template<int THRL> __device__ __forceinline__ void attn_unit(int b,int h,int qb,const bf16*Q,const bf16*K,const bf16*V,const unsigned long long*MK,bf16*O,char*shm){
  const int tid=threadIdx.x,lane=tid&63,r32=lane&31,hi=lane>>5; const int wid=__builtin_amdgcn_readfirstlane(tid>>6);
  const long rowbase=(long)b*SEQ; const int q0=qb*QB;
  const bf16*Qw=Q+(rowbase+q0+wid*QBLK)*QP+h*D;
  const bf16*Kh=K+rowbase*KP+(h>>2)*D,*Vh=V+rowbase*KP+(h>>2)*D;
  const unsigned lds0=(unsigned)(uintptr_t)shm;
  float*wsf=(float*)(shm+LDS_WS)+wid*64;
  const bf16*ksrc=Kh+(long)lane*KP+wid*8;
  const bf16*vsrc=Vh+(long)(16*(wid&3)+(lane>>2))*KP+(wid>>2)*32+(lane&3)*8;
  const unsigned kdst=lds0+LDS_K+wid*1024, vdst=lds0+LDS_V+wid*1024;
  #define DMA_K(t,slot) glds16(ksrc+(long)(t)*KVBLK*KP,(unsigned)__builtin_amdgcn_readfirstlane(kdst+(slot)))
  #define DMA_V(t,slot) glds16(vsrc+(long)(t)*KVBLK*KP,(unsigned)__builtin_amdgcn_readfirstlane(vdst+(slot)))
  const int vb0=(int)(lds0+LDS_V)+((lane>>4)&1)*32+(lane&3)*8+(4*hi+((lane&15)>>2))*64;
  const char*Kbase=shm+LDS_K; bf16x8 kf[8];
  const lds_cptr shm3=(lds_cptr)shm; const lds_cptr kp0=shm3+LDS_K+hi*1024+r32*16; const lds_cptr vp0=shm3+LDS_V+((lane>>4)&1)*32+(lane&3)*8+(4*hi+((lane&15)>>2))*64;
  const int NT=(q0+QB)/KVBLK;
  const __attribute__((address_space(3))) char* shm3m=(const __attribute__((address_space(3))) char*)shm;
  typedef __attribute__((address_space(3))) unsigned long long* lds_u64p;
  const lds_u64p mskw=(lds_u64p)(shm3m+LDS_MSK+wid*8192);
  unsigned long long mtmp[16];
  { const unsigned long long*mq=MK+(q0+wid*QBLK+r32);
    #pragma unroll
    for(int i=0;i<16;++i){int tt=2*i+hi; tt=tt<NT?tt:NT-1; mtmp[i]=mq[(long)tt*SEQ];} }
  DMA_K(0,0);DMA_V(0,0);DMA_K(1,SLOTB);
  bf16x8 qr[4];
  #pragma unroll
  for(int d0=0;d0<4;++d0)qr[d0]=*reinterpret_cast<const bf16x8*>(&Qw[(long)r32*QP+d0*16+hi*8]);
  float mhat=0.f,l_reg=0.f;f32x16 o[2];o[0]=f32x16{};o[1]=f32x16{};f32x16 negm=f32x16{};asm volatile("":"+v"(negm));
  const int qrel=wid*QBLK+r32;
  #define CMASK(P0,P1,t) do{int jb_=(t)-(NT-4); if(jb_>=0)cmask(P0,P1,jb_,qrel,hi);}while(0)
  bool resc=false;
  #define START(P0,P1) do{ const float rm=rowmax(P0,P1); resc=false; \
    { const float dl=rm; mhat=fadd_s(mhat,dl); \
      _Pragma("unroll") for(int r=0;r<16;++r){P0[r]=fsub_s(P0[r],dl);P1[r]=fsub_s(P1[r],dl);} \
      _Pragma("unroll") for(int r=0;r<16;++r)negm[r]=-mhat; asm volatile("":"+v"(negm)); } \
    _Pragma("unroll") for(int r=0;r<16;++r)P0[r]=__builtin_amdgcn_exp2f(P0[r]); }while(0)
  #define RESC() do{ if(resc){ asm volatile("s_waitcnt lgkmcnt(0)":::"memory"); \
      _Pragma("unroll") for(int d_=0;d_<2;++d_) _Pragma("unroll") for(int r=0;r<16;++r)o[d_][r]*=wsf[crow(r,hi)]; } }while(0)
  f32x16 pA0,pA1,pB0,pB1;
  int sl_prev=0,sl_cur=0,sl_next=SLOTB;
  #define ROT() do{sl_prev=sl_cur;sl_cur=sl_next;sl_next=(sl_next==(NSLOT-1)*SLOTB)?0:sl_next+SLOTB;}while(0)
  DMA_K(2,2*SLOTB);
  WAIT_BAR(3);
  #pragma unroll
  for(int i=0;i<16;++i)mskw[(2*i+hi)*32+r32]=mtmp[i];
  #define MLOAD(t,LO,HI) do{ const unsigned long long mw_=mskw[(t)*32+r32]; LO=((unsigned)mw_)>>(4*hi); HI=((unsigned)(mw_>>32))>>(4*hi); }while(0)
  unsigned mlo,mhi; MLOAD(0,mlo,mhi);
  qkt(pA0,pA1,Kbase,qr,negm,r32,hi);asm volatile("s_nop 15\n\ts_nop 7":"+v"(pA0),"+v"(pA1));
  START(pA0,pA1);
  _Pragma("unroll") for(int r=0;r<16;++r)pA1[r]=__builtin_amdgcn_exp2f(pA1[r]);
  _Pragma("unroll") for(int r=0;r<16;++r){pA0[r]=MSKV(pA0[r],mlo,r);pA1[r]=MSKV(pA1[r],mhi,r);}
  WAIT_BAR(0);
  DMA_K(3,0);DMA_V(1,SLOTB);
  ROT();
  kload8(kf,kp0+sl_cur);
  WAIT_BAR(2);
  s16x4 vlo[8],vhi[8]; u32x4 pw0,pw1,pw2,pw3;
  #define PKW(P,B) cvtpk_s(P[B],P[B+1])
  #define PAF(k) __builtin_bit_cast(bf16x8,pw##k)
  #define VFR(i) (bf16x8){vlo[i][0],vlo[i][1],vlo[i][2],vlo[i][3],vhi[i][0],vhi[i][1],vhi[i][2],vhi[i][3]}
  #define PIN(x) asm volatile("":"+v"(x))
  #define MX3(a,b,c) __builtin_fmaxf(__builtin_fmaxf((a),(b)),(c))
  #define GAPA(MF,A0,A1,A2,A3,W0,W1,PW) do{ MF; sacc+=A0; sacc+=A1; sacc+=A2; sacc+=A3; PIN(sacc); W0; W1; PIN(PW); SBAR(); }while(0)
  #define EX(v) __builtin_amdgcn_exp2f(v)
  #define GAPB(MF,X,B,W) do{ MF; X[B]=MSKV(EX(X[B]),W,B); X[B+1]=MSKV(EX(X[B+1]),W,B+1); X[B+2]=MSKV(EX(X[B+2]),W,B+2); X[B+3]=MSKV(EX(X[B+3]),W,B+3); PIN(X); SBAR(); }while(0)
  #define VRD(i) do{ vlo[i]=vtr(vp_+(((i)>>2)*4096+((i)&3)*1024)); vhi[i]=vtr(vp_+(((i)>>2)*4096+((i)&3)*1024+512)); }while(0)
  #define KRD(G,j) do{ if(G){ kload2(kf,kp0+sl_next,j); SBAR(); } }while(0)
  #define STEP(C0,C1,P0,P1,t,GK,GV,GL) do{ SBAR(); \
    const lds_cptr vp_=vp0+sl_prev; MLOAD(t,mlo,mhi); \
    VRD(0); SBAR(); float sacc=(P0[0]+P0[1]); \
    GAPA(C0=__builtin_amdgcn_mfma_f32_32x32x16_bf16(kf[0],qr[0],negm,0,0,0), P0[2],P0[3],P0[4],P0[5],     pw0[0]=PKW(P0,0), pw0[1]=PKW(P0,2), pw0); \
    VRD(4); SBAR(); GAPA(C1=__builtin_amdgcn_mfma_f32_32x32x16_bf16(kf[1],qr[0],negm,0,0,0), P0[6],P0[7],P0[8],P0[9],     pw0[2]=PKW(P0,4), pw0[3]=PKW(P0,6), pw0); \
    VRD(1); SBAR(); GAPA(C0=__builtin_amdgcn_mfma_f32_32x32x16_bf16(kf[2],qr[1],C0,0,0,0),   P0[10],P0[11],P0[12],P0[13], pw1[0]=PKW(P0,8), pw1[1]=PKW(P0,10), pw1); \
    VRD(5); SBAR(); GAPA(C1=__builtin_amdgcn_mfma_f32_32x32x16_bf16(kf[3],qr[1],C1,0,0,0),   P0[14],P0[15],P1[0],P1[1],   pw1[2]=PKW(P0,12),pw1[3]=PKW(P0,14), pw1); \
    VRD(2); SBAR(); GAPA(C0=__builtin_amdgcn_mfma_f32_32x32x16_bf16(kf[4],qr[2],C0,0,0,0),   P1[2],P1[3],P1[4],P1[5],     pw2[0]=PKW(P1,0), pw2[1]=PKW(P1,2), pw2); \
    VRD(6); SBAR(); GAPA(C1=__builtin_amdgcn_mfma_f32_32x32x16_bf16(kf[5],qr[2],C1,0,0,0),   P1[6],P1[7],P1[8],P1[9],     pw2[2]=PKW(P1,4), pw2[3]=PKW(P1,6), pw2); \
    VRD(3); SBAR(); GAPA(C0=__builtin_amdgcn_mfma_f32_32x32x16_bf16(kf[6],qr[3],C0,0,0,0),   P1[10],P1[11],P1[12],P1[13], pw3[0]=PKW(P1,8), pw3[1]=PKW(P1,10), pw3); \
    VRD(7); SBAR(); GAPA(C1=__builtin_amdgcn_mfma_f32_32x32x16_bf16(kf[7],qr[3],C1,0,0,0),   P1[14],P1[15],0.f,0.f,       pw3[2]=PKW(P1,12),pw3[3]=PKW(P1,14), pw3); \
    l_reg+=sacc; \
    if(GK){DMA_K((t)+3,sl_cur);} if(GV){DMA_V((t)+1,sl_next);} \
    { float a=MX3(C0[0],C0[1],C1[0]),b=MX3(C0[2],C0[3],C1[1]); a=MX3(a,C1[2],C1[3]); \
      _Pragma("unroll") for(int r=4;r<16;r+=4){a=MX3(a,C0[r],C0[r+1]);b=MX3(b,C0[r+2],C0[r+3]);a=MX3(a,C1[r],C1[r+1]);b=MX3(b,C1[r+2],C1[r+3]);} \
      float rm=__builtin_fmaxf(a,b); { auto rr=__builtin_amdgcn_permlane32_swap(__float_as_uint(rm),__float_as_uint(rm),false,false); rm=__builtin_fmaxf(__uint_as_float(rr[0]),__uint_as_float(rr[1])); } \
      resc=false; \
      if(__builtin_expect(__any(rm>(float)THRL),0)){ const float dl=__builtin_fmaxf(rm,0.f); mhat+=dl; \
        _Pragma("unroll") for(int r=0;r<16;++r){C0[r]-=dl;C1[r]-=dl;} \
        _Pragma("unroll") for(int r=0;r<16;++r)negm[r]=-mhat; asm volatile("":"+v"(negm)); \
        const float f=__builtin_amdgcn_exp2f(-dl); l_reg*=f; if(hi==0)wsf[r32]=f; resc=true; } } \
    SBAR(); \
    GAPB(o[0]=__builtin_amdgcn_mfma_f32_32x32x16_bf16(PAF(0),VFR(0),o[0],0,0,0), C0,0,mlo); \
    GAPB(o[1]=__builtin_amdgcn_mfma_f32_32x32x16_bf16(PAF(0),VFR(4),o[1],0,0,0), C0,4,mlo); \
    KRD(GL,0); GAPB(o[0]=__builtin_amdgcn_mfma_f32_32x32x16_bf16(PAF(1),VFR(1),o[0],0,0,0), C0,8,mlo); \
    KRD(GL,1); GAPB(o[1]=__builtin_amdgcn_mfma_f32_32x32x16_bf16(PAF(1),VFR(5),o[1],0,0,0), C0,12,mlo); \
    KRD(GL,2); GAPB(o[0]=__builtin_amdgcn_mfma_f32_32x32x16_bf16(PAF(2),VFR(2),o[0],0,0,0), C1,0,mhi); \
    KRD(GL,3); GAPB(o[1]=__builtin_amdgcn_mfma_f32_32x32x16_bf16(PAF(2),VFR(6),o[1],0,0,0), C1,4,mhi); \
    GAPB(o[0]=__builtin_amdgcn_mfma_f32_32x32x16_bf16(PAF(3),VFR(3),o[0],0,0,0), C1,8,mhi); \
    GAPB(o[1]=__builtin_amdgcn_mfma_f32_32x32x16_bf16(PAF(3),VFR(7),o[1],0,0,0), C1,12,mhi); \
    }while(0)
  int t=1;
  #undef CMASK
  #define CMASK(P0,P1,t) do{}while(0)
  for(;t+5<NT;t+=2){
    STEP(pB0,pB1,pA0,pA1,t,true,true,true);     WAIT_BAR(2); RESC(); ROT();
    STEP(pA0,pA1,pB0,pB1,t+1,true,true,true);   WAIT_BAR(2); RESC(); ROT();
  }
  #undef CMASK
  #define CMASK(P0,P1,t) do{int jb_=(t)-(NT-4); if(jb_>=0)cmask(P0,P1,jb_,qrel,hi);}while(0)
  #define ENDW(tt) do{ if((tt)+3<NT){WAIT_BAR(2);} else if((tt)+2<NT){WAIT_BAR(1);} else {WAIT_BAR(0);} }while(0)
  for(;t+1<NT;t+=2){
    STEP(pB0,pB1,pA0,pA1,t,(t+3<NT),(t+1<NT),(t+1<NT));       ENDW(t);   RESC(); ROT();
    STEP(pA0,pA1,pB0,pB1,t+1,(t+4<NT),(t+2<NT),(t+2<NT));     ENDW(t+1); RESC(); ROT();
  }
  STEP(pB0,pB1,pA0,pA1,NT-1,false,false,false); RESC();
  { float sacc=pB0[0]+pB0[1]; _Pragma("unroll") for(int r=2;r<16;++r)sacc+=pB0[r]; _Pragma("unroll") for(int r=0;r<16;++r)sacc+=pB1[r]; l_reg+=sacc;
    pw0=(u32x4){PKW(pB0,0),PKW(pB0,2),PKW(pB0,4),PKW(pB0,6)};pw1=(u32x4){PKW(pB0,8),PKW(pB0,10),PKW(pB0,12),PKW(pB0,14)};pw2=(u32x4){PKW(pB1,0),PKW(pB1,2),PKW(pB1,4),PKW(pB1,6)};pw3=(u32x4){PKW(pB1,8),PKW(pB1,10),PKW(pB1,12),PKW(pB1,14)};
    SBAR(); pv(o,vb0+sl_cur,PAF(0),PAF(1),PAF(2),PAF(3)); }
  #undef PKW
  #undef PAF
  #undef VFR
  #undef PIN
  #undef MX3
  #undef GAPA
  #undef GAPB
  #undef EX
  #undef VRD
  #undef KRD
  #undef STEP
  #undef ENDW
  {auto rr=__builtin_amdgcn_permlane32_swap(__float_as_uint(l_reg),__float_as_uint(l_reg),false,false);l_reg=__uint_as_float(rr[0])+__uint_as_float(rr[1]);}
  if(hi==0)wsf[32+r32]=l_reg;asm volatile("s_waitcnt lgkmcnt(0)":::"memory");
  float rli[16];
  #pragma unroll
  for(int r=0;r<16;++r)rli[r]=__builtin_amdgcn_rcpf(wsf[32+crow(r,hi)]);
  bf16*Ow=O+(rowbase+q0+wid*QBLK)*OP+OOFF+h*D;
  { bf16*stg=(bf16*)(shm+LDS_OST)+wid*2048;
    #pragma unroll
    for(int r=0;r<16;++r){const int orow=crow(r,hi);
      #pragma unroll
      for(int d0=0;d0<2;++d0)stg[orow*64+d0*32+r32]=__float2bfloat16(o[d0][r]*rli[r]);}
    asm volatile("s_waitcnt lgkmcnt(0)":::"memory");
    #pragma unroll
    for(int i=0;i<4;++i){const int row=i*8+(lane>>3),ch=lane&7; const u32x4 v=*(const u32x4*)(stg+row*64+ch*8); ATTN_STORE16(Ow+(long)row*OP+ch*8,v);} }
  asm volatile("s_waitcnt lgkmcnt(0)\n\ts_barrier":::"memory");
  #undef DMA_K
  #undef DMA_V
  #undef CMASK
  #undef START
  #undef RESC
  #undef ROT
}
constexpr int ATTN_LDS_BYTES=LDS_BYTES;
struct AttnTensors { const bf16* Q; const bf16* K; const bf16* V; const unsigned long long* MK; bf16* O; };
struct AttnUnit { int bh; int qb; };
struct StaticOrder {
  int vcu;
  __device__ __forceinline__ explicit StaticOrder(int vcu_):vcu(vcu_){}
  __device__ __forceinline__ bool next(int i,AttnUnit&u)const{ if(vcu>=256)return false; const int s=vcu&1; u.bh=vcu>>1; if(s){ if(i>=5)return false; u.qb=5-i; } else { if(i>=3)return false; u.qb=(i==0)?7:(i==1)?6:0; } return true; }
};
template<class Sched,int THRL=8> __device__ __forceinline__ void attn_phase(char*lds,const AttnTensors&T,const Sched&S){
  AttnUnit u;
  for(int i=0;S.next(i,u);++i){ const int b=u.bh/NHEAD; attn_unit<THRL>(b,u.bh%NHEAD,u.qb,T.Q,T.K,T.V,T.MK+(long)b*32*SEQ,T.O,lds); }
}
#undef SBAR
#undef WAIT_BAR
}
#ifndef PROBE_DUP
#define PROBE_DUP (-1)
#endif
constexpr int D = 1024, NB = 16, SEQ = 2048, MP = NB * SEQ, DB = 32, DS = 4, MS = DB * DS, MTOT = MP + MS, MPAD = 33024;
constexpr int DFF = 2816, NIN = 2888, NINP = 3072, DCONV = 512;
constexpr int PAST = 16384, PAGE = 128, NPAGES = 128, KTOP = 256;
constexpr float EPS = 1e-6f, LOG2E = 1.4426950408889634f;
constexpr float QSCALE = 0.125f * LOG2E;
constexpr size_t O_YP = 0, O_YS = O_YP + (size_t)MP * D, O_KP = O_YS + (size_t)MS * D, O_VP = O_KP + (size_t)MP * 128, O_IP = O_VP + (size_t)MP * 128,
                 O_CP = O_IP + (size_t)MP * 64, O_KS = O_CP + 16 * 2 * 512, O_VS = O_KS + MS * 128, O_IS = O_VS + MS * 128, O_CS = O_IS + MS * 64, O_END = O_CS + 32 * 2 * 512;
static_assert(O_END == 44261376, "output size");

constexpr size_t al(size_t x) { return (x + 0xFFFFF) & ~(size_t)0xFFFFF; }
constexpr size_t WS_CTL = 0, CTL_ZERO_BYTES = 1u << 20;
constexpr size_t WS_ROPE = al(WS_CTL + CTL_ZERO_BYTES);
constexpr size_t WS_WGU1 = al(WS_ROPE + 2052 * 8 * 2 * 4);
constexpr size_t WS_WD1 = al(WS_WGU1 + (size_t)2 * DFF * D * 2);
constexpr size_t WS_WIN = al(WS_WD1 + (size_t)D * DFF * 2);
constexpr size_t WS_WOUT = al(WS_WIN + (size_t)NINP * D * 2);
constexpr size_t WS_WGU2 = al(WS_WOUT + (size_t)D * D * 2);
constexpr size_t WS_WD2 = al(WS_WGU2 + (size_t)2 * DFF * D * 2);
constexpr size_t WS_XB = al(WS_WD2 + (size_t)D * DFF * 2);
constexpr size_t WS_SS0 = al(WS_XB + (size_t)MPAD * D * 2);
constexpr size_t WS_SS1 = al(WS_SS0 + (size_t)MPAD * 4);
constexpr size_t WS_SS2 = al(WS_SS1 + (size_t)MPAD * 64);
constexpr size_t WS_H = al(WS_SS2 + (size_t)MPAD * 64);
constexpr size_t WS_X1 = al(WS_H + (size_t)MPAD * DFF * 2);
constexpr size_t WS_X1B = al(WS_X1 + (size_t)MPAD * D * 4);
constexpr size_t WS_X2 = al(WS_X1B + (size_t)MPAD * D * 2);
constexpr size_t WS_X2B = al(WS_X2 + (size_t)MPAD * D * 4);
constexpr size_t WS_U = al(WS_X2B + (size_t)MPAD * D * 2);
constexpr size_t WS_GB = al(WS_U + (size_t)MPAD * 512 * 2);
constexpr size_t WS_Q = al(WS_GB + (size_t)MPAD * 512 * 2);
constexpr size_t WS_QI = al(WS_Q + (size_t)MPAD * 512 * 2);
constexpr size_t WS_KB = al(WS_QI + (size_t)MPAD * 512 * 2);
constexpr size_t WS_VB = al(WS_KB + (size_t)MPAD * 128 * 2);
constexpr size_t WS_KIB = al(WS_VB + (size_t)MPAD * 128 * 2);
constexpr size_t WS_WI = al(WS_KIB + (size_t)MPAD * 64 * 2);
constexpr size_t WS_CAT = al(WS_WI + (size_t)MPAD * 8 * 4);
constexpr size_t WS_MASK = al(WS_CAT + (size_t)MPAD * D * 2);
constexpr int SSTR = 16384;
constexpr size_t WS_SSC = al(WS_MASK + (size_t)NB * 32 * SEQ * 8);
constexpr size_t WS_XB8 = al(WS_SSC + (size_t)MS * SSTR * 4);
constexpr size_t WS_X2B8 = al(WS_XB8 + (size_t)MPAD * D);
constexpr size_t WS_WGU1_8 = al(WS_X2B8 + (size_t)MPAD * D);
constexpr size_t WS_WGU2_8 = al(WS_WGU1_8 + (size_t)2 * DFF * D);
constexpr size_t WS_WD2_8 = al(WS_WGU2_8 + (size_t)2 * DFF * D);
constexpr size_t WS_H8 = al(WS_WD2_8 + (size_t)D * DFF);
constexpr size_t WS_XI8 = al(WS_H8 + (size_t)MPAD * DFF);
constexpr size_t WS_XS = al(WS_XI8 + (size_t)MPAD * D);
constexpr size_t WS_WGU1I8 = al(WS_XS + (size_t)MPAD * 4);
constexpr size_t WS_WSN = al(WS_WGU1I8 + (size_t)2 * DFF * D);
constexpr size_t WS_X2I8 = al(WS_WSN + (size_t)2 * DFF * 4);
constexpr size_t WS_XS2 = al(WS_X2I8 + (size_t)MPAD * D);
constexpr size_t WS_WGU2I8 = al(WS_XS2 + (size_t)MPAD * 4);
constexpr size_t WS_WSN2 = al(WS_WGU2I8 + (size_t)2 * DFF * D);
constexpr size_t WS_WD1_8 = al(WS_WSN2 + (size_t)2 * DFF * 4);
constexpr size_t WS_END = al(WS_WD1_8 + (size_t)D * DFF);
constexpr float H8SCALE = 4.0f;
constexpr float W8SCALE = 32.0f;

constexpr int CW_TMO = 0, CW_CODE = 1, CW_BAR = 4096;

constexpr int RING_OFF = 0, RING_BYTES = 152576;
constexpr int LDSCTL_OFF = RING_BYTES, MISC_OFF = LDSCTL_OFF + 320;
constexpr int LDS_BYTES = 158720;
static_assert(MISC_OFF + 128 <= LDS_BYTES && attn_body::ATTN_LDS_BYTES <= RING_BYTES && pg8::STAGE_BYTES <= RING_BYTES, "LDS map");

#define GAS __attribute__((address_space(1)))
#define LAS __attribute__((address_space(3)))
typedef unsigned short bf16;
typedef unsigned v4u __attribute__((ext_vector_type(4)));
typedef unsigned v2u __attribute__((ext_vector_type(2)));
typedef float f32x4 __attribute__((ext_vector_type(4)));
typedef float f32x16 __attribute__((ext_vector_type(16)));
typedef short bf16x8 __attribute__((ext_vector_type(8)));
typedef GAS unsigned gu32;
#define RLX_AGENT __ATOMIC_RELAXED, __HIP_MEMORY_SCOPE_AGENT
#define LDS_WAIT() asm volatile("s_waitcnt lgkmcnt(0)" ::: "memory")
#define VM_WAIT() asm volatile("s_waitcnt vmcnt(0)" ::: "memory")
__device__ __forceinline__ unsigned f2bf(float f) { unsigned u = __builtin_bit_cast(unsigned, f); return (u + 0x7fffu + ((u >> 16) & 1u)) >> 16; }
__device__ __forceinline__ unsigned pk2(float lo, float hi) { return f2bf(lo) | (f2bf(hi) << 16); }
__device__ __forceinline__ float bf2f(unsigned short h) { return __builtin_bit_cast(float, (unsigned)h << 16); }
__device__ __forceinline__ float wave_sum(float v) {
#pragma unroll
    for (int o = 1; o < 64; o <<= 1) v += __shfl_xor(v, o);
    return v;
}
__device__ __forceinline__ float wave_max(float v) {
#pragma unroll
    for (int o = 1; o < 64; o <<= 1) v = fmaxf(v, __shfl_xor(v, o));
    return v;
}

#define XB_TMO      128
#define XB_XCNT(j)  (256  + 64 * (j))
#define XB_XSUB(j)  (1280 + 64 * (j))
#define XB_XGEN(j)  (2304 + 64 * (j))
#define XB_TOP      3328
#define XB_TOPGEN   3392
#define XCD_BAR_WORDS 3456
#define XB_SPIN_CAP (1u << 18)

__device__ __forceinline__ unsigned xb_ld(unsigned* p)              { return __hip_atomic_load(p, __ATOMIC_RELAXED, __HIP_MEMORY_SCOPE_AGENT); }
__device__ __forceinline__ unsigned xb_add(unsigned* p, unsigned v) { return __hip_atomic_fetch_add(p, v, __ATOMIC_RELAXED, __HIP_MEMORY_SCOPE_AGENT); }
__device__ __forceinline__ unsigned xb_xcc_id() { return (unsigned)__builtin_amdgcn_s_getreg((3 << 11) | 20) & 0xFu; }
#define XB_SPIN(cond, bar) do { unsigned _sp = 0; while (cond) { __builtin_amdgcn_s_sleep(1); \
    if ((++_sp & 255u) == 0u) { if (xb_ld(&(bar)[XB_TMO])) break; if (_sp > XB_SPIN_CAP) { atomicAdd(&(bar)[XB_TMO], 1u); break; } } } } while (0)

struct XcdBarrier {
    unsigned* bar; unsigned x;
    volatile LAS unsigned* st;
};

__device__ __forceinline__ XcdBarrier xcd_barrier_post(unsigned* bar, volatile LAS unsigned* st) {
    XcdBarrier b; b.bar = bar; b.x = xb_xcc_id(); b.st = st;
    if (threadIdx.x == 0) (void)xb_add(&bar[XB_XCNT(b.x)], 1u);
    return b;
}
__device__ __forceinline__ void xcd_barrier_complete(unsigned* bar, unsigned x, unsigned& nloc, unsigned& nx) {
    const unsigned G = gridDim.x * gridDim.y * gridDim.z;
    unsigned sum, cnt, mine, sp = 0u;
    for (;;) {
        sum = 0u; cnt = 0u; mine = 0u;
#pragma unroll
        for (unsigned j = 0; j < 16; ++j) { const unsigned c = xb_ld(&bar[XB_XCNT(j)]); sum += c; cnt += (c > 0u) ? 1u : 0u; mine = (j == x) ? c : mine; }
        if (sum == G) break;
        __builtin_amdgcn_s_sleep(1);
        if ((++sp & 255u) == 0u) { if (xb_ld(&bar[XB_TMO])) break; if (sp > XB_SPIN_CAP) { atomicAdd(&bar[XB_TMO], 1u); break; } }
    }
    nloc = mine > 0u ? mine : 1u; nx = cnt > 0u ? cnt : 1u;
}

__device__ __forceinline__ void xcd_barrier(const XcdBarrier& b) {
    asm volatile("s_waitcnt vmcnt(0)" ::: "memory");
    __syncthreads();
    if (threadIdx.x == 0) {
        unsigned* bar = b.bar;
        __builtin_amdgcn_s_waitcnt(0);
        unsigned nloc = b.st[0], nx = b.st[1];
        if (nloc == 0u) { xcd_barrier_complete(bar, b.x, nloc, nx); b.st[0] = nloc; b.st[1] = nx; }
        const unsigned old = xb_add(&bar[XB_XSUB(b.x)], 1u);
        const unsigned gen = old / nloc;
        if (old + 1u == (gen + 1u) * nloc) {
            __builtin_amdgcn_fence(__ATOMIC_RELEASE, "agent");
            asm volatile("s_waitcnt vmcnt(0)" ::: "memory");
            const unsigned og = xb_add(&bar[XB_TOP], 1u);
            const unsigned tg = og / nx;
            if (og + 1u == (tg + 1u) * nx) xb_add(&bar[XB_TOPGEN], 1u);
            else XB_SPIN(xb_ld(&bar[XB_TOPGEN]) == tg, bar);
            __builtin_amdgcn_fence(__ATOMIC_ACQUIRE, "agent");
            xb_add(&bar[XB_XGEN(b.x)], 1u);
            asm volatile("s_waitcnt vmcnt(0)" ::: "memory");
        } else {
            XB_SPIN(xb_ld(&bar[XB_TOPGEN]) == gen, bar);
            __builtin_amdgcn_fence(__ATOMIC_ACQUIRE, "agent");
            asm volatile("s_waitcnt vmcnt(0)" ::: "memory");
        }
    }
    __syncthreads();
}
__host__ __device__ __forceinline__ int r32map(int P) { return 16 * ((P >> 2) & 1) + 4 * (P >> 3) + (P & 3); }
__host__ __device__ __forceinline__ int p128(int x) { return (x & ~31) + r32map(x & 31); }
__host__ __device__ __forceinline__ int hdmap(int d) { if (d >= 16) return d; const int fq = (d >> 2) & 1, j = (d & 3) + 4 * (d >> 3); return 8 * fq + j; }
__host__ __device__ __forceinline__ int head_row(int wc, int d) { const int x = hdmap(d); return 128 * (x >> 5) + 32 * wc + r32map(x & 31); }
__device__ __forceinline__ int dstart(int bj, int fq, int half) { return (bj == 0 && fq < 2) ? 4 * fq + 8 * half : 32 * bj + 8 * fq + 4 * half; }

struct MapGate { __device__ __forceinline__ int operator()(int c) const { return 256 * (c >> 7) + p128(c & 127); } };
struct MapUp   { __device__ __forceinline__ int operator()(int c) const { return 256 * (c >> 7) + 128 + p128(c & 127); } };
struct MapLin  { __device__ __forceinline__ int operator()(int c) const { return (c & ~127) + p128(c & 127); } };
struct MapWin  { __device__ __forceinline__ int operator()(int c) const {
    if (c < 512) return 1024 + (c & ~127) + p128(c & 127);
    if (c < 1024) { const int ch = c - 512; return 256 * (ch >> 7) + p128(ch & 127); }
    if (c < 1536) { const int ch = c - 1024; return 256 * (ch >> 7) + 128 + p128(ch & 127); }
    if (c < 2048) { const int x = c - 1536, hd = x >> 6; return 256 * (6 + (hd >> 2)) + head_row(hd & 3, x & 63); }
    if (c < 2176) { const int x = c - 2048; return 256 * 8 + head_row(x >> 6, x & 63); }
    if (c < 2304) { const int x = c - 2176; return 256 * 8 + head_row(2 + (x >> 6), x & 63); }
    if (c < 2816) { const int x = c - 2304, hd = x >> 6; return 256 * (9 + (hd >> 2)) + head_row(hd & 3, x & 63); }
    if (c < 2880) return 256 * 11 + head_row(0, c - 2816);
    return 256 * 11 + 32 + r32map(c - 2880);
} };

using pg8::Unit; using pg8::bf16_t;
__device__ __forceinline__ float rstd_from(const float* ss, int row, int nslot) {
    float s = 0.f;
    if (nslot == 1) s = ss[row];
    else { const f32x4* p = (const f32x4*)(ss + (size_t)row * 16); const f32x4 a = p[0], b = p[1], c = p[2], d = p[3]; s = ((a.x + a.y) + (a.z + a.w)) + ((b.x + b.y) + (b.z + b.w)) + ((c.x + c.y) + (c.z + c.w)) + ((d.x + d.y) + (d.z + d.w)); }
    return __builtin_amdgcn_rsqf(s * (1.0f / D) + EPS);
}
__device__ __forceinline__ float clamp8(float x) { return __builtin_amdgcn_fmed3f(x, -440.0f, 440.0f); }
__device__ __forceinline__ unsigned pk4_fp8(float a, float b, float c, float d) { int w = __builtin_amdgcn_cvt_pk_fp8_f32(clamp8(a), clamp8(b), 0, false); w = __builtin_amdgcn_cvt_pk_fp8_f32(clamp8(c), clamp8(d), w, true); return (unsigned)w; }
#define EPI_CALL_ROWS() \
    __device__ __forceinline__ void operator()(f32x4 (&acc)[2][2][4][2], const Unit& u, int wr, int wc, int fr, int fq, int ui, bool has_next, const Unit& nxt) const { \
        _Pragma("unroll") for (int ai = 0; ai < 2; ++ai) _Pragma("unroll") for (int m = 0; m < 4; ++m) { \
            const f32x4 v[2][2] = {{acc[ai][0][m][0], acc[ai][0][m][1]}, {acc[ai][1][m][0], acc[ai][1][m][1]}}; \
            row(v, u.pm * 256 + ai * 128 + wr * 64 + m * 16 + fr, u.pn, wc, fr, fq, ui); \
            if (has_next) init_rg(acc, nxt, ai, m, wr, wc, fr, fq); } }                        \
    __device__ __forceinline__ void init(f32x4 (&acc)[2][2][4][2], const Unit& u, int wr, int wc, int fr, int fq) const { \
        _Pragma("unroll") for (int ai = 0; ai < 2; ++ai) _Pragma("unroll") for (int m = 0; m < 4; ++m) init_rg(acc, u, ai, m, wr, wc, fr, fq); }
#define EPI_ZERO_INIT() \
    __device__ __forceinline__ void init_rg(f32x4 (&acc)[2][2][4][2], const Unit&, int ai, int m, int, int, int, int) const { \
        _Pragma("unroll") for (int b = 0; b < 2; ++b) _Pragma("unroll") for (int n = 0; n < 2; ++n) acc[ai][b][m][n] = (f32x4){0.f, 0.f, 0.f, 0.f}; }
__device__ __forceinline__ float rstd_of(const LAS float* tab, const float* ss, int nslot, int row, int ui) { return (ui >= 0 && tab) ? tab[ui * 256 + (row & 255)] : rstd_from(ss, row, nslot); }
struct EpiGU {
    static constexpr bool PERM = false, AFTER_DRAIN = false;
    bf16_t* H; const float* ss; int nslot; const LAS float* tab; float wscale; unsigned char* H8; const float* wsn;
    __device__ __forceinline__ void row(const f32x4 (&v)[2][2], int row, int pn, int wc, int fr, int fq, int ui) const {
        typedef float f32x2 __attribute__((ext_vector_type(2)));
        const int col0 = pn * 128 + wc * 32 + 8 * fq;
        const float rs = rstd_of(tab, ss, nslot, row, ui) * (ui >= 0 ? wscale : 1.0f);
        const float c1 = -rs * LOG2E, rs2 = rs * rs;
        const bool f8 = H8 != nullptr;
        const float rs2s = f8 ? rs2 * H8SCALE : rs2;
        f32x2 hh[4];
#pragma unroll
        for (int n = 0; n < 2; ++n)
#pragma unroll
            for (int i = 0; i < 4; i += 2) { const f32x2 ag = {v[0][n][i], v[0][n][i + 1]}, au = {v[1][n][i], v[1][n][i + 1]};
                const f32x2 a = ag * c1; f32x2 e; e.x = __builtin_amdgcn_exp2f(a.x); e.y = __builtin_amdgcn_exp2f(a.y);
                const f32x2 d = e + 1.0f; f32x2 r; r.x = __builtin_amdgcn_rcpf(d.x); r.y = __builtin_amdgcn_rcpf(d.y);
                hh[2 * n + (i >> 1)] = (ag * au) * (r * rs2s); }
        if (f8) { v2u w8; w8.x = pk4_fp8(hh[0].x, hh[0].y, hh[1].x, hh[1].y); w8.y = pk4_fp8(hh[2].x, hh[2].y, hh[3].x, hh[3].y);
            *(v2u*)(H8 + (size_t)row * DFF + col0) = w8; }
        else { v4u w; w.x = pg8::cvt_pk_bf16(hh[0].x, hh[0].y); w.y = pg8::cvt_pk_bf16(hh[1].x, hh[1].y); w.z = pg8::cvt_pk_bf16(hh[2].x, hh[2].y); w.w = pg8::cvt_pk_bf16(hh[3].x, hh[3].y);
        __builtin_nontemporal_store(w, (v4u*)(H + (size_t)row * DFF + col0)); }
    }
    __device__ __forceinline__ void operator()(f32x4 (&acc)[2][2][4][2], const Unit& u, int wr, int wc, int fr, int fq, int ui, bool has_next, const Unit& nxt) const {
        typedef int v4i_ __attribute__((ext_vector_type(4)));
        f32x4 cs[2][2];
#pragma unroll
        for (int bj = 0; bj < 2; ++bj)
#pragma unroll
            for (int n = 0; n < 2; ++n) cs[bj][n] = wsn ? *(const f32x4*)(wsn + u.pn * 256 + bj * 128 + wc * 32 + n * 16 + 4 * fq) : (f32x4){1.f, 1.f, 1.f, 1.f};
#pragma unroll
        for (int ai = 0; ai < 2; ++ai)
#pragma unroll
            for (int m = 0; m < 4; ++m) {
                f32x4 v[2][2];
#pragma unroll
                for (int bj = 0; bj < 2; ++bj)
#pragma unroll
                    for (int n = 0; n < 2; ++n) v[bj][n] = wsn ? __builtin_convertvector(__builtin_bit_cast(v4i_, acc[ai][bj][m][n]), f32x4) * cs[bj][n] : acc[ai][bj][m][n];
                row(v, u.pm * 256 + ai * 128 + wr * 64 + m * 16 + fr, u.pn, wc, fr, fq, ui);
                if (has_next) init_rg(acc, nxt, ai, m, wr, wc, fr, fq); }
    }
    __device__ __forceinline__ void init(f32x4 (&acc)[2][2][4][2], const Unit& u, int wr, int wc, int fr, int fq) const {
#pragma unroll
        for (int ai = 0; ai < 2; ++ai)
#pragma unroll
            for (int m = 0; m < 4; ++m) init_rg(acc, u, ai, m, wr, wc, fr, fq); }
    EPI_ZERO_INIT()
};
__device__ __forceinline__ void bf8_to_f32(const v4u w, f32x4& lo, f32x4& hi) {
    lo = (f32x4){__uint_as_float(w.x << 16), __uint_as_float(w.x & 0xffff0000u), __uint_as_float(w.y << 16), __uint_as_float(w.y & 0xffff0000u)};
    hi = (f32x4){__uint_as_float(w.z << 16), __uint_as_float(w.z & 0xffff0000u), __uint_as_float(w.w << 16), __uint_as_float(w.w & 0xffff0000u)};
}
template <int MODE> struct EpiRes {
    static constexpr bool PERM = false, AFTER_DRAIN = false;
    const bf16_t* resb; float* out; bf16_t* outb; float* ss; unsigned char* out8; float ascale; const float* resf = nullptr; const float* resfs = nullptr;
    __device__ __forceinline__ void row(const f32x4 (&v)[2][2], int row, int pn, int wc, int fr, int fq, int ui) const {
        const bool pre = ui >= 0;
        const float alpha = ((MODE == 1) ? 1.0f : 0.5f) * (pre ? ascale : 1.0f);
        const bool live = row < MTOT;
        float sq = 0.f;
#pragma unroll
        for (int bj = 0; bj < 2; ++bj) {
            const int col = pn * 256 + bj * 128 + wc * 32 + 8 * fq;
            f32x4 r0 = (f32x4){0.f, 0.f, 0.f, 0.f}, r1 = r0;
            if (!pre && live) { if constexpr (MODE == 0) { r0 = *(const f32x4*)(resfs + (size_t)(row - MP) * D + col); r1 = *(const f32x4*)(resfs + (size_t)(row - MP) * D + col + 4); } else bf8_to_f32(*(const v4u*)(resb + (size_t)row * D + col), r0, r1); }
            const f32x4 v0 = r0 + alpha * v[bj][0], v1 = r1 + alpha * v[bj][1];
            if (MODE == 2) { if (live) { __builtin_nontemporal_store(v0, (f32x4*)(out + (size_t)row * D + col)); __builtin_nontemporal_store(v1, (f32x4*)(out + (size_t)row * D + col + 4)); } }
            else {
                v4u w; w.x = pg8::cvt_pk_bf16(v0[0], v0[1]); w.y = pg8::cvt_pk_bf16(v0[2], v0[3]); w.z = pg8::cvt_pk_bf16(v1[0], v1[1]); w.w = pg8::cvt_pk_bf16(v1[2], v1[3]);
                *(v4u*)(outb + (size_t)row * D + col) = w;
                if (MODE == 1 && out8) { v2u w8; w8.x = pk4_fp8(v0[0], v0[1], v0[2], v0[3]); w8.y = pk4_fp8(v1[0], v1[1], v1[2], v1[3]); *(v2u*)(out8 + (size_t)row * D + col) = w8; }
                sq += (v0[0] * v0[0] + v0[1] * v0[1]) + (v0[2] * v0[2] + v0[3] * v0[3]) + (v1[0] * v1[0] + v1[1] * v1[1]) + (v1[2] * v1[2] + v1[3] * v1[3]);
            }
        }
        if (MODE != 2) { sq += __shfl_xor(sq, 16); sq += __shfl_xor(sq, 32); if (fq == 0) ss[(size_t)row * 16 + pn * 4 + wc] = sq; }
    }
    EPI_CALL_ROWS()
    __device__ __forceinline__ void init_rg(f32x4 (&acc)[2][2][4][2], const Unit& u, int ai, int m, int wr, int wc, int fr, int fq) const {
        const float ia = ((MODE == 1) ? 1.0f : 2.0f) / ascale;
        const size_t ro = (size_t)(u.pm * 256 + ai * 128 + wr * 64 + m * 16 + fr) * D + u.pn * 256 + wc * 32 + 8 * fq;
#pragma unroll
        for (int bj = 0; bj < 2; ++bj) { f32x4 lo, hi;
            if constexpr (MODE == 0) { lo = *(const f32x4*)(resf + ro + bj * 128); hi = *(const f32x4*)(resf + ro + bj * 128 + 4); } else bf8_to_f32(*(const v4u*)(resb + ro + bj * 128), lo, hi);
            acc[ai][bj][m][0] = lo * ia; acc[ai][bj][m][1] = hi * ia; }
    }
};
struct EpiWin {
    static constexpr bool PERM = false, AFTER_DRAIN = false;
    unsigned char* ws; float* out; const float* qn; const float* kn; const LAS float* tab;
    __device__ __forceinline__ void row(const f32x4 (&acc)[2][2], int row, int pn, int wc, int fr, int fq, int ui) const {
        const float* ss = (const float*)(ws + WS_SS1); bf16_t* U = (bf16_t*)(ws + WS_U); bf16_t* GB = (bf16_t*)(ws + WS_GB); float* WI = (float*)(ws + WS_WI); const float* rope = (const float*)(ws + WS_ROPE);
        if (pn == 11 && wc >= 2) return;
        const int type = pn < 4 ? 0 : pn < 6 ? 1 : pn < 8 ? 2 : pn == 8 ? (wc < 2 ? 3 : 4) : pn < 11 ? 5 : (wc == 0 ? 6 : 7);
        const int head = (type == 2) ? 4 * (pn - 6) + wc : (type == 5) ? 4 * (pn - 9) + wc : (type == 3) ? wc : (type == 4) ? wc - 2 : 0;
        const bool live = row < MTOT;
        const float rs = rstd_of(tab, ss, 16, row, ui);
        if (type == 0) {
            const int ch0 = pn * 128 + wc * 32 + 8 * fq;
            const f32x4 u0 = (acc[0][0] * rs) * (acc[1][0] * rs), u1 = (acc[0][1] * rs) * (acc[1][1] * rs);
            v4u w; w.x = pg8::cvt_pk_bf16(u0[0], u0[1]); w.y = pg8::cvt_pk_bf16(u0[2], u0[3]); w.z = pg8::cvt_pk_bf16(u1[0], u1[1]); w.w = pg8::cvt_pk_bf16(u1[2], u1[3]);
            *(v4u*)(U + (size_t)row * 512 + ch0) = w;
            if (row < MP) { const int s = row & (SEQ - 1); if (s >= SEQ - 2) { float* o = out + O_CP + ((size_t)(row >> 11) * 2 + (s - (SEQ - 2))) * 512 + ch0; *(f32x4*)o = u0; *(f32x4*)(o + 4) = u1; } }
            else if (live) { const int sr = row - MP, s = sr & 3; if (s >= 2) { float* o = out + O_CS + ((size_t)(sr >> 2) * 2 + (s - 2)) * 512 + ch0; *(f32x4*)o = u0; *(f32x4*)(o + 4) = u1; } }
        } else if (type == 1) {
#pragma unroll
            for (int bj = 0; bj < 2; ++bj) { const int col = (pn - 4) * 256 + bj * 128 + wc * 32 + 8 * fq; const f32x4 a = acc[bj][0] * rs, b = acc[bj][1] * rs;
                v4u w; w.x = pg8::cvt_pk_bf16(a[0], a[1]); w.y = pg8::cvt_pk_bf16(a[2], a[3]); w.z = pg8::cvt_pk_bf16(b[0], b[1]); w.w = pg8::cvt_pk_bf16(b[2], b[3]);
                *(v4u*)(GB + (size_t)row * 512 + col) = w; }
        } else if (type == 7) {
            if (fq == 0) { *(f32x4*)(WI + (size_t)row * 8) = acc[0][0] * rs; *(f32x4*)(WI + (size_t)row * 8 + 4) = acc[0][1] * rs; }
        } else {
            f32x4 v[2][2];
#pragma unroll
            for (int bj = 0; bj < 2; ++bj) { v[bj][0] = acc[bj][0] * rs; v[bj][1] = acc[bj][1] * rs; }
            if (type == 2 || type == 3) {
                float sq = 0.f;
#pragma unroll
                for (int bj = 0; bj < 2; ++bj)
#pragma unroll
                    for (int h2 = 0; h2 < 2; ++h2) sq += (v[bj][h2][0] * v[bj][h2][0] + v[bj][h2][1] * v[bj][h2][1]) + (v[bj][h2][2] * v[bj][h2][2] + v[bj][h2][3] * v[bj][h2][3]);
                sq += __shfl_xor(sq, 16); sq += __shfl_xor(sq, 32);
                const float sc = __builtin_amdgcn_rsqf(sq * (1.0f / 64.0f) + EPS);
#pragma unroll
                for (int bj = 0; bj < 2; ++bj)
#pragma unroll
                    for (int h2 = 0; h2 < 2; ++h2) { const f32x4 gq = *(const f32x4*)(qn + dstart(bj, fq, h2)), gk = *(const f32x4*)(kn + dstart(bj, fq, h2)); v[bj][h2] = v[bj][h2] * sc * ((type == 2) ? gq : gk); }
            }
            if (type != 4 && fq < 2) {
                const int pidx = row < MP ? (row & (SEQ - 1)) : (live ? SEQ + ((row - MP) & 3) : 0);
                const float* rp = rope + ((size_t)pidx * 8 + 4 * fq) * 2;
                const f32x4 cs0 = *(const f32x4*)rp, cs1 = *(const f32x4*)(rp + 4);
                const f32x4 x1 = v[0][0], x2 = v[0][1];
                const f32x4 c = (f32x4){cs0[0], cs0[2], cs1[0], cs1[2]}, s = (f32x4){cs0[1], cs0[3], cs1[1], cs1[3]};
                v[0][0] = x1 * c - x2 * s; v[0][1] = x2 * c + x1 * s;
            }
            const size_t boff = (type == 2) ? WS_Q : (type == 3) ? WS_KB : (type == 4) ? WS_VB : (type == 5) ? WS_QI : WS_KIB;
            const int bp = (type == 2 || type == 5) ? 512 : (type == 6) ? 64 : 128; const float bsc = (type == 2) ? QSCALE : 1.0f;
            bf16_t* bdst = (bf16_t*)(ws + boff);
            const bool hasf = live && (type == 3 || type == 4 || type == 6);
            const size_t fbase = (type == 3) ? (row < MP ? O_KP : O_KS) : (type == 4) ? (row < MP ? O_VP : O_VS) : (row < MP ? O_IP : O_IS);
            float* fdst = out + fbase + (size_t)(row < MP ? row : row - MP) * (type == 6 ? 64 : 128);
#pragma unroll
            for (int bj = 0; bj < 2; ++bj)
#pragma unroll
                for (int h2 = 0; h2 < 2; ++h2) { const int d = head * 64 + dstart(bj, fq, h2); const f32x4 x = v[bj][h2];
                    if (hasf) { if (row < MP) __builtin_nontemporal_store(x, (f32x4*)(fdst + d)); else *(f32x4*)(fdst + d) = x; }
                    v2u w; w.x = pg8::cvt_pk_bf16(x[0] * bsc, x[1] * bsc); w.y = pg8::cvt_pk_bf16(x[2] * bsc, x[3] * bsc);
                    *(v2u*)(bdst + (size_t)row * bp + d) = w; }
        }
    }
    EPI_CALL_ROWS()
    EPI_ZERO_INIT()
};
template <class Epi, int MT, int QM> __device__ __forceinline__ void skinny_unit(PG8_LAS unsigned char* lds, const unsigned char* A, const unsigned char* Bt, int KB, int pn, int wc, int rg, const Epi& E,
                                                                                const float* xs, const float* wsn, float oscale) {
    typedef int v4i_ __attribute__((ext_vector_type(4)));
    const int tid = threadIdx.x, wid = __builtin_amdgcn_readfirstlane(tid >> 6), lane = tid & 63, fr = lane & 15, fq = lane >> 4;
    const int TP = KB >> 7, base = TP >> 3, rem = TP & 7;
    const int np = base + (wid < rem ? 1 : 0), p0 = wid * base + (wid < rem ? wid : rem);
    const unsigned char* ap = A + (size_t)(MP + 16 * MT * rg + fr) * KB + p0 * 128 + 16 * fq;
    const unsigned char* bp = Bt + (size_t)(256 * pn + 32 * wc + fr) * KB + p0 * 128 + 16 * fq;
    pg8::f32x4 acc[MT][2][2];
#pragma unroll
    for (int mt = 0; mt < MT; ++mt)
#pragma unroll
        for (int bj = 0; bj < 2; ++bj)
#pragma unroll
            for (int n = 0; n < 2; ++n) acc[mt][bj][n] = (pg8::f32x4){0.f, 0.f, 0.f, 0.f};
    v4i_ a0[MT], b0[2][2], a1[MT], b1[2][2], a2[MT], b2[2][2], a3[MT], b3[2][2];
#define SK_LOADP(afe, bfe, afo, bfo, p_) do { \
        _Pragma("unroll") for (int mt = 0; mt < MT; ++mt) { afe[mt] = *(const v4i_*)(ap + (size_t)(16 * mt) * KB + 128 * (p_)); afo[mt] = *(const v4i_*)(ap + (size_t)(16 * mt) * KB + 128 * (p_) + 64); } \
        _Pragma("unroll") for (int bj = 0; bj < 2; ++bj) _Pragma("unroll") for (int n = 0; n < 2; ++n) { bfe[bj][n] = *(const v4i_*)(bp + (size_t)(128 * bj + 16 * n) * KB + 128 * (p_)); bfo[bj][n] = *(const v4i_*)(bp + (size_t)(128 * bj + 16 * n) * KB + 128 * (p_) + 64); } } while (0)
#define SK_MMA(af, bf) do { _Pragma("unroll") for (int mt = 0; mt < MT; ++mt) _Pragma("unroll") for (int bj = 0; bj < 2; ++bj) _Pragma("unroll") for (int n = 0; n < 2; ++n) { \
        if constexpr (QM == 0) acc[mt][bj][n] = __builtin_amdgcn_mfma_f32_16x16x32_bf16(__builtin_bit_cast(pg8::bf16x8, bf[bj][n]), __builtin_bit_cast(pg8::bf16x8, af[mt]), acc[mt][bj][n], 0, 0, 0); \
        else if constexpr (QM == 2) acc[mt][bj][n] = __builtin_bit_cast(pg8::f32x4, __builtin_amdgcn_mfma_i32_16x16x64_i8(bf[bj][n], af[mt], __builtin_bit_cast(v4i_, acc[mt][bj][n]), 0, 0, 0)); \
        else { typedef long l2_ __attribute__((ext_vector_type(2))); const l2_ bl_ = __builtin_bit_cast(l2_, bf[bj][n]), al_ = __builtin_bit_cast(l2_, af[mt]); \
            acc[mt][bj][n] = __builtin_amdgcn_mfma_f32_16x16x32_fp8_fp8(bl_[0], al_[0], acc[mt][bj][n], 0, 0, 0); acc[mt][bj][n] = __builtin_amdgcn_mfma_f32_16x16x32_fp8_fp8(bl_[1], al_[1], acc[mt][bj][n], 0, 0, 0); } } } while (0)
    SK_LOADP(a0, b0, a1, b1, 0); if (np > 1) SK_LOADP(a2, b2, a3, b3, 1);
    for (int p = 0; p < np; p += 2) {
        SK_MMA(a0, b0); SK_MMA(a1, b1);
        if (p + 2 < np) SK_LOADP(a0, b0, a1, b1, p + 2);
        if (p + 1 < np) { SK_MMA(a2, b2); SK_MMA(a3, b3);
            if (p + 3 < np) SK_LOADP(a2, b2, a3, b3, p + 3); }
    }
#undef SK_LOADP
#undef SK_MMA
    PG8_LAS pg8::f32x4* slab = (PG8_LAS pg8::f32x4*)lds;
#pragma unroll
    for (int mt = 0; mt < MT; ++mt)
#pragma unroll
        for (int bj = 0; bj < 2; ++bj)
#pragma unroll
            for (int n = 0; n < 2; ++n) { pg8::f32x4 t = acc[mt][bj][n];
                if constexpr (QM == 2) { const v4i_ ti = __builtin_bit_cast(v4i_, t); t = (pg8::f32x4){(float)ti[0], (float)ti[1], (float)ti[2], (float)ti[3]}; }
                slab[((wid * MT + mt) * 4 + bj * 2 + n) * 64 + lane] = t; }
    __syncthreads();
    if (wid < MT) { pg8::f32x4 v[2][2]; const int row = MP + 16 * MT * rg + 16 * wid + fr;
      float rsc = oscale; if constexpr (QM == 2) rsc = xs[row];
#pragma unroll
      for (int bj = 0; bj < 2; ++bj)
#pragma unroll
          for (int n = 0; n < 2; ++n) { const int o = (wid * 4 + bj * 2 + n) * 64 + lane; pg8::f32x4 t = slab[o];
#pragma unroll
              for (int q = 1; q < 8; ++q) t = t + slab[o + q * MT * 4 * 64];
              if constexpr (QM == 2) t = t * (*(const pg8::f32x4*)(wsn + 256 * pn + 128 * bj + 32 * wc + 16 * n + 4 * fq)) * rsc;
              else if constexpr (QM == 1) t = t * rsc;
              v[bj][n] = t; }
      E.row(v, row, pn, wc, fr, fq, -1); }
    __syncthreads();
}
template <class Epi, int MT, int QM> __device__ __forceinline__ void skinny_phase(PG8_LAS unsigned char* lds, const void* A, const void* Bt, int N, int KB, int blk, int G, const Epi& E,
                                                                                 const float* xs = nullptr, const float* wsn = nullptr, float oscale = 1.0f) {
    constexpr int NRG = 8 / MT; const int nu = (N / 256) * 4 * NRG;
    for (int u = blk; u < nu; u += G) skinny_unit<Epi, MT, QM>(lds, (const unsigned char*)A, (const unsigned char*)Bt, KB, u / (4 * NRG), (u / NRG) & 3, u % NRG, E, xs, wsn, oscale);
}
__device__ __forceinline__ void fill_rstd_table(LAS float* tab, const pg8::StaticOrder& S, const float* ss, int nslot, const float* xs = nullptr) {
    const int tid = threadIdx.x; Unit u; int nu = 0;
    while (nu < 11 && S.next(nu, u)) ++nu;
    float sv[6], xsv[6]; int ix[6];
#pragma unroll
    for (int k2 = 0; k2 < 6; ++k2) { const int idx = tid + 512 * k2; ix[k2] = idx; const bool ok = idx < nu * 256; Unit uu_; S.next(ok ? (idx >> 8) : 0, uu_); const int row = uu_.pm * 256 + (idx & 255);
        float s_ = 0.f;
        if (nslot == 1) s_ = ss[row];
        else { const f32x4* p = (const f32x4*)(ss + (size_t)row * 16); const f32x4 a = p[0], b = p[1], c = p[2], d = p[3]; s_ = ((a.x + a.y) + (a.z + a.w)) + ((b.x + b.y) + (b.z + b.w)) + ((c.x + c.y) + (c.z + c.w)) + ((d.x + d.y) + (d.z + d.w)); }
        sv[k2] = s_; xsv[k2] = xs ? xs[row] : 1.0f; }
#pragma unroll
    for (int k2 = 0; k2 < 6; ++k2) if (ix[k2] < nu * 256) tab[ix[k2]] = __builtin_amdgcn_rsqf(sv[k2] * (1.0f / D) + EPS) * xsv[k2];
    __syncthreads();
}
__device__ __forceinline__ void quant_rows_pass(int gw, int NGW, const bf16_t* X, unsigned char* Q, float* XS, int nrows) {
    const int lane = threadIdx.x & 63;
    for (int g8 = gw; g8 < nrows / 8; g8 += NGW) {
        const int m0 = 8 * g8; v4u a[8][2];
#pragma unroll
        for (int r = 0; r < 8; ++r) { a[r][0] = *(const v4u*)(X + (size_t)(m0 + r) * D + 8 * lane); a[r][1] = *(const v4u*)(X + (size_t)(m0 + r) * D + 512 + 8 * lane); }
#pragma unroll
        for (int r = 0; r < 8; ++r) {
            float x[16];
#pragma unroll
            for (int e = 0; e < 4; ++e) { x[2 * e] = __uint_as_float(a[r][0][e] << 16); x[2 * e + 1] = __uint_as_float(a[r][0][e] & 0xffff0000u); x[8 + 2 * e] = __uint_as_float(a[r][1][e] << 16); x[9 + 2 * e] = __uint_as_float(a[r][1][e] & 0xffff0000u); }
            float mx = 0.f;
#pragma unroll
            for (int e = 0; e < 16; ++e) mx = fmaxf(mx, fabsf(x[e]));
            { unsigned v = __float_as_uint(mx), o;
              o = (unsigned)__builtin_amdgcn_update_dpp(0, (int)v, 0xB1, 0xF, 0xF, true); v = o > v ? o : v;
              o = (unsigned)__builtin_amdgcn_update_dpp(0, (int)v, 0x4E, 0xF, 0xF, true); v = o > v ? o : v;
              o = (unsigned)__builtin_amdgcn_update_dpp(0, (int)v, 0x141, 0xF, 0xF, true); v = o > v ? o : v;
              o = (unsigned)__builtin_amdgcn_update_dpp(0, (int)v, 0x140, 0xF, 0xF, true); v = o > v ? o : v;
              const unsigned p0 = (unsigned)__builtin_amdgcn_readlane((int)v, 0), p1 = (unsigned)__builtin_amdgcn_readlane((int)v, 16), p2 = (unsigned)__builtin_amdgcn_readlane((int)v, 32), p3 = (unsigned)__builtin_amdgcn_readlane((int)v, 48);
              const unsigned q0 = p0 > p1 ? p0 : p1, q1 = p2 > p3 ? p2 : p3; mx = __uint_as_float(q0 > q1 ? q0 : q1); }
            const float iq = mx > 0.f ? 127.0f / mx : 0.f;
            unsigned w[4];
#pragma unroll
            for (int e = 0; e < 4; ++e) { const int q0 = (int)__builtin_rintf(x[4 * e] * iq), q1 = (int)__builtin_rintf(x[4 * e + 1] * iq), q2 = (int)__builtin_rintf(x[4 * e + 2] * iq), q3 = (int)__builtin_rintf(x[4 * e + 3] * iq);
                w[e] = (unsigned)(q0 & 0xff) | ((unsigned)(q1 & 0xff) << 8) | ((unsigned)(q2 & 0xff) << 16) | ((unsigned)(q3 & 0xff) << 24); }
            *(v2u*)(Q + (size_t)(m0 + r) * D + 8 * lane) = (v2u){w[0], w[1]};
            *(v2u*)(Q + (size_t)(m0 + r) * D + 512 + 8 * lane) = (v2u){w[2], w[3]};
            if (lane == 0) XS[m0 + r] = mx * (1.0f / 127.0f);
        }
    }
}
struct Frame {
    LAS unsigned char* lds;
    volatile LAS unsigned* MISC;
    gu32* ctl;
    int tid, lane, wave, vcu, G;
    const void* const* in;
    float* out; unsigned char* ws;
};
#define WSP(T, off) ((T*)(F.ws + (off)))

template <class Map> __device__ __forceinline__ void p0_transpose_item(const float* W, int K, int N, const float* gain, bf16* WT, LAS float* scr, int item, int lane, const Map map, unsigned char* WT8 = nullptr) {
    const int nblk = (N + 31) / 32, kb = item / nblk, nb = item % nblk, k0 = 64 * kb, n0 = 32 * nb;
    const bool nok = n0 + (lane & 31) < N;
    { float v[32], gn[32];
#pragma unroll
      for (int i = 0; i < 32; ++i) { const int kk = 2 * i + (lane >> 5); v[i] = nok ? __builtin_nontemporal_load(W + (size_t)(k0 + kk) * N + n0 + (lane & 31)) : 0.f; gn[i] = gain ? gain[k0 + kk] : 1.0f; }
#pragma unroll
      for (int i = 0; i < 32; ++i) { const int kk = 2 * i + (lane >> 5); scr[kk * 33 + (lane & 31)] = v[i] * gn[i]; } }
    LDS_WAIT(); asm volatile("" ::: "memory");
    const int c = lane & 7;
#pragma unroll
    for (int j = 0; j < 4; ++j) { const int n = (lane >> 3) + 8 * j; const LAS float* s = scr + (8 * c) * 33 + n;
        v4u o; o.x = pk2(s[0 * 33], s[1 * 33]); o.y = pk2(s[2 * 33], s[3 * 33]); o.z = pk2(s[4 * 33], s[5 * 33]); o.w = pk2(s[6 * 33], s[7 * 33]);
        if (n0 + n < N) { if (WT) *(GAS v4u*)(WT + (size_t)map(n0 + n) * K + k0 + 8 * c) = o;
            if (WT8) { v2u o8; o8.x = pk4_fp8(s[0 * 33] * W8SCALE, s[1 * 33] * W8SCALE, s[2 * 33] * W8SCALE, s[3 * 33] * W8SCALE); o8.y = pk4_fp8(s[4 * 33] * W8SCALE, s[5 * 33] * W8SCALE, s[6 * 33] * W8SCALE, s[7 * 33] * W8SCALE);
                *(GAS v2u*)(WT8 + (size_t)map(n0 + n) * K + k0 + 8 * c) = o8; } } }
    LDS_WAIT(); asm volatile("" ::: "memory");
}
__device__ __forceinline__ void sincos_d(double a, float& s, float& c) {
    const double TWO_PI = 6.283185307179586476925286766559, PI = 3.14159265358979323846264338327950288;
    double k = __builtin_rint(a / TWO_PI); double r = a - k * TWO_PI;
    double sgn = 1.0; if (r > PI * 0.5) { r = PI - r; sgn = -1.0; } else if (r < -PI * 0.5) { r = -PI - r; sgn = -1.0; }
    const double r2 = r * r;
    double ts = 1.0, tc = 1.0, ps = 1.0, pc = 1.0;
#pragma unroll
    for (int n = 1; n <= 12; ++n) { pc = -pc * r2 / (double)((2 * n - 1) * (2 * n)); ps = -ps * r2 / (double)((2 * n) * (2 * n + 1)); tc += pc; ts += ps; }
    s = (float)(r * ts); c = (float)(sgn * tc);
}
__device__ __forceinline__ void p0_prologue(Frame& F) {
    LAS float* scr = (LAS float*)(F.lds + RING_OFF + F.wave * 16384);
    const int gw = F.vcu * 8 + F.wave, NGW = F.G * 8;
    constexpr int I_G = (D / 64) * (DFF / 32), I_D = (DFF / 64) * (D / 32), I_IN = (D / 64) * ((NIN + 31) / 32), I_O = (D / 64) * (D / 32);
    constexpr int NITEMS = 2 * (2 * I_G + I_D) + I_IN + I_O;
    for (int rep63 = 0; rep63 < (PROBE_DUP == 63 ? 2 : 1); ++rep63)
    for (int it = gw; it < NITEMS; it += NGW) {
        int r = it;
        if (r < I_G) { p0_transpose_item(((const float*)F.in[8]), D, DFF, ((const float*)F.in[7]), WSP(bf16, WS_WGU1), scr, r, F.lane, MapGate()); continue; } r -= I_G;
        if (r < I_G) { p0_transpose_item(((const float*)F.in[9]), D, DFF, ((const float*)F.in[7]), WSP(bf16, WS_WGU1), scr, r, F.lane, MapUp()); continue; } r -= I_G;
        if (r < I_D) { p0_transpose_item(((const float*)F.in[10]), DFF, D, nullptr, (bf16*)nullptr, scr, r, F.lane, MapLin(), WSP(unsigned char, WS_WD1_8)); continue; } r -= I_D;
        if (r < I_G) { p0_transpose_item(((const float*)F.in[19]), D, DFF, ((const float*)F.in[18]), WSP(bf16, WS_WGU2), scr, r, F.lane, MapGate()); continue; } r -= I_G;
        if (r < I_G) { p0_transpose_item(((const float*)F.in[20]), D, DFF, ((const float*)F.in[18]), WSP(bf16, WS_WGU2), scr, r, F.lane, MapUp()); continue; } r -= I_G;
        if (r < I_D) { p0_transpose_item(((const float*)F.in[21]), DFF, D, nullptr, (bf16*)nullptr, scr, r, F.lane, MapLin(), WSP(unsigned char, WS_WD2_8)); continue; } r -= I_D;
        if (r < I_IN) { p0_transpose_item(((const float*)F.in[12]), D, NIN, ((const float*)F.in[11]), WSP(bf16, WS_WIN), scr, r, F.lane, MapWin()); continue; } r -= I_IN;
        p0_transpose_item(((const float*)F.in[17]), D, D, nullptr, WSP(bf16, WS_WOUT), scr, r, F.lane, MapLin());
    }
    float* SS0 = WSP(float, WS_SS0);
    for (int rep64 = 0; rep64 < (PROBE_DUP == 64 ? 2 : 1); ++rep64)
    for (int g4 = gw; g4 < MTOT / 4; g4 += NGW) {
        const int m0 = 4 * g4;
        const float* xrow = m0 < MP ? ((const float*)F.in[0]) + (size_t)m0 * D : ((const float*)F.in[1]) + (size_t)(m0 - MP) * D;
        const GAS f32x4* xr = (const GAS f32x4*)xrow + F.lane;
        f32x4 v[4][4]; float s[4];
#pragma unroll
        for (int r = 0; r < 4; ++r)
#pragma unroll
            for (int j = 0; j < 4; ++j) v[r][j] = __builtin_nontemporal_load((const f32x4*)(xr + 256 * r + 64 * j));
#pragma unroll
        for (int r = 0; r < 4; ++r) { s[r] = 0.f;
#pragma unroll
            for (int j = 0; j < 4; ++j) s[r] += (v[r][j].x * v[r][j].x + v[r][j].y * v[r][j].y) + (v[r][j].z * v[r][j].z + v[r][j].w * v[r][j].w); }
#pragma unroll
        for (int o = 1; o < 64; o <<= 1) {
#pragma unroll
            for (int r = 0; r < 4; ++r) s[r] += __shfl_xor(s[r], o); }
        { float mx[4];
#pragma unroll
          for (int r = 0; r < 4; ++r) { mx[r] = 0.f;
#pragma unroll
              for (int j = 0; j < 4; ++j) mx[r] = fmaxf(mx[r], fmaxf(fmaxf(fabsf(v[r][j].x), fabsf(v[r][j].y)), fmaxf(fabsf(v[r][j].z), fabsf(v[r][j].w)))); }
#pragma unroll
          for (int o = 1; o < 64; o <<= 1) {
#pragma unroll
              for (int r = 0; r < 4; ++r) mx[r] = fmaxf(mx[r], __shfl_xor(mx[r], o)); }
          GAS unsigned* q8 = (GAS unsigned*)(WSP(unsigned char, WS_XI8) + (size_t)m0 * D) + F.lane;
#pragma unroll
          for (int r = 0; r < 4; ++r) { const float iq = mx[r] > 0.f ? 127.0f / mx[r] : 0.f;
#pragma unroll
              for (int j = 0; j < 4; ++j) { const int a_ = (int)__builtin_rintf(v[r][j].x * iq), b_ = (int)__builtin_rintf(v[r][j].y * iq), c_ = (int)__builtin_rintf(v[r][j].z * iq), d_ = (int)__builtin_rintf(v[r][j].w * iq);
                  q8[256 * r + 64 * j] = (unsigned)(a_ & 0xff) | ((unsigned)(b_ & 0xff) << 8) | ((unsigned)(c_ & 0xff) << 16) | ((unsigned)(d_ & 0xff) << 24); } }
          if (F.lane < 4) WSP(float, WS_XS)[m0 + F.lane] = (F.lane == 0 ? mx[0] : F.lane == 1 ? mx[1] : F.lane == 2 ? mx[2] : mx[3]) * (1.0f / 127.0f); }
        if (F.lane < 4) SS0[m0 + F.lane] = F.lane == 0 ? s[0] : F.lane == 1 ? s[1] : F.lane == 2 ? s[2] : s[3];
    }
    { float* rope = WSP(float, WS_ROPE);
      const double invf[8] = {1.0, 0.19392274474868576, 0.03760603093086393, 0.007292664737217109, 0.001414213562373095, 0.0002742481756762073, 5.318295896944988e-05, 1.031338537721246e-05};
      for (int rep65 = 0; rep65 < (PROBE_DUP == 65 ? 2 : 1); ++rep65)
      for (int e = (F.vcu * 512 + F.tid); e < 2052 * 8; e += F.G * 512) { const int p = e >> 3, i = e & 7; const double pos = (double)(p < SEQ ? p : PAST + (p - SEQ));
          double f = invf[0];
#pragma unroll
          for (int q = 1; q < 8; ++q) f = (i == q) ? invf[q] : f;
          float s, c; sincos_d(pos * f, s, c); rope[2 * e] = c; rope[2 * e + 1] = s; } }
}

__device__ __forceinline__ void unpack8(const v4u a, float (&o)[8]) {
#pragma unroll
    for (int e = 0; e < 4; ++e) { o[2 * e] = bf2f((unsigned short)(a[e] & 0xffffu)); o[2 * e + 1] = bf2f((unsigned short)(a[e] >> 16)); }
}
__device__ __forceinline__ void p0b_quant_weights(Frame& F) {
    const int gw = F.vcu * 8 + F.wave, NGW = F.G * 8;
    for (int rr = gw; rr < 4 * DFF; rr += NGW) {
        const bool second = rr >= 2 * DFF; const int r = second ? rr - 2 * DFF : rr;
        const bf16* W = second ? WSP(bf16, WS_WGU2) : WSP(bf16, WS_WGU1); unsigned char* Q = second ? WSP(unsigned char, WS_WGU2I8) : WSP(unsigned char, WS_WGU1I8); float* WSN = second ? WSP(float, WS_WSN2) : WSP(float, WS_WSN);
        const v4u a = *(const GAS v4u*)(W + (size_t)r * D + 8 * F.lane), b = *(const GAS v4u*)(W + (size_t)r * D + 512 + 8 * F.lane);
        float x[16]; { float t0[8], t1[8]; unpack8(a, t0); unpack8(b, t1);
#pragma unroll
            for (int e = 0; e < 8; ++e) { x[e] = t0[e]; x[8 + e] = t1[e]; } }
        float mx = 0.f;
#pragma unroll
        for (int e = 0; e < 16; ++e) mx = fmaxf(mx, fabsf(x[e]));
#pragma unroll
        for (int o = 1; o < 64; o <<= 1) mx = fmaxf(mx, __shfl_xor(mx, o));
        const float iq = mx > 0.f ? 127.0f / mx : 0.f;
        unsigned w[4];
#pragma unroll
        for (int e = 0; e < 4; ++e) { const int q0 = (int)__builtin_rintf(x[4 * e] * iq), q1 = (int)__builtin_rintf(x[4 * e + 1] * iq), q2 = (int)__builtin_rintf(x[4 * e + 2] * iq), q3 = (int)__builtin_rintf(x[4 * e + 3] * iq);
            w[e] = (unsigned)(q0 & 0xff) | ((unsigned)(q1 & 0xff) << 8) | ((unsigned)(q2 & 0xff) << 16) | ((unsigned)(q3 & 0xff) << 24); }
        *(GAS v2u*)(Q + (size_t)r * D + 8 * F.lane) = (v2u){w[0], w[1]};
        *(GAS v2u*)(Q + (size_t)r * D + 512 + 8 * F.lane) = (v2u){w[2], w[3]};
        if (F.lane == 0) WSN[r] = mx * (1.0f / 127.0f);
    }
}
__device__ __forceinline__ void p4_conv(Frame& F) {
    const int gw = F.vcu * 8 + F.wave, NGW = F.G * 8, ch = F.lane * 8;
    const bf16* U = WSP(bf16, WS_U); const bf16* GBp = WSP(bf16, WS_GB); bf16* CAT = WSP(bf16, WS_CAT);
    const float* conv_w = (const float*)F.in[13]; const float* conv_b = (const float*)F.in[14]; const float* cache_conv = (const float*)F.in[5];
    float w0[8], w1[8], w2[8], cb[8];
#pragma unroll
    for (int e = 0; e < 8; ++e) { w0[e] = conv_w[ch + e]; w1[e] = conv_w[512 + ch + e]; w2[e] = conv_w[1024 + ch + e]; cb[e] = conv_b[ch + e]; }
    for (int c = gw; c < MTOT / 8; c += NGW) {
        const int r0 = 8 * c;
        v4u ur[10], gr[8];
#pragma unroll
        for (int e = 0; e < 10; ++e) { const int rr = r0 - 2 + e; ur[e] = *(const GAS v4u*)(U + (size_t)(rr < 0 ? 0 : rr) * 512 + ch); }
#pragma unroll
        for (int e = 0; e < 8; ++e) gr[e] = *(const GAS v4u*)(GBp + (size_t)(r0 + e) * 512 + ch);
        float um2[8], um1[8];
        unpack8(ur[0], um2); unpack8(ur[1], um1);
        if (r0 < MP && (r0 & (SEQ - 1)) == 0) {
#pragma unroll
            for (int e = 0; e < 8; ++e) { um2[e] = 0.f; um1[e] = 0.f; } }
#pragma unroll
        for (int e = 0; e < 8; ++e) {
            if (r0 >= MP && (e & 3) == 0) {
                const float* cc = cache_conv + (size_t)((r0 - MP + e) >> 2) * 2 * 512 + ch;
#pragma unroll
                for (int q = 0; q < 8; ++q) { um2[q] = cc[q]; um1[q] = cc[512 + q]; } }
            float u0[8], g[8], y[8]; unpack8(ur[2 + e], u0); unpack8(gr[e], g);
#pragma unroll
            for (int q = 0; q < 8; ++q) { y[q] = g[q] * (cb[q] + w0[q] * um2[q] + w1[q] * um1[q] + w2[q] * u0[q]); um2[q] = um1[q]; um1[q] = u0[q]; }
            v4u o; o.x = pk2(y[0], y[1]); o.y = pk2(y[2], y[3]); o.z = pk2(y[4], y[5]); o.w = pk2(y[6], y[7]);
            *(GAS v4u*)(CAT + (size_t)(r0 + e) * D + ch) = o;
        }
    }
}
__device__ __forceinline__ int crow16(int r, int hi) { return (r & 3) + 8 * (r >> 2) + 4 * hi; }
__device__ __forceinline__ float xhalf_sum(float v) {
    auto rr = __builtin_amdgcn_permlane32_swap(__float_as_uint(v), __float_as_uint(v), false, false);
    return __uint_as_float(rr[0]) + __uint_as_float(rr[1]);
}
__device__ __forceinline__ void p4_sample_scores(Frame& F) {
    const int gw = F.vcu * 8 + F.wave, NGW = F.G * 8, lane = F.lane, r32 = lane & 31, hi = lane >> 5;
    const bf16* QI = WSP(bf16, WS_QI); const float* WIp = WSP(float, WS_WI); float* SSC = WSP(float, WS_SSC);
    const int* page_table = (const int*)F.in[6]; const float* cache_idx_k = (const float*)F.in[4];
    for (int item = gw; item < DB * NPAGES; item += NGW) {
        const int b = item >> 7, pg = item & 127; const int page = page_table[b * NPAGES + pg];
        bf16x8 a[4]; f32x4 w4[4];
        { const bf16* qrow = QI + (size_t)(MP + 4 * b + (r32 >> 3)) * 512 + (r32 & 7) * 64 + 8 * hi;
#pragma unroll
          for (int s = 0; s < 4; ++s) a[s] = *(const GAS bf16x8*)(qrow + 16 * s);
#pragma unroll
          for (int q = 0; q < 4; ++q) w4[q] = *(const GAS f32x4*)(WIp + (size_t)(MP + 4 * b + q) * 8 + 4 * hi); }
        const float* src = cache_idx_k + ((size_t)page * PAGE + r32) * 64 + 8 * hi;
        f32x4 lo[4][4], hh[4][4];
#pragma unroll
        for (int sub = 0; sub < 4; ++sub)
#pragma unroll
            for (int s = 0; s < 4; ++s) { lo[sub][s] = __builtin_nontemporal_load((const f32x4*)(src + sub * 32 * 64 + 16 * s)); hh[sub][s] = __builtin_nontemporal_load((const f32x4*)(src + sub * 32 * 64 + 16 * s + 4)); }
#pragma unroll
        for (int sub = 0; sub < 4; ++sub) {
            f32x16 acc = {};
#pragma unroll
            for (int s = 0; s < 4; ++s) { v4u p; p.x = pk2(lo[sub][s][0], lo[sub][s][1]); p.y = pk2(lo[sub][s][2], lo[sub][s][3]); p.z = pk2(hh[sub][s][0], hh[sub][s][1]); p.w = pk2(hh[sub][s][2], hh[sub][s][3]);
                acc = __builtin_amdgcn_mfma_f32_32x32x16_bf16(a[s], __builtin_bit_cast(bf16x8, p), acc, 0, 0, 0); }
#pragma unroll
            for (int q = 0; q < 4; ++q) {
                float sum = w4[q][0] * fmaxf(acc[4 * q], 0.f) + w4[q][1] * fmaxf(acc[4 * q + 1], 0.f) + w4[q][2] * fmaxf(acc[4 * q + 2], 0.f) + w4[q][3] * fmaxf(acc[4 * q + 3], 0.f);
                sum = xhalf_sum(sum) + 0.0f;
                if ((q >> 1) == hi) SSC[(size_t)(4 * b + q) * SSTR + pg * PAGE + sub * 32 + r32] = sum;
            }
        }
    }
}
__device__ __forceinline__ unsigned fkey(float s) { const unsigned b = __builtin_bit_cast(unsigned, s); return b ^ ((unsigned)((int)b >> 31) | 0x80000000u); }
__device__ __forceinline__ float unfkey(unsigned k) { const unsigned b = (k & 0x80000000u) ? (k ^ 0x80000000u) : ~k; return __builtin_bit_cast(float, b); }
__device__ __forceinline__ unsigned wave_umax(unsigned v) {
    unsigned o;
    o = (unsigned)__builtin_amdgcn_update_dpp(0, (int)v, 0xB1, 0xF, 0xF, true); v = o > v ? o : v;
    o = (unsigned)__builtin_amdgcn_update_dpp(0, (int)v, 0x4E, 0xF, 0xF, true); v = o > v ? o : v;
    o = (unsigned)__builtin_amdgcn_update_dpp(0, (int)v, 0x141, 0xF, 0xF, true); v = o > v ? o : v;
    o = (unsigned)__builtin_amdgcn_update_dpp(0, (int)v, 0x140, 0xF, 0xF, true); v = o > v ? o : v;
    const unsigned a = (unsigned)__builtin_amdgcn_readlane((int)v, 0), b = (unsigned)__builtin_amdgcn_readlane((int)v, 16), c = (unsigned)__builtin_amdgcn_readlane((int)v, 32), d = (unsigned)__builtin_amdgcn_readlane((int)v, 48);
    const unsigned ab = a > b ? a : b, cd = c > d ? c : d; return ab > cd ? ab : cd;
}
__device__ __forceinline__ int wave_count(unsigned cl) {
    int tot = 0;
#pragma unroll
    for (int bb = 0; bb < 6; ++bb) tot += __popcll(__ballot((cl >> bb) & 1u)) << bb;
    return tot;
}
__device__ __forceinline__ void p4_index_preload(Frame& F, int b, int j, bf16x8 (&a)[4][4], float& pwq) {
    const int tid = F.tid, r32 = F.lane & 31, hi = F.lane >> 5; const size_t rowb = (size_t)b * SEQ; const int t0 = 16 * j;
    const bf16* QI = WSP(bf16, WS_QI); const float* WIp = WSP(float, WS_WI);
    pwq = WIp[(rowb + t0 + ((tid & 127) >> 3)) * 8 + (tid & 7)];
#pragma unroll
    for (int rt = 0; rt < 4; ++rt) { const bf16* qrow = QI + (rowb + t0 + 4 * rt + 2 * (r32 >> 4) + ((r32 >> 2) & 1)) * 512 + (4 * ((r32 >> 3) & 1) + (r32 & 3)) * 64 + 8 * hi;
#pragma unroll
        for (int s = 0; s < 4; ++s) a[rt][s] = *(const GAS bf16x8*)(qrow + 16 * s); }
}
__device__ __forceinline__ void p4_index_unit(Frame& F, int b, int j, int useq, bf16x8 (&a)[4][4], float& pwq, int nj) {
    int tid_ = F.tid; asm volatile("" : "+v"(tid_));
    const int tid = tid_, lane = tid & 63, wid = F.wave, r32 = lane & 31, hi = lane >> 5;
    const int ss_id = (F.vcu * 8 + useq) * 8 + wid, ss_item = ss_id >> 2, ss_sub = ss_id & 3, ss_b = ss_item >> 7, ss_pg = ss_item & 127;
    const bool ss_on = F.vcu < 256;
    const int ss_page = ss_on ? ((const int*)F.in[6])[ss_b * NPAGES + ss_pg] : 0;
    const int t0 = 16 * j, nk = t0 + 16, ntile = (nk + 31) >> 5;
    LAS float* S = (LAS float*)(F.lds + RING_OFF);
    LAS float* WQ = (LAS float*)(F.lds + RING_OFF + 131072);
    LAS unsigned long long* MSK = (LAS unsigned long long*)(F.lds + RING_OFF + 131072 + 512);
    LAS unsigned* HW = (LAS unsigned*)(F.lds + RING_OFF + 131072 + 512 + 4096) + wid * 512;
    const bf16* QI = WSP(bf16, WS_QI); const bf16* KIB = WSP(bf16, WS_KIB); const float* WIp = WSP(float, WS_WI);
    unsigned long long* MASK = WSP(unsigned long long, WS_MASK);
    const size_t rowb = (size_t)b * SEQ;
    for (int rep43 = 0; rep43 < (PROBE_DUP == 43 ? 2 : 1); ++rep43)
    if (j >= 16) {
        if (tid < 128) WQ[tid] = pwq;
        const bf16* kbase = KIB + (rowb + r32) * 64 + 8 * hi;
#define IDX_LOADB(dst, kt_) do { const int kc_ = (kt_) < ntile ? (kt_) : ntile - 1; _Pragma("unroll") for (int s = 0; s < 4; ++s) dst[s] = *(const GAS bf16x8*)(kbase + (size_t)kc_ * 32 * 64 + 16 * s); } while (0)
#define RELU_(x_) __builtin_amdgcn_fmed3f((x_), 0.f, inf_)
#define IDX_COMPUTE(bf_, kt_) do { const int key = (kt_) * 32 + r32; \
            _Pragma("unroll") for (int rt = 0; rt < 4; ++rt) { f32x16 acc = {}; \
                _Pragma("unroll") for (int s = 0; s < 4; ++s) acc = __builtin_amdgcn_mfma_f32_32x32x16_bf16(a[rt][s], bf_[s], acc, 0, 0, 0); \
                _Pragma("unroll") for (int qp = 0; qp < 2; ++qp) { const int ql_ = 4 * rt + 2 * qp + hi;                      \
                    const f32x4 wa = *(const LAS f32x4*)(WQ + ql_ * 8), wb = *(const LAS f32x4*)(WQ + ql_ * 8 + 4); \
                      \
                    float e0_ = RELU_(acc[8 * qp + 0]) * wa[0], e1_ = RELU_(acc[8 * qp + 1]) * wa[1]; \
                    e0_ = __builtin_fmaf(RELU_(acc[8 * qp + 2]), wa[2], e0_); e1_ = __builtin_fmaf(RELU_(acc[8 * qp + 3]), wa[3], e1_); \
                    e0_ = __builtin_fmaf(RELU_(acc[8 * qp + 4]), wb[0], e0_); e1_ = __builtin_fmaf(RELU_(acc[8 * qp + 5]), wb[1], e1_); \
                    e0_ = __builtin_fmaf(RELU_(acc[8 * qp + 6]), wb[2], e0_); e1_ = __builtin_fmaf(RELU_(acc[8 * qp + 7]), wb[3], e1_); \
                    S[ql_ * 2048 + key] = (e0_ + e1_) + 0.0f; } } } while (0)
        float inf_ = __builtin_inff(); asm volatile("" : "+v"(inf_));
        bf16x8 bfA[4], bfB[4];
        IDX_LOADB(bfA, wid);
        __syncthreads();
        for (int kt = wid; kt < ntile; kt += 16) {
            IDX_LOADB(bfB, kt + 8);
            IDX_COMPUTE(bfA, kt);
            if (kt + 8 < ntile) { IDX_LOADB(bfA, kt + 16); IDX_COMPUTE(bfB, kt + 8); }
        }
#undef IDX_LOADB
#undef IDX_COMPUTE
#undef RELU_
        __syncthreads();
    }
    f32x4 ss_lo[4], ss_hh[4];
    { const float* src = ((const float*)F.in[4]) + ((size_t)ss_page * PAGE + ss_sub * 32 + r32) * 64 + 8 * hi;
#pragma unroll
      for (int s = 0; s < 4; ++s) { ss_lo[s] = __builtin_nontemporal_load((const f32x4*)(src + 16 * s)); ss_hh[s] = __builtin_nontemporal_load((const f32x4*)(src + 16 * s + 4)); }
    }
#pragma unroll 1
    for (int rep44 = 0; rep44 < (PROBE_DUP == 44 ? 2 : 1); ++rep44) {
        const int qlA = 2 * wid, tA = t0 + qlA, tB = tA + 1;
        unsigned wloA = 0u, whiA = 0u, wloB = 0u, whiB = 0u;
        if (tA < KTOP) {
            const int lo_ = 64 * lane;
            const unsigned long long wA_ = (lo_ + 63 <= tA) ? ~0ull : (lo_ > tA ? 0ull : ((1ull << (tA - lo_ + 1)) - 1ull)), wB_ = (lo_ + 63 <= tB) ? ~0ull : (lo_ > tB ? 0ull : ((1ull << (tB - lo_ + 1)) - 1ull));
            wloA = (unsigned)wA_; whiA = (unsigned)(wA_ >> 32); wloB = (unsigned)wB_; whiB = (unsigned)(wB_ >> 32);
        } else {
            bool doneA = false, doneB = false;
            { unsigned kvA[32], kvB[32]; float amA = 0.f, amB = 0.f;
              const int ngr = (tA >> 8) + 1;
#pragma unroll
              for (int g4 = 0; g4 < 8; ++g4) {
#pragma unroll
                  for (int e = 0; e < 4; ++e) { kvA[4 * g4 + e] = 0u; kvB[4 * g4 + e] = 0u; }
                  if (g4 < ngr) {
                      float sA[4], sB[4];
#pragma unroll
                      for (int e = 0; e < 4; ++e) { sA[e] = S[qlA * 2048 + lane + 64 * (4 * g4 + e)]; sB[e] = S[qlA * 2048 + 2048 + lane + 64 * (4 * g4 + e)]; }
                      if (g4 == ngr - 1) {
#pragma unroll
                          for (int e = 0; e < 4; ++e) { const int ki = lane + 64 * (4 * g4 + e); sA[e] = (ki <= tA) ? sA[e] : 0.f; sB[e] = (ki <= tB) ? sB[e] : 0.f; } }
#pragma unroll
                      for (int e = 0; e < 4; ++e) { kvA[4 * g4 + e] = __float_as_uint(sA[e]); amA = fmaxf(amA, fabsf(sA[e])); kvB[4 * g4 + e] = __float_as_uint(sB[e]); amB = fmaxf(amB, fabsf(sB[e])); } } }
              const unsigned umA = wave_umax(__float_as_uint(amA)), umB = wave_umax(__float_as_uint(amB));
              const float scaleA = umA ? 0.4999f / __uint_as_float(umA) : 0.f, scaleB = umB ? 0.4999f / __uint_as_float(umB) : 0.f;
#pragma unroll
              for (int g4 = 0; g4 < 8; ++g4) if (g4 < ngr) {
#pragma unroll
                  for (int e = 0; e < 4; ++e) { const int jj = 4 * g4 + e; kvA[jj] = __float_as_uint(__builtin_fmaf(__uint_as_float(kvA[jj]), scaleA, 1.5f)); kvB[jj] = __float_as_uint(__builtin_fmaf(__uint_as_float(kvB[jj]), scaleB, 1.5f)); }
                  if (g4 == ngr - 1) {
#pragma unroll
                      for (int e = 0; e < 4; ++e) { const int jj = 4 * g4 + e; kvA[jj] = (lane + 64 * jj <= tA) ? kvA[jj] : 0u; kvB[jj] = (lane + 64 * jj <= tB) ? kvB[jj] : 0u; } } }
              unsigned pfxA = 0x3F800000u, pfxB = 0x3F800000u, TvA = 0u, TvB = 0u; int needA = KTOP, needB = KTOP;
              const unsigned hwbA = (unsigned)(uintptr_t)HW, hwbB = hwbA + 1024u;
              LAS unsigned* HWB = HW + 256;
#pragma unroll 1
              for (int pass = 0; pass < 3; ++pass) {
                  const int sh = pass == 0 ? 15 : pass == 1 ? 7 : 0;
                  const unsigned lim = pass == 2 ? 128u : (256u << sh);
                  const unsigned limA = doneA ? 0u : lim, limB = doneB ? 0u : lim;
                  *(LAS v4u*)(HW + 4 * lane) = (v4u){0u, 0u, 0u, 0u}; *(LAS v4u*)(HWB + 4 * lane) = (v4u){0u, 0u, 0u, 0u};
                  asm volatile("" ::: "memory");
#pragma unroll
                  for (int g4 = 0; g4 < 8; ++g4) if (g4 < ngr) {
#pragma unroll
                      for (int e = 0; e < 4; ++e) { const unsigned dA_ = kvA[4 * g4 + e] ^ pfxA, dB_ = kvB[4 * g4 + e] ^ pfxB;
                          if (dA_ < limA) __hip_atomic_fetch_add((LAS unsigned*)(uintptr_t)(hwbA + ((dA_ >> sh) << 2)), 1u, __ATOMIC_RELAXED, __HIP_MEMORY_SCOPE_WAVEFRONT);
                          if (dB_ < limB) __hip_atomic_fetch_add((LAS unsigned*)(uintptr_t)(hwbB + ((dB_ >> sh) << 2)), 1u, __ATOMIC_RELAXED, __HIP_MEMORY_SCOPE_WAVEFRONT); } }
                  asm volatile("" ::: "memory");
                  const v4u wA4 = *(const LAS v4u*)(HW + 4 * lane), wB4 = *(const LAS v4u*)(HWB + 4 * lane);
                  asm volatile("" ::: "memory");
#define SEL_SCAN(w4_, need_, HWX_, dgb_, above_, binc_) do { \
                      const unsigned ls_ = (w4_[0] + w4_[1]) + (w4_[2] + w4_[3]); unsigned p_ = ls_; \
                      p_ += (unsigned)__builtin_amdgcn_update_dpp(0, (int)p_, 0x111, 0xF, 0xF, false); p_ += (unsigned)__builtin_amdgcn_update_dpp(0, (int)p_, 0x112, 0xF, 0xF, false); \
                      p_ += (unsigned)__builtin_amdgcn_update_dpp(0, (int)p_, 0x114, 0xF, 0xF, false); p_ += (unsigned)__builtin_amdgcn_update_dpp(0, (int)p_, 0x118, 0xF, 0xF, false); \
                      const unsigned r0_ = (unsigned)__builtin_amdgcn_readlane((int)p_, 15), r1_ = (unsigned)__builtin_amdgcn_readlane((int)p_, 31), r2_ = (unsigned)__builtin_amdgcn_readlane((int)p_, 47), r3_ = (unsigned)__builtin_amdgcn_readlane((int)p_, 63); \
                      const int row_ = lane >> 4; p_ += (row_ == 0) ? 0u : (row_ == 1) ? r0_ : (row_ == 2) ? r0_ + r1_ : r0_ + r1_ + r2_; \
                      const unsigned abl_ = (r0_ + r1_ + r2_ + r3_) - p_;                                    \
                      const unsigned long long fm_ = __ballot((int)abl_ < (need_) && (int)(abl_ + ls_) >= (need_)); \
                      const int src_ = (int)__builtin_ctzll(fm_) & 63; \
                      const unsigned abs_ = (unsigned)__builtin_amdgcn_readlane((int)abl_, src_); \
                      const unsigned ci_ = ((lane & 15) < 4) ? (HWX_)[4 * src_ + (lane & 3)] : 0u;          \
                      unsigned sfx_ = ci_; \
                      sfx_ += (unsigned)__builtin_amdgcn_update_dpp(0, (int)sfx_, 0x101, 0xF, 0xF, false); sfx_ += (unsigned)__builtin_amdgcn_update_dpp(0, (int)sfx_, 0x102, 0xF, 0xF, false); \
                      const unsigned abi_ = abs_ + sfx_ - ci_;                                                \
                      const unsigned long long fb_ = __ballot(lane < 4 && (int)abi_ < (need_) && (int)(abi_ + ci_) >= (need_)); \
                      const int sl2_ = (int)__builtin_ctzll(fb_) & 63; \
                      dgb_ = (unsigned)(4 * src_ + sl2_); above_ = (unsigned)__builtin_amdgcn_readlane((int)abi_, sl2_); binc_ = (unsigned)__builtin_amdgcn_readlane((int)ci_, sl2_); } while (0)
                  unsigned dgA, abvA, bcA, dgB, abvB, bcB;
                  SEL_SCAN(wA4, needA, HW, dgA, abvA, bcA);
                  SEL_SCAN(wB4, needB, HWB, dgB, abvB, bcB);
#undef SEL_SCAN
                  if (!doneA) { pfxA |= dgA << sh; needA -= (int)abvA; TvA = pfxA; doneA = ((int)bcA == needA); }
                  if (!doneB) { pfxB |= dgB << sh; needB -= (int)abvB; TvB = pfxB; doneB = ((int)bcB == needB); }
                  if (doneA && doneB) break;
              }
#define SEL_MASK(kv_, Tv_, wlo_, whi_) do { _Pragma("unroll") for (int j4 = 0; j4 < 8; ++j4) if (j4 < ngr) { \
                      const unsigned long long wa = __ballot(kv_[4 * j4] >= Tv_), wb = __ballot(kv_[4 * j4 + 1] >= Tv_), wc_ = __ballot(kv_[4 * j4 + 2] >= Tv_), wd = __ballot(kv_[4 * j4 + 3] >= Tv_); \
                      asm("s_nop 1\n\tv_writelane_b32 %0, %2, %10\n\tv_writelane_b32 %1, %3, %10\n\tv_writelane_b32 %0, %4, %11\n\tv_writelane_b32 %1, %5, %11\n\tv_writelane_b32 %0, %6, %12\n\tv_writelane_b32 %1, %7, %12\n\tv_writelane_b32 %0, %8, %13\n\tv_writelane_b32 %1, %9, %13" \
                          : "+v"(wlo_), "+v"(whi_) : "s"((unsigned)wa), "s"((unsigned)(wa >> 32)), "s"((unsigned)wb), "s"((unsigned)(wb >> 32)), "s"((unsigned)wc_), "s"((unsigned)(wc_ >> 32)), "s"((unsigned)wd), "s"((unsigned)(wd >> 32)), \
                            "n"(4 * j4), "n"(4 * j4 + 1), "n"(4 * j4 + 2), "n"(4 * j4 + 3)); } } while (0)
              if (doneA) SEL_MASK(kvA, TvA, wloA, whiA);
              if (doneB) SEL_MASK(kvB, TvB, wloB, whiB);
#undef SEL_MASK
            }
#pragma unroll 1
            for (int q2 = 0; q2 < 2; ++q2) {
            if (q2 == 0 ? doneA : doneB) continue;
            const int ql = qlA + q2, t = tA + q2; unsigned wlo = 0u, whi = 0u;
            unsigned uu[32];
#pragma unroll
            for (int jj = 0; jj < 32; ++jj) { const float s = S[ql * 2048 + lane + 64 * jj]; const unsigned k_ = fkey(s); uu[jj] = (lane + 64 * jj <= t) ? k_ : 0u; }
            const int ng = (t >> 8) + 1;
#define SEL_GRP(g4, CAND) if ((g4) < ng) { unsigned long long m0_, m1_, m2_, m3_; \
                    asm volatile("v_cmp_ge_u32_e64 %0, %4, %8\n\tv_cmp_ge_u32_e64 %1, %5, %8\n\tv_cmp_ge_u32_e64 %2, %6, %8\n\tv_cmp_ge_u32_e64 %3, %7, %8" \
                        : "=&s"(m0_), "=&s"(m1_), "=&s"(m2_), "=&s"(m3_) : "v"(uu[4 * (g4)]), "v"(uu[4 * (g4) + 1]), "v"(uu[4 * (g4) + 2]), "v"(uu[4 * (g4) + 3]), "v"(CAND)); \
                    cnt_ += __popcll(m0_) + __popcll(m1_) + __popcll(m2_) + __popcll(m3_); }
#define SEL_COUNT(CAND, OUT) do { int cnt_ = 0; SEL_GRP(0, CAND) SEL_GRP(1, CAND) SEL_GRP(2, CAND) SEL_GRP(3, CAND) SEL_GRP(4, CAND) SEL_GRP(5, CAND) SEL_GRP(6, CAND) SEL_GRP(7, CAND) OUT = cnt_; } while (0)
            unsigned T = 0u; int clo = t + 1;
#pragma unroll 1
            for (int bit = 31; bit >= 0; --bit) {
                const unsigned cand = T | (1u << bit); int c; SEL_COUNT(cand, c);
                if (c >= KTOP) { T = cand; clo = c; if (c == KTOP) break; }
            }
            if (clo == KTOP) {
#pragma unroll
                for (int jj = 0; jj < 32; ++jj) { const unsigned long long word = __ballot(uu[jj] >= T);
                    asm("s_nop 1\n\tv_writelane_b32 %0, %2, %4\n\tv_writelane_b32 %1, %3, %4" : "+v"(wlo), "+v"(whi) : "s"((unsigned)word), "s"((unsigned)(word >> 32)), "n"(jj));     }
            } else {
                int cgt; { const unsigned Tp = T + 1u; SEL_COUNT(Tp, cgt); }
                const int need = KTOP - cgt; int running = 0;
#pragma unroll
                for (int jj = 0; jj < 32; ++jj) {
                    const unsigned long long eq = __ballot(uu[jj] == T);
                    const int rank = (int)__builtin_amdgcn_mbcnt_hi((unsigned)(eq >> 32), __builtin_amdgcn_mbcnt_lo((unsigned)eq, 0u));
                    const unsigned long long word = __ballot(uu[jj] > T || (uu[jj] == T && running + rank < need));
                    asm("s_nop 1\n\tv_writelane_b32 %0, %2, %4\n\tv_writelane_b32 %1, %3, %4" : "+v"(wlo), "+v"(whi) : "s"((unsigned)word), "s"((unsigned)(word >> 32)), "n"(jj));
                    running += __popcll(eq);
                }
            }
            if (q2 == 0) { wloA = wlo; whiA = whi; } else { wloB = wlo; whiB = whi; }
            }
#undef SEL_COUNT
#undef SEL_GRP
        }
        if (lane < 32) { MSK[qlA * 32 + lane] = ((unsigned long long)whiA << 32) | wloA; MSK[qlA * 32 + 32 + lane] = ((unsigned long long)whiB << 32) | wloB; }
    }
    bf16x8 ss_a[4]; f32x4 ss_w[4];
    { const bf16* qrow = QI + (size_t)(MP + 4 * ss_b + (r32 >> 3)) * 512 + (r32 & 7) * 64 + 8 * hi;
#pragma unroll
      for (int s = 0; s < 4; ++s) ss_a[s] = *(const GAS bf16x8*)(qrow + 16 * s);
#pragma unroll
      for (int q = 0; q < 4; ++q) ss_w[q] = *(const GAS f32x4*)(WIp + (size_t)(MP + 4 * ss_b + q) * 8 + 4 * hi); }
    if (nj >= 16) p4_index_preload(F, b, nj, a, pwq);
    if (ss_on) { f32x16 acc = {};
#pragma unroll
        for (int s = 0; s < 4; ++s) { v4u p; p.x = pk2(ss_lo[s][0], ss_lo[s][1]); p.y = pk2(ss_lo[s][2], ss_lo[s][3]); p.z = pk2(ss_hh[s][0], ss_hh[s][1]); p.w = pk2(ss_hh[s][2], ss_hh[s][3]);
            acc = __builtin_amdgcn_mfma_f32_32x32x16_bf16(ss_a[s], __builtin_bit_cast(bf16x8, p), acc, 0, 0, 0); }
        float* SSC = WSP(float, WS_SSC);
#pragma unroll
        for (int q = 0; q < 4; ++q) {
            float sum = ss_w[q][0] * fmaxf(acc[4 * q], 0.f) + ss_w[q][1] * fmaxf(acc[4 * q + 1], 0.f) + ss_w[q][2] * fmaxf(acc[4 * q + 2], 0.f) + ss_w[q][3] * fmaxf(acc[4 * q + 3], 0.f);
            sum = xhalf_sum(sum) + 0.0f;
            if ((q >> 1) == hi) SSC[(size_t)(4 * ss_b + q) * SSTR + ss_pg * PAGE + ss_sub * 32 + r32] = sum;
        } }
    __syncthreads();
    { const int jt = tid >> 4, ql = tid & 15; MASK[((size_t)b * 32 + jt) * SEQ + t0 + ql] = MSK[ql * 32 + jt]; }
    __syncthreads();
}
__device__ __forceinline__ void p4_index(Frame& F) {
    if (F.vcu >= 256) return;
    const int b = F.vcu >> 4, w = F.vcu & 15;
    bf16x8 pa[4][4]; float pwq;
    p4_index_preload(F, b, 127 - w, pa, pwq);
#pragma unroll 1
    for (int k = 0; k < 4; ++k) { const int j1 = w + 16 * k; p4_index_unit(F, b, 127 - j1, 2 * k, pa, pwq, j1); p4_index_unit(F, b, j1, 2 * k + 1, pa, pwq, k < 3 ? 127 - (j1 + 16) : -1); }
}

__device__ __forceinline__ int block_sum8(LAS int* red, int par, int wid, int lane, int v) {
    if (lane == 0) red[par * 8 + wid] = v;
    __syncthreads();
    int s = 0;
#pragma unroll
    for (int w = 0; w < 8; ++w) s += red[par * 8 + w];
    return s;
}
__device__ __forceinline__ void p5_sample_unit(Frame& F, int sq) {
    const int tid = F.tid, lane = F.lane, wid = F.wave;
    const int b = sq >> 2, qi_ = sq & 3, row = MP + sq;
    LAS unsigned char* L0 = F.lds + RING_OFF;
    LAS int* red = (LAS int*)(L0);
    LAS float* newsc = (LAS float*)(L0 + 64);
    LAS int* wcnt = (LAS int*)(L0 + 128);
    LAS int* eqw = (LAS int*)(L0 + 256);
    LAS int* selidx = (LAS int*)(L0 + 2048);
    LAS float* LG = (LAS float*)(L0 + 4096);
    LAS float* OP = (LAS float*)(L0 + 16384);
    const bf16* QI = WSP(bf16, WS_QI); const bf16* KIB = WSP(bf16, WS_KIB); const float* WIp = WSP(float, WS_WI); const float* SSC = WSP(float, WS_SSC);
    const bf16* Qb = WSP(bf16, WS_Q); bf16* CAT = WSP(bf16, WS_CAT);
    if (tid < 64) {
        const int h = (tid >> 2) & 7, jn = tid & 3; float dot = 0.f;
        const bf16* qp = QI + (size_t)row * 512 + h * 64; const bf16* kp = KIB + (size_t)(MP + 4 * b + jn) * 64;
        for (int d = 0; d < 64; ++d) dot += bf2f(qp[d]) * bf2f(kp[d]);
        float v = WIp[(size_t)row * 8 + h] * fmaxf(dot, 0.f);
        v += __shfl_xor(v, 4); v += __shfl_xor(v, 8); v += __shfl_xor(v, 16);
        if (tid < 4) newsc[tid] = (jn <= qi_) ? (v + 0.0f) : -INFINITY;
    }
    __syncthreads();
    unsigned uu[33];
#pragma unroll
    for (int jj = 0; jj < 32; ++jj) uu[jj] = fkey(SSC[(size_t)sq * SSTR + tid + 512 * jj]);
    uu[32] = tid < 4 ? fkey(newsc[tid]) : 0x007FFFFFu;
    unsigned T = 0u; int par = 0;
#pragma unroll 1
    for (int bit = 31; bit >= 0; --bit) {
        const unsigned cand = T | (1u << bit); int c = 0;
#pragma unroll
        for (int jj = 0; jj < 33; ++jj) c += __popcll(__ballot(uu[jj] >= cand));
        c = block_sum8(red, par, wid, lane, c); par ^= 1;
        if (c >= KTOP) { T = cand; if (c == KTOP) break; }
    }
    int cgt = 0;
#pragma unroll
    for (int jj = 0; jj < 33; ++jj) cgt += __popcll(__ballot(uu[jj] > T));
    cgt = block_sum8(red, par, wid, lane, cgt); par ^= 1;
    const int need = KTOP - cgt;
#pragma unroll
    for (int jj = 0; jj < 33; ++jj) { const int n = __popcll(__ballot(uu[jj] == T)); if (lane == 0) eqw[jj * 8 + wid] = n; }
    __syncthreads();
#define SEL_MASK(jj, eqbase, M) do { int below_ = 0, tot_ = 0; \
        _Pragma("unroll") for (int w = 0; w < 8; ++w) { const int n_ = eqw[(jj) * 8 + w]; tot_ += n_; below_ += (w < wid) ? n_ : 0; } \
        const unsigned long long eq_ = __ballot(uu[jj] == T); \
        const int rank_ = (eqbase) + below_ + (int)__builtin_amdgcn_mbcnt_hi((unsigned)(eq_ >> 32), __builtin_amdgcn_mbcnt_lo((unsigned)eq_, 0u)); \
        M = __ballot(uu[jj] > T || (uu[jj] == T && rank_ < need)); (eqbase) += tot_; } while (0)
    { int cw = 0, eqbase = 0;
#pragma unroll
      for (int jj = 0; jj < 33; ++jj) { unsigned long long m; SEL_MASK(jj, eqbase, m); cw += __popcll(m); }
      if (lane == 0) wcnt[wid] = cw; }
    __syncthreads();
    { int base = 0, eqbase = 0;
#pragma unroll
      for (int w = 0; w < 8; ++w) base += (w < wid) ? wcnt[w] : 0;
#pragma unroll
      for (int jj = 0; jj < 33; ++jj) { unsigned long long m; SEL_MASK(jj, eqbase, m);
          const int pos = base + (int)__builtin_amdgcn_mbcnt_hi((unsigned)(m >> 32), __builtin_amdgcn_mbcnt_lo((unsigned)m, 0u));
          if ((m >> lane) & 1ull) { if (pos < KTOP) selidx[pos] = (jj < 32) ? tid + 512 * jj : PAST + tid; }
          base += __popcll(m); } }
#undef SEL_MASK
    __syncthreads();
    const int kk = lane >> 3, ds = lane & 7;
    const float* kptr[4]; const float* vptr[4];
#pragma unroll
    for (int it = 0; it < 4; ++it) {
        const int kidx = selidx[32 * wid + 8 * it + kk];
        if (kidx < PAST) { const size_t pr = (size_t)((const int*)F.in[6])[b * NPAGES + (kidx >> 7)] * PAGE + (kidx & 127); kptr[it] = ((const float*)F.in[2]) + pr * 128 + 8 * ds; vptr[it] = ((const float*)F.in[3]) + pr * 128 + 8 * ds; }
        else { const size_t nr = (size_t)(4 * b + (kidx - PAST)); kptr[it] = F.out + O_KS + nr * 128 + 8 * ds; vptr[it] = F.out + O_VS + nr * 128 + 8 * ds; }
    }
#pragma unroll 1
    for (int g = 0; g < 2; ++g) {
        float qv[4][8];
#pragma unroll
        for (int r = 0; r < 4; ++r) { const v4u qq = *(const GAS v4u*)(Qb + (size_t)row * 512 + (4 * g + r) * 64 + 8 * ds);
#pragma unroll
            for (int e = 0; e < 4; ++e) { qv[r][2 * e] = bf2f((unsigned short)(qq[e] & 0xffffu)); qv[r][2 * e + 1] = bf2f((unsigned short)(qq[e] >> 16)); } }
#pragma unroll
        for (int it = 0; it < 4; ++it) {
            const f32x4 k0 = *(const f32x4*)(kptr[it] + 64 * g), k1 = *(const f32x4*)(kptr[it] + 64 * g + 4);
#pragma unroll
            for (int r = 0; r < 4; ++r) {
                float d = (qv[r][0] * k0[0] + qv[r][1] * k0[1]) + (qv[r][2] * k0[2] + qv[r][3] * k0[3]) + (qv[r][4] * k1[0] + qv[r][5] * k1[1]) + (qv[r][6] * k1[2] + qv[r][7] * k1[3]);
                d += __shfl_xor(d, 1); d += __shfl_xor(d, 2); d += __shfl_xor(d, 4);
                if (ds == 0) LG[(4 * g + r) * 256 + 32 * wid + 8 * it + kk] = d;
            }
        }
    }
    __syncthreads();
    { float l[4];
#pragma unroll
      for (int e = 0; e < 4; ++e) l[e] = LG[wid * 256 + lane + 64 * e];
      const float m = wave_max(fmaxf(fmaxf(l[0], l[1]), fmaxf(l[2], l[3])));
      float p[4], s = 0.f;
#pragma unroll
      for (int e = 0; e < 4; ++e) { p[e] = __builtin_amdgcn_exp2f(l[e] - m); s += p[e]; }
      s = wave_sum(s); const float inv = 1.0f / s;
#pragma unroll
      for (int e = 0; e < 4; ++e) LG[wid * 256 + lane + 64 * e] = p[e] * inv; }
    __syncthreads();
#pragma unroll 1
    for (int g = 0; g < 2; ++g) {
        float acc[4][8];
#pragma unroll
        for (int r = 0; r < 4; ++r)
#pragma unroll
            for (int e = 0; e < 8; ++e) acc[r][e] = 0.f;
#pragma unroll
        for (int it = 0; it < 4; ++it) {
            const f32x4 v0 = *(const f32x4*)(vptr[it] + 64 * g), v1 = *(const f32x4*)(vptr[it] + 64 * g + 4);
#pragma unroll
            for (int r = 0; r < 4; ++r) { const float p = LG[(4 * g + r) * 256 + 32 * wid + 8 * it + kk];
#pragma unroll
                for (int e = 0; e < 4; ++e) { acc[r][e] += p * v0[e]; acc[r][4 + e] += p * v1[e]; } }
        }
#pragma unroll
        for (int r = 0; r < 4; ++r)
#pragma unroll
            for (int e = 0; e < 8; ++e) { float a = acc[r][e]; a += __shfl_xor(a, 8); a += __shfl_xor(a, 16); a += __shfl_xor(a, 32); if (kk == 0) OP[(wid * 8 + 4 * g + r) * 64 + 8 * ds + e] = a; }
    }
    __syncthreads();
    { const int hd = tid >> 6, d = tid & 63; float o = 0.f;
#pragma unroll
      for (int w = 0; w < 8; ++w) o += OP[(w * 8 + hd) * 64 + d];
      CAT[(size_t)row * D + 512 + hd * 64 + d] = (bf16)f2bf(o); }
    __syncthreads();
}

constexpr int N_PHASES = 9;
struct Args { const void* in[22]; float* out; unsigned char* ws; int ph_lo, ph_hi, use_bar, pad; };
__global__ void __launch_bounds__(512, 2) hymba_fwd(Args args) {
    extern __shared__ __attribute__((aligned(16))) unsigned char lds[];
    Frame F;
    F.lds = (LAS unsigned char*)lds;
    F.MISC = (volatile LAS unsigned*)(F.lds + MISC_OFF);
    F.tid = threadIdx.x; F.lane = F.tid & 63; F.wave = __builtin_amdgcn_readfirstlane(F.tid >> 6);
    F.G = gridDim.x; { const int bx = blockIdx.x; F.vcu = (F.G % 8 == 0) ? (bx % 8) * (F.G / 8) + bx / 8 : bx; }
    F.ws = args.ws; F.out = args.out; F.ctl = (gu32*)(args.ws + WS_CTL);
    F.in = args.in;
    for (int u = F.tid; u < (LDS_BYTES - LDSCTL_OFF) / 4; u += 512) ((LAS unsigned*)(F.lds + LDSCTL_OFF))[u] = 0u;
    __syncthreads();
    XcdBarrier bar; bar.bar = (unsigned*)(F.ctl + CW_BAR); bar.x = 0; bar.st = nullptr;
    if (args.use_bar) bar = xcd_barrier_post((unsigned*)(F.ctl + CW_BAR), F.MISC + 8);
    const int lo = args.ph_lo, hi = args.ph_hi;
#define IN(k) (lo <= (k) && (k) < hi)
#define SEAM(k) do { if (IN(k) && IN((k) + 1)) { xcd_barrier(bar); if (PROBE_DUP == 60) xcd_barrier(bar); } } while (0)
    const int cblk = (int)blockIdx.x;

#ifndef PROBE_DUP
#define PROBE_DUP (-1)
#endif
#define RUNPHASE(k, ...) do { if (IN(k)) { { int t_ = F.tid; asm volatile("" : "+v"(t_)); F.tid = t_; F.lane = t_ & 63; }     \
        __VA_ARGS__; if (PROBE_DUP == (k)) { if (args.use_bar) xcd_barrier(bar); __VA_ARGS__; } } SEAM(k); } while (0)
#define RSTAB ((LAS float*)(F.lds + RING_OFF + 131072))
#define GEMM_PHASE(EPI, A_, B_, N_, K_, SS_, NSLOT_, ...) do { pg8::Gemm g{A_, B_, MP, N_, K_}; pg8::StaticOrder S; S.init(MP, N_, F.G, cblk); \
        if ((NSLOT_) > 0) fill_rstd_table(RSTAB, S, SS_, NSLOT_); \
        EPI E{__VA_ARGS__}; \
        pg8::gemm_phase<EPI, pg8::StaticOrder, true, true>(F.lds + RING_OFF, g, S, E); \
        { int nrep_ = (PROBE_DUP == 50) ? 2 : 1; asm volatile("" : "+s"(nrep_)); for (int rep_ = 0; rep_ < nrep_; ++rep_) skinny_phase<EPI, 2, 0>(F.lds + RING_OFF, A_, B_, N_, (K_) * 2, cblk, F.G, E); } } while (0)
#define GEMM_PHASE8(EPI, A8_, B8_, OSC_, N_, K_, SS_, NSLOT_, ...) do { pg8::Gemm g{(const bf16*)(A8_), (const bf16*)(B8_), MP, N_, (K_) / 2}; pg8::StaticOrder S; S.init(MP, N_, F.G, cblk); \
        if ((NSLOT_) > 0) fill_rstd_table(RSTAB, S, SS_, NSLOT_); \
        EPI E{__VA_ARGS__}; \
        pg8::gemm_phase<EPI, pg8::StaticOrder, true, true, 1>(F.lds + RING_OFF, g, S, E); \
        { int nrep_ = (PROBE_DUP == 55) ? 2 : 1; asm volatile("" : "+s"(nrep_)); for (int rep_ = 0; rep_ < nrep_; ++rep_) skinny_phase<EPI, 2, 1>(F.lds + RING_OFF, A8_, B8_, N_, K_, cblk, F.G, E, nullptr, nullptr, OSC_); } } while (0)
#define GEMM_PHASEI(EPI, A8_, B8_, XS_, WSN_, N_, K_, SS_, NSLOT_, ...) do { pg8::Gemm g{(const bf16*)(A8_), (const bf16*)(B8_), MP, N_, (K_) / 2}; pg8::StaticOrder S; S.init(MP, N_, F.G, cblk); \
        fill_rstd_table(RSTAB, S, SS_, NSLOT_, XS_); \
        EPI E{__VA_ARGS__}; \
        pg8::gemm_phase<EPI, pg8::StaticOrder, true, true, 2>(F.lds + RING_OFF, g, S, E); \
        { int nrep_ = (PROBE_DUP == 55) ? 2 : 1; asm volatile("" : "+s"(nrep_)); for (int rep_ = 0; rep_ < nrep_; ++rep_) skinny_phase<EPI, 4, 2>(F.lds + RING_OFF, A8_, B8_, N_, K_, cblk, F.G, E, XS_, WSN_); } } while (0)
    RUNPHASE(0, do { p0_prologue(F); xcd_barrier(bar); p0b_quant_weights(F); } while (0));
    RUNPHASE(1, GEMM_PHASEI(EpiGU, WSP(unsigned char, WS_XI8), WSP(unsigned char, WS_WGU1I8), WSP(float, WS_XS), WSP(float, WS_WSN), 2 * DFF, D, WSP(float, WS_SS0), 1, WSP(bf16, WS_H), WSP(float, WS_SS0), 1, RSTAB, 1.0f, WSP(unsigned char, WS_H8), WSP(float, WS_WSN)));
    RUNPHASE(2, GEMM_PHASE8(EpiRes<0>, WSP(unsigned char, WS_H8), WSP(unsigned char, WS_WD1_8), 1.0f / (W8SCALE * H8SCALE), D, DFF, nullptr, 0, WSP(bf16, WS_XB), nullptr, WSP(bf16, WS_X1B), WSP(float, WS_SS1), nullptr, 1.0f / (W8SCALE * H8SCALE), (const float*)F.in[0], (const float*)F.in[1]));
#if PROBE_DUP >= 21 && PROBE_DUP <= 23
    if (IN(2)) { xcd_barrier(bar); pg8::Gemm g{(const bf16*)WSP(unsigned char, WS_H8), (const bf16*)WSP(unsigned char, WS_WD1_8), MP, D, DFF / 2}; pg8::StaticOrder S; S.init(MP, D, F.G, cblk);
        EpiRes<0> E{WSP(bf16, WS_XB), nullptr, WSP(bf16, WS_X2B), WSP(float, WS_SS2), nullptr, 1.0f / (W8SCALE * H8SCALE), (const float*)F.in[0], (const float*)F.in[1]};
        pg8::gemm_phase<EpiRes<0>, pg8::StaticOrder, true, true, (PROBE_DUP == 21 ? 1 : PROBE_DUP == 22 ? 2 : 0)>(F.lds + RING_OFF, g, S, E); xcd_barrier(bar); }
#endif
    RUNPHASE(3, GEMM_PHASE(EpiWin, WSP(bf16, WS_X1B), WSP(bf16, WS_WIN), NINP, D, WSP(float, WS_SS1), 16, F.ws, F.out, (const float*)F.in[15], (const float*)F.in[16], RSTAB));
    RUNPHASE(4, do { p4_conv(F); if (PROBE_DUP == 40) p4_conv(F); p4_index(F); if (PROBE_DUP == 42) p4_index(F); } while (0));
    RUNPHASE(5, do { if ((F.vcu & 1) == 0 && F.vcu < 256) { p5_sample_unit(F, F.vcu >> 1); if (PROBE_DUP == 51) p5_sample_unit(F, F.vcu >> 1); }
        const attn_body::AttnTensors AT{(const attn_body::bf16*)WSP(bf16, WS_Q), (const attn_body::bf16*)WSP(bf16, WS_KB), (const attn_body::bf16*)WSP(bf16, WS_VB), WSP(unsigned long long, WS_MASK), (attn_body::bf16*)WSP(bf16, WS_CAT)};
        const attn_body::StaticOrder S(F.vcu); attn_body::attn_phase<attn_body::StaticOrder>((char*)lds + RING_OFF, AT, S); } while (0));
    RUNPHASE(6, do { GEMM_PHASE(EpiRes<1>, WSP(bf16, WS_CAT), WSP(bf16, WS_WOUT), D, D, nullptr, 0, WSP(bf16, WS_X1B), nullptr, WSP(bf16, WS_X2B), WSP(float, WS_SS2), nullptr, 1.0f);
                     xcd_barrier(bar); quant_rows_pass(F.vcu * 8 + F.wave, F.G * 8, WSP(bf16, WS_X2B), WSP(unsigned char, WS_X2I8), WSP(float, WS_XS2), MTOT); } while (0));
    RUNPHASE(7, GEMM_PHASEI(EpiGU, WSP(unsigned char, WS_X2I8), WSP(unsigned char, WS_WGU2I8), WSP(float, WS_XS2), WSP(float, WS_WSN2), 2 * DFF, D, WSP(float, WS_SS2), 16, WSP(bf16, WS_H), WSP(float, WS_SS2), 16, RSTAB, 1.0f, WSP(unsigned char, WS_H8), WSP(float, WS_WSN2)));
    RUNPHASE(8, GEMM_PHASE8(EpiRes<2>, WSP(unsigned char, WS_H8), WSP(unsigned char, WS_WD2_8), 1.0f / (W8SCALE * H8SCALE), D, DFF, nullptr, 0, WSP(bf16, WS_X2B), F.out, nullptr, nullptr, nullptr, 1.0f / (W8SCALE * H8SCALE)));
#undef RUNPHASE
#undef GEMM_PHASE
#undef GEMM_PHASE8
#undef GEMM_PHASEI
#undef RSTAB
#undef IN
#undef SEAM
}

#ifndef MK_N_LAUNCHES
#define MK_N_LAUNCHES 1
#endif
extern "C" void kernel_launch(void* const* d_in, const int* in_sizes, int n_in, void* d_out, int out_size, void* d_ws, size_t ws_size, hipStream_t stream) {
    static int grid = 0;
    if (grid == 0) {
        if (n_in != 22 || out_size != (int)O_END || ws_size < WS_END) { fprintf(stderr, "kernel_launch: unexpected problem: n_in %d out %d ws %zu (need %zu)\n", n_in, out_size, ws_size, (size_t)WS_END); grid = -1; return; }
        int dev = 0, cus = 0, per_cu = 0;
        if (hipGetDevice(&dev) != hipSuccess || hipDeviceGetAttribute(&cus, hipDeviceAttributeMultiprocessorCount, dev) != hipSuccess) { grid = -1; return; }
        if (hipFuncSetAttribute((const void*)hymba_fwd, hipFuncAttributeMaxDynamicSharedMemorySize, LDS_BYTES) != hipSuccess) { fprintf(stderr, "kernel_launch: hipFuncSetAttribute failed\n"); grid = -1; return; }
        if (hipOccupancyMaxActiveBlocksPerMultiprocessor(&per_cu, (const void*)hymba_fwd, 512, LDS_BYTES) != hipSuccess || per_cu < 1) { fprintf(stderr, "kernel_launch: occupancy query says %d blocks per CU\n", per_cu); (void)hipGetLastError(); grid = -1; return; }
        grid = cus;
        if (grid % 8 != 0 || grid < 8) { fprintf(stderr, "kernel_launch: unexpected CU count %d\n", cus); grid = -1; return; }
    }
    if (grid < 0) return;
    (void)hipMemsetAsync((char*)d_ws + WS_CTL, 0, CTL_ZERO_BYTES, stream);
    Args a{};
    for (int i = 0; i < 22; ++i) a.in[i] = d_in[i];
    a.out = (float*)d_out; a.ws = (unsigned char*)d_ws;
    if (MK_N_LAUNCHES == 1) { a.ph_lo = 0; a.ph_hi = N_PHASES; a.use_bar = 1; hipLaunchKernelGGL(hymba_fwd, dim3(grid), dim3(512), LDS_BYTES, stream, a); }
    else for (int p = 0; p < N_PHASES; ++p) { a.ph_lo = p; a.ph_hi = p + 1; a.use_bar = 0; hipLaunchKernelGGL(hymba_fwd, dim3(grid), dim3(512), LDS_BYTES, stream, a); }
}
```

```cpp
#include <hip/hip_runtime.h>
#include <cstdio>
#include <cstdint>
#include <type_traits>
namespace pg8 {
#define PG8_LAS __attribute__((address_space(3)))
typedef unsigned short bf16_t;
typedef short bf16x8 __attribute__((ext_vector_type(8)));
typedef float f32x4 __attribute__((ext_vector_type(4)));
typedef unsigned u32x4 __attribute__((ext_vector_type(4)));
constexpr int BM = 256, BK = 64, HALF = 128, HTB = HALF * BK * 2  , STAGE_BYTES = 8 * HTB, NXCD = 8, WGM = 8;

__host__ __device__ __forceinline__ int lds_byte(int r, int c) { const int st = (r >> 4) * 2 + (c >> 5), rr = r & 15, cc = c & 31, ob = rr * 64 + cc * 2; return st * 1024 + (ob ^ (((ob >> 9) & 1) << 5)); }
__host__ __device__ __forceinline__ void stage_rc(int b, int& R, int& C) { const int st = b / 1024, sb = b % 1024, swz = sb ^ (((sb >> 9) & 1) << 5); R = (st >> 1) * 16 + swz / 64; C = (st & 1) * 32 + (swz % 64) / 2; }
__host__ __device__ __forceinline__ int perm32(int rho) { const int n = rho >> 4, i = rho & 15; return 8 * (i >> 2) + 4 * n + (i & 3); }

struct Unit { int pm, pn; };
struct Gemm { const bf16_t* A; const bf16_t* Bt; int M, N, K; };

struct StaticOrder {
    int nM, nN, nwg, G, c;
    __host__ __device__ void init(int M, int N, int G_, int c_) { nM = M / BM; nN = N / BM; nwg = nM * nN; G = G_; c = c_; }
    __host__ __device__ bool next(int i, Unit& u) const {
        const long L = (long)i * G + c; if (L >= nwg) return false;
        int wgid = (int)L; { const int q = nwg / NXCD, r = nwg % NXCD, xcd = wgid % NXCD, off = wgid / NXCD; wgid = (xcd < r ? xcd * (q + 1) : r * (q + 1) + (xcd - r) * q) + off; }
        const int nig = WGM * nN, gid = wgid / nig, fm = gid * WGM, gsz = (nM - fm) < WGM ? (nM - fm) : WGM;
        u.pm = fm + ((wgid % nig) % gsz); u.pn = (wgid % nig) / gsz; return true;
    }
    __device__ __forceinline__ void a_ready(const Unit&) const {}
    __device__ __forceinline__ void done(const Unit&) const {}
};
__device__ __forceinline__ unsigned cvt_pk_bf16(float lo, float hi) { unsigned r; asm volatile("v_cvt_pk_bf16_f32 %0, %1, %2" : "=v"(r) : "v"(lo), "v"(hi)); return r; }
template <class Epi, class Sched, bool ALIGN_EPI = false, bool SP2 = false, int QM = 0, int PFD = 0>
__device__ __forceinline__ void gemm_phase(PG8_LAS unsigned char* lds, const Gemm g, const Sched& S, const Epi& E) {
    const int tid = threadIdx.x, wid = __builtin_amdgcn_readfirstlane(tid >> 6), lane = tid & 63, wr = wid >> 2, wc = wid & 3, fr = lane & 15, fq = lane >> 4;
    const int K = g.K, nt = K / BK;
    unsigned voffA[2], voffB[2];
#pragma unroll
    for (int i = 0; i < 2; ++i) { int R, C; stage_rc(tid * 16 + i * 8192, R, C); const int Rb = Epi::PERM ? ((R & ~31) + perm32(R & 31)) : R;
        voffA[i] = (unsigned)(R * K + C) * 2u; voffB[i] = (unsigned)(Rb * K + C) * 2u; }
    unsigned voffP[2];
#pragma unroll
    for (int i = 0; i < 2; ++i) voffP[i] = (unsigned)((32 * wid + 16 * i + (lane >> 2)) * K) * 2u + (unsigned)(lane & 3) * 4u;
#define PG8_PF(s2, kt) do { if constexpr (PFD != 0) { const char* p_ = ((kt) < nt) ? cA + (size_t)(kt) * kstep : nA + (size_t)((kt) - nt) * kstep; \
        __builtin_amdgcn_global_load_lds((const unsigned*)(p_ + voffP[s2]), (PG8_LAS unsigned*)(lds + 143360 + wid * 256), 4, 0, 0); } } while (0)
#define PG8_WAIT_V8() do { if constexpr (PFD != 0) PG8_WAIT_V(10); else PG8_WAIT_V(8); } while (0)
    const size_t kstep = (size_t)(BK * 2);
    const size_t hstep = (size_t)HALF * K * 2;
    const size_t tstep = 2 * hstep;
    const unsigned ldsw = (unsigned)wid * 1024u;
    const int aoff = lds_byte(wr * 64 + fr, fq * 8), boff = lds_byte(wc * 32 + fr, fq * 8);
#define PG8_SA(b, h) (((b) * 2 + (h)) * HTB)
#define PG8_SB(b, h) ((4 + (b) * 2 + (h)) * HTB)
#define PG8_STAGE(bufoff, gbase, voff) do { _Pragma("unroll") for (int _i = 0; _i < 2; ++_i) \
        __builtin_amdgcn_global_load_lds((const unsigned*)((const char*)(gbase) + (voff)[_i]), (PG8_LAS unsigned*)(lds + (bufoff) + ldsw + _i * 8192), 16, 0, 0); } while (0)
#define PG8_LDF(dst_, addr_) do { if constexpr (QM == 1) { const pg8_v4i lo_ = *(const PG8_LAS pg8_v4i*)(addr_), hi_ = *(const PG8_LAS pg8_v4i*)((addr_) + 1024); \
            (dst_).v = __builtin_shufflevector(lo_, hi_, 0, 1, 2, 3, 4, 5, 6, 7); } \
        else { (dst_).k[0] = *(const PG8_LAS bf16x8*)(addr_); (dst_).k[1] = *(const PG8_LAS bf16x8*)((addr_) + 1024); } } while (0)
#define PG8_LDA(dst, b, h) do { _Pragma("unroll") for (int m = 0; m < 4; ++m) PG8_LDF(dst[m], lds + PG8_SA(b, h) + aoff + m * 2048); } while (0)
#define PG8_LDB(dst, b, h) do { _Pragma("unroll") for (int n = 0; n < 2; ++n) PG8_LDF(dst[n], lds + PG8_SB(b, h) + boff + n * 2048); } while (0)
#define PG8_MMA(ai, bj, At, Bt) do { __builtin_amdgcn_s_setprio(1); if constexpr (QM != 0) asm volatile("s_nop 4");     \
        _Pragma("unroll") for (int m = 0; m < 4; ++m) _Pragma("unroll") for (int n = 0; n < 2; ++n) { \
            if constexpr (QM == 1) asm volatile("v_mfma_scale_f32_16x16x128_f8f6f4 %0, %1, %2, %0, %3, %3 op_sel_hi:[0,0,0]" : "+v"(acc[ai][bj][m][n]) : "v"(Bt[n].v), "v"(At[m].v), "v"(scl8_));     \
            else if constexpr (QM == 2) { _Pragma("unroll") for (int k = 0; k < 2; ++k) asm volatile("v_mfma_i32_16x16x64_i8 %0, %1, %2, %0" : "+v"(acc[ai][bj][m][n]) : "v"(Bt[n].k[k]), "v"(At[m].k[k])); } \
            else { _Pragma("unroll") for (int k = 0; k < 2; ++k) acc[ai][bj][m][n] = __builtin_amdgcn_mfma_f32_16x16x32_bf16(Bt[n].k[k], At[m].k[k], acc[ai][bj][m][n], 0, 0, 0); } } \
        __builtin_amdgcn_s_setprio(0); } while (0)
#define PG8_WAIT_V(n) asm volatile("s_waitcnt vmcnt(" #n ")" ::: "memory")
#define PG8_WAIT_L(n) asm volatile("s_waitcnt lgkmcnt(" #n ")" ::: "memory")
#define PG8_BAR __builtin_amdgcn_s_barrier()
#define PG8_SCHED __builtin_amdgcn_sched_barrier(0)
    Unit cur, nxt; int ui = 0;
    if (!S.next(0, cur)) return;
    f32x4 acc[2][2][4][2];
    E.init(acc, cur, wr, wc, fr, fq);
    typedef int pg8_v8i __attribute__((ext_vector_type(8))); typedef int pg8_v4i __attribute__((ext_vector_type(4)));
    struct FragB { bf16x8 k[2]; }; struct Frag8 { pg8_v8i v; };
    typedef typename std::conditional<QM == 1, Frag8, FragB>::type Frag;
    Frag At[4], B0[2], B1[2];
    unsigned scl8_ = 0x7F7F7F7Fu; asm volatile("" : "+v"(scl8_));
    const char* cA = (const char*)g.A + (size_t)cur.pm * tstep; const char* cB = (const char*)g.Bt + (size_t)cur.pn * tstep;
    S.a_ready(cur);
    if constexpr (SP2) {
        PG8_STAGE(PG8_SB(0, 0), cB, voffB); PG8_STAGE(PG8_SB(0, 1), cB + hstep, voffB); PG8_STAGE(PG8_SA(0, 0), cA, voffA); PG8_STAGE(PG8_SA(0, 1), cA + hstep, voffA);
        if (wr == 1) PG8_BAR;
        PG8_WAIT_V(2); PG8_BAR;
        PG8_STAGE(PG8_SB(1, 0), cB + kstep, voffB); PG8_STAGE(PG8_SA(1, 0), cA + kstep, voffA); PG8_STAGE(PG8_SB(1, 1), cB + hstep + kstep, voffB);
        PG8_WAIT_V(6); PG8_BAR;
    } else {
        PG8_STAGE(PG8_SB(0, 0), cB, voffB); PG8_STAGE(PG8_SA(0, 0), cA, voffA); PG8_STAGE(PG8_SB(0, 1), cB + hstep, voffB); PG8_STAGE(PG8_SA(0, 1), cA + hstep, voffA);
        if (wr == 1) PG8_BAR;
        PG8_WAIT_V(4); PG8_BAR;
        PG8_STAGE(PG8_SB(1, 0), cB + kstep, voffB); PG8_STAGE(PG8_SA(1, 0), cA + kstep, voffA); PG8_STAGE(PG8_SB(1, 1), cB + hstep + kstep, voffB);
        PG8_WAIT_V(6); PG8_BAR;
    }
    for (;;) {
        const bool has_next = S.next(ui + 1, nxt);
        const char* nA = has_next ? (const char*)g.A + (size_t)nxt.pm * tstep : cA; const char* nB = has_next ? (const char*)g.Bt + (size_t)nxt.pn * tstep : cB;
#pragma unroll 1
        for (int t = 0; t < nt; t += 2) {
            const bool last = (t == nt - 2);
            const char* a1 = cA + (size_t)(t + 1) * kstep;
            const char* a2 = last ? nA : cA + (size_t)(t + 2) * kstep; const char* b2 = last ? nB : cB + (size_t)(t + 2) * kstep;
            const char* a3 = a2 + kstep; const char* b3 = b2 + kstep;
            if (last && has_next) S.a_ready(nxt);
            if constexpr (SP2) {
            PG8_LDB(B0, 0, 0); PG8_LDB(B1, 0, 1); PG8_SCHED; PG8_LDA(At, 0, 0); PG8_STAGE(PG8_SA(1, 1), a1 + hstep, voffA); PG8_PF(0, t + PFD);
            PG8_WAIT_V8(); PG8_WAIT_L(0); PG8_BAR; PG8_MMA(0, 0, At, B0); PG8_MMA(0, 1, At, B1); PG8_BAR; PG8_SCHED;
            PG8_LDA(At, 0, 1); PG8_STAGE(PG8_SB(0, 0), b2, voffB); PG8_STAGE(PG8_SB(0, 1), b2 + hstep, voffB); PG8_STAGE(PG8_SA(0, 0), a2, voffA); PG8_PF(1, t + PFD);
            PG8_WAIT_V8(); PG8_WAIT_L(0); PG8_BAR; PG8_MMA(1, 0, At, B0); PG8_MMA(1, 1, At, B1); PG8_BAR; PG8_SCHED;
            PG8_LDB(B0, 1, 0); PG8_LDB(B1, 1, 1); PG8_SCHED; PG8_LDA(At, 1, 0); PG8_STAGE(PG8_SA(0, 1), a2 + hstep, voffA); PG8_PF(0, t + 1 + PFD);
            PG8_WAIT_V8(); PG8_WAIT_L(0); PG8_BAR; PG8_MMA(0, 0, At, B0); PG8_MMA(0, 1, At, B1); PG8_BAR; PG8_SCHED;
            PG8_LDA(At, 1, 1); PG8_STAGE(PG8_SB(1, 0), b3, voffB); PG8_STAGE(PG8_SB(1, 1), b3 + hstep, voffB); PG8_STAGE(PG8_SA(1, 0), a3, voffA); PG8_PF(1, t + 1 + PFD);
            PG8_WAIT_V8(); PG8_WAIT_L(0); PG8_BAR; PG8_MMA(1, 0, At, B0); PG8_MMA(1, 1, At, B1); PG8_BAR; PG8_SCHED;
            } else {
            PG8_LDB(B0, 0, 0); PG8_SCHED; PG8_LDA(At, 0, 0); PG8_STAGE(PG8_SA(1, 1), a1 + hstep, voffA);
            PG8_WAIT_L(8); PG8_BAR; PG8_WAIT_L(0); PG8_MMA(0, 0, At, B0); PG8_BAR; PG8_SCHED;
            PG8_LDB(B1, 0, 1); PG8_STAGE(PG8_SB(0, 0), b2, voffB);
            PG8_BAR; PG8_WAIT_L(0); PG8_MMA(0, 1, At, B1); PG8_BAR;
            PG8_LDA(At, 0, 1); PG8_STAGE(PG8_SA(0, 0), a2, voffA);
            PG8_BAR; PG8_WAIT_L(0); PG8_MMA(1, 0, At, B0); PG8_BAR; PG8_SCHED;
            PG8_STAGE(PG8_SB(0, 1), b2 + hstep, voffB);
            PG8_WAIT_V(6); PG8_BAR; PG8_MMA(1, 1, At, B1); PG8_BAR;
            PG8_LDB(B0, 1, 0); PG8_SCHED; PG8_LDA(At, 1, 0); PG8_STAGE(PG8_SA(0, 1), a2 + hstep, voffA);
            PG8_WAIT_L(8); PG8_BAR; PG8_WAIT_L(0); PG8_MMA(0, 0, At, B0); PG8_BAR; PG8_SCHED;
            PG8_LDB(B1, 1, 1); PG8_STAGE(PG8_SB(1, 0), b3, voffB);
            PG8_BAR; PG8_WAIT_L(0); PG8_MMA(0, 1, At, B1); PG8_BAR;
            PG8_LDA(At, 1, 1); PG8_STAGE(PG8_SA(1, 0), a3, voffA);
            PG8_BAR; PG8_WAIT_L(0); PG8_MMA(1, 0, At, B0); PG8_BAR; PG8_SCHED;
            PG8_STAGE(PG8_SB(1, 1), b3 + hstep, voffB);
            PG8_WAIT_V(6); PG8_BAR; PG8_MMA(1, 1, At, B1); PG8_BAR;
            }
        }
        if constexpr (ALIGN_EPI) { if (wr == 0) PG8_BAR; }
        if constexpr (QM != 0) asm volatile("s_nop 15\n\ts_nop 7" ::: "memory");
        if constexpr (!Epi::AFTER_DRAIN) { E(acc, cur, wr, wc, fr, fq, ui, has_next, nxt);
#if defined(PROBE_DUP) && PROBE_DUP == 61
            E(acc, cur, wr, wc, fr, fq, ui, has_next, nxt);
#endif
            S.done(cur); }
        if (!has_next) break;
        cur = nxt; cA = nA; cB = nB; ++ui;
        if constexpr (ALIGN_EPI) { if (wr == 1) PG8_BAR; }
    }
    PG8_WAIT_V(0);
    if constexpr (!ALIGN_EPI) { if (wr == 0) PG8_BAR; }
    PG8_BAR;
    if constexpr (Epi::AFTER_DRAIN) { E.fused(acc, cur, wr, wc, fr, fq, lds, wid, lane); S.done(cur); }
#undef PG8_SA
#undef PG8_PF
#undef PG8_WAIT_V8
#undef PG8_SB
#undef PG8_STAGE
#undef PG8_LDA
#undef PG8_LDF
#undef PG8_LDB
#undef PG8_MMA
#undef PG8_WAIT_V
#undef PG8_WAIT_L
#undef PG8_BAR
#undef PG8_SCHED
}
}
#include <hip/hip_bf16.h>
#include <cmath>
namespace attn_body {
using bf16=__hip_bfloat16;
using bf16x8=__attribute__((ext_vector_type(8)))short;
using s16x4=__attribute__((ext_vector_type(4)))short;
using f32x16=__attribute__((ext_vector_type(16)))float;
using u32x4=__attribute__((ext_vector_type(4)))unsigned;
constexpr int BATCH=16,NHEAD=8,SEQ=2048,D=64;
constexpr int QP=512,KP=128,OP=1024,OOFF=512;
constexpr int NW=8,QBLK=32,QB=QBLK*NW,KVBLK=64,NQB=SEQ/QB;
constexpr int ATTN_UNIT_ROWS=QB;
__device__ __forceinline__ int crow(int r,int hi){return (r&3)+8*(r>>2)+4*hi;}
#define SBAR() __builtin_amdgcn_sched_barrier(0)
#define MSKV(v,W,r) __uint_as_float(__float_as_uint(v)&(unsigned)(((int)((W)<<(31-(((r)&3)+8*((r)>>2)))))>>31))
__device__ __forceinline__ void cmask(f32x16&p0,f32x16&p1,int jb,int qrel,int hi){
  const float NEG=-INFINITY; int kb=64*jb+4*hi;
  #pragma unroll
  for(int r=0;r<16;++r){int kv=kb+(r&3)+8*(r>>2); if(kv>qrel)p0[r]=NEG; if(kv+32>qrel)p1[r]=NEG;}
}

constexpr int NSLOT=3, SLOTB=8192;
constexpr int LDS_K=0, LDS_V=NSLOT*SLOTB, LDS_WS=2*NSLOT*SLOTB, LDS_OST=LDS_WS+NW*64*4, LDS_MSK=LDS_OST+NW*4096, LDS_BYTES=LDS_MSK+NW*8192;
constexpr float C2=0.125f*1.4426950408889634f;
__device__ __forceinline__ void glds16(const void*gsrc,unsigned lds_dst){unsigned keep;
  asm volatile("s_mov_b32 %0, m0\n\ts_mov_b32 m0, %2\n\ts_nop 0\n\tglobal_load_lds_dwordx4 %1, off\n\ts_mov_b32 m0, %0":"=&s"(keep):"v"(gsrc),"s"(lds_dst):"memory");}
__device__ __forceinline__ float max3f(float a,float b,float c){float r;asm("v_max3_f32 %0, %1, %2, %3":"=v"(r):"v"(a),"v"(b),"v"(c));return r;}
__device__ __forceinline__ float max2f(float a,float b){float r;asm("v_max_f32_e32 %0, %1, %2":"=v"(r):"v"(a),"v"(b));return r;}
__device__ __forceinline__ float fadd_s(float a,float b){float r;asm("v_add_f32_e32 %0, %1, %2":"=v"(r):"v"(a),"v"(b));return r;}
__device__ __forceinline__ float fsub_s(float a,float b){float r;asm("v_sub_f32_e32 %0, %1, %2":"=v"(r):"v"(a),"v"(b));return r;}
typedef float f32x2_t __attribute__((ext_vector_type(2))); typedef __bf16 bf16x2_t __attribute__((ext_vector_type(2)));
__device__ __forceinline__ unsigned cvtpk_s(float lo,float hi){f32x2_t v={lo,hi};bf16x2_t b=__builtin_convertvector(v,bf16x2_t);return __builtin_bit_cast(unsigned,b);}
#define WAIT_BAR(N) asm volatile("s_waitcnt vmcnt(" #N ") lgkmcnt(0)\n\ts_barrier":::"memory")

__device__ __forceinline__ void qkt(f32x16&p0,f32x16&p1,const char*Kslot,const bf16x8*qr,const f32x16&negm,int r32,int hi){
  const char*kb=Kslot+hi*1024+r32*16;
  #pragma unroll
  for(int d0=0;d0<4;++d0){
    const bf16x8 b0=*reinterpret_cast<const bf16x8*>(kb+d0*2048);
    const bf16x8 b1=*reinterpret_cast<const bf16x8*>(kb+d0*2048+512);
    if(d0==0){p0=__builtin_amdgcn_mfma_f32_32x32x16_bf16(b0,qr[0],negm,0,0,0);p1=__builtin_amdgcn_mfma_f32_32x32x16_bf16(b1,qr[0],negm,0,0,0);}
    else{p0=__builtin_amdgcn_mfma_f32_32x32x16_bf16(b0,qr[d0],p0,0,0,0);p1=__builtin_amdgcn_mfma_f32_32x32x16_bf16(b1,qr[d0],p1,0,0,0);}}
}
typedef __attribute__((address_space(3))) const char* lds_cptr;
typedef short v4i16_t __attribute__((ext_vector_type(4)));
__device__ __forceinline__ void kload8(bf16x8*kf,lds_cptr kp){
  kf[0]=*(const __attribute__((address_space(3))) bf16x8*)(kp);      kf[1]=*(const __attribute__((address_space(3))) bf16x8*)(kp+512);
  kf[2]=*(const __attribute__((address_space(3))) bf16x8*)(kp+2048); kf[3]=*(const __attribute__((address_space(3))) bf16x8*)(kp+2560);
  kf[4]=*(const __attribute__((address_space(3))) bf16x8*)(kp+4096); kf[5]=*(const __attribute__((address_space(3))) bf16x8*)(kp+4608);
  kf[6]=*(const __attribute__((address_space(3))) bf16x8*)(kp+6144); kf[7]=*(const __attribute__((address_space(3))) bf16x8*)(kp+6656);
}
__device__ __forceinline__ void kload2(bf16x8*kf,lds_cptr kp,int j){ kf[2*j]=*(const __attribute__((address_space(3))) bf16x8*)(kp+j*2048); kf[2*j+1]=*(const __attribute__((address_space(3))) bf16x8*)(kp+j*2048+512); }
__device__ __forceinline__ s16x4 vtr(lds_cptr p){ return __builtin_bit_cast(s16x4,__builtin_amdgcn_ds_read_tr16_b64_v4i16((__attribute__((address_space(3))) v4i16_t*)p)); }
__device__ __forceinline__ float rowmax(const f32x16&p0,const f32x16&p1){
  float a=max3f(p0[0],p0[1],p1[0]),b=max3f(p0[2],p0[3],p1[1]);a=max3f(a,p1[2],p1[3]);
  #pragma unroll
  for(int r=4;r<16;r+=4){a=max3f(a,p0[r],p0[r+1]);b=max3f(b,p0[r+2],p0[r+3]);a=max3f(a,p1[r],p1[r+1]);b=max3f(b,p1[r+2],p1[r+3]);}
  const float m=max2f(a,b);
  auto rr=__builtin_amdgcn_permlane32_swap(__float_as_uint(m),__float_as_uint(m),false,false);
  return max2f(__uint_as_float(rr[0]),__uint_as_float(rr[1]));
}
__device__ __forceinline__ void pv(f32x16*o,int vb,bf16x8 pa0,bf16x8 pa1,bf16x8 pa2,bf16x8 pa3){
  #pragma unroll
  for(int d0=0;d0<2;++d0){s16x4 lo[4],hi[4];
    #pragma unroll
    for(int ks=0;ks<4;++ks){
      asm volatile("ds_read_b64_tr_b16 %0,%1 offset:%c2":"=&v"(lo[ks]):"v"(vb),"i"(d0*4096+ks*1024):"memory");
      asm volatile("ds_read_b64_tr_b16 %0,%1 offset:%c2":"=&v"(hi[ks]):"v"(vb),"i"(d0*4096+ks*1024+512):"memory");}
    asm volatile("s_waitcnt lgkmcnt(0)":::"memory");SBAR();
    #define PK(k) (bf16x8){lo[k][0],lo[k][1],lo[k][2],lo[k][3],hi[k][0],hi[k][1],hi[k][2],hi[k][3]}
    o[d0]=__builtin_amdgcn_mfma_f32_32x32x16_bf16(pa0,PK(0),o[d0],0,0,0);
    o[d0]=__builtin_amdgcn_mfma_f32_32x32x16_bf16(pa1,PK(1),o[d0],0,0,0);
    o[d0]=__builtin_amdgcn_mfma_f32_32x32x16_bf16(pa2,PK(2),o[d0],0,0,0);
    o[d0]=__builtin_amdgcn_mfma_f32_32x32x16_bf16(pa3,PK(3),o[d0],0,0,0);
    #undef PK
  }
}

#ifndef ATTN_STORE16
#define ATTN_STORE16(p,v) (*(u32x4*)(p)=(v))
#endif
template<int THRL> __device__ __forceinline__ void attn_unit(int b,int h,int qb,const bf16*Q,const bf16*K,const bf16*V,const unsigned long long*MK,bf16*O,char*shm){
  const int tid=threadIdx.x,lane=tid&63,r32=lane&31,hi=lane>>5; const int wid=__builtin_amdgcn_readfirstlane(tid>>6);
  const long rowbase=(long)b*SEQ; const int q0=qb*QB;
  const bf16*Qw=Q+(rowbase+q0+wid*QBLK)*QP+h*D;
  const bf16*Kh=K+rowbase*KP+(h>>2)*D,*Vh=V+rowbase*KP+(h>>2)*D;
  const unsigned lds0=(unsigned)(uintptr_t)shm;
  float*wsf=(float*)(shm+LDS_WS)+wid*64;
  const bf16*ksrc=Kh+(long)lane*KP+wid*8;
  const bf16*vsrc=Vh+(long)(16*(wid&3)+(lane>>2))*KP+(wid>>2)*32+(lane&3)*8;
  const unsigned kdst=lds0+LDS_K+wid*1024, vdst=lds0+LDS_V+wid*1024;
  #define DMA_K(t,slot) glds16(ksrc+(long)(t)*KVBLK*KP,(unsigned)__builtin_amdgcn_readfirstlane(kdst+(slot)))
  #define DMA_V(t,slot) glds16(vsrc+(long)(t)*KVBLK*KP,(unsigned)__builtin_amdgcn_readfirstlane(vdst+(slot)))
  const int vb0=(int)(lds0+LDS_V)+((lane>>4)&1)*32+(lane&3)*8+(4*hi+((lane&15)>>2))*64;
  const char*Kbase=shm+LDS_K; bf16x8 kf[8];
  const lds_cptr shm3=(lds_cptr)shm; const lds_cptr kp0=shm3+LDS_K+hi*1024+r32*16; const lds_cptr vp0=shm3+LDS_V+((lane>>4)&1)*32+(lane&3)*8+(4*hi+((lane&15)>>2))*64;
  const int NT=(q0+QB)/KVBLK;
  const __attribute__((address_space(3))) char* shm3m=(const __attribute__((address_space(3))) char*)shm;
  typedef __attribute__((address_space(3))) unsigned long long* lds_u64p;
  const lds_u64p mskw=(lds_u64p)(shm3m+LDS_MSK+wid*8192);
  unsigned long long mtmp[16];
  { const unsigned long long*mq=MK+(q0+wid*QBLK+r32);
    #pragma unroll
    for(int i=0;i<16;++i){int tt=2*i+hi; tt=tt<NT?tt:NT-1; mtmp[i]=mq[(long)tt*SEQ];} }
  DMA_K(0,0);DMA_V(0,0);DMA_K(1,SLOTB);
  bf16x8 qr[4];
  #pragma unroll
  for(int d0=0;d0<4;++d0)qr[d0]=*reinterpret_cast<const bf16x8*>(&Qw[(long)r32*QP+d0*16+hi*8]);
  float mhat=0.f,l_reg=0.f;f32x16 o[2];o[0]=f32x16{};o[1]=f32x16{};f32x16 negm=f32x16{};asm volatile("":"+v"(negm));
  const int qrel=wid*QBLK+r32;
  #define CMASK(P0,P1,t) do{int jb_=(t)-(NT-4); if(jb_>=0)cmask(P0,P1,jb_,qrel,hi);}while(0)
  bool resc=false;
  #define START(P0,P1) do{ const float rm=rowmax(P0,P1); resc=false; \
    { const float dl=rm; mhat=fadd_s(mhat,dl); \
      _Pragma("unroll") for(int r=0;r<16;++r){P0[r]=fsub_s(P0[r],dl);P1[r]=fsub_s(P1[r],dl);} \
      _Pragma("unroll") for(int r=0;r<16;++r)negm[r]=-mhat; asm volatile("":"+v"(negm)); } \
    _Pragma("unroll") for(int r=0;r<16;++r)P0[r]=__builtin_amdgcn_exp2f(P0[r]); }while(0)
  #define RESC() do{ if(resc){ asm volatile("s_waitcnt lgkmcnt(0)":::"memory"); \
      _Pragma("unroll") for(int d_=0;d_<2;++d_) _Pragma("unroll") for(int r=0;r<16;++r)o[d_][r]*=wsf[crow(r,hi)]; } }while(0)
  f32x16 pA0,pA1,pB0,pB1;
  int sl_prev=0,sl_cur=0,sl_next=SLOTB;
  #define ROT() do{sl_prev=sl_cur;sl_cur=sl_next;sl_next=(sl_next==(NSLOT-1)*SLOTB)?0:sl_next+SLOTB;}while(0)
  DMA_K(2,2*SLOTB);
  WAIT_BAR(3);
  #pragma unroll
  for(int i=0;i<16;++i)mskw[(2*i+hi)*32+r32]=mtmp[i];
  #define MLOAD(t,LO,HI) do{ const unsigned long long mw_=mskw[(t)*32+r32]; LO=((unsigned)mw_)>>(4*hi); HI=((unsigned)(mw_>>32))>>(4*hi); }while(0)
  unsigned mlo,mhi; MLOAD(0,mlo,mhi);
  qkt(pA0,pA1,Kbase,qr,negm,r32,hi);asm volatile("s_nop 15\n\ts_nop 7":"+v"(pA0),"+v"(pA1));
  START(pA0,pA1);
  _Pragma("unroll") for(int r=0;r<16;++r)pA1[r]=__builtin_amdgcn_exp2f(pA1[r]);
  _Pragma("unroll") for(int r=0;r<16;++r){pA0[r]=MSKV(pA0[r],mlo,r);pA1[r]=MSKV(pA1[r],mhi,r);}
  WAIT_BAR(0);
  DMA_K(3,0);DMA_V(1,SLOTB);
  ROT();
  kload8(kf,kp0+sl_cur);
  WAIT_BAR(2);
  s16x4 vlo[8],vhi[8]; u32x4 pw0,pw1,pw2,pw3;
  #define PKW(P,B) cvtpk_s(P[B],P[B+1])
  #define PAF(k) __builtin_bit_cast(bf16x8,pw##k)
  #define VFR(i) (bf16x8){vlo[i][0],vlo[i][1],vlo[i][2],vlo[i][3],vhi[i][0],vhi[i][1],vhi[i][2],vhi[i][3]}
  #define PIN(x) asm volatile("":"+v"(x))
  #define MX3(a,b,c) __builtin_fmaxf(__builtin_fmaxf((a),(b)),(c))
  #define GAPA(MF,A0,A1,A2,A3,W0,W1,PW) do{ MF; sacc+=A0; sacc+=A1; sacc+=A2; sacc+=A3; PIN(sacc); W0; W1; PIN(PW); SBAR(); }while(0)
  #define EX(v) __builtin_amdgcn_exp2f(v)
  #define GAPB(MF,X,B,W) do{ MF; X[B]=MSKV(EX(X[B]),W,B); X[B+1]=MSKV(EX(X[B+1]),W,B+1); X[B+2]=MSKV(EX(X[B+2]),W,B+2); X[B+3]=MSKV(EX(X[B+3]),W,B+3); PIN(X); SBAR(); }while(0)
  #define VRD(i) do{ vlo[i]=vtr(vp_+(((i)>>2)*4096+((i)&3)*1024)); vhi[i]=vtr(vp_+(((i)>>2)*4096+((i)&3)*1024+512)); }while(0)
  #define KRD(G,j) do{ if(G){ kload2(kf,kp0+sl_next,j); SBAR(); } }while(0)
  #define STEP(C0,C1,P0,P1,t,GK,GV,GL) do{ SBAR(); \
    const lds_cptr vp_=vp0+sl_prev; MLOAD(t,mlo,mhi); \
    VRD(0); SBAR(); float sacc=(P0[0]+P0[1]); \
    GAPA(C0=__builtin_amdgcn_mfma_f32_32x32x16_bf16(kf[0],qr[0],negm,0,0,0), P0[2],P0[3],P0[4],P0[5],     pw0[0]=PKW(P0,0), pw0[1]=PKW(P0,2), pw0); \
    VRD(4); SBAR(); GAPA(C1=__builtin_amdgcn_mfma_f32_32x32x16_bf16(kf[1],qr[0],negm,0,0,0), P0[6],P0[7],P0[8],P0[9],     pw0[2]=PKW(P0,4), pw0[3]=PKW(P0,6), pw0); \
    VRD(1); SBAR(); GAPA(C0=__builtin_amdgcn_mfma_f32_32x32x16_bf16(kf[2],qr[1],C0,0,0,0),   P0[10],P0[11],P0[12],P0[13], pw1[0]=PKW(P0,8), pw1[1]=PKW(P0,10), pw1); \
    VRD(5); SBAR(); GAPA(C1=__builtin_amdgcn_mfma_f32_32x32x16_bf16(kf[3],qr[1],C1,0,0,0),   P0[14],P0[15],P1[0],P1[1],   pw1[2]=PKW(P0,12),pw1[3]=PKW(P0,14), pw1); \
    VRD(2); SBAR(); GAPA(C0=__builtin_amdgcn_mfma_f32_32x32x16_bf16(kf[4],qr[2],C0,0,0,0),   P1[2],P1[3],P1[4],P1[5],     pw2[0]=PKW(P1,0), pw2[1]=PKW(P1,2), pw2); \
    VRD(6); SBAR(); GAPA(C1=__builtin_amdgcn_mfma_f32_32x32x16_bf16(kf[5],qr[2],C1,0,0,0),   P1[6],P1[7],P1[8],P1[9],     pw2[2]=PKW(P1,4), pw2[3]=PKW(P1,6), pw2); \
    VRD(3); SBAR(); GAPA(C0=__builtin_amdgcn_mfma_f32_32x32x16_bf16(kf[6],qr[3],C0,0,0,0),   P1[10],P1[11],P1[12],P1[13], pw3[0]=PKW(P1,8), pw3[1]=PKW(P1,10), pw3); \
    VRD(7); SBAR(); GAPA(C1=__builtin_amdgcn_mfma_f32_32x32x16_bf16(kf[7],qr[3],C1,0,0,0),   P1[14],P1[15],0.f,0.f,       pw3[2]=PKW(P1,12),pw3[3]=PKW(P1,14), pw3); \
    l_reg+=sacc; \
    if(GK){DMA_K((t)+3,sl_cur);} if(GV){DMA_V((t)+1,sl_next);} \
    { float a=MX3(C0[0],C0[1],C1[0]),b=MX3(C0[2],C0[3],C1[1]); a=MX3(a,C1[2],C1[3]); \
      _Pragma("unroll") for(int r=4;r<16;r+=4){a=MX3(a,C0[r],C0[r+1]);b=MX3(b,C0[r+2],C0[r+3]);a=MX3(a,C1[r],C1[r+1]);b=MX3(b,C1[r+2],C1[r+3]);} \
      float rm=__builtin_fmaxf(a,b); { auto rr=__builtin_amdgcn_permlane32_swap(__float_as_uint(rm),__float_as_uint(rm),false,false); rm=__builtin_fmaxf(__uint_as_float(rr[0]),__uint_as_float(rr[1])); } \
      resc=false; \
      if(__builtin_expect(__any(rm>(float)THRL),0)){ const float dl=__builtin_fmaxf(rm,0.f); mhat+=dl; \
        _Pragma("unroll") for(int r=0;r<16;++r){C0[r]-=dl;C1[r]-=dl;} \
        _Pragma("unroll") for(int r=0;r<16;++r)negm[r]=-mhat; asm volatile("":"+v"(negm)); \
        const float f=__builtin_amdgcn_exp2f(-dl); l_reg*=f; if(hi==0)wsf[r32]=f; resc=true; } } \
    SBAR(); \
    GAPB(o[0]=__builtin_amdgcn_mfma_f32_32x32x16_bf16(PAF(0),VFR(0),o[0],0,0,0), C0,0,mlo); \
    GAPB(o[1]=__builtin_amdgcn_mfma_f32_32x32x16_bf16(PAF(0),VFR(4),o[1],0,0,0), C0,4,mlo); \
    KRD(GL,0); GAPB(o[0]=__builtin_amdgcn_mfma_f32_32x32x16_bf16(PAF(1),VFR(1),o[0],0,0,0), C0,8,mlo); \
    KRD(GL,1); GAPB(o[1]=__builtin_amdgcn_mfma_f32_32x32x16_bf16(PAF(1),VFR(5),o[1],0,0,0), C0,12,mlo); \
    KRD(GL,2); GAPB(o[0]=__builtin_amdgcn_mfma_f32_32x32x16_bf16(PAF(2),VFR(2),o[0],0,0,0), C1,0,mhi); \
    KRD(GL,3); GAPB(o[1]=__builtin_amdgcn_mfma_f32_32x32x16_bf16(PAF(2),VFR(6),o[1],0,0,0), C1,4,mhi); \
    GAPB(o[0]=__builtin_amdgcn_mfma_f32_32x32x16_bf16(PAF(3),VFR(3),o[0],0,0,0), C1,8,mhi); \
    GAPB(o[1]=__builtin_amdgcn_mfma_f32_32x32x16_bf16(PAF(3),VFR(7),o[1],0,0,0), C1,12,mhi); \
    }while(0)
  int t=1;
  #undef CMASK
  #define CMASK(P0,P1,t) do{}while(0)
  for(;t+5<NT;t+=2){
    STEP(pB0,pB1,pA0,pA1,t,true,true,true);     WAIT_BAR(2); RESC(); ROT();
    STEP(pA0,pA1,pB0,pB1,t+1,true,true,true);   WAIT_BAR(2); RESC(); ROT();
  }
  #undef CMASK
  #define CMASK(P0,P1,t) do{int jb_=(t)-(NT-4); if(jb_>=0)cmask(P0,P1,jb_,qrel,hi);}while(0)
  #define ENDW(tt) do{ if((tt)+3<NT){WAIT_BAR(2);} else if((tt)+2<NT){WAIT_BAR(1);} else {WAIT_BAR(0);} }while(0)
  for(;t+1<NT;t+=2){
    STEP(pB0,pB1,pA0,pA1,t,(t+3<NT),(t+1<NT),(t+1<NT));       ENDW(t);   RESC(); ROT();
    STEP(pA0,pA1,pB0,pB1,t+1,(t+4<NT),(t+2<NT),(t+2<NT));     ENDW(t+1); RESC(); ROT();
  }
  STEP(pB0,pB1,pA0,pA1,NT-1,false,false,false); RESC();
  { float sacc=pB0[0]+pB0[1]; _Pragma("unroll") for(int r=2;r<16;++r)sacc+=pB0[r]; _Pragma("unroll") for(int r=0;r<16;++r)sacc+=pB1[r]; l_reg+=sacc;
    pw0=(u32x4){PKW(pB0,0),PKW(pB0,2),PKW(pB0,4),PKW(pB0,6)};pw1=(u32x4){PKW(pB0,8),PKW(pB0,10),PKW(pB0,12),PKW(pB0,14)};pw2=(u32x4){PKW(pB1,0),PKW(pB1,2),PKW(pB1,4),PKW(pB1,6)};pw3=(u32x4){PKW(pB1,8),PKW(pB1,10),PKW(pB1,12),PKW(pB1,14)};
    SBAR(); pv(o,vb0+sl_cur,PAF(0),PAF(1),PAF(2),PAF(3)); }
  #undef PKW
  #undef PAF
  #undef VFR
  #undef PIN
  #undef MX3
  #undef GAPA
  #undef GAPB
  #undef EX
  #undef VRD
  #undef KRD
  #undef STEP
  #undef ENDW
  {auto rr=__builtin_amdgcn_permlane32_swap(__float_as_uint(l_reg),__float_as_uint(l_reg),false,false);l_reg=__uint_as_float(rr[0])+__uint_as_float(rr[1]);}
  if(hi==0)wsf[32+r32]=l_reg;asm volatile("s_waitcnt lgkmcnt(0)":::"memory");
  float rli[16];
  #pragma unroll
  for(int r=0;r<16;++r)rli[r]=__builtin_amdgcn_rcpf(wsf[32+crow(r,hi)]);
  bf16*Ow=O+(rowbase+q0+wid*QBLK)*OP+OOFF+h*D;
  { bf16*stg=(bf16*)(shm+LDS_OST)+wid*2048;
    #pragma unroll
    for(int r=0;r<16;++r){const int orow=crow(r,hi);
      #pragma unroll
      for(int d0=0;d0<2;++d0)stg[orow*64+d0*32+r32]=__float2bfloat16(o[d0][r]*rli[r]);}
    asm volatile("s_waitcnt lgkmcnt(0)":::"memory");
    #pragma unroll
    for(int i=0;i<4;++i){const int row=i*8+(lane>>3),ch=lane&7; const u32x4 v=*(const u32x4*)(stg+row*64+ch*8); ATTN_STORE16(Ow+(long)row*OP+ch*8,v);} }
  asm volatile("s_waitcnt lgkmcnt(0)\n\ts_barrier":::"memory");
  #undef DMA_K
  #undef DMA_V
  #undef CMASK
  #undef START
  #undef RESC
  #undef ROT
}
constexpr int ATTN_LDS_BYTES=LDS_BYTES;
struct AttnTensors { const bf16* Q; const bf16* K; const bf16* V; const unsigned long long* MK; bf16* O; };
struct AttnUnit { int bh; int qb; };
struct StaticOrder {
  int vcu;
  __device__ __forceinline__ explicit StaticOrder(int vcu_):vcu(vcu_){}
  __device__ __forceinline__ bool next(int i,AttnUnit&u)const{ if(vcu>=256)return false; const int s=vcu&1; u.bh=vcu>>1; if(s){ if(i>=5)return false; u.qb=5-i; } else { if(i>=3)return false; u.qb=(i==0)?7:(i==1)?6:0; } return true; }
};
template<class Sched,int THRL=8> __device__ __forceinline__ void attn_phase(char*lds,const AttnTensors&T,const Sched&S){
  AttnUnit u;
  for(int i=0;S.next(i,u);++i){ const int b=u.bh/NHEAD; attn_unit<THRL>(b,u.bh%NHEAD,u.qb,T.Q,T.K,T.V,T.MK+(long)b*32*SEQ,T.O,lds); }
}
#undef SBAR
#undef WAIT_BAR
}
#ifndef PROBE_DUP
#define PROBE_DUP (-1)
#endif
constexpr int D = 1024, NB = 16, SEQ = 2048, MP = NB * SEQ, DB = 32, DS = 4, MS = DB * DS, MTOT = MP + MS, MPAD = 33024;
constexpr int DFF = 2816, NIN = 2888, NINP = 3072, DCONV = 512;
constexpr int PAST = 16384, PAGE = 128, NPAGES = 128, KTOP = 256;
constexpr float EPS = 1e-6f, LOG2E = 1.4426950408889634f;
constexpr float QSCALE = 0.125f * LOG2E;
constexpr size_t O_YP = 0, O_YS = O_YP + (size_t)MP * D, O_KP = O_YS + (size_t)MS * D, O_VP = O_KP + (size_t)MP * 128, O_IP = O_VP + (size_t)MP * 128,
                 O_CP = O_IP + (size_t)MP * 64, O_KS = O_CP + 16 * 2 * 512, O_VS = O_KS + MS * 128, O_IS = O_VS + MS * 128, O_CS = O_IS + MS * 64, O_END = O_CS + 32 * 2 * 512;
static_assert(O_END == 44261376, "output size");

constexpr size_t al(size_t x) { return (x + 0xFFFFF) & ~(size_t)0xFFFFF; }
constexpr size_t WS_CTL = 0, CTL_ZERO_BYTES = 1u << 20;
constexpr size_t WS_ROPE = al(WS_CTL + CTL_ZERO_BYTES);
constexpr size_t WS_WGU1 = al(WS_ROPE + 2052 * 8 * 2 * 4);
constexpr size_t WS_WD1 = al(WS_WGU1 + (size_t)2 * DFF * D * 2);
constexpr size_t WS_WIN = al(WS_WD1 + (size_t)D * DFF * 2);
constexpr size_t WS_WOUT = al(WS_WIN + (size_t)NINP * D * 2);
constexpr size_t WS_WGU2 = al(WS_WOUT + (size_t)D * D * 2);
constexpr size_t WS_WD2 = al(WS_WGU2 + (size_t)2 * DFF * D * 2);
constexpr size_t WS_XB = al(WS_WD2 + (size_t)D * DFF * 2);
constexpr size_t WS_SS0 = al(WS_XB + (size_t)MPAD * D * 2);
constexpr size_t WS_SS1 = al(WS_SS0 + (size_t)MPAD * 4);
constexpr size_t WS_SS2 = al(WS_SS1 + (size_t)MPAD * 64);
constexpr size_t WS_H = al(WS_SS2 + (size_t)MPAD * 64);
constexpr size_t WS_X1 = al(WS_H + (size_t)MPAD * DFF * 2);
constexpr size_t WS_X1B = al(WS_X1 + (size_t)MPAD * D * 4);
constexpr size_t WS_X2 = al(WS_X1B + (size_t)MPAD * D * 2);
constexpr size_t WS_X2B = al(WS_X2 + (size_t)MPAD * D * 4);
constexpr size_t WS_U = al(WS_X2B + (size_t)MPAD * D * 2);
constexpr size_t WS_GB = al(WS_U + (size_t)MPAD * 512 * 2);
constexpr size_t WS_Q = al(WS_GB + (size_t)MPAD * 512 * 2);
constexpr size_t WS_QI = al(WS_Q + (size_t)MPAD * 512 * 2);
constexpr size_t WS_KB = al(WS_QI + (size_t)MPAD * 512 * 2);
constexpr size_t WS_VB = al(WS_KB + (size_t)MPAD * 128 * 2);
constexpr size_t WS_KIB = al(WS_VB + (size_t)MPAD * 128 * 2);
constexpr size_t WS_WI = al(WS_KIB + (size_t)MPAD * 64 * 2);
constexpr size_t WS_CAT = al(WS_WI + (size_t)MPAD * 8 * 4);
constexpr size_t WS_MASK = al(WS_CAT + (size_t)MPAD * D * 2);
constexpr int SSTR = 16384;
constexpr size_t WS_SSC = al(WS_MASK + (size_t)NB * 32 * SEQ * 8);
constexpr size_t WS_XB8 = al(WS_SSC + (size_t)MS * SSTR * 4);
constexpr size_t WS_X2B8 = al(WS_XB8 + (size_t)MPAD * D);
constexpr size_t WS_WGU1_8 = al(WS_X2B8 + (size_t)MPAD * D);
constexpr size_t WS_WGU2_8 = al(WS_WGU1_8 + (size_t)2 * DFF * D);
constexpr size_t WS_WD2_8 = al(WS_WGU2_8 + (size_t)2 * DFF * D);
constexpr size_t WS_H8 = al(WS_WD2_8 + (size_t)D * DFF);
constexpr size_t WS_XI8 = al(WS_H8 + (size_t)MPAD * DFF);
constexpr size_t WS_XS = al(WS_XI8 + (size_t)MPAD * D);
constexpr size_t WS_WGU1I8 = al(WS_XS + (size_t)MPAD * 4);
constexpr size_t WS_WSN = al(WS_WGU1I8 + (size_t)2 * DFF * D);
constexpr size_t WS_X2I8 = al(WS_WSN + (size_t)2 * DFF * 4);
constexpr size_t WS_XS2 = al(WS_X2I8 + (size_t)MPAD * D);
constexpr size_t WS_WGU2I8 = al(WS_XS2 + (size_t)MPAD * 4);
constexpr size_t WS_WSN2 = al(WS_WGU2I8 + (size_t)2 * DFF * D);
constexpr size_t WS_WD1_8 = al(WS_WSN2 + (size_t)2 * DFF * 4);
constexpr size_t WS_END = al(WS_WD1_8 + (size_t)D * DFF);
constexpr float H8SCALE = 4.0f;
constexpr float W8SCALE = 32.0f;

constexpr int CW_TMO = 0, CW_CODE = 1, CW_BAR = 4096;

constexpr int RING_OFF = 0, RING_BYTES = 152576;
constexpr int LDSCTL_OFF = RING_BYTES, MISC_OFF = LDSCTL_OFF + 320;
constexpr int LDS_BYTES = 158720;
static_assert(MISC_OFF + 128 <= LDS_BYTES && attn_body::ATTN_LDS_BYTES <= RING_BYTES && pg8::STAGE_BYTES <= RING_BYTES, "LDS map");

#define GAS __attribute__((address_space(1)))
#define LAS __attribute__((address_space(3)))
typedef unsigned short bf16;
typedef unsigned v4u __attribute__((ext_vector_type(4)));
typedef unsigned v2u __attribute__((ext_vector_type(2)));
typedef float f32x4 __attribute__((ext_vector_type(4)));
typedef float f32x16 __attribute__((ext_vector_type(16)));
typedef short bf16x8 __attribute__((ext_vector_type(8)));
typedef GAS unsigned gu32;
#define RLX_AGENT __ATOMIC_RELAXED, __HIP_MEMORY_SCOPE_AGENT
#define LDS_WAIT() asm volatile("s_waitcnt lgkmcnt(0)" ::: "memory")
#define VM_WAIT() asm volatile("s_waitcnt vmcnt(0)" ::: "memory")
__device__ __forceinline__ unsigned f2bf(float f) { unsigned u = __builtin_bit_cast(unsigned, f); return (u + 0x7fffu + ((u >> 16) & 1u)) >> 16; }
__device__ __forceinline__ unsigned pk2(float lo, float hi) { return f2bf(lo) | (f2bf(hi) << 16); }
__device__ __forceinline__ float bf2f(unsigned short h) { return __builtin_bit_cast(float, (unsigned)h << 16); }
__device__ __forceinline__ float wave_sum(float v) {
#pragma unroll
    for (int o = 1; o < 64; o <<= 1) v += __shfl_xor(v, o);
    return v;
}
__device__ __forceinline__ float wave_max(float v) {
#pragma unroll
    for (int o = 1; o < 64; o <<= 1) v = fmaxf(v, __shfl_xor(v, o));
    return v;
}

#define XB_TMO      128
#define XB_XCNT(j)  (256  + 64 * (j))
#define XB_XSUB(j)  (1280 + 64 * (j))
#define XB_XGEN(j)  (2304 + 64 * (j))
#define XB_TOP      3328
#define XB_TOPGEN   3392
#define XCD_BAR_WORDS 3456
#define XB_SPIN_CAP (1u << 18)

__device__ __forceinline__ unsigned xb_ld(unsigned* p)              { return __hip_atomic_load(p, __ATOMIC_RELAXED, __HIP_MEMORY_SCOPE_AGENT); }
__device__ __forceinline__ unsigned xb_add(unsigned* p, unsigned v) { return __hip_atomic_fetch_add(p, v, __ATOMIC_RELAXED, __HIP_MEMORY_SCOPE_AGENT); }
__device__ __forceinline__ unsigned xb_xcc_id() { return (unsigned)__builtin_amdgcn_s_getreg((3 << 11) | 20) & 0xFu; }
#define XB_SPIN(cond, bar) do { unsigned _sp = 0; while (cond) { __builtin_amdgcn_s_sleep(1); \
    if ((++_sp & 255u) == 0u) { if (xb_ld(&(bar)[XB_TMO])) break; if (_sp > XB_SPIN_CAP) { atomicAdd(&(bar)[XB_TMO], 1u); break; } } } } while (0)

struct XcdBarrier {
    unsigned* bar; unsigned x;
    volatile LAS unsigned* st;
};

__device__ __forceinline__ XcdBarrier xcd_barrier_post(unsigned* bar, volatile LAS unsigned* st) {
    XcdBarrier b; b.bar = bar; b.x = xb_xcc_id(); b.st = st;
    if (threadIdx.x == 0) (void)xb_add(&bar[XB_XCNT(b.x)], 1u);
    return b;
}
__device__ __forceinline__ void xcd_barrier_complete(unsigned* bar, unsigned x, unsigned& nloc, unsigned& nx) {
    const unsigned G = gridDim.x * gridDim.y * gridDim.z;
    unsigned sum, cnt, mine, sp = 0u;
    for (;;) {
        sum = 0u; cnt = 0u; mine = 0u;
#pragma unroll
        for (unsigned j = 0; j < 16; ++j) { const unsigned c = xb_ld(&bar[XB_XCNT(j)]); sum += c; cnt += (c > 0u) ? 1u : 0u; mine = (j == x) ? c : mine; }
        if (sum == G) break;
        __builtin_amdgcn_s_sleep(1);
        if ((++sp & 255u) == 0u) { if (xb_ld(&bar[XB_TMO])) break; if (sp > XB_SPIN_CAP) { atomicAdd(&bar[XB_TMO], 1u); break; } }
    }
    nloc = mine > 0u ? mine : 1u; nx = cnt > 0u ? cnt : 1u;
}

__device__ __forceinline__ void xcd_barrier(const XcdBarrier& b) {
    asm volatile("s_waitcnt vmcnt(0)" ::: "memory");
    __syncthreads();
    if (threadIdx.x == 0) {
        unsigned* bar = b.bar;
        __builtin_amdgcn_s_waitcnt(0);
        unsigned nloc = b.st[0], nx = b.st[1];
        if (nloc == 0u) { xcd_barrier_complete(bar, b.x, nloc, nx); b.st[0] = nloc; b.st[1] = nx; }
        const unsigned old = xb_add(&bar[XB_XSUB(b.x)], 1u);
        const unsigned gen = old / nloc;
        if (old + 1u == (gen + 1u) * nloc) {
            __builtin_amdgcn_fence(__ATOMIC_RELEASE, "agent");
            asm volatile("s_waitcnt vmcnt(0)" ::: "memory");
            const unsigned og = xb_add(&bar[XB_TOP], 1u);
            const unsigned tg = og / nx;
            if (og + 1u == (tg + 1u) * nx) xb_add(&bar[XB_TOPGEN], 1u);
            else XB_SPIN(xb_ld(&bar[XB_TOPGEN]) == tg, bar);
            __builtin_amdgcn_fence(__ATOMIC_ACQUIRE, "agent");
            xb_add(&bar[XB_XGEN(b.x)], 1u);
            asm volatile("s_waitcnt vmcnt(0)" ::: "memory");
        } else {
            XB_SPIN(xb_ld(&bar[XB_TOPGEN]) == gen, bar);
            __builtin_amdgcn_fence(__ATOMIC_ACQUIRE, "agent");
            asm volatile("s_waitcnt vmcnt(0)" ::: "memory");
        }
    }
    __syncthreads();
}
__host__ __device__ __forceinline__ int r32map(int P) { return 16 * ((P >> 2) & 1) + 4 * (P >> 3) + (P & 3); }
__host__ __device__ __forceinline__ int p128(int x) { return (x & ~31) + r32map(x & 31); }
__host__ __device__ __forceinline__ int hdmap(int d) { if (d >= 16) return d; const int fq = (d >> 2) & 1, j = (d & 3) + 4 * (d >> 3); return 8 * fq + j; }
__host__ __device__ __forceinline__ int head_row(int wc, int d) { const int x = hdmap(d); return 128 * (x >> 5) + 32 * wc + r32map(x & 31); }
__device__ __forceinline__ int dstart(int bj, int fq, int half) { return (bj == 0 && fq < 2) ? 4 * fq + 8 * half : 32 * bj + 8 * fq + 4 * half; }

struct MapGate { __device__ __forceinline__ int operator()(int c) const { return 256 * (c >> 7) + p128(c & 127); } };
struct MapUp   { __device__ __forceinline__ int operator()(int c) const { return 256 * (c >> 7) + 128 + p128(c & 127); } };
struct MapLin  { __device__ __forceinline__ int operator()(int c) const { return (c & ~127) + p128(c & 127); } };
struct MapWin  { __device__ __forceinline__ int operator()(int c) const {
    if (c < 512) return 1024 + (c & ~127) + p128(c & 127);
    if (c < 1024) { const int ch = c - 512; return 256 * (ch >> 7) + p128(ch & 127); }
    if (c < 1536) { const int ch = c - 1024; return 256 * (ch >> 7) + 128 + p128(ch & 127); }
    if (c < 2048) { const int x = c - 1536, hd = x >> 6; return 256 * (6 + (hd >> 2)) + head_row(hd & 3, x & 63); }
    if (c < 2176) { const int x = c - 2048; return 256 * 8 + head_row(x >> 6, x & 63); }
    if (c < 2304) { const int x = c - 2176; return 256 * 8 + head_row(2 + (x >> 6), x & 63); }
    if (c < 2816) { const int x = c - 2304, hd = x >> 6; return 256 * (9 + (hd >> 2)) + head_row(hd & 3, x & 63); }
    if (c < 2880) return 256 * 11 + head_row(0, c - 2816);
    return 256 * 11 + 32 + r32map(c - 2880);
} };

using pg8::Unit; using pg8::bf16_t;
__device__ __forceinline__ float rstd_from(const float* ss, int row, int nslot) {
    float s = 0.f;
    if (nslot == 1) s = ss[row];
    else { const f32x4* p = (const f32x4*)(ss + (size_t)row * 16); const f32x4 a = p[0], b = p[1], c = p[2], d = p[3]; s = ((a.x + a.y) + (a.z + a.w)) + ((b.x + b.y) + (b.z + b.w)) + ((c.x + c.y) + (c.z + c.w)) + ((d.x + d.y) + (d.z + d.w)); }
    return __builtin_amdgcn_rsqf(s * (1.0f / D) + EPS);
}
__device__ __forceinline__ float clamp8(float x) { return __builtin_amdgcn_fmed3f(x, -440.0f, 440.0f); }
__device__ __forceinline__ unsigned pk4_fp8(float a, float b, float c, float d) { int w = __builtin_amdgcn_cvt_pk_fp8_f32(clamp8(a), clamp8(b), 0, false); w = __builtin_amdgcn_cvt_pk_fp8_f32(clamp8(c), clamp8(d), w, true); return (unsigned)w; }
#define EPI_CALL_ROWS() \
    __device__ __forceinline__ void operator()(f32x4 (&acc)[2][2][4][2], const Unit& u, int wr, int wc, int fr, int fq, int ui, bool has_next, const Unit& nxt) const { \
        _Pragma("unroll") for (int ai = 0; ai < 2; ++ai) _Pragma("unroll") for (int m = 0; m < 4; ++m) { \
            const f32x4 v[2][2] = {{acc[ai][0][m][0], acc[ai][0][m][1]}, {acc[ai][1][m][0], acc[ai][1][m][1]}}; \
            row(v, u.pm * 256 + ai * 128 + wr * 64 + m * 16 + fr, u.pn, wc, fr, fq, ui); \
            if (has_next) init_rg(acc, nxt, ai, m, wr, wc, fr, fq); } }                        \
    __device__ __forceinline__ void init(f32x4 (&acc)[2][2][4][2], const Unit& u, int wr, int wc, int fr, int fq) const { \
        _Pragma("unroll") for (int ai = 0; ai < 2; ++ai) _Pragma("unroll") for (int m = 0; m < 4; ++m) init_rg(acc, u, ai, m, wr, wc, fr, fq); }
#define EPI_ZERO_INIT() \
    __device__ __forceinline__ void init_rg(f32x4 (&acc)[2][2][4][2], const Unit&, int ai, int m, int, int, int, int) const { \
        _Pragma("unroll") for (int b = 0; b < 2; ++b) _Pragma("unroll") for (int n = 0; n < 2; ++n) acc[ai][b][m][n] = (f32x4){0.f, 0.f, 0.f, 0.f}; }
__device__ __forceinline__ float rstd_of(const LAS float* tab, const float* ss, int nslot, int row, int ui) { return (ui >= 0 && tab) ? tab[ui * 256 + (row & 255)] : rstd_from(ss, row, nslot); }
struct EpiGU {
    static constexpr bool PERM = false, AFTER_DRAIN = false;
    bf16_t* H; const float* ss; int nslot; const LAS float* tab; float wscale; unsigned char* H8; const float* wsn;
    __device__ __forceinline__ void row(const f32x4 (&v)[2][2], int row, int pn, int wc, int fr, int fq, int ui) const {
        typedef float f32x2 __attribute__((ext_vector_type(2)));
        const int col0 = pn * 128 + wc * 32 + 8 * fq;
        const float rs = rstd_of(tab, ss, nslot, row, ui) * (ui >= 0 ? wscale : 1.0f);
        const float c1 = -rs * LOG2E, rs2 = rs * rs;
        const bool f8 = H8 != nullptr;
        const float rs2s = f8 ? rs2 * H8SCALE : rs2;
        f32x2 hh[4];
#pragma unroll
        for (int n = 0; n < 2; ++n)
#pragma unroll
            for (int i = 0; i < 4; i += 2) { const f32x2 ag = {v[0][n][i], v[0][n][i + 1]}, au = {v[1][n][i], v[1][n][i + 1]};
                const f32x2 a = ag * c1; f32x2 e; e.x = __builtin_amdgcn_exp2f(a.x); e.y = __builtin_amdgcn_exp2f(a.y);
                const f32x2 d = e + 1.0f; f32x2 r; r.x = __builtin_amdgcn_rcpf(d.x); r.y = __builtin_amdgcn_rcpf(d.y);
                hh[2 * n + (i >> 1)] = (ag * au) * (r * rs2s); }
        if (f8) { v2u w8; w8.x = pk4_fp8(hh[0].x, hh[0].y, hh[1].x, hh[1].y); w8.y = pk4_fp8(hh[2].x, hh[2].y, hh[3].x, hh[3].y);
            *(v2u*)(H8 + (size_t)row * DFF + col0) = w8; }
        else { v4u w; w.x = pg8::cvt_pk_bf16(hh[0].x, hh[0].y); w.y = pg8::cvt_pk_bf16(hh[1].x, hh[1].y); w.z = pg8::cvt_pk_bf16(hh[2].x, hh[2].y); w.w = pg8::cvt_pk_bf16(hh[3].x, hh[3].y);
        __builtin_nontemporal_store(w, (v4u*)(H + (size_t)row * DFF + col0)); }
    }
    __device__ __forceinline__ void operator()(f32x4 (&acc)[2][2][4][2], const Unit& u, int wr, int wc, int fr, int fq, int ui, bool has_next, const Unit& nxt) const {
        typedef int v4i_ __attribute__((ext_vector_type(4)));
        f32x4 cs[2][2];
#pragma unroll
        for (int bj = 0; bj < 2; ++bj)
#pragma unroll
            for (int n = 0; n < 2; ++n) cs[bj][n] = wsn ? *(const f32x4*)(wsn + u.pn * 256 + bj * 128 + wc * 32 + n * 16 + 4 * fq) : (f32x4){1.f, 1.f, 1.f, 1.f};
#pragma unroll
        for (int ai = 0; ai < 2; ++ai)
#pragma unroll
            for (int m = 0; m < 4; ++m) {
                f32x4 v[2][2];
#pragma unroll
                for (int bj = 0; bj < 2; ++bj)
#pragma unroll
                    for (int n = 0; n < 2; ++n) v[bj][n] = wsn ? __builtin_convertvector(__builtin_bit_cast(v4i_, acc[ai][bj][m][n]), f32x4) * cs[bj][n] : acc[ai][bj][m][n];
                row(v, u.pm * 256 + ai * 128 + wr * 64 + m * 16 + fr, u.pn, wc, fr, fq, ui);
                if (has_next) init_rg(acc, nxt, ai, m, wr, wc, fr, fq); }
    }
    __device__ __forceinline__ void init(f32x4 (&acc)[2][2][4][2], const Unit& u, int wr, int wc, int fr, int fq) const {
#pragma unroll
        for (int ai = 0; ai < 2; ++ai)
#pragma unroll
            for (int m = 0; m < 4; ++m) init_rg(acc, u, ai, m, wr, wc, fr, fq); }
    EPI_ZERO_INIT()
};
__device__ __forceinline__ void bf8_to_f32(const v4u w, f32x4& lo, f32x4& hi) {
    lo = (f32x4){__uint_as_float(w.x << 16), __uint_as_float(w.x & 0xffff0000u), __uint_as_float(w.y << 16), __uint_as_float(w.y & 0xffff0000u)};
    hi = (f32x4){__uint_as_float(w.z << 16), __uint_as_float(w.z & 0xffff0000u), __uint_as_float(w.w << 16), __uint_as_float(w.w & 0xffff0000u)};
}
template <int MODE> struct EpiRes {
    static constexpr bool PERM = false, AFTER_DRAIN = false;
    const bf16_t* resb; float* out; bf16_t* outb; float* ss; unsigned char* out8; float ascale; const float* resf = nullptr; const float* resfs = nullptr;
    __device__ __forceinline__ void row(const f32x4 (&v)[2][2], int row, int pn, int wc, int fr, int fq, int ui) const {
        const bool pre = ui >= 0;
        const float alpha = ((MODE == 1) ? 1.0f : 0.5f) * (pre ? ascale : 1.0f);
        const bool live = row < MTOT;
        float sq = 0.f;
#pragma unroll
        for (int bj = 0; bj < 2; ++bj) {
            const int col = pn * 256 + bj * 128 + wc * 32 + 8 * fq;
            f32x4 r0 = (f32x4){0.f, 0.f, 0.f, 0.f}, r1 = r0;
            if (!pre && live) { if constexpr (MODE == 0) { r0 = *(const f32x4*)(resfs + (size_t)(row - MP) * D + col); r1 = *(const f32x4*)(resfs + (size_t)(row - MP) * D + col + 4); } else bf8_to_f32(*(const v4u*)(resb + (size_t)row * D + col), r0, r1); }
            const f32x4 v0 = r0 + alpha * v[bj][0], v1 = r1 + alpha * v[bj][1];
            if (MODE == 2) { if (live) { __builtin_nontemporal_store(v0, (f32x4*)(out + (size_t)row * D + col)); __builtin_nontemporal_store(v1, (f32x4*)(out + (size_t)row * D + col + 4)); } }
            else {
                v4u w; w.x = pg8::cvt_pk_bf16(v0[0], v0[1]); w.y = pg8::cvt_pk_bf16(v0[2], v0[3]); w.z = pg8::cvt_pk_bf16(v1[0], v1[1]); w.w = pg8::cvt_pk_bf16(v1[2], v1[3]);
                *(v4u*)(outb + (size_t)row * D + col) = w;
                if (MODE == 1 && out8) { v2u w8; w8.x = pk4_fp8(v0[0], v0[1], v0[2], v0[3]); w8.y = pk4_fp8(v1[0], v1[1], v1[2], v1[3]); *(v2u*)(out8 + (size_t)row * D + col) = w8; }
                sq += (v0[0] * v0[0] + v0[1] * v0[1]) + (v0[2] * v0[2] + v0[3] * v0[3]) + (v1[0] * v1[0] + v1[1] * v1[1]) + (v1[2] * v1[2] + v1[3] * v1[3]);
            }
        }
        if (MODE != 2) { sq += __shfl_xor(sq, 16); sq += __shfl_xor(sq, 32); if (fq == 0) ss[(size_t)row * 16 + pn * 4 + wc] = sq; }
    }
    EPI_CALL_ROWS()
    __device__ __forceinline__ void init_rg(f32x4 (&acc)[2][2][4][2], const Unit& u, int ai, int m, int wr, int wc, int fr, int fq) const {
        const float ia = ((MODE == 1) ? 1.0f : 2.0f) / ascale;
        const size_t ro = (size_t)(u.pm * 256 + ai * 128 + wr * 64 + m * 16 + fr) * D + u.pn * 256 + wc * 32 + 8 * fq;
#pragma unroll
        for (int bj = 0; bj < 2; ++bj) { f32x4 lo, hi;
            if constexpr (MODE == 0) { lo = *(const f32x4*)(resf + ro + bj * 128); hi = *(const f32x4*)(resf + ro + bj * 128 + 4); } else bf8_to_f32(*(const v4u*)(resb + ro + bj * 128), lo, hi);
            acc[ai][bj][m][0] = lo * ia; acc[ai][bj][m][1] = hi * ia; }
    }
};
struct EpiWin {
    static constexpr bool PERM = false, AFTER_DRAIN = false;
    unsigned char* ws; float* out; const float* qn; const float* kn; const LAS float* tab;
    __device__ __forceinline__ void row(const f32x4 (&acc)[2][2], int row, int pn, int wc, int fr, int fq, int ui) const {
        const float* ss = (const float*)(ws + WS_SS1); bf16_t* U = (bf16_t*)(ws + WS_U); bf16_t* GB = (bf16_t*)(ws + WS_GB); float* WI = (float*)(ws + WS_WI); const float* rope = (const float*)(ws + WS_ROPE);
        if (pn == 11 && wc >= 2) return;
        const int type = pn < 4 ? 0 : pn < 6 ? 1 : pn < 8 ? 2 : pn == 8 ? (wc < 2 ? 3 : 4) : pn < 11 ? 5 : (wc == 0 ? 6 : 7);
        const int head = (type == 2) ? 4 * (pn - 6) + wc : (type == 5) ? 4 * (pn - 9) + wc : (type == 3) ? wc : (type == 4) ? wc - 2 : 0;
        const bool live = row < MTOT;
        const float rs = rstd_of(tab, ss, 16, row, ui);
        if (type == 0) {
            const int ch0 = pn * 128 + wc * 32 + 8 * fq;
            const f32x4 u0 = (acc[0][0] * rs) * (acc[1][0] * rs), u1 = (acc[0][1] * rs) * (acc[1][1] * rs);
            v4u w; w.x = pg8::cvt_pk_bf16(u0[0], u0[1]); w.y = pg8::cvt_pk_bf16(u0[2], u0[3]); w.z = pg8::cvt_pk_bf16(u1[0], u1[1]); w.w = pg8::cvt_pk_bf16(u1[2], u1[3]);
            *(v4u*)(U + (size_t)row * 512 + ch0) = w;
            if (row < MP) { const int s = row & (SEQ - 1); if (s >= SEQ - 2) { float* o = out + O_CP + ((size_t)(row >> 11) * 2 + (s - (SEQ - 2))) * 512 + ch0; *(f32x4*)o = u0; *(f32x4*)(o + 4) = u1; } }
            else if (live) { const int sr = row - MP, s = sr & 3; if (s >= 2) { float* o = out + O_CS + ((size_t)(sr >> 2) * 2 + (s - 2)) * 512 + ch0; *(f32x4*)o = u0; *(f32x4*)(o + 4) = u1; } }
        } else if (type == 1) {
#pragma unroll
            for (int bj = 0; bj < 2; ++bj) { const int col = (pn - 4) * 256 + bj * 128 + wc * 32 + 8 * fq; const f32x4 a = acc[bj][0] * rs, b = acc[bj][1] * rs;
                v4u w; w.x = pg8::cvt_pk_bf16(a[0], a[1]); w.y = pg8::cvt_pk_bf16(a[2], a[3]); w.z = pg8::cvt_pk_bf16(b[0], b[1]); w.w = pg8::cvt_pk_bf16(b[2], b[3]);
                *(v4u*)(GB + (size_t)row * 512 + col) = w; }
        } else if (type == 7) {
            if (fq == 0) { *(f32x4*)(WI + (size_t)row * 8) = acc[0][0] * rs; *(f32x4*)(WI + (size_t)row * 8 + 4) = acc[0][1] * rs; }
        } else {
            f32x4 v[2][2];
#pragma unroll
            for (int bj = 0; bj < 2; ++bj) { v[bj][0] = acc[bj][0] * rs; v[bj][1] = acc[bj][1] * rs; }
            if (type == 2 || type == 3) {
                float sq = 0.f;
#pragma unroll
                for (int bj = 0; bj < 2; ++bj)
#pragma unroll
                    for (int h2 = 0; h2 < 2; ++h2) sq += (v[bj][h2][0] * v[bj][h2][0] + v[bj][h2][1] * v[bj][h2][1]) + (v[bj][h2][2] * v[bj][h2][2] + v[bj][h2][3] * v[bj][h2][3]);
                sq += __shfl_xor(sq, 16); sq += __shfl_xor(sq, 32);
                const float sc = __builtin_amdgcn_rsqf(sq * (1.0f / 64.0f) + EPS);
#pragma unroll
                for (int bj = 0; bj < 2; ++bj)
#pragma unroll
                    for (int h2 = 0; h2 < 2; ++h2) { const f32x4 gq = *(const f32x4*)(qn + dstart(bj, fq, h2)), gk = *(const f32x4*)(kn + dstart(bj, fq, h2)); v[bj][h2] = v[bj][h2] * sc * ((type == 2) ? gq : gk); }
            }
            if (type != 4 && fq < 2) {
                const int pidx = row < MP ? (row & (SEQ - 1)) : (live ? SEQ + ((row - MP) & 3) : 0);
                const float* rp = rope + ((size_t)pidx * 8 + 4 * fq) * 2;
                const f32x4 cs0 = *(const f32x4*)rp, cs1 = *(const f32x4*)(rp + 4);
                const f32x4 x1 = v[0][0], x2 = v[0][1];
                const f32x4 c = (f32x4){cs0[0], cs0[2], cs1[0], cs1[2]}, s = (f32x4){cs0[1], cs0[3], cs1[1], cs1[3]};
                v[0][0] = x1 * c - x2 * s; v[0][1] = x2 * c + x1 * s;
            }
            const size_t boff = (type == 2) ? WS_Q : (type == 3) ? WS_KB : (type == 4) ? WS_VB : (type == 5) ? WS_QI : WS_KIB;
            const int bp = (type == 2 || type == 5) ? 512 : (type == 6) ? 64 : 128; const float bsc = (type == 2) ? QSCALE : 1.0f;
            bf16_t* bdst = (bf16_t*)(ws + boff);
            const bool hasf = live && (type == 3 || type == 4 || type == 6);
            const size_t fbase = (type == 3) ? (row < MP ? O_KP : O_KS) : (type == 4) ? (row < MP ? O_VP : O_VS) : (row < MP ? O_IP : O_IS);
            float* fdst = out + fbase + (size_t)(row < MP ? row : row - MP) * (type == 6 ? 64 : 128);
#pragma unroll
            for (int bj = 0; bj < 2; ++bj)
#pragma unroll
                for (int h2 = 0; h2 < 2; ++h2) { const int d = head * 64 + dstart(bj, fq, h2); const f32x4 x = v[bj][h2];
                    if (hasf) { if (row < MP) __builtin_nontemporal_store(x, (f32x4*)(fdst + d)); else *(f32x4*)(fdst + d) = x; }
                    v2u w; w.x = pg8::cvt_pk_bf16(x[0] * bsc, x[1] * bsc); w.y = pg8::cvt_pk_bf16(x[2] * bsc, x[3] * bsc);
                    *(v2u*)(bdst + (size_t)row * bp + d) = w; }
        }
    }
    EPI_CALL_ROWS()
    EPI_ZERO_INIT()
};
template <class Epi, int MT, int QM> __device__ __forceinline__ void skinny_unit(PG8_LAS unsigned char* lds, const unsigned char* A, const unsigned char* Bt, int KB, int pn, int wc, int rg, const Epi& E,
                                                                                const float* xs, const float* wsn, float oscale) {
    typedef int v4i_ __attribute__((ext_vector_type(4)));
    const int tid = threadIdx.x, wid = __builtin_amdgcn_readfirstlane(tid >> 6), lane = tid & 63, fr = lane & 15, fq = lane >> 4;
    const int TP = KB >> 7, base = TP >> 3, rem = TP & 7;
    const int np = base + (wid < rem ? 1 : 0), p0 = wid * base + (wid < rem ? wid : rem);
    const unsigned char* ap = A + (size_t)(MP + 16 * MT * rg + fr) * KB + p0 * 128 + 16 * fq;
    const unsigned char* bp = Bt + (size_t)(256 * pn + 32 * wc + fr) * KB + p0 * 128 + 16 * fq;
    pg8::f32x4 acc[MT][2][2];
#pragma unroll
    for (int mt = 0; mt < MT; ++mt)
#pragma unroll
        for (int bj = 0; bj < 2; ++bj)
#pragma unroll
            for (int n = 0; n < 2; ++n) acc[mt][bj][n] = (pg8::f32x4){0.f, 0.f, 0.f, 0.f};
    v4i_ a0[MT], b0[2][2], a1[MT], b1[2][2], a2[MT], b2[2][2], a3[MT], b3[2][2];
#define SK_LOADP(afe, bfe, afo, bfo, p_) do { \
        _Pragma("unroll") for (int mt = 0; mt < MT; ++mt) { afe[mt] = *(const v4i_*)(ap + (size_t)(16 * mt) * KB + 128 * (p_)); afo[mt] = *(const v4i_*)(ap + (size_t)(16 * mt) * KB + 128 * (p_) + 64); } \
        _Pragma("unroll") for (int bj = 0; bj < 2; ++bj) _Pragma("unroll") for (int n = 0; n < 2; ++n) { bfe[bj][n] = *(const v4i_*)(bp + (size_t)(128 * bj + 16 * n) * KB + 128 * (p_)); bfo[bj][n] = *(const v4i_*)(bp + (size_t)(128 * bj + 16 * n) * KB + 128 * (p_) + 64); } } while (0)
#define SK_MMA(af, bf) do { _Pragma("unroll") for (int mt = 0; mt < MT; ++mt) _Pragma("unroll") for (int bj = 0; bj < 2; ++bj) _Pragma("unroll") for (int n = 0; n < 2; ++n) { \
        if constexpr (QM == 0) acc[mt][bj][n] = __builtin_amdgcn_mfma_f32_16x16x32_bf16(__builtin_bit_cast(pg8::bf16x8, bf[bj][n]), __builtin_bit_cast(pg8::bf16x8, af[mt]), acc[mt][bj][n], 0, 0, 0); \
        else if constexpr (QM == 2) acc[mt][bj][n] = __builtin_bit_cast(pg8::f32x4, __builtin_amdgcn_mfma_i32_16x16x64_i8(bf[bj][n], af[mt], __builtin_bit_cast(v4i_, acc[mt][bj][n]), 0, 0, 0)); \
        else { typedef long l2_ __attribute__((ext_vector_type(2))); const l2_ bl_ = __builtin_bit_cast(l2_, bf[bj][n]), al_ = __builtin_bit_cast(l2_, af[mt]); \
            acc[mt][bj][n] = __builtin_amdgcn_mfma_f32_16x16x32_fp8_fp8(bl_[0], al_[0], acc[mt][bj][n], 0, 0, 0); acc[mt][bj][n] = __builtin_amdgcn_mfma_f32_16x16x32_fp8_fp8(bl_[1], al_[1], acc[mt][bj][n], 0, 0, 0); } } } while (0)
    SK_LOADP(a0, b0, a1, b1, 0); if (np > 1) SK_LOADP(a2, b2, a3, b3, 1);
    for (int p = 0; p < np; p += 2) {
        SK_MMA(a0, b0); SK_MMA(a1, b1);
        if (p + 2 < np) SK_LOADP(a0, b0, a1, b1, p + 2);
        if (p + 1 < np) { SK_MMA(a2, b2); SK_MMA(a3, b3);
            if (p + 3 < np) SK_LOADP(a2, b2, a3, b3, p + 3); }
    }
#undef SK_LOADP
#undef SK_MMA
    PG8_LAS pg8::f32x4* slab = (PG8_LAS pg8::f32x4*)lds;
#pragma unroll
    for (int mt = 0; mt < MT; ++mt)
#pragma unroll
        for (int bj = 0; bj < 2; ++bj)
#pragma unroll
            for (int n = 0; n < 2; ++n) { pg8::f32x4 t = acc[mt][bj][n];
                if constexpr (QM == 2) { const v4i_ ti = __builtin_bit_cast(v4i_, t); t = (pg8::f32x4){(float)ti[0], (float)ti[1], (float)ti[2], (float)ti[3]}; }
                slab[((wid * MT + mt) * 4 + bj * 2 + n) * 64 + lane] = t; }
    __syncthreads();
    if (wid < MT) { pg8::f32x4 v[2][2]; const int row = MP + 16 * MT * rg + 16 * wid + fr;
      float rsc = oscale; if constexpr (QM == 2) rsc = xs[row];
#pragma unroll
      for (int bj = 0; bj < 2; ++bj)
#pragma unroll
          for (int n = 0; n < 2; ++n) { const int o = (wid * 4 + bj * 2 + n) * 64 + lane; pg8::f32x4 t = slab[o];
#pragma unroll
              for (int q = 1; q < 8; ++q) t = t + slab[o + q * MT * 4 * 64];
              if constexpr (QM == 2) t = t * (*(const pg8::f32x4*)(wsn + 256 * pn + 128 * bj + 32 * wc + 16 * n + 4 * fq)) * rsc;
              else if constexpr (QM == 1) t = t * rsc;
              v[bj][n] = t; }
      E.row(v, row, pn, wc, fr, fq, -1); }
    __syncthreads();
}
template <class Epi, int MT, int QM> __device__ __forceinline__ void skinny_phase(PG8_LAS unsigned char* lds, const void* A, const void* Bt, int N, int KB, int blk, int G, const Epi& E,
                                                                                 const float* xs = nullptr, const float* wsn = nullptr, float oscale = 1.0f) {
    constexpr int NRG = 8 / MT; const int nu = (N / 256) * 4 * NRG;
    for (int u = blk; u < nu; u += G) skinny_unit<Epi, MT, QM>(lds, (const unsigned char*)A, (const unsigned char*)Bt, KB, u / (4 * NRG), (u / NRG) & 3, u % NRG, E, xs, wsn, oscale);
}
__device__ __forceinline__ void fill_rstd_table(LAS float* tab, const pg8::StaticOrder& S, const float* ss, int nslot, const float* xs = nullptr) {
    const int tid = threadIdx.x; Unit u; int nu = 0;
    while (nu < 11 && S.next(nu, u)) ++nu;
    float sv[6], xsv[6]; int ix[6];
#pragma unroll
    for (int k2 = 0; k2 < 6; ++k2) { const int idx = tid + 512 * k2; ix[k2] = idx; const bool ok = idx < nu * 256; Unit uu_; S.next(ok ? (idx >> 8) : 0, uu_); const int row = uu_.pm * 256 + (idx & 255);
        float s_ = 0.f;
        if (nslot == 1) s_ = ss[row];
        else { const f32x4* p = (const f32x4*)(ss + (size_t)row * 16); const f32x4 a = p[0], b = p[1], c = p[2], d = p[3]; s_ = ((a.x + a.y) + (a.z + a.w)) + ((b.x + b.y) + (b.z + b.w)) + ((c.x + c.y) + (c.z + c.w)) + ((d.x + d.y) + (d.z + d.w)); }
        sv[k2] = s_; xsv[k2] = xs ? xs[row] : 1.0f; }
#pragma unroll
    for (int k2 = 0; k2 < 6; ++k2) if (ix[k2] < nu * 256) tab[ix[k2]] = __builtin_amdgcn_rsqf(sv[k2] * (1.0f / D) + EPS) * xsv[k2];
    __syncthreads();
}
__device__ __forceinline__ void quant_rows_pass(int gw, int NGW, const bf16_t* X, unsigned char* Q, float* XS, int nrows) {
    const int lane = threadIdx.x & 63;
    for (int g8 = gw; g8 < nrows / 8; g8 += NGW) {
        const int m0 = 8 * g8; v4u a[8][2];
#pragma unroll
        for (int r = 0; r < 8; ++r) { a[r][0] = *(const v4u*)(X + (size_t)(m0 + r) * D + 8 * lane); a[r][1] = *(const v4u*)(X + (size_t)(m0 + r) * D + 512 + 8 * lane); }
#pragma unroll
        for (int r = 0; r < 8; ++r) {
            float x[16];
#pragma unroll
            for (int e = 0; e < 4; ++e) { x[2 * e] = __uint_as_float(a[r][0][e] << 16); x[2 * e + 1] = __uint_as_float(a[r][0][e] & 0xffff0000u); x[8 + 2 * e] = __uint_as_float(a[r][1][e] << 16); x[9 + 2 * e] = __uint_as_float(a[r][1][e] & 0xffff0000u); }
            float mx = 0.f;
#pragma unroll
            for (int e = 0; e < 16; ++e) mx = fmaxf(mx, fabsf(x[e]));
            { unsigned v = __float_as_uint(mx), o;
              o = (unsigned)__builtin_amdgcn_update_dpp(0, (int)v, 0xB1, 0xF, 0xF, true); v = o > v ? o : v;
              o = (unsigned)__builtin_amdgcn_update_dpp(0, (int)v, 0x4E, 0xF, 0xF, true); v = o > v ? o : v;
              o = (unsigned)__builtin_amdgcn_update_dpp(0, (int)v, 0x141, 0xF, 0xF, true); v = o > v ? o : v;
              o = (unsigned)__builtin_amdgcn_update_dpp(0, (int)v, 0x140, 0xF, 0xF, true); v = o > v ? o : v;
              const unsigned p0 = (unsigned)__builtin_amdgcn_readlane((int)v, 0), p1 = (unsigned)__builtin_amdgcn_readlane((int)v, 16), p2 = (unsigned)__builtin_amdgcn_readlane((int)v, 32), p3 = (unsigned)__builtin_amdgcn_readlane((int)v, 48);
              const unsigned q0 = p0 > p1 ? p0 : p1, q1 = p2 > p3 ? p2 : p3; mx = __uint_as_float(q0 > q1 ? q0 : q1); }
            const float iq = mx > 0.f ? 127.0f / mx : 0.f;
            unsigned w[4];
#pragma unroll
            for (int e = 0; e < 4; ++e) { const int q0 = (int)__builtin_rintf(x[4 * e] * iq), q1 = (int)__builtin_rintf(x[4 * e + 1] * iq), q2 = (int)__builtin_rintf(x[4 * e + 2] * iq), q3 = (int)__builtin_rintf(x[4 * e + 3] * iq);
                w[e] = (unsigned)(q0 & 0xff) | ((unsigned)(q1 & 0xff) << 8) | ((unsigned)(q2 & 0xff) << 16) | ((unsigned)(q3 & 0xff) << 24); }
            *(v2u*)(Q + (size_t)(m0 + r) * D + 8 * lane) = (v2u){w[0], w[1]};
            *(v2u*)(Q + (size_t)(m0 + r) * D + 512 + 8 * lane) = (v2u){w[2], w[3]};
            if (lane == 0) XS[m0 + r] = mx * (1.0f / 127.0f);
        }
    }
}
struct Frame {
    LAS unsigned char* lds;
    volatile LAS unsigned* MISC;
    gu32* ctl;
    int tid, lane, wave, vcu, G;
    const void* const* in;
    float* out; unsigned char* ws;
};
#define WSP(T, off) ((T*)(F.ws + (off)))

template <class Map> __device__ __forceinline__ void p0_transpose_item(const float* W, int K, int N, const float* gain, bf16* WT, LAS float* scr, int item, int lane, const Map map, unsigned char* WT8 = nullptr) {
    const int nblk = (N + 31) / 32, kb = item / nblk, nb = item % nblk, k0 = 64 * kb, n0 = 32 * nb;
    const bool nok = n0 + (lane & 31) < N;
    { float v[32], gn[32];
#pragma unroll
      for (int i = 0; i < 32; ++i) { const int kk = 2 * i + (lane >> 5); v[i] = nok ? __builtin_nontemporal_load(W + (size_t)(k0 + kk) * N + n0 + (lane & 31)) : 0.f; gn[i] = gain ? gain[k0 + kk] : 1.0f; }
#pragma unroll
      for (int i = 0; i < 32; ++i) { const int kk = 2 * i + (lane >> 5); scr[kk * 33 + (lane & 31)] = v[i] * gn[i]; } }
    LDS_WAIT(); asm volatile("" ::: "memory");
    const int c = lane & 7;
#pragma unroll
    for (int j = 0; j < 4; ++j) { const int n = (lane >> 3) + 8 * j; const LAS float* s = scr + (8 * c) * 33 + n;
        v4u o; o.x = pk2(s[0 * 33], s[1 * 33]); o.y = pk2(s[2 * 33], s[3 * 33]); o.z = pk2(s[4 * 33], s[5 * 33]); o.w = pk2(s[6 * 33], s[7 * 33]);
        if (n0 + n < N) { if (WT) *(GAS v4u*)(WT + (size_t)map(n0 + n) * K + k0 + 8 * c) = o;
            if (WT8) { v2u o8; o8.x = pk4_fp8(s[0 * 33] * W8SCALE, s[1 * 33] * W8SCALE, s[2 * 33] * W8SCALE, s[3 * 33] * W8SCALE); o8.y = pk4_fp8(s[4 * 33] * W8SCALE, s[5 * 33] * W8SCALE, s[6 * 33] * W8SCALE, s[7 * 33] * W8SCALE);
                *(GAS v2u*)(WT8 + (size_t)map(n0 + n) * K + k0 + 8 * c) = o8; } } }
    LDS_WAIT(); asm volatile("" ::: "memory");
}
__device__ __forceinline__ void sincos_d(double a, float& s, float& c) {
    const double TWO_PI = 6.283185307179586476925286766559, PI = 3.14159265358979323846264338327950288;
    double k = __builtin_rint(a / TWO_PI); double r = a - k * TWO_PI;
    double sgn = 1.0; if (r > PI * 0.5) { r = PI - r; sgn = -1.0; } else if (r < -PI * 0.5) { r = -PI - r; sgn = -1.0; }
    const double r2 = r * r;
    double ts = 1.0, tc = 1.0, ps = 1.0, pc = 1.0;
#pragma unroll
    for (int n = 1; n <= 12; ++n) { pc = -pc * r2 / (double)((2 * n - 1) * (2 * n)); ps = -ps * r2 / (double)((2 * n) * (2 * n + 1)); tc += pc; ts += ps; }
    s = (float)(r * ts); c = (float)(sgn * tc);
}
__device__ __forceinline__ void p0_prologue(Frame& F) {
    LAS float* scr = (LAS float*)(F.lds + RING_OFF + F.wave * 16384);
    const int gw = F.vcu * 8 + F.wave, NGW = F.G * 8;
    constexpr int I_G = (D / 64) * (DFF / 32), I_D = (DFF / 64) * (D / 32), I_IN = (D / 64) * ((NIN + 31) / 32), I_O = (D / 64) * (D / 32);
    constexpr int NITEMS = 2 * (2 * I_G + I_D) + I_IN + I_O;
    for (int rep63 = 0; rep63 < (PROBE_DUP == 63 ? 2 : 1); ++rep63)
    for (int it = gw; it < NITEMS; it += NGW) {
        int r = it;
        if (r < I_G) { p0_transpose_item(((const float*)F.in[8]), D, DFF, ((const float*)F.in[7]), WSP(bf16, WS_WGU1), scr, r, F.lane, MapGate()); continue; } r -= I_G;
        if (r < I_G) { p0_transpose_item(((const float*)F.in[9]), D, DFF, ((const float*)F.in[7]), WSP(bf16, WS_WGU1), scr, r, F.lane, MapUp()); continue; } r -= I_G;
        if (r < I_D) { p0_transpose_item(((const float*)F.in[10]), DFF, D, nullptr, (bf16*)nullptr, scr, r, F.lane, MapLin(), WSP(unsigned char, WS_WD1_8)); continue; } r -= I_D;
        if (r < I_G) { p0_transpose_item(((const float*)F.in[19]), D, DFF, ((const float*)F.in[18]), WSP(bf16, WS_WGU2), scr, r, F.lane, MapGate()); continue; } r -= I_G;
        if (r < I_G) { p0_transpose_item(((const float*)F.in[20]), D, DFF, ((const float*)F.in[18]), WSP(bf16, WS_WGU2), scr, r, F.lane, MapUp()); continue; } r -= I_G;
        if (r < I_D) { p0_transpose_item(((const float*)F.in[21]), DFF, D, nullptr, (bf16*)nullptr, scr, r, F.lane, MapLin(), WSP(unsigned char, WS_WD2_8)); continue; } r -= I_D;
        if (r < I_IN) { p0_transpose_item(((const float*)F.in[12]), D, NIN, ((const float*)F.in[11]), WSP(bf16, WS_WIN), scr, r, F.lane, MapWin()); continue; } r -= I_IN;
        p0_transpose_item(((const float*)F.in[17]), D, D, nullptr, WSP(bf16, WS_WOUT), scr, r, F.lane, MapLin());
    }
    float* SS0 = WSP(float, WS_SS0);
    for (int rep64 = 0; rep64 < (PROBE_DUP == 64 ? 2 : 1); ++rep64)
    for (int g4 = gw; g4 < MTOT / 4; g4 += NGW) {
        const int m0 = 4 * g4;
        const float* xrow = m0 < MP ? ((const float*)F.in[0]) + (size_t)m0 * D : ((const float*)F.in[1]) + (size_t)(m0 - MP) * D;
        const GAS f32x4* xr = (const GAS f32x4*)xrow + F.lane;
        f32x4 v[4][4]; float s[4];
#pragma unroll
        for (int r = 0; r < 4; ++r)
#pragma unroll
            for (int j = 0; j < 4; ++j) v[r][j] = __builtin_nontemporal_load((const f32x4*)(xr + 256 * r + 64 * j));
#pragma unroll
        for (int r = 0; r < 4; ++r) { s[r] = 0.f;
#pragma unroll
            for (int j = 0; j < 4; ++j) s[r] += (v[r][j].x * v[r][j].x + v[r][j].y * v[r][j].y) + (v[r][j].z * v[r][j].z + v[r][j].w * v[r][j].w); }
#pragma unroll
        for (int o = 1; o < 64; o <<= 1) {
#pragma unroll
            for (int r = 0; r < 4; ++r) s[r] += __shfl_xor(s[r], o); }
        { float mx[4];
#pragma unroll
          for (int r = 0; r < 4; ++r) { mx[r] = 0.f;
#pragma unroll
              for (int j = 0; j < 4; ++j) mx[r] = fmaxf(mx[r], fmaxf(fmaxf(fabsf(v[r][j].x), fabsf(v[r][j].y)), fmaxf(fabsf(v[r][j].z), fabsf(v[r][j].w)))); }
#pragma unroll
          for (int o = 1; o < 64; o <<= 1) {
#pragma unroll
              for (int r = 0; r < 4; ++r) mx[r] = fmaxf(mx[r], __shfl_xor(mx[r], o)); }
          GAS unsigned* q8 = (GAS unsigned*)(WSP(unsigned char, WS_XI8) + (size_t)m0 * D) + F.lane;
#pragma unroll
          for (int r = 0; r < 4; ++r) { const float iq = mx[r] > 0.f ? 127.0f / mx[r] : 0.f;
#pragma unroll
              for (int j = 0; j < 4; ++j) { const int a_ = (int)__builtin_rintf(v[r][j].x * iq), b_ = (int)__builtin_rintf(v[r][j].y * iq), c_ = (int)__builtin_rintf(v[r][j].z * iq), d_ = (int)__builtin_rintf(v[r][j].w * iq);
                  q8[256 * r + 64 * j] = (unsigned)(a_ & 0xff) | ((unsigned)(b_ & 0xff) << 8) | ((unsigned)(c_ & 0xff) << 16) | ((unsigned)(d_ & 0xff) << 24); } }
          if (F.lane < 4) WSP(float, WS_XS)[m0 + F.lane] = (F.lane == 0 ? mx[0] : F.lane == 1 ? mx[1] : F.lane == 2 ? mx[2] : mx[3]) * (1.0f / 127.0f); }
        if (F.lane < 4) SS0[m0 + F.lane] = F.lane == 0 ? s[0] : F.lane == 1 ? s[1] : F.lane == 2 ? s[2] : s[3];
    }
    { float* rope = WSP(float, WS_ROPE);
      const double invf[8] = {1.0, 0.19392274474868576, 0.03760603093086393, 0.007292664737217109, 0.001414213562373095, 0.0002742481756762073, 5.318295896944988e-05, 1.031338537721246e-05};
      for (int rep65 = 0; rep65 < (PROBE_DUP == 65 ? 2 : 1); ++rep65)
      for (int e = (F.vcu * 512 + F.tid); e < 2052 * 8; e += F.G * 512) { const int p = e >> 3, i = e & 7; const double pos = (double)(p < SEQ ? p : PAST + (p - SEQ));
          double f = invf[0];
#pragma unroll
          for (int q = 1; q < 8; ++q) f = (i == q) ? invf[q] : f;
          float s, c; sincos_d(pos * f, s, c); rope[2 * e] = c; rope[2 * e + 1] = s; } }
}

__device__ __forceinline__ void unpack8(const v4u a, float (&o)[8]) {
#pragma unroll
    for (int e = 0; e < 4; ++e) { o[2 * e] = bf2f((unsigned short)(a[e] & 0xffffu)); o[2 * e + 1] = bf2f((unsigned short)(a[e] >> 16)); }
}
__device__ __forceinline__ void p0b_quant_weights(Frame& F) {
    const int gw = F.vcu * 8 + F.wave, NGW = F.G * 8;
    for (int rr0 = gw; rr0 < 4 * DFF; rr0 += 4 * NGW) {
        v4u a[4], b[4];
#pragma unroll
        for (int i = 0; i < 4; ++i) { const int rr = rr0 + i * NGW < 4 * DFF ? rr0 + i * NGW : rr0; const bool second = rr >= 2 * DFF; const int r = second ? rr - 2 * DFF : rr;
            const bf16* W = second ? WSP(bf16, WS_WGU2) : WSP(bf16, WS_WGU1);
            a[i] = *(const GAS v4u*)(W + (size_t)r * D + 8 * F.lane); b[i] = *(const GAS v4u*)(W + (size_t)r * D + 512 + 8 * F.lane); }
#pragma unroll
        for (int i = 0; i < 4; ++i) { const int rr = rr0 + i * NGW; if (rr >= 4 * DFF) break;
            const bool second = rr >= 2 * DFF; const int r = second ? rr - 2 * DFF : rr;
            unsigned char* Q = second ? WSP(unsigned char, WS_WGU2I8) : WSP(unsigned char, WS_WGU1I8); float* WSN = second ? WSP(float, WS_WSN2) : WSP(float, WS_WSN);
            float x[16]; { float t0[8], t1[8]; unpack8(a[i], t0); unpack8(b[i], t1);
#pragma unroll
                for (int e = 0; e < 8; ++e) { x[e] = t0[e]; x[8 + e] = t1[e]; } }
            float mx = 0.f;
#pragma unroll
            for (int e = 0; e < 16; ++e) mx = fmaxf(mx, fabsf(x[e]));
#pragma unroll
            for (int o = 1; o < 64; o <<= 1) mx = fmaxf(mx, __shfl_xor(mx, o));
            const float iq = mx > 0.f ? 127.0f / mx : 0.f;
            unsigned w[4];
#pragma unroll
            for (int e = 0; e < 4; ++e) { const int q0 = (int)__builtin_rintf(x[4 * e] * iq), q1 = (int)__builtin_rintf(x[4 * e + 1] * iq), q2 = (int)__builtin_rintf(x[4 * e + 2] * iq), q3 = (int)__builtin_rintf(x[4 * e + 3] * iq);
                w[e] = (unsigned)(q0 & 0xff) | ((unsigned)(q1 & 0xff) << 8) | ((unsigned)(q2 & 0xff) << 16) | ((unsigned)(q3 & 0xff) << 24); }
            *(GAS v2u*)(Q + (size_t)r * D + 8 * F.lane) = (v2u){w[0], w[1]};
            *(GAS v2u*)(Q + (size_t)r * D + 512 + 8 * F.lane) = (v2u){w[2], w[3]};
            if (F.lane == 0) WSN[r] = mx * (1.0f / 127.0f); }
    }
}
__device__ __forceinline__ void p4_conv(Frame& F) {
    const int gw = F.vcu * 8 + F.wave, NGW = F.G * 8, ch = F.lane * 8;
    const bf16* U = WSP(bf16, WS_U); const bf16* GBp = WSP(bf16, WS_GB); bf16* CAT = WSP(bf16, WS_CAT);
    const float* conv_w = (const float*)F.in[13]; const float* conv_b = (const float*)F.in[14]; const float* cache_conv = (const float*)F.in[5];
    float w0[8], w1[8], w2[8], cb[8];
#pragma unroll
    for (int e = 0; e < 8; ++e) { w0[e] = conv_w[ch + e]; w1[e] = conv_w[512 + ch + e]; w2[e] = conv_w[1024 + ch + e]; cb[e] = conv_b[ch + e]; }
    for (int c = gw; c < MTOT / 8; c += NGW) {
        const int r0 = 8 * c;
        v4u ur[10], gr[8];
#pragma unroll
        for (int e = 0; e < 10; ++e) { const int rr = r0 - 2 + e; ur[e] = *(const GAS v4u*)(U + (size_t)(rr < 0 ? 0 : rr) * 512 + ch); }
#pragma unroll
        for (int e = 0; e < 8; ++e) gr[e] = *(const GAS v4u*)(GBp + (size_t)(r0 + e) * 512 + ch);
        float um2[8], um1[8];
        unpack8(ur[0], um2); unpack8(ur[1], um1);
        if (r0 < MP && (r0 & (SEQ - 1)) == 0) {
#pragma unroll
            for (int e = 0; e < 8; ++e) { um2[e] = 0.f; um1[e] = 0.f; } }
#pragma unroll
        for (int e = 0; e < 8; ++e) {
            if (r0 >= MP && (e & 3) == 0) {
                const float* cc = cache_conv + (size_t)((r0 - MP + e) >> 2) * 2 * 512 + ch;
#pragma unroll
                for (int q = 0; q < 8; ++q) { um2[q] = cc[q]; um1[q] = cc[512 + q]; } }
            float u0[8], g[8], y[8]; unpack8(ur[2 + e], u0); unpack8(gr[e], g);
#pragma unroll
            for (int q = 0; q < 8; ++q) { y[q] = g[q] * (cb[q] + w0[q] * um2[q] + w1[q] * um1[q] + w2[q] * u0[q]); um2[q] = um1[q]; um1[q] = u0[q]; }
            v4u o; o.x = pk2(y[0], y[1]); o.y = pk2(y[2], y[3]); o.z = pk2(y[4], y[5]); o.w = pk2(y[6], y[7]);
            *(GAS v4u*)(CAT + (size_t)(r0 + e) * D + ch) = o;
        }
    }
}
__device__ __forceinline__ int crow16(int r, int hi) { return (r & 3) + 8 * (r >> 2) + 4 * hi; }
__device__ __forceinline__ float xhalf_sum(float v) {
    auto rr = __builtin_amdgcn_permlane32_swap(__float_as_uint(v), __float_as_uint(v), false, false);
    return __uint_as_float(rr[0]) + __uint_as_float(rr[1]);
}
__device__ __forceinline__ void p4_sample_scores(Frame& F) {
    const int gw = F.vcu * 8 + F.wave, NGW = F.G * 8, lane = F.lane, r32 = lane & 31, hi = lane >> 5;
    const bf16* QI = WSP(bf16, WS_QI); const float* WIp = WSP(float, WS_WI); float* SSC = WSP(float, WS_SSC);
    const int* page_table = (const int*)F.in[6]; const float* cache_idx_k = (const float*)F.in[4];
    for (int item = gw; item < DB * NPAGES; item += NGW) {
        const int b = item >> 7, pg = item & 127; const int page = page_table[b * NPAGES + pg];
        bf16x8 a[4]; f32x4 w4[4];
        { const bf16* qrow = QI + (size_t)(MP + 4 * b + (r32 >> 3)) * 512 + (r32 & 7) * 64 + 8 * hi;
#pragma unroll
          for (int s = 0; s < 4; ++s) a[s] = *(const GAS bf16x8*)(qrow + 16 * s);
#pragma unroll
          for (int q = 0; q < 4; ++q) w4[q] = *(const GAS f32x4*)(WIp + (size_t)(MP + 4 * b + q) * 8 + 4 * hi); }
        const float* src = cache_idx_k + ((size_t)page * PAGE + r32) * 64 + 8 * hi;
        f32x4 lo[4][4], hh[4][4];
#pragma unroll
        for (int sub = 0; sub < 4; ++sub)
#pragma unroll
            for (int s = 0; s < 4; ++s) { lo[sub][s] = __builtin_nontemporal_load((const f32x4*)(src + sub * 32 * 64 + 16 * s)); hh[sub][s] = __builtin_nontemporal_load((const f32x4*)(src + sub * 32 * 64 + 16 * s + 4)); }
#pragma unroll
        for (int sub = 0; sub < 4; ++sub) {
            f32x16 acc = {};
#pragma unroll
            for (int s = 0; s < 4; ++s) { v4u p; p.x = pk2(lo[sub][s][0], lo[sub][s][1]); p.y = pk2(lo[sub][s][2], lo[sub][s][3]); p.z = pk2(hh[sub][s][0], hh[sub][s][1]); p.w = pk2(hh[sub][s][2], hh[sub][s][3]);
                acc = __builtin_amdgcn_mfma_f32_32x32x16_bf16(a[s], __builtin_bit_cast(bf16x8, p), acc, 0, 0, 0); }
#pragma unroll
            for (int q = 0; q < 4; ++q) {
                float sum = w4[q][0] * fmaxf(acc[4 * q], 0.f) + w4[q][1] * fmaxf(acc[4 * q + 1], 0.f) + w4[q][2] * fmaxf(acc[4 * q + 2], 0.f) + w4[q][3] * fmaxf(acc[4 * q + 3], 0.f);
                sum = xhalf_sum(sum) + 0.0f;
                if ((q >> 1) == hi) SSC[(size_t)(4 * b + q) * SSTR + pg * PAGE + sub * 32 + r32] = sum;
            }
        }
    }
}
__device__ __forceinline__ unsigned fkey(float s) { const unsigned b = __builtin_bit_cast(unsigned, s); return b ^ ((unsigned)((int)b >> 31) | 0x80000000u); }
__device__ __forceinline__ float unfkey(unsigned k) { const unsigned b = (k & 0x80000000u) ? (k ^ 0x80000000u) : ~k; return __builtin_bit_cast(float, b); }
__device__ __forceinline__ unsigned wave_umax(unsigned v) {
    unsigned o;
    o = (unsigned)__builtin_amdgcn_update_dpp(0, (int)v, 0xB1, 0xF, 0xF, true); v = o > v ? o : v;
    o = (unsigned)__builtin_amdgcn_update_dpp(0, (int)v, 0x4E, 0xF, 0xF, true); v = o > v ? o : v;
    o = (unsigned)__builtin_amdgcn_update_dpp(0, (int)v, 0x141, 0xF, 0xF, true); v = o > v ? o : v;
    o = (unsigned)__builtin_amdgcn_update_dpp(0, (int)v, 0x140, 0xF, 0xF, true); v = o > v ? o : v;
    const unsigned a = (unsigned)__builtin_amdgcn_readlane((int)v, 0), b = (unsigned)__builtin_amdgcn_readlane((int)v, 16), c = (unsigned)__builtin_amdgcn_readlane((int)v, 32), d = (unsigned)__builtin_amdgcn_readlane((int)v, 48);
    const unsigned ab = a > b ? a : b, cd = c > d ? c : d; return ab > cd ? ab : cd;
}
__device__ __forceinline__ int wave_count(unsigned cl) {
    int tot = 0;
#pragma unroll
    for (int bb = 0; bb < 6; ++bb) tot += __popcll(__ballot((cl >> bb) & 1u)) << bb;
    return tot;
}
__device__ __forceinline__ void p4_index_preload(Frame& F, int b, int j, bf16x8 (&a)[4][4], float& pwq) {
    const int tid = F.tid, r32 = F.lane & 31, hi = F.lane >> 5; const size_t rowb = (size_t)b * SEQ; const int t0 = 16 * j;
    const bf16* QI = WSP(bf16, WS_QI); const float* WIp = WSP(float, WS_WI);
    pwq = WIp[(rowb + t0 + ((tid & 127) >> 3)) * 8 + (tid & 7)];
#pragma unroll
    for (int rt = 0; rt < 4; ++rt) { const bf16* qrow = QI + (rowb + t0 + 4 * rt + 2 * (r32 >> 4) + ((r32 >> 2) & 1)) * 512 + (4 * ((r32 >> 3) & 1) + (r32 & 3)) * 64 + 8 * hi;
#pragma unroll
        for (int s = 0; s < 4; ++s) a[rt][s] = *(const GAS bf16x8*)(qrow + 16 * s); }
}
__device__ __forceinline__ void p4_index_unit(Frame& F, int b, int j, int useq, bf16x8 (&a)[4][4], float& pwq, int nj) {
    int tid_ = F.tid; asm volatile("" : "+v"(tid_));
    const int tid = tid_, lane = tid & 63, wid = F.wave, r32 = lane & 31, hi = lane >> 5;
    const int ss_id = (F.vcu * 8 + useq) * 8 + wid, ss_item = ss_id >> 2, ss_sub = ss_id & 3, ss_b = ss_item >> 7, ss_pg = ss_item & 127;
    const bool ss_on = F.vcu < 256;
    const int ss_page = ss_on ? ((const int*)F.in[6])[ss_b * NPAGES + ss_pg] : 0;
    const int t0 = 16 * j, nk = t0 + 16, ntile = (nk + 31) >> 5;
    LAS float* S = (LAS float*)(F.lds + RING_OFF);
    LAS float* WQ = (LAS float*)(F.lds + RING_OFF + 131072);
    LAS unsigned long long* MSK = (LAS unsigned long long*)(F.lds + RING_OFF + 131072 + 512);
    LAS unsigned* HW = (LAS unsigned*)(F.lds + RING_OFF + 131072 + 512 + 4096) + wid * 512;
    const bf16* QI = WSP(bf16, WS_QI); const bf16* KIB = WSP(bf16, WS_KIB); const float* WIp = WSP(float, WS_WI);
    unsigned long long* MASK = WSP(unsigned long long, WS_MASK);
    const size_t rowb = (size_t)b * SEQ;
    for (int rep43 = 0; rep43 < (PROBE_DUP == 43 ? 2 : 1); ++rep43)
    if (j >= 16) {
        if (tid < 128) WQ[tid] = pwq;
        const bf16* kbase = KIB + (rowb + r32) * 64 + 8 * hi;
#define IDX_LOADB(dst, kt_) do { const int kc_ = (kt_) < ntile ? (kt_) : ntile - 1; _Pragma("unroll") for (int s = 0; s < 4; ++s) dst[s] = *(const GAS bf16x8*)(kbase + (size_t)kc_ * 32 * 64 + 16 * s); } while (0)
#define RELU_(x_) __builtin_amdgcn_fmed3f((x_), 0.f, inf_)
#define IDX_COMPUTE(bf_, kt_) do { const int key = (kt_) * 32 + r32; \
            _Pragma("unroll") for (int rt = 0; rt < 4; ++rt) { f32x16 acc = {}; \
                _Pragma("unroll") for (int s = 0; s < 4; ++s) acc = __builtin_amdgcn_mfma_f32_32x32x16_bf16(a[rt][s], bf_[s], acc, 0, 0, 0); \
                _Pragma("unroll") for (int qp = 0; qp < 2; ++qp) { const int ql_ = 4 * rt + 2 * qp + hi;                      \
                    const f32x4 wa = *(const LAS f32x4*)(WQ + ql_ * 8), wb = *(const LAS f32x4*)(WQ + ql_ * 8 + 4); \
                      \
                    float e0_ = RELU_(acc[8 * qp + 0]) * wa[0], e1_ = RELU_(acc[8 * qp + 1]) * wa[1]; \
                    e0_ = __builtin_fmaf(RELU_(acc[8 * qp + 2]), wa[2], e0_); e1_ = __builtin_fmaf(RELU_(acc[8 * qp + 3]), wa[3], e1_); \
                    e0_ = __builtin_fmaf(RELU_(acc[8 * qp + 4]), wb[0], e0_); e1_ = __builtin_fmaf(RELU_(acc[8 * qp + 5]), wb[1], e1_); \
                    e0_ = __builtin_fmaf(RELU_(acc[8 * qp + 6]), wb[2], e0_); e1_ = __builtin_fmaf(RELU_(acc[8 * qp + 7]), wb[3], e1_); \
                    S[ql_ * 2048 + key] = (e0_ + e1_) + 0.0f; } } } while (0)
        float inf_ = __builtin_inff(); asm volatile("" : "+v"(inf_));
        bf16x8 bfA[4], bfB[4];
        IDX_LOADB(bfA, wid);
        __syncthreads();
        for (int kt = wid; kt < ntile; kt += 16) {
            IDX_LOADB(bfB, kt + 8);
            IDX_COMPUTE(bfA, kt);
            if (kt + 8 < ntile) { IDX_LOADB(bfA, kt + 16); IDX_COMPUTE(bfB, kt + 8); }
        }
#undef IDX_LOADB
#undef IDX_COMPUTE
#undef RELU_
        __syncthreads();
    }
    f32x4 ss_lo[4], ss_hh[4];
    { const float* src = ((const float*)F.in[4]) + ((size_t)ss_page * PAGE + ss_sub * 32 + r32) * 64 + 8 * hi;
#pragma unroll
      for (int s = 0; s < 4; ++s) { ss_lo[s] = __builtin_nontemporal_load((const f32x4*)(src + 16 * s)); ss_hh[s] = __builtin_nontemporal_load((const f32x4*)(src + 16 * s + 4)); }
    }
#pragma unroll 1
    for (int rep44 = 0; rep44 < (PROBE_DUP == 44 ? 2 : 1); ++rep44) {
        const int qlA = 2 * wid, tA = t0 + qlA, tB = tA + 1;
        unsigned wloA = 0u, whiA = 0u, wloB = 0u, whiB = 0u;
        if (tA < KTOP) {
            const int lo_ = 64 * lane;
            const unsigned long long wA_ = (lo_ + 63 <= tA) ? ~0ull : (lo_ > tA ? 0ull : ((1ull << (tA - lo_ + 1)) - 1ull)), wB_ = (lo_ + 63 <= tB) ? ~0ull : (lo_ > tB ? 0ull : ((1ull << (tB - lo_ + 1)) - 1ull));
            wloA = (unsigned)wA_; whiA = (unsigned)(wA_ >> 32); wloB = (unsigned)wB_; whiB = (unsigned)(wB_ >> 32);
        } else {
            bool doneA = false, doneB = false;
            { unsigned kvA[32], kvB[32]; float amA = 0.f, amB = 0.f;
              const int ngr = (tA >> 8) + 1;
#pragma unroll
              for (int g4 = 0; g4 < 8; ++g4) {
#pragma unroll
                  for (int e = 0; e < 4; ++e) { kvA[4 * g4 + e] = 0u; kvB[4 * g4 + e] = 0u; }
                  if (g4 < ngr) {
                      float sA[4], sB[4];
#pragma unroll
                      for (int e = 0; e < 4; ++e) { sA[e] = S[qlA * 2048 + lane + 64 * (4 * g4 + e)]; sB[e] = S[qlA * 2048 + 2048 + lane + 64 * (4 * g4 + e)]; }
                      if (g4 == ngr - 1) {
#pragma unroll
                          for (int e = 0; e < 4; ++e) { const int ki = lane + 64 * (4 * g4 + e); sA[e] = (ki <= tA) ? sA[e] : 0.f; sB[e] = (ki <= tB) ? sB[e] : 0.f; } }
#pragma unroll
                      for (int e = 0; e < 4; ++e) { kvA[4 * g4 + e] = __float_as_uint(sA[e]); amA = fmaxf(amA, fabsf(sA[e])); kvB[4 * g4 + e] = __float_as_uint(sB[e]); amB = fmaxf(amB, fabsf(sB[e])); } } }
              const unsigned umA = wave_umax(__float_as_uint(amA)), umB = wave_umax(__float_as_uint(amB));
              const float scaleA = umA ? 0.4999f / __uint_as_float(umA) : 0.f, scaleB = umB ? 0.4999f / __uint_as_float(umB) : 0.f;
#pragma unroll
              for (int g4 = 0; g4 < 8; ++g4) if (g4 < ngr) {
#pragma unroll
                  for (int e = 0; e < 4; ++e) { const int jj = 4 * g4 + e; kvA[jj] = __float_as_uint(__builtin_fmaf(__uint_as_float(kvA[jj]), scaleA, 1.5f)); kvB[jj] = __float_as_uint(__builtin_fmaf(__uint_as_float(kvB[jj]), scaleB, 1.5f)); }
                  if (g4 == ngr - 1) {
#pragma unroll
                      for (int e = 0; e < 4; ++e) { const int jj = 4 * g4 + e; kvA[jj] = (lane + 64 * jj <= tA) ? kvA[jj] : 0u; kvB[jj] = (lane + 64 * jj <= tB) ? kvB[jj] : 0u; } } }
              unsigned pfxA = 0x3F800000u, pfxB = 0x3F800000u, TvA = 0u, TvB = 0u; int needA = KTOP, needB = KTOP;
              const unsigned hwbA = (unsigned)(uintptr_t)HW, hwbB = hwbA + 1024u;
              LAS unsigned* HWB = HW + 256;
#pragma unroll 1
              for (int pass = 0; pass < 3; ++pass) {
                  const int sh = pass == 0 ? 15 : pass == 1 ? 7 : 0;
                  const unsigned lim = pass == 2 ? 128u : (256u << sh);
                  const unsigned limA = doneA ? 0u : lim, limB = doneB ? 0u : lim;
                  *(LAS v4u*)(HW + 4 * lane) = (v4u){0u, 0u, 0u, 0u}; *(LAS v4u*)(HWB + 4 * lane) = (v4u){0u, 0u, 0u, 0u};
                  asm volatile("" ::: "memory");
#pragma unroll
                  for (int g4 = 0; g4 < 8; ++g4) if (g4 < ngr) {
#pragma unroll
                      for (int e = 0; e < 4; ++e) { const unsigned dA_ = kvA[4 * g4 + e] ^ pfxA, dB_ = kvB[4 * g4 + e] ^ pfxB;
                          if (dA_ < limA) __hip_atomic_fetch_add((LAS unsigned*)(uintptr_t)(hwbA + ((dA_ >> sh) << 2)), 1u, __ATOMIC_RELAXED, __HIP_MEMORY_SCOPE_WAVEFRONT);
                          if (dB_ < limB) __hip_atomic_fetch_add((LAS unsigned*)(uintptr_t)(hwbB + ((dB_ >> sh) << 2)), 1u, __ATOMIC_RELAXED, __HIP_MEMORY_SCOPE_WAVEFRONT); } }
                  asm volatile("" ::: "memory");
                  const v4u wA4 = *(const LAS v4u*)(HW + 4 * lane), wB4 = *(const LAS v4u*)(HWB + 4 * lane);
                  asm volatile("" ::: "memory");
#define SEL_SCAN(w4_, need_, HWX_, dgb_, above_, binc_) do { \
                      const unsigned ls_ = (w4_[0] + w4_[1]) + (w4_[2] + w4_[3]); unsigned p_ = ls_; \
                      p_ += (unsigned)__builtin_amdgcn_update_dpp(0, (int)p_, 0x111, 0xF, 0xF, false); p_ += (unsigned)__builtin_amdgcn_update_dpp(0, (int)p_, 0x112, 0xF, 0xF, false); \
                      p_ += (unsigned)__builtin_amdgcn_update_dpp(0, (int)p_, 0x114, 0xF, 0xF, false); p_ += (unsigned)__builtin_amdgcn_update_dpp(0, (int)p_, 0x118, 0xF, 0xF, false); \
                      const unsigned r0_ = (unsigned)__builtin_amdgcn_readlane((int)p_, 15), r1_ = (unsigned)__builtin_amdgcn_readlane((int)p_, 31), r2_ = (unsigned)__builtin_amdgcn_readlane((int)p_, 47), r3_ = (unsigned)__builtin_amdgcn_readlane((int)p_, 63); \
                      const int row_ = lane >> 4; p_ += (row_ == 0) ? 0u : (row_ == 1) ? r0_ : (row_ == 2) ? r0_ + r1_ : r0_ + r1_ + r2_; \
                      const unsigned abl_ = (r0_ + r1_ + r2_ + r3_) - p_;                                    \
                      const unsigned long long fm_ = __ballot((int)abl_ < (need_) && (int)(abl_ + ls_) >= (need_)); \
                      const int src_ = (int)__builtin_ctzll(fm_) & 63; \
                      const unsigned abs_ = (unsigned)__builtin_amdgcn_readlane((int)abl_, src_); \
                      const unsigned ci_ = ((lane & 15) < 4) ? (HWX_)[4 * src_ + (lane & 3)] : 0u;          \
                      unsigned sfx_ = ci_; \
                      sfx_ += (unsigned)__builtin_amdgcn_update_dpp(0, (int)sfx_, 0x101, 0xF, 0xF, false); sfx_ += (unsigned)__builtin_amdgcn_update_dpp(0, (int)sfx_, 0x102, 0xF, 0xF, false); \
                      const unsigned abi_ = abs_ + sfx_ - ci_;                                                \
                      const unsigned long long fb_ = __ballot(lane < 4 && (int)abi_ < (need_) && (int)(abi_ + ci_) >= (need_)); \
                      const int sl2_ = (int)__builtin_ctzll(fb_) & 63; \
                      dgb_ = (unsigned)(4 * src_ + sl2_); above_ = (unsigned)__builtin_amdgcn_readlane((int)abi_, sl2_); binc_ = (unsigned)__builtin_amdgcn_readlane((int)ci_, sl2_); } while (0)
                  unsigned dgA, abvA, bcA, dgB, abvB, bcB;
                  SEL_SCAN(wA4, needA, HW, dgA, abvA, bcA);
                  SEL_SCAN(wB4, needB, HWB, dgB, abvB, bcB);
#undef SEL_SCAN
                  if (!doneA) { pfxA |= dgA << sh; needA -= (int)abvA; TvA = pfxA; doneA = ((int)bcA == needA); }
                  if (!doneB) { pfxB |= dgB << sh; needB -= (int)abvB; TvB = pfxB; doneB = ((int)bcB == needB); }
                  if (doneA && doneB) break;
              }
#define SEL_MASK(kv_, Tv_, wlo_, whi_) do { _Pragma("unroll") for (int j4 = 0; j4 < 8; ++j4) if (j4 < ngr) { \
                      const unsigned long long wa = __ballot(kv_[4 * j4] >= Tv_), wb = __ballot(kv_[4 * j4 + 1] >= Tv_), wc_ = __ballot(kv_[4 * j4 + 2] >= Tv_), wd = __ballot(kv_[4 * j4 + 3] >= Tv_); \
                      asm("s_nop 1\n\tv_writelane_b32 %0, %2, %10\n\tv_writelane_b32 %1, %3, %10\n\tv_writelane_b32 %0, %4, %11\n\tv_writelane_b32 %1, %5, %11\n\tv_writelane_b32 %0, %6, %12\n\tv_writelane_b32 %1, %7, %12\n\tv_writelane_b32 %0, %8, %13\n\tv_writelane_b32 %1, %9, %13" \
                          : "+v"(wlo_), "+v"(whi_) : "s"((unsigned)wa), "s"((unsigned)(wa >> 32)), "s"((unsigned)wb), "s"((unsigned)(wb >> 32)), "s"((unsigned)wc_), "s"((unsigned)(wc_ >> 32)), "s"((unsigned)wd), "s"((unsigned)(wd >> 32)), \
                            "n"(4 * j4), "n"(4 * j4 + 1), "n"(4 * j4 + 2), "n"(4 * j4 + 3)); } } while (0)
              if (doneA) SEL_MASK(kvA, TvA, wloA, whiA);
              if (doneB) SEL_MASK(kvB, TvB, wloB, whiB);
#undef SEL_MASK
            }
#pragma unroll 1
            for (int q2 = 0; q2 < 2; ++q2) {
            if (q2 == 0 ? doneA : doneB) continue;
            const int ql = qlA + q2, t = tA + q2; unsigned wlo = 0u, whi = 0u;
            unsigned uu[32];
#pragma unroll
            for (int jj = 0; jj < 32; ++jj) { const float s = S[ql * 2048 + lane + 64 * jj]; const unsigned k_ = fkey(s); uu[jj] = (lane + 64 * jj <= t) ? k_ : 0u; }
            const int ng = (t >> 8) + 1;
#define SEL_GRP(g4, CAND) if ((g4) < ng) { unsigned long long m0_, m1_, m2_, m3_; \
                    asm volatile("v_cmp_ge_u32_e64 %0, %4, %8\n\tv_cmp_ge_u32_e64 %1, %5, %8\n\tv_cmp_ge_u32_e64 %2, %6, %8\n\tv_cmp_ge_u32_e64 %3, %7, %8" \
                        : "=&s"(m0_), "=&s"(m1_), "=&s"(m2_), "=&s"(m3_) : "v"(uu[4 * (g4)]), "v"(uu[4 * (g4) + 1]), "v"(uu[4 * (g4) + 2]), "v"(uu[4 * (g4) + 3]), "v"(CAND)); \
                    cnt_ += __popcll(m0_) + __popcll(m1_) + __popcll(m2_) + __popcll(m3_); }
#define SEL_COUNT(CAND, OUT) do { int cnt_ = 0; SEL_GRP(0, CAND) SEL_GRP(1, CAND) SEL_GRP(2, CAND) SEL_GRP(3, CAND) SEL_GRP(4, CAND) SEL_GRP(5, CAND) SEL_GRP(6, CAND) SEL_GRP(7, CAND) OUT = cnt_; } while (0)
            unsigned T = 0u; int clo = t + 1;
#pragma unroll 1
            for (int bit = 31; bit >= 0; --bit) {
                const unsigned cand = T | (1u << bit); int c; SEL_COUNT(cand, c);
                if (c >= KTOP) { T = cand; clo = c; if (c == KTOP) break; }
            }
            if (clo == KTOP) {
#pragma unroll
                for (int jj = 0; jj < 32; ++jj) { const unsigned long long word = __ballot(uu[jj] >= T);
                    asm("s_nop 1\n\tv_writelane_b32 %0, %2, %4\n\tv_writelane_b32 %1, %3, %4" : "+v"(wlo), "+v"(whi) : "s"((unsigned)word), "s"((unsigned)(word >> 32)), "n"(jj));     }
            } else {
                int cgt; { const unsigned Tp = T + 1u; SEL_COUNT(Tp, cgt); }
                const int need = KTOP - cgt; int running = 0;
#pragma unroll
                for (int jj = 0; jj < 32; ++jj) {
                    const unsigned long long eq = __ballot(uu[jj] == T);
                    const int rank = (int)__builtin_amdgcn_mbcnt_hi((unsigned)(eq >> 32), __builtin_amdgcn_mbcnt_lo((unsigned)eq, 0u));
                    const unsigned long long word = __ballot(uu[jj] > T || (uu[jj] == T && running + rank < need));
                    asm("s_nop 1\n\tv_writelane_b32 %0, %2, %4\n\tv_writelane_b32 %1, %3, %4" : "+v"(wlo), "+v"(whi) : "s"((unsigned)word), "s"((unsigned)(word >> 32)), "n"(jj));
                    running += __popcll(eq);
                }
            }
            if (q2 == 0) { wloA = wlo; whiA = whi; } else { wloB = wlo; whiB = whi; }
            }
#undef SEL_COUNT
#undef SEL_GRP
        }
        if (lane < 32) { MSK[qlA * 32 + lane] = ((unsigned long long)whiA << 32) | wloA; MSK[qlA * 32 + 32 + lane] = ((unsigned long long)whiB << 32) | wloB; }
    }
    bf16x8 ss_a[4]; f32x4 ss_w[4];
    { const bf16* qrow = QI + (size_t)(MP + 4 * ss_b + (r32 >> 3)) * 512 + (r32 & 7) * 64 + 8 * hi;
#pragma unroll
      for (int s = 0; s < 4; ++s) ss_a[s] = *(const GAS bf16x8*)(qrow + 16 * s);
#pragma unroll
      for (int q = 0; q < 4; ++q) ss_w[q] = *(const GAS f32x4*)(WIp + (size_t)(MP + 4 * ss_b + q) * 8 + 4 * hi); }
    if (nj >= 16) p4_index_preload(F, b, nj, a, pwq);
    if (ss_on) { f32x16 acc = {};
#pragma unroll
        for (int s = 0; s < 4; ++s) { v4u p; p.x = pk2(ss_lo[s][0], ss_lo[s][1]); p.y = pk2(ss_lo[s][2], ss_lo[s][3]); p.z = pk2(ss_hh[s][0], ss_hh[s][1]); p.w = pk2(ss_hh[s][2], ss_hh[s][3]);
            acc = __builtin_amdgcn_mfma_f32_32x32x16_bf16(ss_a[s], __builtin_bit_cast(bf16x8, p), acc, 0, 0, 0); }
        float* SSC = WSP(float, WS_SSC);
#pragma unroll
        for (int q = 0; q < 4; ++q) {
            float sum = ss_w[q][0] * fmaxf(acc[4 * q], 0.f) + ss_w[q][1] * fmaxf(acc[4 * q + 1], 0.f) + ss_w[q][2] * fmaxf(acc[4 * q + 2], 0.f) + ss_w[q][3] * fmaxf(acc[4 * q + 3], 0.f);
            sum = xhalf_sum(sum) + 0.0f;
            if ((q >> 1) == hi) SSC[(size_t)(4 * ss_b + q) * SSTR + ss_pg * PAGE + ss_sub * 32 + r32] = sum;
        } }
    __syncthreads();
    { const int jt = tid >> 4, ql = tid & 15; MASK[((size_t)b * 32 + jt) * SEQ + t0 + ql] = MSK[ql * 32 + jt]; }
    __syncthreads();
}
__device__ __forceinline__ void p4_index(Frame& F) {
    if (F.vcu >= 256) return;
    const int b = F.vcu >> 4, w = F.vcu & 15;
    bf16x8 pa[4][4]; float pwq;
    p4_index_preload(F, b, 127 - w, pa, pwq);
#pragma unroll 1
    for (int k = 0; k < 4; ++k) { const int j1 = w + 16 * k; p4_index_unit(F, b, 127 - j1, 2 * k, pa, pwq, j1); p4_index_unit(F, b, j1, 2 * k + 1, pa, pwq, k < 3 ? 127 - (j1 + 16) : -1); }
}

__device__ __forceinline__ void sel_scan256(const v4u w4, int need, const LAS unsigned* tab, int lane, unsigned& dgb, unsigned& above, unsigned& binc) {
    const unsigned ls = (w4[0] + w4[1]) + (w4[2] + w4[3]); unsigned p = ls;
    p += (unsigned)__builtin_amdgcn_update_dpp(0, (int)p, 0x111, 0xF, 0xF, false); p += (unsigned)__builtin_amdgcn_update_dpp(0, (int)p, 0x112, 0xF, 0xF, false);
    p += (unsigned)__builtin_amdgcn_update_dpp(0, (int)p, 0x114, 0xF, 0xF, false); p += (unsigned)__builtin_amdgcn_update_dpp(0, (int)p, 0x118, 0xF, 0xF, false);
    const unsigned r0 = (unsigned)__builtin_amdgcn_readlane((int)p, 15), r1 = (unsigned)__builtin_amdgcn_readlane((int)p, 31), r2 = (unsigned)__builtin_amdgcn_readlane((int)p, 47), r3 = (unsigned)__builtin_amdgcn_readlane((int)p, 63);
    const int row_ = lane >> 4; p += (row_ == 0) ? 0u : (row_ == 1) ? r0 : (row_ == 2) ? r0 + r1 : r0 + r1 + r2;
    const unsigned abl = (r0 + r1 + r2 + r3) - p;
    const unsigned long long fm = __ballot((int)abl < need && (int)(abl + ls) >= need);
    const int src = (int)__builtin_ctzll(fm) & 63;
    const unsigned abs_ = (unsigned)__builtin_amdgcn_readlane((int)abl, src);
    const unsigned ci = ((lane & 15) < 4) ? tab[4 * src + (lane & 3)] : 0u;
    unsigned sfx = ci;
    sfx += (unsigned)__builtin_amdgcn_update_dpp(0, (int)sfx, 0x101, 0xF, 0xF, false); sfx += (unsigned)__builtin_amdgcn_update_dpp(0, (int)sfx, 0x102, 0xF, 0xF, false);
    const unsigned abi = abs_ + sfx - ci;
    const unsigned long long fb = __ballot(lane < 4 && (int)abi < need && (int)(abi + ci) >= need);
    const int sl2 = (int)__builtin_ctzll(fb) & 63;
    dgb = (unsigned)(4 * src + sl2); above = (unsigned)__builtin_amdgcn_readlane((int)abi, sl2); binc = (unsigned)__builtin_amdgcn_readlane((int)ci, sl2);
}
__device__ __forceinline__ int block_sum8(LAS int* red, int par, int wid, int lane, int v) {
    if (lane == 0) red[par * 8 + wid] = v;
    __syncthreads();
    int s = 0;
#pragma unroll
    for (int w = 0; w < 8; ++w) s += red[par * 8 + w];
    return s;
}
__device__ __forceinline__ void p5_sample_unit(Frame& F, int sq) {
    const int tid = F.tid, lane = F.lane, wid = F.wave;
    const int b = sq >> 2, qi_ = sq & 3, row = MP + sq;
    LAS unsigned char* L0 = F.lds + RING_OFF;
    LAS int* red = (LAS int*)(L0);
    LAS float* newsc = (LAS float*)(L0 + 64);
    LAS int* wcnt = (LAS int*)(L0 + 128);
    LAS int* eqw = (LAS int*)(L0 + 256);
    LAS int* selidx = (LAS int*)(L0 + 2048);
    LAS float* LG = (LAS float*)(L0 + 4096);
    LAS float* OP = (LAS float*)(L0 + 16384);
    const bf16* QI = WSP(bf16, WS_QI); const bf16* KIB = WSP(bf16, WS_KIB); const float* WIp = WSP(float, WS_WI); const float* SSC = WSP(float, WS_SSC);
    const bf16* Qb = WSP(bf16, WS_Q); bf16* CAT = WSP(bf16, WS_CAT);
    if (tid < 64) {
        const int h = (tid >> 2) & 7, jn = tid & 3; float dot = 0.f;
        const bf16* qp = QI + (size_t)row * 512 + h * 64; const bf16* kp = KIB + (size_t)(MP + 4 * b + jn) * 64;
        for (int d = 0; d < 64; ++d) dot += bf2f(qp[d]) * bf2f(kp[d]);
        float v = WIp[(size_t)row * 8 + h] * fmaxf(dot, 0.f);
        v += __shfl_xor(v, 4); v += __shfl_xor(v, 8); v += __shfl_xor(v, 16);
        if (tid < 4) newsc[tid] = (jn <= qi_) ? (v + 0.0f) : -INFINITY;
    }
    __syncthreads();
    unsigned uu[33];
#pragma unroll
    for (int jj = 0; jj < 32; ++jj) uu[jj] = fkey(SSC[(size_t)sq * SSTR + tid + 512 * jj]);
    uu[32] = tid < 4 ? fkey(newsc[tid]) : 0x007FFFFFu;
    unsigned T = 0u; int par = 0; bool fast = false;
    { LAS unsigned* RT = (LAS unsigned*)(L0 + 32768);
      LAS unsigned* RX = (LAS unsigned*)(L0 + 1536);
      RT[tid] = 0u; if (tid < 256) RT[512 + tid] = 0u;
      float am = 0.f; unsigned fin = 0u;
#pragma unroll
      for (int jj = 0; jj < 33; ++jj) { const float a_ = fabsf(unfkey(uu[jj])); const bool f_ = a_ < INFINITY; am = fmaxf(am, f_ ? a_ : 0.f); }
      { const unsigned um = wave_umax(__float_as_uint(am)); if (lane == 0) RX[wid] = um; }
      __syncthreads();
      unsigned bm = 0u;
#pragma unroll
      for (int w = 0; w < 8; ++w) { const unsigned x_ = RX[w]; bm = x_ > bm ? x_ : bm; }
      const float scale = bm ? 0.4999f / __uint_as_float(bm) : 0.f;
      unsigned iv[33];
#pragma unroll
      for (int jj = 0; jj < 33; ++jj) { const float s_ = unfkey(uu[jj]); iv[jj] = (fabsf(s_) < INFINITY) ? __float_as_uint(__builtin_fmaf(s_, scale, 1.5f)) : 0u; }
      unsigned pfx = 0x3F800000u; int need = KTOP; bool done = false;
#pragma unroll 1
      for (int pass = 0; pass < 3; ++pass) {
          const int sh = pass == 0 ? 15 : pass == 1 ? 7 : 0; const unsigned lim = pass == 2 ? 128u : (256u << sh);
          LAS unsigned* tab = RT + 256 * pass;
#pragma unroll
          for (int jj = 0; jj < 33; ++jj) { const unsigned d_ = iv[jj] ^ pfx; if (d_ < lim) __hip_atomic_fetch_add(tab + (d_ >> sh), 1u, __ATOMIC_RELAXED, __HIP_MEMORY_SCOPE_WORKGROUP); }
          __syncthreads();
          const v4u w4 = *(const LAS v4u*)(tab + 4 * lane);
          unsigned dg, abv, bc; sel_scan256(w4, need, tab, lane, dg, abv, bc);
          pfx |= dg << sh; need -= (int)abv;
          if ((int)bc == need) { done = true; break; }
      }
      if (done) {
          unsigned mn = 0xFFFFFFFFu;
#pragma unroll
          for (int jj = 0; jj < 33; ++jj) { const unsigned c_ = (iv[jj] >= pfx) ? uu[jj] : 0xFFFFFFFFu; mn = c_ < mn ? c_ : mn; }
          mn = ~wave_umax(~mn);
          if (lane == 0) RX[8 + wid] = mn;
          __syncthreads();
          unsigned t_ = 0xFFFFFFFFu;
#pragma unroll
          for (int w = 0; w < 8; ++w) { const unsigned x_ = RX[8 + w]; t_ = x_ < t_ ? x_ : t_; }
          T = t_; fast = true; }
      (void)fin; }
    if (!fast)
#pragma unroll 1
    for (int bit = 31; bit >= 0; --bit) {
        const unsigned cand = T | (1u << bit); int c = 0;
#pragma unroll
        for (int jj = 0; jj < 33; ++jj) c += __popcll(__ballot(uu[jj] >= cand));
        c = block_sum8(red, par, wid, lane, c); par ^= 1;
        if (c >= KTOP) { T = cand; if (c == KTOP) break; }
    }
    int cgt = 0;
#pragma unroll
    for (int jj = 0; jj < 33; ++jj) cgt += __popcll(__ballot(uu[jj] > T));
    cgt = block_sum8(red, par, wid, lane, cgt); par ^= 1;
    const int need = KTOP - cgt;
#pragma unroll
    for (int jj = 0; jj < 33; ++jj) { const int n = __popcll(__ballot(uu[jj] == T)); if (lane == 0) eqw[jj * 8 + wid] = n; }
    __syncthreads();
#define SEL_MASK(jj, eqbase, M) do { int below_ = 0, tot_ = 0; \
        _Pragma("unroll") for (int w = 0; w < 8; ++w) { const int n_ = eqw[(jj) * 8 + w]; tot_ += n_; below_ += (w < wid) ? n_ : 0; } \
        const unsigned long long eq_ = __ballot(uu[jj] == T); \
        const int rank_ = (eqbase) + below_ + (int)__builtin_amdgcn_mbcnt_hi((unsigned)(eq_ >> 32), __builtin_amdgcn_mbcnt_lo((unsigned)eq_, 0u)); \
        M = __ballot(uu[jj] > T || (uu[jj] == T && rank_ < need)); (eqbase) += tot_; } while (0)
    { int cw = 0, eqbase = 0;
#pragma unroll
      for (int jj = 0; jj < 33; ++jj) { unsigned long long m; SEL_MASK(jj, eqbase, m); cw += __popcll(m); }
      if (lane == 0) wcnt[wid] = cw; }
    __syncthreads();
    { int base = 0, eqbase = 0;
#pragma unroll
      for (int w = 0; w < 8; ++w) base += (w < wid) ? wcnt[w] : 0;
#pragma unroll
      for (int jj = 0; jj < 33; ++jj) { unsigned long long m; SEL_MASK(jj, eqbase, m);
          const int pos = base + (int)__builtin_amdgcn_mbcnt_hi((unsigned)(m >> 32), __builtin_amdgcn_mbcnt_lo((unsigned)m, 0u));
          if ((m >> lane) & 1ull) { if (pos < KTOP) selidx[pos] = (jj < 32) ? tid + 512 * jj : PAST + tid; }
          base += __popcll(m); } }
#undef SEL_MASK
    __syncthreads();
    const int kk = lane >> 3, ds = lane & 7;
    const float* kptr[4]; const float* vptr[4];
#pragma unroll
    for (int it = 0; it < 4; ++it) {
        const int kidx = selidx[32 * wid + 8 * it + kk];
        if (kidx < PAST) { const size_t pr = (size_t)((const int*)F.in[6])[b * NPAGES + (kidx >> 7)] * PAGE + (kidx & 127); kptr[it] = ((const float*)F.in[2]) + pr * 128 + 8 * ds; vptr[it] = ((const float*)F.in[3]) + pr * 128 + 8 * ds; }
        else { const size_t nr = (size_t)(4 * b + (kidx - PAST)); kptr[it] = F.out + O_KS + nr * 128 + 8 * ds; vptr[it] = F.out + O_VS + nr * 128 + 8 * ds; }
    }
    f32x4 kreg[2][4][2], vreg[2][4][2];
#pragma unroll
    for (int g = 0; g < 2; ++g)
#pragma unroll
        for (int it = 0; it < 4; ++it) { kreg[g][it][0] = *(const f32x4*)(kptr[it] + 64 * g); kreg[g][it][1] = *(const f32x4*)(kptr[it] + 64 * g + 4); }
#pragma unroll
    for (int g = 0; g < 2; ++g)
#pragma unroll
        for (int it = 0; it < 4; ++it) { vreg[g][it][0] = *(const f32x4*)(vptr[it] + 64 * g); vreg[g][it][1] = *(const f32x4*)(vptr[it] + 64 * g + 4); }
#pragma unroll
    for (int g = 0; g < 2; ++g) {
        float qv[4][8];
#pragma unroll
        for (int r = 0; r < 4; ++r) { const v4u qq = *(const GAS v4u*)(Qb + (size_t)row * 512 + (4 * g + r) * 64 + 8 * ds);
#pragma unroll
            for (int e = 0; e < 4; ++e) { qv[r][2 * e] = bf2f((unsigned short)(qq[e] & 0xffffu)); qv[r][2 * e + 1] = bf2f((unsigned short)(qq[e] >> 16)); } }
#pragma unroll
        for (int it = 0; it < 4; ++it) {
            const f32x4 k0 = kreg[g][it][0], k1 = kreg[g][it][1];
#pragma unroll
            for (int r = 0; r < 4; ++r) {
                float d = (qv[r][0] * k0[0] + qv[r][1] * k0[1]) + (qv[r][2] * k0[2] + qv[r][3] * k0[3]) + (qv[r][4] * k1[0] + qv[r][5] * k1[1]) + (qv[r][6] * k1[2] + qv[r][7] * k1[3]);
                d += __shfl_xor(d, 1); d += __shfl_xor(d, 2); d += __shfl_xor(d, 4);
                if (ds == 0) LG[(4 * g + r) * 256 + 32 * wid + 8 * it + kk] = d;
            }
        }
    }
    __syncthreads();
    { float l[4];
#pragma unroll
      for (int e = 0; e < 4; ++e) l[e] = LG[wid * 256 + lane + 64 * e];
      const float m = wave_max(fmaxf(fmaxf(l[0], l[1]), fmaxf(l[2], l[3])));
      float p[4], s = 0.f;
#pragma unroll
      for (int e = 0; e < 4; ++e) { p[e] = __builtin_amdgcn_exp2f(l[e] - m); s += p[e]; }
      s = wave_sum(s); const float inv = 1.0f / s;
#pragma unroll
      for (int e = 0; e < 4; ++e) LG[wid * 256 + lane + 64 * e] = p[e] * inv; }
    __syncthreads();
#pragma unroll
    for (int g = 0; g < 2; ++g) {
        float acc[4][8];
#pragma unroll
        for (int r = 0; r < 4; ++r)
#pragma unroll
            for (int e = 0; e < 8; ++e) acc[r][e] = 0.f;
#pragma unroll
        for (int it = 0; it < 4; ++it) {
            const f32x4 v0 = vreg[g][it][0], v1 = vreg[g][it][1];
#pragma unroll
            for (int r = 0; r < 4; ++r) { const float p = LG[(4 * g + r) * 256 + 32 * wid + 8 * it + kk];
#pragma unroll
                for (int e = 0; e < 4; ++e) { acc[r][e] += p * v0[e]; acc[r][4 + e] += p * v1[e]; } }
        }
#pragma unroll
        for (int r = 0; r < 4; ++r)
#pragma unroll
            for (int e = 0; e < 8; ++e) { float a = acc[r][e]; a += __shfl_xor(a, 8); a += __shfl_xor(a, 16); a += __shfl_xor(a, 32); if (kk == 0) OP[(wid * 8 + 4 * g + r) * 64 + 8 * ds + e] = a; }
    }
    __syncthreads();
    { const int hd = tid >> 6, d = tid & 63; float o = 0.f;
#pragma unroll
      for (int w = 0; w < 8; ++w) o += OP[(w * 8 + hd) * 64 + d];
      CAT[(size_t)row * D + 512 + hd * 64 + d] = (bf16)f2bf(o); }
    __syncthreads();
}

constexpr int N_PHASES = 9;
struct Args { const void* in[22]; float* out; unsigned char* ws; int ph_lo, ph_hi, use_bar, pad; };
__global__ void __launch_bounds__(512, 2) hymba_fwd(Args args) {
    extern __shared__ __attribute__((aligned(16))) unsigned char lds[];
    Frame F;
    F.lds = (LAS unsigned char*)lds;
    F.MISC = (volatile LAS unsigned*)(F.lds + MISC_OFF);
    F.tid = threadIdx.x; F.lane = F.tid & 63; F.wave = __builtin_amdgcn_readfirstlane(F.tid >> 6);
    F.G = gridDim.x; { const int bx = blockIdx.x; F.vcu = (F.G % 8 == 0) ? (bx % 8) * (F.G / 8) + bx / 8 : bx; }
    F.ws = args.ws; F.out = args.out; F.ctl = (gu32*)(args.ws + WS_CTL);
    F.in = args.in;
    for (int u = F.tid; u < (LDS_BYTES - LDSCTL_OFF) / 4; u += 512) ((LAS unsigned*)(F.lds + LDSCTL_OFF))[u] = 0u;
    __syncthreads();
    XcdBarrier bar; bar.bar = (unsigned*)(F.ctl + CW_BAR); bar.x = 0; bar.st = nullptr;
    if (args.use_bar) bar = xcd_barrier_post((unsigned*)(F.ctl + CW_BAR), F.MISC + 8);
    const int lo = args.ph_lo, hi = args.ph_hi;
#define IN(k) (lo <= (k) && (k) < hi)
#define SEAM(k) do { if (IN(k) && IN((k) + 1)) { xcd_barrier(bar); if (PROBE_DUP == 60) xcd_barrier(bar); } } while (0)
    const int cblk = (int)blockIdx.x;

#ifndef PROBE_DUP
#define PROBE_DUP (-1)
#endif
#define RUNPHASE(k, ...) do { if (IN(k)) { { int t_ = F.tid; asm volatile("" : "+v"(t_)); F.tid = t_; F.lane = t_ & 63; }     \
        __VA_ARGS__; if (PROBE_DUP == (k)) { if (args.use_bar) xcd_barrier(bar); __VA_ARGS__; } } SEAM(k); } while (0)
#define RSTAB ((LAS float*)(F.lds + RING_OFF + 131072))
#define GEMM_PHASE(EPI, A_, B_, N_, K_, SS_, NSLOT_, ...) do { pg8::Gemm g{A_, B_, MP, N_, K_}; pg8::StaticOrder S; S.init(MP, N_, F.G, cblk); \
        if ((NSLOT_) > 0) fill_rstd_table(RSTAB, S, SS_, NSLOT_); \
        EPI E{__VA_ARGS__}; \
        pg8::gemm_phase<EPI, pg8::StaticOrder, true, true>(F.lds + RING_OFF, g, S, E); \
        { int nrep_ = (PROBE_DUP == 50) ? 2 : 1; asm volatile("" : "+s"(nrep_)); for (int rep_ = 0; rep_ < nrep_; ++rep_) skinny_phase<EPI, 2, 0>(F.lds + RING_OFF, A_, B_, N_, (K_) * 2, cblk, F.G, E); } } while (0)
#define GEMM_PHASE8(EPI, A8_, B8_, OSC_, N_, K_, SS_, NSLOT_, ...) do { pg8::Gemm g{(const bf16*)(A8_), (const bf16*)(B8_), MP, N_, (K_) / 2}; pg8::StaticOrder S; S.init(MP, N_, F.G, cblk); \
        if ((NSLOT_) > 0) fill_rstd_table(RSTAB, S, SS_, NSLOT_); \
        EPI E{__VA_ARGS__}; \
        pg8::gemm_phase<EPI, pg8::StaticOrder, true, true, 1>(F.lds + RING_OFF, g, S, E); \
        { int nrep_ = (PROBE_DUP == 55) ? 2 : 1; asm volatile("" : "+s"(nrep_)); for (int rep_ = 0; rep_ < nrep_; ++rep_) skinny_phase<EPI, 2, 1>(F.lds + RING_OFF, A8_, B8_, N_, K_, cblk, F.G, E, nullptr, nullptr, OSC_); } } while (0)
#define GEMM_PHASEI(EPI, A8_, B8_, XS_, WSN_, N_, K_, SS_, NSLOT_, ...) do { pg8::Gemm g{(const bf16*)(A8_), (const bf16*)(B8_), MP, N_, (K_) / 2}; pg8::StaticOrder S; S.init(MP, N_, F.G, cblk); \
        fill_rstd_table(RSTAB, S, SS_, NSLOT_, XS_); \
        EPI E{__VA_ARGS__}; \
        pg8::gemm_phase<EPI, pg8::StaticOrder, true, true, 2>(F.lds + RING_OFF, g, S, E); \
        { int nrep_ = (PROBE_DUP == 55) ? 2 : 1; asm volatile("" : "+s"(nrep_)); for (int rep_ = 0; rep_ < nrep_; ++rep_) skinny_phase<EPI, 4, 2>(F.lds + RING_OFF, A8_, B8_, N_, K_, cblk, F.G, E, XS_, WSN_); } } while (0)
    RUNPHASE(0, do { p0_prologue(F); xcd_barrier(bar); p0b_quant_weights(F); } while (0));
    RUNPHASE(1, GEMM_PHASEI(EpiGU, WSP(unsigned char, WS_XI8), WSP(unsigned char, WS_WGU1I8), WSP(float, WS_XS), WSP(float, WS_WSN), 2 * DFF, D, WSP(float, WS_SS0), 1, WSP(bf16, WS_H), WSP(float, WS_SS0), 1, RSTAB, 1.0f, WSP(unsigned char, WS_H8), WSP(float, WS_WSN)));
    RUNPHASE(2, GEMM_PHASE8(EpiRes<0>, WSP(unsigned char, WS_H8), WSP(unsigned char, WS_WD1_8), 1.0f / (W8SCALE * H8SCALE), D, DFF, nullptr, 0, WSP(bf16, WS_XB), nullptr, WSP(bf16, WS_X1B), WSP(float, WS_SS1), nullptr, 1.0f / (W8SCALE * H8SCALE), (const float*)F.in[0], (const float*)F.in[1]));
#if PROBE_DUP >= 21 && PROBE_DUP <= 23
    if (IN(2)) { xcd_barrier(bar); pg8::Gemm g{(const bf16*)WSP(unsigned char, WS_H8), (const bf16*)WSP(unsigned char, WS_WD1_8), MP, D, DFF / 2}; pg8::StaticOrder S; S.init(MP, D, F.G, cblk);
        EpiRes<0> E{WSP(bf16, WS_XB), nullptr, WSP(bf16, WS_X2B), WSP(float, WS_SS2), nullptr, 1.0f / (W8SCALE * H8SCALE), (const float*)F.in[0], (const float*)F.in[1]};
        pg8::gemm_phase<EpiRes<0>, pg8::StaticOrder, true, true, (PROBE_DUP == 21 ? 1 : PROBE_DUP == 22 ? 2 : 0)>(F.lds + RING_OFF, g, S, E); xcd_barrier(bar); }
#endif
    RUNPHASE(3, GEMM_PHASE(EpiWin, WSP(bf16, WS_X1B), WSP(bf16, WS_WIN), NINP, D, WSP(float, WS_SS1), 16, F.ws, F.out, (const float*)F.in[15], (const float*)F.in[16], RSTAB));
    RUNPHASE(4, do { p4_conv(F); if (PROBE_DUP == 40) p4_conv(F); p4_index(F); if (PROBE_DUP == 42) p4_index(F); } while (0));
    RUNPHASE(5, do { if ((F.vcu & 1) == 0 && F.vcu < 256) { p5_sample_unit(F, F.vcu >> 1); if (PROBE_DUP == 51) p5_sample_unit(F, F.vcu >> 1); }
        const attn_body::AttnTensors AT{(const attn_body::bf16*)WSP(bf16, WS_Q), (const attn_body::bf16*)WSP(bf16, WS_KB), (const attn_body::bf16*)WSP(bf16, WS_VB), WSP(unsigned long long, WS_MASK), (attn_body::bf16*)WSP(bf16, WS_CAT)};
        const attn_body::StaticOrder S(F.vcu); attn_body::attn_phase<attn_body::StaticOrder>((char*)lds + RING_OFF, AT, S); } while (0));
    RUNPHASE(6, do { GEMM_PHASE(EpiRes<1>, WSP(bf16, WS_CAT), WSP(bf16, WS_WOUT), D, D, nullptr, 0, WSP(bf16, WS_X1B), nullptr, WSP(bf16, WS_X2B), WSP(float, WS_SS2), nullptr, 1.0f);
                     xcd_barrier(bar); quant_rows_pass(F.vcu * 8 + F.wave, F.G * 8, WSP(bf16, WS_X2B), WSP(unsigned char, WS_X2I8), WSP(float, WS_XS2), MTOT); } while (0));
    RUNPHASE(7, GEMM_PHASEI(EpiGU, WSP(unsigned char, WS_X2I8), WSP(unsigned char, WS_WGU2I8), WSP(float, WS_XS2), WSP(float, WS_WSN2), 2 * DFF, D, WSP(float, WS_SS2), 16, WSP(bf16, WS_H), WSP(float, WS_SS2), 16, RSTAB, 1.0f, WSP(unsigned char, WS_H8), WSP(float, WS_WSN2)));
    RUNPHASE(8, GEMM_PHASE8(EpiRes<2>, WSP(unsigned char, WS_H8), WSP(unsigned char, WS_WD2_8), 1.0f / (W8SCALE * H8SCALE), D, DFF, nullptr, 0, WSP(bf16, WS_X2B), F.out, nullptr, nullptr, nullptr, 1.0f / (W8SCALE * H8SCALE)));
#undef RUNPHASE
#undef GEMM_PHASE
#undef GEMM_PHASE8
#undef GEMM_PHASEI
#undef RSTAB
#undef IN
#undef SEAM
}

#ifndef MK_N_LAUNCHES
#define MK_N_LAUNCHES 1
#endif
extern "C" void kernel_launch(void* const* d_in, const int* in_sizes, int n_in, void* d_out, int out_size, void* d_ws, size_t ws_size, hipStream_t stream) {
    static int grid = 0;
    if (grid == 0) {
        if (n_in != 22 || out_size != (int)O_END || ws_size < WS_END) { fprintf(stderr, "kernel_launch: unexpected problem: n_in %d out %d ws %zu (need %zu)\n", n_in, out_size, ws_size, (size_t)WS_END); grid = -1; return; }
        int dev = 0, cus = 0, per_cu = 0;
        if (hipGetDevice(&dev) != hipSuccess || hipDeviceGetAttribute(&cus, hipDeviceAttributeMultiprocessorCount, dev) != hipSuccess) { grid = -1; return; }
        if (hipFuncSetAttribute((const void*)hymba_fwd, hipFuncAttributeMaxDynamicSharedMemorySize, LDS_BYTES) != hipSuccess) { fprintf(stderr, "kernel_launch: hipFuncSetAttribute failed\n"); grid = -1; return; }
        if (hipOccupancyMaxActiveBlocksPerMultiprocessor(&per_cu, (const void*)hymba_fwd, 512, LDS_BYTES) != hipSuccess || per_cu < 1) { fprintf(stderr, "kernel_launch: occupancy query says %d blocks per CU\n", per_cu); (void)hipGetLastError(); grid = -1; return; }
        grid = cus;
        if (grid % 8 != 0 || grid < 8) { fprintf(stderr, "kernel_launch: unexpected CU count %d\n", cus); grid = -1; return; }
    }
    if (grid < 0) return;
    (void)hipMemsetAsync((char*)d_ws + WS_CTL, 0, CTL_ZERO_BYTES, stream);
    Args a{};
    for (int i = 0; i < 22; ++i) a.in[i] = d_in[i];
    a.out = (float*)d_out; a.ws = (unsigned char*)d_ws;
    if (MK_N_LAUNCHES == 1) { a.ph_lo = 0; a.ph_hi = N_PHASES; a.use_bar = 1; hipLaunchKernelGGL(hymba_fwd, dim3(grid), dim3(512), LDS_BYTES, stream, a); }
    else for (int p = 0; p < N_PHASES; ++p) { a.ph_lo = p; a.ph_hi = p + 1; a.use_bar = 0; hipLaunchKernelGGL(hymba_fwd, dim3(grid), dim3(512), LDS_BYTES, stream, a); }
}
```

```cpp
#include <hip/hip_runtime.h>
#include <cstdio>
#include <cstdint>
#include <type_traits>
namespace pg8 {
#define PG8_LAS __attribute__((address_space(3)))
typedef unsigned short bf16_t;
typedef short bf16x8 __attribute__((ext_vector_type(8)));
typedef float f32x4 __attribute__((ext_vector_type(4)));
typedef unsigned u32x4 __attribute__((ext_vector_type(4)));
constexpr int BM = 256, BK = 64, HALF = 128, HTB = HALF * BK * 2  , STAGE_BYTES = 8 * HTB, NXCD = 8, WGM = 8;

__host__ __device__ __forceinline__ int lds_byte(int r, int c) { const int st = (r >> 4) * 2 + (c >> 5), rr = r & 15, cc = c & 31, ob = rr * 64 + cc * 2; return st * 1024 + (ob ^ (((ob >> 9) & 1) << 5)); }
__host__ __device__ __forceinline__ void stage_rc(int b, int& R, int& C) { const int st = b / 1024, sb = b % 1024, swz = sb ^ (((sb >> 9) & 1) << 5); R = (st >> 1) * 16 + swz / 64; C = (st & 1) * 32 + (swz % 64) / 2; }
__host__ __device__ __forceinline__ int perm32(int rho) { const int n = rho >> 4, i = rho & 15; return 8 * (i >> 2) + 4 * n + (i & 3); }

struct Unit { int pm, pn; };
struct Gemm { const bf16_t* A; const bf16_t* Bt; int M, N, K; };

struct StaticOrder {
    int nM, nN, nwg, G, c;
    __host__ __device__ void init(int M, int N, int G_, int c_) { nM = M / BM; nN = N / BM; nwg = nM * nN; G = G_; c = c_; }
    __host__ __device__ bool next(int i, Unit& u) const {
        const long L = (long)i * G + c; if (L >= nwg) return false;
        int wgid = (int)L; { const int q = nwg / NXCD, r = nwg % NXCD, xcd = wgid % NXCD, off = wgid / NXCD; wgid = (xcd < r ? xcd * (q + 1) : r * (q + 1) + (xcd - r) * q) + off; }
        const int nig = WGM * nN, gid = wgid / nig, fm = gid * WGM, gsz = (nM - fm) < WGM ? (nM - fm) : WGM;
        u.pm = fm + ((wgid % nig) % gsz); u.pn = (wgid % nig) / gsz; return true;
    }
    __device__ __forceinline__ void a_ready(const Unit&) const {}
    __device__ __forceinline__ void done(const Unit&) const {}
};
__device__ __forceinline__ unsigned cvt_pk_bf16(float lo, float hi) { unsigned r; asm volatile("v_cvt_pk_bf16_f32 %0, %1, %2" : "=v"(r) : "v"(lo), "v"(hi)); return r; }
template <class Epi, class Sched, bool ALIGN_EPI = false, bool SP2 = false, int QM = 0, int PFD = 0>
__device__ __forceinline__ void gemm_phase(PG8_LAS unsigned char* lds, const Gemm g, const Sched& S, const Epi& E) {
    const int tid = threadIdx.x, wid = __builtin_amdgcn_readfirstlane(tid >> 6), lane = tid & 63, wr = wid >> 2, wc = wid & 3, fr = lane & 15, fq = lane >> 4;
    const int K = g.K, nt = K / BK;
    unsigned voffA[2], voffB[2];
#pragma unroll
    for (int i = 0; i < 2; ++i) { int R, C; stage_rc(tid * 16 + i * 8192, R, C); const int Rb = Epi::PERM ? ((R & ~31) + perm32(R & 31)) : R;
        voffA[i] = (unsigned)(R * K + C) * 2u; voffB[i] = (unsigned)(Rb * K + C) * 2u; }
    unsigned voffP[2];
#pragma unroll
    for (int i = 0; i < 2; ++i) voffP[i] = (unsigned)((32 * wid + 16 * i + (lane >> 2)) * K) * 2u + (unsigned)(lane & 3) * 4u;
#define PG8_PF(s2, kt) do { if constexpr (PFD != 0) { const char* p_ = ((kt) < nt) ? cA + (size_t)(kt) * kstep : nA + (size_t)((kt) - nt) * kstep; \
        __builtin_amdgcn_global_load_lds((const unsigned*)(p_ + voffP[s2]), (PG8_LAS unsigned*)(lds + 143360 + wid * 256), 4, 0, 0); } } while (0)
#define PG8_WAIT_V8() do { if constexpr (PFD != 0) PG8_WAIT_V(10); else PG8_WAIT_V(8); } while (0)
    const size_t kstep = (size_t)(BK * 2);
    const size_t hstep = (size_t)HALF * K * 2;
    const size_t tstep = 2 * hstep;
    const unsigned ldsw = (unsigned)wid * 1024u;
    const int aoff = lds_byte(wr * 64 + fr, fq * 8), boff = lds_byte(wc * 32 + fr, fq * 8);
#define PG8_SA(b, h) (((b) * 2 + (h)) * HTB)
#define PG8_SB(b, h) ((4 + (b) * 2 + (h)) * HTB)
#define PG8_STAGE(bufoff, gbase, voff) do { _Pragma("unroll") for (int _i = 0; _i < 2; ++_i) \
        __builtin_amdgcn_global_load_lds((const unsigned*)((const char*)(gbase) + (voff)[_i]), (PG8_LAS unsigned*)(lds + (bufoff) + ldsw + _i * 8192), 16, 0, 0); } while (0)
#define PG8_LDF(dst_, addr_) do { if constexpr (QM == 1) { const pg8_v4i lo_ = *(const PG8_LAS pg8_v4i*)(addr_), hi_ = *(const PG8_LAS pg8_v4i*)((addr_) + 1024); \
            (dst_).v = __builtin_shufflevector(lo_, hi_, 0, 1, 2, 3, 4, 5, 6, 7); } \
        else { (dst_).k[0] = *(const PG8_LAS bf16x8*)(addr_); (dst_).k[1] = *(const PG8_LAS bf16x8*)((addr_) + 1024); } } while (0)
#define PG8_LDA(dst, b, h) do { _Pragma("unroll") for (int m = 0; m < 4; ++m) PG8_LDF(dst[m], lds + PG8_SA(b, h) + aoff + m * 2048); } while (0)
#define PG8_LDB(dst, b, h) do { _Pragma("unroll") for (int n = 0; n < 2; ++n) PG8_LDF(dst[n], lds + PG8_SB(b, h) + boff + n * 2048); } while (0)
#define PG8_MMA(ai, bj, At, Bt) do { __builtin_amdgcn_s_setprio(1); if constexpr (QM != 0) asm volatile("s_nop 4");     \
        _Pragma("unroll") for (int m = 0; m < 4; ++m) _Pragma("unroll") for (int n = 0; n < 2; ++n) { \
            if constexpr (QM == 1) asm volatile("v_mfma_scale_f32_16x16x128_f8f6f4 %0, %1, %2, %0, %3, %3 op_sel_hi:[0,0,0]" : "+v"(acc[ai][bj][m][n]) : "v"(Bt[n].v), "v"(At[m].v), "v"(scl8_));     \
            else if constexpr (QM == 2) { _Pragma("unroll") for (int k = 0; k < 2; ++k) asm volatile("v_mfma_i32_16x16x64_i8 %0, %1, %2, %0" : "+v"(acc[ai][bj][m][n]) : "v"(Bt[n].k[k]), "v"(At[m].k[k])); } \
            else { _Pragma("unroll") for (int k = 0; k < 2; ++k) acc[ai][bj][m][n] = __builtin_amdgcn_mfma_f32_16x16x32_bf16(Bt[n].k[k], At[m].k[k], acc[ai][bj][m][n], 0, 0, 0); } } \
        __builtin_amdgcn_s_setprio(0); } while (0)
#define PG8_WAIT_V(n) asm volatile("s_waitcnt vmcnt(" #n ")" ::: "memory")
#define PG8_WAIT_L(n) asm volatile("s_waitcnt lgkmcnt(" #n ")" ::: "memory")
#define PG8_BAR __builtin_amdgcn_s_barrier()
#define PG8_SCHED __builtin_amdgcn_sched_barrier(0)
    Unit cur, nxt; int ui = 0;
    if (!S.next(0, cur)) return;
    f32x4 acc[2][2][4][2];
    E.init(acc, cur, wr, wc, fr, fq);
    typedef int pg8_v8i __attribute__((ext_vector_type(8))); typedef int pg8_v4i __attribute__((ext_vector_type(4)));
    struct FragB { bf16x8 k[2]; }; struct Frag8 { pg8_v8i v; };
    typedef typename std::conditional<QM == 1, Frag8, FragB>::type Frag;
    Frag At[4], B0[2], B1[2];
    unsigned scl8_ = 0x7F7F7F7Fu; asm volatile("" : "+v"(scl8_));
    const char* cA = (const char*)g.A + (size_t)cur.pm * tstep; const char* cB = (const char*)g.Bt + (size_t)cur.pn * tstep;
    S.a_ready(cur);
    if constexpr (SP2) {
        PG8_STAGE(PG8_SB(0, 0), cB, voffB); PG8_STAGE(PG8_SB(0, 1), cB + hstep, voffB); PG8_STAGE(PG8_SA(0, 0), cA, voffA); PG8_STAGE(PG8_SA(0, 1), cA + hstep, voffA);
        if (wr == 1) PG8_BAR;
        PG8_WAIT_V(2); PG8_BAR;
        PG8_STAGE(PG8_SB(1, 0), cB + kstep, voffB); PG8_STAGE(PG8_SA(1, 0), cA + kstep, voffA); PG8_STAGE(PG8_SB(1, 1), cB + hstep + kstep, voffB);
        PG8_WAIT_V(6); PG8_BAR;
    } else {
        PG8_STAGE(PG8_SB(0, 0), cB, voffB); PG8_STAGE(PG8_SA(0, 0), cA, voffA); PG8_STAGE(PG8_SB(0, 1), cB + hstep, voffB); PG8_STAGE(PG8_SA(0, 1), cA + hstep, voffA);
        if (wr == 1) PG8_BAR;
        PG8_WAIT_V(4); PG8_BAR;
        PG8_STAGE(PG8_SB(1, 0), cB + kstep, voffB); PG8_STAGE(PG8_SA(1, 0), cA + kstep, voffA); PG8_STAGE(PG8_SB(1, 1), cB + hstep + kstep, voffB);
        PG8_WAIT_V(6); PG8_BAR;
    }
    for (;;) {
        const bool has_next = S.next(ui + 1, nxt);
        const char* nA = has_next ? (const char*)g.A + (size_t)nxt.pm * tstep : cA; const char* nB = has_next ? (const char*)g.Bt + (size_t)nxt.pn * tstep : cB;
#pragma unroll 1
        for (int t = 0; t < nt; t += 2) {
            const bool last = (t == nt - 2);
            const char* a1 = cA + (size_t)(t + 1) * kstep;
            const char* a2 = last ? nA : cA + (size_t)(t + 2) * kstep; const char* b2 = last ? nB : cB + (size_t)(t + 2) * kstep;
            const char* a3 = a2 + kstep; const char* b3 = b2 + kstep;
            if (last && has_next) S.a_ready(nxt);
            if constexpr (SP2) {
            PG8_LDB(B0, 0, 0); PG8_LDB(B1, 0, 1); PG8_SCHED; PG8_LDA(At, 0, 0); PG8_STAGE(PG8_SA(1, 1), a1 + hstep, voffA); PG8_PF(0, t + PFD);
            PG8_WAIT_V8(); PG8_WAIT_L(0); PG8_BAR; PG8_MMA(0, 0, At, B0); PG8_MMA(0, 1, At, B1); PG8_BAR; PG8_SCHED;
            PG8_LDA(At, 0, 1); PG8_STAGE(PG8_SB(0, 0), b2, voffB); PG8_STAGE(PG8_SB(0, 1), b2 + hstep, voffB); PG8_STAGE(PG8_SA(0, 0), a2, voffA); PG8_PF(1, t + PFD);
            PG8_WAIT_V8(); PG8_WAIT_L(0); PG8_BAR; PG8_MMA(1, 0, At, B0); PG8_MMA(1, 1, At, B1); PG8_BAR; PG8_SCHED;
            PG8_LDB(B0, 1, 0); PG8_LDB(B1, 1, 1); PG8_SCHED; PG8_LDA(At, 1, 0); PG8_STAGE(PG8_SA(0, 1), a2 + hstep, voffA); PG8_PF(0, t + 1 + PFD);
            PG8_WAIT_V8(); PG8_WAIT_L(0); PG8_BAR; PG8_MMA(0, 0, At, B0); PG8_MMA(0, 1, At, B1); PG8_BAR; PG8_SCHED;
            PG8_LDA(At, 1, 1); PG8_STAGE(PG8_SB(1, 0), b3, voffB); PG8_STAGE(PG8_SB(1, 1), b3 + hstep, voffB); PG8_STAGE(PG8_SA(1, 0), a3, voffA); PG8_PF(1, t + 1 + PFD);
            PG8_WAIT_V8(); PG8_WAIT_L(0); PG8_BAR; PG8_MMA(1, 0, At, B0); PG8_MMA(1, 1, At, B1); PG8_BAR; PG8_SCHED;
            } else {
            PG8_LDB(B0, 0, 0); PG8_SCHED; PG8_LDA(At, 0, 0); PG8_STAGE(PG8_SA(1, 1), a1 + hstep, voffA);
            PG8_WAIT_L(8); PG8_BAR; PG8_WAIT_L(0); PG8_MMA(0, 0, At, B0); PG8_BAR; PG8_SCHED;
            PG8_LDB(B1, 0, 1); PG8_STAGE(PG8_SB(0, 0), b2, voffB);
            PG8_BAR; PG8_WAIT_L(0); PG8_MMA(0, 1, At, B1); PG8_BAR;
            PG8_LDA(At, 0, 1); PG8_STAGE(PG8_SA(0, 0), a2, voffA);
            PG8_BAR; PG8_WAIT_L(0); PG8_MMA(1, 0, At, B0); PG8_BAR; PG8_SCHED;
            PG8_STAGE(PG8_SB(0, 1), b2 + hstep, voffB);
            PG8_WAIT_V(6); PG8_BAR; PG8_MMA(1, 1, At, B1); PG8_BAR;
            PG8_LDB(B0, 1, 0); PG8_SCHED; PG8_LDA(At, 1, 0); PG8_STAGE(PG8_SA(0, 1), a2 + hstep, voffA);
            PG8_WAIT_L(8); PG8_BAR; PG8_WAIT_L(0); PG8_MMA(0, 0, At, B0); PG8_BAR; PG8_SCHED;
            PG8_LDB(B1, 1, 1); PG8_STAGE(PG8_SB(1, 0), b3, voffB);
            PG8_BAR; PG8_WAIT_L(0); PG8_MMA(0, 1, At, B1); PG8_BAR;
            PG8_LDA(At, 1, 1); PG8_STAGE(PG8_SA(1, 0), a3, voffA);
            PG8_BAR; PG8_WAIT_L(0); PG8_MMA(1, 0, At, B0); PG8_BAR; PG8_SCHED;
            PG8_STAGE(PG8_SB(1, 1), b3 + hstep, voffB);
            PG8_WAIT_V(6); PG8_BAR; PG8_MMA(1, 1, At, B1); PG8_BAR;
            }
        }
        if constexpr (ALIGN_EPI) { if (wr == 0) PG8_BAR; }
        if constexpr (QM != 0) asm volatile("s_nop 15\n\ts_nop 7" ::: "memory");
        if constexpr (!Epi::AFTER_DRAIN) { E(acc, cur, wr, wc, fr, fq, ui, has_next, nxt);
#if defined(PROBE_DUP) && PROBE_DUP == 61
            E(acc, cur, wr, wc, fr, fq, ui, has_next, nxt);
#endif
            S.done(cur); }
        if (!has_next) break;
        cur = nxt; cA = nA; cB = nB; ++ui;
        if constexpr (ALIGN_EPI) { if (wr == 1) PG8_BAR; }
    }
    PG8_WAIT_V(0);
    if constexpr (!ALIGN_EPI) { if (wr == 0) PG8_BAR; }
    PG8_BAR;
    if constexpr (Epi::AFTER_DRAIN) { E.fused(acc, cur, wr, wc, fr, fq, lds, wid, lane); S.done(cur); }
#undef PG8_SA
#undef PG8_PF
#undef PG8_WAIT_V8
#undef PG8_SB
#undef PG8_STAGE
#undef PG8_LDA
#undef PG8_LDF
#undef PG8_LDB
#undef PG8_MMA
#undef PG8_WAIT_V
#undef PG8_WAIT_L
#undef PG8_BAR
#undef PG8_SCHED
}
}
#include <hip/hip_bf16.h>
#include <cmath>
namespace attn_body {
using bf16=__hip_bfloat16;
using bf16x8=__attribute__((ext_vector_type(8)))short;
using s16x4=__attribute__((ext_vector_type(4)))short;
using f32x16=__attribute__((ext_vector_type(16)))float;
using u32x4=__attribute__((ext_vector_type(4)))unsigned;
constexpr int BATCH=16,NHEAD=8,SEQ=2048,D=64;
constexpr int QP=512,KP=128,OP=1024,OOFF=512;
constexpr int NW=8,QBLK=32,QB=QBLK*NW,KVBLK=64,NQB=SEQ/QB;
constexpr int ATTN_UNIT_ROWS=QB;
__device__ __forceinline__ int crow(int r,int hi){return (r&3)+8*(r>>2)+4*hi;}
#define SBAR() __builtin_amdgcn_sched_barrier(0)
__device__ __forceinline__ float mskv_bit(float v,unsigned W,unsigned bit){ int m; asm("v_bfe_i32 %1, %2, %3, 1\n\tv_and_b32 %0, %0, %1":"+v"(v),"=&v"(m):"v"(W),"s"(bit)); return v; }
#define MSKV(v,W,r) mskv_bit(v,W,(unsigned)(((r)&3)+8*((r)>>2)))
__device__ __forceinline__ void cmask(f32x16&p0,f32x16&p1,int jb,int qrel,int hi){
  const float NEG=-INFINITY; int kb=64*jb+4*hi;
  #pragma unroll
  for(int r=0;r<16;++r){int kv=kb+(r&3)+8*(r>>2); if(kv>qrel)p0[r]=NEG; if(kv+32>qrel)p1[r]=NEG;}
}

constexpr int NSLOT=3, SLOTB=8192;
constexpr int LDS_K=0, LDS_V=NSLOT*SLOTB, LDS_WS=2*NSLOT*SLOTB, LDS_OST=LDS_WS+NW*64*4, LDS_MSK=LDS_OST+NW*4096, LDS_BYTES=LDS_MSK+NW*8192;
constexpr float C2=0.125f*1.4426950408889634f;
__device__ __forceinline__ void glds16(const void*gsrc,unsigned lds_dst){unsigned keep;
  asm volatile("s_mov_b32 %0, m0\n\ts_mov_b32 m0, %2\n\ts_nop 0\n\tglobal_load_lds_dwordx4 %1, off\n\ts_mov_b32 m0, %0":"=&s"(keep):"v"(gsrc),"s"(lds_dst):"memory");}
__device__ __forceinline__ float max3f(float a,float b,float c){float r;asm("v_max3_f32 %0, %1, %2, %3":"=v"(r):"v"(a),"v"(b),"v"(c));return r;}
__device__ __forceinline__ float max2f(float a,float b){float r;asm("v_max_f32_e32 %0, %1, %2":"=v"(r):"v"(a),"v"(b));return r;}
__device__ __forceinline__ float fadd_s(float a,float b){float r;asm("v_add_f32_e32 %0, %1, %2":"=v"(r):"v"(a),"v"(b));return r;}
__device__ __forceinline__ float fsub_s(float a,float b){float r;asm("v_sub_f32_e32 %0, %1, %2":"=v"(r):"v"(a),"v"(b));return r;}
typedef float f32x2_t __attribute__((ext_vector_type(2))); typedef __bf16 bf16x2_t __attribute__((ext_vector_type(2)));
__device__ __forceinline__ unsigned cvtpk_s(float lo,float hi){f32x2_t v={lo,hi};bf16x2_t b=__builtin_convertvector(v,bf16x2_t);return __builtin_bit_cast(unsigned,b);}
#define WAIT_BAR(N) asm volatile("s_waitcnt vmcnt(" #N ") lgkmcnt(0)\n\ts_barrier":::"memory")

__device__ __forceinline__ void qkt(f32x16&p0,f32x16&p1,const char*Kslot,const bf16x8*qr,const f32x16&negm,int r32,int hi){
  const char*kb=Kslot+hi*1024+r32*16;
  #pragma unroll
  for(int d0=0;d0<4;++d0){
    const bf16x8 b0=*reinterpret_cast<const bf16x8*>(kb+d0*2048);
    const bf16x8 b1=*reinterpret_cast<const bf16x8*>(kb+d0*2048+512);
    if(d0==0){p0=__builtin_amdgcn_mfma_f32_32x32x16_bf16(b0,qr[0],negm,0,0,0);p1=__builtin_amdgcn_mfma_f32_32x32x16_bf16(b1,qr[0],negm,0,0,0);}
    else{p0=__builtin_amdgcn_mfma_f32_32x32x16_bf16(b0,qr[d0],p0,0,0,0);p1=__builtin_amdgcn_mfma_f32_32x32x16_bf16(b1,qr[d0],p1,0,0,0);}}
}
typedef __attribute__((address_space(3))) const char* lds_cptr;
typedef short v4i16_t __attribute__((ext_vector_type(4)));
__device__ __forceinline__ void kload8(bf16x8*kf,lds_cptr kp){
  kf[0]=*(const __attribute__((address_space(3))) bf16x8*)(kp);      kf[1]=*(const __attribute__((address_space(3))) bf16x8*)(kp+512);
  kf[2]=*(const __attribute__((address_space(3))) bf16x8*)(kp+2048); kf[3]=*(const __attribute__((address_space(3))) bf16x8*)(kp+2560);
  kf[4]=*(const __attribute__((address_space(3))) bf16x8*)(kp+4096); kf[5]=*(const __attribute__((address_space(3))) bf16x8*)(kp+4608);
  kf[6]=*(const __attribute__((address_space(3))) bf16x8*)(kp+6144); kf[7]=*(const __attribute__((address_space(3))) bf16x8*)(kp+6656);
}
__device__ __forceinline__ void kload2(bf16x8*kf,lds_cptr kp,int j){ kf[2*j]=*(const __attribute__((address_space(3))) bf16x8*)(kp+j*2048); kf[2*j+1]=*(const __attribute__((address_space(3))) bf16x8*)(kp+j*2048+512); }
__device__ __forceinline__ s16x4 vtr(lds_cptr p){ return __builtin_bit_cast(s16x4,__builtin_amdgcn_ds_read_tr16_b64_v4i16((__attribute__((address_space(3))) v4i16_t*)p)); }
__device__ __forceinline__ float rowmax(const f32x16&p0,const f32x16&p1){
  float a=max3f(p0[0],p0[1],p1[0]),b=max3f(p0[2],p0[3],p1[1]);a=max3f(a,p1[2],p1[3]);
  #pragma unroll
  for(int r=4;r<16;r+=4){a=max3f(a,p0[r],p0[r+1]);b=max3f(b,p0[r+2],p0[r+3]);a=max3f(a,p1[r],p1[r+1]);b=max3f(b,p1[r+2],p1[r+3]);}
  const float m=max2f(a,b);
  auto rr=__builtin_amdgcn_permlane32_swap(__float_as_uint(m),__float_as_uint(m),false,false);
  return max2f(__uint_as_float(rr[0]),__uint_as_float(rr[1]));
}
__device__ __forceinline__ void pv(f32x16*o,int vb,bf16x8 pa0,bf16x8 pa1,bf16x8 pa2,bf16x8 pa3){
  #pragma unroll
  for(int d0=0;d0<2;++d0){s16x4 lo[4],hi[4];
    #pragma unroll
    for(int ks=0;ks<4;++ks){
      asm volatile("ds_read_b64_tr_b16 %0,%1 offset:%c2":"=&v"(lo[ks]):"v"(vb),"i"(d0*4096+ks*1024):"memory");
      asm volatile("ds_read_b64_tr_b16 %0,%1 offset:%c2":"=&v"(hi[ks]):"v"(vb),"i"(d0*4096+ks*1024+512):"memory");}
    asm volatile("s_waitcnt lgkmcnt(0)":::"memory");SBAR();
    #define PK(k) (bf16x8){lo[k][0],lo[k][1],lo[k][2],lo[k][3],hi[k][0],hi[k][1],hi[k][2],hi[k][3]}
    o[d0]=__builtin_amdgcn_mfma_f32_32x32x16_bf16(pa0,PK(0),o[d0],0,0,0);
    o[d0]=__builtin_amdgcn_mfma_f32_32x32x16_bf16(pa1,PK(1),o[d0],0,0,0);
    o[d0]=__builtin_amdgcn_mfma_f32_32x32x16_bf16(pa2,PK(2),o[d0],0,0,0);
    o[d0]=__builtin_amdgcn_mfma_f32_32x32x16_bf16(pa3,PK(3),o[d0],0,0,0);
    #undef PK
  }
}

#ifndef ATTN_STORE16
#define ATTN_STORE16(p,v) (*(u32x4*)(p)=(v))
#endif
template<int THRL> __device__ __forceinline__ void attn_unit(int b,int h,int qb,const bf16*Q,const bf16*K,const bf16*V,const unsigned long long*MK,bf16*O,char*shm){
  const int tid=threadIdx.x,lane=tid&63,r32=lane&31,hi=lane>>5; const int wid=__builtin_amdgcn_readfirstlane(tid>>6);
  const long rowbase=(long)b*SEQ; const int q0=qb*QB;
  const bf16*Qw=Q+(rowbase+q0+wid*QBLK)*QP+h*D;
  const bf16*Kh=K+rowbase*KP+(h>>2)*D,*Vh=V+rowbase*KP+(h>>2)*D;
  const unsigned lds0=(unsigned)(uintptr_t)shm;
  float*wsf=(float*)(shm+LDS_WS)+wid*64;
  const bf16*ksrc=Kh+(long)lane*KP+wid*8;
  const bf16*vsrc=Vh+(long)(16*(wid&3)+(lane>>2))*KP+(wid>>2)*32+(lane&3)*8;
  const unsigned kdst=lds0+LDS_K+wid*1024, vdst=lds0+LDS_V+wid*1024;
  #define DMA_K(t,slot) glds16(ksrc+(long)(t)*KVBLK*KP,(unsigned)__builtin_amdgcn_readfirstlane(kdst+(slot)))
  #define DMA_V(t,slot) glds16(vsrc+(long)(t)*KVBLK*KP,(unsigned)__builtin_amdgcn_readfirstlane(vdst+(slot)))
  const int vb0=(int)(lds0+LDS_V)+((lane>>4)&1)*32+(lane&3)*8+(4*hi+((lane&15)>>2))*64;
  const char*Kbase=shm+LDS_K; bf16x8 kf[8];
  const lds_cptr shm3=(lds_cptr)shm; const lds_cptr kp0=shm3+LDS_K+hi*1024+r32*16; const lds_cptr vp0=shm3+LDS_V+((lane>>4)&1)*32+(lane&3)*8+(4*hi+((lane&15)>>2))*64;
  const int NT=(q0+QB)/KVBLK;
  const __attribute__((address_space(3))) char* shm3m=(const __attribute__((address_space(3))) char*)shm;
  typedef __attribute__((address_space(3))) unsigned long long* lds_u64p;
  const lds_u64p mskw=(lds_u64p)(shm3m+LDS_MSK+wid*8192);
  { const unsigned long long*mq=MK+(q0+wid*QBLK+2*(lane&15)); const unsigned mdst=lds0+LDS_MSK+wid*8192;
    #pragma unroll
    for(int i=0;i<8;++i){int tt=4*i+(lane>>4); tt=tt<NT?tt:NT-1; glds16(mq+(long)tt*SEQ,(unsigned)__builtin_amdgcn_readfirstlane(mdst+i*1024));} }
  DMA_K(0,0);DMA_V(0,0);DMA_K(1,SLOTB);
  bf16x8 qr[4];
  #pragma unroll
  for(int d0=0;d0<4;++d0)qr[d0]=*reinterpret_cast<const bf16x8*>(&Qw[(long)r32*QP+d0*16+hi*8]);
  float mhat=0.f,l_reg=0.f;f32x16 o[2];o[0]=f32x16{};o[1]=f32x16{};f32x16 negm=f32x16{};asm volatile("":"+v"(negm));
  const int qrel=wid*QBLK+r32;
  #define CMASK(P0,P1,t) do{int jb_=(t)-(NT-4); if(jb_>=0)cmask(P0,P1,jb_,qrel,hi);}while(0)
  bool resc=false;
  #define START(P0,P1) do{ const float rm=rowmax(P0,P1); resc=false; \
    { const float dl=rm; mhat=fadd_s(mhat,dl); \
      _Pragma("unroll") for(int r=0;r<16;++r){P0[r]=fsub_s(P0[r],dl);P1[r]=fsub_s(P1[r],dl);} \
      _Pragma("unroll") for(int r=0;r<16;++r)negm[r]=-mhat; asm volatile("":"+v"(negm)); } \
    _Pragma("unroll") for(int r=0;r<16;++r)P0[r]=__builtin_amdgcn_exp2f(P0[r]); }while(0)
  #define RESC() do{ if(resc){ asm volatile("s_waitcnt lgkmcnt(0)":::"memory"); \
      _Pragma("unroll") for(int d_=0;d_<2;++d_) _Pragma("unroll") for(int r=0;r<16;++r)o[d_][r]*=wsf[crow(r,hi)]; } }while(0)
  f32x16 pA0,pA1,pB0,pB1;
  int sl_prev=0,sl_cur=0,sl_next=SLOTB;
  #define ROT() do{sl_prev=sl_cur;sl_cur=sl_next;sl_next=(sl_next==(NSLOT-1)*SLOTB)?0:sl_next+SLOTB;}while(0)
  DMA_K(2,2*SLOTB);
  WAIT_BAR(3);
  #define MLOAD(t,LO,HI) do{ const unsigned long long mw_=mskw[(t)*32+r32]; LO=((unsigned)mw_)>>(4*hi); HI=((unsigned)(mw_>>32))>>(4*hi); }while(0)
  unsigned mlo,mhi; MLOAD(0,mlo,mhi);
  qkt(pA0,pA1,Kbase,qr,negm,r32,hi);asm volatile("s_nop 15\n\ts_nop 7":"+v"(pA0),"+v"(pA1));
  START(pA0,pA1);
  _Pragma("unroll") for(int r=0;r<16;++r)pA1[r]=__builtin_amdgcn_exp2f(pA1[r]);
  _Pragma("unroll") for(int r=0;r<16;++r){pA0[r]=MSKV(pA0[r],mlo,r);pA1[r]=MSKV(pA1[r],mhi,r);}
  WAIT_BAR(0);
  DMA_K(3,0);DMA_V(1,SLOTB);
  ROT();
  kload8(kf,kp0+sl_cur);
  WAIT_BAR(2);
  s16x4 vlo[8],vhi[8]; u32x4 pw0,pw1,pw2,pw3;
  #define PKW(P,B) cvtpk_s(P[B],P[B+1])
  #define PAF(k) __builtin_bit_cast(bf16x8,pw##k)
  #define VFR(i) (bf16x8){vlo[i][0],vlo[i][1],vlo[i][2],vlo[i][3],vhi[i][0],vhi[i][1],vhi[i][2],vhi[i][3]}
  #define PIN(x) asm volatile("":"+v"(x))
  #define MX3(a,b,c) __builtin_fmaxf(__builtin_fmaxf((a),(b)),(c))
  #define GAPA(MF,A0,A1,A2,A3,W0,W1,PW) do{ MF; sacc+=A0; sacc+=A1; sacc+=A2; sacc+=A3; PIN(sacc); W0; W1; PIN(PW); SBAR(); }while(0)
  #define EX(v) __builtin_amdgcn_exp2f(v)
  #define GAPB(MF,X,B,W) do{ MF; X[B]=MSKV(EX(X[B]),W,B); X[B+1]=MSKV(EX(X[B+1]),W,B+1); X[B+2]=MSKV(EX(X[B+2]),W,B+2); X[B+3]=MSKV(EX(X[B+3]),W,B+3); PIN(X); SBAR(); }while(0)
  #define VRD(i) do{ vlo[i]=vtr(vp_+(((i)>>2)*4096+((i)&3)*1024)); vhi[i]=vtr(vp_+(((i)>>2)*4096+((i)&3)*1024+512)); }while(0)
  #define KRD(G,j) do{ if(G){ kload2(kf,kp0+sl_next,j); SBAR(); } }while(0)
  #define STEP(C0,C1,P0,P1,t,GK,GV,GL) do{ SBAR(); \
    const lds_cptr vp_=vp0+sl_prev; MLOAD(t,mlo,mhi); \
    VRD(0); SBAR(); float sacc=(P0[0]+P0[1]); \
    GAPA(C0=__builtin_amdgcn_mfma_f32_32x32x16_bf16(kf[0],qr[0],negm,0,0,0), P0[2],P0[3],P0[4],P0[5],     pw0[0]=PKW(P0,0), pw0[1]=PKW(P0,2), pw0); \
    VRD(4); SBAR(); GAPA(C1=__builtin_amdgcn_mfma_f32_32x32x16_bf16(kf[1],qr[0],negm,0,0,0), P0[6],P0[7],P0[8],P0[9],     pw0[2]=PKW(P0,4), pw0[3]=PKW(P0,6), pw0); \
    VRD(1); SBAR(); GAPA(C0=__builtin_amdgcn_mfma_f32_32x32x16_bf16(kf[2],qr[1],C0,0,0,0),   P0[10],P0[11],P0[12],P0[13], pw1[0]=PKW(P0,8), pw1[1]=PKW(P0,10), pw1); \
    VRD(5); SBAR(); GAPA(C1=__builtin_amdgcn_mfma_f32_32x32x16_bf16(kf[3],qr[1],C1,0,0,0),   P0[14],P0[15],P1[0],P1[1],   pw1[2]=PKW(P0,12),pw1[3]=PKW(P0,14), pw1); \
    VRD(2); SBAR(); GAPA(C0=__builtin_amdgcn_mfma_f32_32x32x16_bf16(kf[4],qr[2],C0,0,0,0),   P1[2],P1[3],P1[4],P1[5],     pw2[0]=PKW(P1,0), pw2[1]=PKW(P1,2), pw2); \
    VRD(6); SBAR(); GAPA(C1=__builtin_amdgcn_mfma_f32_32x32x16_bf16(kf[5],qr[2],C1,0,0,0),   P1[6],P1[7],P1[8],P1[9],     pw2[2]=PKW(P1,4), pw2[3]=PKW(P1,6), pw2); \
    VRD(3); SBAR(); GAPA(C0=__builtin_amdgcn_mfma_f32_32x32x16_bf16(kf[6],qr[3],C0,0,0,0),   P1[10],P1[11],P1[12],P1[13], pw3[0]=PKW(P1,8), pw3[1]=PKW(P1,10), pw3); \
    VRD(7); SBAR(); GAPA(C1=__builtin_amdgcn_mfma_f32_32x32x16_bf16(kf[7],qr[3],C1,0,0,0),   P1[14],P1[15],0.f,0.f,       pw3[2]=PKW(P1,12),pw3[3]=PKW(P1,14), pw3); \
    l_reg+=sacc; \
    if(GK){DMA_K((t)+3,sl_cur);} if(GV){DMA_V((t)+1,sl_next);} \
    { float a=MX3(C0[0],C0[1],C1[0]),b=MX3(C0[2],C0[3],C1[1]); a=MX3(a,C1[2],C1[3]); \
      _Pragma("unroll") for(int r=4;r<16;r+=4){a=MX3(a,C0[r],C0[r+1]);b=MX3(b,C0[r+2],C0[r+3]);a=MX3(a,C1[r],C1[r+1]);b=MX3(b,C1[r+2],C1[r+3]);} \
      float rm=__builtin_fmaxf(a,b); { auto rr=__builtin_amdgcn_permlane32_swap(__float_as_uint(rm),__float_as_uint(rm),false,false); rm=__builtin_fmaxf(__uint_as_float(rr[0]),__uint_as_float(rr[1])); } \
      resc=false; \
      if(__builtin_expect(__any(rm>(float)THRL),0)){ const float dl=__builtin_fmaxf(rm,0.f); mhat+=dl; \
        _Pragma("unroll") for(int r=0;r<16;++r){C0[r]-=dl;C1[r]-=dl;} \
        _Pragma("unroll") for(int r=0;r<16;++r)negm[r]=-mhat; asm volatile("":"+v"(negm)); \
        const float f=__builtin_amdgcn_exp2f(-dl); l_reg*=f; if(hi==0)wsf[r32]=f; resc=true; } } \
    SBAR(); \
    GAPB(o[0]=__builtin_amdgcn_mfma_f32_32x32x16_bf16(PAF(0),VFR(0),o[0],0,0,0), C0,0,mlo); \
    GAPB(o[1]=__builtin_amdgcn_mfma_f32_32x32x16_bf16(PAF(0),VFR(4),o[1],0,0,0), C0,4,mlo); \
    KRD(GL,0); GAPB(o[0]=__builtin_amdgcn_mfma_f32_32x32x16_bf16(PAF(1),VFR(1),o[0],0,0,0), C0,8,mlo); \
    KRD(GL,1); GAPB(o[1]=__builtin_amdgcn_mfma_f32_32x32x16_bf16(PAF(1),VFR(5),o[1],0,0,0), C0,12,mlo); \
    KRD(GL,2); GAPB(o[0]=__builtin_amdgcn_mfma_f32_32x32x16_bf16(PAF(2),VFR(2),o[0],0,0,0), C1,0,mhi); \
    KRD(GL,3); GAPB(o[1]=__builtin_amdgcn_mfma_f32_32x32x16_bf16(PAF(2),VFR(6),o[1],0,0,0), C1,4,mhi); \
    GAPB(o[0]=__builtin_amdgcn_mfma_f32_32x32x16_bf16(PAF(3),VFR(3),o[0],0,0,0), C1,8,mhi); \
    GAPB(o[1]=__builtin_amdgcn_mfma_f32_32x32x16_bf16(PAF(3),VFR(7),o[1],0,0,0), C1,12,mhi); \
    }while(0)
  int t=1;
  #undef CMASK
  #define CMASK(P0,P1,t) do{}while(0)
  for(;t+5<NT;t+=2){
    STEP(pB0,pB1,pA0,pA1,t,true,true,true);     WAIT_BAR(2); RESC(); ROT();
    STEP(pA0,pA1,pB0,pB1,t+1,true,true,true);   WAIT_BAR(2); RESC(); ROT();
  }
  #undef CMASK
  #define CMASK(P0,P1,t) do{int jb_=(t)-(NT-4); if(jb_>=0)cmask(P0,P1,jb_,qrel,hi);}while(0)
  #define ENDW(tt) do{ if((tt)+3<NT){WAIT_BAR(2);} else if((tt)+2<NT){WAIT_BAR(1);} else {WAIT_BAR(0);} }while(0)
  for(;t+1<NT;t+=2){
    STEP(pB0,pB1,pA0,pA1,t,(t+3<NT),(t+1<NT),(t+1<NT));       ENDW(t);   RESC(); ROT();
    STEP(pA0,pA1,pB0,pB1,t+1,(t+4<NT),(t+2<NT),(t+2<NT));     ENDW(t+1); RESC(); ROT();
  }
  STEP(pB0,pB1,pA0,pA1,NT-1,false,false,false); RESC();
  { float sacc=pB0[0]+pB0[1]; _Pragma("unroll") for(int r=2;r<16;++r)sacc+=pB0[r]; _Pragma("unroll") for(int r=0;r<16;++r)sacc+=pB1[r]; l_reg+=sacc;
    pw0=(u32x4){PKW(pB0,0),PKW(pB0,2),PKW(pB0,4),PKW(pB0,6)};pw1=(u32x4){PKW(pB0,8),PKW(pB0,10),PKW(pB0,12),PKW(pB0,14)};pw2=(u32x4){PKW(pB1,0),PKW(pB1,2),PKW(pB1,4),PKW(pB1,6)};pw3=(u32x4){PKW(pB1,8),PKW(pB1,10),PKW(pB1,12),PKW(pB1,14)};
    SBAR(); pv(o,vb0+sl_cur,PAF(0),PAF(1),PAF(2),PAF(3)); }
  #undef PKW
  #undef PAF
  #undef VFR
  #undef PIN
  #undef MX3
  #undef GAPA
  #undef GAPB
  #undef EX
  #undef VRD
  #undef KRD
  #undef STEP
  #undef ENDW
  {auto rr=__builtin_amdgcn_permlane32_swap(__float_as_uint(l_reg),__float_as_uint(l_reg),false,false);l_reg=__uint_as_float(rr[0])+__uint_as_float(rr[1]);}
  if(hi==0)wsf[32+r32]=l_reg;asm volatile("s_waitcnt lgkmcnt(0)":::"memory");
  float rli[16];
  #pragma unroll
  for(int r=0;r<16;++r)rli[r]=__builtin_amdgcn_rcpf(wsf[32+crow(r,hi)]);
  bf16*Ow=O+(rowbase+q0+wid*QBLK)*OP+OOFF+h*D;
  { bf16*stg=(bf16*)(shm+LDS_OST)+wid*2048;
    #pragma unroll
    for(int r=0;r<16;++r){const int orow=crow(r,hi);
      #pragma unroll
      for(int d0=0;d0<2;++d0)stg[orow*64+d0*32+r32]=__float2bfloat16(o[d0][r]*rli[r]);}
    asm volatile("s_waitcnt lgkmcnt(0)":::"memory");
    #pragma unroll
    for(int i=0;i<4;++i){const int row=i*8+(lane>>3),ch=lane&7; const u32x4 v=*(const u32x4*)(stg+row*64+ch*8); ATTN_STORE16(Ow+(long)row*OP+ch*8,v);} }
  asm volatile("s_waitcnt lgkmcnt(0)\n\ts_barrier":::"memory");
  #undef DMA_K
  #undef DMA_V
  #undef CMASK
  #undef START
  #undef RESC
  #undef ROT
}
constexpr int ATTN_LDS_BYTES=LDS_BYTES;
struct AttnTensors { const bf16* Q; const bf16* K; const bf16* V; const unsigned long long* MK; bf16* O; };
struct AttnUnit { int bh; int qb; };
struct StaticOrder {
  int vcu;
  __device__ __forceinline__ explicit StaticOrder(int vcu_):vcu(vcu_){}
  __device__ __forceinline__ bool next(int i,AttnUnit&u)const{ if(vcu>=256)return false; const int s=vcu&1; u.bh=vcu>>1; if(s){ if(i>=5)return false; u.qb=(i<2)?6-i:5-i; } else { if(i>=3)return false; u.qb=(i==0)?7:(i==1)?4:0; } return true; }
};
template<class Sched,int THRL=8> __device__ __forceinline__ void attn_phase(char*lds,const AttnTensors&T,const Sched&S){
  AttnUnit u;
  for(int i=0;S.next(i,u);++i){ const int b=u.bh/NHEAD; attn_unit<THRL>(b,u.bh%NHEAD,u.qb,T.Q,T.K,T.V,T.MK+(long)b*32*SEQ,T.O,lds); }
}
#undef SBAR
#undef WAIT_BAR
}
#ifndef PROBE_DUP
#define PROBE_DUP (-1)
#endif
constexpr int D = 1024, NB = 16, SEQ = 2048, MP = NB * SEQ, DB = 32, DS = 4, MS = DB * DS, MTOT = MP + MS, MPAD = 33024;
constexpr int DFF = 2816, NIN = 2888, NINP = 3072, DCONV = 512;
constexpr int PAST = 16384, PAGE = 128, NPAGES = 128, KTOP = 256;
constexpr float EPS = 1e-6f, LOG2E = 1.4426950408889634f;
constexpr float QSCALE = 0.125f * LOG2E;
constexpr size_t O_YP = 0, O_YS = O_YP + (size_t)MP * D, O_KP = O_YS + (size_t)MS * D, O_VP = O_KP + (size_t)MP * 128, O_IP = O_VP + (size_t)MP * 128,
                 O_CP = O_IP + (size_t)MP * 64, O_KS = O_CP + 16 * 2 * 512, O_VS = O_KS + MS * 128, O_IS = O_VS + MS * 128, O_CS = O_IS + MS * 64, O_END = O_CS + 32 * 2 * 512;
static_assert(O_END == 44261376, "output size");

constexpr size_t al(size_t x) { return (x + 0xFFFFF) & ~(size_t)0xFFFFF; }
constexpr size_t WS_CTL = 0, CTL_ZERO_BYTES = 1u << 20;
constexpr size_t WS_ROPE = al(WS_CTL + CTL_ZERO_BYTES);
constexpr size_t WS_WGU1 = al(WS_ROPE + 2052 * 8 * 2 * 4);
constexpr size_t WS_WD1 = al(WS_WGU1 + (size_t)2 * DFF * D * 2);
constexpr size_t WS_WIN = al(WS_WD1 + (size_t)D * DFF * 2);
constexpr size_t WS_WOUT = al(WS_WIN + (size_t)NINP * D * 2);
constexpr size_t WS_WGU2 = al(WS_WOUT + (size_t)D * D * 2);
constexpr size_t WS_WD2 = al(WS_WGU2 + (size_t)2 * DFF * D * 2);
constexpr size_t WS_XB = al(WS_WD2 + (size_t)D * DFF * 2);
constexpr size_t WS_SS0 = al(WS_XB + (size_t)MPAD * D * 2);
constexpr size_t WS_SS1 = al(WS_SS0 + (size_t)MPAD * 4);
constexpr size_t WS_SS2 = al(WS_SS1 + (size_t)MPAD * 64);
constexpr size_t WS_H = al(WS_SS2 + (size_t)MPAD * 64);
constexpr size_t WS_X1 = al(WS_H + (size_t)MPAD * DFF * 2);
constexpr size_t WS_X1B = al(WS_X1 + (size_t)MPAD * D * 4);
constexpr size_t WS_X2 = al(WS_X1B + (size_t)MPAD * D * 2);
constexpr size_t WS_X2B = al(WS_X2 + (size_t)MPAD * D * 4);
constexpr size_t WS_U = al(WS_X2B + (size_t)MPAD * D * 2);
constexpr size_t WS_GB = al(WS_U + (size_t)MPAD * 512 * 2);
constexpr size_t WS_Q = al(WS_GB + (size_t)MPAD * 512 * 2);
constexpr size_t WS_QI = al(WS_Q + (size_t)MPAD * 512 * 2);
constexpr size_t WS_KB = al(WS_QI + (size_t)MPAD * 512 * 2);
constexpr size_t WS_VB = al(WS_KB + (size_t)MPAD * 128 * 2);
constexpr size_t WS_KIB = al(WS_VB + (size_t)MPAD * 128 * 2);
constexpr size_t WS_WI = al(WS_KIB + (size_t)MPAD * 64 * 2);
constexpr size_t WS_CAT = al(WS_WI + (size_t)MPAD * 8 * 4);
constexpr size_t WS_MASK = al(WS_CAT + (size_t)MPAD * D * 2);
constexpr int SSTR = 16384;
constexpr size_t WS_SSC = al(WS_MASK + (size_t)NB * 32 * SEQ * 8);
constexpr size_t WS_XB8 = al(WS_SSC + (size_t)MS * SSTR * 4);
constexpr size_t WS_X2B8 = al(WS_XB8 + (size_t)MPAD * D);
constexpr size_t WS_WGU1_8 = al(WS_X2B8 + (size_t)MPAD * D);
constexpr size_t WS_WGU2_8 = al(WS_WGU1_8 + (size_t)2 * DFF * D);
constexpr size_t WS_WD2_8 = al(WS_WGU2_8 + (size_t)2 * DFF * D);
constexpr size_t WS_H8 = al(WS_WD2_8 + (size_t)D * DFF);
constexpr size_t WS_XI8 = al(WS_H8 + (size_t)MPAD * DFF);
constexpr size_t WS_XS = al(WS_XI8 + (size_t)MPAD * D);
constexpr size_t WS_WGU1I8 = al(WS_XS + (size_t)MPAD * 4);
constexpr size_t WS_WSN = al(WS_WGU1I8 + (size_t)2 * DFF * D);
constexpr size_t WS_X2I8 = al(WS_WSN + (size_t)2 * DFF * 4);
constexpr size_t WS_XS2 = al(WS_X2I8 + (size_t)MPAD * D);
constexpr size_t WS_WGU2I8 = al(WS_XS2 + (size_t)MPAD * 4);
constexpr size_t WS_WSN2 = al(WS_WGU2I8 + (size_t)2 * DFF * D);
constexpr size_t WS_WD1_8 = al(WS_WSN2 + (size_t)2 * DFF * 4);
constexpr size_t WS_END = al(WS_WD1_8 + (size_t)D * DFF);
constexpr float H8SCALE = 4.0f;
constexpr float W8SCALE = 32.0f;

constexpr int CW_TMO = 0, CW_CODE = 1, CW_BAR = 4096;

constexpr int RING_OFF = 0, RING_BYTES = 152576;
constexpr int LDSCTL_OFF = RING_BYTES, MISC_OFF = LDSCTL_OFF + 320;
constexpr int LDS_BYTES = 158720;
static_assert(MISC_OFF + 128 <= LDS_BYTES && attn_body::ATTN_LDS_BYTES <= RING_BYTES && pg8::STAGE_BYTES <= RING_BYTES, "LDS map");

#define GAS __attribute__((address_space(1)))
#define LAS __attribute__((address_space(3)))
typedef unsigned short bf16;
typedef unsigned v4u __attribute__((ext_vector_type(4)));
typedef unsigned v2u __attribute__((ext_vector_type(2)));
typedef float f32x4 __attribute__((ext_vector_type(4)));
typedef float f32x16 __attribute__((ext_vector_type(16)));
typedef short bf16x8 __attribute__((ext_vector_type(8)));
typedef GAS unsigned gu32;
#define RLX_AGENT __ATOMIC_RELAXED, __HIP_MEMORY_SCOPE_AGENT
#define LDS_WAIT() asm volatile("s_waitcnt lgkmcnt(0)" ::: "memory")
#define VM_WAIT() asm volatile("s_waitcnt vmcnt(0)" ::: "memory")
__device__ __forceinline__ unsigned f2bf(float f) { unsigned u = __builtin_bit_cast(unsigned, f); return (u + 0x7fffu + ((u >> 16) & 1u)) >> 16; }
__device__ __forceinline__ unsigned pk2(float lo, float hi) { return f2bf(lo) | (f2bf(hi) << 16); }
__device__ __forceinline__ float bf2f(unsigned short h) { return __builtin_bit_cast(float, (unsigned)h << 16); }
__device__ __forceinline__ float wave_sum(float v) {
#pragma unroll
    for (int o = 1; o < 64; o <<= 1) v += __shfl_xor(v, o);
    return v;
}
__device__ __forceinline__ float wave_max(float v) {
#pragma unroll
    for (int o = 1; o < 64; o <<= 1) v = fmaxf(v, __shfl_xor(v, o));
    return v;
}

#define XB_TMO      128
#define XB_XCNT(j)  (256  + 64 * (j))
#define XB_XSUB(j)  (1280 + 64 * (j))
#define XB_XGEN(j)  (2304 + 64 * (j))
#define XB_TOP      3328
#define XB_TOPGEN   3392
#define XCD_BAR_WORDS 3456
#define XB_SPIN_CAP (1u << 18)

__device__ __forceinline__ unsigned xb_ld(unsigned* p)              { return __hip_atomic_load(p, __ATOMIC_RELAXED, __HIP_MEMORY_SCOPE_AGENT); }
__device__ __forceinline__ unsigned xb_add(unsigned* p, unsigned v) { return __hip_atomic_fetch_add(p, v, __ATOMIC_RELAXED, __HIP_MEMORY_SCOPE_AGENT); }
__device__ __forceinline__ unsigned xb_xcc_id() { return (unsigned)__builtin_amdgcn_s_getreg((3 << 11) | 20) & 0xFu; }
#define XB_SPIN(cond, bar) do { unsigned _sp = 0; while (cond) { __builtin_amdgcn_s_sleep(1); \
    if ((++_sp & 255u) == 0u) { if (xb_ld(&(bar)[XB_TMO])) break; if (_sp > XB_SPIN_CAP) { atomicAdd(&(bar)[XB_TMO], 1u); break; } } } } while (0)

struct XcdBarrier {
    unsigned* bar; unsigned x;
    volatile LAS unsigned* st;
};

__device__ __forceinline__ XcdBarrier xcd_barrier_post(unsigned* bar, volatile LAS unsigned* st) {
    XcdBarrier b; b.bar = bar; b.x = xb_xcc_id(); b.st = st;
    if (threadIdx.x == 0) (void)xb_add(&bar[XB_XCNT(b.x)], 1u);
    return b;
}
__device__ __forceinline__ void xcd_barrier_complete(unsigned* bar, unsigned x, unsigned& nloc, unsigned& nx) {
    const unsigned G = gridDim.x * gridDim.y * gridDim.z;
    unsigned sum, cnt, mine, sp = 0u;
    for (;;) {
        sum = 0u; cnt = 0u; mine = 0u;
#pragma unroll
        for (unsigned j = 0; j < 16; ++j) { const unsigned c = xb_ld(&bar[XB_XCNT(j)]); sum += c; cnt += (c > 0u) ? 1u : 0u; mine = (j == x) ? c : mine; }
        if (sum == G) break;
        __builtin_amdgcn_s_sleep(1);
        if ((++sp & 255u) == 0u) { if (xb_ld(&bar[XB_TMO])) break; if (sp > XB_SPIN_CAP) { atomicAdd(&bar[XB_TMO], 1u); break; } }
    }
    nloc = mine > 0u ? mine : 1u; nx = cnt > 0u ? cnt : 1u;
}

__device__ __forceinline__ void xcd_barrier(const XcdBarrier& b) {
    asm volatile("s_waitcnt vmcnt(0)" ::: "memory");
    __syncthreads();
    if (threadIdx.x == 0) {
        unsigned* bar = b.bar;
        __builtin_amdgcn_s_waitcnt(0);
        unsigned nloc = b.st[0], nx = b.st[1];
        if (nloc == 0u) { xcd_barrier_complete(bar, b.x, nloc, nx); b.st[0] = nloc; b.st[1] = nx; }
        const unsigned old = xb_add(&bar[XB_XSUB(b.x)], 1u);
        const unsigned gen = old / nloc;
        if (old + 1u == (gen + 1u) * nloc) {
            __builtin_amdgcn_fence(__ATOMIC_RELEASE, "agent");
            asm volatile("s_waitcnt vmcnt(0)" ::: "memory");
            const unsigned og = xb_add(&bar[XB_TOP], 1u);
            const unsigned tg = og / nx;
            if (og + 1u == (tg + 1u) * nx) xb_add(&bar[XB_TOPGEN], 1u);
            else XB_SPIN(xb_ld(&bar[XB_TOPGEN]) == tg, bar);
            __builtin_amdgcn_fence(__ATOMIC_ACQUIRE, "agent");
            xb_add(&bar[XB_XGEN(b.x)], 1u);
            asm volatile("s_waitcnt vmcnt(0)" ::: "memory");
        } else {
            XB_SPIN(xb_ld(&bar[XB_TOPGEN]) == gen, bar);
            __builtin_amdgcn_fence(__ATOMIC_ACQUIRE, "agent");
            asm volatile("s_waitcnt vmcnt(0)" ::: "memory");
        }
    }
    __syncthreads();
}
__host__ __device__ __forceinline__ int r32map(int P) { return 16 * ((P >> 2) & 1) + 4 * (P >> 3) + (P & 3); }
__host__ __device__ __forceinline__ int p128(int x) { return (x & ~31) + r32map(x & 31); }
__host__ __device__ __forceinline__ int hdmap(int d) { if (d >= 16) return d; const int fq = (d >> 2) & 1, j = (d & 3) + 4 * (d >> 3); return 8 * fq + j; }
__host__ __device__ __forceinline__ int head_row(int wc, int d) { const int x = hdmap(d); return 128 * (x >> 5) + 32 * wc + r32map(x & 31); }
__device__ __forceinline__ int dstart(int bj, int fq, int half) { return (bj == 0 && fq < 2) ? 4 * fq + 8 * half : 32 * bj + 8 * fq + 4 * half; }

struct MapGate { __device__ __forceinline__ int operator()(int c) const { return 256 * (c >> 7) + p128(c & 127); } };
struct MapUp   { __device__ __forceinline__ int operator()(int c) const { return 256 * (c >> 7) + 128 + p128(c & 127); } };
struct MapLin  { __device__ __forceinline__ int operator()(int c) const { return (c & ~127) + p128(c & 127); } };
struct MapWin  { __device__ __forceinline__ int operator()(int c) const {
    if (c < 512) return 1024 + (c & ~127) + p128(c & 127);
    if (c < 1024) { const int ch = c - 512; return 256 * (ch >> 7) + p128(ch & 127); }
    if (c < 1536) { const int ch = c - 1024; return 256 * (ch >> 7) + 128 + p128(ch & 127); }
    if (c < 2048) { const int x = c - 1536, hd = x >> 6; return 256 * (6 + (hd >> 2)) + head_row(hd & 3, x & 63); }
    if (c < 2176) { const int x = c - 2048; return 256 * 8 + head_row(x >> 6, x & 63); }
    if (c < 2304) { const int x = c - 2176; return 256 * 8 + head_row(2 + (x >> 6), x & 63); }
    if (c < 2816) { const int x = c - 2304, hd = x >> 6; return 256 * (9 + (hd >> 2)) + head_row(hd & 3, x & 63); }
    if (c < 2880) return 256 * 11 + head_row(0, c - 2816);
    return 256 * 11 + 32 + r32map(c - 2880);
} };

using pg8::Unit; using pg8::bf16_t;
__device__ __forceinline__ float rstd_from(const float* ss, int row, int nslot) {
    float s = 0.f;
    if (nslot == 1) s = ss[row];
    else { const f32x4* p = (const f32x4*)(ss + (size_t)row * 16); const f32x4 a = p[0], b = p[1], c = p[2], d = p[3]; s = ((a.x + a.y) + (a.z + a.w)) + ((b.x + b.y) + (b.z + b.w)) + ((c.x + c.y) + (c.z + c.w)) + ((d.x + d.y) + (d.z + d.w)); }
    return __builtin_amdgcn_rsqf(s * (1.0f / D) + EPS);
}
__device__ __forceinline__ float clamp8(float x) { return __builtin_amdgcn_fmed3f(x, -440.0f, 440.0f); }
__device__ __forceinline__ unsigned pk4_fp8(float a, float b, float c, float d) { int w = __builtin_amdgcn_cvt_pk_fp8_f32(clamp8(a), clamp8(b), 0, false); w = __builtin_amdgcn_cvt_pk_fp8_f32(clamp8(c), clamp8(d), w, true); return (unsigned)w; }
#define EPI_CALL_ROWS() \
    __device__ __forceinline__ void operator()(f32x4 (&acc)[2][2][4][2], const Unit& u, int wr, int wc, int fr, int fq, int ui, bool has_next, const Unit& nxt) const { \
        _Pragma("unroll") for (int ai = 0; ai < 2; ++ai) _Pragma("unroll") for (int m = 0; m < 4; ++m) { \
            const f32x4 v[2][2] = {{acc[ai][0][m][0], acc[ai][0][m][1]}, {acc[ai][1][m][0], acc[ai][1][m][1]}}; \
            row(v, u.pm * 256 + ai * 128 + wr * 64 + m * 16 + fr, u.pn, wc, fr, fq, ui); \
            if (has_next) init_rg(acc, nxt, ai, m, wr, wc, fr, fq); } }                        \
    __device__ __forceinline__ void init(f32x4 (&acc)[2][2][4][2], const Unit& u, int wr, int wc, int fr, int fq) const { \
        _Pragma("unroll") for (int ai = 0; ai < 2; ++ai) _Pragma("unroll") for (int m = 0; m < 4; ++m) init_rg(acc, u, ai, m, wr, wc, fr, fq); }
#define EPI_ZERO_INIT() \
    __device__ __forceinline__ void init_rg(f32x4 (&acc)[2][2][4][2], const Unit&, int ai, int m, int, int, int, int) const { \
        _Pragma("unroll") for (int b = 0; b < 2; ++b) _Pragma("unroll") for (int n = 0; n < 2; ++n) acc[ai][b][m][n] = (f32x4){0.f, 0.f, 0.f, 0.f}; }
__device__ __forceinline__ float rstd_of(const LAS float* tab, const float* ss, int nslot, int row, int ui) { return (ui >= 0 && tab) ? tab[ui * 256 + (row & 255)] : rstd_from(ss, row, nslot); }
struct EpiGU {
    static constexpr bool PERM = false, AFTER_DRAIN = false;
    bf16_t* H; const float* ss; int nslot; const LAS float* tab; float wscale; unsigned char* H8; const float* wsn;
    __device__ __forceinline__ void row(const f32x4 (&v)[2][2], int row, int pn, int wc, int fr, int fq, int ui) const {
        typedef float f32x2 __attribute__((ext_vector_type(2)));
        const int col0 = pn * 128 + wc * 32 + 8 * fq;
        const float rs = rstd_of(tab, ss, nslot, row, ui) * (ui >= 0 ? wscale : 1.0f);
        const float c1 = -rs * LOG2E, rs2 = rs * rs;
        const bool f8 = H8 != nullptr;
        const float rs2s = f8 ? rs2 * H8SCALE : rs2;
        f32x2 hh[4];
#pragma unroll
        for (int n = 0; n < 2; ++n)
#pragma unroll
            for (int i = 0; i < 4; i += 2) { const f32x2 ag = {v[0][n][i], v[0][n][i + 1]}, au = {v[1][n][i], v[1][n][i + 1]};
                const f32x2 a = ag * c1; f32x2 e; e.x = __builtin_amdgcn_exp2f(a.x); e.y = __builtin_amdgcn_exp2f(a.y);
                const f32x2 d = e + 1.0f; f32x2 r; r.x = __builtin_amdgcn_rcpf(d.x); r.y = __builtin_amdgcn_rcpf(d.y);
                hh[2 * n + (i >> 1)] = (ag * au) * (r * rs2s); }
        if (f8) { v2u w8; w8.x = pk4_fp8(hh[0].x, hh[0].y, hh[1].x, hh[1].y); w8.y = pk4_fp8(hh[2].x, hh[2].y, hh[3].x, hh[3].y);
            *(v2u*)(H8 + (size_t)row * DFF + col0) = w8; }
        else { v4u w; w.x = pg8::cvt_pk_bf16(hh[0].x, hh[0].y); w.y = pg8::cvt_pk_bf16(hh[1].x, hh[1].y); w.z = pg8::cvt_pk_bf16(hh[2].x, hh[2].y); w.w = pg8::cvt_pk_bf16(hh[3].x, hh[3].y);
        __builtin_nontemporal_store(w, (v4u*)(H + (size_t)row * DFF + col0)); }
    }
    __device__ __forceinline__ void operator()(f32x4 (&acc)[2][2][4][2], const Unit& u, int wr, int wc, int fr, int fq, int ui, bool has_next, const Unit& nxt) const {
        typedef int v4i_ __attribute__((ext_vector_type(4)));
        f32x4 cs[2][2];
#pragma unroll
        for (int bj = 0; bj < 2; ++bj)
#pragma unroll
            for (int n = 0; n < 2; ++n) cs[bj][n] = wsn ? *(const f32x4*)(wsn + u.pn * 256 + bj * 128 + wc * 32 + n * 16 + 4 * fq) : (f32x4){1.f, 1.f, 1.f, 1.f};
#pragma unroll
        for (int ai = 0; ai < 2; ++ai)
#pragma unroll
            for (int m = 0; m < 4; ++m) {
                f32x4 v[2][2];
#pragma unroll
                for (int bj = 0; bj < 2; ++bj)
#pragma unroll
                    for (int n = 0; n < 2; ++n) v[bj][n] = wsn ? __builtin_convertvector(__builtin_bit_cast(v4i_, acc[ai][bj][m][n]), f32x4) * cs[bj][n] : acc[ai][bj][m][n];
                row(v, u.pm * 256 + ai * 128 + wr * 64 + m * 16 + fr, u.pn, wc, fr, fq, ui);
                if (has_next) init_rg(acc, nxt, ai, m, wr, wc, fr, fq); }
    }
    __device__ __forceinline__ void init(f32x4 (&acc)[2][2][4][2], const Unit& u, int wr, int wc, int fr, int fq) const {
#pragma unroll
        for (int ai = 0; ai < 2; ++ai)
#pragma unroll
            for (int m = 0; m < 4; ++m) init_rg(acc, u, ai, m, wr, wc, fr, fq); }
    EPI_ZERO_INIT()
};
__device__ __forceinline__ void bf8_to_f32(const v4u w, f32x4& lo, f32x4& hi) {
    lo = (f32x4){__uint_as_float(w.x << 16), __uint_as_float(w.x & 0xffff0000u), __uint_as_float(w.y << 16), __uint_as_float(w.y & 0xffff0000u)};
    hi = (f32x4){__uint_as_float(w.z << 16), __uint_as_float(w.z & 0xffff0000u), __uint_as_float(w.w << 16), __uint_as_float(w.w & 0xffff0000u)};
}
template <int MODE> struct EpiRes {
    static constexpr bool PERM = false, AFTER_DRAIN = false;
    const bf16_t* resb; float* out; bf16_t* outb; float* ss; unsigned char* out8; float ascale; const float* resf = nullptr; const float* resfs = nullptr;
    __device__ __forceinline__ void row(const f32x4 (&v)[2][2], int row, int pn, int wc, int fr, int fq, int ui) const {
        const bool pre = ui >= 0;
        const float alpha = ((MODE == 1) ? 1.0f : 0.5f) * (pre ? ascale : 1.0f);
        const bool live = row < MTOT;
        float sq = 0.f;
#pragma unroll
        for (int bj = 0; bj < 2; ++bj) {
            const int col = pn * 256 + bj * 128 + wc * 32 + 8 * fq;
            f32x4 r0 = (f32x4){0.f, 0.f, 0.f, 0.f}, r1 = r0;
            if (!pre && live) { if constexpr (MODE == 0) { r0 = *(const f32x4*)(resfs + (size_t)(row - MP) * D + col); r1 = *(const f32x4*)(resfs + (size_t)(row - MP) * D + col + 4); } else bf8_to_f32(*(const v4u*)(resb + (size_t)row * D + col), r0, r1); }
            const f32x4 v0 = r0 + alpha * v[bj][0], v1 = r1 + alpha * v[bj][1];
            if (MODE == 2) { if (live) { __builtin_nontemporal_store(v0, (f32x4*)(out + (size_t)row * D + col)); __builtin_nontemporal_store(v1, (f32x4*)(out + (size_t)row * D + col + 4)); } }
            else {
                v4u w; w.x = pg8::cvt_pk_bf16(v0[0], v0[1]); w.y = pg8::cvt_pk_bf16(v0[2], v0[3]); w.z = pg8::cvt_pk_bf16(v1[0], v1[1]); w.w = pg8::cvt_pk_bf16(v1[2], v1[3]);
                *(v4u*)(outb + (size_t)row * D + col) = w;
                if (MODE == 1 && out8) { v2u w8; w8.x = pk4_fp8(v0[0], v0[1], v0[2], v0[3]); w8.y = pk4_fp8(v1[0], v1[1], v1[2], v1[3]); *(v2u*)(out8 + (size_t)row * D + col) = w8; }
                sq += (v0[0] * v0[0] + v0[1] * v0[1]) + (v0[2] * v0[2] + v0[3] * v0[3]) + (v1[0] * v1[0] + v1[1] * v1[1]) + (v1[2] * v1[2] + v1[3] * v1[3]);
            }
        }
        if (MODE != 2) { sq += __shfl_xor(sq, 16); sq += __shfl_xor(sq, 32); if (fq == 0) ss[(size_t)row * 16 + pn * 4 + wc] = sq; }
    }
    EPI_CALL_ROWS()
    __device__ __forceinline__ void init_rg(f32x4 (&acc)[2][2][4][2], const Unit& u, int ai, int m, int wr, int wc, int fr, int fq) const {
        const float ia = ((MODE == 1) ? 1.0f : 2.0f) / ascale;
        const size_t ro = (size_t)(u.pm * 256 + ai * 128 + wr * 64 + m * 16 + fr) * D + u.pn * 256 + wc * 32 + 8 * fq;
#pragma unroll
        for (int bj = 0; bj < 2; ++bj) { f32x4 lo, hi;
            if constexpr (MODE == 0) { lo = *(const f32x4*)(resf + ro + bj * 128); hi = *(const f32x4*)(resf + ro + bj * 128 + 4); } else bf8_to_f32(*(const v4u*)(resb + ro + bj * 128), lo, hi);
            acc[ai][bj][m][0] = lo * ia; acc[ai][bj][m][1] = hi * ia; }
    }
};
struct EpiWin {
    static constexpr bool PERM = false, AFTER_DRAIN = false;
    unsigned char* ws; float* out; const float* qn; const float* kn; const LAS float* tab;
    __device__ __forceinline__ void row(const f32x4 (&acc)[2][2], int row, int pn, int wc, int fr, int fq, int ui) const {
        const float* ss = (const float*)(ws + WS_SS1); bf16_t* U = (bf16_t*)(ws + WS_U); bf16_t* GB = (bf16_t*)(ws + WS_GB); float* WI = (float*)(ws + WS_WI); const float* rope = (const float*)(ws + WS_ROPE);
        if (pn == 11 && wc >= 2) return;
        const int type = pn < 4 ? 0 : pn < 6 ? 1 : pn < 8 ? 2 : pn == 8 ? (wc < 2 ? 3 : 4) : pn < 11 ? 5 : (wc == 0 ? 6 : 7);
        const int head = (type == 2) ? 4 * (pn - 6) + wc : (type == 5) ? 4 * (pn - 9) + wc : (type == 3) ? wc : (type == 4) ? wc - 2 : 0;
        const bool live = row < MTOT;
        const float rs = rstd_of(tab, ss, 16, row, ui);
        if (type == 0) {
            const int ch0 = pn * 128 + wc * 32 + 8 * fq;
            const f32x4 u0 = (acc[0][0] * rs) * (acc[1][0] * rs), u1 = (acc[0][1] * rs) * (acc[1][1] * rs);
            v4u w; w.x = pg8::cvt_pk_bf16(u0[0], u0[1]); w.y = pg8::cvt_pk_bf16(u0[2], u0[3]); w.z = pg8::cvt_pk_bf16(u1[0], u1[1]); w.w = pg8::cvt_pk_bf16(u1[2], u1[3]);
            *(v4u*)(U + (size_t)row * 512 + ch0) = w;
            if (row < MP) { const int s = row & (SEQ - 1); if (s >= SEQ - 2) { float* o = out + O_CP + ((size_t)(row >> 11) * 2 + (s - (SEQ - 2))) * 512 + ch0; *(f32x4*)o = u0; *(f32x4*)(o + 4) = u1; } }
            else if (live) { const int sr = row - MP, s = sr & 3; if (s >= 2) { float* o = out + O_CS + ((size_t)(sr >> 2) * 2 + (s - 2)) * 512 + ch0; *(f32x4*)o = u0; *(f32x4*)(o + 4) = u1; } }
        } else if (type == 1) {
#pragma unroll
            for (int bj = 0; bj < 2; ++bj) { const int col = (pn - 4) * 256 + bj * 128 + wc * 32 + 8 * fq; const f32x4 a = acc[bj][0] * rs, b = acc[bj][1] * rs;
                v4u w; w.x = pg8::cvt_pk_bf16(a[0], a[1]); w.y = pg8::cvt_pk_bf16(a[2], a[3]); w.z = pg8::cvt_pk_bf16(b[0], b[1]); w.w = pg8::cvt_pk_bf16(b[2], b[3]);
                *(v4u*)(GB + (size_t)row * 512 + col) = w; }
        } else if (type == 7) {
            if (fq == 0) { *(f32x4*)(WI + (size_t)row * 8) = acc[0][0] * rs; *(f32x4*)(WI + (size_t)row * 8 + 4) = acc[0][1] * rs; }
        } else {
            f32x4 v[2][2];
#pragma unroll
            for (int bj = 0; bj < 2; ++bj) { v[bj][0] = acc[bj][0] * rs; v[bj][1] = acc[bj][1] * rs; }
            if (type == 2 || type == 3) {
                float sq = 0.f;
#pragma unroll
                for (int bj = 0; bj < 2; ++bj)
#pragma unroll
                    for (int h2 = 0; h2 < 2; ++h2) sq += (v[bj][h2][0] * v[bj][h2][0] + v[bj][h2][1] * v[bj][h2][1]) + (v[bj][h2][2] * v[bj][h2][2] + v[bj][h2][3] * v[bj][h2][3]);
                sq += __shfl_xor(sq, 16); sq += __shfl_xor(sq, 32);
                const float sc = __builtin_amdgcn_rsqf(sq * (1.0f / 64.0f) + EPS);
#pragma unroll
                for (int bj = 0; bj < 2; ++bj)
#pragma unroll
                    for (int h2 = 0; h2 < 2; ++h2) { const f32x4 gq = *(const f32x4*)(qn + dstart(bj, fq, h2)), gk = *(const f32x4*)(kn + dstart(bj, fq, h2)); v[bj][h2] = v[bj][h2] * sc * ((type == 2) ? gq : gk); }
            }
            if (type != 4 && fq < 2) {
                const int pidx = row < MP ? (row & (SEQ - 1)) : (live ? SEQ + ((row - MP) & 3) : 0);
                const float* rp = rope + ((size_t)pidx * 8 + 4 * fq) * 2;
                const f32x4 cs0 = *(const f32x4*)rp, cs1 = *(const f32x4*)(rp + 4);
                const f32x4 x1 = v[0][0], x2 = v[0][1];
                const f32x4 c = (f32x4){cs0[0], cs0[2], cs1[0], cs1[2]}, s = (f32x4){cs0[1], cs0[3], cs1[1], cs1[3]};
                v[0][0] = x1 * c - x2 * s; v[0][1] = x2 * c + x1 * s;
            }
            const size_t boff = (type == 2) ? WS_Q : (type == 3) ? WS_KB : (type == 4) ? WS_VB : (type == 5) ? WS_QI : WS_KIB;
            const int bp = (type == 2 || type == 5) ? 512 : (type == 6) ? 64 : 128; const float bsc = (type == 2) ? QSCALE : 1.0f;
            bf16_t* bdst = (bf16_t*)(ws + boff);
            const bool hasf = live && (type == 3 || type == 4 || type == 6);
            const size_t fbase = (type == 3) ? (row < MP ? O_KP : O_KS) : (type == 4) ? (row < MP ? O_VP : O_VS) : (row < MP ? O_IP : O_IS);
            float* fdst = out + fbase + (size_t)(row < MP ? row : row - MP) * (type == 6 ? 64 : 128);
#pragma unroll
            for (int bj = 0; bj < 2; ++bj)
#pragma unroll
                for (int h2 = 0; h2 < 2; ++h2) { const int d = head * 64 + dstart(bj, fq, h2); const f32x4 x = v[bj][h2];
                    if (hasf) { if (row < MP) __builtin_nontemporal_store(x, (f32x4*)(fdst + d)); else *(f32x4*)(fdst + d) = x; }
                    v2u w; w.x = pg8::cvt_pk_bf16(x[0] * bsc, x[1] * bsc); w.y = pg8::cvt_pk_bf16(x[2] * bsc, x[3] * bsc);
                    *(v2u*)(bdst + (size_t)row * bp + d) = w; }
        }
    }
    EPI_CALL_ROWS()
    EPI_ZERO_INIT()
};
template <class Epi, int MT, int QM> __device__ __forceinline__ void skinny_unit(PG8_LAS unsigned char* lds, const unsigned char* A, const unsigned char* Bt, int KB, int pn, int wc, int rg, const Epi& E,
                                                                                const float* xs, const float* wsn, float oscale) {
    typedef int v4i_ __attribute__((ext_vector_type(4)));
    const int tid = threadIdx.x, wid = __builtin_amdgcn_readfirstlane(tid >> 6), lane = tid & 63, fr = lane & 15, fq = lane >> 4;
    const int TP = KB >> 7, base = TP >> 3, rem = TP & 7;
    const int np = base + (wid < rem ? 1 : 0), p0 = wid * base + (wid < rem ? wid : rem);
    const unsigned char* ap = A + (size_t)(MP + 16 * MT * rg + fr) * KB + p0 * 128 + 16 * fq;
    const unsigned char* bp = Bt + (size_t)(256 * pn + 32 * wc + fr) * KB + p0 * 128 + 16 * fq;
    pg8::f32x4 acc[MT][2][2];
#pragma unroll
    for (int mt = 0; mt < MT; ++mt)
#pragma unroll
        for (int bj = 0; bj < 2; ++bj)
#pragma unroll
            for (int n = 0; n < 2; ++n) acc[mt][bj][n] = (pg8::f32x4){0.f, 0.f, 0.f, 0.f};
    v4i_ a0[MT], b0[2][2], a1[MT], b1[2][2], a2[MT], b2[2][2], a3[MT], b3[2][2];
#define SK_LOADP(afe, bfe, afo, bfo, p_) do { \
        _Pragma("unroll") for (int mt = 0; mt < MT; ++mt) { afe[mt] = *(const v4i_*)(ap + (size_t)(16 * mt) * KB + 128 * (p_)); afo[mt] = *(const v4i_*)(ap + (size_t)(16 * mt) * KB + 128 * (p_) + 64); } \
        _Pragma("unroll") for (int bj = 0; bj < 2; ++bj) _Pragma("unroll") for (int n = 0; n < 2; ++n) { bfe[bj][n] = *(const v4i_*)(bp + (size_t)(128 * bj + 16 * n) * KB + 128 * (p_)); bfo[bj][n] = *(const v4i_*)(bp + (size_t)(128 * bj + 16 * n) * KB + 128 * (p_) + 64); } } while (0)
#define SK_MMA(af, bf) do { _Pragma("unroll") for (int mt = 0; mt < MT; ++mt) _Pragma("unroll") for (int bj = 0; bj < 2; ++bj) _Pragma("unroll") for (int n = 0; n < 2; ++n) { \
        if constexpr (QM == 0) acc[mt][bj][n] = __builtin_amdgcn_mfma_f32_16x16x32_bf16(__builtin_bit_cast(pg8::bf16x8, bf[bj][n]), __builtin_bit_cast(pg8::bf16x8, af[mt]), acc[mt][bj][n], 0, 0, 0); \
        else if constexpr (QM == 2) acc[mt][bj][n] = __builtin_bit_cast(pg8::f32x4, __builtin_amdgcn_mfma_i32_16x16x64_i8(bf[bj][n], af[mt], __builtin_bit_cast(v4i_, acc[mt][bj][n]), 0, 0, 0)); \
        else { typedef long l2_ __attribute__((ext_vector_type(2))); const l2_ bl_ = __builtin_bit_cast(l2_, bf[bj][n]), al_ = __builtin_bit_cast(l2_, af[mt]); \
            acc[mt][bj][n] = __builtin_amdgcn_mfma_f32_16x16x32_fp8_fp8(bl_[0], al_[0], acc[mt][bj][n], 0, 0, 0); acc[mt][bj][n] = __builtin_amdgcn_mfma_f32_16x16x32_fp8_fp8(bl_[1], al_[1], acc[mt][bj][n], 0, 0, 0); } } } while (0)
    SK_LOADP(a0, b0, a1, b1, 0); if (np > 1) SK_LOADP(a2, b2, a3, b3, 1);
    for (int p = 0; p < np; p += 2) {
        SK_MMA(a0, b0); SK_MMA(a1, b1);
        if (p + 2 < np) SK_LOADP(a0, b0, a1, b1, p + 2);
        if (p + 1 < np) { SK_MMA(a2, b2); SK_MMA(a3, b3);
            if (p + 3 < np) SK_LOADP(a2, b2, a3, b3, p + 3); }
    }
#undef SK_LOADP
#undef SK_MMA
    PG8_LAS pg8::f32x4* slab = (PG8_LAS pg8::f32x4*)lds;
#pragma unroll
    for (int mt = 0; mt < MT; ++mt)
#pragma unroll
        for (int bj = 0; bj < 2; ++bj)
#pragma unroll
            for (int n = 0; n < 2; ++n) { pg8::f32x4 t = acc[mt][bj][n];
                if constexpr (QM == 2) { const v4i_ ti = __builtin_bit_cast(v4i_, t); t = (pg8::f32x4){(float)ti[0], (float)ti[1], (float)ti[2], (float)ti[3]}; }
                slab[((wid * MT + mt) * 4 + bj * 2 + n) * 64 + lane] = t; }
    __syncthreads();
    if (wid < MT) { pg8::f32x4 v[2][2]; const int row = MP + 16 * MT * rg + 16 * wid + fr;
      float rsc = oscale; if constexpr (QM == 2) rsc = xs[row];
#pragma unroll
      for (int bj = 0; bj < 2; ++bj)
#pragma unroll
          for (int n = 0; n < 2; ++n) { const int o = (wid * 4 + bj * 2 + n) * 64 + lane; pg8::f32x4 t = slab[o];
#pragma unroll
              for (int q = 1; q < 8; ++q) t = t + slab[o + q * MT * 4 * 64];
              if constexpr (QM == 2) t = t * (*(const pg8::f32x4*)(wsn + 256 * pn + 128 * bj + 32 * wc + 16 * n + 4 * fq)) * rsc;
              else if constexpr (QM == 1) t = t * rsc;
              v[bj][n] = t; }
      E.row(v, row, pn, wc, fr, fq, -1); }
    __syncthreads();
}
template <class Epi, int MT, int QM> __device__ __forceinline__ void skinny_phase(PG8_LAS unsigned char* lds, const void* A, const void* Bt, int N, int KB, int blk, int G, const Epi& E,
                                                                                 const float* xs = nullptr, const float* wsn = nullptr, float oscale = 1.0f) {
    constexpr int NRG = 8 / MT; const int nu = (N / 256) * 4 * NRG;
    for (int u = blk; u < nu; u += G) skinny_unit<Epi, MT, QM>(lds, (const unsigned char*)A, (const unsigned char*)Bt, KB, u / (4 * NRG), (u / NRG) & 3, u % NRG, E, xs, wsn, oscale);
}
__device__ __forceinline__ void fill_rstd_table(LAS float* tab, const pg8::StaticOrder& S, const float* ss, int nslot, const float* xs = nullptr) {
    const int tid = threadIdx.x; Unit u; int nu = 0;
    while (nu < 11 && S.next(nu, u)) ++nu;
    float sv[6], xsv[6]; int ix[6];
#pragma unroll
    for (int k2 = 0; k2 < 6; ++k2) { const int idx = tid + 512 * k2; ix[k2] = idx; const bool ok = idx < nu * 256; Unit uu_; S.next(ok ? (idx >> 8) : 0, uu_); const int row = uu_.pm * 256 + (idx & 255);
        float s_ = 0.f;
        if (nslot == 1) s_ = ss[row];
        else { const f32x4* p = (const f32x4*)(ss + (size_t)row * 16); const f32x4 a = p[0], b = p[1], c = p[2], d = p[3]; s_ = ((a.x + a.y) + (a.z + a.w)) + ((b.x + b.y) + (b.z + b.w)) + ((c.x + c.y) + (c.z + c.w)) + ((d.x + d.y) + (d.z + d.w)); }
        sv[k2] = s_; xsv[k2] = xs ? xs[row] : 1.0f; }
#pragma unroll
    for (int k2 = 0; k2 < 6; ++k2) if (ix[k2] < nu * 256) tab[ix[k2]] = __builtin_amdgcn_rsqf(sv[k2] * (1.0f / D) + EPS) * xsv[k2];
    __syncthreads();
}
__device__ __forceinline__ void quant_rows_pass(int gw, int NGW, const bf16_t* X, unsigned char* Q, float* XS, int nrows) {
    const int lane = threadIdx.x & 63;
    for (int g8 = gw; g8 < nrows / 8; g8 += NGW) {
        const int m0 = 8 * g8; v4u a[8][2];
#pragma unroll
        for (int r = 0; r < 8; ++r) { a[r][0] = *(const v4u*)(X + (size_t)(m0 + r) * D + 8 * lane); a[r][1] = *(const v4u*)(X + (size_t)(m0 + r) * D + 512 + 8 * lane); }
#pragma unroll
        for (int r = 0; r < 8; ++r) {
            float x[16];
#pragma unroll
            for (int e = 0; e < 4; ++e) { x[2 * e] = __uint_as_float(a[r][0][e] << 16); x[2 * e + 1] = __uint_as_float(a[r][0][e] & 0xffff0000u); x[8 + 2 * e] = __uint_as_float(a[r][1][e] << 16); x[9 + 2 * e] = __uint_as_float(a[r][1][e] & 0xffff0000u); }
            float mx = 0.f;
#pragma unroll
            for (int e = 0; e < 16; ++e) mx = fmaxf(mx, fabsf(x[e]));
            { unsigned v = __float_as_uint(mx), o;
              o = (unsigned)__builtin_amdgcn_update_dpp(0, (int)v, 0xB1, 0xF, 0xF, true); v = o > v ? o : v;
              o = (unsigned)__builtin_amdgcn_update_dpp(0, (int)v, 0x4E, 0xF, 0xF, true); v = o > v ? o : v;
              o = (unsigned)__builtin_amdgcn_update_dpp(0, (int)v, 0x141, 0xF, 0xF, true); v = o > v ? o : v;
              o = (unsigned)__builtin_amdgcn_update_dpp(0, (int)v, 0x140, 0xF, 0xF, true); v = o > v ? o : v;
              const unsigned p0 = (unsigned)__builtin_amdgcn_readlane((int)v, 0), p1 = (unsigned)__builtin_amdgcn_readlane((int)v, 16), p2 = (unsigned)__builtin_amdgcn_readlane((int)v, 32), p3 = (unsigned)__builtin_amdgcn_readlane((int)v, 48);
              const unsigned q0 = p0 > p1 ? p0 : p1, q1 = p2 > p3 ? p2 : p3; mx = __uint_as_float(q0 > q1 ? q0 : q1); }
            const float iq = mx > 0.f ? 127.0f / mx : 0.f;
            unsigned w[4];
#pragma unroll
            for (int e = 0; e < 4; ++e) { const int q0 = (int)__builtin_rintf(x[4 * e] * iq), q1 = (int)__builtin_rintf(x[4 * e + 1] * iq), q2 = (int)__builtin_rintf(x[4 * e + 2] * iq), q3 = (int)__builtin_rintf(x[4 * e + 3] * iq);
                w[e] = (unsigned)(q0 & 0xff) | ((unsigned)(q1 & 0xff) << 8) | ((unsigned)(q2 & 0xff) << 16) | ((unsigned)(q3 & 0xff) << 24); }
            *(v2u*)(Q + (size_t)(m0 + r) * D + 8 * lane) = (v2u){w[0], w[1]};
            *(v2u*)(Q + (size_t)(m0 + r) * D + 512 + 8 * lane) = (v2u){w[2], w[3]};
            if (lane == 0) XS[m0 + r] = mx * (1.0f / 127.0f);
        }
    }
}
struct Frame {
    LAS unsigned char* lds;
    volatile LAS unsigned* MISC;
    gu32* ctl;
    int tid, lane, wave, vcu, G;
    const void* const* in;
    float* out; unsigned char* ws;
};
#define WSP(T, off) ((T*)(F.ws + (off)))

template <class Map> __device__ __forceinline__ void p0_transpose_item(const float* W, int K, int N, const float* gain, bf16* WT, LAS float* scr, int item, int lane, const Map map, unsigned char* WT8 = nullptr) {
    const int nblk = (N + 31) / 32, kb = item / nblk, nb = item % nblk, k0 = 64 * kb, n0 = 32 * nb;
    const bool nok = n0 + (lane & 31) < N;
    { float v[32], gn[32];
#pragma unroll
      for (int i = 0; i < 32; ++i) { const int kk = 2 * i + (lane >> 5); v[i] = nok ? __builtin_nontemporal_load(W + (size_t)(k0 + kk) * N + n0 + (lane & 31)) : 0.f; gn[i] = gain ? gain[k0 + kk] : 1.0f; }
#pragma unroll
      for (int i = 0; i < 32; ++i) { const int kk = 2 * i + (lane >> 5); scr[kk * 33 + (lane & 31)] = v[i] * gn[i]; } }
    LDS_WAIT(); asm volatile("" ::: "memory");
    const int c = lane & 7;
#pragma unroll
    for (int j = 0; j < 4; ++j) { const int n = (lane >> 3) + 8 * j; const LAS float* s = scr + (8 * c) * 33 + n;
        v4u o; o.x = pk2(s[0 * 33], s[1 * 33]); o.y = pk2(s[2 * 33], s[3 * 33]); o.z = pk2(s[4 * 33], s[5 * 33]); o.w = pk2(s[6 * 33], s[7 * 33]);
        if (n0 + n < N) { if (WT) *(GAS v4u*)(WT + (size_t)map(n0 + n) * K + k0 + 8 * c) = o;
            if (WT8) { v2u o8; o8.x = pk4_fp8(s[0 * 33] * W8SCALE, s[1 * 33] * W8SCALE, s[2 * 33] * W8SCALE, s[3 * 33] * W8SCALE); o8.y = pk4_fp8(s[4 * 33] * W8SCALE, s[5 * 33] * W8SCALE, s[6 * 33] * W8SCALE, s[7 * 33] * W8SCALE);
                *(GAS v2u*)(WT8 + (size_t)map(n0 + n) * K + k0 + 8 * c) = o8; } } }
    LDS_WAIT(); asm volatile("" ::: "memory");
}
__device__ __forceinline__ void sincos_d(double a, float& s, float& c) {
    const double TWO_PI = 6.283185307179586476925286766559, PI = 3.14159265358979323846264338327950288;
    double k = __builtin_rint(a / TWO_PI); double r = a - k * TWO_PI;
    double sgn = 1.0; if (r > PI * 0.5) { r = PI - r; sgn = -1.0; } else if (r < -PI * 0.5) { r = -PI - r; sgn = -1.0; }
    const double r2 = r * r;
    double ts = 1.0, tc = 1.0, ps = 1.0, pc = 1.0;
#pragma unroll
    for (int n = 1; n <= 12; ++n) { pc = -pc * r2 / (double)((2 * n - 1) * (2 * n)); ps = -ps * r2 / (double)((2 * n) * (2 * n + 1)); tc += pc; ts += ps; }
    s = (float)(r * ts); c = (float)(sgn * tc);
}
__device__ __forceinline__ void p0_prologue(Frame& F) {
    LAS float* scr = (LAS float*)(F.lds + RING_OFF + F.wave * 16384);
    const int gw = F.vcu * 8 + F.wave, NGW = F.G * 8;
    constexpr int I_G = (D / 64) * (DFF / 32), I_D = (DFF / 64) * (D / 32), I_IN = (D / 64) * ((NIN + 31) / 32), I_O = (D / 64) * (D / 32);
    constexpr int NITEMS = 2 * (2 * I_G + I_D) + I_IN + I_O;
    for (int rep63 = 0; rep63 < (PROBE_DUP == 63 ? 2 : 1); ++rep63)
    for (int it = gw; it < NITEMS; it += NGW) {
        int r = it;
        if (r < I_G) { p0_transpose_item(((const float*)F.in[8]), D, DFF, ((const float*)F.in[7]), WSP(bf16, WS_WGU1), scr, r, F.lane, MapGate()); continue; } r -= I_G;
        if (r < I_G) { p0_transpose_item(((const float*)F.in[9]), D, DFF, ((const float*)F.in[7]), WSP(bf16, WS_WGU1), scr, r, F.lane, MapUp()); continue; } r -= I_G;
        if (r < I_D) { p0_transpose_item(((const float*)F.in[10]), DFF, D, nullptr, (bf16*)nullptr, scr, r, F.lane, MapLin(), WSP(unsigned char, WS_WD1_8)); continue; } r -= I_D;
        if (r < I_G) { p0_transpose_item(((const float*)F.in[19]), D, DFF, ((const float*)F.in[18]), WSP(bf16, WS_WGU2), scr, r, F.lane, MapGate()); continue; } r -= I_G;
        if (r < I_G) { p0_transpose_item(((const float*)F.in[20]), D, DFF, ((const float*)F.in[18]), WSP(bf16, WS_WGU2), scr, r, F.lane, MapUp()); continue; } r -= I_G;
        if (r < I_D) { p0_transpose_item(((const float*)F.in[21]), DFF, D, nullptr, (bf16*)nullptr, scr, r, F.lane, MapLin(), WSP(unsigned char, WS_WD2_8)); continue; } r -= I_D;
        if (r < I_IN) { p0_transpose_item(((const float*)F.in[12]), D, NIN, ((const float*)F.in[11]), WSP(bf16, WS_WIN), scr, r, F.lane, MapWin()); continue; } r -= I_IN;
        p0_transpose_item(((const float*)F.in[17]), D, D, nullptr, WSP(bf16, WS_WOUT), scr, r, F.lane, MapLin());
    }
    float* SS0 = WSP(float, WS_SS0);
    for (int rep64 = 0; rep64 < (PROBE_DUP == 64 ? 2 : 1); ++rep64)
    for (int g4 = gw; g4 < MTOT / 4; g4 += NGW) {
        const int m0 = 4 * g4;
        const float* xrow = m0 < MP ? ((const float*)F.in[0]) + (size_t)m0 * D : ((const float*)F.in[1]) + (size_t)(m0 - MP) * D;
        const GAS f32x4* xr = (const GAS f32x4*)xrow + F.lane;
        f32x4 v[4][4]; float s[4];
#pragma unroll
        for (int r = 0; r < 4; ++r)
#pragma unroll
            for (int j = 0; j < 4; ++j) v[r][j] = __builtin_nontemporal_load((const f32x4*)(xr + 256 * r + 64 * j));
#pragma unroll
        for (int r = 0; r < 4; ++r) { s[r] = 0.f;
#pragma unroll
            for (int j = 0; j < 4; ++j) s[r] += (v[r][j].x * v[r][j].x + v[r][j].y * v[r][j].y) + (v[r][j].z * v[r][j].z + v[r][j].w * v[r][j].w); }
#pragma unroll
        for (int o = 1; o < 64; o <<= 1) {
#pragma unroll
            for (int r = 0; r < 4; ++r) s[r] += __shfl_xor(s[r], o); }
        { float mx[4];
#pragma unroll
          for (int r = 0; r < 4; ++r) { mx[r] = 0.f;
#pragma unroll
              for (int j = 0; j < 4; ++j) mx[r] = fmaxf(mx[r], fmaxf(fmaxf(fabsf(v[r][j].x), fabsf(v[r][j].y)), fmaxf(fabsf(v[r][j].z), fabsf(v[r][j].w)))); }
#pragma unroll
          for (int o = 1; o < 64; o <<= 1) {
#pragma unroll
              for (int r = 0; r < 4; ++r) mx[r] = fmaxf(mx[r], __shfl_xor(mx[r], o)); }
          GAS unsigned* q8 = (GAS unsigned*)(WSP(unsigned char, WS_XI8) + (size_t)m0 * D) + F.lane;
#pragma unroll
          for (int r = 0; r < 4; ++r) { const float iq = mx[r] > 0.f ? 127.0f / mx[r] : 0.f;
#pragma unroll
              for (int j = 0; j < 4; ++j) { const int a_ = (int)__builtin_rintf(v[r][j].x * iq), b_ = (int)__builtin_rintf(v[r][j].y * iq), c_ = (int)__builtin_rintf(v[r][j].z * iq), d_ = (int)__builtin_rintf(v[r][j].w * iq);
                  q8[256 * r + 64 * j] = (unsigned)(a_ & 0xff) | ((unsigned)(b_ & 0xff) << 8) | ((unsigned)(c_ & 0xff) << 16) | ((unsigned)(d_ & 0xff) << 24); } }
          if (F.lane < 4) WSP(float, WS_XS)[m0 + F.lane] = (F.lane == 0 ? mx[0] : F.lane == 1 ? mx[1] : F.lane == 2 ? mx[2] : mx[3]) * (1.0f / 127.0f); }
        if (F.lane < 4) SS0[m0 + F.lane] = F.lane == 0 ? s[0] : F.lane == 1 ? s[1] : F.lane == 2 ? s[2] : s[3];
    }
    { float* rope = WSP(float, WS_ROPE);
      const double invf[8] = {1.0, 0.19392274474868576, 0.03760603093086393, 0.007292664737217109, 0.001414213562373095, 0.0002742481756762073, 5.318295896944988e-05, 1.031338537721246e-05};
      for (int rep65 = 0; rep65 < (PROBE_DUP == 65 ? 2 : 1); ++rep65)
      for (int e = (F.vcu * 512 + F.tid); e < 2052 * 8; e += F.G * 512) { const int p = e >> 3, i = e & 7; const double pos = (double)(p < SEQ ? p : PAST + (p - SEQ));
          double f = invf[0];
#pragma unroll
          for (int q = 1; q < 8; ++q) f = (i == q) ? invf[q] : f;
          float s, c; sincos_d(pos * f, s, c); rope[2 * e] = c; rope[2 * e + 1] = s; } }
}

__device__ __forceinline__ void unpack8(const v4u a, float (&o)[8]) {
#pragma unroll
    for (int e = 0; e < 4; ++e) { o[2 * e] = bf2f((unsigned short)(a[e] & 0xffffu)); o[2 * e + 1] = bf2f((unsigned short)(a[e] >> 16)); }
}
__device__ __forceinline__ void p0b_quant_weights(Frame& F) {
    const int gw = F.vcu * 8 + F.wave, NGW = F.G * 8;
    for (int rr0 = gw; rr0 < 4 * DFF; rr0 += 4 * NGW) {
        v4u a[4], b[4];
#pragma unroll
        for (int i = 0; i < 4; ++i) { const int rr = rr0 + i * NGW < 4 * DFF ? rr0 + i * NGW : rr0; const bool second = rr >= 2 * DFF; const int r = second ? rr - 2 * DFF : rr;
            const bf16* W = second ? WSP(bf16, WS_WGU2) : WSP(bf16, WS_WGU1);
            a[i] = *(const GAS v4u*)(W + (size_t)r * D + 8 * F.lane); b[i] = *(const GAS v4u*)(W + (size_t)r * D + 512 + 8 * F.lane); }
#pragma unroll
        for (int i = 0; i < 4; ++i) { const int rr = rr0 + i * NGW; if (rr >= 4 * DFF) break;
            const bool second = rr >= 2 * DFF; const int r = second ? rr - 2 * DFF : rr;
            unsigned char* Q = second ? WSP(unsigned char, WS_WGU2I8) : WSP(unsigned char, WS_WGU1I8); float* WSN = second ? WSP(float, WS_WSN2) : WSP(float, WS_WSN);
            float x[16]; { float t0[8], t1[8]; unpack8(a[i], t0); unpack8(b[i], t1);
#pragma unroll
                for (int e = 0; e < 8; ++e) { x[e] = t0[e]; x[8 + e] = t1[e]; } }
            float mx = 0.f;
#pragma unroll
            for (int e = 0; e < 16; ++e) mx = fmaxf(mx, fabsf(x[e]));
#pragma unroll
            for (int o = 1; o < 64; o <<= 1) mx = fmaxf(mx, __shfl_xor(mx, o));
            const float iq = mx > 0.f ? 127.0f / mx : 0.f;
            unsigned w[4];
#pragma unroll
            for (int e = 0; e < 4; ++e) { const int q0 = (int)__builtin_rintf(x[4 * e] * iq), q1 = (int)__builtin_rintf(x[4 * e + 1] * iq), q2 = (int)__builtin_rintf(x[4 * e + 2] * iq), q3 = (int)__builtin_rintf(x[4 * e + 3] * iq);
                w[e] = (unsigned)(q0 & 0xff) | ((unsigned)(q1 & 0xff) << 8) | ((unsigned)(q2 & 0xff) << 16) | ((unsigned)(q3 & 0xff) << 24); }
            *(GAS v2u*)(Q + (size_t)r * D + 8 * F.lane) = (v2u){w[0], w[1]};
            *(GAS v2u*)(Q + (size_t)r * D + 512 + 8 * F.lane) = (v2u){w[2], w[3]};
            if (F.lane == 0) WSN[r] = mx * (1.0f / 127.0f); }
    }
}
__device__ __forceinline__ void p4_conv(Frame& F) {
    const int gw = F.vcu * 8 + F.wave, NGW = F.G * 8, ch = F.lane * 8;
    const bf16* U = WSP(bf16, WS_U); const bf16* GBp = WSP(bf16, WS_GB); bf16* CAT = WSP(bf16, WS_CAT);
    const float* conv_w = (const float*)F.in[13]; const float* conv_b = (const float*)F.in[14]; const float* cache_conv = (const float*)F.in[5];
    float w0[8], w1[8], w2[8], cb[8];
#pragma unroll
    for (int e = 0; e < 8; ++e) { w0[e] = conv_w[ch + e]; w1[e] = conv_w[512 + ch + e]; w2[e] = conv_w[1024 + ch + e]; cb[e] = conv_b[ch + e]; }
    for (int c = gw; c < MTOT / 8; c += NGW) {
        const int r0 = 8 * c;
        v4u ur[10], gr[8];
#pragma unroll
        for (int e = 0; e < 10; ++e) { const int rr = r0 - 2 + e; ur[e] = *(const GAS v4u*)(U + (size_t)(rr < 0 ? 0 : rr) * 512 + ch); }
#pragma unroll
        for (int e = 0; e < 8; ++e) gr[e] = *(const GAS v4u*)(GBp + (size_t)(r0 + e) * 512 + ch);
        float um2[8], um1[8];
        unpack8(ur[0], um2); unpack8(ur[1], um1);
        if (r0 < MP && (r0 & (SEQ - 1)) == 0) {
#pragma unroll
            for (int e = 0; e < 8; ++e) { um2[e] = 0.f; um1[e] = 0.f; } }
#pragma unroll
        for (int e = 0; e < 8; ++e) {
            if (r0 >= MP && (e & 3) == 0) {
                const float* cc = cache_conv + (size_t)((r0 - MP + e) >> 2) * 2 * 512 + ch;
#pragma unroll
                for (int q = 0; q < 8; ++q) { um2[q] = cc[q]; um1[q] = cc[512 + q]; } }
            float u0[8], g[8], y[8]; unpack8(ur[2 + e], u0); unpack8(gr[e], g);
#pragma unroll
            for (int q = 0; q < 8; ++q) { y[q] = g[q] * (cb[q] + w0[q] * um2[q] + w1[q] * um1[q] + w2[q] * u0[q]); um2[q] = um1[q]; um1[q] = u0[q]; }
            v4u o; o.x = pk2(y[0], y[1]); o.y = pk2(y[2], y[3]); o.z = pk2(y[4], y[5]); o.w = pk2(y[6], y[7]);
            *(GAS v4u*)(CAT + (size_t)(r0 + e) * D + ch) = o;
        }
    }
}
__device__ __forceinline__ int crow16(int r, int hi) { return (r & 3) + 8 * (r >> 2) + 4 * hi; }
__device__ __forceinline__ float xhalf_sum(float v) {
    auto rr = __builtin_amdgcn_permlane32_swap(__float_as_uint(v), __float_as_uint(v), false, false);
    return __uint_as_float(rr[0]) + __uint_as_float(rr[1]);
}
__device__ __forceinline__ void p4_sample_scores(Frame& F) {
    const int gw = F.vcu * 8 + F.wave, NGW = F.G * 8, lane = F.lane, r32 = lane & 31, hi = lane >> 5;
    const bf16* QI = WSP(bf16, WS_QI); const float* WIp = WSP(float, WS_WI); float* SSC = WSP(float, WS_SSC);
    const int* page_table = (const int*)F.in[6]; const float* cache_idx_k = (const float*)F.in[4];
    for (int item = gw; item < DB * NPAGES; item += NGW) {
        const int b = item >> 7, pg = item & 127; const int page = page_table[b * NPAGES + pg];
        bf16x8 a[4]; f32x4 w4[4];
        { const bf16* qrow = QI + (size_t)(MP + 4 * b + (r32 >> 3)) * 512 + (r32 & 7) * 64 + 8 * hi;
#pragma unroll
          for (int s = 0; s < 4; ++s) a[s] = *(const GAS bf16x8*)(qrow + 16 * s);
#pragma unroll
          for (int q = 0; q < 4; ++q) w4[q] = *(const GAS f32x4*)(WIp + (size_t)(MP + 4 * b + q) * 8 + 4 * hi); }
        const float* src = cache_idx_k + ((size_t)page * PAGE + r32) * 64 + 8 * hi;
        f32x4 lo[4][4], hh[4][4];
#pragma unroll
        for (int sub = 0; sub < 4; ++sub)
#pragma unroll
            for (int s = 0; s < 4; ++s) { lo[sub][s] = __builtin_nontemporal_load((const f32x4*)(src + sub * 32 * 64 + 16 * s)); hh[sub][s] = __builtin_nontemporal_load((const f32x4*)(src + sub * 32 * 64 + 16 * s + 4)); }
#pragma unroll
        for (int sub = 0; sub < 4; ++sub) {
            f32x16 acc = {};
#pragma unroll
            for (int s = 0; s < 4; ++s) { v4u p; p.x = pk2(lo[sub][s][0], lo[sub][s][1]); p.y = pk2(lo[sub][s][2], lo[sub][s][3]); p.z = pk2(hh[sub][s][0], hh[sub][s][1]); p.w = pk2(hh[sub][s][2], hh[sub][s][3]);
                acc = __builtin_amdgcn_mfma_f32_32x32x16_bf16(a[s], __builtin_bit_cast(bf16x8, p), acc, 0, 0, 0); }
#pragma unroll
            for (int q = 0; q < 4; ++q) {
                float sum = w4[q][0] * fmaxf(acc[4 * q], 0.f) + w4[q][1] * fmaxf(acc[4 * q + 1], 0.f) + w4[q][2] * fmaxf(acc[4 * q + 2], 0.f) + w4[q][3] * fmaxf(acc[4 * q + 3], 0.f);
                sum = xhalf_sum(sum) + 0.0f;
                if ((q >> 1) == hi) SSC[(size_t)(4 * b + q) * SSTR + pg * PAGE + sub * 32 + r32] = sum;
            }
        }
    }
}
__device__ __forceinline__ unsigned fkey(float s) { const unsigned b = __builtin_bit_cast(unsigned, s); return b ^ ((unsigned)((int)b >> 31) | 0x80000000u); }
__device__ __forceinline__ float unfkey(unsigned k) { const unsigned b = (k & 0x80000000u) ? (k ^ 0x80000000u) : ~k; return __builtin_bit_cast(float, b); }
__device__ __forceinline__ unsigned wave_umax(unsigned v) {
    unsigned o;
    o = (unsigned)__builtin_amdgcn_update_dpp(0, (int)v, 0xB1, 0xF, 0xF, true); v = o > v ? o : v;
    o = (unsigned)__builtin_amdgcn_update_dpp(0, (int)v, 0x4E, 0xF, 0xF, true); v = o > v ? o : v;
    o = (unsigned)__builtin_amdgcn_update_dpp(0, (int)v, 0x141, 0xF, 0xF, true); v = o > v ? o : v;
    o = (unsigned)__builtin_amdgcn_update_dpp(0, (int)v, 0x140, 0xF, 0xF, true); v = o > v ? o : v;
    const unsigned a = (unsigned)__builtin_amdgcn_readlane((int)v, 0), b = (unsigned)__builtin_amdgcn_readlane((int)v, 16), c = (unsigned)__builtin_amdgcn_readlane((int)v, 32), d = (unsigned)__builtin_amdgcn_readlane((int)v, 48);
    const unsigned ab = a > b ? a : b, cd = c > d ? c : d; return ab > cd ? ab : cd;
}
__device__ __forceinline__ int wave_count(unsigned cl) {
    int tot = 0;
#pragma unroll
    for (int bb = 0; bb < 6; ++bb) tot += __popcll(__ballot((cl >> bb) & 1u)) << bb;
    return tot;
}
__device__ __forceinline__ void p4_index_preload(Frame& F, int b, int j, bf16x8 (&a)[4][4], float& pwq) {
    const int tid = F.tid, r32 = F.lane & 31, hi = F.lane >> 5; const size_t rowb = (size_t)b * SEQ; const int t0 = 16 * j;
    const bf16* QI = WSP(bf16, WS_QI); const float* WIp = WSP(float, WS_WI);
    pwq = WIp[(rowb + t0 + ((tid & 127) >> 3)) * 8 + (tid & 7)];
#pragma unroll
    for (int rt = 0; rt < 4; ++rt) { const bf16* qrow = QI + (rowb + t0 + 4 * rt + 2 * (r32 >> 4) + ((r32 >> 2) & 1)) * 512 + (4 * ((r32 >> 3) & 1) + (r32 & 3)) * 64 + 8 * hi;
#pragma unroll
        for (int s = 0; s < 4; ++s) a[rt][s] = *(const GAS bf16x8*)(qrow + 16 * s); }
}
__device__ __forceinline__ void p4_index_unit(Frame& F, int b, int j, int useq, bf16x8 (&a)[4][4], float& pwq, int nj) {
    int tid_ = F.tid; asm volatile("" : "+v"(tid_));
    const int tid = tid_, lane = tid & 63, wid = F.wave, r32 = lane & 31, hi = lane >> 5;
    const int ss_id = (F.vcu * 8 + useq) * 8 + wid, ss_item = ss_id >> 2, ss_sub = ss_id & 3, ss_b = ss_item >> 7, ss_pg = ss_item & 127;
    const bool ss_on = F.vcu < 256;
    const int ss_page = ss_on ? ((const int*)F.in[6])[ss_b * NPAGES + ss_pg] : 0;
    const int t0 = 16 * j, nk = t0 + 16, ntile = (nk + 31) >> 5;
    LAS float* S = (LAS float*)(F.lds + RING_OFF);
    LAS float* WQ = (LAS float*)(F.lds + RING_OFF + 131072);
    LAS unsigned long long* MSK = (LAS unsigned long long*)(F.lds + RING_OFF + 131072 + 512);
    LAS unsigned* HW = (LAS unsigned*)(F.lds + RING_OFF + 131072 + 512 + 4096) + wid * 512;
    const bf16* QI = WSP(bf16, WS_QI); const bf16* KIB = WSP(bf16, WS_KIB); const float* WIp = WSP(float, WS_WI);
    unsigned long long* MASK = WSP(unsigned long long, WS_MASK);
    const size_t rowb = (size_t)b * SEQ;
    for (int rep43 = 0; rep43 < (PROBE_DUP == 43 ? 2 : 1); ++rep43)
    if (j >= 16) {
        if (tid < 128) WQ[tid] = pwq;
        const bf16* kbase = KIB + (rowb + r32) * 64 + 8 * hi;
#define IDX_LOADB(dst, kt_) do { const int kc_ = (kt_) < ntile ? (kt_) : ntile - 1; _Pragma("unroll") for (int s = 0; s < 4; ++s) dst[s] = *(const GAS bf16x8*)(kbase + (size_t)kc_ * 32 * 64 + 16 * s); } while (0)
#define RELU_(x_) __builtin_amdgcn_fmed3f((x_), 0.f, inf_)
#define IDX_COMPUTE(bf_, kt_) do { const int key = (kt_) * 32 + r32; \
            _Pragma("unroll") for (int rt = 0; rt < 4; ++rt) { f32x16 acc = {}; \
                _Pragma("unroll") for (int s = 0; s < 4; ++s) acc = __builtin_amdgcn_mfma_f32_32x32x16_bf16(a[rt][s], bf_[s], acc, 0, 0, 0); \
                _Pragma("unroll") for (int qp = 0; qp < 2; ++qp) { const int ql_ = 4 * rt + 2 * qp + hi;                      \
                    const f32x4 wa = *(const LAS f32x4*)(WQ + ql_ * 8), wb = *(const LAS f32x4*)(WQ + ql_ * 8 + 4); \
                      \
                    float e0_ = RELU_(acc[8 * qp + 0]) * wa[0], e1_ = RELU_(acc[8 * qp + 1]) * wa[1]; \
                    e0_ = __builtin_fmaf(RELU_(acc[8 * qp + 2]), wa[2], e0_); e1_ = __builtin_fmaf(RELU_(acc[8 * qp + 3]), wa[3], e1_); \
                    e0_ = __builtin_fmaf(RELU_(acc[8 * qp + 4]), wb[0], e0_); e1_ = __builtin_fmaf(RELU_(acc[8 * qp + 5]), wb[1], e1_); \
                    e0_ = __builtin_fmaf(RELU_(acc[8 * qp + 6]), wb[2], e0_); e1_ = __builtin_fmaf(RELU_(acc[8 * qp + 7]), wb[3], e1_); \
                    S[ql_ * 2048 + key] = (e0_ + e1_) + 0.0f; } } } while (0)
        float inf_ = __builtin_inff(); asm volatile("" : "+v"(inf_));
        bf16x8 bfA[4], bfB[4];
        IDX_LOADB(bfA, wid);
        __syncthreads();
        for (int kt = wid; kt < ntile; kt += 16) {
            IDX_LOADB(bfB, kt + 8);
            IDX_COMPUTE(bfA, kt);
            if (kt + 8 < ntile) { IDX_LOADB(bfA, kt + 16); IDX_COMPUTE(bfB, kt + 8); }
        }
#undef IDX_LOADB
#undef IDX_COMPUTE
#undef RELU_
        __syncthreads();
    }
    f32x4 ss_lo[4], ss_hh[4];
    { const float* src = ((const float*)F.in[4]) + ((size_t)ss_page * PAGE + ss_sub * 32 + r32) * 64 + 8 * hi;
#pragma unroll
      for (int s = 0; s < 4; ++s) { ss_lo[s] = __builtin_nontemporal_load((const f32x4*)(src + 16 * s)); ss_hh[s] = __builtin_nontemporal_load((const f32x4*)(src + 16 * s + 4)); }
    }
#pragma unroll 1
    for (int rep44 = 0; rep44 < (PROBE_DUP == 44 ? 2 : 1); ++rep44) {
        const int qlA = 2 * wid, tA = t0 + qlA, tB = tA + 1;
        unsigned wloA = 0u, whiA = 0u, wloB = 0u, whiB = 0u;
        if (tA < KTOP) {
            const int lo_ = 64 * lane;
            const unsigned long long wA_ = (lo_ + 63 <= tA) ? ~0ull : (lo_ > tA ? 0ull : ((1ull << (tA - lo_ + 1)) - 1ull)), wB_ = (lo_ + 63 <= tB) ? ~0ull : (lo_ > tB ? 0ull : ((1ull << (tB - lo_ + 1)) - 1ull));
            wloA = (unsigned)wA_; whiA = (unsigned)(wA_ >> 32); wloB = (unsigned)wB_; whiB = (unsigned)(wB_ >> 32);
        } else {
            bool doneA = false, doneB = false;
            { unsigned kvA[32], kvB[32]; float amA = 0.f, amB = 0.f;
              const int ngr = (tA >> 8) + 1;
#pragma unroll
              for (int g4 = 0; g4 < 8; ++g4) {
#pragma unroll
                  for (int e = 0; e < 4; ++e) { kvA[4 * g4 + e] = 0u; kvB[4 * g4 + e] = 0u; }
                  if (g4 < ngr) {
                      float sA[4], sB[4];
#pragma unroll
                      for (int e = 0; e < 4; ++e) { sA[e] = S[qlA * 2048 + lane + 64 * (4 * g4 + e)]; sB[e] = S[qlA * 2048 + 2048 + lane + 64 * (4 * g4 + e)]; }
                      if (g4 == ngr - 1) {
#pragma unroll
                          for (int e = 0; e < 4; ++e) { const int ki = lane + 64 * (4 * g4 + e); sA[e] = (ki <= tA) ? sA[e] : 0.f; sB[e] = (ki <= tB) ? sB[e] : 0.f; } }
#pragma unroll
                      for (int e = 0; e < 4; ++e) { kvA[4 * g4 + e] = __float_as_uint(sA[e]); amA = fmaxf(amA, fabsf(sA[e])); kvB[4 * g4 + e] = __float_as_uint(sB[e]); amB = fmaxf(amB, fabsf(sB[e])); } } }
              const unsigned umA = wave_umax(__float_as_uint(amA)), umB = wave_umax(__float_as_uint(amB));
              const float scaleA = umA ? 0.4999f / __uint_as_float(umA) : 0.f, scaleB = umB ? 0.4999f / __uint_as_float(umB) : 0.f;
#pragma unroll
              for (int g4 = 0; g4 < 8; ++g4) if (g4 < ngr) {
#pragma unroll
                  for (int e = 0; e < 4; ++e) { const int jj = 4 * g4 + e; kvA[jj] = __float_as_uint(__builtin_fmaf(__uint_as_float(kvA[jj]), scaleA, 1.5f)); kvB[jj] = __float_as_uint(__builtin_fmaf(__uint_as_float(kvB[jj]), scaleB, 1.5f)); }
                  if (g4 == ngr - 1) {
#pragma unroll
                      for (int e = 0; e < 4; ++e) { const int jj = 4 * g4 + e; kvA[jj] = (lane + 64 * jj <= tA) ? kvA[jj] : 0u; kvB[jj] = (lane + 64 * jj <= tB) ? kvB[jj] : 0u; } } }
              unsigned pfxA = 0x3F800000u, pfxB = 0x3F800000u, TvA = 0u, TvB = 0u; int needA = KTOP, needB = KTOP;
              const unsigned hwbA = (unsigned)(uintptr_t)HW, hwbB = hwbA + 1024u;
              LAS unsigned* HWB = HW + 256;
#pragma unroll 1
              for (int pass = 0; pass < 3; ++pass) {
                  const int sh = pass == 0 ? 15 : pass == 1 ? 7 : 0;
                  const unsigned lim = pass == 2 ? 128u : (256u << sh);
                  const unsigned limA = doneA ? 0u : lim, limB = doneB ? 0u : lim;
                  *(LAS v4u*)(HW + 4 * lane) = (v4u){0u, 0u, 0u, 0u}; *(LAS v4u*)(HWB + 4 * lane) = (v4u){0u, 0u, 0u, 0u};
                  asm volatile("" ::: "memory");
#pragma unroll
                  for (int g4 = 0; g4 < 8; ++g4) if (g4 < ngr) {
#pragma unroll
                      for (int e = 0; e < 4; ++e) { const unsigned dA_ = kvA[4 * g4 + e] ^ pfxA, dB_ = kvB[4 * g4 + e] ^ pfxB;
                          if (dA_ < limA) __hip_atomic_fetch_add((LAS unsigned*)(uintptr_t)(hwbA + ((dA_ >> sh) << 2)), 1u, __ATOMIC_RELAXED, __HIP_MEMORY_SCOPE_WAVEFRONT);
                          if (dB_ < limB) __hip_atomic_fetch_add((LAS unsigned*)(uintptr_t)(hwbB + ((dB_ >> sh) << 2)), 1u, __ATOMIC_RELAXED, __HIP_MEMORY_SCOPE_WAVEFRONT); } }
                  asm volatile("" ::: "memory");
                  const v4u wA4 = *(const LAS v4u*)(HW + 4 * lane), wB4 = *(const LAS v4u*)(HWB + 4 * lane);
                  asm volatile("" ::: "memory");
#define SEL_SCAN(w4_, need_, HWX_, dgb_, above_, binc_) do { \
                      const unsigned ls_ = (w4_[0] + w4_[1]) + (w4_[2] + w4_[3]); unsigned p_ = ls_; \
                      p_ += (unsigned)__builtin_amdgcn_update_dpp(0, (int)p_, 0x111, 0xF, 0xF, false); p_ += (unsigned)__builtin_amdgcn_update_dpp(0, (int)p_, 0x112, 0xF, 0xF, false); \
                      p_ += (unsigned)__builtin_amdgcn_update_dpp(0, (int)p_, 0x114, 0xF, 0xF, false); p_ += (unsigned)__builtin_amdgcn_update_dpp(0, (int)p_, 0x118, 0xF, 0xF, false); \
                      const unsigned r0_ = (unsigned)__builtin_amdgcn_readlane((int)p_, 15), r1_ = (unsigned)__builtin_amdgcn_readlane((int)p_, 31), r2_ = (unsigned)__builtin_amdgcn_readlane((int)p_, 47), r3_ = (unsigned)__builtin_amdgcn_readlane((int)p_, 63); \
                      const int row_ = lane >> 4; p_ += (row_ == 0) ? 0u : (row_ == 1) ? r0_ : (row_ == 2) ? r0_ + r1_ : r0_ + r1_ + r2_; \
                      const unsigned abl_ = (r0_ + r1_ + r2_ + r3_) - p_;                                    \
                      const unsigned long long fm_ = __ballot((int)abl_ < (need_) && (int)(abl_ + ls_) >= (need_)); \
                      const int src_ = (int)__builtin_ctzll(fm_) & 63; \
                      const unsigned abs_ = (unsigned)__builtin_amdgcn_readlane((int)abl_, src_); \
                      const unsigned ci_ = ((lane & 15) < 4) ? (HWX_)[4 * src_ + (lane & 3)] : 0u;          \
                      unsigned sfx_ = ci_; \
                      sfx_ += (unsigned)__builtin_amdgcn_update_dpp(0, (int)sfx_, 0x101, 0xF, 0xF, false); sfx_ += (unsigned)__builtin_amdgcn_update_dpp(0, (int)sfx_, 0x102, 0xF, 0xF, false); \
                      const unsigned abi_ = abs_ + sfx_ - ci_;                                                \
                      const unsigned long long fb_ = __ballot(lane < 4 && (int)abi_ < (need_) && (int)(abi_ + ci_) >= (need_)); \
                      const int sl2_ = (int)__builtin_ctzll(fb_) & 63; \
                      dgb_ = (unsigned)(4 * src_ + sl2_); above_ = (unsigned)__builtin_amdgcn_readlane((int)abi_, sl2_); binc_ = (unsigned)__builtin_amdgcn_readlane((int)ci_, sl2_); } while (0)
                  unsigned dgA, abvA, bcA, dgB, abvB, bcB;
                  SEL_SCAN(wA4, needA, HW, dgA, abvA, bcA);
                  SEL_SCAN(wB4, needB, HWB, dgB, abvB, bcB);
#undef SEL_SCAN
                  if (!doneA) { pfxA |= dgA << sh; needA -= (int)abvA; TvA = pfxA; doneA = ((int)bcA == needA); }
                  if (!doneB) { pfxB |= dgB << sh; needB -= (int)abvB; TvB = pfxB; doneB = ((int)bcB == needB); }
                  if (doneA && doneB) break;
              }
#define SEL_MASK(kv_, Tv_, wlo_, whi_) do { _Pragma("unroll") for (int j4 = 0; j4 < 8; ++j4) if (j4 < ngr) { \
                      const unsigned long long wa = __ballot(kv_[4 * j4] >= Tv_), wb = __ballot(kv_[4 * j4 + 1] >= Tv_), wc_ = __ballot(kv_[4 * j4 + 2] >= Tv_), wd = __ballot(kv_[4 * j4 + 3] >= Tv_); \
                      asm("s_nop 1\n\tv_writelane_b32 %0, %2, %10\n\tv_writelane_b32 %1, %3, %10\n\tv_writelane_b32 %0, %4, %11\n\tv_writelane_b32 %1, %5, %11\n\tv_writelane_b32 %0, %6, %12\n\tv_writelane_b32 %1, %7, %12\n\tv_writelane_b32 %0, %8, %13\n\tv_writelane_b32 %1, %9, %13" \
                          : "+v"(wlo_), "+v"(whi_) : "s"((unsigned)wa), "s"((unsigned)(wa >> 32)), "s"((unsigned)wb), "s"((unsigned)(wb >> 32)), "s"((unsigned)wc_), "s"((unsigned)(wc_ >> 32)), "s"((unsigned)wd), "s"((unsigned)(wd >> 32)), \
                            "n"(4 * j4), "n"(4 * j4 + 1), "n"(4 * j4 + 2), "n"(4 * j4 + 3)); } } while (0)
              if (doneA) SEL_MASK(kvA, TvA, wloA, whiA);
              if (doneB) SEL_MASK(kvB, TvB, wloB, whiB);
#undef SEL_MASK
            }
#pragma unroll 1
            for (int q2 = 0; q2 < 2; ++q2) {
            if (q2 == 0 ? doneA : doneB) continue;
            const int ql = qlA + q2, t = tA + q2; unsigned wlo = 0u, whi = 0u;
            unsigned uu[32];
#pragma unroll
            for (int jj = 0; jj < 32; ++jj) { const float s = S[ql * 2048 + lane + 64 * jj]; const unsigned k_ = fkey(s); uu[jj] = (lane + 64 * jj <= t) ? k_ : 0u; }
            const int ng = (t >> 8) + 1;
#define SEL_GRP(g4, CAND) if ((g4) < ng) { unsigned long long m0_, m1_, m2_, m3_; \
                    asm volatile("v_cmp_ge_u32_e64 %0, %4, %8\n\tv_cmp_ge_u32_e64 %1, %5, %8\n\tv_cmp_ge_u32_e64 %2, %6, %8\n\tv_cmp_ge_u32_e64 %3, %7, %8" \
                        : "=&s"(m0_), "=&s"(m1_), "=&s"(m2_), "=&s"(m3_) : "v"(uu[4 * (g4)]), "v"(uu[4 * (g4) + 1]), "v"(uu[4 * (g4) + 2]), "v"(uu[4 * (g4) + 3]), "v"(CAND)); \
                    cnt_ += __popcll(m0_) + __popcll(m1_) + __popcll(m2_) + __popcll(m3_); }
#define SEL_COUNT(CAND, OUT) do { int cnt_ = 0; SEL_GRP(0, CAND) SEL_GRP(1, CAND) SEL_GRP(2, CAND) SEL_GRP(3, CAND) SEL_GRP(4, CAND) SEL_GRP(5, CAND) SEL_GRP(6, CAND) SEL_GRP(7, CAND) OUT = cnt_; } while (0)
            unsigned T = 0u; int clo = t + 1;
#pragma unroll 1
            for (int bit = 31; bit >= 0; --bit) {
                const unsigned cand = T | (1u << bit); int c; SEL_COUNT(cand, c);
                if (c >= KTOP) { T = cand; clo = c; if (c == KTOP) break; }
            }
            if (clo == KTOP) {
#pragma unroll
                for (int jj = 0; jj < 32; ++jj) { const unsigned long long word = __ballot(uu[jj] >= T);
                    asm("s_nop 1\n\tv_writelane_b32 %0, %2, %4\n\tv_writelane_b32 %1, %3, %4" : "+v"(wlo), "+v"(whi) : "s"((unsigned)word), "s"((unsigned)(word >> 32)), "n"(jj));     }
            } else {
                int cgt; { const unsigned Tp = T + 1u; SEL_COUNT(Tp, cgt); }
                const int need = KTOP - cgt; int running = 0;
#pragma unroll
                for (int jj = 0; jj < 32; ++jj) {
                    const unsigned long long eq = __ballot(uu[jj] == T);
                    const int rank = (int)__builtin_amdgcn_mbcnt_hi((unsigned)(eq >> 32), __builtin_amdgcn_mbcnt_lo((unsigned)eq, 0u));
                    const unsigned long long word = __ballot(uu[jj] > T || (uu[jj] == T && running + rank < need));
                    asm("s_nop 1\n\tv_writelane_b32 %0, %2, %4\n\tv_writelane_b32 %1, %3, %4" : "+v"(wlo), "+v"(whi) : "s"((unsigned)word), "s"((unsigned)(word >> 32)), "n"(jj));
                    running += __popcll(eq);
                }
            }
            if (q2 == 0) { wloA = wlo; whiA = whi; } else { wloB = wlo; whiB = whi; }
            }
#undef SEL_COUNT
#undef SEL_GRP
        }
        if (lane < 32) { MSK[qlA * 32 + lane] = ((unsigned long long)whiA << 32) | wloA; MSK[qlA * 32 + 32 + lane] = ((unsigned long long)whiB << 32) | wloB; }
    }
    bf16x8 ss_a[4]; f32x4 ss_w[4];
    { const bf16* qrow = QI + (size_t)(MP + 4 * ss_b + (r32 >> 3)) * 512 + (r32 & 7) * 64 + 8 * hi;
#pragma unroll
      for (int s = 0; s < 4; ++s) ss_a[s] = *(const GAS bf16x8*)(qrow + 16 * s);
#pragma unroll
      for (int q = 0; q < 4; ++q) ss_w[q] = *(const GAS f32x4*)(WIp + (size_t)(MP + 4 * ss_b + q) * 8 + 4 * hi); }
    if (nj >= 16) p4_index_preload(F, b, nj, a, pwq);
    if (ss_on) { f32x16 acc = {};
#pragma unroll
        for (int s = 0; s < 4; ++s) { v4u p; p.x = pk2(ss_lo[s][0], ss_lo[s][1]); p.y = pk2(ss_lo[s][2], ss_lo[s][3]); p.z = pk2(ss_hh[s][0], ss_hh[s][1]); p.w = pk2(ss_hh[s][2], ss_hh[s][3]);
            acc = __builtin_amdgcn_mfma_f32_32x32x16_bf16(ss_a[s], __builtin_bit_cast(bf16x8, p), acc, 0, 0, 0); }
        float* SSC = WSP(float, WS_SSC);
#pragma unroll
        for (int q = 0; q < 4; ++q) {
            float sum = ss_w[q][0] * fmaxf(acc[4 * q], 0.f) + ss_w[q][1] * fmaxf(acc[4 * q + 1], 0.f) + ss_w[q][2] * fmaxf(acc[4 * q + 2], 0.f) + ss_w[q][3] * fmaxf(acc[4 * q + 3], 0.f);
            sum = xhalf_sum(sum) + 0.0f;
            if ((q >> 1) == hi) SSC[(size_t)(4 * ss_b + q) * SSTR + ss_pg * PAGE + ss_sub * 32 + r32] = sum;
        } }
    __syncthreads();
    { const int jt = tid >> 4, ql = tid & 15; MASK[((size_t)b * 32 + jt) * SEQ + t0 + ql] = MSK[ql * 32 + jt]; }
    __syncthreads();
}
__device__ __forceinline__ void p4_index(Frame& F) {
    if (F.vcu >= 256) return;
    const int b = F.vcu >> 4, w = F.vcu & 15;
    bf16x8 pa[4][4]; float pwq;
    p4_index_preload(F, b, 127 - w, pa, pwq);
#pragma unroll 1
    for (int k = 0; k < 4; ++k) { const int j1 = w + 16 * k; p4_index_unit(F, b, 127 - j1, 2 * k, pa, pwq, j1); p4_index_unit(F, b, j1, 2 * k + 1, pa, pwq, k < 3 ? 127 - (j1 + 16) : -1); }
}

__device__ __forceinline__ void sel_scan256(const v4u w4, int need, const LAS unsigned* tab, int lane, unsigned& dgb, unsigned& above, unsigned& binc) {
    const unsigned ls = (w4[0] + w4[1]) + (w4[2] + w4[3]); unsigned p = ls;
    p += (unsigned)__builtin_amdgcn_update_dpp(0, (int)p, 0x111, 0xF, 0xF, false); p += (unsigned)__builtin_amdgcn_update_dpp(0, (int)p, 0x112, 0xF, 0xF, false);
    p += (unsigned)__builtin_amdgcn_update_dpp(0, (int)p, 0x114, 0xF, 0xF, false); p += (unsigned)__builtin_amdgcn_update_dpp(0, (int)p, 0x118, 0xF, 0xF, false);
    const unsigned r0 = (unsigned)__builtin_amdgcn_readlane((int)p, 15), r1 = (unsigned)__builtin_amdgcn_readlane((int)p, 31), r2 = (unsigned)__builtin_amdgcn_readlane((int)p, 47), r3 = (unsigned)__builtin_amdgcn_readlane((int)p, 63);
    const int row_ = lane >> 4; p += (row_ == 0) ? 0u : (row_ == 1) ? r0 : (row_ == 2) ? r0 + r1 : r0 + r1 + r2;
    const unsigned abl = (r0 + r1 + r2 + r3) - p;
    const unsigned long long fm = __ballot((int)abl < need && (int)(abl + ls) >= need);
    const int src = (int)__builtin_ctzll(fm) & 63;
    const unsigned abs_ = (unsigned)__builtin_amdgcn_readlane((int)abl, src);
    const unsigned ci = ((lane & 15) < 4) ? tab[4 * src + (lane & 3)] : 0u;
    unsigned sfx = ci;
    sfx += (unsigned)__builtin_amdgcn_update_dpp(0, (int)sfx, 0x101, 0xF, 0xF, false); sfx += (unsigned)__builtin_amdgcn_update_dpp(0, (int)sfx, 0x102, 0xF, 0xF, false);
    const unsigned abi = abs_ + sfx - ci;
    const unsigned long long fb = __ballot(lane < 4 && (int)abi < need && (int)(abi + ci) >= need);
    const int sl2 = (int)__builtin_ctzll(fb) & 63;
    dgb = (unsigned)(4 * src + sl2); above = (unsigned)__builtin_amdgcn_readlane((int)abi, sl2); binc = (unsigned)__builtin_amdgcn_readlane((int)ci, sl2);
}
__device__ __forceinline__ int block_sum8(LAS int* red, int par, int wid, int lane, int v) {
    if (lane == 0) red[par * 8 + wid] = v;
    __syncthreads();
    int s = 0;
#pragma unroll
    for (int w = 0; w < 8; ++w) s += red[par * 8 + w];
    return s;
}
__device__ __forceinline__ void p5_sample_unit(Frame& F, int sq) {
    const int tid = F.tid, lane = F.lane, wid = F.wave;
    const int b = sq >> 2, qi_ = sq & 3, row = MP + sq;
    LAS unsigned char* L0 = F.lds + RING_OFF;
    LAS int* red = (LAS int*)(L0);
    LAS float* newsc = (LAS float*)(L0 + 64);
    LAS int* wcnt = (LAS int*)(L0 + 128);
    LAS int* eqw = (LAS int*)(L0 + 256);
    LAS int* selidx = (LAS int*)(L0 + 2048);
    LAS float* LG = (LAS float*)(L0 + 4096);
    LAS float* OP = (LAS float*)(L0 + 16384);
    const bf16* QI = WSP(bf16, WS_QI); const bf16* KIB = WSP(bf16, WS_KIB); const float* WIp = WSP(float, WS_WI); const float* SSC = WSP(float, WS_SSC);
    const bf16* Qb = WSP(bf16, WS_Q); bf16* CAT = WSP(bf16, WS_CAT);
    for (int rep56 = 0; rep56 < (PROBE_DUP == 56 ? 2 : 1); ++rep56) {
    if (tid < 64) {
        const int h = (tid >> 2) & 7, jn = tid & 3; float dot = 0.f;
        const bf16* qp = QI + (size_t)row * 512 + h * 64; const bf16* kp = KIB + (size_t)(MP + 4 * b + jn) * 64;
        for (int d = 0; d < 64; ++d) dot += bf2f(qp[d]) * bf2f(kp[d]);
        float v = WIp[(size_t)row * 8 + h] * fmaxf(dot, 0.f);
        v += __shfl_xor(v, 4); v += __shfl_xor(v, 8); v += __shfl_xor(v, 16);
        if (tid < 4) newsc[tid] = (jn <= qi_) ? (v + 0.0f) : -INFINITY;
    }
    __syncthreads();
    unsigned uu[33];
#pragma unroll
    for (int jj = 0; jj < 32; ++jj) uu[jj] = fkey(SSC[(size_t)sq * SSTR + tid + 512 * jj]);
    uu[32] = tid < 4 ? fkey(newsc[tid]) : 0x007FFFFFu;
    unsigned T = 0u; int par = 0; bool fast = false;
    { LAS unsigned* RT = (LAS unsigned*)(L0 + 32768);
      LAS unsigned* RX = (LAS unsigned*)(L0 + 1536);
      RT[tid] = 0u; if (tid < 256) RT[512 + tid] = 0u;
      float am = 0.f; unsigned fin = 0u;
#pragma unroll
      for (int jj = 0; jj < 33; ++jj) { const float a_ = fabsf(unfkey(uu[jj])); const bool f_ = a_ < INFINITY; am = fmaxf(am, f_ ? a_ : 0.f); }
      { const unsigned um = wave_umax(__float_as_uint(am)); if (lane == 0) RX[wid] = um; }
      __syncthreads();
      unsigned bm = 0u;
#pragma unroll
      for (int w = 0; w < 8; ++w) { const unsigned x_ = RX[w]; bm = x_ > bm ? x_ : bm; }
      const float scale = bm ? 0.4999f / __uint_as_float(bm) : 0.f;
      unsigned iv[33];
#pragma unroll
      for (int jj = 0; jj < 33; ++jj) { const float s_ = unfkey(uu[jj]); iv[jj] = (fabsf(s_) < INFINITY) ? __float_as_uint(__builtin_fmaf(s_, scale, 1.5f)) : 0u; }
      unsigned pfx = 0x3F800000u; int need = KTOP; bool done = false;
#pragma unroll 1
      for (int pass = 0; pass < 3; ++pass) {
          const int sh = pass == 0 ? 15 : pass == 1 ? 7 : 0; const unsigned lim = pass == 2 ? 128u : (256u << sh);
          LAS unsigned* tab = RT + 256 * pass;
#pragma unroll
          for (int jj = 0; jj < 33; ++jj) { const unsigned d_ = iv[jj] ^ pfx; if (d_ < lim) __hip_atomic_fetch_add(tab + (d_ >> sh), 1u, __ATOMIC_RELAXED, __HIP_MEMORY_SCOPE_WORKGROUP); }
          __syncthreads();
          const v4u w4 = *(const LAS v4u*)(tab + 4 * lane);
          unsigned dg, abv, bc; sel_scan256(w4, need, tab, lane, dg, abv, bc);
          pfx |= dg << sh; need -= (int)abv;
          if ((int)bc == need) { done = true; break; }
      }
      if (done) {
          unsigned mn = 0xFFFFFFFFu;
#pragma unroll
          for (int jj = 0; jj < 33; ++jj) { const unsigned c_ = (iv[jj] >= pfx) ? uu[jj] : 0xFFFFFFFFu; mn = c_ < mn ? c_ : mn; }
          mn = ~wave_umax(~mn);
          if (lane == 0) RX[8 + wid] = mn;
          __syncthreads();
          unsigned t_ = 0xFFFFFFFFu;
#pragma unroll
          for (int w = 0; w < 8; ++w) { const unsigned x_ = RX[8 + w]; t_ = x_ < t_ ? x_ : t_; }
          T = t_; fast = true; }
      (void)fin; }
    if (!fast)
#pragma unroll 1
    for (int bit = 31; bit >= 0; --bit) {
        const unsigned cand = T | (1u << bit); int c = 0;
#pragma unroll
        for (int jj = 0; jj < 33; ++jj) c += __popcll(__ballot(uu[jj] >= cand));
        c = block_sum8(red, par, wid, lane, c); par ^= 1;
        if (c >= KTOP) { T = cand; if (c == KTOP) break; }
    }
    int cgt = 0;
#pragma unroll
    for (int jj = 0; jj < 33; ++jj) cgt += __popcll(__ballot(uu[jj] > T));
    cgt = block_sum8(red, par, wid, lane, cgt); par ^= 1;
    const int need = KTOP - cgt;
#pragma unroll
    for (int jj = 0; jj < 33; ++jj) { const int n = __popcll(__ballot(uu[jj] == T)); if (lane == 0) eqw[jj * 8 + wid] = n; }
    __syncthreads();
#define SEL_MASK(jj, eqbase, M) do { int below_ = 0, tot_ = 0; \
        _Pragma("unroll") for (int w = 0; w < 8; ++w) { const int n_ = eqw[(jj) * 8 + w]; tot_ += n_; below_ += (w < wid) ? n_ : 0; } \
        const unsigned long long eq_ = __ballot(uu[jj] == T); \
        const int rank_ = (eqbase) + below_ + (int)__builtin_amdgcn_mbcnt_hi((unsigned)(eq_ >> 32), __builtin_amdgcn_mbcnt_lo((unsigned)eq_, 0u)); \
        M = __ballot(uu[jj] > T || (uu[jj] == T && rank_ < need)); (eqbase) += tot_; } while (0)
    { int cw = 0, eqbase = 0;
#pragma unroll
      for (int jj = 0; jj < 33; ++jj) { unsigned long long m; SEL_MASK(jj, eqbase, m); cw += __popcll(m); }
      if (lane == 0) wcnt[wid] = cw; }
    __syncthreads();
    { int base = 0, eqbase = 0;
#pragma unroll
      for (int w = 0; w < 8; ++w) base += (w < wid) ? wcnt[w] : 0;
#pragma unroll
      for (int jj = 0; jj < 33; ++jj) { unsigned long long m; SEL_MASK(jj, eqbase, m);
          const int pos = base + (int)__builtin_amdgcn_mbcnt_hi((unsigned)(m >> 32), __builtin_amdgcn_mbcnt_lo((unsigned)m, 0u));
          if ((m >> lane) & 1ull) { if (pos < KTOP) selidx[pos] = (jj < 32) ? tid + 512 * jj : PAST + tid; }
          base += __popcll(m); } }
#undef SEL_MASK
    __syncthreads();
    }
    for (int rep57 = 0; rep57 < (PROBE_DUP == 57 ? 2 : 1); ++rep57) {
    const int kk = lane >> 3, ds = lane & 7;
    const float* kptr[4]; const float* vptr[4];
#pragma unroll
    for (int it = 0; it < 4; ++it) {
        const int kidx = selidx[32 * wid + 8 * it + kk];
        if (kidx < PAST) { const size_t pr = (size_t)((const int*)F.in[6])[b * NPAGES + (kidx >> 7)] * PAGE + (kidx & 127); kptr[it] = ((const float*)F.in[2]) + pr * 128 + 8 * ds; vptr[it] = ((const float*)F.in[3]) + pr * 128 + 8 * ds; }
        else { const size_t nr = (size_t)(4 * b + (kidx - PAST)); kptr[it] = F.out + O_KS + nr * 128 + 8 * ds; vptr[it] = F.out + O_VS + nr * 128 + 8 * ds; }
    }
    f32x4 kreg[2][4][2], vreg[2][4][2];
#pragma unroll
    for (int g = 0; g < 2; ++g)
#pragma unroll
        for (int it = 0; it < 4; ++it) { kreg[g][it][0] = *(const f32x4*)(kptr[it] + 64 * g); kreg[g][it][1] = *(const f32x4*)(kptr[it] + 64 * g + 4); }
#pragma unroll
    for (int g = 0; g < 2; ++g)
#pragma unroll
        for (int it = 0; it < 4; ++it) { vreg[g][it][0] = *(const f32x4*)(vptr[it] + 64 * g); vreg[g][it][1] = *(const f32x4*)(vptr[it] + 64 * g + 4); }
#pragma unroll
    for (int g = 0; g < 2; ++g) {
        float qv[4][8];
#pragma unroll
        for (int r = 0; r < 4; ++r) { const v4u qq = *(const GAS v4u*)(Qb + (size_t)row * 512 + (4 * g + r) * 64 + 8 * ds);
#pragma unroll
            for (int e = 0; e < 4; ++e) { qv[r][2 * e] = bf2f((unsigned short)(qq[e] & 0xffffu)); qv[r][2 * e + 1] = bf2f((unsigned short)(qq[e] >> 16)); } }
#pragma unroll
        for (int it = 0; it < 4; ++it) {
            const f32x4 k0 = kreg[g][it][0], k1 = kreg[g][it][1];
#pragma unroll
            for (int r = 0; r < 4; ++r) {
                float d = (qv[r][0] * k0[0] + qv[r][1] * k0[1]) + (qv[r][2] * k0[2] + qv[r][3] * k0[3]) + (qv[r][4] * k1[0] + qv[r][5] * k1[1]) + (qv[r][6] * k1[2] + qv[r][7] * k1[3]);
                d += __shfl_xor(d, 1); d += __shfl_xor(d, 2); d += __shfl_xor(d, 4);
                if (ds == 0) LG[(4 * g + r) * 256 + 32 * wid + 8 * it + kk] = d;
            }
        }
    }
    __syncthreads();
    { float l[4];
#pragma unroll
      for (int e = 0; e < 4; ++e) l[e] = LG[wid * 256 + lane + 64 * e];
      const float m = wave_max(fmaxf(fmaxf(l[0], l[1]), fmaxf(l[2], l[3])));
      float p[4], s = 0.f;
#pragma unroll
      for (int e = 0; e < 4; ++e) { p[e] = __builtin_amdgcn_exp2f(l[e] - m); s += p[e]; }
      s = wave_sum(s); const float inv = 1.0f / s;
#pragma unroll
      for (int e = 0; e < 4; ++e) LG[wid * 256 + lane + 64 * e] = p[e] * inv; }
    __syncthreads();
#pragma unroll
    for (int g = 0; g < 2; ++g) {
        float acc[4][8];
#pragma unroll
        for (int r = 0; r < 4; ++r)
#pragma unroll
            for (int e = 0; e < 8; ++e) acc[r][e] = 0.f;
#pragma unroll
        for (int it = 0; it < 4; ++it) {
            const f32x4 v0 = vreg[g][it][0], v1 = vreg[g][it][1];
#pragma unroll
            for (int r = 0; r < 4; ++r) { const float p = LG[(4 * g + r) * 256 + 32 * wid + 8 * it + kk];
#pragma unroll
                for (int e = 0; e < 4; ++e) { acc[r][e] += p * v0[e]; acc[r][4 + e] += p * v1[e]; } }
        }
#pragma unroll
        for (int r = 0; r < 4; ++r)
#pragma unroll
            for (int e = 0; e < 8; ++e) { float a = acc[r][e]; a += __shfl_xor(a, 8); a += __shfl_xor(a, 16); a += __shfl_xor(a, 32); if (kk == 0) OP[(wid * 8 + 4 * g + r) * 64 + 8 * ds + e] = a; }
    }
    __syncthreads();
    { const int hd = tid >> 6, d = tid & 63; float o = 0.f;
#pragma unroll
      for (int w = 0; w < 8; ++w) o += OP[(w * 8 + hd) * 64 + d];
      CAT[(size_t)row * D + 512 + hd * 64 + d] = (bf16)f2bf(o); }
    __syncthreads();
    }
}

constexpr int N_PHASES = 9;
struct Args { const void* in[22]; float* out; unsigned char* ws; int ph_lo, ph_hi, use_bar, pad; };
__global__ void __launch_bounds__(512, 2) hymba_fwd(Args args) {
    extern __shared__ __attribute__((aligned(16))) unsigned char lds[];
    Frame F;
    F.lds = (LAS unsigned char*)lds;
    F.MISC = (volatile LAS unsigned*)(F.lds + MISC_OFF);
    F.tid = threadIdx.x; F.lane = F.tid & 63; F.wave = __builtin_amdgcn_readfirstlane(F.tid >> 6);
    F.G = gridDim.x; { const int bx = blockIdx.x; F.vcu = (F.G % 8 == 0) ? (bx % 8) * (F.G / 8) + bx / 8 : bx; }
    F.ws = args.ws; F.out = args.out; F.ctl = (gu32*)(args.ws + WS_CTL);
    F.in = args.in;
    for (int u = F.tid; u < (LDS_BYTES - LDSCTL_OFF) / 4; u += 512) ((LAS unsigned*)(F.lds + LDSCTL_OFF))[u] = 0u;
    __syncthreads();
    XcdBarrier bar; bar.bar = (unsigned*)(F.ctl + CW_BAR); bar.x = 0; bar.st = nullptr;
    if (args.use_bar) bar = xcd_barrier_post((unsigned*)(F.ctl + CW_BAR), F.MISC + 8);
    const int lo = args.ph_lo, hi = args.ph_hi;
#define IN(k) (lo <= (k) && (k) < hi)
#define SEAM(k) do { if (IN(k) && IN((k) + 1)) { xcd_barrier(bar); if (PROBE_DUP == 60) xcd_barrier(bar); } } while (0)
    const int cblk = (int)blockIdx.x;

#ifndef PROBE_DUP
#define PROBE_DUP (-1)
#endif
#define RUNPHASE(k, ...) do { if (IN(k)) { { int t_ = F.tid; asm volatile("" : "+v"(t_)); F.tid = t_; F.lane = t_ & 63; }     \
        __VA_ARGS__; if (PROBE_DUP == (k)) { if (args.use_bar) xcd_barrier(bar); __VA_ARGS__; } } SEAM(k); } while (0)
#define RSTAB ((LAS float*)(F.lds + RING_OFF + 131072))
#define GEMM_PHASE(EPI, A_, B_, N_, K_, SS_, NSLOT_, ...) do { pg8::Gemm g{A_, B_, MP, N_, K_}; pg8::StaticOrder S; S.init(MP, N_, F.G, cblk); \
        if ((NSLOT_) > 0) fill_rstd_table(RSTAB, S, SS_, NSLOT_); \
        EPI E{__VA_ARGS__}; \
        pg8::gemm_phase<EPI, pg8::StaticOrder, true, true>(F.lds + RING_OFF, g, S, E); \
        { int nrep_ = (PROBE_DUP == 50) ? 2 : 1; asm volatile("" : "+s"(nrep_)); for (int rep_ = 0; rep_ < nrep_; ++rep_) skinny_phase<EPI, 2, 0>(F.lds + RING_OFF, A_, B_, N_, (K_) * 2, cblk, F.G, E); } } while (0)
#define GEMM_PHASE8(EPI, A8_, B8_, OSC_, N_, K_, SS_, NSLOT_, ...) do { pg8::Gemm g{(const bf16*)(A8_), (const bf16*)(B8_), MP, N_, (K_) / 2}; pg8::StaticOrder S; S.init(MP, N_, F.G, cblk); \
        if ((NSLOT_) > 0) fill_rstd_table(RSTAB, S, SS_, NSLOT_); \
        EPI E{__VA_ARGS__}; \
        pg8::gemm_phase<EPI, pg8::StaticOrder, true, true, 1>(F.lds + RING_OFF, g, S, E); \
        { int nrep_ = (PROBE_DUP == 55) ? 2 : 1; asm volatile("" : "+s"(nrep_)); for (int rep_ = 0; rep_ < nrep_; ++rep_) skinny_phase<EPI, 2, 1>(F.lds + RING_OFF, A8_, B8_, N_, K_, cblk, F.G, E, nullptr, nullptr, OSC_); } } while (0)
#define GEMM_PHASEI(EPI, A8_, B8_, XS_, WSN_, N_, K_, SS_, NSLOT_, ...) do { pg8::Gemm g{(const bf16*)(A8_), (const bf16*)(B8_), MP, N_, (K_) / 2}; pg8::StaticOrder S; S.init(MP, N_, F.G, cblk); \
        fill_rstd_table(RSTAB, S, SS_, NSLOT_, XS_); \
        EPI E{__VA_ARGS__}; \
        pg8::gemm_phase<EPI, pg8::StaticOrder, true, true, 2>(F.lds + RING_OFF, g, S, E); \
        { int nrep_ = (PROBE_DUP == 55) ? 2 : 1; asm volatile("" : "+s"(nrep_)); for (int rep_ = 0; rep_ < nrep_; ++rep_) skinny_phase<EPI, 4, 2>(F.lds + RING_OFF, A8_, B8_, N_, K_, cblk, F.G, E, XS_, WSN_); } } while (0)
    RUNPHASE(0, do { p0_prologue(F); xcd_barrier(bar); p0b_quant_weights(F); } while (0));
    RUNPHASE(1, GEMM_PHASEI(EpiGU, WSP(unsigned char, WS_XI8), WSP(unsigned char, WS_WGU1I8), WSP(float, WS_XS), WSP(float, WS_WSN), 2 * DFF, D, WSP(float, WS_SS0), 1, WSP(bf16, WS_H), WSP(float, WS_SS0), 1, RSTAB, 1.0f, WSP(unsigned char, WS_H8), WSP(float, WS_WSN)));
    RUNPHASE(2, GEMM_PHASE8(EpiRes<0>, WSP(unsigned char, WS_H8), WSP(unsigned char, WS_WD1_8), 1.0f / (W8SCALE * H8SCALE), D, DFF, nullptr, 0, WSP(bf16, WS_XB), nullptr, WSP(bf16, WS_X1B), WSP(float, WS_SS1), nullptr, 1.0f / (W8SCALE * H8SCALE), (const float*)F.in[0], (const float*)F.in[1]));
#if PROBE_DUP >= 21 && PROBE_DUP <= 23
    if (IN(2)) { xcd_barrier(bar); pg8::Gemm g{(const bf16*)WSP(unsigned char, WS_H8), (const bf16*)WSP(unsigned char, WS_WD1_8), MP, D, DFF / 2}; pg8::StaticOrder S; S.init(MP, D, F.G, cblk);
        EpiRes<0> E{WSP(bf16, WS_XB), nullptr, WSP(bf16, WS_X2B), WSP(float, WS_SS2), nullptr, 1.0f / (W8SCALE * H8SCALE), (const float*)F.in[0], (const float*)F.in[1]};
        pg8::gemm_phase<EpiRes<0>, pg8::StaticOrder, true, true, (PROBE_DUP == 21 ? 1 : PROBE_DUP == 22 ? 2 : 0)>(F.lds + RING_OFF, g, S, E); xcd_barrier(bar); }
#endif
    RUNPHASE(3, GEMM_PHASE(EpiWin, WSP(bf16, WS_X1B), WSP(bf16, WS_WIN), NINP, D, WSP(float, WS_SS1), 16, F.ws, F.out, (const float*)F.in[15], (const float*)F.in[16], RSTAB));
    RUNPHASE(4, do { p4_conv(F); if (PROBE_DUP == 40) p4_conv(F); p4_index(F); if (PROBE_DUP == 42) p4_index(F); } while (0));
    RUNPHASE(5, do { if ((F.vcu & 1) == 0 && F.vcu < 256) { p5_sample_unit(F, F.vcu >> 1); if (PROBE_DUP == 51) p5_sample_unit(F, F.vcu >> 1); }
        const attn_body::AttnTensors AT{(const attn_body::bf16*)WSP(bf16, WS_Q), (const attn_body::bf16*)WSP(bf16, WS_KB), (const attn_body::bf16*)WSP(bf16, WS_VB), WSP(unsigned long long, WS_MASK), (attn_body::bf16*)WSP(bf16, WS_CAT)};
        const attn_body::StaticOrder S(F.vcu); attn_body::attn_phase<attn_body::StaticOrder>((char*)lds + RING_OFF, AT, S); } while (0));
    RUNPHASE(6, do { GEMM_PHASE(EpiRes<1>, WSP(bf16, WS_CAT), WSP(bf16, WS_WOUT), D, D, nullptr, 0, WSP(bf16, WS_X1B), nullptr, WSP(bf16, WS_X2B), WSP(float, WS_SS2), nullptr, 1.0f);
                     xcd_barrier(bar); quant_rows_pass(F.vcu * 8 + F.wave, F.G * 8, WSP(bf16, WS_X2B), WSP(unsigned char, WS_X2I8), WSP(float, WS_XS2), MTOT); } while (0));
    RUNPHASE(7, GEMM_PHASEI(EpiGU, WSP(unsigned char, WS_X2I8), WSP(unsigned char, WS_WGU2I8), WSP(float, WS_XS2), WSP(float, WS_WSN2), 2 * DFF, D, WSP(float, WS_SS2), 16, WSP(bf16, WS_H), WSP(float, WS_SS2), 16, RSTAB, 1.0f, WSP(unsigned char, WS_H8), WSP(float, WS_WSN2)));
    RUNPHASE(8, GEMM_PHASE8(EpiRes<2>, WSP(unsigned char, WS_H8), WSP(unsigned char, WS_WD2_8), 1.0f / (W8SCALE * H8SCALE), D, DFF, nullptr, 0, WSP(bf16, WS_X2B), F.out, nullptr, nullptr, nullptr, 1.0f / (W8SCALE * H8SCALE)));
#undef RUNPHASE
#undef GEMM_PHASE
#undef GEMM_PHASE8
#undef GEMM_PHASEI
#undef RSTAB
#undef IN
#undef SEAM
}

#ifndef MK_N_LAUNCHES
#define MK_N_LAUNCHES 1
#endif
extern "C" void kernel_launch(void* const* d_in, const int* in_sizes, int n_in, void* d_out, int out_size, void* d_ws, size_t ws_size, hipStream_t stream) {
    static int grid = 0;
    if (grid == 0) {
        if (n_in != 22 || out_size != (int)O_END || ws_size < WS_END) { fprintf(stderr, "kernel_launch: unexpected problem: n_in %d out %d ws %zu (need %zu)\n", n_in, out_size, ws_size, (size_t)WS_END); grid = -1; return; }
        int dev = 0, cus = 0, per_cu = 0;
        if (hipGetDevice(&dev) != hipSuccess || hipDeviceGetAttribute(&cus, hipDeviceAttributeMultiprocessorCount, dev) != hipSuccess) { grid = -1; return; }
        if (hipFuncSetAttribute((const void*)hymba_fwd, hipFuncAttributeMaxDynamicSharedMemorySize, LDS_BYTES) != hipSuccess) { fprintf(stderr, "kernel_launch: hipFuncSetAttribute failed\n"); grid = -1; return; }
        if (hipOccupancyMaxActiveBlocksPerMultiprocessor(&per_cu, (const void*)hymba_fwd, 512, LDS_BYTES) != hipSuccess || per_cu < 1) { fprintf(stderr, "kernel_launch: occupancy query says %d blocks per CU\n", per_cu); (void)hipGetLastError(); grid = -1; return; }
        grid = cus;
        if (grid % 8 != 0 || grid < 8) { fprintf(stderr, "kernel_launch: unexpected CU count %d\n", cus); grid = -1; return; }
    }
    if (grid < 0) return;
    (void)hipMemsetAsync((char*)d_ws + WS_CTL, 0, CTL_ZERO_BYTES, stream);
    Args a{};
    for (int i = 0; i < 22; ++i) a.in[i] = d_in[i];
    a.out = (float*)d_out; a.ws = (unsigned char*)d_ws;
    if (MK_N_LAUNCHES == 1) { a.ph_lo = 0; a.ph_hi = N_PHASES; a.use_bar = 1; hipLaunchKernelGGL(hymba_fwd, dim3(grid), dim3(512), LDS_BYTES, stream, a); }
    else for (int p = 0; p < N_PHASES; ++p) { a.ph_lo = p; a.ph_hi = p + 1; a.use_bar = 0; hipLaunchKernelGGL(hymba_fwd, dim3(grid), dim3(512), LDS_BYTES, stream, a); }
}
```

```cpp
#include <hip/hip_runtime.h>
#include <cstdio>
#include <cstdint>
#include <type_traits>
namespace pg8 {
#define PG8_LAS __attribute__((address_space(3)))
typedef unsigned short bf16_t;
typedef short bf16x8 __attribute__((ext_vector_type(8)));
typedef float f32x4 __attribute__((ext_vector_type(4)));
typedef unsigned u32x4 __attribute__((ext_vector_type(4)));
constexpr int BM = 256, BK = 64, HALF = 128, HTB = HALF * BK * 2  , STAGE_BYTES = 8 * HTB, NXCD = 8, WGM = 8;

__host__ __device__ __forceinline__ int lds_byte(int r, int c) { const int st = (r >> 4) * 2 + (c >> 5), rr = r & 15, cc = c & 31, ob = rr * 64 + cc * 2; return st * 1024 + (ob ^ (((ob >> 9) & 1) << 5)); }
__host__ __device__ __forceinline__ void stage_rc(int b, int& R, int& C) { const int st = b / 1024, sb = b % 1024, swz = sb ^ (((sb >> 9) & 1) << 5); R = (st >> 1) * 16 + swz / 64; C = (st & 1) * 32 + (swz % 64) / 2; }
__host__ __device__ __forceinline__ int perm32(int rho) { const int n = rho >> 4, i = rho & 15; return 8 * (i >> 2) + 4 * n + (i & 3); }

struct Unit { int pm, pn; };
struct Gemm { const bf16_t* A; const bf16_t* Bt; int M, N, K; };

struct StaticOrder {
    int nM, nN, nwg, G, c;
    __host__ __device__ void init(int M, int N, int G_, int c_) { nM = M / BM; nN = N / BM; nwg = nM * nN; G = G_; c = c_; }
    __host__ __device__ bool next(int i, Unit& u) const {
        const long L = (long)i * G + c; if (L >= nwg) return false;
        int wgid = (int)L; { const int q = nwg / NXCD, r = nwg % NXCD, xcd = wgid % NXCD, off = wgid / NXCD; wgid = (xcd < r ? xcd * (q + 1) : r * (q + 1) + (xcd - r) * q) + off; }
        const int nig = WGM * nN, gid = wgid / nig, fm = gid * WGM, gsz = (nM - fm) < WGM ? (nM - fm) : WGM;
        u.pm = fm + ((wgid % nig) % gsz); u.pn = (wgid % nig) / gsz; return true;
    }
    __device__ __forceinline__ void a_ready(const Unit&) const {}
    __device__ __forceinline__ void done(const Unit&) const {}
};
__device__ __forceinline__ unsigned cvt_pk_bf16(float lo, float hi) { unsigned r; asm volatile("v_cvt_pk_bf16_f32 %0, %1, %2" : "=v"(r) : "v"(lo), "v"(hi)); return r; }
template <class Epi, class Sched, bool ALIGN_EPI = false, bool SP2 = false, int QM = 0, int PFD = 0>
__device__ __forceinline__ void gemm_phase(PG8_LAS unsigned char* lds, const Gemm g, const Sched& S, const Epi& E) {
    const int tid = threadIdx.x, wid = __builtin_amdgcn_readfirstlane(tid >> 6), lane = tid & 63, wr = wid >> 2, wc = wid & 3, fr = lane & 15, fq = lane >> 4;
    const int K = g.K, nt = K / BK;
    unsigned voffA[2], voffB[2];
#pragma unroll
    for (int i = 0; i < 2; ++i) { int R, C; stage_rc(tid * 16 + i * 8192, R, C); const int Rb = Epi::PERM ? ((R & ~31) + perm32(R & 31)) : R;
        voffA[i] = (unsigned)(R * K + C) * 2u; voffB[i] = (unsigned)(Rb * K + C) * 2u; }
    unsigned voffP[2];
#pragma unroll
    for (int i = 0; i < 2; ++i) voffP[i] = (unsigned)((32 * wid + 16 * i + (lane >> 2)) * K) * 2u + (unsigned)(lane & 3) * 4u;
#define PG8_PF(s2, kt) do { if constexpr (PFD != 0) { const char* p_ = ((kt) < nt) ? cA + (size_t)(kt) * kstep : nA + (size_t)((kt) - nt) * kstep; \
        __builtin_amdgcn_global_load_lds((const unsigned*)(p_ + voffP[s2]), (PG8_LAS unsigned*)(lds + 143360 + wid * 256), 4, 0, 0); } } while (0)
#define PG8_WAIT_V8() do { if constexpr (PFD != 0) PG8_WAIT_V(10); else PG8_WAIT_V(8); } while (0)
    const size_t kstep = (size_t)(BK * 2);
    const size_t hstep = (size_t)HALF * K * 2;
    const size_t tstep = 2 * hstep;
    const unsigned ldsw = (unsigned)wid * 1024u;
    const int aoff = lds_byte(wr * 64 + fr, fq * 8), boff = lds_byte(wc * 32 + fr, fq * 8);
#define PG8_SA(b, h) (((b) * 2 + (h)) * HTB)
#define PG8_SB(b, h) ((4 + (b) * 2 + (h)) * HTB)
#define PG8_STAGE(bufoff, gbase, voff) do { _Pragma("unroll") for (int _i = 0; _i < 2; ++_i) \
        __builtin_amdgcn_global_load_lds((const unsigned*)((const char*)(gbase) + (voff)[_i]), (PG8_LAS unsigned*)(lds + (bufoff) + ldsw + _i * 8192), 16, 0, 0); } while (0)
#define PG8_LDF(dst_, addr_) do { if constexpr (QM == 1) { const pg8_v4i lo_ = *(const PG8_LAS pg8_v4i*)(addr_), hi_ = *(const PG8_LAS pg8_v4i*)((addr_) + 1024); \
            (dst_).v = __builtin_shufflevector(lo_, hi_, 0, 1, 2, 3, 4, 5, 6, 7); } \
        else { (dst_).k[0] = *(const PG8_LAS bf16x8*)(addr_); (dst_).k[1] = *(const PG8_LAS bf16x8*)((addr_) + 1024); } } while (0)
#define PG8_LDA(dst, b, h) do { _Pragma("unroll") for (int m = 0; m < 4; ++m) PG8_LDF(dst[m], lds + PG8_SA(b, h) + aoff + m * 2048); } while (0)
#define PG8_LDB(dst, b, h) do { _Pragma("unroll") for (int n = 0; n < 2; ++n) PG8_LDF(dst[n], lds + PG8_SB(b, h) + boff + n * 2048); } while (0)
#define PG8_MMA(ai, bj, At, Bt) do { __builtin_amdgcn_s_setprio(1); if constexpr (QM != 0) asm volatile("s_nop 4");     \
        _Pragma("unroll") for (int m = 0; m < 4; ++m) _Pragma("unroll") for (int n = 0; n < 2; ++n) { \
            if constexpr (QM == 1) asm volatile("v_mfma_scale_f32_16x16x128_f8f6f4 %0, %1, %2, %0, %3, %3 op_sel_hi:[0,0,0]" : "+v"(acc[ai][bj][m][n]) : "v"(Bt[n].v), "v"(At[m].v), "v"(scl8_));     \
            else if constexpr (QM == 2) { _Pragma("unroll") for (int k = 0; k < 2; ++k) asm volatile("v_mfma_i32_16x16x64_i8 %0, %1, %2, %0" : "+v"(acc[ai][bj][m][n]) : "v"(Bt[n].k[k]), "v"(At[m].k[k])); } \
            else { _Pragma("unroll") for (int k = 0; k < 2; ++k) acc[ai][bj][m][n] = __builtin_amdgcn_mfma_f32_16x16x32_bf16(Bt[n].k[k], At[m].k[k], acc[ai][bj][m][n], 0, 0, 0); } } \
        __builtin_amdgcn_s_setprio(0); } while (0)
#define PG8_WAIT_V(n) asm volatile("s_waitcnt vmcnt(" #n ")" ::: "memory")
#define PG8_WAIT_L(n) asm volatile("s_waitcnt lgkmcnt(" #n ")" ::: "memory")
#define PG8_BAR __builtin_amdgcn_s_barrier()
#define PG8_SCHED __builtin_amdgcn_sched_barrier(0)
    Unit cur, nxt; int ui = 0;
    if (!S.next(0, cur)) return;
    f32x4 acc[2][2][4][2];
    E.init(acc, cur, wr, wc, fr, fq);
    typedef int pg8_v8i __attribute__((ext_vector_type(8))); typedef int pg8_v4i __attribute__((ext_vector_type(4)));
    struct FragB { bf16x8 k[2]; }; struct Frag8 { pg8_v8i v; };
    typedef typename std::conditional<QM == 1, Frag8, FragB>::type Frag;
    Frag At[4], B0[2], B1[2];
    unsigned scl8_ = 0x7F7F7F7Fu; asm volatile("" : "+v"(scl8_));
    const char* cA = (const char*)g.A + (size_t)cur.pm * tstep; const char* cB = (const char*)g.Bt + (size_t)cur.pn * tstep;
    S.a_ready(cur);
    if constexpr (SP2) {
        PG8_STAGE(PG8_SB(0, 0), cB, voffB); PG8_STAGE(PG8_SB(0, 1), cB + hstep, voffB); PG8_STAGE(PG8_SA(0, 0), cA, voffA); PG8_STAGE(PG8_SA(0, 1), cA + hstep, voffA);
        if (wr == 1) PG8_BAR;
        PG8_WAIT_V(2); PG8_BAR;
        PG8_STAGE(PG8_SB(1, 0), cB + kstep, voffB); PG8_STAGE(PG8_SA(1, 0), cA + kstep, voffA); PG8_STAGE(PG8_SB(1, 1), cB + hstep + kstep, voffB);
        PG8_WAIT_V(6); PG8_BAR;
    } else {
        PG8_STAGE(PG8_SB(0, 0), cB, voffB); PG8_STAGE(PG8_SA(0, 0), cA, voffA); PG8_STAGE(PG8_SB(0, 1), cB + hstep, voffB); PG8_STAGE(PG8_SA(0, 1), cA + hstep, voffA);
        if (wr == 1) PG8_BAR;
        PG8_WAIT_V(4); PG8_BAR;
        PG8_STAGE(PG8_SB(1, 0), cB + kstep, voffB); PG8_STAGE(PG8_SA(1, 0), cA + kstep, voffA); PG8_STAGE(PG8_SB(1, 1), cB + hstep + kstep, voffB);
        PG8_WAIT_V(6); PG8_BAR;
    }
    for (;;) {
        const bool has_next = S.next(ui + 1, nxt);
        const char* nA = has_next ? (const char*)g.A + (size_t)nxt.pm * tstep : cA; const char* nB = has_next ? (const char*)g.Bt + (size_t)nxt.pn * tstep : cB;
#pragma unroll 1
        for (int t = 0; t < nt; t += 2) {
            const bool last = (t == nt - 2);
            const char* a1 = cA + (size_t)(t + 1) * kstep;
            const char* a2 = last ? nA : cA + (size_t)(t + 2) * kstep; const char* b2 = last ? nB : cB + (size_t)(t + 2) * kstep;
            const char* a3 = a2 + kstep; const char* b3 = b2 + kstep;
            if (last && has_next) S.a_ready(nxt);
            if constexpr (SP2) {
            PG8_LDB(B0, 0, 0); PG8_LDB(B1, 0, 1); PG8_SCHED; PG8_LDA(At, 0, 0); PG8_STAGE(PG8_SA(1, 1), a1 + hstep, voffA); PG8_PF(0, t + PFD);
            PG8_WAIT_V8(); PG8_WAIT_L(0); PG8_BAR; PG8_MMA(0, 0, At, B0); PG8_MMA(0, 1, At, B1); PG8_BAR; PG8_SCHED;
            PG8_LDA(At, 0, 1); PG8_STAGE(PG8_SB(0, 0), b2, voffB); PG8_STAGE(PG8_SB(0, 1), b2 + hstep, voffB); PG8_STAGE(PG8_SA(0, 0), a2, voffA); PG8_PF(1, t + PFD);
            PG8_WAIT_V8(); PG8_WAIT_L(0); PG8_BAR; PG8_MMA(1, 0, At, B0); PG8_MMA(1, 1, At, B1); PG8_BAR; PG8_SCHED;
            PG8_LDB(B0, 1, 0); PG8_LDB(B1, 1, 1); PG8_SCHED; PG8_LDA(At, 1, 0); PG8_STAGE(PG8_SA(0, 1), a2 + hstep, voffA); PG8_PF(0, t + 1 + PFD);
            PG8_WAIT_V8(); PG8_WAIT_L(0); PG8_BAR; PG8_MMA(0, 0, At, B0); PG8_MMA(0, 1, At, B1); PG8_BAR; PG8_SCHED;
            PG8_LDA(At, 1, 1); PG8_STAGE(PG8_SB(1, 0), b3, voffB); PG8_STAGE(PG8_SB(1, 1), b3 + hstep, voffB); PG8_STAGE(PG8_SA(1, 0), a3, voffA); PG8_PF(1, t + 1 + PFD);
            PG8_WAIT_V8(); PG8_WAIT_L(0); PG8_BAR; PG8_MMA(1, 0, At, B0); PG8_MMA(1, 1, At, B1); PG8_BAR; PG8_SCHED;
            } else {
            PG8_LDB(B0, 0, 0); PG8_SCHED; PG8_LDA(At, 0, 0); PG8_STAGE(PG8_SA(1, 1), a1 + hstep, voffA);
            PG8_WAIT_L(8); PG8_BAR; PG8_WAIT_L(0); PG8_MMA(0, 0, At, B0); PG8_BAR; PG8_SCHED;
            PG8_LDB(B1, 0, 1); PG8_STAGE(PG8_SB(0, 0), b2, voffB);
            PG8_BAR; PG8_WAIT_L(0); PG8_MMA(0, 1, At, B1); PG8_BAR;
            PG8_LDA(At, 0, 1); PG8_STAGE(PG8_SA(0, 0), a2, voffA);
            PG8_BAR; PG8_WAIT_L(0); PG8_MMA(1, 0, At, B0); PG8_BAR; PG8_SCHED;
            PG8_STAGE(PG8_SB(0, 1), b2 + hstep, voffB);
            PG8_WAIT_V(6); PG8_BAR; PG8_MMA(1, 1, At, B1); PG8_BAR;
            PG8_LDB(B0, 1, 0); PG8_SCHED; PG8_LDA(At, 1, 0); PG8_STAGE(PG8_SA(0, 1), a2 + hstep, voffA);
            PG8_WAIT_L(8); PG8_BAR; PG8_WAIT_L(0); PG8_MMA(0, 0, At, B0); PG8_BAR; PG8_SCHED;
            PG8_LDB(B1, 1, 1); PG8_STAGE(PG8_SB(1, 0), b3, voffB);
            PG8_BAR; PG8_WAIT_L(0); PG8_MMA(0, 1, At, B1); PG8_BAR;
            PG8_LDA(At, 1, 1); PG8_STAGE(PG8_SA(1, 0), a3, voffA);
            PG8_BAR; PG8_WAIT_L(0); PG8_MMA(1, 0, At, B0); PG8_BAR; PG8_SCHED;
            PG8_STAGE(PG8_SB(1, 1), b3 + hstep, voffB);
            PG8_WAIT_V(6); PG8_BAR; PG8_MMA(1, 1, At, B1); PG8_BAR;
            }
        }
        if constexpr (ALIGN_EPI) { if (wr == 0) PG8_BAR; }
        if constexpr (QM != 0) asm volatile("s_nop 15\n\ts_nop 7" ::: "memory");
        if constexpr (!Epi::AFTER_DRAIN) { E(acc, cur, wr, wc, fr, fq, ui, has_next, nxt);
#if defined(PROBE_DUP) && PROBE_DUP == 61
            E(acc, cur, wr, wc, fr, fq, ui, has_next, nxt);
#endif
            S.done(cur); }
        if (!has_next) break;
        cur = nxt; cA = nA; cB = nB; ++ui;
        if constexpr (ALIGN_EPI) { if (wr == 1) PG8_BAR; }
    }
    PG8_WAIT_V(0);
    if constexpr (!ALIGN_EPI) { if (wr == 0) PG8_BAR; }
    PG8_BAR;
    if constexpr (Epi::AFTER_DRAIN) { E.fused(acc, cur, wr, wc, fr, fq, lds, wid, lane); S.done(cur); }
#undef PG8_SA
#undef PG8_PF
#undef PG8_WAIT_V8
#undef PG8_SB
#undef PG8_STAGE
#undef PG8_LDA
#undef PG8_LDF
#undef PG8_LDB
#undef PG8_MMA
#undef PG8_WAIT_V
#undef PG8_WAIT_L
#undef PG8_BAR
#undef PG8_SCHED
}
}
#include <hip/hip_bf16.h>
#include <cmath>
namespace attn_body {
using bf16=__hip_bfloat16;
using bf16x8=__attribute__((ext_vector_type(8)))short;
using s16x4=__attribute__((ext_vector_type(4)))short;
using f32x16=__attribute__((ext_vector_type(16)))float;
using u32x4=__attribute__((ext_vector_type(4)))unsigned;
constexpr int BATCH=16,NHEAD=8,SEQ=2048,D=64;
constexpr int QP=512,KP=128,OP=1024,OOFF=512;
constexpr int NW=8,QBLK=32,QB=QBLK*NW,KVBLK=64,NQB=SEQ/QB;
constexpr int ATTN_UNIT_ROWS=QB;
__device__ __forceinline__ int crow(int r,int hi){return (r&3)+8*(r>>2)+4*hi;}
#define SBAR() __builtin_amdgcn_sched_barrier(0)
__device__ __forceinline__ float mskv_bit(float v,unsigned W,unsigned bit){ int m; asm("v_bfe_i32 %1, %2, %3, 1\n\tv_and_b32 %0, %0, %1":"+v"(v),"=&v"(m):"v"(W),"s"(bit)); return v; }
#define MSKV(v,W,r) mskv_bit(v,W,(unsigned)(((r)&3)+8*((r)>>2)))
__device__ __forceinline__ void cmask(f32x16&p0,f32x16&p1,int jb,int qrel,int hi){
  const float NEG=-INFINITY; int kb=64*jb+4*hi;
  #pragma unroll
  for(int r=0;r<16;++r){int kv=kb+(r&3)+8*(r>>2); if(kv>qrel)p0[r]=NEG; if(kv+32>qrel)p1[r]=NEG;}
}

constexpr int NSLOT=3, SLOTB=8192;
constexpr int LDS_K=0, LDS_V=NSLOT*SLOTB, LDS_WS=2*NSLOT*SLOTB, LDS_OST=LDS_WS+NW*64*4, LDS_MSK=LDS_OST+NW*4096, LDS_BYTES=LDS_MSK+NW*8192;
constexpr float C2=0.125f*1.4426950408889634f;
__device__ __forceinline__ void glds16(const void*gsrc,unsigned lds_dst){unsigned keep;
  asm volatile("s_mov_b32 %0, m0\n\ts_mov_b32 m0, %2\n\ts_nop 0\n\tglobal_load_lds_dwordx4 %1, off\n\ts_mov_b32 m0, %0":"=&s"(keep):"v"(gsrc),"s"(lds_dst):"memory");}
__device__ __forceinline__ float max3f(float a,float b,float c){float r;asm("v_max3_f32 %0, %1, %2, %3":"=v"(r):"v"(a),"v"(b),"v"(c));return r;}
__device__ __forceinline__ float max2f(float a,float b){float r;asm("v_max_f32_e32 %0, %1, %2":"=v"(r):"v"(a),"v"(b));return r;}
__device__ __forceinline__ float fadd_s(float a,float b){float r;asm("v_add_f32_e32 %0, %1, %2":"=v"(r):"v"(a),"v"(b));return r;}
__device__ __forceinline__ float fsub_s(float a,float b){float r;asm("v_sub_f32_e32 %0, %1, %2":"=v"(r):"v"(a),"v"(b));return r;}
typedef float f32x2_t __attribute__((ext_vector_type(2))); typedef __bf16 bf16x2_t __attribute__((ext_vector_type(2)));
__device__ __forceinline__ unsigned cvtpk_s(float lo,float hi){f32x2_t v={lo,hi};bf16x2_t b=__builtin_convertvector(v,bf16x2_t);return __builtin_bit_cast(unsigned,b);}
#define WAIT_BAR(N) asm volatile("s_waitcnt vmcnt(" #N ") lgkmcnt(0)\n\ts_barrier":::"memory")

__device__ __forceinline__ void qkt(f32x16&p0,f32x16&p1,const char*Kslot,const bf16x8*qr,const f32x16&negm,int r32,int hi){
  const char*kb=Kslot+hi*1024+r32*16;
  #pragma unroll
  for(int d0=0;d0<4;++d0){
    const bf16x8 b0=*reinterpret_cast<const bf16x8*>(kb+d0*2048);
    const bf16x8 b1=*reinterpret_cast<const bf16x8*>(kb+d0*2048+512);
    if(d0==0){p0=__builtin_amdgcn_mfma_f32_32x32x16_bf16(b0,qr[0],negm,0,0,0);p1=__builtin_amdgcn_mfma_f32_32x32x16_bf16(b1,qr[0],negm,0,0,0);}
    else{p0=__builtin_amdgcn_mfma_f32_32x32x16_bf16(b0,qr[d0],p0,0,0,0);p1=__builtin_amdgcn_mfma_f32_32x32x16_bf16(b1,qr[d0],p1,0,0,0);}}
}
typedef __attribute__((address_space(3))) const char* lds_cptr;
typedef short v4i16_t __attribute__((ext_vector_type(4)));
__device__ __forceinline__ void kload8(bf16x8*kf,lds_cptr kp){
  kf[0]=*(const __attribute__((address_space(3))) bf16x8*)(kp);      kf[1]=*(const __attribute__((address_space(3))) bf16x8*)(kp+512);
  kf[2]=*(const __attribute__((address_space(3))) bf16x8*)(kp+2048); kf[3]=*(const __attribute__((address_space(3))) bf16x8*)(kp+2560);
  kf[4]=*(const __attribute__((address_space(3))) bf16x8*)(kp+4096); kf[5]=*(const __attribute__((address_space(3))) bf16x8*)(kp+4608);
  kf[6]=*(const __attribute__((address_space(3))) bf16x8*)(kp+6144); kf[7]=*(const __attribute__((address_space(3))) bf16x8*)(kp+6656);
}
__device__ __forceinline__ void kload2(bf16x8*kf,lds_cptr kp,int j){ kf[2*j]=*(const __attribute__((address_space(3))) bf16x8*)(kp+j*2048); kf[2*j+1]=*(const __attribute__((address_space(3))) bf16x8*)(kp+j*2048+512); }
__device__ __forceinline__ s16x4 vtr(lds_cptr p){ return __builtin_bit_cast(s16x4,__builtin_amdgcn_ds_read_tr16_b64_v4i16((__attribute__((address_space(3))) v4i16_t*)p)); }
__device__ __forceinline__ float rowmax(const f32x16&p0,const f32x16&p1){
  float a=max3f(p0[0],p0[1],p1[0]),b=max3f(p0[2],p0[3],p1[1]);a=max3f(a,p1[2],p1[3]);
  #pragma unroll
  for(int r=4;r<16;r+=4){a=max3f(a,p0[r],p0[r+1]);b=max3f(b,p0[r+2],p0[r+3]);a=max3f(a,p1[r],p1[r+1]);b=max3f(b,p1[r+2],p1[r+3]);}
  const float m=max2f(a,b);
  auto rr=__builtin_amdgcn_permlane32_swap(__float_as_uint(m),__float_as_uint(m),false,false);
  return max2f(__uint_as_float(rr[0]),__uint_as_float(rr[1]));
}
__device__ __forceinline__ void pv(f32x16*o,int vb,bf16x8 pa0,bf16x8 pa1,bf16x8 pa2,bf16x8 pa3){
  #pragma unroll
  for(int d0=0;d0<2;++d0){s16x4 lo[4],hi[4];
    #pragma unroll
    for(int ks=0;ks<4;++ks){
      asm volatile("ds_read_b64_tr_b16 %0,%1 offset:%c2":"=&v"(lo[ks]):"v"(vb),"i"(d0*4096+ks*1024):"memory");
      asm volatile("ds_read_b64_tr_b16 %0,%1 offset:%c2":"=&v"(hi[ks]):"v"(vb),"i"(d0*4096+ks*1024+512):"memory");}
    asm volatile("s_waitcnt lgkmcnt(0)":::"memory");SBAR();
    #define PK(k) (bf16x8){lo[k][0],lo[k][1],lo[k][2],lo[k][3],hi[k][0],hi[k][1],hi[k][2],hi[k][3]}
    o[d0]=__builtin_amdgcn_mfma_f32_32x32x16_bf16(pa0,PK(0),o[d0],0,0,0);
    o[d0]=__builtin_amdgcn_mfma_f32_32x32x16_bf16(pa1,PK(1),o[d0],0,0,0);
    o[d0]=__builtin_amdgcn_mfma_f32_32x32x16_bf16(pa2,PK(2),o[d0],0,0,0);
    o[d0]=__builtin_amdgcn_mfma_f32_32x32x16_bf16(pa3,PK(3),o[d0],0,0,0);
    #undef PK
  }
}

#ifndef ATTN_STORE16
#define ATTN_STORE16(p,v) (*(u32x4*)(p)=(v))
#endif
template<int THRL> __device__ __forceinline__ void attn_unit(int b,int h,int qb,const bf16*Q,const bf16*K,const bf16*V,const unsigned long long*MK,bf16*O,char*shm){
  const int tid=threadIdx.x,lane=tid&63,r32=lane&31,hi=lane>>5; const int wid=__builtin_amdgcn_readfirstlane(tid>>6);
  const long rowbase=(long)b*SEQ; const int q0=qb*QB;
  const bf16*Qw=Q+(rowbase+q0+wid*QBLK)*QP+h*D;
  const bf16*Kh=K+rowbase*KP+(h>>2)*D,*Vh=V+rowbase*KP+(h>>2)*D;
  const unsigned lds0=(unsigned)(uintptr_t)shm;
  float*wsf=(float*)(shm+LDS_WS)+wid*64;
  const bf16*ksrc=Kh+(long)lane*KP+wid*8;
  const bf16*vsrc=Vh+(long)(16*(wid&3)+(lane>>2))*KP+(wid>>2)*32+(lane&3)*8;
  const unsigned kdst=lds0+LDS_K+wid*1024, vdst=lds0+LDS_V+wid*1024;
  #define DMA_K(t,slot) glds16(ksrc+(long)(t)*KVBLK*KP,(unsigned)__builtin_amdgcn_readfirstlane(kdst+(slot)))
  #define DMA_V(t,slot) glds16(vsrc+(long)(t)*KVBLK*KP,(unsigned)__builtin_amdgcn_readfirstlane(vdst+(slot)))
  const int vb0=(int)(lds0+LDS_V)+((lane>>4)&1)*32+(lane&3)*8+(4*hi+((lane&15)>>2))*64;
  const char*Kbase=shm+LDS_K; bf16x8 kf[8];
  const lds_cptr shm3=(lds_cptr)shm; const lds_cptr kp0=shm3+LDS_K+hi*1024+r32*16; const lds_cptr vp0=shm3+LDS_V+((lane>>4)&1)*32+(lane&3)*8+(4*hi+((lane&15)>>2))*64;
  const int NT=(q0+QB)/KVBLK;
  const __attribute__((address_space(3))) char* shm3m=(const __attribute__((address_space(3))) char*)shm;
  typedef __attribute__((address_space(3))) unsigned long long* lds_u64p;
  const lds_u64p mskw=(lds_u64p)(shm3m+LDS_MSK+wid*8192);
  { const unsigned long long*mq=MK+(q0+wid*QBLK+2*(lane&15)); const unsigned mdst=lds0+LDS_MSK+wid*8192;
    #pragma unroll
    for(int i=0;i<8;++i){int tt=4*i+(lane>>4); tt=tt<NT?tt:NT-1; glds16(mq+(long)tt*SEQ,(unsigned)__builtin_amdgcn_readfirstlane(mdst+i*1024));} }
  DMA_K(0,0);DMA_V(0,0);DMA_K(1,SLOTB);
  bf16x8 qr[4];
  #pragma unroll
  for(int d0=0;d0<4;++d0)qr[d0]=*reinterpret_cast<const bf16x8*>(&Qw[(long)r32*QP+d0*16+hi*8]);
  float mhat=0.f,l_reg=0.f;f32x16 o[2];o[0]=f32x16{};o[1]=f32x16{};f32x16 negm=f32x16{};asm volatile("":"+v"(negm));
  const int qrel=wid*QBLK+r32;
  #define CMASK(P0,P1,t) do{int jb_=(t)-(NT-4); if(jb_>=0)cmask(P0,P1,jb_,qrel,hi);}while(0)
  bool resc=false;
  #define START(P0,P1) do{ const float rm=rowmax(P0,P1); resc=false; \
    { const float dl=rm; mhat=fadd_s(mhat,dl); \
      _Pragma("unroll") for(int r=0;r<16;++r){P0[r]=fsub_s(P0[r],dl);P1[r]=fsub_s(P1[r],dl);} \
      _Pragma("unroll") for(int r=0;r<16;++r)negm[r]=-mhat; asm volatile("":"+v"(negm)); } \
    _Pragma("unroll") for(int r=0;r<16;++r)P0[r]=__builtin_amdgcn_exp2f(P0[r]); }while(0)
  #define RESC() do{ if(resc){ asm volatile("s_waitcnt lgkmcnt(0)":::"memory"); \
      _Pragma("unroll") for(int d_=0;d_<2;++d_) _Pragma("unroll") for(int r=0;r<16;++r)o[d_][r]*=wsf[crow(r,hi)]; } }while(0)
  f32x16 pA0,pA1,pB0,pB1;
  int sl_prev=0,sl_cur=0,sl_next=SLOTB;
  #define ROT() do{sl_prev=sl_cur;sl_cur=sl_next;sl_next=(sl_next==(NSLOT-1)*SLOTB)?0:sl_next+SLOTB;}while(0)
  DMA_K(2,2*SLOTB);
  WAIT_BAR(3);
  #define MLOAD(t,LO,HI) do{ const unsigned long long mw_=mskw[(t)*32+r32]; LO=((unsigned)mw_)>>(4*hi); HI=((unsigned)(mw_>>32))>>(4*hi); }while(0)
  unsigned mlo,mhi; MLOAD(0,mlo,mhi);
  qkt(pA0,pA1,Kbase,qr,negm,r32,hi);asm volatile("s_nop 15\n\ts_nop 7":"+v"(pA0),"+v"(pA1));
  START(pA0,pA1);
  _Pragma("unroll") for(int r=0;r<16;++r)pA1[r]=__builtin_amdgcn_exp2f(pA1[r]);
  _Pragma("unroll") for(int r=0;r<16;++r){pA0[r]=MSKV(pA0[r],mlo,r);pA1[r]=MSKV(pA1[r],mhi,r);}
  WAIT_BAR(0);
  DMA_K(3,0);DMA_V(1,SLOTB);
  ROT();
  kload8(kf,kp0+sl_cur);
  WAIT_BAR(2);
  s16x4 vlo[8],vhi[8]; u32x4 pw0,pw1,pw2,pw3;
  #define PKW(P,B) cvtpk_s(P[B],P[B+1])
  #define PAF(k) __builtin_bit_cast(bf16x8,pw##k)
  #define VFR(i) (bf16x8){vlo[i][0],vlo[i][1],vlo[i][2],vlo[i][3],vhi[i][0],vhi[i][1],vhi[i][2],vhi[i][3]}
  #define PIN(x) asm volatile("":"+v"(x))
  #define MX3(a,b,c) __builtin_fmaxf(__builtin_fmaxf((a),(b)),(c))
  #define GAPA(MF,A0,A1,A2,A3,W0,W1,PW) do{ MF; sacc+=A0; sacc+=A1; sacc+=A2; sacc+=A3; PIN(sacc); W0; W1; PIN(PW); SBAR(); }while(0)
  #define EX(v) __builtin_amdgcn_exp2f(v)
  #define GAPB(MF,X,B,W) do{ MF; X[B]=MSKV(EX(X[B]),W,B); X[B+1]=MSKV(EX(X[B+1]),W,B+1); X[B+2]=MSKV(EX(X[B+2]),W,B+2); X[B+3]=MSKV(EX(X[B+3]),W,B+3); PIN(X); SBAR(); }while(0)
  #define VRD(i) do{ vlo[i]=vtr(vp_+(((i)>>2)*4096+((i)&3)*1024)); vhi[i]=vtr(vp_+(((i)>>2)*4096+((i)&3)*1024+512)); }while(0)
  #define KRD(G,j) do{ if(G){ kload2(kf,kp0+sl_next,j); SBAR(); } }while(0)
  #define STEP(C0,C1,P0,P1,t,GK,GV,GL) do{ SBAR(); \
    const lds_cptr vp_=vp0+sl_prev; MLOAD(t,mlo,mhi); \
    VRD(0); SBAR(); float sacc=(P0[0]+P0[1]); \
    GAPA(C0=__builtin_amdgcn_mfma_f32_32x32x16_bf16(kf[0],qr[0],negm,0,0,0), P0[2],P0[3],P0[4],P0[5],     pw0[0]=PKW(P0,0), pw0[1]=PKW(P0,2), pw0); \
    VRD(4); SBAR(); GAPA(C1=__builtin_amdgcn_mfma_f32_32x32x16_bf16(kf[1],qr[0],negm,0,0,0), P0[6],P0[7],P0[8],P0[9],     pw0[2]=PKW(P0,4), pw0[3]=PKW(P0,6), pw0); \
    VRD(1); SBAR(); GAPA(C0=__builtin_amdgcn_mfma_f32_32x32x16_bf16(kf[2],qr[1],C0,0,0,0),   P0[10],P0[11],P0[12],P0[13], pw1[0]=PKW(P0,8), pw1[1]=PKW(P0,10), pw1); \
    VRD(5); SBAR(); GAPA(C1=__builtin_amdgcn_mfma_f32_32x32x16_bf16(kf[3],qr[1],C1,0,0,0),   P0[14],P0[15],P1[0],P1[1],   pw1[2]=PKW(P0,12),pw1[3]=PKW(P0,14), pw1); \
    VRD(2); SBAR(); GAPA(C0=__builtin_amdgcn_mfma_f32_32x32x16_bf16(kf[4],qr[2],C0,0,0,0),   P1[2],P1[3],P1[4],P1[5],     pw2[0]=PKW(P1,0), pw2[1]=PKW(P1,2), pw2); \
    VRD(6); SBAR(); GAPA(C1=__builtin_amdgcn_mfma_f32_32x32x16_bf16(kf[5],qr[2],C1,0,0,0),   P1[6],P1[7],P1[8],P1[9],     pw2[2]=PKW(P1,4), pw2[3]=PKW(P1,6), pw2); \
    VRD(3); SBAR(); GAPA(C0=__builtin_amdgcn_mfma_f32_32x32x16_bf16(kf[6],qr[3],C0,0,0,0),   P1[10],P1[11],P1[12],P1[13], pw3[0]=PKW(P1,8), pw3[1]=PKW(P1,10), pw3); \
    VRD(7); SBAR(); GAPA(C1=__builtin_amdgcn_mfma_f32_32x32x16_bf16(kf[7],qr[3],C1,0,0,0),   P1[14],P1[15],0.f,0.f,       pw3[2]=PKW(P1,12),pw3[3]=PKW(P1,14), pw3); \
    l_reg+=sacc; \
    if(GK){DMA_K((t)+3,sl_cur);} if(GV){DMA_V((t)+1,sl_next);} \
    { float a=MX3(C0[0],C0[1],C1[0]),b=MX3(C0[2],C0[3],C1[1]); a=MX3(a,C1[2],C1[3]); \
      _Pragma("unroll") for(int r=4;r<16;r+=4){a=MX3(a,C0[r],C0[r+1]);b=MX3(b,C0[r+2],C0[r+3]);a=MX3(a,C1[r],C1[r+1]);b=MX3(b,C1[r+2],C1[r+3]);} \
      float rm=__builtin_fmaxf(a,b); { auto rr=__builtin_amdgcn_permlane32_swap(__float_as_uint(rm),__float_as_uint(rm),false,false); rm=__builtin_fmaxf(__uint_as_float(rr[0]),__uint_as_float(rr[1])); } \
      resc=false; \
      if(__builtin_expect(__any(rm>(float)THRL),0)){ const float dl=__builtin_fmaxf(rm,0.f); mhat+=dl; \
        _Pragma("unroll") for(int r=0;r<16;++r){C0[r]-=dl;C1[r]-=dl;} \
        _Pragma("unroll") for(int r=0;r<16;++r)negm[r]=-mhat; asm volatile("":"+v"(negm)); \
        const float f=__builtin_amdgcn_exp2f(-dl); l_reg*=f; if(hi==0)wsf[r32]=f; resc=true; } } \
    SBAR(); \
    GAPB(o[0]=__builtin_amdgcn_mfma_f32_32x32x16_bf16(PAF(0),VFR(0),o[0],0,0,0), C0,0,mlo); \
    GAPB(o[1]=__builtin_amdgcn_mfma_f32_32x32x16_bf16(PAF(0),VFR(4),o[1],0,0,0), C0,4,mlo); \
    KRD(GL,0); GAPB(o[0]=__builtin_amdgcn_mfma_f32_32x32x16_bf16(PAF(1),VFR(1),o[0],0,0,0), C0,8,mlo); \
    KRD(GL,1); GAPB(o[1]=__builtin_amdgcn_mfma_f32_32x32x16_bf16(PAF(1),VFR(5),o[1],0,0,0), C0,12,mlo); \
    KRD(GL,2); GAPB(o[0]=__builtin_amdgcn_mfma_f32_32x32x16_bf16(PAF(2),VFR(2),o[0],0,0,0), C1,0,mhi); \
    KRD(GL,3); GAPB(o[1]=__builtin_amdgcn_mfma_f32_32x32x16_bf16(PAF(2),VFR(6),o[1],0,0,0), C1,4,mhi); \
    GAPB(o[0]=__builtin_amdgcn_mfma_f32_32x32x16_bf16(PAF(3),VFR(3),o[0],0,0,0), C1,8,mhi); \
    GAPB(o[1]=__builtin_amdgcn_mfma_f32_32x32x16_bf16(PAF(3),VFR(7),o[1],0,0,0), C1,12,mhi); \
    }while(0)
  int t=1;
  #undef CMASK
  #define CMASK(P0,P1,t) do{}while(0)
  for(;t+5<NT;t+=2){
    STEP(pB0,pB1,pA0,pA1,t,true,true,true);     WAIT_BAR(2); RESC(); ROT();
    STEP(pA0,pA1,pB0,pB1,t+1,true,true,true);   WAIT_BAR(2); RESC(); ROT();
  }
  #undef CMASK
  #define CMASK(P0,P1,t) do{int jb_=(t)-(NT-4); if(jb_>=0)cmask(P0,P1,jb_,qrel,hi);}while(0)
  #define ENDW(tt) do{ if((tt)+3<NT){WAIT_BAR(2);} else if((tt)+2<NT){WAIT_BAR(1);} else {WAIT_BAR(0);} }while(0)
  for(;t+1<NT;t+=2){
    STEP(pB0,pB1,pA0,pA1,t,(t+3<NT),(t+1<NT),(t+1<NT));       ENDW(t);   RESC(); ROT();
    STEP(pA0,pA1,pB0,pB1,t+1,(t+4<NT),(t+2<NT),(t+2<NT));     ENDW(t+1); RESC(); ROT();
  }
  STEP(pB0,pB1,pA0,pA1,NT-1,false,false,false); RESC();
  { float sacc=pB0[0]+pB0[1]; _Pragma("unroll") for(int r=2;r<16;++r)sacc+=pB0[r]; _Pragma("unroll") for(int r=0;r<16;++r)sacc+=pB1[r]; l_reg+=sacc;
    pw0=(u32x4){PKW(pB0,0),PKW(pB0,2),PKW(pB0,4),PKW(pB0,6)};pw1=(u32x4){PKW(pB0,8),PKW(pB0,10),PKW(pB0,12),PKW(pB0,14)};pw2=(u32x4){PKW(pB1,0),PKW(pB1,2),PKW(pB1,4),PKW(pB1,6)};pw3=(u32x4){PKW(pB1,8),PKW(pB1,10),PKW(pB1,12),PKW(pB1,14)};
    SBAR(); pv(o,vb0+sl_cur,PAF(0),PAF(1),PAF(2),PAF(3)); }
  #undef PKW
  #undef PAF
  #undef VFR
  #undef PIN
  #undef MX3
  #undef GAPA
  #undef GAPB
  #undef EX
  #undef VRD
  #undef KRD
  #undef STEP
  #undef ENDW
  {auto rr=__builtin_amdgcn_permlane32_swap(__float_as_uint(l_reg),__float_as_uint(l_reg),false,false);l_reg=__uint_as_float(rr[0])+__uint_as_float(rr[1]);}
  if(hi==0)wsf[32+r32]=l_reg;asm volatile("s_waitcnt lgkmcnt(0)":::"memory");
  float rli[16];
  #pragma unroll
  for(int r=0;r<16;++r)rli[r]=__builtin_amdgcn_rcpf(wsf[32+crow(r,hi)]);
  bf16*Ow=O+(rowbase+q0+wid*QBLK)*OP+OOFF+h*D;
  { bf16*stg=(bf16*)(shm+LDS_OST)+wid*2048;
    #pragma unroll
    for(int r=0;r<16;++r){const int orow=crow(r,hi);
      #pragma unroll
      for(int d0=0;d0<2;++d0)stg[orow*64+d0*32+r32]=__float2bfloat16(o[d0][r]*rli[r]);}
    asm volatile("s_waitcnt lgkmcnt(0)":::"memory");
    #pragma unroll
    for(int i=0;i<4;++i){const int row=i*8+(lane>>3),ch=lane&7; const u32x4 v=*(const u32x4*)(stg+row*64+ch*8); ATTN_STORE16(Ow+(long)row*OP+ch*8,v);} }
  asm volatile("s_waitcnt lgkmcnt(0)\n\ts_barrier":::"memory");
  #undef DMA_K
  #undef DMA_V
  #undef CMASK
  #undef START
  #undef RESC
  #undef ROT
}
constexpr int ATTN_LDS_BYTES=LDS_BYTES;
struct AttnTensors { const bf16* Q; const bf16* K; const bf16* V; const unsigned long long* MK; bf16* O; };
struct AttnUnit { int bh; int qb; };
struct StaticOrder {
  int vcu;
  __device__ __forceinline__ explicit StaticOrder(int vcu_):vcu(vcu_){}
  __device__ __forceinline__ bool next(int i,AttnUnit&u)const{ if(vcu>=256)return false; const int s=vcu&1; u.bh=vcu>>1; if(s){ if(i>=5)return false; u.qb=(i<2)?6-i:5-i; } else { if(i>=3)return false; u.qb=(i==0)?7:(i==1)?4:0; } return true; }
};
template<class Sched,int THRL=8> __device__ __forceinline__ void attn_phase(char*lds,const AttnTensors&T,const Sched&S){
  AttnUnit u;
  for(int i=0;S.next(i,u);++i){ const int b=u.bh/NHEAD; attn_unit<THRL>(b,u.bh%NHEAD,u.qb,T.Q,T.K,T.V,T.MK+(long)b*32*SEQ,T.O,lds); }
}
#undef SBAR
#undef WAIT_BAR
}
#ifndef PROBE_DUP
#define PROBE_DUP (-1)
#endif
constexpr int D = 1024, NB = 16, SEQ = 2048, MP = NB * SEQ, DB = 32, DS = 4, MS = DB * DS, MTOT = MP + MS, MPAD = 33024;
constexpr int DFF = 2816, NIN = 2888, NINP = 3072, DCONV = 512;
constexpr int PAST = 16384, PAGE = 128, NPAGES = 128, KTOP = 256;
constexpr float EPS = 1e-6f, LOG2E = 1.4426950408889634f;
constexpr float QSCALE = 0.125f * LOG2E;
constexpr size_t O_YP = 0, O_YS = O_YP + (size_t)MP * D, O_KP = O_YS + (size_t)MS * D, O_VP = O_KP + (size_t)MP * 128, O_IP = O_VP + (size_t)MP * 128,
                 O_CP = O_IP + (size_t)MP * 64, O_KS = O_CP + 16 * 2 * 512, O_VS = O_KS + MS * 128, O_IS = O_VS + MS * 128, O_CS = O_IS + MS * 64, O_END = O_CS + 32 * 2 * 512;
static_assert(O_END == 44261376, "output size");

constexpr size_t al(size_t x) { return (x + 0xFFFFF) & ~(size_t)0xFFFFF; }
constexpr size_t WS_CTL = 0, CTL_ZERO_BYTES = 1u << 20;
constexpr size_t WS_ROPE = al(WS_CTL + CTL_ZERO_BYTES);
constexpr size_t WS_WGU1 = al(WS_ROPE + 2052 * 8 * 2 * 4);
constexpr size_t WS_WD1 = al(WS_WGU1 + (size_t)2 * DFF * D * 2);
constexpr size_t WS_WIN = al(WS_WD1 + (size_t)D * DFF * 2);
constexpr size_t WS_WOUT = al(WS_WIN + (size_t)NINP * D * 2);
constexpr size_t WS_WGU2 = al(WS_WOUT + (size_t)D * D * 2);
constexpr size_t WS_WD2 = al(WS_WGU2 + (size_t)2 * DFF * D * 2);
constexpr size_t WS_XB = al(WS_WD2 + (size_t)D * DFF * 2);
constexpr size_t WS_SS0 = al(WS_XB + (size_t)MPAD * D * 2);
constexpr size_t WS_SS1 = al(WS_SS0 + (size_t)MPAD * 4);
constexpr size_t WS_SS2 = al(WS_SS1 + (size_t)MPAD * 64);
constexpr size_t WS_H = al(WS_SS2 + (size_t)MPAD * 64);
constexpr size_t WS_X1 = al(WS_H + (size_t)MPAD * DFF * 2);
constexpr size_t WS_X1B = al(WS_X1 + (size_t)MPAD * D * 4);
constexpr size_t WS_X2 = al(WS_X1B + (size_t)MPAD * D * 2);
constexpr size_t WS_X2B = al(WS_X2 + (size_t)MPAD * D * 4);
constexpr size_t WS_U = al(WS_X2B + (size_t)MPAD * D * 2);
constexpr size_t WS_GB = al(WS_U + (size_t)MPAD * 512 * 2);
constexpr size_t WS_Q = al(WS_GB + (size_t)MPAD * 512 * 2);
constexpr size_t WS_QI = al(WS_Q + (size_t)MPAD * 512 * 2);
constexpr size_t WS_KB = al(WS_QI + (size_t)MPAD * 512 * 2);
constexpr size_t WS_VB = al(WS_KB + (size_t)MPAD * 128 * 2);
constexpr size_t WS_KIB = al(WS_VB + (size_t)MPAD * 128 * 2);
constexpr size_t WS_WI = al(WS_KIB + (size_t)MPAD * 64 * 2);
constexpr size_t WS_CAT = al(WS_WI + (size_t)MPAD * 8 * 4);
constexpr size_t WS_MASK = al(WS_CAT + (size_t)MPAD * D * 2);
constexpr int SSTR = 16384;
constexpr size_t WS_SSC = al(WS_MASK + (size_t)NB * 32 * SEQ * 8);
constexpr size_t WS_XB8 = al(WS_SSC + (size_t)MS * SSTR * 4);
constexpr size_t WS_X2B8 = al(WS_XB8 + (size_t)MPAD * D);
constexpr size_t WS_WGU1_8 = al(WS_X2B8 + (size_t)MPAD * D);
constexpr size_t WS_WGU2_8 = al(WS_WGU1_8 + (size_t)2 * DFF * D);
constexpr size_t WS_WD2_8 = al(WS_WGU2_8 + (size_t)2 * DFF * D);
constexpr size_t WS_H8 = al(WS_WD2_8 + (size_t)D * DFF);
constexpr size_t WS_XI8 = al(WS_H8 + (size_t)MPAD * DFF);
constexpr size_t WS_XS = al(WS_XI8 + (size_t)MPAD * D);
constexpr size_t WS_WGU1I8 = al(WS_XS + (size_t)MPAD * 4);
constexpr size_t WS_WSN = al(WS_WGU1I8 + (size_t)2 * DFF * D);
constexpr size_t WS_X2I8 = al(WS_WSN + (size_t)2 * DFF * 4);
constexpr size_t WS_XS2 = al(WS_X2I8 + (size_t)MPAD * D);
constexpr size_t WS_WGU2I8 = al(WS_XS2 + (size_t)MPAD * 4);
constexpr size_t WS_WSN2 = al(WS_WGU2I8 + (size_t)2 * DFF * D);
constexpr size_t WS_WD1_8 = al(WS_WSN2 + (size_t)2 * DFF * 4);
constexpr size_t WS_END = al(WS_WD1_8 + (size_t)D * DFF);
constexpr float H8SCALE = 4.0f;
constexpr float W8SCALE = 32.0f;

constexpr int CW_TMO = 0, CW_CODE = 1, CW_BAR = 4096;

constexpr int RING_OFF = 0, RING_BYTES = 152576;
constexpr int LDSCTL_OFF = RING_BYTES, MISC_OFF = LDSCTL_OFF + 320;
constexpr int LDS_BYTES = 158720;
static_assert(MISC_OFF + 128 <= LDS_BYTES && attn_body::ATTN_LDS_BYTES <= RING_BYTES && pg8::STAGE_BYTES <= RING_BYTES, "LDS map");

#define GAS __attribute__((address_space(1)))
#define LAS __attribute__((address_space(3)))
typedef unsigned short bf16;
typedef unsigned v4u __attribute__((ext_vector_type(4)));
typedef unsigned v2u __attribute__((ext_vector_type(2)));
typedef float f32x4 __attribute__((ext_vector_type(4)));
typedef float f32x16 __attribute__((ext_vector_type(16)));
typedef short bf16x8 __attribute__((ext_vector_type(8)));
typedef GAS unsigned gu32;
#define RLX_AGENT __ATOMIC_RELAXED, __HIP_MEMORY_SCOPE_AGENT
#define LDS_WAIT() asm volatile("s_waitcnt lgkmcnt(0)" ::: "memory")
#define VM_WAIT() asm volatile("s_waitcnt vmcnt(0)" ::: "memory")
__device__ __forceinline__ unsigned f2bf(float f) { unsigned u = __builtin_bit_cast(unsigned, f); return (u + 0x7fffu + ((u >> 16) & 1u)) >> 16; }
__device__ __forceinline__ unsigned pk2(float lo, float hi) { return f2bf(lo) | (f2bf(hi) << 16); }
__device__ __forceinline__ float bf2f(unsigned short h) { return __builtin_bit_cast(float, (unsigned)h << 16); }
__device__ __forceinline__ float wave_sum(float v) {
#pragma unroll
    for (int o = 1; o < 64; o <<= 1) v += __shfl_xor(v, o);
    return v;
}
__device__ __forceinline__ float wave_max(float v) {
#pragma unroll
    for (int o = 1; o < 64; o <<= 1) v = fmaxf(v, __shfl_xor(v, o));
    return v;
}

#define XB_TMO      128
#define XB_XCNT(j)  (256  + 64 * (j))
#define XB_XSUB(j)  (1280 + 64 * (j))
#define XB_XGEN(j)  (2304 + 64 * (j))
#define XB_TOP      3328
#define XB_TOPGEN   3392
#define XCD_BAR_WORDS 3456
#define XB_SPIN_CAP (1u << 18)

__device__ __forceinline__ unsigned xb_ld(unsigned* p)              { return __hip_atomic_load(p, __ATOMIC_RELAXED, __HIP_MEMORY_SCOPE_AGENT); }
__device__ __forceinline__ unsigned xb_add(unsigned* p, unsigned v) { return __hip_atomic_fetch_add(p, v, __ATOMIC_RELAXED, __HIP_MEMORY_SCOPE_AGENT); }
__device__ __forceinline__ unsigned xb_xcc_id() { return (unsigned)__builtin_amdgcn_s_getreg((3 << 11) | 20) & 0xFu; }
#define XB_SPIN(cond, bar) do { unsigned _sp = 0; while (cond) { __builtin_amdgcn_s_sleep(1); \
    if ((++_sp & 255u) == 0u) { if (xb_ld(&(bar)[XB_TMO])) break; if (_sp > XB_SPIN_CAP) { atomicAdd(&(bar)[XB_TMO], 1u); break; } } } } while (0)

struct XcdBarrier {
    unsigned* bar; unsigned x;
    volatile LAS unsigned* st;
};

__device__ __forceinline__ XcdBarrier xcd_barrier_post(unsigned* bar, volatile LAS unsigned* st) {
    XcdBarrier b; b.bar = bar; b.x = xb_xcc_id(); b.st = st;
    if (threadIdx.x == 0) (void)xb_add(&bar[XB_XCNT(b.x)], 1u);
    return b;
}
__device__ __forceinline__ void xcd_barrier_complete(unsigned* bar, unsigned x, unsigned& nloc, unsigned& nx) {
    const unsigned G = gridDim.x * gridDim.y * gridDim.z;
    unsigned sum, cnt, mine, sp = 0u;
    for (;;) {
        sum = 0u; cnt = 0u; mine = 0u;
#pragma unroll
        for (unsigned j = 0; j < 16; ++j) { const unsigned c = xb_ld(&bar[XB_XCNT(j)]); sum += c; cnt += (c > 0u) ? 1u : 0u; mine = (j == x) ? c : mine; }
        if (sum == G) break;
        __builtin_amdgcn_s_sleep(1);
        if ((++sp & 255u) == 0u) { if (xb_ld(&bar[XB_TMO])) break; if (sp > XB_SPIN_CAP) { atomicAdd(&bar[XB_TMO], 1u); break; } }
    }
    nloc = mine > 0u ? mine : 1u; nx = cnt > 0u ? cnt : 1u;
}

__device__ __forceinline__ void xcd_barrier(const XcdBarrier& b) {
    asm volatile("s_waitcnt vmcnt(0)" ::: "memory");
    __syncthreads();
    if (threadIdx.x == 0) {
        unsigned* bar = b.bar;
        __builtin_amdgcn_s_waitcnt(0);
        unsigned nloc = b.st[0], nx = b.st[1];
        if (nloc == 0u) { xcd_barrier_complete(bar, b.x, nloc, nx); b.st[0] = nloc; b.st[1] = nx; }
        const unsigned old = xb_add(&bar[XB_XSUB(b.x)], 1u);
        const unsigned gen = old / nloc;
        if (old + 1u == (gen + 1u) * nloc) {
            __builtin_amdgcn_fence(__ATOMIC_RELEASE, "agent");
            asm volatile("s_waitcnt vmcnt(0)" ::: "memory");
            const unsigned og = xb_add(&bar[XB_TOP], 1u);
            const unsigned tg = og / nx;
            if (og + 1u == (tg + 1u) * nx) xb_add(&bar[XB_TOPGEN], 1u);
            else XB_SPIN(xb_ld(&bar[XB_TOPGEN]) == tg, bar);
            __builtin_amdgcn_fence(__ATOMIC_ACQUIRE, "agent");
            xb_add(&bar[XB_XGEN(b.x)], 1u);
            asm volatile("s_waitcnt vmcnt(0)" ::: "memory");
        } else {
            XB_SPIN(xb_ld(&bar[XB_TOPGEN]) == gen, bar);
            __builtin_amdgcn_fence(__ATOMIC_ACQUIRE, "agent");
            asm volatile("s_waitcnt vmcnt(0)" ::: "memory");
        }
    }
    __syncthreads();
}
__host__ __device__ __forceinline__ int r32map(int P) { return 16 * ((P >> 2) & 1) + 4 * (P >> 3) + (P & 3); }
__host__ __device__ __forceinline__ int p128(int x) { return (x & ~31) + r32map(x & 31); }
__host__ __device__ __forceinline__ int hdmap(int d) { if (d >= 16) return d; const int fq = (d >> 2) & 1, j = (d & 3) + 4 * (d >> 3); return 8 * fq + j; }
__host__ __device__ __forceinline__ int head_row(int wc, int d) { const int x = hdmap(d); return 128 * (x >> 5) + 32 * wc + r32map(x & 31); }
__device__ __forceinline__ int dstart(int bj, int fq, int half) { return (bj == 0 && fq < 2) ? 4 * fq + 8 * half : 32 * bj + 8 * fq + 4 * half; }

struct MapGate { __device__ __forceinline__ int operator()(int c) const { return 256 * (c >> 7) + p128(c & 127); } };
struct MapUp   { __device__ __forceinline__ int operator()(int c) const { return 256 * (c >> 7) + 128 + p128(c & 127); } };
struct MapLin  { __device__ __forceinline__ int operator()(int c) const { return (c & ~127) + p128(c & 127); } };
struct MapWin  { __device__ __forceinline__ int operator()(int c) const {
    if (c < 512) return 1024 + (c & ~127) + p128(c & 127);
    if (c < 1024) { const int ch = c - 512; return 256 * (ch >> 7) + p128(ch & 127); }
    if (c < 1536) { const int ch = c - 1024; return 256 * (ch >> 7) + 128 + p128(ch & 127); }
    if (c < 2048) { const int x = c - 1536, hd = x >> 6; return 256 * (6 + (hd >> 2)) + head_row(hd & 3, x & 63); }
    if (c < 2176) { const int x = c - 2048; return 256 * 8 + head_row(x >> 6, x & 63); }
    if (c < 2304) { const int x = c - 2176; return 256 * 8 + head_row(2 + (x >> 6), x & 63); }
    if (c < 2816) { const int x = c - 2304, hd = x >> 6; return 256 * (9 + (hd >> 2)) + head_row(hd & 3, x & 63); }
    if (c < 2880) return 256 * 11 + head_row(0, c - 2816);
    return 256 * 11 + 32 + r32map(c - 2880);
} };

using pg8::Unit; using pg8::bf16_t;
__device__ __forceinline__ float rstd_from(const float* ss, int row, int nslot) {
    float s = 0.f;
    if (nslot == 1) s = ss[row];
    else { const f32x4* p = (const f32x4*)(ss + (size_t)row * 16); const f32x4 a = p[0], b = p[1], c = p[2], d = p[3]; s = ((a.x + a.y) + (a.z + a.w)) + ((b.x + b.y) + (b.z + b.w)) + ((c.x + c.y) + (c.z + c.w)) + ((d.x + d.y) + (d.z + d.w)); }
    return __builtin_amdgcn_rsqf(s * (1.0f / D) + EPS);
}
__device__ __forceinline__ float clamp8(float x) { return __builtin_amdgcn_fmed3f(x, -440.0f, 440.0f); }
__device__ __forceinline__ unsigned pk4_fp8(float a, float b, float c, float d) { int w = __builtin_amdgcn_cvt_pk_fp8_f32(clamp8(a), clamp8(b), 0, false); w = __builtin_amdgcn_cvt_pk_fp8_f32(clamp8(c), clamp8(d), w, true); return (unsigned)w; }
#define EPI_CALL_ROWS() \
    __device__ __forceinline__ void operator()(f32x4 (&acc)[2][2][4][2], const Unit& u, int wr, int wc, int fr, int fq, int ui, bool has_next, const Unit& nxt) const { \
        _Pragma("unroll") for (int ai = 0; ai < 2; ++ai) _Pragma("unroll") for (int m = 0; m < 4; ++m) { \
            const f32x4 v[2][2] = {{acc[ai][0][m][0], acc[ai][0][m][1]}, {acc[ai][1][m][0], acc[ai][1][m][1]}}; \
            row(v, u.pm * 256 + ai * 128 + wr * 64 + m * 16 + fr, u.pn, wc, fr, fq, ui); \
            if (has_next) init_rg(acc, nxt, ai, m, wr, wc, fr, fq); } }                        \
    __device__ __forceinline__ void init(f32x4 (&acc)[2][2][4][2], const Unit& u, int wr, int wc, int fr, int fq) const { \
        _Pragma("unroll") for (int ai = 0; ai < 2; ++ai) _Pragma("unroll") for (int m = 0; m < 4; ++m) init_rg(acc, u, ai, m, wr, wc, fr, fq); }
#define EPI_ZERO_INIT() \
    __device__ __forceinline__ void init_rg(f32x4 (&acc)[2][2][4][2], const Unit&, int ai, int m, int, int, int, int) const { \
        _Pragma("unroll") for (int b = 0; b < 2; ++b) _Pragma("unroll") for (int n = 0; n < 2; ++n) acc[ai][b][m][n] = (f32x4){0.f, 0.f, 0.f, 0.f}; }
__device__ __forceinline__ float rstd_of(const LAS float* tab, const float* ss, int nslot, int row, int ui) { return (ui >= 0 && tab) ? tab[ui * 256 + (row & 255)] : rstd_from(ss, row, nslot); }
struct EpiGU {
    static constexpr bool PERM = false, AFTER_DRAIN = false;
    bf16_t* H; const float* ss; int nslot; const LAS float* tab; float wscale; unsigned char* H8; const float* wsn;
    __device__ __forceinline__ void row(const f32x4 (&v)[2][2], int row, int pn, int wc, int fr, int fq, int ui) const {
        typedef float f32x2 __attribute__((ext_vector_type(2)));
        const int col0 = pn * 128 + wc * 32 + 8 * fq;
        const float rs = rstd_of(tab, ss, nslot, row, ui) * (ui >= 0 ? wscale : 1.0f);
        const float c1 = -rs * LOG2E, rs2 = rs * rs;
        const bool f8 = H8 != nullptr;
        const float rs2s = f8 ? rs2 * H8SCALE : rs2;
        f32x2 hh[4];
#pragma unroll
        for (int n = 0; n < 2; ++n)
#pragma unroll
            for (int i = 0; i < 4; i += 2) { const f32x2 ag = {v[0][n][i], v[0][n][i + 1]}, au = {v[1][n][i], v[1][n][i + 1]};
                const f32x2 a = ag * c1; f32x2 e; e.x = __builtin_amdgcn_exp2f(a.x); e.y = __builtin_amdgcn_exp2f(a.y);
                const f32x2 d = e + 1.0f; f32x2 r; r.x = __builtin_amdgcn_rcpf(d.x); r.y = __builtin_amdgcn_rcpf(d.y);
                hh[2 * n + (i >> 1)] = (ag * au) * (r * rs2s); }
        if (f8) { v2u w8; w8.x = pk4_fp8(hh[0].x, hh[0].y, hh[1].x, hh[1].y); w8.y = pk4_fp8(hh[2].x, hh[2].y, hh[3].x, hh[3].y);
            *(v2u*)(H8 + (size_t)row * DFF + col0) = w8; }
        else { v4u w; w.x = pg8::cvt_pk_bf16(hh[0].x, hh[0].y); w.y = pg8::cvt_pk_bf16(hh[1].x, hh[1].y); w.z = pg8::cvt_pk_bf16(hh[2].x, hh[2].y); w.w = pg8::cvt_pk_bf16(hh[3].x, hh[3].y);
        __builtin_nontemporal_store(w, (v4u*)(H + (size_t)row * DFF + col0)); }
    }
    __device__ __forceinline__ void operator()(f32x4 (&acc)[2][2][4][2], const Unit& u, int wr, int wc, int fr, int fq, int ui, bool has_next, const Unit& nxt) const {
        typedef int v4i_ __attribute__((ext_vector_type(4)));
        f32x4 cs[2][2];
#pragma unroll
        for (int bj = 0; bj < 2; ++bj)
#pragma unroll
            for (int n = 0; n < 2; ++n) cs[bj][n] = wsn ? *(const f32x4*)(wsn + u.pn * 256 + bj * 128 + wc * 32 + n * 16 + 4 * fq) : (f32x4){1.f, 1.f, 1.f, 1.f};
#pragma unroll
        for (int ai = 0; ai < 2; ++ai)
#pragma unroll
            for (int m = 0; m < 4; ++m) {
                f32x4 v[2][2];
#pragma unroll
                for (int bj = 0; bj < 2; ++bj)
#pragma unroll
                    for (int n = 0; n < 2; ++n) v[bj][n] = wsn ? __builtin_convertvector(__builtin_bit_cast(v4i_, acc[ai][bj][m][n]), f32x4) * cs[bj][n] : acc[ai][bj][m][n];
                row(v, u.pm * 256 + ai * 128 + wr * 64 + m * 16 + fr, u.pn, wc, fr, fq, ui);
                if (has_next) init_rg(acc, nxt, ai, m, wr, wc, fr, fq); }
    }
    __device__ __forceinline__ void init(f32x4 (&acc)[2][2][4][2], const Unit& u, int wr, int wc, int fr, int fq) const {
#pragma unroll
        for (int ai = 0; ai < 2; ++ai)
#pragma unroll
            for (int m = 0; m < 4; ++m) init_rg(acc, u, ai, m, wr, wc, fr, fq); }
    EPI_ZERO_INIT()
};
__device__ __forceinline__ void bf8_to_f32(const v4u w, f32x4& lo, f32x4& hi) {
    lo = (f32x4){__uint_as_float(w.x << 16), __uint_as_float(w.x & 0xffff0000u), __uint_as_float(w.y << 16), __uint_as_float(w.y & 0xffff0000u)};
    hi = (f32x4){__uint_as_float(w.z << 16), __uint_as_float(w.z & 0xffff0000u), __uint_as_float(w.w << 16), __uint_as_float(w.w & 0xffff0000u)};
}
template <int MODE> struct EpiRes {
    static constexpr bool PERM = false, AFTER_DRAIN = false;
    const bf16_t* resb; float* out; bf16_t* outb; float* ss; unsigned char* out8; float ascale; const float* resf = nullptr; const float* resfs = nullptr;
    __device__ __forceinline__ void row(const f32x4 (&v)[2][2], int row, int pn, int wc, int fr, int fq, int ui) const {
        const bool pre = ui >= 0;
        const float alpha = ((MODE == 1) ? 1.0f : 0.5f) * (pre ? ascale : 1.0f);
        const bool live = row < MTOT;
        float sq = 0.f;
#pragma unroll
        for (int bj = 0; bj < 2; ++bj) {
            const int col = pn * 256 + bj * 128 + wc * 32 + 8 * fq;
            f32x4 r0 = (f32x4){0.f, 0.f, 0.f, 0.f}, r1 = r0;
            if (!pre && live) { if constexpr (MODE == 0) { r0 = *(const f32x4*)(resfs + (size_t)(row - MP) * D + col); r1 = *(const f32x4*)(resfs + (size_t)(row - MP) * D + col + 4); } else bf8_to_f32(*(const v4u*)(resb + (size_t)row * D + col), r0, r1); }
            const f32x4 v0 = r0 + alpha * v[bj][0], v1 = r1 + alpha * v[bj][1];
            if (MODE == 2) { if (live) { __builtin_nontemporal_store(v0, (f32x4*)(out + (size_t)row * D + col)); __builtin_nontemporal_store(v1, (f32x4*)(out + (size_t)row * D + col + 4)); } }
            else {
                v4u w; w.x = pg8::cvt_pk_bf16(v0[0], v0[1]); w.y = pg8::cvt_pk_bf16(v0[2], v0[3]); w.z = pg8::cvt_pk_bf16(v1[0], v1[1]); w.w = pg8::cvt_pk_bf16(v1[2], v1[3]);
                *(v4u*)(outb + (size_t)row * D + col) = w;
                if (MODE == 1 && out8) { v2u w8; w8.x = pk4_fp8(v0[0], v0[1], v0[2], v0[3]); w8.y = pk4_fp8(v1[0], v1[1], v1[2], v1[3]); *(v2u*)(out8 + (size_t)row * D + col) = w8; }
                sq += (v0[0] * v0[0] + v0[1] * v0[1]) + (v0[2] * v0[2] + v0[3] * v0[3]) + (v1[0] * v1[0] + v1[1] * v1[1]) + (v1[2] * v1[2] + v1[3] * v1[3]);
            }
        }
        if (MODE != 2) { sq += __shfl_xor(sq, 16); sq += __shfl_xor(sq, 32); if (fq == 0) ss[(size_t)row * 16 + pn * 4 + wc] = sq; }
    }
    EPI_CALL_ROWS()
    __device__ __forceinline__ void init_rg(f32x4 (&acc)[2][2][4][2], const Unit& u, int ai, int m, int wr, int wc, int fr, int fq) const {
        const float ia = ((MODE == 1) ? 1.0f : 2.0f) / ascale;
        const size_t ro = (size_t)(u.pm * 256 + ai * 128 + wr * 64 + m * 16 + fr) * D + u.pn * 256 + wc * 32 + 8 * fq;
#pragma unroll
        for (int bj = 0; bj < 2; ++bj) { f32x4 lo, hi;
            if constexpr (MODE == 0) { lo = *(const f32x4*)(resf + ro + bj * 128); hi = *(const f32x4*)(resf + ro + bj * 128 + 4); } else bf8_to_f32(*(const v4u*)(resb + ro + bj * 128), lo, hi);
            acc[ai][bj][m][0] = lo * ia; acc[ai][bj][m][1] = hi * ia; }
    }
};
struct EpiWin {
    static constexpr bool PERM = false, AFTER_DRAIN = false;
    unsigned char* ws; float* out; const float* qn; const float* kn; const LAS float* tab;
    __device__ __forceinline__ void row(const f32x4 (&acc)[2][2], int row, int pn, int wc, int fr, int fq, int ui) const {
        const float* ss = (const float*)(ws + WS_SS1); bf16_t* U = (bf16_t*)(ws + WS_U); bf16_t* GB = (bf16_t*)(ws + WS_GB); float* WI = (float*)(ws + WS_WI); const float* rope = (const float*)(ws + WS_ROPE);
        if (pn == 11 && wc >= 2) return;
        const int type = pn < 4 ? 0 : pn < 6 ? 1 : pn < 8 ? 2 : pn == 8 ? (wc < 2 ? 3 : 4) : pn < 11 ? 5 : (wc == 0 ? 6 : 7);
        const int head = (type == 2) ? 4 * (pn - 6) + wc : (type == 5) ? 4 * (pn - 9) + wc : (type == 3) ? wc : (type == 4) ? wc - 2 : 0;
        const bool live = row < MTOT;
        const float rs = rstd_of(tab, ss, 16, row, ui);
        if (type == 0) {
            const int ch0 = pn * 128 + wc * 32 + 8 * fq;
            const f32x4 u0 = (acc[0][0] * rs) * (acc[1][0] * rs), u1 = (acc[0][1] * rs) * (acc[1][1] * rs);
            v4u w; w.x = pg8::cvt_pk_bf16(u0[0], u0[1]); w.y = pg8::cvt_pk_bf16(u0[2], u0[3]); w.z = pg8::cvt_pk_bf16(u1[0], u1[1]); w.w = pg8::cvt_pk_bf16(u1[2], u1[3]);
            *(v4u*)(U + (size_t)row * 512 + ch0) = w;
            if (row < MP) { const int s = row & (SEQ - 1); if (s >= SEQ - 2) { float* o = out + O_CP + ((size_t)(row >> 11) * 2 + (s - (SEQ - 2))) * 512 + ch0; *(f32x4*)o = u0; *(f32x4*)(o + 4) = u1; } }
            else if (live) { const int sr = row - MP, s = sr & 3; if (s >= 2) { float* o = out + O_CS + ((size_t)(sr >> 2) * 2 + (s - 2)) * 512 + ch0; *(f32x4*)o = u0; *(f32x4*)(o + 4) = u1; } }
        } else if (type == 1) {
#pragma unroll
            for (int bj = 0; bj < 2; ++bj) { const int col = (pn - 4) * 256 + bj * 128 + wc * 32 + 8 * fq; const f32x4 a = acc[bj][0] * rs, b = acc[bj][1] * rs;
                v4u w; w.x = pg8::cvt_pk_bf16(a[0], a[1]); w.y = pg8::cvt_pk_bf16(a[2], a[3]); w.z = pg8::cvt_pk_bf16(b[0], b[1]); w.w = pg8::cvt_pk_bf16(b[2], b[3]);
                *(v4u*)(GB + (size_t)row * 512 + col) = w; }
        } else if (type == 7) {
            if (fq == 0) { *(f32x4*)(WI + (size_t)row * 8) = acc[0][0] * rs; *(f32x4*)(WI + (size_t)row * 8 + 4) = acc[0][1] * rs; }
        } else {
            f32x4 v[2][2];
#pragma unroll
            for (int bj = 0; bj < 2; ++bj) { v[bj][0] = acc[bj][0] * rs; v[bj][1] = acc[bj][1] * rs; }
            if (type == 2 || type == 3) {
                float sq = 0.f;
#pragma unroll
                for (int bj = 0; bj < 2; ++bj)
#pragma unroll
                    for (int h2 = 0; h2 < 2; ++h2) sq += (v[bj][h2][0] * v[bj][h2][0] + v[bj][h2][1] * v[bj][h2][1]) + (v[bj][h2][2] * v[bj][h2][2] + v[bj][h2][3] * v[bj][h2][3]);
                sq += __shfl_xor(sq, 16); sq += __shfl_xor(sq, 32);
                const float sc = __builtin_amdgcn_rsqf(sq * (1.0f / 64.0f) + EPS);
#pragma unroll
                for (int bj = 0; bj < 2; ++bj)
#pragma unroll
                    for (int h2 = 0; h2 < 2; ++h2) { const f32x4 gq = *(const f32x4*)(qn + dstart(bj, fq, h2)), gk = *(const f32x4*)(kn + dstart(bj, fq, h2)); v[bj][h2] = v[bj][h2] * sc * ((type == 2) ? gq : gk); }
            }
            if (type != 4 && fq < 2) {
                const int pidx = row < MP ? (row & (SEQ - 1)) : (live ? SEQ + ((row - MP) & 3) : 0);
                const float* rp = rope + ((size_t)pidx * 8 + 4 * fq) * 2;
                const f32x4 cs0 = *(const f32x4*)rp, cs1 = *(const f32x4*)(rp + 4);
                const f32x4 x1 = v[0][0], x2 = v[0][1];
                const f32x4 c = (f32x4){cs0[0], cs0[2], cs1[0], cs1[2]}, s = (f32x4){cs0[1], cs0[3], cs1[1], cs1[3]};
                v[0][0] = x1 * c - x2 * s; v[0][1] = x2 * c + x1 * s;
            }
            const size_t boff = (type == 2) ? WS_Q : (type == 3) ? WS_KB : (type == 4) ? WS_VB : (type == 5) ? WS_QI : WS_KIB;
            const int bp = (type == 2 || type == 5) ? 512 : (type == 6) ? 64 : 128; const float bsc = (type == 2) ? QSCALE : 1.0f;
            bf16_t* bdst = (bf16_t*)(ws + boff);
            const bool hasf = live && (type == 3 || type == 4 || type == 6);
            const size_t fbase = (type == 3) ? (row < MP ? O_KP : O_KS) : (type == 4) ? (row < MP ? O_VP : O_VS) : (row < MP ? O_IP : O_IS);
            float* fdst = out + fbase + (size_t)(row < MP ? row : row - MP) * (type == 6 ? 64 : 128);
#pragma unroll
            for (int bj = 0; bj < 2; ++bj)
#pragma unroll
                for (int h2 = 0; h2 < 2; ++h2) { const int d = head * 64 + dstart(bj, fq, h2); const f32x4 x = v[bj][h2];
                    if (hasf) { if (row < MP) __builtin_nontemporal_store(x, (f32x4*)(fdst + d)); else *(f32x4*)(fdst + d) = x; }
                    v2u w; w.x = pg8::cvt_pk_bf16(x[0] * bsc, x[1] * bsc); w.y = pg8::cvt_pk_bf16(x[2] * bsc, x[3] * bsc);
                    *(v2u*)(bdst + (size_t)row * bp + d) = w; }
        }
    }
    EPI_CALL_ROWS()
    EPI_ZERO_INIT()
};
template <class Epi, int MT, int QM> __device__ __forceinline__ void skinny_unit(PG8_LAS unsigned char* lds, const unsigned char* A, const unsigned char* Bt, int KB, int pn, int wc, int rg, const Epi& E,
                                                                                const float* xs, const float* wsn, float oscale) {
    typedef int v4i_ __attribute__((ext_vector_type(4)));
    const int tid = threadIdx.x, wid = __builtin_amdgcn_readfirstlane(tid >> 6), lane = tid & 63, fr = lane & 15, fq = lane >> 4;
    const int TP = KB >> 7, base = TP >> 3, rem = TP & 7;
    const int np = base + (wid < rem ? 1 : 0), p0 = wid * base + (wid < rem ? wid : rem);
    const unsigned char* ap = A + (size_t)(MP + 16 * MT * rg + fr) * KB + p0 * 128 + 16 * fq;
    const unsigned char* bp = Bt + (size_t)(256 * pn + 32 * wc + fr) * KB + p0 * 128 + 16 * fq;
    pg8::f32x4 acc[MT][2][2];
#pragma unroll
    for (int mt = 0; mt < MT; ++mt)
#pragma unroll
        for (int bj = 0; bj < 2; ++bj)
#pragma unroll
            for (int n = 0; n < 2; ++n) acc[mt][bj][n] = (pg8::f32x4){0.f, 0.f, 0.f, 0.f};
    v4i_ a0[MT], b0[2][2], a1[MT], b1[2][2], a2[MT], b2[2][2], a3[MT], b3[2][2];
#define SK_LOADP(afe, bfe, afo, bfo, p_) do { \
        _Pragma("unroll") for (int mt = 0; mt < MT; ++mt) { afe[mt] = *(const v4i_*)(ap + (size_t)(16 * mt) * KB + 128 * (p_)); afo[mt] = *(const v4i_*)(ap + (size_t)(16 * mt) * KB + 128 * (p_) + 64); } \
        _Pragma("unroll") for (int bj = 0; bj < 2; ++bj) _Pragma("unroll") for (int n = 0; n < 2; ++n) { bfe[bj][n] = *(const v4i_*)(bp + (size_t)(128 * bj + 16 * n) * KB + 128 * (p_)); bfo[bj][n] = *(const v4i_*)(bp + (size_t)(128 * bj + 16 * n) * KB + 128 * (p_) + 64); } } while (0)
#define SK_MMA(af, bf) do { _Pragma("unroll") for (int mt = 0; mt < MT; ++mt) _Pragma("unroll") for (int bj = 0; bj < 2; ++bj) _Pragma("unroll") for (int n = 0; n < 2; ++n) { \
        if constexpr (QM == 0) acc[mt][bj][n] = __builtin_amdgcn_mfma_f32_16x16x32_bf16(__builtin_bit_cast(pg8::bf16x8, bf[bj][n]), __builtin_bit_cast(pg8::bf16x8, af[mt]), acc[mt][bj][n], 0, 0, 0); \
        else if constexpr (QM == 2) acc[mt][bj][n] = __builtin_bit_cast(pg8::f32x4, __builtin_amdgcn_mfma_i32_16x16x64_i8(bf[bj][n], af[mt], __builtin_bit_cast(v4i_, acc[mt][bj][n]), 0, 0, 0)); \
        else { typedef long l2_ __attribute__((ext_vector_type(2))); const l2_ bl_ = __builtin_bit_cast(l2_, bf[bj][n]), al_ = __builtin_bit_cast(l2_, af[mt]); \
            acc[mt][bj][n] = __builtin_amdgcn_mfma_f32_16x16x32_fp8_fp8(bl_[0], al_[0], acc[mt][bj][n], 0, 0, 0); acc[mt][bj][n] = __builtin_amdgcn_mfma_f32_16x16x32_fp8_fp8(bl_[1], al_[1], acc[mt][bj][n], 0, 0, 0); } } } while (0)
    SK_LOADP(a0, b0, a1, b1, 0); if (np > 1) SK_LOADP(a2, b2, a3, b3, 1);
    for (int p = 0; p < np; p += 2) {
        SK_MMA(a0, b0); SK_MMA(a1, b1);
        if (p + 2 < np) SK_LOADP(a0, b0, a1, b1, p + 2);
        if (p + 1 < np) { SK_MMA(a2, b2); SK_MMA(a3, b3);
            if (p + 3 < np) SK_LOADP(a2, b2, a3, b3, p + 3); }
    }
#undef SK_LOADP
#undef SK_MMA
    PG8_LAS pg8::f32x4* slab = (PG8_LAS pg8::f32x4*)lds;
#pragma unroll
    for (int mt = 0; mt < MT; ++mt)
#pragma unroll
        for (int bj = 0; bj < 2; ++bj)
#pragma unroll
            for (int n = 0; n < 2; ++n) { pg8::f32x4 t = acc[mt][bj][n];
                if constexpr (QM == 2) { const v4i_ ti = __builtin_bit_cast(v4i_, t); t = (pg8::f32x4){(float)ti[0], (float)ti[1], (float)ti[2], (float)ti[3]}; }
                slab[((wid * MT + mt) * 4 + bj * 2 + n) * 64 + lane] = t; }
    __syncthreads();
    if (wid < MT) { pg8::f32x4 v[2][2]; const int row = MP + 16 * MT * rg + 16 * wid + fr;
      float rsc = oscale; if constexpr (QM == 2) rsc = xs[row];
#pragma unroll
      for (int bj = 0; bj < 2; ++bj)
#pragma unroll
          for (int n = 0; n < 2; ++n) { const int o = (wid * 4 + bj * 2 + n) * 64 + lane; pg8::f32x4 t = slab[o];
#pragma unroll
              for (int q = 1; q < 8; ++q) t = t + slab[o + q * MT * 4 * 64];
              if constexpr (QM == 2) t = t * (*(const pg8::f32x4*)(wsn + 256 * pn + 128 * bj + 32 * wc + 16 * n + 4 * fq)) * rsc;
              else if constexpr (QM == 1) t = t * rsc;
              v[bj][n] = t; }
      E.row(v, row, pn, wc, fr, fq, -1); }
    __syncthreads();
}
template <class Epi, int MT, int QM> __device__ __forceinline__ void skinny_phase(PG8_LAS unsigned char* lds, const void* A, const void* Bt, int N, int KB, int blk, int G, const Epi& E,
                                                                                 const float* xs = nullptr, const float* wsn = nullptr, float oscale = 1.0f) {
    constexpr int NRG = 8 / MT; const int nu = (N / 256) * 4 * NRG;
    for (int u = blk; u < nu; u += G) skinny_unit<Epi, MT, QM>(lds, (const unsigned char*)A, (const unsigned char*)Bt, KB, u / (4 * NRG), (u / NRG) & 3, u % NRG, E, xs, wsn, oscale);
}
__device__ __forceinline__ void fill_rstd_table(LAS float* tab, const pg8::StaticOrder& S, const float* ss, int nslot, const float* xs = nullptr) {
    const int tid = threadIdx.x; Unit u; int nu = 0;
    while (nu < 11 && S.next(nu, u)) ++nu;
    float sv[6], xsv[6]; int ix[6];
#pragma unroll
    for (int k2 = 0; k2 < 6; ++k2) { const int idx = tid + 512 * k2; ix[k2] = idx; const bool ok = idx < nu * 256; Unit uu_; S.next(ok ? (idx >> 8) : 0, uu_); const int row = uu_.pm * 256 + (idx & 255);
        float s_ = 0.f;
        if (nslot == 1) s_ = ss[row];
        else { const f32x4* p = (const f32x4*)(ss + (size_t)row * 16); const f32x4 a = p[0], b = p[1], c = p[2], d = p[3]; s_ = ((a.x + a.y) + (a.z + a.w)) + ((b.x + b.y) + (b.z + b.w)) + ((c.x + c.y) + (c.z + c.w)) + ((d.x + d.y) + (d.z + d.w)); }
        sv[k2] = s_; xsv[k2] = xs ? xs[row] : 1.0f; }
#pragma unroll
    for (int k2 = 0; k2 < 6; ++k2) if (ix[k2] < nu * 256) tab[ix[k2]] = __builtin_amdgcn_rsqf(sv[k2] * (1.0f / D) + EPS) * xsv[k2];
    __syncthreads();
}
__device__ __forceinline__ void quant_rows_pass(int gw, int NGW, const bf16_t* X, unsigned char* Q, float* XS, int nrows) {
    const int lane = threadIdx.x & 63;
    for (int g8 = gw; g8 < nrows / 8; g8 += NGW) {
        const int m0 = 8 * g8; v4u a[8][2];
#pragma unroll
        for (int r = 0; r < 8; ++r) { a[r][0] = *(const v4u*)(X + (size_t)(m0 + r) * D + 8 * lane); a[r][1] = *(const v4u*)(X + (size_t)(m0 + r) * D + 512 + 8 * lane); }
#pragma unroll
        for (int r = 0; r < 8; ++r) {
            float x[16];
#pragma unroll
            for (int e = 0; e < 4; ++e) { x[2 * e] = __uint_as_float(a[r][0][e] << 16); x[2 * e + 1] = __uint_as_float(a[r][0][e] & 0xffff0000u); x[8 + 2 * e] = __uint_as_float(a[r][1][e] << 16); x[9 + 2 * e] = __uint_as_float(a[r][1][e] & 0xffff0000u); }
            float mx = 0.f;
#pragma unroll
            for (int e = 0; e < 16; ++e) mx = fmaxf(mx, fabsf(x[e]));
            { unsigned v = __float_as_uint(mx), o;
              o = (unsigned)__builtin_amdgcn_update_dpp(0, (int)v, 0xB1, 0xF, 0xF, true); v = o > v ? o : v;
              o = (unsigned)__builtin_amdgcn_update_dpp(0, (int)v, 0x4E, 0xF, 0xF, true); v = o > v ? o : v;
              o = (unsigned)__builtin_amdgcn_update_dpp(0, (int)v, 0x141, 0xF, 0xF, true); v = o > v ? o : v;
              o = (unsigned)__builtin_amdgcn_update_dpp(0, (int)v, 0x140, 0xF, 0xF, true); v = o > v ? o : v;
              const unsigned p0 = (unsigned)__builtin_amdgcn_readlane((int)v, 0), p1 = (unsigned)__builtin_amdgcn_readlane((int)v, 16), p2 = (unsigned)__builtin_amdgcn_readlane((int)v, 32), p3 = (unsigned)__builtin_amdgcn_readlane((int)v, 48);
              const unsigned q0 = p0 > p1 ? p0 : p1, q1 = p2 > p3 ? p2 : p3; mx = __uint_as_float(q0 > q1 ? q0 : q1); }
            const float iq = mx > 0.f ? 127.0f / mx : 0.f;
            unsigned w[4];
#pragma unroll
            for (int e = 0; e < 4; ++e) { const int q0 = (int)__builtin_rintf(x[4 * e] * iq), q1 = (int)__builtin_rintf(x[4 * e + 1] * iq), q2 = (int)__builtin_rintf(x[4 * e + 2] * iq), q3 = (int)__builtin_rintf(x[4 * e + 3] * iq);
                w[e] = (unsigned)(q0 & 0xff) | ((unsigned)(q1 & 0xff) << 8) | ((unsigned)(q2 & 0xff) << 16) | ((unsigned)(q3 & 0xff) << 24); }
            *(v2u*)(Q + (size_t)(m0 + r) * D + 8 * lane) = (v2u){w[0], w[1]};
            *(v2u*)(Q + (size_t)(m0 + r) * D + 512 + 8 * lane) = (v2u){w[2], w[3]};
            if (lane == 0) XS[m0 + r] = mx * (1.0f / 127.0f);
        }
    }
}
struct Frame {
    LAS unsigned char* lds;
    volatile LAS unsigned* MISC;
    gu32* ctl;
    int tid, lane, wave, vcu, G;
    const void* const* in;
    float* out; unsigned char* ws;
};
#define WSP(T, off) ((T*)(F.ws + (off)))

template <class Map> __device__ __forceinline__ void p0_transpose_item(const float* W, int K, int N, const float* gain, bf16* WT, LAS float* scr, int item, int lane, const Map map, unsigned char* WT8 = nullptr) {
    const int nblk = (N + 31) / 32, kb = item / nblk, nb = item % nblk, k0 = 64 * kb, n0 = 32 * nb;
    const bool nok = n0 + (lane & 31) < N;
    { float v[32], gn[32];
#pragma unroll
      for (int i = 0; i < 32; ++i) { const int kk = 2 * i + (lane >> 5); v[i] = nok ? __builtin_nontemporal_load(W + (size_t)(k0 + kk) * N + n0 + (lane & 31)) : 0.f; gn[i] = gain ? gain[k0 + kk] : 1.0f; }
#pragma unroll
      for (int i = 0; i < 32; ++i) { const int kk = 2 * i + (lane >> 5); scr[kk * 33 + (lane & 31)] = v[i] * gn[i]; } }
    LDS_WAIT(); asm volatile("" ::: "memory");
    const int c = lane & 7;
#pragma unroll
    for (int j = 0; j < 4; ++j) { const int n = (lane >> 3) + 8 * j; const LAS float* s = scr + (8 * c) * 33 + n;
        v4u o; o.x = pk2(s[0 * 33], s[1 * 33]); o.y = pk2(s[2 * 33], s[3 * 33]); o.z = pk2(s[4 * 33], s[5 * 33]); o.w = pk2(s[6 * 33], s[7 * 33]);
        if (n0 + n < N) { if (WT) *(GAS v4u*)(WT + (size_t)map(n0 + n) * K + k0 + 8 * c) = o;
            if (WT8) { v2u o8; o8.x = pk4_fp8(s[0 * 33] * W8SCALE, s[1 * 33] * W8SCALE, s[2 * 33] * W8SCALE, s[3 * 33] * W8SCALE); o8.y = pk4_fp8(s[4 * 33] * W8SCALE, s[5 * 33] * W8SCALE, s[6 * 33] * W8SCALE, s[7 * 33] * W8SCALE);
                *(GAS v2u*)(WT8 + (size_t)map(n0 + n) * K + k0 + 8 * c) = o8; } } }
    LDS_WAIT(); asm volatile("" ::: "memory");
}
__device__ __forceinline__ void sincos_d(double a, float& s, float& c) {
    const double TWO_PI = 6.283185307179586476925286766559, PI = 3.14159265358979323846264338327950288;
    double k = __builtin_rint(a / TWO_PI); double r = a - k * TWO_PI;
    double sgn = 1.0; if (r > PI * 0.5) { r = PI - r; sgn = -1.0; } else if (r < -PI * 0.5) { r = -PI - r; sgn = -1.0; }
    const double r2 = r * r;
    double ts = 1.0, tc = 1.0, ps = 1.0, pc = 1.0;
#pragma unroll
    for (int n = 1; n <= 12; ++n) { pc = -pc * r2 / (double)((2 * n - 1) * (2 * n)); ps = -ps * r2 / (double)((2 * n) * (2 * n + 1)); tc += pc; ts += ps; }
    s = (float)(r * ts); c = (float)(sgn * tc);
}
__device__ __forceinline__ void p0_prologue(Frame& F) {
    LAS float* scr = (LAS float*)(F.lds + RING_OFF + F.wave * 16384);
    const int gw = F.vcu * 8 + F.wave, NGW = F.G * 8;
    constexpr int I_G = (D / 64) * (DFF / 32), I_D = (DFF / 64) * (D / 32), I_IN = (D / 64) * ((NIN + 31) / 32), I_O = (D / 64) * (D / 32);
    constexpr int NITEMS = 2 * (2 * I_G + I_D) + I_IN + I_O;
    for (int rep63 = 0; rep63 < (PROBE_DUP == 63 ? 2 : 1); ++rep63)
    for (int it = gw; it < NITEMS; it += NGW) {
        int r = it;
        if (r < I_G) { p0_transpose_item(((const float*)F.in[8]), D, DFF, ((const float*)F.in[7]), WSP(bf16, WS_WGU1), scr, r, F.lane, MapGate()); continue; } r -= I_G;
        if (r < I_G) { p0_transpose_item(((const float*)F.in[9]), D, DFF, ((const float*)F.in[7]), WSP(bf16, WS_WGU1), scr, r, F.lane, MapUp()); continue; } r -= I_G;
        if (r < I_D) { p0_transpose_item(((const float*)F.in[10]), DFF, D, nullptr, (bf16*)nullptr, scr, r, F.lane, MapLin(), WSP(unsigned char, WS_WD1_8)); continue; } r -= I_D;
        if (r < I_G) { p0_transpose_item(((const float*)F.in[19]), D, DFF, ((const float*)F.in[18]), WSP(bf16, WS_WGU2), scr, r, F.lane, MapGate()); continue; } r -= I_G;
        if (r < I_G) { p0_transpose_item(((const float*)F.in[20]), D, DFF, ((const float*)F.in[18]), WSP(bf16, WS_WGU2), scr, r, F.lane, MapUp()); continue; } r -= I_G;
        if (r < I_D) { p0_transpose_item(((const float*)F.in[21]), DFF, D, nullptr, (bf16*)nullptr, scr, r, F.lane, MapLin(), WSP(unsigned char, WS_WD2_8)); continue; } r -= I_D;
        if (r < I_IN) { p0_transpose_item(((const float*)F.in[12]), D, NIN, ((const float*)F.in[11]), WSP(bf16, WS_WIN), scr, r, F.lane, MapWin()); continue; } r -= I_IN;
        p0_transpose_item(((const float*)F.in[17]), D, D, nullptr, WSP(bf16, WS_WOUT), scr, r, F.lane, MapLin());
    }
    float* SS0 = WSP(float, WS_SS0);
    for (int rep64 = 0; rep64 < (PROBE_DUP == 64 ? 2 : 1); ++rep64)
    for (int g4 = gw; g4 < MTOT / 4; g4 += NGW) {
        const int m0 = 4 * g4;
        const float* xrow = m0 < MP ? ((const float*)F.in[0]) + (size_t)m0 * D : ((const float*)F.in[1]) + (size_t)(m0 - MP) * D;
        const GAS f32x4* xr = (const GAS f32x4*)xrow + F.lane;
        f32x4 v[4][4]; float s[4];
#pragma unroll
        for (int r = 0; r < 4; ++r)
#pragma unroll
            for (int j = 0; j < 4; ++j) v[r][j] = __builtin_nontemporal_load((const f32x4*)(xr + 256 * r + 64 * j));
#pragma unroll
        for (int r = 0; r < 4; ++r) { s[r] = 0.f;
#pragma unroll
            for (int j = 0; j < 4; ++j) s[r] += (v[r][j].x * v[r][j].x + v[r][j].y * v[r][j].y) + (v[r][j].z * v[r][j].z + v[r][j].w * v[r][j].w); }
#pragma unroll
        for (int o = 1; o < 64; o <<= 1) {
#pragma unroll
            for (int r = 0; r < 4; ++r) s[r] += __shfl_xor(s[r], o); }
        { float mx[4];
#pragma unroll
          for (int r = 0; r < 4; ++r) { mx[r] = 0.f;
#pragma unroll
              for (int j = 0; j < 4; ++j) mx[r] = fmaxf(mx[r], fmaxf(fmaxf(fabsf(v[r][j].x), fabsf(v[r][j].y)), fmaxf(fabsf(v[r][j].z), fabsf(v[r][j].w)))); }
#pragma unroll
          for (int o = 1; o < 64; o <<= 1) {
#pragma unroll
              for (int r = 0; r < 4; ++r) mx[r] = fmaxf(mx[r], __shfl_xor(mx[r], o)); }
          GAS unsigned* q8 = (GAS unsigned*)(WSP(unsigned char, WS_XI8) + (size_t)m0 * D) + F.lane;
#pragma unroll
          for (int r = 0; r < 4; ++r) { const float iq = mx[r] > 0.f ? 127.0f / mx[r] : 0.f;
#pragma unroll
              for (int j = 0; j < 4; ++j) { const int a_ = (int)__builtin_rintf(v[r][j].x * iq), b_ = (int)__builtin_rintf(v[r][j].y * iq), c_ = (int)__builtin_rintf(v[r][j].z * iq), d_ = (int)__builtin_rintf(v[r][j].w * iq);
                  q8[256 * r + 64 * j] = (unsigned)(a_ & 0xff) | ((unsigned)(b_ & 0xff) << 8) | ((unsigned)(c_ & 0xff) << 16) | ((unsigned)(d_ & 0xff) << 24); } }
          if (F.lane < 4) WSP(float, WS_XS)[m0 + F.lane] = (F.lane == 0 ? mx[0] : F.lane == 1 ? mx[1] : F.lane == 2 ? mx[2] : mx[3]) * (1.0f / 127.0f); }
        if (F.lane < 4) SS0[m0 + F.lane] = F.lane == 0 ? s[0] : F.lane == 1 ? s[1] : F.lane == 2 ? s[2] : s[3];
    }
    { float* rope = WSP(float, WS_ROPE);
      const double invf[8] = {1.0, 0.19392274474868576, 0.03760603093086393, 0.007292664737217109, 0.001414213562373095, 0.0002742481756762073, 5.318295896944988e-05, 1.031338537721246e-05};
      for (int rep65 = 0; rep65 < (PROBE_DUP == 65 ? 2 : 1); ++rep65)
      for (int e = (F.vcu * 512 + F.tid); e < 2052 * 8; e += F.G * 512) { const int p = e >> 3, i = e & 7; const double pos = (double)(p < SEQ ? p : PAST + (p - SEQ));
          double f = invf[0];
#pragma unroll
          for (int q = 1; q < 8; ++q) f = (i == q) ? invf[q] : f;
          float s, c; sincos_d(pos * f, s, c); rope[2 * e] = c; rope[2 * e + 1] = s; } }
}

__device__ __forceinline__ void unpack8(const v4u a, float (&o)[8]) {
#pragma unroll
    for (int e = 0; e < 4; ++e) { o[2 * e] = bf2f((unsigned short)(a[e] & 0xffffu)); o[2 * e + 1] = bf2f((unsigned short)(a[e] >> 16)); }
}
__device__ __forceinline__ void p0b_quant_weights(Frame& F) {
    const int gw = F.vcu * 8 + F.wave, NGW = F.G * 8;
    for (int rr0 = gw; rr0 < 4 * DFF; rr0 += 4 * NGW) {
        v4u a[4], b[4];
#pragma unroll
        for (int i = 0; i < 4; ++i) { const int rr = rr0 + i * NGW < 4 * DFF ? rr0 + i * NGW : rr0; const bool second = rr >= 2 * DFF; const int r = second ? rr - 2 * DFF : rr;
            const bf16* W = second ? WSP(bf16, WS_WGU2) : WSP(bf16, WS_WGU1);
            a[i] = *(const GAS v4u*)(W + (size_t)r * D + 8 * F.lane); b[i] = *(const GAS v4u*)(W + (size_t)r * D + 512 + 8 * F.lane); }
#pragma unroll
        for (int i = 0; i < 4; ++i) { const int rr = rr0 + i * NGW; if (rr >= 4 * DFF) break;
            const bool second = rr >= 2 * DFF; const int r = second ? rr - 2 * DFF : rr;
            unsigned char* Q = second ? WSP(unsigned char, WS_WGU2I8) : WSP(unsigned char, WS_WGU1I8); float* WSN = second ? WSP(float, WS_WSN2) : WSP(float, WS_WSN);
            float x[16]; { float t0[8], t1[8]; unpack8(a[i], t0); unpack8(b[i], t1);
#pragma unroll
                for (int e = 0; e < 8; ++e) { x[e] = t0[e]; x[8 + e] = t1[e]; } }
            float mx = 0.f;
#pragma unroll
            for (int e = 0; e < 16; ++e) mx = fmaxf(mx, fabsf(x[e]));
#pragma unroll
            for (int o = 1; o < 64; o <<= 1) mx = fmaxf(mx, __shfl_xor(mx, o));
            const float iq = mx > 0.f ? 127.0f / mx : 0.f;
            unsigned w[4];
#pragma unroll
            for (int e = 0; e < 4; ++e) { const int q0 = (int)__builtin_rintf(x[4 * e] * iq), q1 = (int)__builtin_rintf(x[4 * e + 1] * iq), q2 = (int)__builtin_rintf(x[4 * e + 2] * iq), q3 = (int)__builtin_rintf(x[4 * e + 3] * iq);
                w[e] = (unsigned)(q0 & 0xff) | ((unsigned)(q1 & 0xff) << 8) | ((unsigned)(q2 & 0xff) << 16) | ((unsigned)(q3 & 0xff) << 24); }
            *(GAS v2u*)(Q + (size_t)r * D + 8 * F.lane) = (v2u){w[0], w[1]};
            *(GAS v2u*)(Q + (size_t)r * D + 512 + 8 * F.lane) = (v2u){w[2], w[3]};
            if (F.lane == 0) WSN[r] = mx * (1.0f / 127.0f); }
    }
}
__device__ __forceinline__ void p4_conv(Frame& F) {
    const int gw = F.vcu * 8 + F.wave, NGW = F.G * 8, ch = F.lane * 8;
    const bf16* U = WSP(bf16, WS_U); const bf16* GBp = WSP(bf16, WS_GB); bf16* CAT = WSP(bf16, WS_CAT);
    const float* conv_w = (const float*)F.in[13]; const float* conv_b = (const float*)F.in[14]; const float* cache_conv = (const float*)F.in[5];
    float w0[8], w1[8], w2[8], cb[8];
#pragma unroll
    for (int e = 0; e < 8; ++e) { w0[e] = conv_w[ch + e]; w1[e] = conv_w[512 + ch + e]; w2[e] = conv_w[1024 + ch + e]; cb[e] = conv_b[ch + e]; }
    for (int c = gw; c < MTOT / 8; c += NGW) {
        const int r0 = 8 * c;
        v4u ur[10], gr[8];
#pragma unroll
        for (int e = 0; e < 10; ++e) { const int rr = r0 - 2 + e; ur[e] = *(const GAS v4u*)(U + (size_t)(rr < 0 ? 0 : rr) * 512 + ch); }
#pragma unroll
        for (int e = 0; e < 8; ++e) gr[e] = *(const GAS v4u*)(GBp + (size_t)(r0 + e) * 512 + ch);
        float um2[8], um1[8];
        unpack8(ur[0], um2); unpack8(ur[1], um1);
        if (r0 < MP && (r0 & (SEQ - 1)) == 0) {
#pragma unroll
            for (int e = 0; e < 8; ++e) { um2[e] = 0.f; um1[e] = 0.f; } }
#pragma unroll
        for (int e = 0; e < 8; ++e) {
            if (r0 >= MP && (e & 3) == 0) {
                const float* cc = cache_conv + (size_t)((r0 - MP + e) >> 2) * 2 * 512 + ch;
#pragma unroll
                for (int q = 0; q < 8; ++q) { um2[q] = cc[q]; um1[q] = cc[512 + q]; } }
            float u0[8], g[8], y[8]; unpack8(ur[2 + e], u0); unpack8(gr[e], g);
#pragma unroll
            for (int q = 0; q < 8; ++q) { y[q] = g[q] * (cb[q] + w0[q] * um2[q] + w1[q] * um1[q] + w2[q] * u0[q]); um2[q] = um1[q]; um1[q] = u0[q]; }
            v4u o; o.x = pk2(y[0], y[1]); o.y = pk2(y[2], y[3]); o.z = pk2(y[4], y[5]); o.w = pk2(y[6], y[7]);
            *(GAS v4u*)(CAT + (size_t)(r0 + e) * D + ch) = o;
        }
    }
}
__device__ __forceinline__ int crow16(int r, int hi) { return (r & 3) + 8 * (r >> 2) + 4 * hi; }
__device__ __forceinline__ float xhalf_sum(float v) {
    auto rr = __builtin_amdgcn_permlane32_swap(__float_as_uint(v), __float_as_uint(v), false, false);
    return __uint_as_float(rr[0]) + __uint_as_float(rr[1]);
}
__device__ __forceinline__ void p4_sample_scores(Frame& F) {
    const int gw = F.vcu * 8 + F.wave, NGW = F.G * 8, lane = F.lane, r32 = lane & 31, hi = lane >> 5;
    const bf16* QI = WSP(bf16, WS_QI); const float* WIp = WSP(float, WS_WI); float* SSC = WSP(float, WS_SSC);
    const int* page_table = (const int*)F.in[6]; const float* cache_idx_k = (const float*)F.in[4];
    for (int item = gw; item < DB * NPAGES; item += NGW) {
        const int b = item >> 7, pg = item & 127; const int page = page_table[b * NPAGES + pg];
        bf16x8 a[4]; f32x4 w4[4];
        { const bf16* qrow = QI + (size_t)(MP + 4 * b + (r32 >> 3)) * 512 + (r32 & 7) * 64 + 8 * hi;
#pragma unroll
          for (int s = 0; s < 4; ++s) a[s] = *(const GAS bf16x8*)(qrow + 16 * s);
#pragma unroll
          for (int q = 0; q < 4; ++q) w4[q] = *(const GAS f32x4*)(WIp + (size_t)(MP + 4 * b + q) * 8 + 4 * hi); }
        const float* src = cache_idx_k + ((size_t)page * PAGE + r32) * 64 + 8 * hi;
        f32x4 lo[4][4], hh[4][4];
#pragma unroll
        for (int sub = 0; sub < 4; ++sub)
#pragma unroll
            for (int s = 0; s < 4; ++s) { lo[sub][s] = __builtin_nontemporal_load((const f32x4*)(src + sub * 32 * 64 + 16 * s)); hh[sub][s] = __builtin_nontemporal_load((const f32x4*)(src + sub * 32 * 64 + 16 * s + 4)); }
#pragma unroll
        for (int sub = 0; sub < 4; ++sub) {
            f32x16 acc = {};
#pragma unroll
            for (int s = 0; s < 4; ++s) { v4u p; p.x = pk2(lo[sub][s][0], lo[sub][s][1]); p.y = pk2(lo[sub][s][2], lo[sub][s][3]); p.z = pk2(hh[sub][s][0], hh[sub][s][1]); p.w = pk2(hh[sub][s][2], hh[sub][s][3]);
                acc = __builtin_amdgcn_mfma_f32_32x32x16_bf16(a[s], __builtin_bit_cast(bf16x8, p), acc, 0, 0, 0); }
#pragma unroll
            for (int q = 0; q < 4; ++q) {
                float sum = w4[q][0] * fmaxf(acc[4 * q], 0.f) + w4[q][1] * fmaxf(acc[4 * q + 1], 0.f) + w4[q][2] * fmaxf(acc[4 * q + 2], 0.f) + w4[q][3] * fmaxf(acc[4 * q + 3], 0.f);
                sum = xhalf_sum(sum) + 0.0f;
                if ((q >> 1) == hi) SSC[(size_t)(4 * b + q) * SSTR + pg * PAGE + sub * 32 + r32] = sum;
            }
        }
    }
}
__device__ __forceinline__ unsigned fkey(float s) { const unsigned b = __builtin_bit_cast(unsigned, s); return b ^ ((unsigned)((int)b >> 31) | 0x80000000u); }
__device__ __forceinline__ float unfkey(unsigned k) { const unsigned b = (k & 0x80000000u) ? (k ^ 0x80000000u) : ~k; return __builtin_bit_cast(float, b); }
__device__ __forceinline__ unsigned wave_umax(unsigned v) {
    unsigned o;
    o = (unsigned)__builtin_amdgcn_update_dpp(0, (int)v, 0xB1, 0xF, 0xF, true); v = o > v ? o : v;
    o = (unsigned)__builtin_amdgcn_update_dpp(0, (int)v, 0x4E, 0xF, 0xF, true); v = o > v ? o : v;
    o = (unsigned)__builtin_amdgcn_update_dpp(0, (int)v, 0x141, 0xF, 0xF, true); v = o > v ? o : v;
    o = (unsigned)__builtin_amdgcn_update_dpp(0, (int)v, 0x140, 0xF, 0xF, true); v = o > v ? o : v;
    const unsigned a = (unsigned)__builtin_amdgcn_readlane((int)v, 0), b = (unsigned)__builtin_amdgcn_readlane((int)v, 16), c = (unsigned)__builtin_amdgcn_readlane((int)v, 32), d = (unsigned)__builtin_amdgcn_readlane((int)v, 48);
    const unsigned ab = a > b ? a : b, cd = c > d ? c : d; return ab > cd ? ab : cd;
}
__device__ __forceinline__ int wave_count(unsigned cl) {
    int tot = 0;
#pragma unroll
    for (int bb = 0; bb < 6; ++bb) tot += __popcll(__ballot((cl >> bb) & 1u)) << bb;
    return tot;
}
__device__ __forceinline__ void p4_index_preload(Frame& F, int b, int j, bf16x8 (&a)[4][4], float& pwq) {
    const int tid = F.tid, r32 = F.lane & 31, hi = F.lane >> 5; const size_t rowb = (size_t)b * SEQ; const int t0 = 16 * j;
    const bf16* QI = WSP(bf16, WS_QI); const float* WIp = WSP(float, WS_WI);
    pwq = WIp[(rowb + t0 + ((tid & 127) >> 3)) * 8 + (tid & 7)];
#pragma unroll
    for (int rt = 0; rt < 4; ++rt) { const bf16* qrow = QI + (rowb + t0 + 4 * rt + 2 * (r32 >> 4) + ((r32 >> 2) & 1)) * 512 + (4 * ((r32 >> 3) & 1) + (r32 & 3)) * 64 + 8 * hi;
#pragma unroll
        for (int s = 0; s < 4; ++s) a[rt][s] = *(const GAS bf16x8*)(qrow + 16 * s); }
}
__device__ __forceinline__ void p4_index_unit(Frame& F, int b, int j, int useq, bf16x8 (&a)[4][4], float& pwq, int nj) {
    int tid_ = F.tid; asm volatile("" : "+v"(tid_));
    const int tid = tid_, lane = tid & 63, wid = F.wave, r32 = lane & 31, hi = lane >> 5;
    const int ss_id = (F.vcu * 8 + useq) * 8 + wid, ss_item = ss_id >> 2, ss_sub = ss_id & 3, ss_b = ss_item >> 7, ss_pg = ss_item & 127;
    const bool ss_on = F.vcu < 256;
    const int ss_page = ss_on ? ((const int*)F.in[6])[ss_b * NPAGES + ss_pg] : 0;
    const int t0 = 16 * j, nk = t0 + 16, ntile = (nk + 31) >> 5;
    LAS float* S = (LAS float*)(F.lds + RING_OFF);
    LAS float* WQ = (LAS float*)(F.lds + RING_OFF + 131072);
    LAS unsigned long long* MSK = (LAS unsigned long long*)(F.lds + RING_OFF + 131072 + 512);
    LAS unsigned* HW = (LAS unsigned*)(F.lds + RING_OFF + 131072 + 512 + 4096) + wid * 512;
    const bf16* QI = WSP(bf16, WS_QI); const bf16* KIB = WSP(bf16, WS_KIB); const float* WIp = WSP(float, WS_WI);
    unsigned long long* MASK = WSP(unsigned long long, WS_MASK);
    const size_t rowb = (size_t)b * SEQ;
    for (int rep43 = 0; rep43 < (PROBE_DUP == 43 ? 2 : 1); ++rep43)
    if (j >= 16) {
        if (tid < 128) WQ[tid] = pwq;
        const bf16* kbase = KIB + (rowb + r32) * 64 + 8 * hi;
#define IDX_LOADB(dst, kt_) do { const int kc_ = (kt_) < ntile ? (kt_) : ntile - 1; _Pragma("unroll") for (int s = 0; s < 4; ++s) dst[s] = *(const GAS bf16x8*)(kbase + (size_t)kc_ * 32 * 64 + 16 * s); } while (0)
#define RELU_(x_) __builtin_amdgcn_fmed3f((x_), 0.f, inf_)
#define IDX_COMPUTE(bf_, kt_) do { const int key = (kt_) * 32 + r32; \
            _Pragma("unroll") for (int rt = 0; rt < 4; ++rt) { f32x16 acc = {}; \
                _Pragma("unroll") for (int s = 0; s < 4; ++s) acc = __builtin_amdgcn_mfma_f32_32x32x16_bf16(a[rt][s], bf_[s], acc, 0, 0, 0); \
                _Pragma("unroll") for (int qp = 0; qp < 2; ++qp) { const int ql_ = 4 * rt + 2 * qp + hi;                      \
                    const f32x4 wa = *(const LAS f32x4*)(WQ + ql_ * 8), wb = *(const LAS f32x4*)(WQ + ql_ * 8 + 4); \
                      \
                    float e0_ = RELU_(acc[8 * qp + 0]) * wa[0], e1_ = RELU_(acc[8 * qp + 1]) * wa[1]; \
                    e0_ = __builtin_fmaf(RELU_(acc[8 * qp + 2]), wa[2], e0_); e1_ = __builtin_fmaf(RELU_(acc[8 * qp + 3]), wa[3], e1_); \
                    e0_ = __builtin_fmaf(RELU_(acc[8 * qp + 4]), wb[0], e0_); e1_ = __builtin_fmaf(RELU_(acc[8 * qp + 5]), wb[1], e1_); \
                    e0_ = __builtin_fmaf(RELU_(acc[8 * qp + 6]), wb[2], e0_); e1_ = __builtin_fmaf(RELU_(acc[8 * qp + 7]), wb[3], e1_); \
                    S[ql_ * 2048 + key] = (e0_ + e1_) + 0.0f; } } } while (0)
        float inf_ = __builtin_inff(); asm volatile("" : "+v"(inf_));
        bf16x8 bfA[4], bfB[4];
        IDX_LOADB(bfA, wid);
        __syncthreads();
        for (int kt = wid; kt < ntile; kt += 16) {
            IDX_LOADB(bfB, kt + 8);
            IDX_COMPUTE(bfA, kt);
            if (kt + 8 < ntile) { IDX_LOADB(bfA, kt + 16); IDX_COMPUTE(bfB, kt + 8); }
        }
#undef IDX_LOADB
#undef IDX_COMPUTE
#undef RELU_
        __syncthreads();
    }
    f32x4 ss_lo[4], ss_hh[4];
    { const float* src = ((const float*)F.in[4]) + ((size_t)ss_page * PAGE + ss_sub * 32 + r32) * 64 + 8 * hi;
#pragma unroll
      for (int s = 0; s < 4; ++s) { ss_lo[s] = __builtin_nontemporal_load((const f32x4*)(src + 16 * s)); ss_hh[s] = __builtin_nontemporal_load((const f32x4*)(src + 16 * s + 4)); }
    }
#pragma unroll 1
    for (int rep44 = 0; rep44 < (PROBE_DUP == 44 ? 2 : 1); ++rep44) {
        const int qlA = 2 * wid, tA = t0 + qlA, tB = tA + 1;
        unsigned wloA = 0u, whiA = 0u, wloB = 0u, whiB = 0u;
        if (tA < KTOP) {
            const int lo_ = 64 * lane;
            const unsigned long long wA_ = (lo_ + 63 <= tA) ? ~0ull : (lo_ > tA ? 0ull : ((1ull << (tA - lo_ + 1)) - 1ull)), wB_ = (lo_ + 63 <= tB) ? ~0ull : (lo_ > tB ? 0ull : ((1ull << (tB - lo_ + 1)) - 1ull));
            wloA = (unsigned)wA_; whiA = (unsigned)(wA_ >> 32); wloB = (unsigned)wB_; whiB = (unsigned)(wB_ >> 32);
        } else {
            bool doneA = false, doneB = false;
            { unsigned kvA[32], kvB[32]; float amA = 0.f, amB = 0.f;
              const int ngr = (tA >> 8) + 1;
#pragma unroll
              for (int g4 = 0; g4 < 8; ++g4) {
#pragma unroll
                  for (int e = 0; e < 4; ++e) { kvA[4 * g4 + e] = 0u; kvB[4 * g4 + e] = 0u; }
                  if (g4 < ngr) {
                      float sA[4], sB[4];
#pragma unroll
                      for (int e = 0; e < 4; ++e) { sA[e] = S[qlA * 2048 + lane + 64 * (4 * g4 + e)]; sB[e] = S[qlA * 2048 + 2048 + lane + 64 * (4 * g4 + e)]; }
                      if (g4 == ngr - 1) {
#pragma unroll
                          for (int e = 0; e < 4; ++e) { const int ki = lane + 64 * (4 * g4 + e); sA[e] = (ki <= tA) ? sA[e] : 0.f; sB[e] = (ki <= tB) ? sB[e] : 0.f; } }
#pragma unroll
                      for (int e = 0; e < 4; ++e) { kvA[4 * g4 + e] = __float_as_uint(sA[e]); amA = fmaxf(amA, fabsf(sA[e])); kvB[4 * g4 + e] = __float_as_uint(sB[e]); amB = fmaxf(amB, fabsf(sB[e])); } } }
              const unsigned umA = wave_umax(__float_as_uint(amA)), umB = wave_umax(__float_as_uint(amB));
              const float scaleA = umA ? 0.4999f / __uint_as_float(umA) : 0.f, scaleB = umB ? 0.4999f / __uint_as_float(umB) : 0.f;
#pragma unroll
              for (int g4 = 0; g4 < 8; ++g4) if (g4 < ngr) {
#pragma unroll
                  for (int e = 0; e < 4; ++e) { const int jj = 4 * g4 + e; kvA[jj] = __float_as_uint(__builtin_fmaf(__uint_as_float(kvA[jj]), scaleA, 1.5f)); kvB[jj] = __float_as_uint(__builtin_fmaf(__uint_as_float(kvB[jj]), scaleB, 1.5f)); }
                  if (g4 == ngr - 1) {
#pragma unroll
                      for (int e = 0; e < 4; ++e) { const int jj = 4 * g4 + e; kvA[jj] = (lane + 64 * jj <= tA) ? kvA[jj] : 0u; kvB[jj] = (lane + 64 * jj <= tB) ? kvB[jj] : 0u; } } }
              unsigned pfxA = 0x3F800000u, pfxB = 0x3F800000u, TvA = 0u, TvB = 0u; int needA = KTOP, needB = KTOP;
              const unsigned hwbA = (unsigned)(uintptr_t)HW, hwbB = hwbA + 1024u;
              LAS unsigned* HWB = HW + 256;
#pragma unroll 1
              for (int pass = 0; pass < 3; ++pass) {
                  const int sh = pass == 0 ? 15 : pass == 1 ? 7 : 0;
                  const unsigned lim = pass == 2 ? 128u : (256u << sh);
                  const unsigned limA = doneA ? 0u : lim, limB = doneB ? 0u : lim;
                  *(LAS v4u*)(HW + 4 * lane) = (v4u){0u, 0u, 0u, 0u}; *(LAS v4u*)(HWB + 4 * lane) = (v4u){0u, 0u, 0u, 0u};
                  asm volatile("" ::: "memory");
#pragma unroll
                  for (int g4 = 0; g4 < 8; ++g4) if (g4 < ngr) {
#pragma unroll
                      for (int e = 0; e < 4; ++e) { const unsigned dA_ = kvA[4 * g4 + e] ^ pfxA, dB_ = kvB[4 * g4 + e] ^ pfxB;
                          if (dA_ < limA) __hip_atomic_fetch_add((LAS unsigned*)(uintptr_t)(hwbA + ((dA_ >> sh) << 2)), 1u, __ATOMIC_RELAXED, __HIP_MEMORY_SCOPE_WAVEFRONT);
                          if (dB_ < limB) __hip_atomic_fetch_add((LAS unsigned*)(uintptr_t)(hwbB + ((dB_ >> sh) << 2)), 1u, __ATOMIC_RELAXED, __HIP_MEMORY_SCOPE_WAVEFRONT); } }
                  asm volatile("" ::: "memory");
                  const v4u wA4 = *(const LAS v4u*)(HW + 4 * lane), wB4 = *(const LAS v4u*)(HWB + 4 * lane);
                  asm volatile("" ::: "memory");
#define SEL_SCAN(w4_, need_, HWX_, dgb_, above_, binc_) do { \
                      const unsigned ls_ = (w4_[0] + w4_[1]) + (w4_[2] + w4_[3]); unsigned p_ = ls_; \
                      p_ += (unsigned)__builtin_amdgcn_update_dpp(0, (int)p_, 0x111, 0xF, 0xF, false); p_ += (unsigned)__builtin_amdgcn_update_dpp(0, (int)p_, 0x112, 0xF, 0xF, false); \
                      p_ += (unsigned)__builtin_amdgcn_update_dpp(0, (int)p_, 0x114, 0xF, 0xF, false); p_ += (unsigned)__builtin_amdgcn_update_dpp(0, (int)p_, 0x118, 0xF, 0xF, false); \
                      const unsigned r0_ = (unsigned)__builtin_amdgcn_readlane((int)p_, 15), r1_ = (unsigned)__builtin_amdgcn_readlane((int)p_, 31), r2_ = (unsigned)__builtin_amdgcn_readlane((int)p_, 47), r3_ = (unsigned)__builtin_amdgcn_readlane((int)p_, 63); \
                      const int row_ = lane >> 4; p_ += (row_ == 0) ? 0u : (row_ == 1) ? r0_ : (row_ == 2) ? r0_ + r1_ : r0_ + r1_ + r2_; \
                      const unsigned abl_ = (r0_ + r1_ + r2_ + r3_) - p_;                                    \
                      const unsigned long long fm_ = __ballot((int)abl_ < (need_) && (int)(abl_ + ls_) >= (need_)); \
                      const int src_ = (int)__builtin_ctzll(fm_) & 63; \
                      const unsigned abs_ = (unsigned)__builtin_amdgcn_readlane((int)abl_, src_); \
                      const unsigned ci_ = ((lane & 15) < 4) ? (HWX_)[4 * src_ + (lane & 3)] : 0u;          \
                      unsigned sfx_ = ci_; \
                      sfx_ += (unsigned)__builtin_amdgcn_update_dpp(0, (int)sfx_, 0x101, 0xF, 0xF, false); sfx_ += (unsigned)__builtin_amdgcn_update_dpp(0, (int)sfx_, 0x102, 0xF, 0xF, false); \
                      const unsigned abi_ = abs_ + sfx_ - ci_;                                                \
                      const unsigned long long fb_ = __ballot(lane < 4 && (int)abi_ < (need_) && (int)(abi_ + ci_) >= (need_)); \
                      const int sl2_ = (int)__builtin_ctzll(fb_) & 63; \
                      dgb_ = (unsigned)(4 * src_ + sl2_); above_ = (unsigned)__builtin_amdgcn_readlane((int)abi_, sl2_); binc_ = (unsigned)__builtin_amdgcn_readlane((int)ci_, sl2_); } while (0)
                  unsigned dgA, abvA, bcA, dgB, abvB, bcB;
                  SEL_SCAN(wA4, needA, HW, dgA, abvA, bcA);
                  SEL_SCAN(wB4, needB, HWB, dgB, abvB, bcB);
#undef SEL_SCAN
                  if (!doneA) { pfxA |= dgA << sh; needA -= (int)abvA; TvA = pfxA; doneA = ((int)bcA == needA); }
                  if (!doneB) { pfxB |= dgB << sh; needB -= (int)abvB; TvB = pfxB; doneB = ((int)bcB == needB); }
                  if (doneA && doneB) break;
              }
#define SEL_MASK(kv_, Tv_, wlo_, whi_) do { _Pragma("unroll") for (int j4 = 0; j4 < 8; ++j4) if (j4 < ngr) { \
                      const unsigned long long wa = __ballot(kv_[4 * j4] >= Tv_), wb = __ballot(kv_[4 * j4 + 1] >= Tv_), wc_ = __ballot(kv_[4 * j4 + 2] >= Tv_), wd = __ballot(kv_[4 * j4 + 3] >= Tv_); \
                      asm("s_nop 1\n\tv_writelane_b32 %0, %2, %10\n\tv_writelane_b32 %1, %3, %10\n\tv_writelane_b32 %0, %4, %11\n\tv_writelane_b32 %1, %5, %11\n\tv_writelane_b32 %0, %6, %12\n\tv_writelane_b32 %1, %7, %12\n\tv_writelane_b32 %0, %8, %13\n\tv_writelane_b32 %1, %9, %13" \
                          : "+v"(wlo_), "+v"(whi_) : "s"((unsigned)wa), "s"((unsigned)(wa >> 32)), "s"((unsigned)wb), "s"((unsigned)(wb >> 32)), "s"((unsigned)wc_), "s"((unsigned)(wc_ >> 32)), "s"((unsigned)wd), "s"((unsigned)(wd >> 32)), \
                            "n"(4 * j4), "n"(4 * j4 + 1), "n"(4 * j4 + 2), "n"(4 * j4 + 3)); } } while (0)
              if (doneA) SEL_MASK(kvA, TvA, wloA, whiA);
              if (doneB) SEL_MASK(kvB, TvB, wloB, whiB);
#undef SEL_MASK
            }
#pragma unroll 1
            for (int q2 = 0; q2 < 2; ++q2) {
            if (q2 == 0 ? doneA : doneB) continue;
            const int ql = qlA + q2, t = tA + q2; unsigned wlo = 0u, whi = 0u;
            unsigned uu[32];
#pragma unroll
            for (int jj = 0; jj < 32; ++jj) { const float s = S[ql * 2048 + lane + 64 * jj]; const unsigned k_ = fkey(s); uu[jj] = (lane + 64 * jj <= t) ? k_ : 0u; }
            const int ng = (t >> 8) + 1;
#define SEL_GRP(g4, CAND) if ((g4) < ng) { unsigned long long m0_, m1_, m2_, m3_; \
                    asm volatile("v_cmp_ge_u32_e64 %0, %4, %8\n\tv_cmp_ge_u32_e64 %1, %5, %8\n\tv_cmp_ge_u32_e64 %2, %6, %8\n\tv_cmp_ge_u32_e64 %3, %7, %8" \
                        : "=&s"(m0_), "=&s"(m1_), "=&s"(m2_), "=&s"(m3_) : "v"(uu[4 * (g4)]), "v"(uu[4 * (g4) + 1]), "v"(uu[4 * (g4) + 2]), "v"(uu[4 * (g4) + 3]), "v"(CAND)); \
                    cnt_ += __popcll(m0_) + __popcll(m1_) + __popcll(m2_) + __popcll(m3_); }
#define SEL_COUNT(CAND, OUT) do { int cnt_ = 0; SEL_GRP(0, CAND) SEL_GRP(1, CAND) SEL_GRP(2, CAND) SEL_GRP(3, CAND) SEL_GRP(4, CAND) SEL_GRP(5, CAND) SEL_GRP(6, CAND) SEL_GRP(7, CAND) OUT = cnt_; } while (0)
            unsigned T = 0u; int clo = t + 1;
#pragma unroll 1
            for (int bit = 31; bit >= 0; --bit) {
                const unsigned cand = T | (1u << bit); int c; SEL_COUNT(cand, c);
                if (c >= KTOP) { T = cand; clo = c; if (c == KTOP) break; }
            }
            if (clo == KTOP) {
#pragma unroll
                for (int jj = 0; jj < 32; ++jj) { const unsigned long long word = __ballot(uu[jj] >= T);
                    asm("s_nop 1\n\tv_writelane_b32 %0, %2, %4\n\tv_writelane_b32 %1, %3, %4" : "+v"(wlo), "+v"(whi) : "s"((unsigned)word), "s"((unsigned)(word >> 32)), "n"(jj));     }
            } else {
                int cgt; { const unsigned Tp = T + 1u; SEL_COUNT(Tp, cgt); }
                const int need = KTOP - cgt; int running = 0;
#pragma unroll
                for (int jj = 0; jj < 32; ++jj) {
                    const unsigned long long eq = __ballot(uu[jj] == T);
                    const int rank = (int)__builtin_amdgcn_mbcnt_hi((unsigned)(eq >> 32), __builtin_amdgcn_mbcnt_lo((unsigned)eq, 0u));
                    const unsigned long long word = __ballot(uu[jj] > T || (uu[jj] == T && running + rank < need));
                    asm("s_nop 1\n\tv_writelane_b32 %0, %2, %4\n\tv_writelane_b32 %1, %3, %4" : "+v"(wlo), "+v"(whi) : "s"((unsigned)word), "s"((unsigned)(word >> 32)), "n"(jj));
                    running += __popcll(eq);
                }
            }
            if (q2 == 0) { wloA = wlo; whiA = whi; } else { wloB = wlo; whiB = whi; }
            }
#undef SEL_COUNT
#undef SEL_GRP
        }
        if (lane < 32) { MSK[qlA * 32 + lane] = ((unsigned long long)whiA << 32) | wloA; MSK[qlA * 32 + 32 + lane] = ((unsigned long long)whiB << 32) | wloB; }
    }
    bf16x8 ss_a[4]; f32x4 ss_w[4];
    { const bf16* qrow = QI + (size_t)(MP + 4 * ss_b + (r32 >> 3)) * 512 + (r32 & 7) * 64 + 8 * hi;
#pragma unroll
      for (int s = 0; s < 4; ++s) ss_a[s] = *(const GAS bf16x8*)(qrow + 16 * s);
#pragma unroll
      for (int q = 0; q < 4; ++q) ss_w[q] = *(const GAS f32x4*)(WIp + (size_t)(MP + 4 * ss_b + q) * 8 + 4 * hi); }
    if (nj >= 16) p4_index_preload(F, b, nj, a, pwq);
    __syncthreads();
    { const int jt = tid >> 4, ql = tid & 15; MASK[((size_t)b * 32 + jt) * SEQ + t0 + ql] = MSK[ql * 32 + jt]; }
    if (ss_on) { f32x16 acc = {};
#pragma unroll
        for (int s = 0; s < 4; ++s) { v4u p; p.x = pk2(ss_lo[s][0], ss_lo[s][1]); p.y = pk2(ss_lo[s][2], ss_lo[s][3]); p.z = pk2(ss_hh[s][0], ss_hh[s][1]); p.w = pk2(ss_hh[s][2], ss_hh[s][3]);
            acc = __builtin_amdgcn_mfma_f32_32x32x16_bf16(ss_a[s], __builtin_bit_cast(bf16x8, p), acc, 0, 0, 0); }
        float* SSC = WSP(float, WS_SSC);
#pragma unroll
        for (int q = 0; q < 4; ++q) {
            float sum = ss_w[q][0] * fmaxf(acc[4 * q], 0.f) + ss_w[q][1] * fmaxf(acc[4 * q + 1], 0.f) + ss_w[q][2] * fmaxf(acc[4 * q + 2], 0.f) + ss_w[q][3] * fmaxf(acc[4 * q + 3], 0.f);
            sum = xhalf_sum(sum) + 0.0f;
            if ((q >> 1) == hi) SSC[(size_t)(4 * ss_b + q) * SSTR + ss_pg * PAGE + ss_sub * 32 + r32] = sum;
        } }
    __syncthreads();
}
__device__ __forceinline__ void p4_index(Frame& F) {
    if (F.vcu >= 256) return;
    const int b = F.vcu >> 4, w = F.vcu & 15;
    bf16x8 pa[4][4]; float pwq;
    p4_index_preload(F, b, 127 - w, pa, pwq);
#pragma unroll 1
    for (int k = 0; k < 4; ++k) { const int j1 = w + 16 * k; p4_index_unit(F, b, 127 - j1, 2 * k, pa, pwq, j1); p4_index_unit(F, b, j1, 2 * k + 1, pa, pwq, k < 3 ? 127 - (j1 + 16) : -1); }
}

__device__ __forceinline__ void sel_scan256(const v4u w4, int need, const LAS unsigned* tab, int lane, unsigned& dgb, unsigned& above, unsigned& binc) {
    const unsigned ls = (w4[0] + w4[1]) + (w4[2] + w4[3]); unsigned p = ls;
    p += (unsigned)__builtin_amdgcn_update_dpp(0, (int)p, 0x111, 0xF, 0xF, false); p += (unsigned)__builtin_amdgcn_update_dpp(0, (int)p, 0x112, 0xF, 0xF, false);
    p += (unsigned)__builtin_amdgcn_update_dpp(0, (int)p, 0x114, 0xF, 0xF, false); p += (unsigned)__builtin_amdgcn_update_dpp(0, (int)p, 0x118, 0xF, 0xF, false);
    const unsigned r0 = (unsigned)__builtin_amdgcn_readlane((int)p, 15), r1 = (unsigned)__builtin_amdgcn_readlane((int)p, 31), r2 = (unsigned)__builtin_amdgcn_readlane((int)p, 47), r3 = (unsigned)__builtin_amdgcn_readlane((int)p, 63);
    const int row_ = lane >> 4; p += (row_ == 0) ? 0u : (row_ == 1) ? r0 : (row_ == 2) ? r0 + r1 : r0 + r1 + r2;
    const unsigned abl = (r0 + r1 + r2 + r3) - p;
    const unsigned long long fm = __ballot((int)abl < need && (int)(abl + ls) >= need);
    const int src = (int)__builtin_ctzll(fm) & 63;
    const unsigned abs_ = (unsigned)__builtin_amdgcn_readlane((int)abl, src);
    const unsigned ci = ((lane & 15) < 4) ? tab[4 * src + (lane & 3)] : 0u;
    unsigned sfx = ci;
    sfx += (unsigned)__builtin_amdgcn_update_dpp(0, (int)sfx, 0x101, 0xF, 0xF, false); sfx += (unsigned)__builtin_amdgcn_update_dpp(0, (int)sfx, 0x102, 0xF, 0xF, false);
    const unsigned abi = abs_ + sfx - ci;
    const unsigned long long fb = __ballot(lane < 4 && (int)abi < need && (int)(abi + ci) >= need);
    const int sl2 = (int)__builtin_ctzll(fb) & 63;
    dgb = (unsigned)(4 * src + sl2); above = (unsigned)__builtin_amdgcn_readlane((int)abi, sl2); binc = (unsigned)__builtin_amdgcn_readlane((int)ci, sl2);
}
__device__ __forceinline__ int block_sum8(LAS int* red, int par, int wid, int lane, int v) {
    if (lane == 0) red[par * 8 + wid] = v;
    __syncthreads();
    int s = 0;
#pragma unroll
    for (int w = 0; w < 8; ++w) s += red[par * 8 + w];
    return s;
}
__device__ __forceinline__ void p5_sample_unit(Frame& F, int sq) {
    const int tid = F.tid, lane = F.lane, wid = F.wave;
    const int b = sq >> 2, qi_ = sq & 3, row = MP + sq;
    LAS unsigned char* L0 = F.lds + RING_OFF;
    LAS int* red = (LAS int*)(L0);
    LAS float* newsc = (LAS float*)(L0 + 64);
    LAS int* wcnt = (LAS int*)(L0 + 128);
    LAS int* eqw = (LAS int*)(L0 + 256);
    LAS int* selidx = (LAS int*)(L0 + 2048);
    LAS float* LG = (LAS float*)(L0 + 4096);
    LAS float* OP = (LAS float*)(L0 + 16384);
    const bf16* QI = WSP(bf16, WS_QI); const bf16* KIB = WSP(bf16, WS_KIB); const float* WIp = WSP(float, WS_WI); const float* SSC = WSP(float, WS_SSC);
    const bf16* Qb = WSP(bf16, WS_Q); bf16* CAT = WSP(bf16, WS_CAT);
    for (int rep56 = 0; rep56 < (PROBE_DUP == 56 ? 2 : 1); ++rep56) {
    if (tid < 64) {
        const int h = (tid >> 2) & 7, jn = tid & 3; float dot = 0.f;
        const bf16* qp = QI + (size_t)row * 512 + h * 64; const bf16* kp = KIB + (size_t)(MP + 4 * b + jn) * 64;
        for (int d = 0; d < 64; ++d) dot += bf2f(qp[d]) * bf2f(kp[d]);
        float v = WIp[(size_t)row * 8 + h] * fmaxf(dot, 0.f);
        v += __shfl_xor(v, 4); v += __shfl_xor(v, 8); v += __shfl_xor(v, 16);
        if (tid < 4) newsc[tid] = (jn <= qi_) ? (v + 0.0f) : -INFINITY;
    }
    __syncthreads();
    unsigned uu[33];
#pragma unroll
    for (int jj = 0; jj < 32; ++jj) uu[jj] = fkey(SSC[(size_t)sq * SSTR + tid + 512 * jj]);
    uu[32] = tid < 4 ? fkey(newsc[tid]) : 0x007FFFFFu;
    unsigned T = 0u; int par = 0; bool fast = false;
    { LAS unsigned* RT = (LAS unsigned*)(L0 + 32768);
      LAS unsigned* RX = (LAS unsigned*)(L0 + 1536);
      RT[tid] = 0u; if (tid < 256) RT[512 + tid] = 0u;
      float am = 0.f; unsigned fin = 0u;
#pragma unroll
      for (int jj = 0; jj < 33; ++jj) { const float a_ = fabsf(unfkey(uu[jj])); const bool f_ = a_ < INFINITY; am = fmaxf(am, f_ ? a_ : 0.f); }
      { const unsigned um = wave_umax(__float_as_uint(am)); if (lane == 0) RX[wid] = um; }
      __syncthreads();
      unsigned bm = 0u;
#pragma unroll
      for (int w = 0; w < 8; ++w) { const unsigned x_ = RX[w]; bm = x_ > bm ? x_ : bm; }
      const float scale = bm ? 0.4999f / __uint_as_float(bm) : 0.f;
      unsigned iv[33];
#pragma unroll
      for (int jj = 0; jj < 33; ++jj) { const float s_ = unfkey(uu[jj]); iv[jj] = (fabsf(s_) < INFINITY) ? __float_as_uint(__builtin_fmaf(s_, scale, 1.5f)) : 0u; }
      unsigned pfx = 0x3F800000u; int need = KTOP; bool done = false;
#pragma unroll 1
      for (int pass = 0; pass < 3; ++pass) {
          const int sh = pass == 0 ? 15 : pass == 1 ? 7 : 0; const unsigned lim = pass == 2 ? 128u : (256u << sh);
          LAS unsigned* tab = RT + 256 * pass;
#pragma unroll
          for (int jj = 0; jj < 33; ++jj) { const unsigned d_ = iv[jj] ^ pfx; if (d_ < lim) __hip_atomic_fetch_add(tab + (d_ >> sh), 1u, __ATOMIC_RELAXED, __HIP_MEMORY_SCOPE_WORKGROUP); }
          __syncthreads();
          const v4u w4 = *(const LAS v4u*)(tab + 4 * lane);
          unsigned dg, abv, bc; sel_scan256(w4, need, tab, lane, dg, abv, bc);
          pfx |= dg << sh; need -= (int)abv;
          if ((int)bc == need) { done = true; break; }
      }
      if (done) {
          unsigned mn = 0xFFFFFFFFu;
#pragma unroll
          for (int jj = 0; jj < 33; ++jj) { const unsigned c_ = (iv[jj] >= pfx) ? uu[jj] : 0xFFFFFFFFu; mn = c_ < mn ? c_ : mn; }
          mn = ~wave_umax(~mn);
          if (lane == 0) RX[8 + wid] = mn;
          __syncthreads();
          unsigned t_ = 0xFFFFFFFFu;
#pragma unroll
          for (int w = 0; w < 8; ++w) { const unsigned x_ = RX[8 + w]; t_ = x_ < t_ ? x_ : t_; }
          T = t_; fast = true; }
      (void)fin; }
    if (!fast)
#pragma unroll 1
    for (int bit = 31; bit >= 0; --bit) {
        const unsigned cand = T | (1u << bit); int c = 0;
#pragma unroll
        for (int jj = 0; jj < 33; ++jj) c += __popcll(__ballot(uu[jj] >= cand));
        c = block_sum8(red, par, wid, lane, c); par ^= 1;
        if (c >= KTOP) { T = cand; if (c == KTOP) break; }
    }
    int cgt = 0;
#pragma unroll
    for (int jj = 0; jj < 33; ++jj) cgt += __popcll(__ballot(uu[jj] > T));
    cgt = block_sum8(red, par, wid, lane, cgt); par ^= 1;
    const int need = KTOP - cgt;
#pragma unroll
    for (int jj = 0; jj < 33; ++jj) { const int n = __popcll(__ballot(uu[jj] == T)); if (lane == 0) eqw[jj * 8 + wid] = n; }
    __syncthreads();
#define SEL_MASK(jj, eqbase, M) do { int below_ = 0, tot_ = 0; \
        _Pragma("unroll") for (int w = 0; w < 8; ++w) { const int n_ = eqw[(jj) * 8 + w]; tot_ += n_; below_ += (w < wid) ? n_ : 0; } \
        const unsigned long long eq_ = __ballot(uu[jj] == T); \
        const int rank_ = (eqbase) + below_ + (int)__builtin_amdgcn_mbcnt_hi((unsigned)(eq_ >> 32), __builtin_amdgcn_mbcnt_lo((unsigned)eq_, 0u)); \
        M = __ballot(uu[jj] > T || (uu[jj] == T && rank_ < need)); (eqbase) += tot_; } while (0)
    { int cw = 0, eqbase = 0;
#pragma unroll
      for (int jj = 0; jj < 33; ++jj) { unsigned long long m; SEL_MASK(jj, eqbase, m); cw += __popcll(m); }
      if (lane == 0) wcnt[wid] = cw; }
    __syncthreads();
    { int base = 0, eqbase = 0;
#pragma unroll
      for (int w = 0; w < 8; ++w) base += (w < wid) ? wcnt[w] : 0;
#pragma unroll
      for (int jj = 0; jj < 33; ++jj) { unsigned long long m; SEL_MASK(jj, eqbase, m);
          const int pos = base + (int)__builtin_amdgcn_mbcnt_hi((unsigned)(m >> 32), __builtin_amdgcn_mbcnt_lo((unsigned)m, 0u));
          if ((m >> lane) & 1ull) { if (pos < KTOP) selidx[pos] = (jj < 32) ? tid + 512 * jj : PAST + tid; }
          base += __popcll(m); } }
#undef SEL_MASK
    __syncthreads();
    }
    for (int rep57 = 0; rep57 < (PROBE_DUP == 57 ? 2 : 1); ++rep57) {
    const int kk = lane >> 3, ds = lane & 7;
    const float* kptr[4]; const float* vptr[4];
#pragma unroll
    for (int it = 0; it < 4; ++it) {
        const int kidx = selidx[32 * wid + 8 * it + kk];
        if (kidx < PAST) { const size_t pr = (size_t)((const int*)F.in[6])[b * NPAGES + (kidx >> 7)] * PAGE + (kidx & 127); kptr[it] = ((const float*)F.in[2]) + pr * 128 + 8 * ds; vptr[it] = ((const float*)F.in[3]) + pr * 128 + 8 * ds; }
        else { const size_t nr = (size_t)(4 * b + (kidx - PAST)); kptr[it] = F.out + O_KS + nr * 128 + 8 * ds; vptr[it] = F.out + O_VS + nr * 128 + 8 * ds; }
    }
    f32x4 kreg[2][4][2], vreg[2][4][2];
#pragma unroll
    for (int g = 0; g < 2; ++g)
#pragma unroll
        for (int it = 0; it < 4; ++it) { kreg[g][it][0] = *(const f32x4*)(kptr[it] + 64 * g); kreg[g][it][1] = *(const f32x4*)(kptr[it] + 64 * g + 4); }
#pragma unroll
    for (int g = 0; g < 2; ++g)
#pragma unroll
        for (int it = 0; it < 4; ++it) { vreg[g][it][0] = *(const f32x4*)(vptr[it] + 64 * g); vreg[g][it][1] = *(const f32x4*)(vptr[it] + 64 * g + 4); }
#pragma unroll
    for (int g = 0; g < 2; ++g) {
        float qv[4][8];
#pragma unroll
        for (int r = 0; r < 4; ++r) { const v4u qq = *(const GAS v4u*)(Qb + (size_t)row * 512 + (4 * g + r) * 64 + 8 * ds);
#pragma unroll
            for (int e = 0; e < 4; ++e) { qv[r][2 * e] = bf2f((unsigned short)(qq[e] & 0xffffu)); qv[r][2 * e + 1] = bf2f((unsigned short)(qq[e] >> 16)); } }
#pragma unroll
        for (int it = 0; it < 4; ++it) {
            const f32x4 k0 = kreg[g][it][0], k1 = kreg[g][it][1];
#pragma unroll
            for (int r = 0; r < 4; ++r) {
                float d = (qv[r][0] * k0[0] + qv[r][1] * k0[1]) + (qv[r][2] * k0[2] + qv[r][3] * k0[3]) + (qv[r][4] * k1[0] + qv[r][5] * k1[1]) + (qv[r][6] * k1[2] + qv[r][7] * k1[3]);
                d += __shfl_xor(d, 1); d += __shfl_xor(d, 2); d += __shfl_xor(d, 4);
                if (ds == 0) LG[(4 * g + r) * 256 + 32 * wid + 8 * it + kk] = d;
            }
        }
    }
    __syncthreads();
    { float l[4];
#pragma unroll
      for (int e = 0; e < 4; ++e) l[e] = LG[wid * 256 + lane + 64 * e];
      const float m = wave_max(fmaxf(fmaxf(l[0], l[1]), fmaxf(l[2], l[3])));
      float p[4], s = 0.f;
#pragma unroll
      for (int e = 0; e < 4; ++e) { p[e] = __builtin_amdgcn_exp2f(l[e] - m); s += p[e]; }
      s = wave_sum(s); const float inv = 1.0f / s;
#pragma unroll
      for (int e = 0; e < 4; ++e) LG[wid * 256 + lane + 64 * e] = p[e] * inv; }
    __syncthreads();
#pragma unroll
    for (int g = 0; g < 2; ++g) {
        float acc[4][8];
#pragma unroll
        for (int r = 0; r < 4; ++r)
#pragma unroll
            for (int e = 0; e < 8; ++e) acc[r][e] = 0.f;
#pragma unroll
        for (int it = 0; it < 4; ++it) {
            const f32x4 v0 = vreg[g][it][0], v1 = vreg[g][it][1];
#pragma unroll
            for (int r = 0; r < 4; ++r) { const float p = LG[(4 * g + r) * 256 + 32 * wid + 8 * it + kk];
#pragma unroll
                for (int e = 0; e < 4; ++e) { acc[r][e] += p * v0[e]; acc[r][4 + e] += p * v1[e]; } }
        }
#pragma unroll
        for (int r = 0; r < 4; ++r)
#pragma unroll
            for (int e = 0; e < 8; ++e) { float a = acc[r][e]; a += __shfl_xor(a, 8); a += __shfl_xor(a, 16); a += __shfl_xor(a, 32); if (kk == 0) OP[(wid * 8 + 4 * g + r) * 64 + 8 * ds + e] = a; }
    }
    __syncthreads();
    { const int hd = tid >> 6, d = tid & 63; float o = 0.f;
#pragma unroll
      for (int w = 0; w < 8; ++w) o += OP[(w * 8 + hd) * 64 + d];
      CAT[(size_t)row * D + 512 + hd * 64 + d] = (bf16)f2bf(o); }
    __syncthreads();
    }
}

constexpr int N_PHASES = 9;
struct Args { const void* in[22]; float* out; unsigned char* ws; int ph_lo, ph_hi, use_bar, pad; };
__global__ void __launch_bounds__(512, 2) hymba_fwd(Args args) {
    extern __shared__ __attribute__((aligned(16))) unsigned char lds[];
    Frame F;
    F.lds = (LAS unsigned char*)lds;
    F.MISC = (volatile LAS unsigned*)(F.lds + MISC_OFF);
    F.tid = threadIdx.x; F.lane = F.tid & 63; F.wave = __builtin_amdgcn_readfirstlane(F.tid >> 6);
    F.G = gridDim.x; { const int bx = blockIdx.x; F.vcu = (F.G % 8 == 0) ? (bx % 8) * (F.G / 8) + bx / 8 : bx; }
    F.ws = args.ws; F.out = args.out; F.ctl = (gu32*)(args.ws + WS_CTL);
    F.in = args.in;
    for (int u = F.tid; u < (LDS_BYTES - LDSCTL_OFF) / 4; u += 512) ((LAS unsigned*)(F.lds + LDSCTL_OFF))[u] = 0u;
    __syncthreads();
    XcdBarrier bar; bar.bar = (unsigned*)(F.ctl + CW_BAR); bar.x = 0; bar.st = nullptr;
    if (args.use_bar) bar = xcd_barrier_post((unsigned*)(F.ctl + CW_BAR), F.MISC + 8);
    const int lo = args.ph_lo, hi = args.ph_hi;
#define IN(k) (lo <= (k) && (k) < hi)
#define SEAM(k) do { if (IN(k) && IN((k) + 1)) { xcd_barrier(bar); if (PROBE_DUP == 60) xcd_barrier(bar); } } while (0)
    const int cblk = (int)blockIdx.x;

#ifndef PROBE_DUP
#define PROBE_DUP (-1)
#endif
#define RUNPHASE(k, ...) do { if (IN(k)) { { int t_ = F.tid; asm volatile("" : "+v"(t_)); F.tid = t_; F.lane = t_ & 63; }     \
        __VA_ARGS__; if (PROBE_DUP == (k)) { if (args.use_bar) xcd_barrier(bar); __VA_ARGS__; } } SEAM(k); } while (0)
#define RSTAB ((LAS float*)(F.lds + RING_OFF + 131072))
#define GEMM_PHASE(EPI, A_, B_, N_, K_, SS_, NSLOT_, ...) do { pg8::Gemm g{A_, B_, MP, N_, K_}; pg8::StaticOrder S; S.init(MP, N_, F.G, cblk); \
        if ((NSLOT_) > 0) fill_rstd_table(RSTAB, S, SS_, NSLOT_); \
        EPI E{__VA_ARGS__}; \
        pg8::gemm_phase<EPI, pg8::StaticOrder, true, true>(F.lds + RING_OFF, g, S, E); \
        { int nrep_ = (PROBE_DUP == 50) ? 2 : 1; asm volatile("" : "+s"(nrep_)); for (int rep_ = 0; rep_ < nrep_; ++rep_) skinny_phase<EPI, 2, 0>(F.lds + RING_OFF, A_, B_, N_, (K_) * 2, cblk, F.G, E); } } while (0)
#define GEMM_PHASE8(EPI, A8_, B8_, OSC_, N_, K_, SS_, NSLOT_, ...) do { pg8::Gemm g{(const bf16*)(A8_), (const bf16*)(B8_), MP, N_, (K_) / 2}; pg8::StaticOrder S; S.init(MP, N_, F.G, cblk); \
        if ((NSLOT_) > 0) fill_rstd_table(RSTAB, S, SS_, NSLOT_); \
        EPI E{__VA_ARGS__}; \
        pg8::gemm_phase<EPI, pg8::StaticOrder, true, true, 1>(F.lds + RING_OFF, g, S, E); \
        { int nrep_ = (PROBE_DUP == 55) ? 2 : 1; asm volatile("" : "+s"(nrep_)); for (int rep_ = 0; rep_ < nrep_; ++rep_) skinny_phase<EPI, 2, 1>(F.lds + RING_OFF, A8_, B8_, N_, K_, cblk, F.G, E, nullptr, nullptr, OSC_); } } while (0)
#define GEMM_PHASEI(EPI, A8_, B8_, XS_, WSN_, N_, K_, SS_, NSLOT_, ...) do { pg8::Gemm g{(const bf16*)(A8_), (const bf16*)(B8_), MP, N_, (K_) / 2}; pg8::StaticOrder S; S.init(MP, N_, F.G, cblk); \
        fill_rstd_table(RSTAB, S, SS_, NSLOT_, XS_); \
        EPI E{__VA_ARGS__}; \
        pg8::gemm_phase<EPI, pg8::StaticOrder, true, true, 2>(F.lds + RING_OFF, g, S, E); \
        { int nrep_ = (PROBE_DUP == 55) ? 2 : 1; asm volatile("" : "+s"(nrep_)); for (int rep_ = 0; rep_ < nrep_; ++rep_) skinny_phase<EPI, 4, 2>(F.lds + RING_OFF, A8_, B8_, N_, K_, cblk, F.G, E, XS_, WSN_); } } while (0)
    RUNPHASE(0, do { p0_prologue(F); xcd_barrier(bar); p0b_quant_weights(F); } while (0));
    RUNPHASE(1, GEMM_PHASEI(EpiGU, WSP(unsigned char, WS_XI8), WSP(unsigned char, WS_WGU1I8), WSP(float, WS_XS), WSP(float, WS_WSN), 2 * DFF, D, WSP(float, WS_SS0), 1, WSP(bf16, WS_H), WSP(float, WS_SS0), 1, RSTAB, 1.0f, WSP(unsigned char, WS_H8), WSP(float, WS_WSN)));
    RUNPHASE(2, GEMM_PHASE8(EpiRes<0>, WSP(unsigned char, WS_H8), WSP(unsigned char, WS_WD1_8), 1.0f / (W8SCALE * H8SCALE), D, DFF, nullptr, 0, WSP(bf16, WS_XB), nullptr, WSP(bf16, WS_X1B), WSP(float, WS_SS1), nullptr, 1.0f / (W8SCALE * H8SCALE), (const float*)F.in[0], (const float*)F.in[1]));
#if PROBE_DUP >= 21 && PROBE_DUP <= 23
    if (IN(2)) { xcd_barrier(bar); pg8::Gemm g{(const bf16*)WSP(unsigned char, WS_H8), (const bf16*)WSP(unsigned char, WS_WD1_8), MP, D, DFF / 2}; pg8::StaticOrder S; S.init(MP, D, F.G, cblk);
        EpiRes<0> E{WSP(bf16, WS_XB), nullptr, WSP(bf16, WS_X2B), WSP(float, WS_SS2), nullptr, 1.0f / (W8SCALE * H8SCALE), (const float*)F.in[0], (const float*)F.in[1]};
        pg8::gemm_phase<EpiRes<0>, pg8::StaticOrder, true, true, (PROBE_DUP == 21 ? 1 : PROBE_DUP == 22 ? 2 : 0)>(F.lds + RING_OFF, g, S, E); xcd_barrier(bar); }
#endif
    RUNPHASE(3, GEMM_PHASE(EpiWin, WSP(bf16, WS_X1B), WSP(bf16, WS_WIN), NINP, D, WSP(float, WS_SS1), 16, F.ws, F.out, (const float*)F.in[15], (const float*)F.in[16], RSTAB));
    RUNPHASE(4, do { p4_conv(F); if (PROBE_DUP == 40) p4_conv(F); p4_index(F); if (PROBE_DUP == 42) p4_index(F); } while (0));
    RUNPHASE(5, do { if ((F.vcu & 1) == 0 && F.vcu < 256) { p5_sample_unit(F, F.vcu >> 1); if (PROBE_DUP == 51) p5_sample_unit(F, F.vcu >> 1); }
        const attn_body::AttnTensors AT{(const attn_body::bf16*)WSP(bf16, WS_Q), (const attn_body::bf16*)WSP(bf16, WS_KB), (const attn_body::bf16*)WSP(bf16, WS_VB), WSP(unsigned long long, WS_MASK), (attn_body::bf16*)WSP(bf16, WS_CAT)};
        const attn_body::StaticOrder S(F.vcu); attn_body::attn_phase<attn_body::StaticOrder>((char*)lds + RING_OFF, AT, S); } while (0));
    RUNPHASE(6, do { GEMM_PHASE(EpiRes<1>, WSP(bf16, WS_CAT), WSP(bf16, WS_WOUT), D, D, nullptr, 0, WSP(bf16, WS_X1B), nullptr, WSP(bf16, WS_X2B), WSP(float, WS_SS2), nullptr, 1.0f);
                     xcd_barrier(bar); quant_rows_pass(F.vcu * 8 + F.wave, F.G * 8, WSP(bf16, WS_X2B), WSP(unsigned char, WS_X2I8), WSP(float, WS_XS2), MTOT); } while (0));
    RUNPHASE(7, GEMM_PHASEI(EpiGU, WSP(unsigned char, WS_X2I8), WSP(unsigned char, WS_WGU2I8), WSP(float, WS_XS2), WSP(float, WS_WSN2), 2 * DFF, D, WSP(float, WS_SS2), 16, WSP(bf16, WS_H), WSP(float, WS_SS2), 16, RSTAB, 1.0f, WSP(unsigned char, WS_H8), WSP(float, WS_WSN2)));
    RUNPHASE(8, GEMM_PHASE8(EpiRes<2>, WSP(unsigned char, WS_H8), WSP(unsigned char, WS_WD2_8), 1.0f / (W8SCALE * H8SCALE), D, DFF, nullptr, 0, WSP(bf16, WS_X2B), F.out, nullptr, nullptr, nullptr, 1.0f / (W8SCALE * H8SCALE)));
#undef RUNPHASE
#undef GEMM_PHASE
#undef GEMM_PHASE8
#undef GEMM_PHASEI
#undef RSTAB
#undef IN
#undef SEAM
}

#ifndef MK_N_LAUNCHES
#define MK_N_LAUNCHES 1
#endif
extern "C" void kernel_launch(void* const* d_in, const int* in_sizes, int n_in, void* d_out, int out_size, void* d_ws, size_t ws_size, hipStream_t stream) {
    static int grid = 0;
    if (grid == 0) {
        if (n_in != 22 || out_size != (int)O_END || ws_size < WS_END) { fprintf(stderr, "kernel_launch: unexpected problem: n_in %d out %d ws %zu (need %zu)\n", n_in, out_size, ws_size, (size_t)WS_END); grid = -1; return; }
        int dev = 0, cus = 0, per_cu = 0;
        if (hipGetDevice(&dev) != hipSuccess || hipDeviceGetAttribute(&cus, hipDeviceAttributeMultiprocessorCount, dev) != hipSuccess) { grid = -1; return; }
        if (hipFuncSetAttribute((const void*)hymba_fwd, hipFuncAttributeMaxDynamicSharedMemorySize, LDS_BYTES) != hipSuccess) { fprintf(stderr, "kernel_launch: hipFuncSetAttribute failed\n"); grid = -1; return; }
        if (hipOccupancyMaxActiveBlocksPerMultiprocessor(&per_cu, (const void*)hymba_fwd, 512, LDS_BYTES) != hipSuccess || per_cu < 1) { fprintf(stderr, "kernel_launch: occupancy query says %d blocks per CU\n", per_cu); (void)hipGetLastError(); grid = -1; return; }
        grid = cus;
        if (grid % 8 != 0 || grid < 8) { fprintf(stderr, "kernel_launch: unexpected CU count %d\n", cus); grid = -1; return; }
    }
    if (grid < 0) return;
    (void)hipMemsetAsync((char*)d_ws + WS_CTL, 0, CTL_ZERO_BYTES, stream);
    Args a{};
    for (int i = 0; i < 22; ++i) a.in[i] = d_in[i];
    a.out = (float*)d_out; a.ws = (unsigned char*)d_ws;
    if (MK_N_LAUNCHES == 1) { a.ph_lo = 0; a.ph_hi = N_PHASES; a.use_bar = 1; hipLaunchKernelGGL(hymba_fwd, dim3(grid), dim3(512), LDS_BYTES, stream, a); }
    else for (int p = 0; p < N_PHASES; ++p) { a.ph_lo = p; a.ph_hi = p + 1; a.use_bar = 0; hipLaunchKernelGGL(hymba_fwd, dim3(grid), dim3(512), LDS_BYTES, stream, a); }
}
```
